# Optimizing an MI355X kernel written in HIP

```python
import jax, jax.numpy as jnp
from jax import lax
import numpy as np

D_MODEL = 1024
BATCH = 8
SEQ = 2048
DEPTH = 2

GRID_W = 64
CTX_LEN = 256
HEAD_DIM = 64
A_HEADS = 8
A_KV_HEADS = 2
A_WIDTH = A_HEADS * HEAD_DIM
A_KV_WIDTH = A_KV_HEADS * HEAD_DIM
Q_BLOCK = 128
ROPE_BASE = 10000.0
B_HEADS = 4
B_WIDTH = B_HEADS * HEAD_DIM
DECAY_LORA = 64
AAA_LORA = 64
GATE_LORA = 128
LNX_EPS = 64e-5
C_HEADS = 4
C_WIDTH = C_HEADS * HEAD_DIM
WIN_ROWS = 8
WIN_COLS = 16
D_MIX = A_WIDTH + B_WIDTH + C_WIDTH
IN_SIZES = (A_WIDTH, A_KV_WIDTH, A_KV_WIDTH,
            B_WIDTH, B_WIDTH, B_WIDTH, 2 * DECAY_LORA, 2 * AAA_LORA, GATE_LORA,
            C_WIDTH, C_WIDTH, C_WIDTH)
N_IN = A_WIDTH + 2 * A_KV_WIDTH + 3 * B_WIDTH + 2 * DECAY_LORA + 2 * AAA_LORA + GATE_LORA + 3 * C_WIDTH
N_EXPERTS = 16
CAPACITY_FACTOR = 2
D_EXPERT = 1024
NORM_EPS = 1e-6

kernel_name = "hybrid_flow_gqa_rwkv7_natten_ecmoe"


def rms_norm(x, g, eps=NORM_EPS):
    xf = x.astype(jnp.float32)
    y = xf * lax.rsqrt(jnp.mean(xf * xf, axis=-1, keepdims=True) + eps)
    return (y * g.astype(jnp.float32)).astype(x.dtype)


def modulate(h, shift, scale):
    return h * (1 + scale) + shift


def rope_1d(x, pos):
    half = x.shape[-1] // 2
    inv = ROPE_BASE ** (-jnp.arange(half, dtype=jnp.float32) / half)
    ang = pos.astype(jnp.float32)[:, None] * inv[None, :]
    cos, sin = jnp.cos(ang)[:, None, :], jnp.sin(ang)[:, None, :]
    xf = x.astype(jnp.float32)
    x1, x2 = xf[..., :half], xf[..., half:]
    return jnp.concatenate([x1 * cos - x2 * sin, x2 * cos + x1 * sin], axis=-1).astype(x.dtype)


def rope_2d(x, row, col):
    h = x.shape[-1] // 2
    return jnp.concatenate([rope_1d(x[..., :h], row), rope_1d(x[..., h:], col)], axis=-1)


def gqa_attend(q, k, v):
    s = jnp.einsum('bmkgd,bskd->bkgms', q, k).astype(jnp.float32) * (HEAD_DIM ** -0.5)
    p = jax.nn.softmax(s, axis=-1).astype(v.dtype)
    return jnp.einsum('bkgms,bskd->bmkgd', p, v)


def mixer_grid_attention(q, k, v, q_gain, k_gain, n_ctx, need_ctx):
    B_, T, _ = q.shape
    n = T - n_ctx
    G = A_HEADS // A_KV_HEADS
    q = rms_norm(q.reshape(B_, T, A_HEADS, HEAD_DIM), q_gain)
    k = rms_norm(k.reshape(B_, T, A_KV_HEADS, HEAD_DIM), k_gain)
    v = v.reshape(B_, T, A_KV_HEADS, HEAD_DIM)
    pos = jnp.arange(n)
    row, col = pos // GRID_W, pos % GRID_W
    q_l = rope_2d(q[:, n_ctx:], row, col)
    k_l = rope_2d(k[:, n_ctx:], row, col)
    q_c, k_c, v_c, v_l = q[:, :n_ctx], k[:, :n_ctx], v[:, :n_ctx], v[:, n_ctx:]
    keys = jnp.concatenate([k_l, k_c], axis=1)
    vals = jnp.concatenate([v_l, v_c], axis=1)
    nb = n // Q_BLOCK
    qb = q_l.reshape(B_, nb, Q_BLOCK, A_KV_HEADS, G, HEAD_DIM).swapaxes(0, 1)
    o_l = lax.map(lambda qq: gqa_attend(qq, keys, vals), qb)
    o_l = o_l.swapaxes(0, 1).reshape(B_, n, A_WIDTH)
    o_c = None
    if need_ctx:
        o_c = gqa_attend(q_c.reshape(B_, n_ctx, A_KV_HEADS, G, HEAD_DIM), k_c, v_c).reshape(B_, n_ctx, A_WIDTH)
    return o_c, o_l


def mixer_neighbourhood(q, k, v, rpb, n_ctx, need_ctx):
    B_, T, _ = q.shape
    n = T - n_ctx
    rows = n // GRID_W
    wr = min(WIN_ROWS, rows)
    heads = lambda t: t.reshape(B_, T, C_HEADS, HEAD_DIM)
    q, k, v = heads(q), heads(k), heads(v)
    q_c, k_c, v_c = q[:, :n_ctx], k[:, :n_ctx], v[:, :n_ctx]
    q_l, k_l, v_l = q[:, n_ctx:], k[:, n_ctx:], v[:, n_ctx:]
    r = jnp.arange(rows)
    col = jnp.arange(GRID_W)
    row_start = jnp.clip(r - wr // 2, 0, rows - wr)
    col_start = jnp.clip(col - WIN_COLS // 2, 0, GRID_W - WIN_COLS)
    w_idx = jnp.arange(wr * WIN_COLS)
    key_row = row_start[:, None] + (w_idx // WIN_COLS)[None, :]
    key_col = col_start[:, None] + (w_idx % WIN_COLS)[None, :]
    idx = key_row[:, None, :] * GRID_W + key_col[None, :, :]
    d_row = (key_row - r[:, None] + WIN_ROWS - 1)[:, None, :]
    d_col = (key_col - col[:, None] + WIN_COLS - 1)[None, :, :]
    bias = rpb[:, d_row, d_col].astype(jnp.float32).transpose(1, 0, 2, 3)
    q_rows = q_l.reshape(B_, rows, GRID_W, C_HEADS, HEAD_DIM).swapaxes(0, 1)
    scale = HEAD_DIM ** -0.5

    def row_block(args):
        q_r, idx_r, bias_r = args
        k_w, v_w = k_l[:, idx_r], v_l[:, idx_r]
        s_w = jnp.einsum('bqhd,bqwhd->bhqw', q_r, k_w).astype(jnp.float32) * scale + bias_r
        s_c = jnp.einsum('bqhd,bchd->bhqc', q_r, k_c).astype(jnp.float32) * scale
        p = jax.nn.softmax(jnp.concatenate([s_w, s_c], axis=-1), axis=-1).astype(v_l.dtype)
        W = idx_r.shape[-1]
        return (jnp.einsum('bhqw,bqwhd->bqhd', p[..., :W], v_w)
                + jnp.einsum('bhqc,bchd->bqhd', p[..., W:], v_c))

    o_l = lax.map(row_block, (q_rows, idx, bias)).swapaxes(0, 1).reshape(B_, n, C_WIDTH)
    o_c = None
    if need_ctx:
        o_c = gqa_attend(q_c[:, :, :, None, :], k_c, v_c).reshape(B_, n_ctx, C_WIDTH)
    return o_c, o_l


def flip_segments(t, n_ctx):
    return jnp.concatenate([t[:, :n_ctx][:, ::-1], t[:, n_ctx:][:, ::-1]], axis=1)


def wkv_scan(r, w, k, v, a, b):
    B_, _, H, N = r.shape
    xs = tuple(t.swapaxes(0, 1) for t in (r, w, k, v, a, b))

    def step(S, inp):
        r_t, w_t, k_t, v_t, a_t, b_t = inp
        sa = jnp.einsum('bhij,bhj->bhi', S, a_t)
        S = S * w_t[:, :, None, :] + sa[..., None] * b_t[:, :, None, :] + v_t[..., None] * k_t[:, :, None, :]
        return S, jnp.einsum('bhij,bhj->bhi', S, r_t)

    _, y = lax.scan(step, jnp.zeros((B_, H, N, N), jnp.float32), xs)
    return y.swapaxes(0, 1)


def mixer_rwkv7(r, k, v, w_low, a_low, g_low, w0, w_up, a0, a_up, g_up, k_k, k_a, r_k, lnx_w, lnx_b, n_ctx):
    f32 = jnp.float32
    B_, T, _ = r.shape
    heads = lambda t: t.reshape(B_, T, B_HEADS, HEAD_DIM)
    r, k, v = r.astype(f32), k.astype(f32), v.astype(f32)
    kk = heads(k * k_k.astype(f32))
    kk = kk / jnp.maximum(jnp.sqrt(jnp.sum(kk * kk, axis=-1, keepdims=True)), 1e-12)
    g = jax.nn.sigmoid(g_low.astype(f32)) @ g_up.astype(f32)
    ys, bonuses = [], []
    for d in range(2):
        wl = w_low[..., d * DECAY_LORA:(d + 1) * DECAY_LORA].astype(f32)
        al = a_low[..., d * AAA_LORA:(d + 1) * AAA_LORA].astype(f32)
        w = -jax.nn.softplus(-(w0[d].astype(f32) + jnp.tanh(wl) @ w_up[d].astype(f32))) - 0.5
        decay = jnp.exp(-jnp.exp(w))
        a = jax.nn.sigmoid(a0[d].astype(f32) + al @ a_up[d].astype(f32))
        kd = k * (1 + (a - 1) * k_a.astype(f32))
        seq = [heads(t) for t in (r, decay, kd, v)] + [-kk, kk * heads(a)]
        if d == 1:
            seq = [flip_segments(t, n_ctx) for t in seq]
        y = wkv_scan(*seq)
        if d == 1:
            y = flip_segments(y, n_ctx)
        ys.append(y)
        bonuses.append(jnp.sum(heads(r * kd * r_k.astype(f32)), axis=-1, keepdims=True) * heads(v))
    y = ys[0] + ys[1]
    mu = jnp.mean(y, axis=-1, keepdims=True)
    var = jnp.mean(jnp.square(y - mu), axis=-1, keepdims=True)
    y = ((y - mu) * lax.rsqrt(var + LNX_EPS)).reshape(B_, T, B_WIDTH) * lnx_w.astype(f32) + lnx_b.astype(f32)
    return (y + (bonuses[0] + bonuses[1]).reshape(B_, T, B_WIDTH)) * g


def ec_moe(h, w_router, w_gate, w_up, w_down):
    B_, n, _ = h.shape
    cap = CAPACITY_FACTOR * n // N_EXPERTS
    aff = jax.nn.softmax((h @ w_router).astype(jnp.float32), axis=-1)
    gate, idx = lax.top_k(aff.swapaxes(1, 2), cap)
    bidx = jnp.arange(B_)[:, None, None]
    xe = h[bidx, idx]
    hid = jax.nn.silu(jnp.einsum('becd,edf->becf', xe, w_gate)) * jnp.einsum('becd,edf->becf', xe, w_up)
    ye = jnp.einsum('becf,efd->becd', hid, w_down) * gate[..., None].astype(h.dtype)
    return jnp.zeros_like(h).at[bidx, idx].add(ye)


def setup_inputs(seed: int = 0) -> dict:
    key = jax.random.key(seed)
    ks = iter(jax.random.split(key, 40))
    nrm = lambda shape, s: jax.random.normal(next(ks), shape, jnp.float32) * s
    L, D = DEPTH, D_MODEL
    return {
        "x": nrm((BATCH, SEQ, D), 1.0),
        "c": nrm((BATCH, D), 1.0),
        "ctx": nrm((BATCH, CTX_LEN, D), 1.0),
        "c_ctx": nrm((D,), 1.0),
        "w_mod": nrm((L, D, 6 * D), 0.5 * D ** -0.5),
        "b_mod": nrm((L, 6 * D), 0.01),
        "g_pre_mix": 1.0 + nrm((L, D), 0.05),
        "g_post_mix": 1.0 + nrm((L, D), 0.05),
        "g_pre_ffn": 1.0 + nrm((L, D), 0.05),
        "g_post_ffn": 1.0 + nrm((L, D), 0.05),
        "w_in": nrm((L, D, N_IN), D ** -0.5),
        "w_out": nrm((L, D_MIX, D), D_MIX ** -0.5),
        "q_gain": 1.0 + nrm((L, HEAD_DIM), 0.05),
        "k_gain": 1.0 + nrm((L, HEAD_DIM), 0.05),
        "rpb": nrm((L, C_HEADS, 2 * WIN_ROWS - 1, 2 * WIN_COLS - 1), 0.1),
        "rk_w0": jax.random.uniform(next(ks), (L, 2, B_WIDTH), jnp.float32, -5.0, 0.0),
        "rk_w_up": nrm((L, 2, DECAY_LORA, B_WIDTH), 0.5 * DECAY_LORA ** -0.5),
        "rk_a0": nrm((L, 2, B_WIDTH), 0.1),
        "rk_a_up": nrm((L, 2, AAA_LORA, B_WIDTH), 0.5 * AAA_LORA ** -0.5),
        "rk_g_up": nrm((L, GATE_LORA, B_WIDTH), GATE_LORA ** -0.5),
        "rk_k_k": 0.85 + nrm((L, B_WIDTH), 0.05),
        "rk_k_a": 1.0 + nrm((L, B_WIDTH), 0.05),
        "rk_r_k": nrm((L, B_WIDTH), 0.1),
        "rk_lnx_w": 1.0 + nrm((L, B_WIDTH), 0.05),
        "rk_lnx_b": nrm((L, B_WIDTH), 0.01),
        "w_router": nrm((L, D, N_EXPERTS), D ** -0.5),
        "w_e_gate": nrm((L, N_EXPERTS, D, D_EXPERT), D ** -0.5),
        "w_e_up": nrm((L, N_EXPERTS, D, D_EXPERT), D ** -0.5),
        "w_e_down": nrm((L, N_EXPERTS, D_EXPERT, D), D_EXPERT ** -0.5),
    }


def reference(x, c, ctx, c_ctx, w_mod, b_mod, g_pre_mix, g_post_mix, g_pre_ffn, g_post_ffn,
              w_in, w_out, q_gain, k_gain, rpb, rk_w0, rk_w_up, rk_a0, rk_a_up, rk_g_up,
              rk_k_k, rk_k_a, rk_r_k, rk_lnx_w, rk_lnx_b, w_router, w_e_gate, w_e_up, w_e_down):
    x_l, x_c = x, ctx
    n_ctx = ctx.shape[1]
    in_splits = np.cumsum(IN_SIZES)[:-1].tolist()
    s_l, s_c = jax.nn.silu(c), jax.nn.silu(c_ctx)
    for i in range(DEPTH):
        need_ctx = i < DEPTH - 1
        m_l = jnp.split((s_l @ w_mod[i] + b_mod[i])[:, None, :], 6, axis=-1)
        m_c = jnp.split(s_c @ w_mod[i] + b_mod[i], 6, axis=-1)
        h = jnp.concatenate([modulate(rms_norm(x_c, g_pre_mix[i]), m_c[0], m_c[1]),
                             modulate(rms_norm(x_l, g_pre_mix[i]), m_l[0], m_l[1])], axis=1)
        proj = h @ w_in[i]
        (qa, ka, va, rb, kb, vb, wlb, alb, glb, qn, kn, vn) = jnp.split(proj, in_splits, axis=-1)
        oa_c, oa_l = mixer_grid_attention(qa, ka, va, q_gain[i], k_gain[i], n_ctx, need_ctx)
        ob = mixer_rwkv7(rb, kb, vb, wlb, alb, glb, rk_w0[i], rk_w_up[i], rk_a0[i], rk_a_up[i],
                         rk_g_up[i], rk_k_k[i], rk_k_a[i], rk_r_k[i], rk_lnx_w[i], rk_lnx_b[i],
                         n_ctx).astype(x.dtype)
        on_c, on_l = mixer_neighbourhood(qn, kn, vn, rpb[i], n_ctx, need_ctx)
        y_l = jnp.concatenate([oa_l, ob[:, n_ctx:], on_l], axis=-1) @ w_out[i]
        x_l = x_l + m_l[2] * rms_norm(y_l, g_post_mix[i])
        if need_ctx:
            y_c = jnp.concatenate([oa_c, ob[:, :n_ctx], on_c], axis=-1) @ w_out[i]
            x_c = x_c + m_c[2] * rms_norm(y_c, g_post_mix[i])
        h_l = modulate(rms_norm(x_l, g_pre_ffn[i]), m_l[3], m_l[4])
        f_l = ec_moe(h_l, w_router[i], w_e_gate[i], w_e_up[i], w_e_down[i])
        x_l = x_l + m_l[5] * rms_norm(f_l, g_post_ffn[i])
        if need_ctx:
            h_c = modulate(rms_norm(x_c, g_pre_ffn[i]), m_c[3], m_c[4])
            f_c = ec_moe(h_c, w_router[i], w_e_gate[i], w_e_up[i], w_e_down[i])
            x_c = x_c + m_c[5] * rms_norm(f_c, g_post_ffn[i])
    return x_l
```

```cpp
#define GOLD_GEMM 1
#define N_LAUNCH_MODE 1
#include <hip/hip_runtime.h>
#include <hip/hip_cooperative_groups.h>
#include <cstdio>
#include <cstdint>
namespace cg = cooperative_groups;

#ifndef GOLD_GEMM
#define GOLD_GEMM 0
#endif
#ifndef GOLD_ATTN
#define GOLD_ATTN 1
#endif
#ifndef N_LAUNCH_MODE
#define N_LAUNCH_MODE 1
#endif

#define LAS __attribute__((address_space(3)))
typedef unsigned short bf16;
typedef float f32x4 __attribute__((ext_vector_type(4)));
typedef unsigned u32x4 __attribute__((ext_vector_type(4)));
typedef unsigned u32x2 __attribute__((ext_vector_type(2)));
typedef short bf16x8 __attribute__((ext_vector_type(8)));

constexpr int D = 1024, NB = 8, SEQ = 2048, CTXL = 256, T = SEQ + CTXL, M = NB * T, NL = 2;
constexpr int NINP = 2816;
constexpr int NE = 16, MEXP = 2304;
constexpr float LOG2E = 1.4426950408889634f;
constexpr float C2 = 0.125f * LOG2E;
constexpr int NTHREADS = 512, NWAVES = 8;
constexpr int LDS_BYTES = 147456, RING_BYTES = 131072, MISC_OFF = RING_BYTES + 320;

constexpr size_t MiB = 1u << 20;
constexpr size_t WS_CTL = 0, CTL_ZERO_BYTES = 1 * MiB;
constexpr size_t WS_MOD = 1 * MiB;
constexpr size_t WS_WIN = 2 * MiB;
constexpr size_t WS_WOUT = 13 * MiB;
constexpr size_t WS_LORA = 17 * MiB;
constexpr size_t WS_WGU = 19 * MiB;
constexpr size_t WS_WD = 83 * MiB;
constexpr size_t WS_X = 115 * MiB;
constexpr size_t R0 = 187 * MiB;
constexpr size_t WS_YD = R0 + 0 * MiB;
constexpr size_t WS_H = R0 + 36 * MiB;
constexpr size_t WS_QKV = R0 + 72 * MiB;
constexpr size_t WS_R32 = R0 + 126 * MiB;
constexpr size_t WS_Z = R0 + 180 * MiB;
constexpr size_t WS_DEC = R0 + 194 * MiB;
constexpr size_t WS_ASIG = R0 + 230 * MiB;
constexpr size_t WS_G = R0 + 266 * MiB;
constexpr size_t WS_O = R0 + 284 * MiB;
constexpr size_t WS_END = R0 + 320 * MiB;
constexpr size_t WS_Y = WS_QKV;
constexpr size_t WS_OUTE = WS_QKV;
constexpr size_t WS_H2 = WS_DEC;
constexpr size_t WS_AFF = WS_Z;
constexpr size_t WS_INV = WS_Z + 2 * MiB;
constexpr size_t WS_SELG = WS_Z + 4 * MiB;
constexpr size_t WS_SELT = WS_Z + 5 * MiB;
constexpr size_t WS_XE = WS_ASIG;
constexpr size_t WS_HID = WS_YD;
static_assert(WS_END <= 512 * MiB, "ws map");
constexpr int CW_BAR = 4096;
constexpr int CW_QUEUE = 16384;

__device__ __forceinline__ unsigned f2bf(float f) { unsigned u = __builtin_bit_cast(unsigned, f); return (u + 0x7fffu + ((u >> 16) & 1u)) >> 16; }
__device__ __forceinline__ unsigned pk2(float lo, float hi) { return f2bf(lo) | (f2bf(hi) << 16); }
__device__ __forceinline__ float bf2f(unsigned h) { return __builtin_bit_cast(float, h << 16); }
__device__ __forceinline__ float bflo(unsigned w) { return __builtin_bit_cast(float, w << 16); }
__device__ __forceinline__ float bfhi(unsigned w) { return __builtin_bit_cast(float, w & 0xffff0000u); }
__device__ __forceinline__ float wave_sum(float v) {
#pragma unroll
    for (int o = 1; o < 64; o <<= 1) v += __shfl_xor(v, o);
    return v;
}
__device__ __forceinline__ float sigmoidf_(float x) { return __builtin_amdgcn_rcpf(1.f + __expf(-x)); }
#define LDS_WAIT() asm volatile("s_waitcnt lgkmcnt(0)" ::: "memory")

#define XB_TMO      128
#define XB_XCNT(j)  (256  + 64 * (j))
#define XB_XSUB(j)  (1280 + 64 * (j))
#define XB_XGEN(j)  (2304 + 64 * (j))
#define XB_TOP      3328
#define XB_TOPGEN   3392
#define XCD_BAR_WORDS 3456
#define XB_SPIN_CAP (1u << 22)
__device__ __forceinline__ unsigned xb_ld(unsigned* p)              { return __hip_atomic_load(p, __ATOMIC_RELAXED, __HIP_MEMORY_SCOPE_AGENT); }
__device__ __forceinline__ unsigned xb_add(unsigned* p, unsigned v) { return __hip_atomic_fetch_add(p, v, __ATOMIC_RELAXED, __HIP_MEMORY_SCOPE_AGENT); }
__device__ __forceinline__ unsigned xb_xcc_id() { return (unsigned)__builtin_amdgcn_s_getreg((3 << 11) | 20) & 0xFu; }
#define XB_SPIN(cond, bar) do { unsigned _sp = 0; while (cond) { __builtin_amdgcn_s_sleep(1); \
    if ((++_sp & 255u) == 0u) { if (xb_ld(&(bar)[XB_TMO])) break; if (_sp > XB_SPIN_CAP) { atomicAdd(&(bar)[XB_TMO], 1u); break; } } } } while (0)
struct XcdBarrier { unsigned* bar; unsigned x; volatile LAS unsigned* st; };
__device__ __forceinline__ XcdBarrier xcd_barrier_post(unsigned* bar, volatile LAS unsigned* st) {
    XcdBarrier b; b.bar = bar; b.x = xb_xcc_id(); b.st = st;
    if (threadIdx.x == 0) (void)xb_add(&bar[XB_XCNT(b.x)], 1u);
    return b;
}
__device__ __forceinline__ void xcd_barrier_complete(unsigned* bar, unsigned x, unsigned& nloc, unsigned& nx) {
    const unsigned G = gridDim.x * gridDim.y * gridDim.z;
    unsigned sum, cnt, mine, sp = 0u;
    for (;;) {
        sum = 0u; cnt = 0u; mine = 0u;
#pragma unroll
        for (unsigned j = 0; j < 16; ++j) { const unsigned c = xb_ld(&bar[XB_XCNT(j)]); sum += c; cnt += (c > 0u) ? 1u : 0u; mine = (j == x) ? c : mine; }
        if (sum == G) break;
        __builtin_amdgcn_s_sleep(1);
        if ((++sp & 255u) == 0u) { if (xb_ld(&bar[XB_TMO])) break; if (sp > XB_SPIN_CAP) { atomicAdd(&bar[XB_TMO], 1u); break; } }
    }
    nloc = mine > 0u ? mine : 1u; nx = cnt > 0u ? cnt : 1u;
}
__device__ __forceinline__ void xcd_barrier(const XcdBarrier& b) {
    asm volatile("s_waitcnt vmcnt(0)" ::: "memory");
    __syncthreads();
    if (threadIdx.x == 0) {
        unsigned* bar = b.bar;
        __builtin_amdgcn_s_waitcnt(0);
        unsigned nloc = b.st[0], nx = b.st[1];
        if (nloc == 0u) { xcd_barrier_complete(bar, b.x, nloc, nx); b.st[0] = nloc; b.st[1] = nx; }
        const unsigned old = xb_add(&bar[XB_XSUB(b.x)], 1u);
        const unsigned gen = old / nloc;
        if (old + 1u == (gen + 1u) * nloc) {
            __builtin_amdgcn_fence(__ATOMIC_RELEASE, "agent");
            asm volatile("s_waitcnt vmcnt(0)" ::: "memory");
            const unsigned og = xb_add(&bar[XB_TOP], 1u);
            const unsigned tg = og / nx;
            if (og + 1u == (tg + 1u) * nx) xb_add(&bar[XB_TOPGEN], 1u);
            else XB_SPIN(xb_ld(&bar[XB_TOPGEN]) == tg, bar);
            __builtin_amdgcn_fence(__ATOMIC_ACQUIRE, "agent");
            xb_add(&bar[XB_XGEN(b.x)], 1u);
            asm volatile("s_waitcnt vmcnt(0)" ::: "memory");
        } else {
            XB_SPIN(xb_ld(&bar[XB_XGEN(b.x)]) == gen, bar);
            __builtin_amdgcn_fence(__ATOMIC_ACQUIRE, "agent");
            asm volatile("s_waitcnt vmcnt(0)" ::: "memory");
        }
    }
    __syncthreads();
}
namespace pg8 {
#define PG8_LAS __attribute__((address_space(3)))
typedef unsigned short bf16_t;
typedef short bf16x8 __attribute__((ext_vector_type(8)));
typedef float f32x4 __attribute__((ext_vector_type(4)));
typedef unsigned u32x4 __attribute__((ext_vector_type(4)));
constexpr int BM = 256, BK = 64, HALF = 128, HTB = HALF * BK * 2  , STAGE_BYTES = 8 * HTB, NXCD = 8, WGM = 8;

__host__ __device__ __forceinline__ int lds_byte(int r, int c) { const int st = (r >> 4) * 2 + (c >> 5), rr = r & 15, cc = c & 31, ob = rr * 64 + cc * 2; return st * 1024 + (ob ^ (((ob >> 9) & 1) << 5)); }
__host__ __device__ __forceinline__ void stage_rc(int b, int& R, int& C) { const int st = b / 1024, sb = b % 1024, swz = sb ^ (((sb >> 9) & 1) << 5); R = (st >> 1) * 16 + swz / 64; C = (st & 1) * 32 + (swz % 64) / 2; }
__host__ __device__ __forceinline__ int perm32(int rho) { const int n = rho >> 4, i = rho & 15; return 8 * (i >> 2) + 4 * n + (i & 3); }

struct Unit { int pm, pn; };
struct Gemm { const bf16_t* A; const bf16_t* Bt; int M, N, K; };

struct StaticOrder {
    int nM, nN, nwg, G, c;
    __host__ __device__ void init(int M, int N, int G_, int c_) { nM = M / BM; nN = N / BM; nwg = nM * nN; G = G_; c = c_; }
    __host__ __device__ bool next(int i, Unit& u) const {
        const long L = (long)i * G + c; if (L >= nwg) return false;
        int wgid = (int)L; { const int q = nwg / NXCD, r = nwg % NXCD, xcd = wgid % NXCD, off = wgid / NXCD; wgid = (xcd < r ? xcd * (q + 1) : r * (q + 1) + (xcd - r) * q) + off; }
        const int nig = WGM * nN, gid = wgid / nig, fm = gid * WGM, gsz = (nM - fm) < WGM ? (nM - fm) : WGM;
        u.pm = fm + ((wgid % nig) % gsz); u.pn = (wgid % nig) / gsz; return true;
    }
    __device__ __forceinline__ void a_ready(const Unit&) const {}
    __device__ __forceinline__ void done(const Unit&) const {}
};
__device__ __forceinline__ unsigned cvt_pk_bf16(float lo, float hi) { unsigned r; asm volatile("v_cvt_pk_bf16_f32 %0, %1, %2" : "=v"(r) : "v"(lo), "v"(hi)); return r; }
typedef float f32x2 __attribute__((ext_vector_type(2)));
template <class Epi, class Sched, bool ALIGN_EPI = false, bool SP2 = false>
__device__ __forceinline__ void gemm_phase(PG8_LAS unsigned char* lds, const Gemm g, const Sched& S, const Epi& E) {
    const int tid = threadIdx.x, wid = __builtin_amdgcn_readfirstlane(tid >> 6), lane = tid & 63, wr = wid >> 2, wc = wid & 3, fr = lane & 15, fq = lane >> 4;
    const int K = g.K, nt = K / BK;
    unsigned voffA[2], voffB[2];
#pragma unroll
    for (int i = 0; i < 2; ++i) { int R, C; stage_rc(tid * 16 + i * 8192, R, C); const int Rb = Epi::PERM ? ((R & ~31) + perm32(R & 31)) : R;
        voffA[i] = (unsigned)(R * K + C) * 2u; voffB[i] = (unsigned)(Rb * K + C) * 2u; }
    const size_t kstep = (size_t)(BK * 2);
    const size_t hstep = (size_t)HALF * K * 2;
    const size_t tstep = 2 * hstep;
    const unsigned ldsw = (unsigned)wid * 1024u;
    const int aoff = lds_byte(wr * 64 + fr, fq * 8), boff = lds_byte(wc * 32 + fr, fq * 8);
#define PG8_SA(b, h) (((b) * 2 + (h)) * HTB)
#define PG8_SB(b, h) ((4 + (b) * 2 + (h)) * HTB)
#define PG8_STAGE(bufoff, gbase, voff) do { _Pragma("unroll") for (int _i = 0; _i < 2; ++_i) \
        __builtin_amdgcn_global_load_lds((const unsigned*)((const char*)(gbase) + (voff)[_i]), (PG8_LAS unsigned*)(lds + (bufoff) + ldsw + _i * 8192), 16, 0, 0); } while (0)
#define PG8_LDA(dst, b, h) do { _Pragma("unroll") for (int m = 0; m < 4; ++m) _Pragma("unroll") for (int k = 0; k < 2; ++k) dst[m][k] = *(const PG8_LAS bf16x8*)(lds + PG8_SA(b, h) + aoff + m * 2048 + k * 1024); } while (0)
#define PG8_LDB(dst, b, h) do { _Pragma("unroll") for (int n = 0; n < 2; ++n) _Pragma("unroll") for (int k = 0; k < 2; ++k) dst[n][k] = *(const PG8_LAS bf16x8*)(lds + PG8_SB(b, h) + boff + n * 2048 + k * 1024); } while (0)
#define PG8_MMA(ai, bj, At, Bt) do { __builtin_amdgcn_s_setprio(1); _Pragma("unroll") for (int m = 0; m < 4; ++m) _Pragma("unroll") for (int n = 0; n < 2; ++n) _Pragma("unroll") for (int k = 0; k < 2; ++k) \
        acc[ai][bj][m][n] = __builtin_amdgcn_mfma_f32_16x16x32_bf16(Bt[n][k], At[m][k], acc[ai][bj][m][n], 0, 0, 0); __builtin_amdgcn_s_setprio(0); } while (0)
#define PG8_WAIT_V(n) asm volatile("s_waitcnt vmcnt(" #n ")" ::: "memory")
#define PG8_WAIT_L(n) asm volatile("s_waitcnt lgkmcnt(" #n ")" ::: "memory")
#define PG8_BAR __builtin_amdgcn_s_barrier()
#define PG8_SCHED __builtin_amdgcn_sched_barrier(0)
    Unit cur, nxt; int ui = 0;
    if (!S.next(0, cur)) return;
    f32x4 acc[2][2][4][2];
#pragma unroll
    for (int a = 0; a < 2; ++a)
#pragma unroll
        for (int b = 0; b < 2; ++b)
#pragma unroll
            for (int m = 0; m < 4; ++m)
#pragma unroll
                for (int n = 0; n < 2; ++n) acc[a][b][m][n] = (f32x4){0.f, 0.f, 0.f, 0.f};
    bf16x8 At[4][2], B0[2][2], B1[2][2];
    const char* cA = (const char*)g.A + (size_t)cur.pm * tstep; const char* cB = (const char*)g.Bt + (size_t)cur.pn * tstep;
    S.a_ready(cur);
    if constexpr (SP2) {
        PG8_STAGE(PG8_SB(0, 0), cB, voffB); PG8_STAGE(PG8_SB(0, 1), cB + hstep, voffB); PG8_STAGE(PG8_SA(0, 0), cA, voffA); PG8_STAGE(PG8_SA(0, 1), cA + hstep, voffA);
        if (wr == 1) PG8_BAR;
        PG8_WAIT_V(2); PG8_BAR;
        PG8_STAGE(PG8_SB(1, 0), cB + kstep, voffB); PG8_STAGE(PG8_SA(1, 0), cA + kstep, voffA); PG8_STAGE(PG8_SB(1, 1), cB + hstep + kstep, voffB);
        PG8_WAIT_V(6); PG8_BAR;
    } else {
        PG8_STAGE(PG8_SB(0, 0), cB, voffB); PG8_STAGE(PG8_SA(0, 0), cA, voffA); PG8_STAGE(PG8_SB(0, 1), cB + hstep, voffB); PG8_STAGE(PG8_SA(0, 1), cA + hstep, voffA);
        if (wr == 1) PG8_BAR;
        PG8_WAIT_V(4); PG8_BAR;
        PG8_STAGE(PG8_SB(1, 0), cB + kstep, voffB); PG8_STAGE(PG8_SA(1, 0), cA + kstep, voffA); PG8_STAGE(PG8_SB(1, 1), cB + hstep + kstep, voffB);
        PG8_WAIT_V(6); PG8_BAR;
    }
    for (;;) {
        const bool has_next = S.next(ui + 1, nxt);
        const char* nA = has_next ? (const char*)g.A + (size_t)nxt.pm * tstep : cA; const char* nB = has_next ? (const char*)g.Bt + (size_t)nxt.pn * tstep : cB;
        for (int t = 0; t < nt; t += 2) {
            const bool last = (t == nt - 2);
            const char* a1 = cA + (size_t)(t + 1) * kstep;
            const char* a2 = last ? nA : cA + (size_t)(t + 2) * kstep; const char* b2 = last ? nB : cB + (size_t)(t + 2) * kstep;
            const char* a3 = a2 + kstep; const char* b3 = b2 + kstep;
            if (last && has_next) S.a_ready(nxt);
            if constexpr (SP2) {
            PG8_LDB(B0, 0, 0); PG8_LDB(B1, 0, 1); PG8_SCHED; PG8_LDA(At, 0, 0); PG8_STAGE(PG8_SA(1, 1), a1 + hstep, voffA);
            PG8_WAIT_V(8); PG8_WAIT_L(0); PG8_BAR; PG8_MMA(0, 0, At, B0); PG8_MMA(0, 1, At, B1); PG8_BAR; PG8_SCHED;
            PG8_LDA(At, 0, 1); PG8_STAGE(PG8_SB(0, 0), b2, voffB); PG8_STAGE(PG8_SB(0, 1), b2 + hstep, voffB); PG8_STAGE(PG8_SA(0, 0), a2, voffA);
            PG8_WAIT_V(8); PG8_WAIT_L(0); PG8_BAR; PG8_MMA(1, 0, At, B0); PG8_MMA(1, 1, At, B1); PG8_BAR; PG8_SCHED;
            PG8_LDB(B0, 1, 0); PG8_LDB(B1, 1, 1); PG8_SCHED; PG8_LDA(At, 1, 0); PG8_STAGE(PG8_SA(0, 1), a2 + hstep, voffA);
            PG8_WAIT_V(8); PG8_WAIT_L(0); PG8_BAR; PG8_MMA(0, 0, At, B0); PG8_MMA(0, 1, At, B1); PG8_BAR; PG8_SCHED;
            PG8_LDA(At, 1, 1); PG8_STAGE(PG8_SB(1, 0), b3, voffB); PG8_STAGE(PG8_SB(1, 1), b3 + hstep, voffB); PG8_STAGE(PG8_SA(1, 0), a3, voffA);
            PG8_WAIT_V(8); PG8_WAIT_L(0); PG8_BAR; PG8_MMA(1, 0, At, B0); PG8_MMA(1, 1, At, B1); PG8_BAR; PG8_SCHED;
            } else {
            PG8_LDB(B0, 0, 0); PG8_SCHED; PG8_LDA(At, 0, 0); PG8_STAGE(PG8_SA(1, 1), a1 + hstep, voffA);
            PG8_WAIT_L(8); PG8_BAR; PG8_WAIT_L(0); PG8_MMA(0, 0, At, B0); PG8_BAR; PG8_SCHED;
            PG8_LDB(B1, 0, 1); PG8_STAGE(PG8_SB(0, 0), b2, voffB);
            PG8_BAR; PG8_WAIT_L(0); PG8_MMA(0, 1, At, B1); PG8_BAR;
            PG8_LDA(At, 0, 1); PG8_STAGE(PG8_SA(0, 0), a2, voffA);
            PG8_BAR; PG8_WAIT_L(0); PG8_MMA(1, 0, At, B0); PG8_BAR; PG8_SCHED;
            PG8_STAGE(PG8_SB(0, 1), b2 + hstep, voffB);
            PG8_WAIT_V(6); PG8_BAR; PG8_MMA(1, 1, At, B1); PG8_BAR;
            PG8_LDB(B0, 1, 0); PG8_SCHED; PG8_LDA(At, 1, 0); PG8_STAGE(PG8_SA(0, 1), a2 + hstep, voffA);
            PG8_WAIT_L(8); PG8_BAR; PG8_WAIT_L(0); PG8_MMA(0, 0, At, B0); PG8_BAR; PG8_SCHED;
            PG8_LDB(B1, 1, 1); PG8_STAGE(PG8_SB(1, 0), b3, voffB);
            PG8_BAR; PG8_WAIT_L(0); PG8_MMA(0, 1, At, B1); PG8_BAR;
            PG8_LDA(At, 1, 1); PG8_STAGE(PG8_SA(1, 0), a3, voffA);
            PG8_BAR; PG8_WAIT_L(0); PG8_MMA(1, 0, At, B0); PG8_BAR; PG8_SCHED;
            PG8_STAGE(PG8_SB(1, 1), b3 + hstep, voffB);
            PG8_WAIT_V(6); PG8_BAR; PG8_MMA(1, 1, At, B1); PG8_BAR;
            }
        }
        if constexpr (ALIGN_EPI) { if (wr == 0) PG8_BAR; }
        if constexpr (!Epi::AFTER_DRAIN) { E(acc, cur, wr, wc, fr, fq); S.done(cur); }
        if (!has_next) break;
#pragma unroll
        for (int a = 0; a < 2; ++a)
#pragma unroll
            for (int b = 0; b < 2; ++b)
#pragma unroll
                for (int m = 0; m < 4; ++m)
#pragma unroll
                    for (int n = 0; n < 2; ++n) acc[a][b][m][n] = (f32x4){0.f, 0.f, 0.f, 0.f};
        cur = nxt; cA = nA; cB = nB; ++ui;
        if constexpr (ALIGN_EPI) { if (wr == 1) PG8_BAR; }
    }
    PG8_WAIT_V(0);
    if constexpr (!ALIGN_EPI) { if (wr == 0) PG8_BAR; }
    PG8_BAR;
    if constexpr (Epi::AFTER_DRAIN) { E.fused(acc, cur, wr, wc, fr, fq, lds, wid, lane); S.done(cur); }
#undef PG8_SA
#undef PG8_SB
#undef PG8_STAGE
#undef PG8_LDA
#undef PG8_LDB
#undef PG8_MMA
#undef PG8_WAIT_V
#undef PG8_WAIT_L
#undef PG8_BAR
#undef PG8_SCHED
}
}

__device__ __forceinline__ u32x4 pack8(const f32x4 a, const f32x4 b) {
    u32x4 w; w.x = pk2(a[0], a[1]); w.y = pk2(a[2], a[3]); w.z = pk2(b[0], b[1]); w.w = pk2(b[2], b[3]); return w;
}
__device__ __forceinline__ float tanh_fast(float x) { const float e = __expf(2.f * x); return 1.f - 2.f * __builtin_amdgcn_rcpf(1.f + e); }
__device__ __forceinline__ float decay_of(float v) { const float ew = 0.6065306597126334f * __builtin_amdgcn_rcpf(1.f + __expf(-v)); return __expf(-ew); }
struct EpiInproj {
    static constexpr bool PERM = true, AFTER_DRAIN = false;
    bf16* QKV; float* R32; bf16* Z;
    __device__ __forceinline__ void operator()(const f32x4 (&acc)[2][2][4][2], const pg8::Unit& u, int wr, int wc, int fr, int fq) const {
        const int pn = u.pn;
#pragma unroll
        for (int ai = 0; ai < 2; ++ai)
#pragma unroll
            for (int m = 0; m < 4; ++m) {
                const unsigned row = (unsigned)u.pm * 256u + ai * 128 + wr * 64 + m * 16 + fr;
#pragma unroll
                for (int bj = 0; bj < 2; ++bj) {
                    f32x4 v0 = acc[ai][bj][m][0], v1 = acc[ai][bj][m][1];
                    const int cb = bj * 128 + wc * 32 + 8 * fq;
                    if (pn < 6) {
                        if (pn == 3) { v0 = v0 * C2; v1 = v1 * C2; }
                        *(u32x4*)(QKV + row * 1536 + pn * 256 + cb) = pack8(v0, v1);
                    } else if (pn < 9) {
                        float* p = R32 + row * 768 + (pn - 6) * 256 + cb;
                        *(f32x4*)p = v0; *(f32x4*)(p + 4) = v1;
                    } else if (pn == 9) {
                        if (bj == 0) {
#pragma unroll
                            for (int e = 0; e < 4; ++e) { v0[e] = tanh_fast(v0[e]); v1[e] = tanh_fast(v1[e]); }
                        }
                        *(u32x4*)(Z + row * 384 + cb) = pack8(v0, v1);
                    } else {
                        if (bj == 0) {
#pragma unroll
                            for (int e = 0; e < 4; ++e) { v0[e] = sigmoidf_(v0[e]); v1[e] = sigmoidf_(v1[e]); }
                            *(u32x4*)(Z + row * 384 + 256 + cb) = pack8(v0, v1);
                        }
                    }
                }
            }
    }
};
struct EpiLora {
    static constexpr bool PERM = true, AFTER_DRAIN = false;
    float* DEC; float* ASIG; float* G; const float* w0; const float* a0;
    template <int KIND> __device__ __forceinline__ void body(const f32x4 (&acc)[2][2][4][2], float* dst, const float* bias, unsigned row0, int cb0) const {
#pragma unroll
        for (int bj = 0; bj < 2; ++bj) {
            const int cb = bj * 128 + cb0;
            f32x4 b0 = (f32x4){0.f, 0.f, 0.f, 0.f}, b1 = b0;
            if (KIND != 2) { b0 = *(const f32x4*)(bias + cb); b1 = *(const f32x4*)(bias + cb + 4); }
#pragma unroll
            for (int ai = 0; ai < 2; ++ai)
#pragma unroll
                for (int m = 0; m < 4; ++m) {
                    f32x4 v0 = acc[ai][bj][m][0] + b0, v1 = acc[ai][bj][m][1] + b1;
#pragma unroll
                    for (int e = 0; e < 4; ++e) {
                        if (KIND == 0) { v0[e] = decay_of(v0[e]); v1[e] = decay_of(v1[e]); }
                        if (KIND == 1) { v0[e] = sigmoidf_(v0[e]); v1[e] = sigmoidf_(v1[e]); }
                    }
                    float* p = dst + (row0 + ai * 128 + m * 16) * 256u + cb;
                    *(f32x4*)p = v0; *(f32x4*)(p + 4) = v1;
                    asm volatile("" ::: "memory");
                }
        }
    }
    __device__ __forceinline__ void operator()(const f32x4 (&acc)[2][2][4][2], const pg8::Unit& u, int wr, int wc, int fr, int fq) const {
        const int pn = u.pn; const unsigned row0 = (unsigned)u.pm * 256u + wr * 64 + fr; const int cb0 = wc * 32 + 8 * fq;
        if (pn < 2) body<0>(acc, DEC + (size_t)pn * M * 256, w0 + pn * 256, row0, cb0);
        else if (pn < 4) body<1>(acc, ASIG + (size_t)(pn - 2) * M * 256, a0 + (pn - 2) * 256, row0, cb0);
        else body<2>(acc, G, w0, row0, cb0);
    }
};
struct EpiOut {
    static constexpr bool PERM = true, AFTER_DRAIN = false;
    float* Y;
    __device__ __forceinline__ void operator()(const f32x4 (&acc)[2][2][4][2], const pg8::Unit& u, int wr, int wc, int fr, int fq) const {
#pragma unroll
        for (int ai = 0; ai < 2; ++ai)
#pragma unroll
            for (int m = 0; m < 4; ++m) {
                const unsigned row = (unsigned)u.pm * 256u + ai * 128 + wr * 64 + m * 16 + fr;
#pragma unroll
                for (int bj = 0; bj < 2; ++bj) {
                    float* p = Y + row * 1024 + u.pn * 256 + bj * 128 + wc * 32 + 8 * fq;
                    *(f32x4*)p = acc[ai][bj][m][0]; *(f32x4*)(p + 4) = acc[ai][bj][m][1];
                }
            }
    }
};
struct EpiMoe1 {
    static constexpr bool PERM = true, AFTER_DRAIN = false;
    bf16* HID;
    __device__ __forceinline__ void operator()(const f32x4 (&acc)[2][2][4][2], const pg8::Unit& u, int wr, int wc, int fr, int fq) const {
        const int pnl = u.pn & 7;
#pragma unroll
        for (int ai = 0; ai < 2; ++ai)
#pragma unroll
            for (int m = 0; m < 4; ++m) {
                const unsigned row = (unsigned)u.pm * 256u + ai * 128 + wr * 64 + m * 16 + fr;
                f32x4 h0, h1;
#pragma unroll
                for (int e = 0; e < 4; ++e) {
                    const float g0 = acc[ai][0][m][0][e], g1 = acc[ai][0][m][1][e];
                    h0[e] = g0 * sigmoidf_(g0) * acc[ai][1][m][0][e];
                    h1[e] = g1 * sigmoidf_(g1) * acc[ai][1][m][1][e];
                }
                *(u32x4*)(HID + row * 1024 + pnl * 128 + wc * 32 + 8 * fq) = pack8(h0, h1);
            }
    }
};
struct EpiMoe2 {
    static constexpr bool PERM = true, AFTER_DRAIN = false;
    bf16* OUTE; const float* selg;
    __device__ __forceinline__ void operator()(const f32x4 (&acc)[2][2][4][2], const pg8::Unit& u, int wr, int wc, int fr, int fq) const {
        const int pnl = u.pn & 3;
#pragma unroll
        for (int ai = 0; ai < 2; ++ai)
#pragma unroll
            for (int m = 0; m < 4; ++m) {
                const unsigned row = (unsigned)u.pm * 256u + ai * 128 + wr * 64 + m * 16 + fr;
                const float gt = selg[row];
#pragma unroll
                for (int bj = 0; bj < 2; ++bj)
                    *(u32x4*)(OUTE + row * 1024 + pnl * 256 + bj * 128 + wc * 32 + 8 * fq) = pack8(acc[ai][bj][m][0] * gt, acc[ai][bj][m][1] * gt);
            }
    }
};

struct TileSched {
    int nM, nN, G, c; bool latent_only;
    __device__ __forceinline__ bool next(int i, pg8::Unit& u) const {
        const long L = (long)i * G + c; if (L >= (long)nM * nN) return false;
        const int pmi = (int)(L / nN); u.pn = (int)(L % nN); u.pm = latent_only ? (pmi >> 3) * 9 + 1 + (pmi & 7) : pmi; return true;
    }
    __device__ __forceinline__ void a_ready(const pg8::Unit&) const {}
    __device__ __forceinline__ void done(const pg8::Unit&) const {}
};
struct MoeSched {
    int nMe, nNe, G, c;
    __device__ __forceinline__ bool next(int i, pg8::Unit& u) const {
        const long L = (long)i * G + c; if (L >= (long)NE * nMe * nNe) return false;
        const int pnl = (int)(L % nNe), t = (int)(L / nNe), pml = t % nMe, e = t / nMe;
        u.pm = e * 9 + pml; u.pn = e * nNe + pnl; return true;
    }
    __device__ __forceinline__ void a_ready(const pg8::Unit&) const {}
    __device__ __forceinline__ void done(const pg8::Unit&) const {}
};

template <class Epi, class Sched>
__device__ __forceinline__ void gemm_ref(const pg8::Gemm g, const Sched& S, const Epi& E) {
    const int tid = threadIdx.x, wid = tid >> 6, lane = tid & 63, wr = wid >> 2, wc = wid & 3, fr = lane & 15, fq = lane >> 4;
    int K = g.K; asm volatile("" : "+s"(K));
    pg8::Unit u;
    for (int ui = 0; S.next(ui, u); ++ui) {
        f32x4 acc[2][2][4][2];
#pragma unroll
        for (int a = 0; a < 2; ++a)
#pragma unroll
            for (int b = 0; b < 2; ++b)
#pragma unroll
                for (int m = 0; m < 4; ++m)
#pragma unroll
                    for (int n = 0; n < 2; ++n) acc[a][b][m][n] = (f32x4){0.f, 0.f, 0.f, 0.f};
        const bf16* Ab = g.A + ((size_t)u.pm * 256 + wr * 64 + fr) * K;
        const bf16* Bb = g.Bt + ((size_t)u.pn * 256 + wc * 32 + 8 * fq) * K;
#pragma unroll
        for (int ai = 0; ai < 2; ++ai)
#pragma unroll
            for (int bj = 0; bj < 2; ++bj)
#pragma unroll
                for (int m = 0; m < 4; ++m)
#pragma unroll
                    for (int n = 0; n < 2; ++n)
#pragma unroll
                        for (int e = 0; e < 4; ++e) {
                            const bf16* ar = Ab + (size_t)(ai * 128 + m * 16) * K; const bf16* br = Bb + (size_t)(bj * 128 + 4 * n + e) * K;
                            float s0 = 0.f, s1 = 0.f;
#pragma unroll 2
                            for (int k0 = 0; k0 < K; k0 += 8) {
                                const u32x4 wa = *(const u32x4*)(ar + k0), wb = *(const u32x4*)(br + k0);
                                s0 += bflo(wa.x) * bflo(wb.x) + bflo(wa.y) * bflo(wb.y) + bflo(wa.z) * bflo(wb.z) + bflo(wa.w) * bflo(wb.w);
                                s1 += bfhi(wa.x) * bfhi(wb.x) + bfhi(wa.y) * bfhi(wb.y) + bfhi(wa.z) * bfhi(wb.z) + bfhi(wa.w) * bfhi(wb.w);
                            }
                            acc[ai][bj][m][n][e] = s0 + s1;
                            asm volatile("" ::: "memory");
                        }
        E(acc, u, wr, wc, fr, fq);
    }
}
template <class Epi, class Sched>
__device__ __forceinline__ void run_gemm(LAS unsigned char* lds, const pg8::Gemm g, const Sched& S, const Epi& E) {
#if GOLD_GEMM
    gemm_ref<Epi, Sched>(g, S, E);
    __syncthreads();
#else
    pg8::Gemm g2 = g; { int kd = g.K; asm volatile("" : "+s"(kd)); g2.K = kd; }
    pg8::gemm_phase<Epi, Sched, true, true>(lds, g2, S, E);
#endif
}

struct Args { const float* in[29]; float* out; unsigned char* ws; int ph_lo, ph_hi; };
enum { I_X = 0, I_C, I_CTX, I_CCTX, I_WMOD, I_BMOD, I_GPREMIX, I_GPOSTMIX, I_GPREFFN, I_GPOSTFFN, I_WIN, I_WOUT, I_QGAIN, I_KGAIN, I_RPB,
       I_W0, I_WUP, I_A0, I_AUP, I_GUP, I_KK, I_KA, I_RK, I_LNXW, I_LNXB, I_WROUTER, I_WEGATE, I_WEUP, I_WEDOWN };

struct Frame {
    LAS unsigned char* lds; volatile LAS unsigned* MISC; unsigned* ctl;
    int wave, vcu, G;
    const float* const* in; float* out; unsigned char* ws;
};
#define TID_ ((int)threadIdx.x)
#define LANE_ ((int)(threadIdx.x & 63u))
#define WSP(T_, off) ((T_*)(F.ws + (off)))

__device__ __forceinline__ void cvt_item(const float* src, int ld_src, bf16* dst, int ld_dst, LAS float* scr, int lane) {
#pragma unroll 8
    for (int i = 0; i < 32; ++i) { const int kk = 2 * i + (lane >> 5); scr[kk * 33 + (lane & 31)] = src[(size_t)kk * ld_src + (lane & 31)]; }
    LDS_WAIT(); asm volatile("" ::: "memory");
    const int c = lane & 7;
#pragma unroll
    for (int j = 0; j < 4; ++j) { const int n = (lane >> 3) + 8 * j; const LAS float* s = scr + (8 * c) * 33 + n;
        u32x4 o; o.x = pk2(s[0 * 33], s[1 * 33]); o.y = pk2(s[2 * 33], s[3 * 33]); o.z = pk2(s[4 * 33], s[5 * 33]); o.w = pk2(s[6 * 33], s[7 * 33]);
        *(u32x4*)(dst + (size_t)n * ld_dst + 8 * c) = o; }
    LDS_WAIT(); asm volatile("" ::: "memory");
}
__device__ __forceinline__ void cvt_moe(Frame& F, int l) {
    LAS float* scr = (LAS float*)(F.lds + F.wave * 16384);
    const int gw = F.vcu * NWAVES + F.wave, NGW = F.G * NWAVES;
    bf16* WGU = WSP(bf16, WS_WGU); bf16* WD = WSP(bf16, WS_WD);
    for (int it = gw; it < 3 * 8192; it += NGW) {
        const int which = it >> 13, r = it & 8191, e = r >> 9, q = r & 511, kb = q >> 5, nb = q & 31, n0 = nb * 32;
        const float* W = F.in[which == 0 ? I_WEGATE : (which == 1 ? I_WEUP : I_WEDOWN)] + ((size_t)(l * NE + e) * 1024 + kb * 64) * 1024 + n0;
        bf16* dst;
        if (which < 2) dst = WGU + ((size_t)e * 2048 + (n0 >> 7) * 256 + which * 128 + (n0 & 127)) * 1024 + kb * 64;
        else dst = WD + ((size_t)e * 1024 + n0) * 1024 + kb * 64;
        cvt_item(W, 1024, dst, 1024, scr, LANE_);
    }
}

__device__ __forceinline__ void phase_init(Frame& F) {
    const int tid = TID_;
    {
        LAS float* sil = (LAS float*)F.lds;
        LAS float* red = (LAS float*)(F.lds + 40960);
        float* MOD = WSP(float, WS_MOD);
        bool have = false;
        for (int it = F.vcu; it < 2 * 96; it += F.G) {
            if (!have) {
                for (int i = tid; i < 9 * 1024; i += NTHREADS) { const int r = i >> 10, k = i & 1023; const float cv = (r < 8) ? F.in[I_C][r * 1024 + k] : F.in[I_CCTX][k]; sil[i] = cv / (1.f + expf(-cv)); }
                __syncthreads(); have = true;
            }
            const int l = it / 96, n0 = (it % 96) * 64, ks = tid >> 6, col = tid & 63;
            float acc[9];
#pragma unroll
            for (int r = 0; r < 9; ++r) acc[r] = 0.f;
            const float* w = F.in[I_WMOD] + ((size_t)l * 1024 + ks * 128) * 6144 + n0 + col;
            for (int k = 0; k < 128; ++k) { const float wv = w[(size_t)k * 6144];
#pragma unroll
                for (int r = 0; r < 9; ++r) acc[r] += sil[r * 1024 + ks * 128 + k] * wv; }
#pragma unroll
            for (int r = 0; r < 9; ++r) red[(ks * 9 + r) * 64 + col] = acc[r];
            __syncthreads();
            for (int o = tid; o < 576; o += NTHREADS) { const int r = o >> 6, cc = o & 63; float s = 0.f;
#pragma unroll
                for (int k2 = 0; k2 < 8; ++k2) s += red[(k2 * 9 + r) * 64 + cc];
                MOD[(size_t)(l * 9 + r) * 6144 + n0 + cc] = s + F.in[I_BMOD][l * 6144 + n0 + cc]; }
            __syncthreads();
        }
        __syncthreads();
    }
    {
        LAS float* scr = (LAS float*)(F.lds + F.wave * 16384);
        const int gw = F.vcu * NWAVES + F.wave, NGW = F.G * NWAVES;
        bf16* WIN = WSP(bf16, WS_WIN); bf16* WOUT = WSP(bf16, WS_WOUT);
        for (int it = gw; it < 2 * (1344 + 512); it += NGW) {
            const int l = it / 1856, r = it % 1856;
            if (r < 1344) { const int kb = r / 84, n0 = (r % 84) * 32; const int dn = n0 < 768 ? n0 : (n0 < 1920 ? n0 + 768 : n0 - 1152);
                cvt_item(F.in[I_WIN] + ((size_t)l * 1024 + kb * 64) * 2688 + n0, 2688, WIN + ((size_t)l * NINP + dn) * 1024 + kb * 64, 1024, scr, LANE_); }
            else { const int q = r - 1344, kb = q >> 5, n0 = (q & 31) * 32;
                cvt_item(F.in[I_WOUT] + ((size_t)l * 1024 + kb * 64) * 1024 + n0, 1024, WOUT + ((size_t)l * 1024 + n0) * 1024 + kb * 64, 1024, scr, LANE_); }
        }
        cvt_moe(F, 0);
    }
    {
        const size_t gt = (size_t)F.vcu * NTHREADS + tid, NT = (size_t)F.G * NTHREADS;
        f32x4* X = WSP(f32x4, WS_X);
        for (size_t i = gt; i < (size_t)M * 256; i += NT) { const int m = (int)(i >> 8), q = (int)(i & 255), b = m / T, t = m % T;
            const f32x4* src = t < CTXL ? (const f32x4*)(F.in[I_CTX] + ((size_t)b * CTXL + t) * 1024) : (const f32x4*)(F.in[I_X] + ((size_t)b * SEQ + (t - CTXL)) * 1024);
            X[i] = src[q]; }
        u32x4* WIN4 = WSP(u32x4, WS_WIN);
        for (size_t i = gt; i < (size_t)2 * 128 * 128; i += NT) { const int l = (int)(i >> 14), r = (int)(i & 16383); WIN4[((size_t)l * NINP + 2688) * 128 + r] = (u32x4){0u, 0u, 0u, 0u}; }
        bf16* LORA = WSP(bf16, WS_LORA);
        for (size_t i = gt; i < (size_t)2 * 1280 * 384; i += NT) { const int l = (int)(i / (1280 * 384)), r = (int)(i % (1280 * 384)), n = r / 384, k = r % 384, tile = n >> 8, nn = n & 255;
            float v = 0.f;
            if (tile < 2) { const int d = tile, kk = k - 64 * d; if (kk >= 0 && kk < 64) v = F.in[I_WUP][(((size_t)l * 2 + d) * 64 + kk) * 256 + nn]; }
            else if (tile < 4) { const int d = tile - 2, kk = k - 128 - 64 * d; if (kk >= 0 && kk < 64) v = F.in[I_AUP][(((size_t)l * 2 + d) * 64 + kk) * 256 + nn]; }
            else { const int kk = k - 256; if (kk >= 0) v = F.in[I_GUP][((size_t)l * 128 + kk) * 256 + nn]; }
            LORA[i] = (bf16)f2bf(v); }
    }
}

__device__ __forceinline__ float row_ss(const f32x4 (&v)[4]) {
    float s = 0.f;
#pragma unroll
    for (int j = 0; j < 4; ++j) s += (v[j][0] * v[j][0] + v[j][1] * v[j][1]) + (v[j][2] * v[j][2] + v[j][3] * v[j][3]);
    return wave_sum(s);
}
__device__ __forceinline__ void mod_store(const f32x4 (&x)[4], float rinv, const float* g, const float* shift, const float* scale, bf16* dst, int lane, f32x4 (&h)[4]) {
#pragma unroll
    for (int j = 0; j < 4; ++j) { const int e = 256 * j + 4 * lane;
        const f32x4 gg = *(const f32x4*)(g + e), sh = *(const f32x4*)(shift + e), sc = *(const f32x4*)(scale + e);
        h[j] = x[j] * rinv * gg * (sc + 1.f) + sh;
        u32x2 w; w.x = pk2(h[j][0], h[j][1]); w.y = pk2(h[j][2], h[j][3]); *(u32x2*)(dst + e) = w; }
}
__device__ __forceinline__ void phase_row0(Frame& F) {
    const int gw = F.vcu * NWAVES + F.wave, NGW = F.G * NWAVES, lane = LANE_;
    const float* X = WSP(float, WS_X); bf16* H = WSP(bf16, WS_H); const float* MOD = WSP(float, WS_MOD);
    for (int m = gw; m < M; m += NGW) { const int b = m / T, t = m % T, r = t < CTXL ? 8 : b;
        f32x4 x[4], h[4];
#pragma unroll
        for (int j = 0; j < 4; ++j) x[j] = *(const f32x4*)(X + (size_t)m * 1024 + 256 * j + 4 * lane);
        const float rinv = rsqrtf(row_ss(x) * (1.f / 1024.f) + 1e-6f);
        const float* md = MOD + (size_t)(0 * 9 + r) * 6144;
        mod_store(x, rinv, F.in[I_GPREMIX], md, md + 1024, H + (size_t)m * 1024, lane, h);
    }
}
__device__ __forceinline__ void phase_row1(Frame& F, int l) {
    const int gw = F.vcu * NWAVES + F.wave, NGW = F.G * NWAVES, lane = LANE_;
    float* X = WSP(float, WS_X); const float* Y = WSP(float, WS_Y); bf16* H2 = WSP(bf16, WS_H2); const float* MOD = WSP(float, WS_MOD);
    float* AFF = WSP(float, WS_AFF); int* INV = WSP(int, WS_INV);
    {
        const f32x4* src = (const f32x4*)(F.in[I_WROUTER] + (size_t)l * 1024 * 16); LAS f32x4* dstl = (LAS f32x4*)F.lds;
        for (int i = TID_; i < 4096; i += NTHREADS) dstl[i] = src[i];
        __syncthreads();
    }
    const LAS float* wbase = (const LAS float*)F.lds + lane * 64;
    for (int m = gw; m < M; m += NGW) { const int b = m / T, t = m % T, r = t < CTXL ? 8 : b;
        if (l == NL - 1 && t < CTXL) continue;
        const float* md = MOD + (size_t)(l * 9 + r) * 6144;
        f32x4 x[4], y[4], h[4];
#pragma unroll
        for (int j = 0; j < 4; ++j) { y[j] = *(const f32x4*)(Y + (size_t)m * 1024 + 256 * j + 4 * lane); x[j] = *(const f32x4*)(X + (size_t)m * 1024 + 256 * j + 4 * lane); }
        const float rinv = rsqrtf(row_ss(y) * (1.f / 1024.f) + 1e-6f);
#pragma unroll
        for (int j = 0; j < 4; ++j) { const int e = 256 * j + 4 * lane;
            const f32x4 gg = *(const f32x4*)(F.in[I_GPOSTMIX] + l * 1024 + e), gt = *(const f32x4*)(md + 2 * 1024 + e);
            x[j] = x[j] + gt * (y[j] * rinv * gg); *(f32x4*)(X + (size_t)m * 1024 + e) = x[j]; }
        const float rinv2 = rsqrtf(row_ss(x) * (1.f / 1024.f) + 1e-6f);
        mod_store(x, rinv2, F.in[I_GPREFFN] + l * 1024, md + 3 * 1024, md + 4 * 1024, H2 + (size_t)m * 1024, lane, h);
        float lg[16];
#pragma unroll
        for (int k = 0; k < 16; ++k) lg[k] = 0.f;
#pragma unroll
        for (int j = 0; j < 4; ++j)
#pragma unroll
            for (int c = 0; c < 4; ++c) { const LAS float* w = wbase + j * 4096 + c * 16; const float hv = h[j][c];
#pragma unroll
                for (int q = 0; q < 4; ++q) { const f32x4 wv = *(const LAS f32x4*)(w + 4 * q); lg[4 * q + 0] += hv * wv[0]; lg[4 * q + 1] += hv * wv[1]; lg[4 * q + 2] += hv * wv[2]; lg[4 * q + 3] += hv * wv[3]; }
                asm volatile("" ::: "memory"); }
        float mx = -1e30f;
#pragma unroll
        for (int k = 0; k < 16; ++k) { lg[k] = wave_sum(lg[k]); mx = fmaxf(mx, lg[k]); }
        float den = 0.f, mine = 0.f;
#pragma unroll
        for (int k = 0; k < 16; ++k) { const float ex = expf(lg[k] - mx); den += ex; if ((lane & 15) == k) mine = ex; }
        if (lane < 16) { AFF[(size_t)m * 16 + lane] = mine / den; INV[(size_t)m * 16 + lane] = -1; }
    }
}
__device__ __forceinline__ void phase_row2(Frame& F, int l) {
    const int gw = F.vcu * NWAVES + F.wave, NGW = F.G * NWAVES, lane = LANE_;
    float* X = WSP(float, WS_X); const bf16* OUTE = WSP(bf16, WS_OUTE); bf16* H = WSP(bf16, WS_H); const float* MOD = WSP(float, WS_MOD);
    const int* INV = WSP(int, WS_INV);
    const bool last = (l == NL - 1);
    for (int m = gw; m < M; m += NGW) { const int b = m / T, t = m % T, r = t < CTXL ? 8 : b;
        if (last && t < CTXL) continue;
        const float* md = MOD + (size_t)(l * 9 + r) * 6144;
        f32x4 x[4], f[4], h[4];
#pragma unroll
        for (int j = 0; j < 4; ++j) { x[j] = *(const f32x4*)(X + (size_t)m * 1024 + 256 * j + 4 * lane); f[j] = (f32x4){0.f, 0.f, 0.f, 0.f}; }
        const int invl = INV[(size_t)m * 16 + (lane & 15)];
        for (int e = 0; e < 16; ++e) { const int rr = __shfl(invl, e);
            if (rr >= 0) {
#pragma unroll
                for (int j = 0; j < 4; ++j) { const u32x2 w = *(const u32x2*)(OUTE + (size_t)rr * 1024 + 256 * j + 4 * lane);
                    f[j][0] += bflo(w.x); f[j][1] += bfhi(w.x); f[j][2] += bflo(w.y); f[j][3] += bfhi(w.y); } } }
        const float rinv = rsqrtf(row_ss(f) * (1.f / 1024.f) + 1e-6f);
#pragma unroll
        for (int j = 0; j < 4; ++j) { const int e = 256 * j + 4 * lane;
            const f32x4 gg = *(const f32x4*)(F.in[I_GPOSTFFN] + l * 1024 + e), gt = *(const f32x4*)(md + 5 * 1024 + e);
            x[j] = x[j] + gt * (f[j] * rinv * gg);
            if (last) *(f32x4*)(F.out + ((size_t)b * SEQ + (t - CTXL)) * 1024 + e) = x[j];
            else *(f32x4*)(X + (size_t)m * 1024 + e) = x[j]; }
        if (!last) {
            const float rinv2 = rsqrtf(row_ss(x) * (1.f / 1024.f) + 1e-6f);
            const float* md2 = MOD + (size_t)((l + 1) * 9 + r) * 6144;
            mod_store(x, rinv2, F.in[I_GPREMIX] + (l + 1) * 1024, md2, md2 + 1024, H + (size_t)m * 1024, lane, h);
        }
    }
}

__device__ __forceinline__ void phase_qkprep(Frame& F, int l) {
    const int gw = F.vcu * NWAVES + F.wave, NGW = F.G * NWAVES, lane = LANE_;
    bf16* QKV = WSP(bf16, WS_QKV);
    const float qg = F.in[I_QGAIN][l * 64 + lane], kg = F.in[I_KGAIN][l * 64 + lane];
    const int i16 = lane & 15; const bool second = (lane & 16) != 0, colseg = (lane & 32) != 0;
    const float inv = exp2f(-(float)i16 * (13.287712379549449f / 16.f));
    for (int it = gw; it < M * 10; it += NGW) { const int m = it / 10, s = it % 10, t = m % T;
        if (l == NL - 1 && t < CTXL && s < 8) continue;
        bf16* p = QKV + (size_t)m * 1536 + (s < 8 ? s * 64 : 512 + (s - 8) * 64) + lane;
        const float x = bf2f(*p);
        const float ss = wave_sum(x * x);
        float y = x * rsqrtf(ss * (1.f / 64.f) + 1e-6f) * (s < 8 ? qg : kg);
        if (t >= CTXL) { const int pos = t - CTXL; const float ang = (float)(colseg ? (pos & 63) : (pos >> 6)) * inv;
            const float cs = cosf(ang), sn = sinf(ang); const float other = __shfl_xor(y, 16);
            y = second ? (y * cs + other * sn) : (y * cs - other * sn); }
        if (s < 8) y *= C2;
        *p = (bf16)f2bf(y);
    }
}

__device__ __forceinline__ float red8(float x) { x += __shfl_xor(x, 1); x += __shfl_xor(x, 2); x += __shfl_xor(x, 4); return x; }
constexpr int SC_TC = 16, SC_STEP = 6 * 64, SC_BUF = SC_TC * SC_STEP;
__device__ __forceinline__ int scan_tok(int p, int dir) { return p < CTXL ? (dir ? CTXL - 1 - p : p) : (dir ? (T + CTXL - 1) - p : p); }
__device__ __forceinline__ void scan_chain(Frame& F, int chain, int l) {
    const int b = chain >> 3, h = (chain >> 1) & 3, dir = chain & 1;
    const int tid = TID_, lane = LANE_, wave = F.wave, i = tid >> 3, jc = tid & 7;
    LAS float* buf = (LAS float*)F.lds;
    const float* R32 = WSP(float, WS_R32); const float* DEC = WSP(float, WS_DEC) + (size_t)dir * M * 256; const float* ASIG = WSP(float, WS_ASIG) + (size_t)dir * M * 256;
    float* YD = WSP(float, WS_YD) + (size_t)dir * M * 256;
    const float kkw = F.in[I_KK][l * 256 + h * 64 + lane], kaw = F.in[I_KA][l * 256 + h * 64 + lane];
    float S[8];
#pragma unroll
    for (int j = 0; j < 8; ++j) S[j] = 0.f;
    float pr[2][5];
    constexpr int NCH = T / SC_TC;
#define SC_LOAD(c) do { _Pragma("unroll") for (int s2 = 0; s2 < 2; ++s2) { const int p = (c) * SC_TC + 2 * wave + s2; const size_t m = (size_t)b * T + scan_tok(p, dir); \
        pr[s2][0] = R32[m * 768 + h * 64 + lane]; pr[s2][1] = R32[m * 768 + 256 + h * 64 + lane]; pr[s2][2] = R32[m * 768 + 512 + h * 64 + lane]; \
        pr[s2][3] = DEC[m * 256 + h * 64 + lane]; pr[s2][4] = ASIG[m * 256 + h * 64 + lane]; } } while (0)
#define SC_PREP(bi) do { _Pragma("unroll") for (int s2 = 0; s2 < 2; ++s2) { const float r_ = pr[s2][0], kb_ = pr[s2][1], v_ = pr[s2][2], de_ = pr[s2][3], as_ = pr[s2][4]; \
        float kk_ = kb_ * kkw; const float nn_ = sqrtf(wave_sum(kk_ * kk_)); kk_ = kk_ / fmaxf(nn_, 1e-12f); const float kd_ = kb_ * (1.f + (as_ - 1.f) * kaw); \
        LAS float* o_ = buf + (bi) * SC_BUF + (2 * wave + s2) * SC_STEP + lane; o_[0] = r_; o_[64] = de_; o_[128] = kd_; o_[192] = v_; o_[256] = -kk_; o_[320] = kk_ * as_; } } while (0)
    SC_LOAD(0); SC_PREP(0); SC_LOAD(1);
    for (int c = 0; c < NCH; ++c) {
        __syncthreads();
        if (c + 1 < NCH) SC_PREP((c + 1) & 1);
        if (c + 2 < NCH) SC_LOAD(c + 2);
        const LAS float* bc = buf + (c & 1) * SC_BUF;
#pragma unroll
        for (int s = 0; s < SC_TC; ++s) {
            const LAS float* vec = bc + s * SC_STEP;
            const f32x4 r0 = *(const LAS f32x4*)(vec + 8 * jc), r1 = *(const LAS f32x4*)(vec + 8 * jc + 4);
            const f32x4 w0 = *(const LAS f32x4*)(vec + 64 + 8 * jc), w1 = *(const LAS f32x4*)(vec + 64 + 8 * jc + 4);
            const f32x4 k0 = *(const LAS f32x4*)(vec + 128 + 8 * jc), k1 = *(const LAS f32x4*)(vec + 128 + 8 * jc + 4);
            const float vi = vec[192 + i];
            const f32x4 a0 = *(const LAS f32x4*)(vec + 256 + 8 * jc), a1 = *(const LAS f32x4*)(vec + 256 + 8 * jc + 4);
            const f32x4 b0 = *(const LAS f32x4*)(vec + 320 + 8 * jc), b1 = *(const LAS f32x4*)(vec + 320 + 8 * jc + 4);
            float sa = 0.f;
#pragma unroll
            for (int j = 0; j < 4; ++j) sa += S[j] * a0[j] + S[4 + j] * a1[j];
            sa = red8(sa);
            float y = 0.f;
#pragma unroll
            for (int j = 0; j < 4; ++j) {
                S[j] = S[j] * w0[j] + sa * b0[j] + vi * k0[j];
                S[4 + j] = S[4 + j] * w1[j] + sa * b1[j] + vi * k1[j];
                y += S[j] * r0[j] + S[4 + j] * r1[j];
            }
            y = red8(y);
            if (jc == 0) YD[((size_t)b * T + scan_tok(c * SC_TC + s, dir)) * 256 + h * 64 + i] = y;
        }
    }
#undef SC_LOAD
#undef SC_PREP
    __syncthreads();
}

__device__ __forceinline__ void attn_ref_unit(Frame& F, int mode, int qrow0, int qcol, int krow0, int nkeys, int kcol, int vcol, int ocol,
                                              int rb, const float* rpbh) {
    const int tid = TID_, q = tid & 255, dh = tid >> 8;
    const bf16* QKV = WSP(bf16, WS_QKV); bf16* O = WSP(bf16, WS_O);
    const int gr = 4 * rb + (q >> 6), gc = q & 63;
    const size_t qrow = (size_t)qrow0 + q;
    float qv[64], o[32];
#pragma unroll
    for (int d8 = 0; d8 < 8; ++d8) { const u32x4 w = *(const u32x4*)(QKV + qrow * 1536 + qcol + 8 * d8);
        qv[8 * d8 + 0] = bflo(w.x); qv[8 * d8 + 1] = bfhi(w.x); qv[8 * d8 + 2] = bflo(w.y); qv[8 * d8 + 3] = bfhi(w.y);
        qv[8 * d8 + 4] = bflo(w.z); qv[8 * d8 + 5] = bfhi(w.z); qv[8 * d8 + 6] = bflo(w.w); qv[8 * d8 + 7] = bfhi(w.w); }
#pragma unroll
    for (int d = 0; d < 32; ++d) o[d] = 0.f;
    float mrun = -1e30f, lrun = 0.f;
    const int kend = mode == 0 ? nkeys : 128 + CTXL;
    const int rs = min(max(gr - 4, 0), 32 - 8), cs = min(max(gc - 8, 0), 64 - 16);
    for (int kk = 0; kk < kend; ++kk) {
        size_t krow; float bias = 0.f;
        if (mode == 0) krow = (size_t)krow0 + kk;
        else if (kk < 128) { const int kr = rs + (kk >> 4), kc = cs + (kk & 15); krow = (size_t)krow0 + CTXL + kr * 64 + kc; bias = rpbh[(kr - gr + 7) * 31 + (kc - gc + 15)] * LOG2E; }
        else krow = (size_t)krow0 + (kk - 128);
        float s = bias;
#pragma unroll
        for (int d8 = 0; d8 < 8; ++d8) { const u32x4 w = *(const u32x4*)(QKV + krow * 1536 + kcol + 8 * d8);
            s += qv[8 * d8 + 0] * bflo(w.x) + qv[8 * d8 + 1] * bfhi(w.x) + qv[8 * d8 + 2] * bflo(w.y) + qv[8 * d8 + 3] * bfhi(w.y)
               + qv[8 * d8 + 4] * bflo(w.z) + qv[8 * d8 + 5] * bfhi(w.z) + qv[8 * d8 + 6] * bflo(w.w) + qv[8 * d8 + 7] * bfhi(w.w); }
        const float mn = fmaxf(mrun, s), al = exp2f(mrun - mn), p = exp2f(s - mn);
        lrun = lrun * al + p; mrun = mn;
#pragma unroll
        for (int d8 = 0; d8 < 4; ++d8) { const u32x4 w = *(const u32x4*)(QKV + krow * 1536 + vcol + 32 * dh + 8 * d8);
            o[8 * d8 + 0] = o[8 * d8 + 0] * al + p * bflo(w.x); o[8 * d8 + 1] = o[8 * d8 + 1] * al + p * bfhi(w.x);
            o[8 * d8 + 2] = o[8 * d8 + 2] * al + p * bflo(w.y); o[8 * d8 + 3] = o[8 * d8 + 3] * al + p * bfhi(w.y);
            o[8 * d8 + 4] = o[8 * d8 + 4] * al + p * bflo(w.z); o[8 * d8 + 5] = o[8 * d8 + 5] * al + p * bfhi(w.z);
            o[8 * d8 + 6] = o[8 * d8 + 6] * al + p * bflo(w.w); o[8 * d8 + 7] = o[8 * d8 + 7] * al + p * bfhi(w.w); }
    }
    const float li = 1.f / lrun;
#pragma unroll
    for (int d8 = 0; d8 < 4; ++d8) { u32x4 w;
        w.x = pk2(o[8 * d8 + 0] * li, o[8 * d8 + 1] * li); w.y = pk2(o[8 * d8 + 2] * li, o[8 * d8 + 3] * li);
        w.z = pk2(o[8 * d8 + 4] * li, o[8 * d8 + 5] * li); w.w = pk2(o[8 * d8 + 6] * li, o[8 * d8 + 7] * li);
        *(u32x4*)(O + qrow * 1024 + ocol + 32 * dh + 8 * d8) = w; }
}
__device__ __forceinline__ void attn_item(Frame& F, int item, int l) {
    const float* rpb = F.in[I_RPB] + (size_t)l * 4 * 15 * 31;
    int mode = 0, qrow0, qcol, krow0, nkeys, kcol, vcol, ocol, rb = 0;
    if (item < 512) { const int b = item >> 6, h = (item >> 3) & 7, qb = item & 7;
        qrow0 = b * T + CTXL + qb * 256; qcol = h * 64; krow0 = b * T; nkeys = T; kcol = 512 + (h >> 2) * 64; vcol = 640 + (h >> 2) * 64; ocol = h * 64; }
    else if (item < 768) { const int it = item - 512, b = it >> 5, h = (it >> 3) & 3; rb = it & 7; mode = 1;
        qrow0 = b * T + CTXL + rb * 256; qcol = 768 + h * 64; krow0 = b * T; nkeys = 0; kcol = 1024 + h * 64; vcol = 1280 + h * 64; ocol = 768 + h * 64; rpb += h * 15 * 31; }
    else if (item < 832) { const int it = item - 768, b = it >> 3, h = it & 7;
        qrow0 = b * T; qcol = h * 64; krow0 = b * T; nkeys = CTXL; kcol = 512 + (h >> 2) * 64; vcol = 640 + (h >> 2) * 64; ocol = h * 64; }
    else { const int it = item - 832, b = it >> 2, h = it & 3;
        qrow0 = b * T; qcol = 768 + h * 64; krow0 = b * T; nkeys = CTXL; kcol = 1024 + h * 64; vcol = 1280 + h * 64; ocol = 768 + h * 64; }
    attn_ref_unit(F, mode, qrow0, qcol, krow0, nkeys, kcol, vcol, ocol, rb, rpb);
}
__device__ __forceinline__ void phase_mixer(Frame& F, int l) {
    if (F.vcu < 64) scan_chain(F, F.vcu, l);
    const int nitems = (l == NL - 1) ? 768 : 864;
    for (;;) {
        if (TID_ == 0) F.MISC[16] = atomicAdd(F.ctl + CW_QUEUE + 64 * l, 1u);
        __syncthreads();
        const int item = (int)F.MISC[16];
        __syncthreads();
        if (item >= nitems) break;
        attn_item(F, item, l);
    }
}

__device__ __forceinline__ void phase_post(Frame& F, int l) {
    const int gw = F.vcu * NWAVES + F.wave, NGW = F.G * NWAVES, lane = LANE_;
    const float* R32 = WSP(float, WS_R32); const float* ASIG = WSP(float, WS_ASIG); const float* YD = WSP(float, WS_YD); const float* Gb = WSP(float, WS_G);
    bf16* O = WSP(bf16, WS_O);
    for (int it = gw; it < M * 4; it += NGW) { const int m = it >> 2, h = it & 3, t = m % T, ch = h * 64 + lane;
        if (l == NL - 1 && t < CTXL) continue;
        const float y = YD[(size_t)m * 256 + ch] + YD[((size_t)M + m) * 256 + ch];
        const float mu = wave_sum(y) * (1.f / 64.f); const float dv = y - mu; const float var = wave_sum(dv * dv) * (1.f / 64.f);
        float yn = dv * rsqrtf(var + 64e-5f) * F.in[I_LNXW][l * 256 + ch] + F.in[I_LNXB][l * 256 + ch];
        const float r = R32[(size_t)m * 768 + ch], kb = R32[(size_t)m * 768 + 256 + ch], v = R32[(size_t)m * 768 + 512 + ch];
        const float ka = F.in[I_KA][l * 256 + ch], rk = F.in[I_RK][l * 256 + ch];
        const float as0 = ASIG[(size_t)m * 256 + ch], as1 = ASIG[((size_t)M + m) * 256 + ch];
        const float kd0 = kb * (1.f + (as0 - 1.f) * ka), kd1 = kb * (1.f + (as1 - 1.f) * ka);
        const float bon = (wave_sum(r * kd0 * rk) + wave_sum(r * kd1 * rk)) * v;
        O[(size_t)m * 1024 + 512 + ch] = (bf16)f2bf((yn + bon) * Gb[(size_t)m * 256 + ch]);
    }
}

__device__ __forceinline__ void phase_topk(Frame& F, int l) {
    const int tid = TID_;
    LAS unsigned long long* keys = (LAS unsigned long long*)F.lds;
    const float* AFF = WSP(float, WS_AFF); int* INV = WSP(int, WS_INV); float* SELG = WSP(float, WS_SELG); int* SELT = WSP(int, WS_SELT);
    const bf16* H2 = WSP(bf16, WS_H2); bf16* XE = WSP(bf16, WS_XE);
    const int nitems = (l == NL - 1) ? 128 : 256;
    for (int it = F.vcu; it < nitems; it += F.G) {
        const int seg = it >> 7, be = it & 127, b = be >> 4, e = be & 15;
        const int n = seg ? CTXL : SEQ, cap = n / 8, mbase = b * T + (seg ? 0 : CTXL);
        const int rowbase = e * MEXP + (seg ? 2048 + b * 32 : b * 256);
        for (int i = tid; i < n; i += NTHREADS) keys[i] = ((unsigned long long)__float_as_uint(AFF[(size_t)(mbase + i) * 16 + e]) << 32) | (unsigned)(0xFFFFFFFFu - (unsigned)i);
        __syncthreads();
        for (int k = 2; k <= n; k <<= 1)
            for (int j = k >> 1; j > 0; j >>= 1) {
                for (int t = tid; t < (n >> 1); t += NTHREADS) { const int i = 2 * t - (t & (j - 1)), p = i + j; const bool desc = ((i & k) == 0);
                    const unsigned long long a = keys[i], bb = keys[p];
                    if ((a < bb) == desc) { keys[i] = bb; keys[p] = a; } }
                __syncthreads();
            }
        for (int s = tid; s < cap; s += NTHREADS) { const unsigned long long kv = keys[s]; const int idx = (int)(0xFFFFFFFFu - (unsigned)kv); const int m = mbase + idx;
            SELG[rowbase + s] = __uint_as_float((unsigned)(kv >> 32)); SELT[rowbase + s] = m; INV[(size_t)m * 16 + e] = rowbase + s; }
        for (int s = F.wave; s < cap; s += NWAVES) { const unsigned long long kv = keys[s]; const int m = mbase + (int)(0xFFFFFFFFu - (unsigned)kv);
            const u32x4* src = (const u32x4*)(H2 + (size_t)m * 1024); u32x4* dst = (u32x4*)(XE + (size_t)(rowbase + s) * 1024);
            dst[LANE_] = src[LANE_]; dst[64 + LANE_] = src[64 + LANE_]; }
        __syncthreads();
    }
}

constexpr int N_PHASES = 2 + 10 * NL;
#ifndef EN_MASK
#define EN_MASK 0xFFFFF
#endif
#define EN(k) ((EN_MASK >> (k)) & 1)
__global__ void __launch_bounds__(NTHREADS, 2) fwd_kernel(Args args) {
    extern __shared__ __attribute__((aligned(16))) unsigned char lds_raw[];
    cg::grid_group grid = cg::this_grid();
    Frame F;
    F.lds = (LAS unsigned char*)lds_raw;
    F.MISC = (volatile LAS unsigned*)(F.lds + MISC_OFF);
    F.wave = __builtin_amdgcn_readfirstlane(TID_ >> 6);
    F.G = gridDim.x; { const int bx = blockIdx.x; F.vcu = (F.G % 8 == 0) ? (bx % 8) * (F.G / 8) + bx / 8 : bx; }
    F.in = args.in; F.out = args.out; F.ws = args.ws; F.ctl = (unsigned*)(args.ws + WS_CTL);
    for (int u = TID_; u < (LDS_BYTES - RING_BYTES) / 4; u += NTHREADS) ((LAS unsigned*)(F.lds + RING_BYTES))[u] = 0u;
    __syncthreads();
    const int lo = args.ph_lo, hi = args.ph_hi;
    XcdBarrier bar; bar.bar = F.ctl + CW_BAR; bar.x = 0; bar.st = nullptr;
    if (hi - lo > 1) bar = xcd_barrier_post(F.ctl + CW_BAR, F.MISC + 8);
    LAS unsigned char* ring = F.lds;

#define IN(k) (lo <= (k) && (k) < hi)
#define SEAM(k) do { if (IN(k) && IN((k) + 1)) { if ((k) == lo) grid.sync(); else xcd_barrier(bar); } } while (0)
    if (IN(0)) { if (EN(10)) phase_init(F); }
    SEAM(0);
    if (IN(1)) { if (EN(11)) phase_row0(F); }
    SEAM(1);
#define LAYER(l) do { constexpr int base = 2 + 10 * (l); constexpr bool last = ((l) == NL - 1); \
    if (IN(base + 0)) { if (EN(0)) { \
        pg8::Gemm g{WSP(bf16, WS_H), WSP(bf16, WS_WIN) + (size_t)(l) * NINP * 1024, M, NINP, D}; \
        TileSched S{M / 256, NINP / 256, F.G, F.vcu, false}; \
        EpiInproj E{WSP(bf16, WS_QKV), WSP(float, WS_R32), WSP(bf16, WS_Z)}; \
        run_gemm<EpiInproj, TileSched>(ring, g, S, E); } } \
    SEAM(base + 0); \
    if (IN(base + 1)) { if (EN(1)) { \
        pg8::Gemm g{WSP(bf16, WS_Z), WSP(bf16, WS_LORA) + (size_t)(l) * 1280 * 384, M, 1280, 384}; \
        TileSched S{M / 256, 5, F.G, F.vcu, false}; \
        EpiLora E{WSP(float, WS_DEC), WSP(float, WS_ASIG), WSP(float, WS_G), F.in[I_W0] + (l) * 512, F.in[I_A0] + (l) * 512}; \
        run_gemm<EpiLora, TileSched>(ring, g, S, E); } \
        if (EN(12)) phase_qkprep(F, (l)); } \
    SEAM(base + 1); \
    if (IN(base + 2)) { if (EN(2)) phase_mixer(F, (l)); } \
    SEAM(base + 2); \
    if (IN(base + 3)) { if (EN(3)) phase_post(F, (l)); } \
    SEAM(base + 3); \
    if (IN(base + 4)) { if (EN(4)) { \
        pg8::Gemm g{WSP(bf16, WS_O), WSP(bf16, WS_WOUT) + (size_t)(l) * 1024 * 1024, M, D, D}; \
        TileSched S{last ? 64 : 72, 4, F.G, F.vcu, last}; \
        EpiOut E{WSP(float, WS_Y)}; \
        run_gemm<EpiOut, TileSched>(ring, g, S, E); } } \
    SEAM(base + 4); \
    if (IN(base + 5)) { if (EN(5)) phase_row1(F, (l)); } \
    SEAM(base + 5); \
    if (IN(base + 6)) { if (EN(6)) phase_topk(F, (l)); } \
    SEAM(base + 6); \
    if (IN(base + 7)) { if (EN(7)) { \
        pg8::Gemm g{WSP(bf16, WS_XE), WSP(bf16, WS_WGU), NE * MEXP, NE * 2048, D}; \
        MoeSched S{last ? 8 : 9, 8, F.G, F.vcu}; \
        EpiMoe1 E{WSP(bf16, WS_HID)}; \
        run_gemm<EpiMoe1, MoeSched>(ring, g, S, E); } } \
    SEAM(base + 7); \
    if (IN(base + 8)) { if (EN(8)) { \
        pg8::Gemm g{WSP(bf16, WS_HID), WSP(bf16, WS_WD), NE * MEXP, NE * 1024, D}; \
        MoeSched S{last ? 8 : 9, 4, F.G, F.vcu}; \
        EpiMoe2 E{WSP(bf16, WS_OUTE), WSP(float, WS_SELG)}; \
        run_gemm<EpiMoe2, MoeSched>(ring, g, S, E); } } \
    SEAM(base + 8); \
    if (IN(base + 9)) { if (EN(9)) { phase_row2(F, (l)); if (!last) { __syncthreads(); cvt_moe(F, (l) + 1); } } } \
    SEAM(base + 9); \
  } while (0)
    LAYER(0);
    LAYER(1);
#undef LAYER
#undef SEAM
#undef IN
}

extern "C" void kernel_launch(void* const* d_in, const int* in_sizes, int n_in, void* d_out, int out_size, void* d_ws, size_t ws_size, hipStream_t stream) {
    static int grid = 0;
    if (grid == 0) {
        if (n_in != 29 || out_size != NB * SEQ * D || ws_size < WS_END) { fprintf(stderr, "kernel_launch: unexpected sizes n_in %d out %d ws %zu\n", n_in, out_size, ws_size); grid = -1; return; }
        int dev = 0, cus = 0, per_cu = 0;
        if (hipGetDevice(&dev) != hipSuccess || hipDeviceGetAttribute(&cus, hipDeviceAttributeMultiprocessorCount, dev) != hipSuccess) { grid = -1; return; }
        if (hipFuncSetAttribute((const void*)fwd_kernel, hipFuncAttributeMaxDynamicSharedMemorySize, LDS_BYTES) != hipSuccess) { fprintf(stderr, "kernel_launch: hipFuncSetAttribute failed\n"); grid = -1; return; }
        if (hipOccupancyMaxActiveBlocksPerMultiprocessor(&per_cu, (const void*)fwd_kernel, NTHREADS, LDS_BYTES) != hipSuccess || per_cu < 1) { fprintf(stderr, "kernel_launch: occupancy query says %d\n", per_cu); per_cu = 1; }
        (void)hipGetLastError();
        grid = cus;
        fprintf(stderr, "kernel_launch: grid %d, per_cu %d, ws %zu\n", grid, per_cu, ws_size);
    }
    if (grid < 0) return;
    if (hipMemsetAsync((char*)d_ws + WS_CTL, 0, CTL_ZERO_BYTES, stream) != hipSuccess) return;
    Args a{};
    for (int i = 0; i < 29; ++i) a.in[i] = (const float*)d_in[i];
    a.out = (float*)d_out; a.ws = (unsigned char*)d_ws;
#if N_LAUNCH_MODE
    a.ph_lo = 0; a.ph_hi = N_PHASES;
    { void* kargs[] = {&a};
      hipError_t e = hipLaunchCooperativeKernel((const void*)fwd_kernel, dim3(grid), dim3(NTHREADS), kargs, LDS_BYTES, stream);
      if (e != hipSuccess) fprintf(stderr, "kernel_launch: cooperative launch failed: %s\n", hipGetErrorString(e)); }
#else
    for (int ph = 0; ph < N_PHASES; ++ph) {
        a.ph_lo = ph; a.ph_hi = ph + 1;
        void* kargs[] = {&a};
        hipError_t e = hipLaunchCooperativeKernel((const void*)fwd_kernel, dim3(grid), dim3(NTHREADS), kargs, LDS_BYTES, stream);
        if (e != hipSuccess) { fprintf(stderr, "kernel_launch: launch %d failed: %s\n", ph, hipGetErrorString(e)); break; }
    }
#endif
}
```

```cpp
#define GOLD_GEMM 0
#define N_LAUNCH_MODE 1
#define GOLD_ATTN 0
#define REP_MASK 0
#include <hip/hip_runtime.h>
#include <hip/hip_cooperative_groups.h>
#include <cstdio>
#include <cstdint>
namespace cg = cooperative_groups;

#ifndef GOLD_GEMM
#define GOLD_GEMM 0
#endif
#ifndef GOLD_ATTN
#define GOLD_ATTN 1
#endif
#ifndef N_LAUNCH_MODE
#define N_LAUNCH_MODE 1
#endif

#define LAS __attribute__((address_space(3)))
typedef unsigned short bf16;
typedef float f32x4 __attribute__((ext_vector_type(4)));
typedef unsigned u32x4 __attribute__((ext_vector_type(4)));
typedef unsigned u32x2 __attribute__((ext_vector_type(2)));
typedef short bf16x8 __attribute__((ext_vector_type(8)));

constexpr int D = 1024, NB = 8, SEQ = 2048, CTXL = 256, T = SEQ + CTXL, M = NB * T, NL = 2;
constexpr int NINP = 2816;
constexpr int NE = 16, MEXP = 2304;
constexpr float LOG2E = 1.4426950408889634f;
constexpr float C2 = 0.125f * LOG2E;
constexpr int NTHREADS = 512, NWAVES = 8;
constexpr int LDS_BYTES = 147456, RING_BYTES = 131072, MISC_OFF = RING_BYTES + 320;

constexpr size_t MiB = 1u << 20;
constexpr size_t WS_CTL = 0, CTL_ZERO_BYTES = 1 * MiB;
constexpr size_t WS_MOD = 1 * MiB;
constexpr size_t WS_WIN = 2 * MiB;
constexpr size_t WS_WOUT = 13 * MiB;
constexpr size_t WS_LORA = 17 * MiB;
constexpr size_t WS_WGU = 19 * MiB;
constexpr size_t WS_WD = 83 * MiB;
constexpr size_t WS_X = 115 * MiB;
constexpr size_t R0 = 187 * MiB;
constexpr size_t WS_YD = R0 + 0 * MiB;
constexpr size_t WS_H = R0 + 36 * MiB;
constexpr size_t WS_QKV = R0 + 72 * MiB;
constexpr size_t WS_R32 = R0 + 126 * MiB;
constexpr size_t WS_Z = R0 + 180 * MiB;
constexpr size_t WS_DEC = R0 + 194 * MiB;
constexpr size_t WS_ASIG = R0 + 230 * MiB;
constexpr size_t WS_G = R0 + 266 * MiB;
constexpr size_t WS_O = R0 + 284 * MiB;
constexpr size_t WS_END = R0 + 320 * MiB;
constexpr size_t WS_Y = WS_QKV;
constexpr size_t WS_OUTE = WS_QKV;
constexpr size_t WS_H2 = WS_DEC;
constexpr size_t WS_AFF = WS_Z;
constexpr size_t WS_INV = WS_Z + 2 * MiB;
constexpr size_t WS_SELG = WS_Z + 4 * MiB;
constexpr size_t WS_SELT = WS_Z + 5 * MiB;
constexpr size_t WS_XE = WS_ASIG;
constexpr size_t WS_HID = WS_YD;
static_assert(WS_END <= 512 * MiB, "ws map");
constexpr int CW_BAR = 4096;
constexpr int CW_QUEUE = 16384;

__device__ __forceinline__ unsigned f2bf(float f) { unsigned u = __builtin_bit_cast(unsigned, f); return (u + 0x7fffu + ((u >> 16) & 1u)) >> 16; }
__device__ __forceinline__ unsigned pk2(float lo, float hi) { return f2bf(lo) | (f2bf(hi) << 16); }
__device__ __forceinline__ float bf2f(unsigned h) { return __builtin_bit_cast(float, h << 16); }
__device__ __forceinline__ float bflo(unsigned w) { return __builtin_bit_cast(float, w << 16); }
__device__ __forceinline__ float bfhi(unsigned w) { return __builtin_bit_cast(float, w & 0xffff0000u); }
template <int CTRL> __device__ __forceinline__ float dppf(float x) { return __builtin_bit_cast(float, __builtin_amdgcn_update_dpp(0, __builtin_bit_cast(int, x), CTRL, 0xF, 0xF, true)); }
__device__ __forceinline__ float red8(float x) { x += dppf<0xB1>(x); x += dppf<0x4E>(x); x += dppf<0x141>(x); return x; }
__device__ __forceinline__ float wave_sum(float v) {
    v = red8(v); v += dppf<0x140>(v);
    const float a0 = __builtin_bit_cast(float, __builtin_amdgcn_readlane(__builtin_bit_cast(int, v), 0));
    const float a1 = __builtin_bit_cast(float, __builtin_amdgcn_readlane(__builtin_bit_cast(int, v), 16));
    const float a2 = __builtin_bit_cast(float, __builtin_amdgcn_readlane(__builtin_bit_cast(int, v), 32));
    const float a3 = __builtin_bit_cast(float, __builtin_amdgcn_readlane(__builtin_bit_cast(int, v), 48));
    return (a0 + a1) + (a2 + a3);
}
__device__ __forceinline__ float sigmoidf_(float x) { return __builtin_amdgcn_rcpf(1.f + __expf(-x)); }
#define LDS_WAIT() asm volatile("s_waitcnt lgkmcnt(0)" ::: "memory")

#define XB_TMO      128
#define XB_XCNT(j)  (256  + 64 * (j))
#define XB_XSUB(j)  (1280 + 64 * (j))
#define XB_XGEN(j)  (2304 + 64 * (j))
#define XB_TOP      3328
#define XB_TOPGEN   3392
#define XCD_BAR_WORDS 3456
#define XB_SPIN_CAP (1u << 22)
__device__ __forceinline__ unsigned xb_ld(unsigned* p)              { return __hip_atomic_load(p, __ATOMIC_RELAXED, __HIP_MEMORY_SCOPE_AGENT); }
__device__ __forceinline__ unsigned xb_add(unsigned* p, unsigned v) { return __hip_atomic_fetch_add(p, v, __ATOMIC_RELAXED, __HIP_MEMORY_SCOPE_AGENT); }
__device__ __forceinline__ unsigned xb_xcc_id() { return (unsigned)__builtin_amdgcn_s_getreg((3 << 11) | 20) & 0xFu; }
#define XB_SPIN(cond, bar) do { unsigned _sp = 0; while (cond) { __builtin_amdgcn_s_sleep(1); \
    if ((++_sp & 255u) == 0u) { if (xb_ld(&(bar)[XB_TMO])) break; if (_sp > XB_SPIN_CAP) { atomicAdd(&(bar)[XB_TMO], 1u); break; } } } } while (0)
struct XcdBarrier { unsigned* bar; unsigned x; volatile LAS unsigned* st; };
__device__ __forceinline__ XcdBarrier xcd_barrier_post(unsigned* bar, volatile LAS unsigned* st) {
    XcdBarrier b; b.bar = bar; b.x = xb_xcc_id(); b.st = st;
    if (threadIdx.x == 0) (void)xb_add(&bar[XB_XCNT(b.x)], 1u);
    return b;
}
__device__ __forceinline__ void xcd_barrier_complete(unsigned* bar, unsigned x, unsigned& nloc, unsigned& nx) {
    const unsigned G = gridDim.x * gridDim.y * gridDim.z;
    unsigned sum, cnt, mine, sp = 0u;
    for (;;) {
        sum = 0u; cnt = 0u; mine = 0u;
#pragma unroll
        for (unsigned j = 0; j < 16; ++j) { const unsigned c = xb_ld(&bar[XB_XCNT(j)]); sum += c; cnt += (c > 0u) ? 1u : 0u; mine = (j == x) ? c : mine; }
        if (sum == G) break;
        __builtin_amdgcn_s_sleep(1);
        if ((++sp & 255u) == 0u) { if (xb_ld(&bar[XB_TMO])) break; if (sp > XB_SPIN_CAP) { atomicAdd(&bar[XB_TMO], 1u); break; } }
    }
    nloc = mine > 0u ? mine : 1u; nx = cnt > 0u ? cnt : 1u;
}
__device__ __forceinline__ void xcd_barrier(const XcdBarrier& b) {
    asm volatile("s_waitcnt vmcnt(0)" ::: "memory");
    __syncthreads();
    if (threadIdx.x == 0) {
        unsigned* bar = b.bar;
        __builtin_amdgcn_s_waitcnt(0);
        unsigned nloc = b.st[0], nx = b.st[1];
        if (nloc == 0u) { xcd_barrier_complete(bar, b.x, nloc, nx); b.st[0] = nloc; b.st[1] = nx; }
        const unsigned old = xb_add(&bar[XB_XSUB(b.x)], 1u);
        const unsigned gen = old / nloc;
        if (old + 1u == (gen + 1u) * nloc) {
            __builtin_amdgcn_fence(__ATOMIC_RELEASE, "agent");
            asm volatile("s_waitcnt vmcnt(0)" ::: "memory");
            const unsigned og = xb_add(&bar[XB_TOP], 1u);
            const unsigned tg = og / nx;
            if (og + 1u == (tg + 1u) * nx) xb_add(&bar[XB_TOPGEN], 1u);
            else XB_SPIN(xb_ld(&bar[XB_TOPGEN]) == tg, bar);
            __builtin_amdgcn_fence(__ATOMIC_ACQUIRE, "agent");
            xb_add(&bar[XB_XGEN(b.x)], 1u);
            asm volatile("s_waitcnt vmcnt(0)" ::: "memory");
        } else {
            XB_SPIN(xb_ld(&bar[XB_XGEN(b.x)]) == gen, bar);
            __builtin_amdgcn_fence(__ATOMIC_ACQUIRE, "agent");
            asm volatile("s_waitcnt vmcnt(0)" ::: "memory");
        }
    }
    __syncthreads();
}
namespace pg8 {
#define PG8_LAS __attribute__((address_space(3)))
typedef unsigned short bf16_t;
typedef short bf16x8 __attribute__((ext_vector_type(8)));
typedef float f32x4 __attribute__((ext_vector_type(4)));
typedef unsigned u32x4 __attribute__((ext_vector_type(4)));
constexpr int BM = 256, BK = 64, HALF = 128, HTB = HALF * BK * 2  , STAGE_BYTES = 8 * HTB, NXCD = 8, WGM = 8;

__host__ __device__ __forceinline__ int lds_byte(int r, int c) { const int st = (r >> 4) * 2 + (c >> 5), rr = r & 15, cc = c & 31, ob = rr * 64 + cc * 2; return st * 1024 + (ob ^ (((ob >> 9) & 1) << 5)); }
__host__ __device__ __forceinline__ void stage_rc(int b, int& R, int& C) { const int st = b / 1024, sb = b % 1024, swz = sb ^ (((sb >> 9) & 1) << 5); R = (st >> 1) * 16 + swz / 64; C = (st & 1) * 32 + (swz % 64) / 2; }
__host__ __device__ __forceinline__ int perm32(int rho) { const int n = rho >> 4, i = rho & 15; return 8 * (i >> 2) + 4 * n + (i & 3); }

struct Unit { int pm, pn; };
struct Gemm { const bf16_t* A; const bf16_t* Bt; int M, N, K; };

struct StaticOrder {
    int nM, nN, nwg, G, c;
    __host__ __device__ void init(int M, int N, int G_, int c_) { nM = M / BM; nN = N / BM; nwg = nM * nN; G = G_; c = c_; }
    __host__ __device__ bool next(int i, Unit& u) const {
        const long L = (long)i * G + c; if (L >= nwg) return false;
        int wgid = (int)L; { const int q = nwg / NXCD, r = nwg % NXCD, xcd = wgid % NXCD, off = wgid / NXCD; wgid = (xcd < r ? xcd * (q + 1) : r * (q + 1) + (xcd - r) * q) + off; }
        const int nig = WGM * nN, gid = wgid / nig, fm = gid * WGM, gsz = (nM - fm) < WGM ? (nM - fm) : WGM;
        u.pm = fm + ((wgid % nig) % gsz); u.pn = (wgid % nig) / gsz; return true;
    }
    __device__ __forceinline__ void a_ready(const Unit&) const {}
    __device__ __forceinline__ void done(const Unit&) const {}
};
__device__ __forceinline__ unsigned cvt_pk_bf16(float lo, float hi) { unsigned r; asm volatile("v_cvt_pk_bf16_f32 %0, %1, %2" : "=v"(r) : "v"(lo), "v"(hi)); return r; }
typedef float f32x2 __attribute__((ext_vector_type(2)));
template <class Epi, class Sched, bool ALIGN_EPI = false, bool SP2 = false>
__device__ __forceinline__ void gemm_phase(PG8_LAS unsigned char* lds, const Gemm g, const Sched& S, const Epi& E) {
    const int tid = threadIdx.x, wid = __builtin_amdgcn_readfirstlane(tid >> 6), lane = tid & 63, wr = wid >> 2, wc = wid & 3, fr = lane & 15, fq = lane >> 4;
    const int K = g.K, nt = K / BK;
    unsigned voffA[2], voffB[2];
#pragma unroll
    for (int i = 0; i < 2; ++i) { int R, C; stage_rc(tid * 16 + i * 8192, R, C); const int Rb = Epi::PERM ? ((R & ~31) + perm32(R & 31)) : R;
        voffA[i] = (unsigned)(R * K + C) * 2u; voffB[i] = (unsigned)(Rb * K + C) * 2u; }
    const size_t kstep = (size_t)(BK * 2);
    const size_t hstep = (size_t)HALF * K * 2;
    const size_t tstep = 2 * hstep;
    const unsigned ldsw = (unsigned)wid * 1024u;
    const int aoff = lds_byte(wr * 64 + fr, fq * 8), boff = lds_byte(wc * 32 + fr, fq * 8);
#define PG8_SA(b, h) (((b) * 2 + (h)) * HTB)
#define PG8_SB(b, h) ((4 + (b) * 2 + (h)) * HTB)
#define PG8_STAGE(bufoff, gbase, voff) do { _Pragma("unroll") for (int _i = 0; _i < 2; ++_i) \
        __builtin_amdgcn_global_load_lds((const unsigned*)((const char*)(gbase) + (voff)[_i]), (PG8_LAS unsigned*)(lds + (bufoff) + ldsw + _i * 8192), 16, 0, 0); } while (0)
#define PG8_LDA(dst, b, h) do { _Pragma("unroll") for (int m = 0; m < 4; ++m) _Pragma("unroll") for (int k = 0; k < 2; ++k) dst[m][k] = *(const PG8_LAS bf16x8*)(lds + PG8_SA(b, h) + aoff + m * 2048 + k * 1024); } while (0)
#define PG8_LDB(dst, b, h) do { _Pragma("unroll") for (int n = 0; n < 2; ++n) _Pragma("unroll") for (int k = 0; k < 2; ++k) dst[n][k] = *(const PG8_LAS bf16x8*)(lds + PG8_SB(b, h) + boff + n * 2048 + k * 1024); } while (0)
#define PG8_MMA(ai, bj, At, Bt) do { __builtin_amdgcn_s_setprio(1); _Pragma("unroll") for (int m = 0; m < 4; ++m) _Pragma("unroll") for (int n = 0; n < 2; ++n) _Pragma("unroll") for (int k = 0; k < 2; ++k) \
        acc[ai][bj][m][n] = __builtin_amdgcn_mfma_f32_16x16x32_bf16(Bt[n][k], At[m][k], acc[ai][bj][m][n], 0, 0, 0); __builtin_amdgcn_s_setprio(0); } while (0)
#define PG8_WAIT_V(n) asm volatile("s_waitcnt vmcnt(" #n ")" ::: "memory")
#define PG8_WAIT_L(n) asm volatile("s_waitcnt lgkmcnt(" #n ")" ::: "memory")
#define PG8_BAR __builtin_amdgcn_s_barrier()
#define PG8_SCHED __builtin_amdgcn_sched_barrier(0)
    Unit cur, nxt; int ui = 0;
    if (!S.next(0, cur)) return;
    f32x4 acc[2][2][4][2];
#pragma unroll
    for (int a = 0; a < 2; ++a)
#pragma unroll
        for (int b = 0; b < 2; ++b)
#pragma unroll
            for (int m = 0; m < 4; ++m)
#pragma unroll
                for (int n = 0; n < 2; ++n) acc[a][b][m][n] = (f32x4){0.f, 0.f, 0.f, 0.f};
    bf16x8 At[4][2], B0[2][2], B1[2][2];
    const char* cA = (const char*)g.A + (size_t)cur.pm * tstep; const char* cB = (const char*)g.Bt + (size_t)cur.pn * tstep;
    S.a_ready(cur);
    if constexpr (SP2) {
        PG8_STAGE(PG8_SB(0, 0), cB, voffB); PG8_STAGE(PG8_SB(0, 1), cB + hstep, voffB); PG8_STAGE(PG8_SA(0, 0), cA, voffA); PG8_STAGE(PG8_SA(0, 1), cA + hstep, voffA);
        if (wr == 1) PG8_BAR;
        PG8_WAIT_V(2); PG8_BAR;
        PG8_STAGE(PG8_SB(1, 0), cB + kstep, voffB); PG8_STAGE(PG8_SA(1, 0), cA + kstep, voffA); PG8_STAGE(PG8_SB(1, 1), cB + hstep + kstep, voffB);
        PG8_WAIT_V(6); PG8_BAR;
    } else {
        PG8_STAGE(PG8_SB(0, 0), cB, voffB); PG8_STAGE(PG8_SA(0, 0), cA, voffA); PG8_STAGE(PG8_SB(0, 1), cB + hstep, voffB); PG8_STAGE(PG8_SA(0, 1), cA + hstep, voffA);
        if (wr == 1) PG8_BAR;
        PG8_WAIT_V(4); PG8_BAR;
        PG8_STAGE(PG8_SB(1, 0), cB + kstep, voffB); PG8_STAGE(PG8_SA(1, 0), cA + kstep, voffA); PG8_STAGE(PG8_SB(1, 1), cB + hstep + kstep, voffB);
        PG8_WAIT_V(6); PG8_BAR;
    }
    for (;;) {
        const bool has_next = S.next(ui + 1, nxt);
        const char* nA = has_next ? (const char*)g.A + (size_t)nxt.pm * tstep : cA; const char* nB = has_next ? (const char*)g.Bt + (size_t)nxt.pn * tstep : cB;
        for (int t = 0; t < nt; t += 2) {
            const bool last = (t == nt - 2);
            const char* a1 = cA + (size_t)(t + 1) * kstep;
            const char* a2 = last ? nA : cA + (size_t)(t + 2) * kstep; const char* b2 = last ? nB : cB + (size_t)(t + 2) * kstep;
            const char* a3 = a2 + kstep; const char* b3 = b2 + kstep;
            if (last && has_next) S.a_ready(nxt);
            if constexpr (SP2) {
            PG8_LDB(B0, 0, 0); PG8_LDB(B1, 0, 1); PG8_SCHED; PG8_LDA(At, 0, 0); PG8_STAGE(PG8_SA(1, 1), a1 + hstep, voffA);
            PG8_WAIT_V(8); PG8_WAIT_L(0); PG8_BAR; PG8_MMA(0, 0, At, B0); PG8_MMA(0, 1, At, B1); PG8_BAR; PG8_SCHED;
            PG8_LDA(At, 0, 1); PG8_STAGE(PG8_SB(0, 0), b2, voffB); PG8_STAGE(PG8_SB(0, 1), b2 + hstep, voffB); PG8_STAGE(PG8_SA(0, 0), a2, voffA);
            PG8_WAIT_V(8); PG8_WAIT_L(0); PG8_BAR; PG8_MMA(1, 0, At, B0); PG8_MMA(1, 1, At, B1); PG8_BAR; PG8_SCHED;
            PG8_LDB(B0, 1, 0); PG8_LDB(B1, 1, 1); PG8_SCHED; PG8_LDA(At, 1, 0); PG8_STAGE(PG8_SA(0, 1), a2 + hstep, voffA);
            PG8_WAIT_V(8); PG8_WAIT_L(0); PG8_BAR; PG8_MMA(0, 0, At, B0); PG8_MMA(0, 1, At, B1); PG8_BAR; PG8_SCHED;
            PG8_LDA(At, 1, 1); PG8_STAGE(PG8_SB(1, 0), b3, voffB); PG8_STAGE(PG8_SB(1, 1), b3 + hstep, voffB); PG8_STAGE(PG8_SA(1, 0), a3, voffA);
            PG8_WAIT_V(8); PG8_WAIT_L(0); PG8_BAR; PG8_MMA(1, 0, At, B0); PG8_MMA(1, 1, At, B1); PG8_BAR; PG8_SCHED;
            } else {
            PG8_LDB(B0, 0, 0); PG8_SCHED; PG8_LDA(At, 0, 0); PG8_STAGE(PG8_SA(1, 1), a1 + hstep, voffA);
            PG8_WAIT_L(8); PG8_BAR; PG8_WAIT_L(0); PG8_MMA(0, 0, At, B0); PG8_BAR; PG8_SCHED;
            PG8_LDB(B1, 0, 1); PG8_STAGE(PG8_SB(0, 0), b2, voffB);
            PG8_BAR; PG8_WAIT_L(0); PG8_MMA(0, 1, At, B1); PG8_BAR;
            PG8_LDA(At, 0, 1); PG8_STAGE(PG8_SA(0, 0), a2, voffA);
            PG8_BAR; PG8_WAIT_L(0); PG8_MMA(1, 0, At, B0); PG8_BAR; PG8_SCHED;
            PG8_STAGE(PG8_SB(0, 1), b2 + hstep, voffB);
            PG8_WAIT_V(6); PG8_BAR; PG8_MMA(1, 1, At, B1); PG8_BAR;
            PG8_LDB(B0, 1, 0); PG8_SCHED; PG8_LDA(At, 1, 0); PG8_STAGE(PG8_SA(0, 1), a2 + hstep, voffA);
            PG8_WAIT_L(8); PG8_BAR; PG8_WAIT_L(0); PG8_MMA(0, 0, At, B0); PG8_BAR; PG8_SCHED;
            PG8_LDB(B1, 1, 1); PG8_STAGE(PG8_SB(1, 0), b3, voffB);
            PG8_BAR; PG8_WAIT_L(0); PG8_MMA(0, 1, At, B1); PG8_BAR;
            PG8_LDA(At, 1, 1); PG8_STAGE(PG8_SA(1, 0), a3, voffA);
            PG8_BAR; PG8_WAIT_L(0); PG8_MMA(1, 0, At, B0); PG8_BAR; PG8_SCHED;
            PG8_STAGE(PG8_SB(1, 1), b3 + hstep, voffB);
            PG8_WAIT_V(6); PG8_BAR; PG8_MMA(1, 1, At, B1); PG8_BAR;
            }
        }
        if constexpr (ALIGN_EPI) { if (wr == 0) PG8_BAR; }
        if constexpr (!Epi::AFTER_DRAIN) { E(acc, cur, wr, wc, fr, fq); S.done(cur); }
        if (!has_next) break;
#pragma unroll
        for (int a = 0; a < 2; ++a)
#pragma unroll
            for (int b = 0; b < 2; ++b)
#pragma unroll
                for (int m = 0; m < 4; ++m)
#pragma unroll
                    for (int n = 0; n < 2; ++n) acc[a][b][m][n] = (f32x4){0.f, 0.f, 0.f, 0.f};
        cur = nxt; cA = nA; cB = nB; ++ui;
        if constexpr (ALIGN_EPI) { if (wr == 1) PG8_BAR; }
    }
    PG8_WAIT_V(0);
    if constexpr (!ALIGN_EPI) { if (wr == 0) PG8_BAR; }
    PG8_BAR;
    if constexpr (Epi::AFTER_DRAIN) { E.fused(acc, cur, wr, wc, fr, fq, lds, wid, lane); S.done(cur); }
#undef PG8_SA
#undef PG8_SB
#undef PG8_STAGE
#undef PG8_LDA
#undef PG8_LDB
#undef PG8_MMA
#undef PG8_WAIT_V
#undef PG8_WAIT_L
#undef PG8_BAR
#undef PG8_SCHED
}
}

__device__ __forceinline__ u32x4 pack8(const f32x4 a, const f32x4 b) {
    u32x4 w; w.x = pk2(a[0], a[1]); w.y = pk2(a[2], a[3]); w.z = pk2(b[0], b[1]); w.w = pk2(b[2], b[3]); return w;
}
__device__ __forceinline__ float tanh_fast(float x) { const float e = __expf(2.f * x); return 1.f - 2.f * __builtin_amdgcn_rcpf(1.f + e); }
__device__ __forceinline__ float decay_of(float v) { const float ew = 0.6065306597126334f * __builtin_amdgcn_rcpf(1.f + __expf(-v)); return __expf(-ew); }
struct EpiInproj {
    static constexpr bool PERM = true, AFTER_DRAIN = false;
    bf16* QKV; float* R32; bf16* Z;
    __device__ __forceinline__ void operator()(const f32x4 (&acc)[2][2][4][2], const pg8::Unit& u, int wr, int wc, int fr, int fq) const {
        const int pn = u.pn;
#pragma unroll
        for (int ai = 0; ai < 2; ++ai)
#pragma unroll
            for (int m = 0; m < 4; ++m) {
                const unsigned row = (unsigned)u.pm * 256u + ai * 128 + wr * 64 + m * 16 + fr;
#pragma unroll
                for (int bj = 0; bj < 2; ++bj) {
                    f32x4 v0 = acc[ai][bj][m][0], v1 = acc[ai][bj][m][1];
                    const int cb = bj * 128 + wc * 32 + 8 * fq;
                    if (pn < 6) {
                        if (pn == 3) { v0 = v0 * C2; v1 = v1 * C2; }
                        *(u32x4*)(QKV + row * 1536 + pn * 256 + cb) = pack8(v0, v1);
                    } else if (pn < 9) {
                        float* p = R32 + row * 768 + (pn - 6) * 256 + cb;
                        *(f32x4*)p = v0; *(f32x4*)(p + 4) = v1;
                    } else if (pn == 9) {
                        if (bj == 0) {
#pragma unroll
                            for (int e = 0; e < 4; ++e) { v0[e] = tanh_fast(v0[e]); v1[e] = tanh_fast(v1[e]); }
                        }
                        *(u32x4*)(Z + row * 384 + cb) = pack8(v0, v1);
                    } else {
                        if (bj == 0) {
#pragma unroll
                            for (int e = 0; e < 4; ++e) { v0[e] = sigmoidf_(v0[e]); v1[e] = sigmoidf_(v1[e]); }
                            *(u32x4*)(Z + row * 384 + 256 + cb) = pack8(v0, v1);
                        }
                    }
                }
            }
    }
};
struct EpiLora {
    static constexpr bool PERM = true, AFTER_DRAIN = false;
    float* DEC; float* ASIG; float* G; const float* w0; const float* a0;
    template <int KIND> __device__ __forceinline__ void body(const f32x4 (&acc)[2][2][4][2], float* dst, const float* bias, unsigned row0, int cb0) const {
#pragma unroll
        for (int bj = 0; bj < 2; ++bj) {
            const int cb = bj * 128 + cb0;
            f32x4 b0 = (f32x4){0.f, 0.f, 0.f, 0.f}, b1 = b0;
            if (KIND != 2) { b0 = *(const f32x4*)(bias + cb); b1 = *(const f32x4*)(bias + cb + 4); }
#pragma unroll
            for (int ai = 0; ai < 2; ++ai)
#pragma unroll
                for (int m = 0; m < 4; ++m) {
                    f32x4 v0 = acc[ai][bj][m][0] + b0, v1 = acc[ai][bj][m][1] + b1;
#pragma unroll
                    for (int e = 0; e < 4; ++e) {
                        if (KIND == 0) { v0[e] = decay_of(v0[e]); v1[e] = decay_of(v1[e]); }
                        if (KIND == 1) { v0[e] = sigmoidf_(v0[e]); v1[e] = sigmoidf_(v1[e]); }
                    }
                    float* p = dst + (row0 + ai * 128 + m * 16) * 256u + cb;
                    *(f32x4*)p = v0; *(f32x4*)(p + 4) = v1;
                    asm volatile("" ::: "memory");
                }
        }
    }
    __device__ __forceinline__ void operator()(const f32x4 (&acc)[2][2][4][2], const pg8::Unit& u, int wr, int wc, int fr, int fq) const {
        const int pn = u.pn; const unsigned row0 = (unsigned)u.pm * 256u + wr * 64 + fr; const int cb0 = wc * 32 + 8 * fq;
        if (pn < 2) body<0>(acc, DEC + (size_t)pn * M * 256, w0 + pn * 256, row0, cb0);
        else if (pn < 4) body<1>(acc, ASIG + (size_t)(pn - 2) * M * 256, a0 + (pn - 2) * 256, row0, cb0);
        else body<2>(acc, G, w0, row0, cb0);
    }
};
struct EpiOut {
    static constexpr bool PERM = true, AFTER_DRAIN = false;
    float* Y;
    __device__ __forceinline__ void operator()(const f32x4 (&acc)[2][2][4][2], const pg8::Unit& u, int wr, int wc, int fr, int fq) const {
#pragma unroll
        for (int ai = 0; ai < 2; ++ai)
#pragma unroll
            for (int m = 0; m < 4; ++m) {
                const unsigned row = (unsigned)u.pm * 256u + ai * 128 + wr * 64 + m * 16 + fr;
#pragma unroll
                for (int bj = 0; bj < 2; ++bj) {
                    float* p = Y + row * 1024 + u.pn * 256 + bj * 128 + wc * 32 + 8 * fq;
                    *(f32x4*)p = acc[ai][bj][m][0]; *(f32x4*)(p + 4) = acc[ai][bj][m][1];
                }
            }
    }
};
struct EpiMoe1 {
    static constexpr bool PERM = true, AFTER_DRAIN = false;
    bf16* HID;
    __device__ __forceinline__ void operator()(const f32x4 (&acc)[2][2][4][2], const pg8::Unit& u, int wr, int wc, int fr, int fq) const {
        const int pnl = u.pn & 7;
#pragma unroll
        for (int ai = 0; ai < 2; ++ai)
#pragma unroll
            for (int m = 0; m < 4; ++m) {
                const unsigned row = (unsigned)u.pm * 256u + ai * 128 + wr * 64 + m * 16 + fr;
                f32x4 h0, h1;
#pragma unroll
                for (int e = 0; e < 4; ++e) {
                    const float g0 = acc[ai][0][m][0][e], g1 = acc[ai][0][m][1][e];
                    h0[e] = g0 * sigmoidf_(g0) * acc[ai][1][m][0][e];
                    h1[e] = g1 * sigmoidf_(g1) * acc[ai][1][m][1][e];
                }
                *(u32x4*)(HID + row * 1024 + pnl * 128 + wc * 32 + 8 * fq) = pack8(h0, h1);
            }
    }
};
struct EpiMoe2 {
    static constexpr bool PERM = true, AFTER_DRAIN = false;
    bf16* OUTE; const float* selg;
    __device__ __forceinline__ void operator()(const f32x4 (&acc)[2][2][4][2], const pg8::Unit& u, int wr, int wc, int fr, int fq) const {
        const int pnl = u.pn & 3;
#pragma unroll
        for (int ai = 0; ai < 2; ++ai)
#pragma unroll
            for (int m = 0; m < 4; ++m) {
                const unsigned row = (unsigned)u.pm * 256u + ai * 128 + wr * 64 + m * 16 + fr;
                const float gt = selg[row];
#pragma unroll
                for (int bj = 0; bj < 2; ++bj)
                    *(u32x4*)(OUTE + row * 1024 + pnl * 256 + bj * 128 + wc * 32 + 8 * fq) = pack8(acc[ai][bj][m][0] * gt, acc[ai][bj][m][1] * gt);
            }
    }
};

struct TileSched {
    int nM, nN, G, c; bool latent_only;
    __device__ __forceinline__ bool next(int i, pg8::Unit& u) const {
        const long L = (long)i * G + c; if (L >= (long)nM * nN) return false;
        const int pmi = (int)(L / nN); u.pn = (int)(L % nN); u.pm = latent_only ? (pmi >> 3) * 9 + 1 + (pmi & 7) : pmi; return true;
    }
    __device__ __forceinline__ void a_ready(const pg8::Unit&) const {}
    __device__ __forceinline__ void done(const pg8::Unit&) const {}
};
struct MoeSched {
    int nMe, nNe, G, c;
    __device__ __forceinline__ bool next(int i, pg8::Unit& u) const {
        const long L = (long)i * G + c; if (L >= (long)NE * nMe * nNe) return false;
        const int pnl = (int)(L % nNe), t = (int)(L / nNe), pml = t % nMe, e = t / nMe;
        u.pm = e * 9 + pml; u.pn = e * nNe + pnl; return true;
    }
    __device__ __forceinline__ void a_ready(const pg8::Unit&) const {}
    __device__ __forceinline__ void done(const pg8::Unit&) const {}
};

template <class Epi, class Sched>
__device__ __forceinline__ void gemm_ref(const pg8::Gemm g, const Sched& S, const Epi& E) {
    const int tid = threadIdx.x, wid = tid >> 6, lane = tid & 63, wr = wid >> 2, wc = wid & 3, fr = lane & 15, fq = lane >> 4;
    int K = g.K; asm volatile("" : "+s"(K));
    pg8::Unit u;
    for (int ui = 0; S.next(ui, u); ++ui) {
        f32x4 acc[2][2][4][2];
#pragma unroll
        for (int a = 0; a < 2; ++a)
#pragma unroll
            for (int b = 0; b < 2; ++b)
#pragma unroll
                for (int m = 0; m < 4; ++m)
#pragma unroll
                    for (int n = 0; n < 2; ++n) acc[a][b][m][n] = (f32x4){0.f, 0.f, 0.f, 0.f};
        const bf16* Ab = g.A + ((size_t)u.pm * 256 + wr * 64 + fr) * K;
        const bf16* Bb = g.Bt + ((size_t)u.pn * 256 + wc * 32 + 8 * fq) * K;
#pragma unroll
        for (int ai = 0; ai < 2; ++ai)
#pragma unroll
            for (int bj = 0; bj < 2; ++bj)
#pragma unroll
                for (int m = 0; m < 4; ++m)
#pragma unroll
                    for (int n = 0; n < 2; ++n)
#pragma unroll
                        for (int e = 0; e < 4; ++e) {
                            const bf16* ar = Ab + (size_t)(ai * 128 + m * 16) * K; const bf16* br = Bb + (size_t)(bj * 128 + 4 * n + e) * K;
                            float s0 = 0.f, s1 = 0.f;
#pragma unroll 2
                            for (int k0 = 0; k0 < K; k0 += 8) {
                                const u32x4 wa = *(const u32x4*)(ar + k0), wb = *(const u32x4*)(br + k0);
                                s0 += bflo(wa.x) * bflo(wb.x) + bflo(wa.y) * bflo(wb.y) + bflo(wa.z) * bflo(wb.z) + bflo(wa.w) * bflo(wb.w);
                                s1 += bfhi(wa.x) * bfhi(wb.x) + bfhi(wa.y) * bfhi(wb.y) + bfhi(wa.z) * bfhi(wb.z) + bfhi(wa.w) * bfhi(wb.w);
                            }
                            acc[ai][bj][m][n][e] = s0 + s1;
                            asm volatile("" ::: "memory");
                        }
        E(acc, u, wr, wc, fr, fq);
    }
}
template <class Epi, class Sched>
__device__ __forceinline__ void run_gemm(LAS unsigned char* lds, const pg8::Gemm g, const Sched& S, const Epi& E) {
#if GOLD_GEMM
    gemm_ref<Epi, Sched>(g, S, E);
    __syncthreads();
#else
    pg8::Gemm g2 = g; { int kd = g.K; asm volatile("" : "+s"(kd)); g2.K = kd; }
    pg8::gemm_phase<Epi, Sched, true, true>(lds, g2, S, E);
#endif
}

struct Args { const float* in[29]; float* out; unsigned char* ws; int ph_lo, ph_hi; };
enum { I_X = 0, I_C, I_CTX, I_CCTX, I_WMOD, I_BMOD, I_GPREMIX, I_GPOSTMIX, I_GPREFFN, I_GPOSTFFN, I_WIN, I_WOUT, I_QGAIN, I_KGAIN, I_RPB,
       I_W0, I_WUP, I_A0, I_AUP, I_GUP, I_KK, I_KA, I_RK, I_LNXW, I_LNXB, I_WROUTER, I_WEGATE, I_WEUP, I_WEDOWN };

struct Frame {
    LAS unsigned char* lds; volatile LAS unsigned* MISC; unsigned* ctl;
    int wave, vcu, G;
    const float* const* in; float* out; unsigned char* ws;
};
#define TID_ ((int)threadIdx.x)
#define LANE_ ((int)(threadIdx.x & 63u))
#define WSP(T_, off) ((T_*)(F.ws + (off)))

__device__ __forceinline__ void cvt_item(const float* src, int ld_src, bf16* dst, int ld_dst, LAS float* scr, int lane) {
#pragma unroll 8
    for (int i = 0; i < 32; ++i) { const int kk = 2 * i + (lane >> 5); scr[kk * 33 + (lane & 31)] = src[(size_t)kk * ld_src + (lane & 31)]; }
    LDS_WAIT(); asm volatile("" ::: "memory");
    const int c = lane & 7;
#pragma unroll
    for (int j = 0; j < 4; ++j) { const int n = (lane >> 3) + 8 * j; const LAS float* s = scr + (8 * c) * 33 + n;
        u32x4 o; o.x = pk2(s[0 * 33], s[1 * 33]); o.y = pk2(s[2 * 33], s[3 * 33]); o.z = pk2(s[4 * 33], s[5 * 33]); o.w = pk2(s[6 * 33], s[7 * 33]);
        *(u32x4*)(dst + (size_t)n * ld_dst + 8 * c) = o; }
    LDS_WAIT(); asm volatile("" ::: "memory");
}
__device__ __forceinline__ void cvt_moe_item(Frame& F, int l, int it, LAS float* scr, int lane) {
    const int which = it >> 13, r = it & 8191, e = r >> 9, q = r & 511, kb = q >> 5, nb = q & 31, n0 = nb * 32;
    const float* W = F.in[which == 0 ? I_WEGATE : (which == 1 ? I_WEUP : I_WEDOWN)] + ((size_t)(l * NE + e) * 1024 + kb * 64) * 1024 + n0;
    bf16* dst;
    if (which < 2) dst = WSP(bf16, WS_WGU) + ((size_t)e * 2048 + (n0 >> 7) * 256 + which * 128 + (n0 & 127)) * 1024 + kb * 64;
    else dst = WSP(bf16, WS_WD) + ((size_t)e * 1024 + n0) * 1024 + kb * 64;
    cvt_item(W, 1024, dst, 1024, scr, lane);
}
constexpr int CVT_BLK = 32, CVT_NBLK = 3 * 8192 / CVT_BLK;
__device__ __forceinline__ void cvt_moe_block(Frame& F, int l, int bi) {
    int lane = LANE_; asm volatile("" : "+v"(lane));
    LAS float* scr = (LAS float*)(F.lds + F.wave * 16384);
#pragma unroll 1
    for (int k = 0; k < CVT_BLK / NWAVES; ++k) cvt_moe_item(F, l, bi * CVT_BLK + k * NWAVES + F.wave, scr, lane);
}

__device__ __forceinline__ void phase_init(Frame& F) {
    const int tid = TID_;
    {
        LAS float* sil = (LAS float*)F.lds;
        LAS float* red = (LAS float*)(F.lds + 40960);
        float* MOD = WSP(float, WS_MOD);
        bool have = false;
        for (int it = F.vcu; it < 2 * 96; it += F.G) {
            if (!have) {
                for (int i = tid; i < 9 * 1024; i += NTHREADS) { const int r = i >> 10, k = i & 1023; const float cv = (r < 8) ? F.in[I_C][r * 1024 + k] : F.in[I_CCTX][k]; sil[i] = cv / (1.f + expf(-cv)); }
                __syncthreads(); have = true;
            }
            const int l = it / 96, n0 = (it % 96) * 64, ks = tid >> 6, col = tid & 63;
            float acc[9];
#pragma unroll
            for (int r = 0; r < 9; ++r) acc[r] = 0.f;
            const float* w = F.in[I_WMOD] + ((size_t)l * 1024 + ks * 128) * 6144 + n0 + col;
            for (int k = 0; k < 128; ++k) { const float wv = w[(size_t)k * 6144];
#pragma unroll
                for (int r = 0; r < 9; ++r) acc[r] += sil[r * 1024 + ks * 128 + k] * wv; }
#pragma unroll
            for (int r = 0; r < 9; ++r) red[(ks * 9 + r) * 64 + col] = acc[r];
            __syncthreads();
            for (int o = tid; o < 576; o += NTHREADS) { const int r = o >> 6, cc = o & 63; float s = 0.f;
#pragma unroll
                for (int k2 = 0; k2 < 8; ++k2) s += red[(k2 * 9 + r) * 64 + cc];
                MOD[(size_t)(l * 9 + r) * 6144 + n0 + cc] = s + F.in[I_BMOD][l * 6144 + n0 + cc]; }
            __syncthreads();
        }
        __syncthreads();
    }
    {
        LAS float* scr = (LAS float*)(F.lds + F.wave * 16384);
        const int gw = F.vcu * NWAVES + F.wave, NGW = F.G * NWAVES;
        bf16* WIN = WSP(bf16, WS_WIN); bf16* WOUT = WSP(bf16, WS_WOUT);
        for (int it = gw; it < 2 * (1344 + 512); it += NGW) {
            const int l = it / 1856, r = it % 1856;
            if (r < 1344) { const int kb = r / 84, n0 = (r % 84) * 32; const int dn = n0 < 768 ? n0 : (n0 < 1920 ? n0 + 768 : n0 - 1152);
                cvt_item(F.in[I_WIN] + ((size_t)l * 1024 + kb * 64) * 2688 + n0, 2688, WIN + ((size_t)l * NINP + dn) * 1024 + kb * 64, 1024, scr, LANE_); }
            else { const int q = r - 1344, kb = q >> 5, n0 = (q & 31) * 32;
                cvt_item(F.in[I_WOUT] + ((size_t)l * 1024 + kb * 64) * 1024 + n0, 1024, WOUT + ((size_t)l * 1024 + n0) * 1024 + kb * 64, 1024, scr, LANE_); }
        }
    }
    {
        const size_t gt = (size_t)F.vcu * NTHREADS + tid, NT = (size_t)F.G * NTHREADS;
        f32x4* X = WSP(f32x4, WS_X);
        for (size_t i = gt; i < (size_t)M * 256; i += NT) { const int m = (int)(i >> 8), q = (int)(i & 255), b = m / T, t = m % T;
            const f32x4* src = t < CTXL ? (const f32x4*)(F.in[I_CTX] + ((size_t)b * CTXL + t) * 1024) : (const f32x4*)(F.in[I_X] + ((size_t)b * SEQ + (t - CTXL)) * 1024);
            X[i] = src[q]; }
        u32x4* WIN4 = WSP(u32x4, WS_WIN);
        for (size_t i = gt; i < (size_t)2 * 128 * 128; i += NT) { const int l = (int)(i >> 14), r = (int)(i & 16383); WIN4[((size_t)l * NINP + 2688) * 128 + r] = (u32x4){0u, 0u, 0u, 0u}; }
        bf16* LORA = WSP(bf16, WS_LORA);
        for (size_t i = gt; i < (size_t)2 * 1280 * 384; i += NT) { const int l = (int)(i / (1280 * 384)), r = (int)(i % (1280 * 384)), n = r / 384, k = r % 384, tile = n >> 8, nn = n & 255;
            float v = 0.f;
            if (tile < 2) { const int d = tile, kk = k - 64 * d; if (kk >= 0 && kk < 64) v = F.in[I_WUP][(((size_t)l * 2 + d) * 64 + kk) * 256 + nn]; }
            else if (tile < 4) { const int d = tile - 2, kk = k - 128 - 64 * d; if (kk >= 0 && kk < 64) v = F.in[I_AUP][(((size_t)l * 2 + d) * 64 + kk) * 256 + nn]; }
            else { const int kk = k - 256; if (kk >= 0) v = F.in[I_GUP][((size_t)l * 128 + kk) * 256 + nn]; }
            LORA[i] = (bf16)f2bf(v); }
    }
}

__device__ __forceinline__ float row_ss(const f32x4 (&v)[4]) {
    float s = 0.f;
#pragma unroll
    for (int j = 0; j < 4; ++j) s += (v[j][0] * v[j][0] + v[j][1] * v[j][1]) + (v[j][2] * v[j][2] + v[j][3] * v[j][3]);
    return wave_sum(s);
}
__device__ __forceinline__ void mod_store(const f32x4 (&x)[4], float rinv, const float* g, const float* shift, const float* scale, bf16* dst, int lane, f32x4 (&h)[4]) {
#pragma unroll
    for (int j = 0; j < 4; ++j) { const int e = 256 * j + 4 * lane;
        const f32x4 gg = *(const f32x4*)(g + e), sh = *(const f32x4*)(shift + e), sc = *(const f32x4*)(scale + e);
        h[j] = x[j] * rinv * gg * (sc + 1.f) + sh;
        u32x2 w; w.x = pk2(h[j][0], h[j][1]); w.y = pk2(h[j][2], h[j][3]); *(u32x2*)(dst + e) = w; }
}
__device__ __forceinline__ void phase_row0(Frame& F) {
    const int gw = F.vcu * NWAVES + F.wave, NGW = F.G * NWAVES, lane = LANE_;
    const float* X = WSP(float, WS_X); bf16* H = WSP(bf16, WS_H); const float* MOD = WSP(float, WS_MOD);
    for (int m = gw; m < M; m += NGW) { const int b = m / T, t = m % T, r = t < CTXL ? 8 : b;
        f32x4 x[4], h[4];
#pragma unroll
        for (int j = 0; j < 4; ++j) x[j] = *(const f32x4*)(X + (size_t)m * 1024 + 256 * j + 4 * lane);
        const float rinv = rsqrtf(row_ss(x) * (1.f / 1024.f) + 1e-6f);
        const float* md = MOD + (size_t)(0 * 9 + r) * 6144;
        mod_store(x, rinv, F.in[I_GPREMIX], md, md + 1024, H + (size_t)m * 1024, lane, h);
    }
}
__device__ __forceinline__ void phase_row1(Frame& F, int l, bool dry = false) {
    const int gw = F.vcu * NWAVES + F.wave, NGW = F.G * NWAVES, lane = LANE_;
    const float* X = WSP(float, WS_X); const float* Y = WSP(float, WS_Y); const float* MOD = WSP(float, WS_MOD);
    float* Xs = dry ? WSP(float, WS_XE) : WSP(float, WS_X); bf16* H2 = dry ? WSP(bf16, WS_XE) : WSP(bf16, WS_H2);
    float* AFF = dry ? WSP(float, WS_XE) : WSP(float, WS_AFF); int* INV = dry ? WSP(int, WS_XE) : WSP(int, WS_INV);
    {
        const f32x4* src = (const f32x4*)(F.in[I_WROUTER] + (size_t)l * 1024 * 16); LAS f32x4* dstl = (LAS f32x4*)F.lds;
        for (int i = TID_; i < 4096; i += NTHREADS) dstl[i] = src[i];
        __syncthreads();
    }
    const LAS float* wbase = (const LAS float*)F.lds + lane * 64;
    for (int m = gw; m < M; m += NGW) { const int b = m / T, t = m % T, r = t < CTXL ? 8 : b;
        if (l == NL - 1 && t < CTXL) continue;
        const float* md = MOD + (size_t)(l * 9 + r) * 6144;
        f32x4 x[4], y[4], h[4];
#pragma unroll
        for (int j = 0; j < 4; ++j) { y[j] = *(const f32x4*)(Y + (size_t)m * 1024 + 256 * j + 4 * lane); x[j] = *(const f32x4*)(X + (size_t)m * 1024 + 256 * j + 4 * lane); }
        const float rinv = rsqrtf(row_ss(y) * (1.f / 1024.f) + 1e-6f);
#pragma unroll
        for (int j = 0; j < 4; ++j) { const int e = 256 * j + 4 * lane;
            const f32x4 gg = *(const f32x4*)(F.in[I_GPOSTMIX] + l * 1024 + e), gt = *(const f32x4*)(md + 2 * 1024 + e);
            x[j] = x[j] + gt * (y[j] * rinv * gg); *(f32x4*)(Xs + (size_t)m * 1024 + e) = x[j]; }
        const float rinv2 = rsqrtf(row_ss(x) * (1.f / 1024.f) + 1e-6f);
        mod_store(x, rinv2, F.in[I_GPREFFN] + l * 1024, md + 3 * 1024, md + 4 * 1024, H2 + (size_t)m * 1024, lane, h);
        float lg[16];
#pragma unroll
        for (int k = 0; k < 16; ++k) lg[k] = 0.f;
#pragma unroll
        for (int j = 0; j < 4; ++j)
#pragma unroll
            for (int c = 0; c < 4; ++c) { const LAS float* w = wbase + j * 4096 + c * 16; const float hv = h[j][c];
#pragma unroll
                for (int q = 0; q < 4; ++q) { const f32x4 wv = *(const LAS f32x4*)(w + 4 * q); lg[4 * q + 0] += hv * wv[0]; lg[4 * q + 1] += hv * wv[1]; lg[4 * q + 2] += hv * wv[2]; lg[4 * q + 3] += hv * wv[3]; }
                asm volatile("" ::: "memory"); }
        float mx = -1e30f;
#pragma unroll
        for (int k = 0; k < 16; ++k) { lg[k] = wave_sum(lg[k]); mx = fmaxf(mx, lg[k]); }
        float den = 0.f, mine = 0.f;
#pragma unroll
        for (int k = 0; k < 16; ++k) { const float ex = expf(lg[k] - mx); den += ex; if ((lane & 15) == k) mine = ex; }
        if (lane < 16) { AFF[(size_t)m * 16 + lane] = mine / den; INV[(size_t)m * 16 + lane] = -1; }
    }
}
__device__ __forceinline__ void phase_row2(Frame& F, int l, bool dry = false) {
    const int gw = F.vcu * NWAVES + F.wave, NGW = F.G * NWAVES, lane = LANE_;
    const float* X = WSP(float, WS_X); const bf16* OUTE = WSP(bf16, WS_OUTE); const float* MOD = WSP(float, WS_MOD);
    float* Xs = dry ? WSP(float, WS_XE) : WSP(float, WS_X); bf16* H = dry ? WSP(bf16, WS_XE) : WSP(bf16, WS_H); float* outp = dry ? WSP(float, WS_XE) : F.out;
    const int* INV = WSP(int, WS_INV);
    const bool last = (l == NL - 1);
    for (int m = gw; m < M; m += NGW) { const int b = m / T, t = m % T, r = t < CTXL ? 8 : b;
        if (last && t < CTXL) continue;
        const float* md = MOD + (size_t)(l * 9 + r) * 6144;
        f32x4 x[4], f[4], h[4];
#pragma unroll
        for (int j = 0; j < 4; ++j) { x[j] = *(const f32x4*)(X + (size_t)m * 1024 + 256 * j + 4 * lane); f[j] = (f32x4){0.f, 0.f, 0.f, 0.f}; }
        const int invl = INV[(size_t)m * 16 + (lane & 15)];
        for (int e = 0; e < 16; ++e) { const int rr = __shfl(invl, e);
            if (rr >= 0) {
#pragma unroll
                for (int j = 0; j < 4; ++j) { const u32x2 w = *(const u32x2*)(OUTE + (size_t)rr * 1024 + 256 * j + 4 * lane);
                    f[j][0] += bflo(w.x); f[j][1] += bfhi(w.x); f[j][2] += bflo(w.y); f[j][3] += bfhi(w.y); } } }
        const float rinv = rsqrtf(row_ss(f) * (1.f / 1024.f) + 1e-6f);
#pragma unroll
        for (int j = 0; j < 4; ++j) { const int e = 256 * j + 4 * lane;
            const f32x4 gg = *(const f32x4*)(F.in[I_GPOSTFFN] + l * 1024 + e), gt = *(const f32x4*)(md + 5 * 1024 + e);
            x[j] = x[j] + gt * (f[j] * rinv * gg);
            if (last) *(f32x4*)(outp + ((size_t)b * SEQ + (t - CTXL)) * 1024 + e) = x[j];
            else *(f32x4*)(Xs + (size_t)m * 1024 + e) = x[j]; }
        if (!last) {
            const float rinv2 = rsqrtf(row_ss(x) * (1.f / 1024.f) + 1e-6f);
            const float* md2 = MOD + (size_t)((l + 1) * 9 + r) * 6144;
            mod_store(x, rinv2, F.in[I_GPREMIX] + (l + 1) * 1024, md2, md2 + 1024, H + (size_t)m * 1024, lane, h);
        }
    }
}

__device__ __forceinline__ void phase_qkprep(Frame& F, int l, bool dry = false) {
    const int gw = F.vcu * NWAVES + F.wave, NGW = F.G * NWAVES, lane = LANE_;
    bf16* QKV = WSP(bf16, WS_QKV);
    const float qg = F.in[I_QGAIN][l * 64 + lane], kg = F.in[I_KGAIN][l * 64 + lane];
    const int i16 = lane & 15; const bool second = (lane & 16) != 0, colseg = (lane & 32) != 0;
    const float inv = exp2f(-(float)i16 * (13.287712379549449f / 16.f));
    for (int it = gw; it < M * 10; it += NGW) { const int m = it / 10, s = it % 10, t = m % T;
        if (l == NL - 1 && t < CTXL && s < 8) continue;
        bf16* p = QKV + (size_t)m * 1536 + (s < 8 ? s * 64 : 512 + (s - 8) * 64) + lane;
        const float x = bf2f(*p);
        const float ss = wave_sum(x * x);
        float y = x * rsqrtf(ss * (1.f / 64.f) + 1e-6f) * (s < 8 ? qg : kg);
        if (t >= CTXL) { const int pos = t - CTXL; const float ang = (float)(colseg ? (pos & 63) : (pos >> 6)) * inv;
            const float cs = cosf(ang), sn = sinf(ang); const float other = __shfl_xor(y, 16);
            y = second ? (y * cs + other * sn) : (y * cs - other * sn); }
        if (s < 8) y *= C2;
        if (dry) p = WSP(bf16, WS_YD) + (p - QKV);
        *p = (bf16)f2bf(y);
    }
}
#include <hip/hip_bf16.h>
#include <cmath>
namespace attn_body {
using bf16=__hip_bfloat16;
using bf16x8=__attribute__((ext_vector_type(8)))short;
using s16x4=__attribute__((ext_vector_type(4)))short;
using f32x16=__attribute__((ext_vector_type(16)))float;
using u32x4=__attribute__((ext_vector_type(4)))unsigned;
constexpr int D=64,QP=1536,OP=1024;
constexpr int NW=8,QBLK=32,QB=QBLK*NW,KVBLK=64;
__device__ __forceinline__ int crow(int r,int hi){return (r&3)+8*(r>>2)+4*hi;}
#define SBAR() __builtin_amdgcn_sched_barrier(0)
constexpr int NSLOT=3, SLOTB=8192;
constexpr int LDS_K=0, LDS_V=NSLOT*SLOTB, LDS_WS=2*NSLOT*SLOTB, LDS_OST=LDS_WS+NW*64*4, LDS_RPB=LDS_OST+NW*4096, LDS_BYTES=LDS_RPB+3072;
constexpr float C2=0.125f*1.4426950408889634f;
__device__ __forceinline__ void glds16(const void*gsrc,unsigned lds_dst){unsigned keep;
  asm volatile("s_mov_b32 %0, m0\n\ts_mov_b32 m0, %2\n\ts_nop 0\n\tglobal_load_lds_dwordx4 %1, off\n\ts_mov_b32 m0, %0":"=&s"(keep):"v"(gsrc),"s"(lds_dst):"memory");}
__device__ __forceinline__ float max3f(float a,float b,float c){float r;asm("v_max3_f32 %0, %1, %2, %3":"=v"(r):"v"(a),"v"(b),"v"(c));return r;}
__device__ __forceinline__ float max2f(float a,float b){float r;asm("v_max_f32_e32 %0, %1, %2":"=v"(r):"v"(a),"v"(b));return r;}
__device__ __forceinline__ float fadd_s(float a,float b){float r;asm("v_add_f32_e32 %0, %1, %2":"=v"(r):"v"(a),"v"(b));return r;}
__device__ __forceinline__ float fsub_s(float a,float b){float r;asm("v_sub_f32_e32 %0, %1, %2":"=v"(r):"v"(a),"v"(b));return r;}
typedef float f32x2_t __attribute__((ext_vector_type(2))); typedef __bf16 bf16x2_t __attribute__((ext_vector_type(2)));
__device__ __forceinline__ unsigned cvtpk_s(float lo,float hi){f32x2_t v={lo,hi};bf16x2_t b=__builtin_convertvector(v,bf16x2_t);return __builtin_bit_cast(unsigned,b);}
#define WAIT_BAR(N) asm volatile("s_waitcnt vmcnt(" #N ") lgkmcnt(0)\n\ts_barrier":::"memory")

__device__ __forceinline__ void qkt(f32x16&p0,f32x16&p1,const char*Kslot,const bf16x8*qr,const f32x16&negm,int r32,int hi){
  const char*kb=Kslot+hi*1024+r32*16;
  #pragma unroll
  for(int d0=0;d0<4;++d0){
    const bf16x8 b0=*reinterpret_cast<const bf16x8*>(kb+d0*2048);
    const bf16x8 b1=*reinterpret_cast<const bf16x8*>(kb+d0*2048+512);
    if(d0==0){p0=__builtin_amdgcn_mfma_f32_32x32x16_bf16(b0,qr[0],negm,0,0,0);p1=__builtin_amdgcn_mfma_f32_32x32x16_bf16(b1,qr[0],negm,0,0,0);}
    else{p0=__builtin_amdgcn_mfma_f32_32x32x16_bf16(b0,qr[d0],p0,0,0,0);p1=__builtin_amdgcn_mfma_f32_32x32x16_bf16(b1,qr[d0],p1,0,0,0);}}
}
typedef __attribute__((address_space(3))) const char* lds_cptr;
typedef short v4i16_t __attribute__((ext_vector_type(4)));
__device__ __forceinline__ void kload8(bf16x8*kf,lds_cptr kp){
  kf[0]=*(const __attribute__((address_space(3))) bf16x8*)(kp);      kf[1]=*(const __attribute__((address_space(3))) bf16x8*)(kp+512);
  kf[2]=*(const __attribute__((address_space(3))) bf16x8*)(kp+2048); kf[3]=*(const __attribute__((address_space(3))) bf16x8*)(kp+2560);
  kf[4]=*(const __attribute__((address_space(3))) bf16x8*)(kp+4096); kf[5]=*(const __attribute__((address_space(3))) bf16x8*)(kp+4608);
  kf[6]=*(const __attribute__((address_space(3))) bf16x8*)(kp+6144); kf[7]=*(const __attribute__((address_space(3))) bf16x8*)(kp+6656);
}
__device__ __forceinline__ void kload2(bf16x8*kf,lds_cptr kp,int j){ kf[2*j]=*(const __attribute__((address_space(3))) bf16x8*)(kp+j*2048); kf[2*j+1]=*(const __attribute__((address_space(3))) bf16x8*)(kp+j*2048+512); }
__device__ __forceinline__ s16x4 vtr(lds_cptr p){ return __builtin_bit_cast(s16x4,__builtin_amdgcn_ds_read_tr16_b64_v4i16((__attribute__((address_space(3))) v4i16_t*)p)); }
__device__ __forceinline__ float rowmax(const f32x16&p0,const f32x16&p1){
  float a=max3f(p0[0],p0[1],p1[0]),b=max3f(p0[2],p0[3],p1[1]);a=max3f(a,p1[2],p1[3]);
  #pragma unroll
  for(int r=4;r<16;r+=4){a=max3f(a,p0[r],p0[r+1]);b=max3f(b,p0[r+2],p0[r+3]);a=max3f(a,p1[r],p1[r+1]);b=max3f(b,p1[r+2],p1[r+3]);}
  const float m=max2f(a,b);
  auto rr=__builtin_amdgcn_permlane32_swap(__float_as_uint(m),__float_as_uint(m),false,false);
  return max2f(__uint_as_float(rr[0]),__uint_as_float(rr[1]));
}
__device__ __forceinline__ void pv(f32x16*o,int vb,bf16x8 pa0,bf16x8 pa1,bf16x8 pa2,bf16x8 pa3){
  #pragma unroll
  for(int d0=0;d0<2;++d0){s16x4 lo[4],hi[4];
    #pragma unroll
    for(int ks=0;ks<4;++ks){
      asm volatile("ds_read_b64_tr_b16 %0,%1 offset:%c2":"=&v"(lo[ks]):"v"(vb),"i"(d0*4096+ks*1024):"memory");
      asm volatile("ds_read_b64_tr_b16 %0,%1 offset:%c2":"=&v"(hi[ks]):"v"(vb),"i"(d0*4096+ks*1024+512):"memory");}
    asm volatile("s_waitcnt lgkmcnt(0)":::"memory");SBAR();
    #define PK(k) (bf16x8){lo[k][0],lo[k][1],lo[k][2],lo[k][3],hi[k][0],hi[k][1],hi[k][2],hi[k][3]}
    o[d0]=__builtin_amdgcn_mfma_f32_32x32x16_bf16(pa0,PK(0),o[d0],0,0,0);
    o[d0]=__builtin_amdgcn_mfma_f32_32x32x16_bf16(pa1,PK(1),o[d0],0,0,0);
    o[d0]=__builtin_amdgcn_mfma_f32_32x32x16_bf16(pa2,PK(2),o[d0],0,0,0);
    o[d0]=__builtin_amdgcn_mfma_f32_32x32x16_bf16(pa3,PK(3),o[d0],0,0,0);
    #undef PK
  }
}

#ifndef ATTN_STORE16
#define ATTN_STORE16(p,v) (*(u32x4*)(p)=(v))
#endif
template<int THRL,bool WIN> __device__ __forceinline__ void attn_unit(const bf16*Qw0,const bf16*__restrict__ Kh,const bf16*__restrict__ Vh,bf16*Ow0,const int NT,const int toff,const int rb,const int rs0,const float*rpbh,char*shm){
  int tid_=threadIdx.x; asm volatile("":"+v"(tid_));
  const int tid=tid_,lane=tid&63,r32=lane&31,hi=lane>>5; const int wid=__builtin_amdgcn_readfirstlane(tid>>6);
  const bf16*Qw=Qw0+(long)(wid*QBLK)*QP;
  const unsigned lds0=(unsigned)(uintptr_t)shm;
  float*wsf=(float*)(shm+LDS_WS)+wid*64;
  const bf16*ksrc=Kh+(long)lane*QP+wid*8;
  const bf16*vsrc=Vh+(long)(16*(wid&3)+(lane>>2))*QP+(wid>>2)*32+(lane&3)*8;
  const unsigned kdst=lds0+LDS_K+wid*1024, vdst=lds0+LDS_V+wid*1024;
  #define TROW(t) ((long)(((t)+(((t)>=4)?toff:0))*KVBLK)*QP)
  #define DMA_K(t,slot) glds16(ksrc+TROW(t),(unsigned)__builtin_amdgcn_readfirstlane(kdst+(slot)))
  #define DMA_V(t,slot) glds16(vsrc+TROW(t),(unsigned)__builtin_amdgcn_readfirstlane(vdst+(slot)))
  const int vb0=(int)(lds0+LDS_V)+((lane>>4)&1)*32+(lane&3)*8+(4*hi+((lane&15)>>2))*64;
  const char*Kbase=shm+LDS_K; bf16x8 kf[8];
  const lds_cptr shm3=(lds_cptr)shm; const lds_cptr kp0=shm3+LDS_K+hi*1024+r32*16; const lds_cptr vp0=shm3+LDS_V+((lane>>4)&1)*32+(lane&3)*8+(4*hi+((lane&15)>>2))*64;
  DMA_K(0,0);DMA_V(0,0);DMA_K(1,SLOTB);
  bf16x8 qr[4];
  #pragma unroll
  for(int d0=0;d0<4;++d0)qr[d0]=*reinterpret_cast<const bf16x8*>(&Qw[(long)r32*QP+d0*16+hi*8]);
  float mhat=0.f,l_reg=0.f;f32x16 o[2];o[0]=f32x16{};o[1]=f32x16{};f32x16 negm=f32x16{};asm volatile("":"+v"(negm));
  const int gr=4*rb+(wid>>1), gc=(wid&1)*32+r32, rsq=min(max(gr-4,0),24), csq=min(max(gc-8,0),48);
  const float*rpbl=(const float*)(shm+LDS_RPB+256)+(15-gc+4*hi);
  const int kcb=4*hi-csq;
  if(WIN){ for(int i_=tid;i_<15*31;i_+=512)((float*)(shm+LDS_RPB+256))[i_]=rpbh[i_]*1.4426950408889634f; }
  #define CMASK(P0,P1,t) do{ if(WIN && (t)>=4){ const int kr_=rs0+(t)-4; const bool rowok_=(kr_>=rsq)&&(kr_<rsq+8); \
      if(!rowok_){ _Pragma("unroll") for(int r=0;r<16;++r){P0[r]=-INFINITY;P1[r]=-INFINITY;} } \
      else { const float*bp_=rpbl+(kr_-gr+7)*31; \
        _Pragma("unroll") for(int r=0;r<16;++r){ const int o_=(r&3)+8*(r>>2); \
          const float b0_=bp_[o_], b1_=bp_[o_+32]; \
          P0[r]=((unsigned)(kcb+o_)<16u)?P0[r]+b0_:-INFINITY; P1[r]=((unsigned)(kcb+o_+32)<16u)?P1[r]+b1_:-INFINITY; } } } }while(0)
  bool resc=false;
  #define START(P0,P1) do{ const float rm=rowmax(P0,P1); resc=false; \
    { const float dl=rm; mhat=fadd_s(mhat,dl); \
      _Pragma("unroll") for(int r=0;r<16;++r){P0[r]=fsub_s(P0[r],dl);P1[r]=fsub_s(P1[r],dl);} \
      _Pragma("unroll") for(int r=0;r<16;++r)negm[r]=-mhat; asm volatile("":"+v"(negm)); } \
    _Pragma("unroll") for(int r=0;r<16;++r)P0[r]=__builtin_amdgcn_exp2f(P0[r]); }while(0)
  #define RESC() do{ if(resc){ asm volatile("s_waitcnt lgkmcnt(0)":::"memory"); \
      _Pragma("unroll") for(int d_=0;d_<2;++d_) _Pragma("unroll") for(int r=0;r<16;++r)o[d_][r]*=wsf[crow(r,hi)]; } }while(0)
  f32x16 pA0,pA1,pB0,pB1;
  int sl_prev=0,sl_cur=0,sl_next=SLOTB;
  #define ROT() do{sl_prev=sl_cur;sl_cur=sl_next;sl_next=(sl_next==(NSLOT-1)*SLOTB)?0:sl_next+SLOTB;}while(0)
  DMA_K(2,2*SLOTB);
  WAIT_BAR(3);
  qkt(pA0,pA1,Kbase,qr,negm,r32,hi);asm volatile("s_nop 15\n\ts_nop 7":"+v"(pA0),"+v"(pA1));CMASK(pA0,pA1,0);
  START(pA0,pA1);
  _Pragma("unroll") for(int r=0;r<16;++r)pA1[r]=__builtin_amdgcn_exp2f(pA1[r]);
  WAIT_BAR(0);
  DMA_K(3,0);DMA_V(1,SLOTB);
  ROT();
  kload8(kf,kp0+sl_cur);
  WAIT_BAR(2);
  s16x4 vlo[8],vhi[8]; u32x4 pw0,pw1,pw2,pw3;
  #define PKW(P,B) cvtpk_s(P[B],P[B+1])
  #define PAF(k) __builtin_bit_cast(bf16x8,pw##k)
  #define VFR(i) (bf16x8){vlo[i][0],vlo[i][1],vlo[i][2],vlo[i][3],vhi[i][0],vhi[i][1],vhi[i][2],vhi[i][3]}
  #define PIN(x) asm volatile("":"+v"(x))
  #define MX3(a,b,c) __builtin_fmaxf(__builtin_fmaxf((a),(b)),(c))
  #define GAPA(MF,A0,A1,A2,A3,W0,W1,PW) do{ MF; sacc+=A0; sacc+=A1; sacc+=A2; sacc+=A3; PIN(sacc); W0; W1; PIN(PW); SBAR(); }while(0)
  #define EX(v) __builtin_amdgcn_exp2f(v)
  #define GAPB(MF,X,B) do{ MF; X[B]=EX(X[B]); X[B+1]=EX(X[B+1]); X[B+2]=EX(X[B+2]); X[B+3]=EX(X[B+3]); PIN(X); SBAR(); }while(0)
  #define VRD(i) do{ vlo[i]=vtr(vp_+(((i)>>2)*4096+((i)&3)*1024)); vhi[i]=vtr(vp_+(((i)>>2)*4096+((i)&3)*1024+512)); }while(0)
  #define KRD(G,j) do{ if(G){ kload2(kf,kp0+sl_next,j); SBAR(); } }while(0)
  #define STEP(C0,C1,P0,P1,t,GK,GV,GL) do{ SBAR(); \
    const lds_cptr vp_=vp0+sl_prev; \
    VRD(0); SBAR(); float sacc=(P0[0]+P0[1]); \
    GAPA(C0=__builtin_amdgcn_mfma_f32_32x32x16_bf16(kf[0],qr[0],negm,0,0,0), P0[2],P0[3],P0[4],P0[5],     pw0[0]=PKW(P0,0), pw0[1]=PKW(P0,2), pw0); \
    VRD(4); SBAR(); GAPA(C1=__builtin_amdgcn_mfma_f32_32x32x16_bf16(kf[1],qr[0],negm,0,0,0), P0[6],P0[7],P0[8],P0[9],     pw0[2]=PKW(P0,4), pw0[3]=PKW(P0,6), pw0); \
    VRD(1); SBAR(); GAPA(C0=__builtin_amdgcn_mfma_f32_32x32x16_bf16(kf[2],qr[1],C0,0,0,0),   P0[10],P0[11],P0[12],P0[13], pw1[0]=PKW(P0,8), pw1[1]=PKW(P0,10), pw1); \
    VRD(5); SBAR(); GAPA(C1=__builtin_amdgcn_mfma_f32_32x32x16_bf16(kf[3],qr[1],C1,0,0,0),   P0[14],P0[15],P1[0],P1[1],   pw1[2]=PKW(P0,12),pw1[3]=PKW(P0,14), pw1); \
    VRD(2); SBAR(); GAPA(C0=__builtin_amdgcn_mfma_f32_32x32x16_bf16(kf[4],qr[2],C0,0,0,0),   P1[2],P1[3],P1[4],P1[5],     pw2[0]=PKW(P1,0), pw2[1]=PKW(P1,2), pw2); \
    VRD(6); SBAR(); GAPA(C1=__builtin_amdgcn_mfma_f32_32x32x16_bf16(kf[5],qr[2],C1,0,0,0),   P1[6],P1[7],P1[8],P1[9],     pw2[2]=PKW(P1,4), pw2[3]=PKW(P1,6), pw2); \
    VRD(3); SBAR(); GAPA(C0=__builtin_amdgcn_mfma_f32_32x32x16_bf16(kf[6],qr[3],C0,0,0,0),   P1[10],P1[11],P1[12],P1[13], pw3[0]=PKW(P1,8), pw3[1]=PKW(P1,10), pw3); \
    VRD(7); SBAR(); GAPA(C1=__builtin_amdgcn_mfma_f32_32x32x16_bf16(kf[7],qr[3],C1,0,0,0),   P1[14],P1[15],0.f,0.f,       pw3[2]=PKW(P1,12),pw3[3]=PKW(P1,14), pw3); \
    l_reg+=sacc; \
    if(GK){DMA_K((t)+3,sl_cur);} if(GV){DMA_V((t)+1,sl_next);} \
    CMASK(C0,C1,t); \
    { float a=MX3(C0[0],C0[1],C1[0]),b=MX3(C0[2],C0[3],C1[1]); a=MX3(a,C1[2],C1[3]); \
      _Pragma("unroll") for(int r=4;r<16;r+=4){a=MX3(a,C0[r],C0[r+1]);b=MX3(b,C0[r+2],C0[r+3]);a=MX3(a,C1[r],C1[r+1]);b=MX3(b,C1[r+2],C1[r+3]);} \
      float rm=__builtin_fmaxf(a,b); { auto rr=__builtin_amdgcn_permlane32_swap(__float_as_uint(rm),__float_as_uint(rm),false,false); rm=__builtin_fmaxf(__uint_as_float(rr[0]),__uint_as_float(rr[1])); } \
      resc=false; \
      if(__builtin_expect(__any(rm>(float)THRL),0)){ const float dl=__builtin_fmaxf(rm,0.f); mhat+=dl; \
        _Pragma("unroll") for(int r=0;r<16;++r){C0[r]-=dl;C1[r]-=dl;} \
        _Pragma("unroll") for(int r=0;r<16;++r)negm[r]=-mhat; asm volatile("":"+v"(negm)); \
        const float f=__builtin_amdgcn_exp2f(-dl); l_reg*=f; if(hi==0)wsf[r32]=f; resc=true; } } \
    SBAR(); \
    GAPB(o[0]=__builtin_amdgcn_mfma_f32_32x32x16_bf16(PAF(0),VFR(0),o[0],0,0,0), C0,0); \
    GAPB(o[1]=__builtin_amdgcn_mfma_f32_32x32x16_bf16(PAF(0),VFR(4),o[1],0,0,0), C0,4); \
    KRD(GL,0); GAPB(o[0]=__builtin_amdgcn_mfma_f32_32x32x16_bf16(PAF(1),VFR(1),o[0],0,0,0), C0,8); \
    KRD(GL,1); GAPB(o[1]=__builtin_amdgcn_mfma_f32_32x32x16_bf16(PAF(1),VFR(5),o[1],0,0,0), C0,12); \
    KRD(GL,2); GAPB(o[0]=__builtin_amdgcn_mfma_f32_32x32x16_bf16(PAF(2),VFR(2),o[0],0,0,0), C1,0); \
    KRD(GL,3); GAPB(o[1]=__builtin_amdgcn_mfma_f32_32x32x16_bf16(PAF(2),VFR(6),o[1],0,0,0), C1,4); \
    GAPB(o[0]=__builtin_amdgcn_mfma_f32_32x32x16_bf16(PAF(3),VFR(3),o[0],0,0,0), C1,8); \
    GAPB(o[1]=__builtin_amdgcn_mfma_f32_32x32x16_bf16(PAF(3),VFR(7),o[1],0,0,0), C1,12); \
    }while(0)
  int t=1;
  for(;t+5<NT;t+=2){
    STEP(pB0,pB1,pA0,pA1,t,true,true,true);     WAIT_BAR(2); RESC(); ROT();
    STEP(pA0,pA1,pB0,pB1,t+1,true,true,true);   WAIT_BAR(2); RESC(); ROT();
  }
  #define ENDW(tt) do{ if((tt)+3<NT){WAIT_BAR(2);} else if((tt)+2<NT){WAIT_BAR(1);} else {WAIT_BAR(0);} }while(0)
  for(;t+1<NT;t+=2){
    STEP(pB0,pB1,pA0,pA1,t,(t+3<NT),(t+1<NT),(t+1<NT));       ENDW(t);   RESC(); ROT();
    STEP(pA0,pA1,pB0,pB1,t+1,(t+4<NT),(t+2<NT),(t+2<NT));     ENDW(t+1); RESC(); ROT();
  }
  STEP(pB0,pB1,pA0,pA1,NT-1,false,false,false); RESC();
  { float sacc=pB0[0]+pB0[1]; _Pragma("unroll") for(int r=2;r<16;++r)sacc+=pB0[r]; _Pragma("unroll") for(int r=0;r<16;++r)sacc+=pB1[r]; l_reg+=sacc;
    pw0=(u32x4){PKW(pB0,0),PKW(pB0,2),PKW(pB0,4),PKW(pB0,6)};pw1=(u32x4){PKW(pB0,8),PKW(pB0,10),PKW(pB0,12),PKW(pB0,14)};pw2=(u32x4){PKW(pB1,0),PKW(pB1,2),PKW(pB1,4),PKW(pB1,6)};pw3=(u32x4){PKW(pB1,8),PKW(pB1,10),PKW(pB1,12),PKW(pB1,14)};
    SBAR(); pv(o,vb0+sl_cur,PAF(0),PAF(1),PAF(2),PAF(3)); }
  #undef PKW
  #undef PAF
  #undef VFR
  #undef PIN
  #undef MX3
  #undef GAPA
  #undef GAPB
  #undef EX
  #undef VRD
  #undef KRD
  #undef STEP
  #undef ENDW
  {auto rr=__builtin_amdgcn_permlane32_swap(__float_as_uint(l_reg),__float_as_uint(l_reg),false,false);l_reg=__uint_as_float(rr[0])+__uint_as_float(rr[1]);}
  if(hi==0)wsf[32+r32]=l_reg;asm volatile("s_waitcnt lgkmcnt(0)":::"memory");
  float rli[16];
  #pragma unroll
  for(int r=0;r<16;++r)rli[r]=__builtin_amdgcn_rcpf(wsf[32+crow(r,hi)]);
  bf16*Ow=Ow0+(long)(wid*QBLK)*OP;
  { bf16*stg=(bf16*)(shm+LDS_OST)+wid*2048;
    #pragma unroll
    for(int r=0;r<16;++r){const int orow=crow(r,hi);
      #pragma unroll
      for(int d0=0;d0<2;++d0)stg[orow*64+d0*32+r32]=__float2bfloat16(o[d0][r]*rli[r]);}
    asm volatile("s_waitcnt lgkmcnt(0)":::"memory");
    #pragma unroll
    for(int i=0;i<4;++i){const int row=i*8+(lane>>3),ch=lane&7; const u32x4 v=*(const u32x4*)(stg+row*64+ch*8); ATTN_STORE16(Ow+(long)row*OP+ch*8,v);} }
  asm volatile("s_waitcnt lgkmcnt(0)\n\ts_barrier":::"memory");
  #undef DMA_K
  #undef TROW
  #undef DMA_V
  #undef CMASK
  #undef START
  #undef RESC
  #undef ROT
}
constexpr int ATTN_LDS_BYTES=LDS_BYTES;
#undef SBAR
#undef WAIT_BAR
}

constexpr int SC_TC = 16, SC_STEP = 6 * 64, SC_BUF = SC_TC * SC_STEP;
constexpr int SC_YOFF = 2 * SC_BUF, SC_DUMMY = SC_YOFF + 2 * SC_TC * 64;
typedef float f32x2 __attribute__((ext_vector_type(2)));
__device__ __forceinline__ int scan_tok(int p, int dir) { return p < CTXL ? (dir ? CTXL - 1 - p : p) : (dir ? (T + CTXL - 1) - p : p); }
struct ScanVec { f32x4 r0, r1, w0, w1, k0, k1, a0, a1, b0, b1; float vi; };
__device__ __forceinline__ void scan_ld(ScanVec& V, const LAS float* vec, int jc, int i) {
    V.r0 = *(const LAS f32x4*)(vec + 8 * jc); V.r1 = *(const LAS f32x4*)(vec + 8 * jc + 4);
    V.w0 = *(const LAS f32x4*)(vec + 64 + 8 * jc); V.w1 = *(const LAS f32x4*)(vec + 64 + 8 * jc + 4);
    V.k0 = *(const LAS f32x4*)(vec + 128 + 8 * jc); V.k1 = *(const LAS f32x4*)(vec + 128 + 8 * jc + 4);
    V.vi = vec[192 + i];
    V.a0 = *(const LAS f32x4*)(vec + 256 + 8 * jc); V.a1 = *(const LAS f32x4*)(vec + 256 + 8 * jc + 4);
    V.b0 = *(const LAS f32x4*)(vec + 320 + 8 * jc); V.b1 = *(const LAS f32x4*)(vec + 320 + 8 * jc + 4);
}
__device__ __forceinline__ float dot8(const f32x4 s0, const f32x4 s1, const f32x4 x0, const f32x4 x1) {
    const f32x4 p = s0 * x0 + s1 * x1;
    return (p[0] + p[1]) + (p[2] + p[3]);
}
__device__ __forceinline__ void scan_chain(Frame& F, int chain, int half, int l) {
    const int b = chain >> 3, h = (chain >> 1) & 3, dir = chain & 1;
    int tid_ = threadIdx.x; asm volatile("" : "+v"(tid_));
    const int tid = tid_, lane = tid & 63, wave = F.wave, jc = lane & 7, il = 8 * (wave & 3) + (lane >> 3), i = 32 * half + il;
    const bool comp = wave < 4; const int hw = wave & 3, ht = tid & 255;
    LAS float* buf = (LAS float*)F.lds;
    const float* R32 = WSP(float, WS_R32); const float* DEC = WSP(float, WS_DEC) + (size_t)dir * M * 256; const float* ASIG = WSP(float, WS_ASIG) + (size_t)dir * M * 256;
    float* YD = WSP(float, WS_YD) + (size_t)dir * M * 256;
    const float kkw = F.in[I_KK][l * 256 + h * 64 + lane], kaw = F.in[I_KA][l * 256 + h * 64 + lane];
    f32x4 S0 = (f32x4){0.f, 0.f, 0.f, 0.f}, S1 = S0;
    float pr[4][5];
    constexpr int NCH = T / SC_TC;
    const int ywr = (jc == 0) ? il : (SC_DUMMY - SC_YOFF) + ht;
#define SC_LOAD(c) do { _Pragma("unroll") for (int s4 = 0; s4 < 4; ++s4) { const int p = (c) * SC_TC + 4 * hw + s4; const size_t m = (size_t)b * T + scan_tok(p, dir); \
        pr[s4][0] = R32[m * 768 + h * 64 + lane]; pr[s4][1] = R32[m * 768 + 256 + h * 64 + lane]; pr[s4][2] = R32[m * 768 + 512 + h * 64 + lane]; \
        pr[s4][3] = DEC[m * 256 + h * 64 + lane]; pr[s4][4] = ASIG[m * 256 + h * 64 + lane]; } } while (0)
#define SC_PREP(bi) do { _Pragma("unroll") for (int s4 = 0; s4 < 4; ++s4) { const float r_ = pr[s4][0], kb_ = pr[s4][1], v_ = pr[s4][2], de_ = pr[s4][3], as_ = pr[s4][4]; \
        float kk_ = kb_ * kkw; kk_ = kk_ * __builtin_amdgcn_rsqf(fmaxf(wave_sum(kk_ * kk_), 1e-24f)); const float kd_ = kb_ * (1.f + (as_ - 1.f) * kaw); \
        LAS float* o_ = buf + (bi) * SC_BUF + (4 * hw + s4) * SC_STEP + lane; o_[0] = r_; o_[64] = de_; o_[128] = kd_; o_[192] = v_; o_[256] = -kk_; o_[320] = kk_ * as_; } } while (0)
#define SC_FLUSH(c) do { const int s_ = ht >> 4, i2_ = 2 * (ht & 15); \
        const f32x2 yv_ = *(const LAS f32x2*)(buf + SC_YOFF + ((c) & 1) * SC_TC * 32 + s_ * 32 + i2_); \
        *(f32x2*)(YD + ((size_t)b * T + scan_tok((c) * SC_TC + s_, dir)) * 256 + h * 64 + 32 * half + i2_) = yv_; } while (0)
    if (!comp) { SC_LOAD(0); SC_PREP(0); SC_LOAD(1); }
    for (int c = 0; c < NCH; ++c) {
        __syncthreads();
        if (!comp) {
            if (c > 0) SC_FLUSH(c - 1);
            if (c + 1 < NCH) SC_PREP((c + 1) & 1);
            if (c + 2 < NCH) SC_LOAD(c + 2);
        } else {
            const LAS float* bc = buf + (c & 1) * SC_BUF;
            LAS float* yst = buf + SC_YOFF + (c & 1) * SC_TC * 32 + ywr;
            ScanVec V; scan_ld(V, bc, jc, i);
#pragma unroll
            for (int s = 0; s < SC_TC; ++s) {
                ScanVec N = V;
                if (s + 1 < SC_TC) scan_ld(N, bc + (s + 1) * SC_STEP, jc, i);
                const float sa = red8(dot8(S0, S1, V.a0, V.a1));
                const f32x4 u0 = S0 * V.w0 + V.k0 * V.vi, u1 = S1 * V.w1 + V.k1 * V.vi;
                S0 = u0 + V.b0 * sa; S1 = u1 + V.b1 * sa;
                const float y = red8(dot8(S0, S1, V.r0, V.r1));
                yst[(jc == 0) ? s * 32 : 0] = y;
                V = N;
            }
        }
    }
    __syncthreads();
    if (!comp) SC_FLUSH(NCH - 1);
#undef SC_LOAD
#undef SC_PREP
#undef SC_FLUSH
    __syncthreads();
}

#if GOLD_ATTN
__device__ __forceinline__ void attn_ref_unit(Frame& F, int mode, int qrow0, int qcol, int krow0, int nkeys, int kcol, int vcol, int ocol,
                                              int rb, const float* rpbh) {
    const int tid = TID_, q = tid & 255, dh = tid >> 8;
    const bf16* QKV = WSP(bf16, WS_QKV); bf16* O = WSP(bf16, WS_O);
    const int gr = 4 * rb + (q >> 6), gc = q & 63;
    const size_t qrow = (size_t)qrow0 + q;
    float qv[64], o[32];
#pragma unroll
    for (int d8 = 0; d8 < 8; ++d8) { const u32x4 w = *(const u32x4*)(QKV + qrow * 1536 + qcol + 8 * d8);
        qv[8 * d8 + 0] = bflo(w.x); qv[8 * d8 + 1] = bfhi(w.x); qv[8 * d8 + 2] = bflo(w.y); qv[8 * d8 + 3] = bfhi(w.y);
        qv[8 * d8 + 4] = bflo(w.z); qv[8 * d8 + 5] = bfhi(w.z); qv[8 * d8 + 6] = bflo(w.w); qv[8 * d8 + 7] = bfhi(w.w); }
#pragma unroll
    for (int d = 0; d < 32; ++d) o[d] = 0.f;
    float mrun = -1e30f, lrun = 0.f;
    const int kend = mode == 0 ? nkeys : 128 + CTXL;
    const int rs = min(max(gr - 4, 0), 32 - 8), cs = min(max(gc - 8, 0), 64 - 16);
    for (int kk = 0; kk < kend; ++kk) {
        size_t krow; float bias = 0.f;
        if (mode == 0) krow = (size_t)krow0 + kk;
        else if (kk < 128) { const int kr = rs + (kk >> 4), kc = cs + (kk & 15); krow = (size_t)krow0 + CTXL + kr * 64 + kc; bias = rpbh[(kr - gr + 7) * 31 + (kc - gc + 15)] * LOG2E; }
        else krow = (size_t)krow0 + (kk - 128);
        float s = bias;
#pragma unroll
        for (int d8 = 0; d8 < 8; ++d8) { const u32x4 w = *(const u32x4*)(QKV + krow * 1536 + kcol + 8 * d8);
            s += qv[8 * d8 + 0] * bflo(w.x) + qv[8 * d8 + 1] * bfhi(w.x) + qv[8 * d8 + 2] * bflo(w.y) + qv[8 * d8 + 3] * bfhi(w.y)
               + qv[8 * d8 + 4] * bflo(w.z) + qv[8 * d8 + 5] * bfhi(w.z) + qv[8 * d8 + 6] * bflo(w.w) + qv[8 * d8 + 7] * bfhi(w.w); }
        const float mn = fmaxf(mrun, s), al = exp2f(mrun - mn), p = exp2f(s - mn);
        lrun = lrun * al + p; mrun = mn;
#pragma unroll
        for (int d8 = 0; d8 < 4; ++d8) { const u32x4 w = *(const u32x4*)(QKV + krow * 1536 + vcol + 32 * dh + 8 * d8);
            o[8 * d8 + 0] = o[8 * d8 + 0] * al + p * bflo(w.x); o[8 * d8 + 1] = o[8 * d8 + 1] * al + p * bfhi(w.x);
            o[8 * d8 + 2] = o[8 * d8 + 2] * al + p * bflo(w.y); o[8 * d8 + 3] = o[8 * d8 + 3] * al + p * bfhi(w.y);
            o[8 * d8 + 4] = o[8 * d8 + 4] * al + p * bflo(w.z); o[8 * d8 + 5] = o[8 * d8 + 5] * al + p * bfhi(w.z);
            o[8 * d8 + 6] = o[8 * d8 + 6] * al + p * bflo(w.w); o[8 * d8 + 7] = o[8 * d8 + 7] * al + p * bfhi(w.w); }
    }
    const float li = 1.f / lrun;
#pragma unroll
    for (int d8 = 0; d8 < 4; ++d8) { u32x4 w;
        w.x = pk2(o[8 * d8 + 0] * li, o[8 * d8 + 1] * li); w.y = pk2(o[8 * d8 + 2] * li, o[8 * d8 + 3] * li);
        w.z = pk2(o[8 * d8 + 4] * li, o[8 * d8 + 5] * li); w.w = pk2(o[8 * d8 + 6] * li, o[8 * d8 + 7] * li);
        *(u32x4*)(O + qrow * 1024 + ocol + 32 * dh + 8 * d8) = w; }
}
#endif
__device__ __forceinline__ void attn_item(Frame& F, int item, int l) {
    const float* rpb = F.in[I_RPB] + (size_t)l * 4 * 15 * 31;
    int mode = 0, qrow0, qcol, krow0, nkeys, kcol, vcol, ocol, rb = 0;
    if (item < 512) { const int b = item >> 6, h = (item >> 3) & 7, qb = item & 7;
        qrow0 = b * T + CTXL + qb * 256; qcol = h * 64; krow0 = b * T; nkeys = T; kcol = 512 + (h >> 2) * 64; vcol = 640 + (h >> 2) * 64; ocol = h * 64; }
    else if (item < 768) { const int it = item - 512, b = it >> 5, h = (it >> 3) & 3; rb = it & 7; mode = 1;
        qrow0 = b * T + CTXL + rb * 256; qcol = 768 + h * 64; krow0 = b * T; nkeys = 0; kcol = 1024 + h * 64; vcol = 1280 + h * 64; ocol = 768 + h * 64; rpb += h * 15 * 31; }
    else if (item < 832) { const int it = item - 768, b = it >> 3, h = it & 7;
        qrow0 = b * T; qcol = h * 64; krow0 = b * T; nkeys = CTXL; kcol = 512 + (h >> 2) * 64; vcol = 640 + (h >> 2) * 64; ocol = h * 64; }
    else { const int it = item - 832, b = it >> 2, h = it & 3;
        qrow0 = b * T; qcol = 768 + h * 64; krow0 = b * T; nkeys = CTXL; kcol = 1024 + h * 64; vcol = 1280 + h * 64; ocol = 768 + h * 64; }
#if GOLD_ATTN
    attn_ref_unit(F, mode, qrow0, qcol, krow0, nkeys, kcol, vcol, ocol, rb, rpb);
#else
    const attn_body::bf16* QKV = (const attn_body::bf16*)WSP(bf16, WS_QKV); attn_body::bf16* O = (attn_body::bf16*)WSP(bf16, WS_O);
    const attn_body::bf16* Qw0 = QKV + (size_t)qrow0 * 1536 + qcol; const attn_body::bf16* Kh = QKV + (size_t)krow0 * 1536 + kcol; const attn_body::bf16* Vh = QKV + (size_t)krow0 * 1536 + vcol;
    attn_body::bf16* Ow0 = O + (size_t)qrow0 * 1024 + ocol;
    if (mode == 0) attn_body::attn_unit<8, false>(Qw0, Kh, Vh, Ow0, nkeys >> 6, 0, 0, 0, rpb, (char*)F.lds);
    else { const int rs0 = min(max(4 * rb - 4, 0), 24); attn_body::attn_unit<8, true>(Qw0, Kh, Vh, Ow0, (rb == 0 || rb == 7) ? 12 : 16, rs0, rb, rs0, rpb, (char*)F.lds); }
#endif
}
__device__ __forceinline__ void phase_mixer(Frame& F, int l) {
    if (F.vcu < 128) scan_chain(F, F.vcu >> 1, F.vcu & 1, l);
    const int nattn = (l == NL - 1) ? 768 : 864, nitems = nattn + CVT_NBLK;
    for (;;) {
        if (TID_ == 0) F.MISC[16] = atomicAdd(F.ctl + CW_QUEUE + 64 * l, 1u);
        __syncthreads();
        const int item = (int)F.MISC[16];
        __syncthreads();
        if (item >= nitems) break;
        if (item < nattn) attn_item(F, item, l);
        else { cvt_moe_block(F, l, item - nattn); __syncthreads(); }
    }
}

__device__ __forceinline__ void phase_post(Frame& F, int l) {
    const int gw = F.vcu * NWAVES + F.wave, NGW = F.G * NWAVES, lane = LANE_;
    const float* R32 = WSP(float, WS_R32); const float* ASIG = WSP(float, WS_ASIG); const float* YD = WSP(float, WS_YD); const float* Gb = WSP(float, WS_G);
    bf16* O = WSP(bf16, WS_O);
    for (int it = gw; it < M * 4; it += NGW) { const int m = it >> 2, h = it & 3, t = m % T, ch = h * 64 + lane;
        if (l == NL - 1 && t < CTXL) continue;
        const float y = YD[(size_t)m * 256 + ch] + YD[((size_t)M + m) * 256 + ch];
        const float mu = wave_sum(y) * (1.f / 64.f); const float dv = y - mu; const float var = wave_sum(dv * dv) * (1.f / 64.f);
        float yn = dv * rsqrtf(var + 64e-5f) * F.in[I_LNXW][l * 256 + ch] + F.in[I_LNXB][l * 256 + ch];
        const float r = R32[(size_t)m * 768 + ch], kb = R32[(size_t)m * 768 + 256 + ch], v = R32[(size_t)m * 768 + 512 + ch];
        const float ka = F.in[I_KA][l * 256 + ch], rk = F.in[I_RK][l * 256 + ch];
        const float as0 = ASIG[(size_t)m * 256 + ch], as1 = ASIG[((size_t)M + m) * 256 + ch];
        const float kd0 = kb * (1.f + (as0 - 1.f) * ka), kd1 = kb * (1.f + (as1 - 1.f) * ka);
        const float bon = (wave_sum(r * kd0 * rk) + wave_sum(r * kd1 * rk)) * v;
        O[(size_t)m * 1024 + 512 + ch] = (bf16)f2bf((yn + bon) * Gb[(size_t)m * 256 + ch]);
    }
}

__device__ __forceinline__ void phase_topk(Frame& F, int l) {
    const int tid = TID_;
    LAS unsigned long long* keys = (LAS unsigned long long*)F.lds;
    const float* AFF = WSP(float, WS_AFF); int* INV = WSP(int, WS_INV); float* SELG = WSP(float, WS_SELG); int* SELT = WSP(int, WS_SELT);
    const bf16* H2 = WSP(bf16, WS_H2); bf16* XE = WSP(bf16, WS_XE);
    const int nitems = (l == NL - 1) ? 128 : 256;
    for (int it = F.vcu; it < nitems; it += F.G) {
        const int seg = it >> 7, be = it & 127, b = be >> 4, e = be & 15;
        const int n = seg ? CTXL : SEQ, cap = n / 8, mbase = b * T + (seg ? 0 : CTXL);
        const int rowbase = e * MEXP + (seg ? 2048 + b * 32 : b * 256);
        for (int i = tid; i < n; i += NTHREADS) keys[i] = ((unsigned long long)__float_as_uint(AFF[(size_t)(mbase + i) * 16 + e]) << 32) | (unsigned)(0xFFFFFFFFu - (unsigned)i);
        __syncthreads();
        for (int k = 2; k <= n; k <<= 1)
            for (int j = k >> 1; j > 0; j >>= 1) {
                for (int t = tid; t < (n >> 1); t += NTHREADS) { const int i = 2 * t - (t & (j - 1)), p = i + j; const bool desc = ((i & k) == 0);
                    const unsigned long long a = keys[i], bb = keys[p];
                    if ((a < bb) == desc) { keys[i] = bb; keys[p] = a; } }
                __syncthreads();
            }
        for (int s = tid; s < cap; s += NTHREADS) { const unsigned long long kv = keys[s]; const int idx = (int)(0xFFFFFFFFu - (unsigned)kv); const int m = mbase + idx;
            SELG[rowbase + s] = __uint_as_float((unsigned)(kv >> 32)); SELT[rowbase + s] = m; INV[(size_t)m * 16 + e] = rowbase + s; }
        for (int s = F.wave; s < cap; s += NWAVES) { const unsigned long long kv = keys[s]; const int m = mbase + (int)(0xFFFFFFFFu - (unsigned)kv);
            const u32x4* src = (const u32x4*)(H2 + (size_t)m * 1024); u32x4* dst = (u32x4*)(XE + (size_t)(rowbase + s) * 1024);
            dst[LANE_] = src[LANE_]; dst[64 + LANE_] = src[64 + LANE_]; }
        __syncthreads();
    }
}

constexpr int N_PHASES = 2 + 10 * NL;
#ifndef EN_MASK
#define EN_MASK 0xFFFFF
#endif
#define EN(k) ((EN_MASK >> (k)) & 1)
#ifndef REP_MASK
#define REP_MASK 0
#endif
#define REP(k) ((REP_MASK >> (k)) & 1)
#define RUNPH(k, body) do { if (EN(k)) { body; if (REP(k)) { xcd_barrier(bar); body; } } } while (0)
__global__ void __launch_bounds__(NTHREADS, 2) fwd_kernel(Args args) {
    extern __shared__ __attribute__((aligned(16))) unsigned char lds_raw[];
    cg::grid_group grid = cg::this_grid();
    Frame F;
    F.lds = (LAS unsigned char*)lds_raw;
    F.MISC = (volatile LAS unsigned*)(F.lds + MISC_OFF);
    F.wave = __builtin_amdgcn_readfirstlane(TID_ >> 6);
    F.G = gridDim.x; { const int bx = blockIdx.x; F.vcu = (F.G % 8 == 0) ? (bx % 8) * (F.G / 8) + bx / 8 : bx; }
    F.in = args.in; F.out = args.out; F.ws = args.ws; F.ctl = (unsigned*)(args.ws + WS_CTL);
    { int u0 = TID_; asm volatile("" : "+v"(u0)); for (int u = u0; u < (LDS_BYTES - RING_BYTES) / 4; u += NTHREADS) ((LAS unsigned*)(F.lds + RING_BYTES))[u] = 0u; }
    __syncthreads();
    const int lo = args.ph_lo, hi = args.ph_hi;
    XcdBarrier bar; bar.bar = F.ctl + CW_BAR; bar.x = 0; bar.st = nullptr;
    if (hi - lo > 1) bar = xcd_barrier_post(F.ctl + CW_BAR, F.MISC + 8);
    LAS unsigned char* ring = F.lds;

#define IN(k) (lo <= (k) && (k) < hi)
#define SEAM(k) do { if (IN(k) && IN((k) + 1)) { if ((k) == lo) grid.sync(); else xcd_barrier(bar); } } while (0)
    if (IN(0)) { RUNPH(10, phase_init(F)); }
    SEAM(0);
    if (IN(1)) { RUNPH(11, phase_row0(F)); }
    SEAM(1);
#define LAYER(l) do { constexpr int base = 2 + 10 * (l); constexpr bool last = ((l) == NL - 1); \
    if (IN(base + 0)) { if (EN(0)) { \
        pg8::Gemm g{WSP(bf16, WS_H), WSP(bf16, WS_WIN) + (size_t)(l) * NINP * 1024, M, NINP, D}; \
        TileSched S{M / 256, NINP / 256, F.G, F.vcu, false}; \
        EpiInproj E{WSP(bf16, WS_QKV), WSP(float, WS_R32), WSP(bf16, WS_Z)}; \
        for (int rep_ = 0; rep_ < (REP(0) ? 2 : 1); ++rep_) { if (rep_) xcd_barrier(bar); run_gemm<EpiInproj, TileSched>(ring, g, S, E); } } } \
    SEAM(base + 0); \
    if (IN(base + 1)) { if (EN(1)) { \
        pg8::Gemm g{WSP(bf16, WS_Z), WSP(bf16, WS_LORA) + (size_t)(l) * 1280 * 384, M, 1280, 384}; \
        TileSched S{M / 256, 5, F.G, F.vcu, false}; \
        EpiLora E{WSP(float, WS_DEC), WSP(float, WS_ASIG), WSP(float, WS_G), F.in[I_W0] + (l) * 512, F.in[I_A0] + (l) * 512}; \
        for (int rep_ = 0; rep_ < (REP(1) ? 2 : 1); ++rep_) { if (rep_) xcd_barrier(bar); run_gemm<EpiLora, TileSched>(ring, g, S, E); } } \
        if (EN(12)) { phase_qkprep(F, (l)); if (REP(12)) { xcd_barrier(bar); phase_qkprep(F, (l), true); } } } \
    SEAM(base + 1); \
    if (IN(base + 2)) { RUNPH(2, phase_mixer(F, (l))); } \
    SEAM(base + 2); \
    if (IN(base + 3)) { RUNPH(3, phase_post(F, (l))); } \
    SEAM(base + 3); \
    if (IN(base + 4)) { if (EN(4)) { \
        pg8::Gemm g{WSP(bf16, WS_O), WSP(bf16, WS_WOUT) + (size_t)(l) * 1024 * 1024, M, D, D}; \
        TileSched S{last ? 64 : 72, 4, F.G, F.vcu, last}; \
        EpiOut E{WSP(float, WS_Y)}; \
        for (int rep_ = 0; rep_ < (REP(4) ? 2 : 1); ++rep_) { if (rep_) xcd_barrier(bar); run_gemm<EpiOut, TileSched>(ring, g, S, E); } } } \
    SEAM(base + 4); \
    if (IN(base + 5)) { if (EN(5)) { phase_row1(F, (l)); if (REP(5)) { xcd_barrier(bar); phase_row1(F, (l), true); } } } \
    SEAM(base + 5); \
    if (IN(base + 6)) { RUNPH(6, phase_topk(F, (l))); } \
    SEAM(base + 6); \
    if (IN(base + 7)) { if (EN(7)) { \
        pg8::Gemm g{WSP(bf16, WS_XE), WSP(bf16, WS_WGU), NE * MEXP, NE * 2048, D}; \
        MoeSched S{last ? 8 : 9, 8, F.G, F.vcu}; \
        EpiMoe1 E{WSP(bf16, WS_HID)}; \
        for (int rep_ = 0; rep_ < (REP(7) ? 2 : 1); ++rep_) { if (rep_) xcd_barrier(bar); run_gemm<EpiMoe1, MoeSched>(ring, g, S, E); } } } \
    SEAM(base + 7); \
    if (IN(base + 8)) { if (EN(8)) { \
        pg8::Gemm g{WSP(bf16, WS_HID), WSP(bf16, WS_WD), NE * MEXP, NE * 1024, D}; \
        MoeSched S{last ? 8 : 9, 4, F.G, F.vcu}; \
        EpiMoe2 E{WSP(bf16, WS_OUTE), WSP(float, WS_SELG)}; \
        for (int rep_ = 0; rep_ < (REP(8) ? 2 : 1); ++rep_) { if (rep_) xcd_barrier(bar); run_gemm<EpiMoe2, MoeSched>(ring, g, S, E); } } } \
    SEAM(base + 8); \
    if (IN(base + 9)) { if (EN(9)) { phase_row2(F, (l)); if (REP(9)) { xcd_barrier(bar); phase_row2(F, (l), true); } } } \
    SEAM(base + 9); \
  } while (0)
    LAYER(0);
    LAYER(1);
#undef LAYER
#undef SEAM
#undef IN
}

extern "C" void kernel_launch(void* const* d_in, const int* in_sizes, int n_in, void* d_out, int out_size, void* d_ws, size_t ws_size, hipStream_t stream) {
    static int grid = 0;
    if (grid == 0) {
        if (n_in != 29 || out_size != NB * SEQ * D || ws_size < WS_END) { fprintf(stderr, "kernel_launch: unexpected sizes n_in %d out %d ws %zu\n", n_in, out_size, ws_size); grid = -1; return; }
        int dev = 0, cus = 0, per_cu = 0;
        if (hipGetDevice(&dev) != hipSuccess || hipDeviceGetAttribute(&cus, hipDeviceAttributeMultiprocessorCount, dev) != hipSuccess) { grid = -1; return; }
        if (hipFuncSetAttribute((const void*)fwd_kernel, hipFuncAttributeMaxDynamicSharedMemorySize, LDS_BYTES) != hipSuccess) { fprintf(stderr, "kernel_launch: hipFuncSetAttribute failed\n"); grid = -1; return; }
        if (hipOccupancyMaxActiveBlocksPerMultiprocessor(&per_cu, (const void*)fwd_kernel, NTHREADS, LDS_BYTES) != hipSuccess || per_cu < 1) { fprintf(stderr, "kernel_launch: occupancy query says %d\n", per_cu); per_cu = 1; }
        (void)hipGetLastError();
        grid = cus;
        fprintf(stderr, "kernel_launch: grid %d, per_cu %d, ws %zu\n", grid, per_cu, ws_size);
    }
    if (grid < 0) return;
    if (hipMemsetAsync((char*)d_ws + WS_CTL, 0, CTL_ZERO_BYTES, stream) != hipSuccess) return;
    Args a{};
    for (int i = 0; i < 29; ++i) a.in[i] = (const float*)d_in[i];
    a.out = (float*)d_out; a.ws = (unsigned char*)d_ws;
#if N_LAUNCH_MODE
    a.ph_lo = 0; a.ph_hi = N_PHASES;
    { void* kargs[] = {&a};
      hipError_t e = hipLaunchCooperativeKernel((const void*)fwd_kernel, dim3(grid), dim3(NTHREADS), kargs, LDS_BYTES, stream);
      if (e != hipSuccess) fprintf(stderr, "kernel_launch: cooperative launch failed: %s\n", hipGetErrorString(e)); }
#else
    for (int ph = 0; ph < N_PHASES; ++ph) {
        a.ph_lo = ph; a.ph_hi = ph + 1;
        void* kargs[] = {&a};
        hipError_t e = hipLaunchCooperativeKernel((const void*)fwd_kernel, dim3(grid), dim3(NTHREADS), kargs, LDS_BYTES, stream);
        if (e != hipSuccess) { fprintf(stderr, "kernel_launch: launch %d failed: %s\n", ph, hipGetErrorString(e)); break; }
    }
#endif
}
```

```cpp
#define GOLD_GEMM 0
#define N_LAUNCH_MODE 1
#define GOLD_ATTN 0
#define REP_MASK 0
#define CHUNK_SCAN 1
#include <hip/hip_runtime.h>
#include <hip/hip_cooperative_groups.h>
#include <cstdio>
#include <cstdint>
namespace cg = cooperative_groups;

#ifndef GOLD_GEMM
#define GOLD_GEMM 0
#endif
#ifndef GOLD_ATTN
#define GOLD_ATTN 1
#endif
#ifndef N_LAUNCH_MODE
#define N_LAUNCH_MODE 1
#endif

#define LAS __attribute__((address_space(3)))
typedef unsigned short bf16;
typedef float f32x4 __attribute__((ext_vector_type(4)));
typedef unsigned u32x4 __attribute__((ext_vector_type(4)));
typedef unsigned u32x2 __attribute__((ext_vector_type(2)));
typedef short bf16x8 __attribute__((ext_vector_type(8)));

constexpr int D = 1024, NB = 8, SEQ = 2048, CTXL = 256, T = SEQ + CTXL, M = NB * T, NL = 2;
constexpr int NINP = 2816;
constexpr int NE = 16, MEXP = 2304;
constexpr float LOG2E = 1.4426950408889634f;
constexpr float C2 = 0.125f * LOG2E;
constexpr int NTHREADS = 512, NWAVES = 8;
constexpr int LDS_BYTES = 147456, RING_BYTES = 131072, MISC_OFF = RING_BYTES + 320;

constexpr size_t MiB = 1u << 20;
constexpr size_t WS_CTL = 0, CTL_ZERO_BYTES = 1 * MiB;
constexpr size_t WS_MOD = 1 * MiB;
constexpr size_t WS_WIN = 2 * MiB;
constexpr size_t WS_WOUT = 13 * MiB;
constexpr size_t WS_LORA = 17 * MiB;
constexpr size_t WS_WGU = 19 * MiB;
constexpr size_t WS_WD = 83 * MiB;
constexpr size_t WS_X = 115 * MiB;
constexpr size_t R0 = 187 * MiB;
constexpr size_t WS_YD = R0 + 0 * MiB;
constexpr size_t WS_H = R0 + 36 * MiB;
constexpr size_t WS_QKV = R0 + 72 * MiB;
constexpr size_t WS_R32 = R0 + 126 * MiB;
constexpr size_t WS_Z = R0 + 180 * MiB;
constexpr size_t WS_DEC = R0 + 194 * MiB;
constexpr size_t WS_ASIG = R0 + 230 * MiB;
constexpr size_t WS_G = R0 + 266 * MiB;
constexpr size_t WS_O = R0 + 284 * MiB;
constexpr size_t WS_END = R0 + 320 * MiB;
constexpr size_t WS_Y = WS_QKV;
constexpr size_t WS_OUTE = WS_QKV;
constexpr size_t WS_H2 = WS_DEC;
constexpr size_t WS_AFF = WS_Z;
constexpr size_t WS_INV = WS_Z + 2 * MiB;
constexpr size_t WS_SELG = WS_Z + 4 * MiB;
constexpr size_t WS_SELT = WS_Z + 5 * MiB;
constexpr size_t WS_XE = WS_ASIG;
constexpr size_t WS_HID = WS_YD;
static_assert(WS_END <= 512 * MiB, "ws map");
constexpr int CW_BAR = 4096;
constexpr int CW_QUEUE = 16384;

__device__ __forceinline__ unsigned f2bf(float f) { unsigned u = __builtin_bit_cast(unsigned, f); return (u + 0x7fffu + ((u >> 16) & 1u)) >> 16; }
__device__ __forceinline__ unsigned pk2(float lo, float hi) { return f2bf(lo) | (f2bf(hi) << 16); }
__device__ __forceinline__ float bf2f(unsigned h) { return __builtin_bit_cast(float, h << 16); }
__device__ __forceinline__ float bflo(unsigned w) { return __builtin_bit_cast(float, w << 16); }
__device__ __forceinline__ float bfhi(unsigned w) { return __builtin_bit_cast(float, w & 0xffff0000u); }
template <int CTRL> __device__ __forceinline__ float dppf(float x) { return __builtin_bit_cast(float, __builtin_amdgcn_update_dpp(0, __builtin_bit_cast(int, x), CTRL, 0xF, 0xF, true)); }
__device__ __forceinline__ float red8(float x) { x += dppf<0xB1>(x); x += dppf<0x4E>(x); x += dppf<0x141>(x); return x; }
__device__ __forceinline__ float wave_sum(float v) {
    v = red8(v); v += dppf<0x140>(v);
    const float a0 = __builtin_bit_cast(float, __builtin_amdgcn_readlane(__builtin_bit_cast(int, v), 0));
    const float a1 = __builtin_bit_cast(float, __builtin_amdgcn_readlane(__builtin_bit_cast(int, v), 16));
    const float a2 = __builtin_bit_cast(float, __builtin_amdgcn_readlane(__builtin_bit_cast(int, v), 32));
    const float a3 = __builtin_bit_cast(float, __builtin_amdgcn_readlane(__builtin_bit_cast(int, v), 48));
    return (a0 + a1) + (a2 + a3);
}
__device__ __forceinline__ float sigmoidf_(float x) { return __builtin_amdgcn_rcpf(1.f + __expf(-x)); }
#define LDS_WAIT() asm volatile("s_waitcnt lgkmcnt(0)" ::: "memory")

#define XB_TMO      128
#define XB_XCNT(j)  (256  + 64 * (j))
#define XB_XSUB(j)  (1280 + 64 * (j))
#define XB_XGEN(j)  (2304 + 64 * (j))
#define XB_TOP      3328
#define XB_TOPGEN   3392
#define XCD_BAR_WORDS 3456
#define XB_SPIN_CAP (1u << 22)
__device__ __forceinline__ unsigned xb_ld(unsigned* p)              { return __hip_atomic_load(p, __ATOMIC_RELAXED, __HIP_MEMORY_SCOPE_AGENT); }
__device__ __forceinline__ unsigned xb_add(unsigned* p, unsigned v) { return __hip_atomic_fetch_add(p, v, __ATOMIC_RELAXED, __HIP_MEMORY_SCOPE_AGENT); }
__device__ __forceinline__ unsigned xb_xcc_id() { return (unsigned)__builtin_amdgcn_s_getreg((3 << 11) | 20) & 0xFu; }
#define XB_SPIN(cond, bar) do { unsigned _sp = 0; while (cond) { __builtin_amdgcn_s_sleep(1); \
    if ((++_sp & 255u) == 0u) { if (xb_ld(&(bar)[XB_TMO])) break; if (_sp > XB_SPIN_CAP) { atomicAdd(&(bar)[XB_TMO], 1u); break; } } } } while (0)
struct XcdBarrier { unsigned* bar; unsigned x; volatile LAS unsigned* st; };
__device__ __forceinline__ XcdBarrier xcd_barrier_post(unsigned* bar, volatile LAS unsigned* st) {
    XcdBarrier b; b.bar = bar; b.x = xb_xcc_id(); b.st = st;
    if (threadIdx.x == 0) (void)xb_add(&bar[XB_XCNT(b.x)], 1u);
    return b;
}
__device__ __forceinline__ void xcd_barrier_complete(unsigned* bar, unsigned x, unsigned& nloc, unsigned& nx) {
    const unsigned G = gridDim.x * gridDim.y * gridDim.z;
    unsigned sum, cnt, mine, sp = 0u;
    for (;;) {
        sum = 0u; cnt = 0u; mine = 0u;
#pragma unroll
        for (unsigned j = 0; j < 16; ++j) { const unsigned c = xb_ld(&bar[XB_XCNT(j)]); sum += c; cnt += (c > 0u) ? 1u : 0u; mine = (j == x) ? c : mine; }
        if (sum == G) break;
        __builtin_amdgcn_s_sleep(1);
        if ((++sp & 255u) == 0u) { if (xb_ld(&bar[XB_TMO])) break; if (sp > XB_SPIN_CAP) { atomicAdd(&bar[XB_TMO], 1u); break; } }
    }
    nloc = mine > 0u ? mine : 1u; nx = cnt > 0u ? cnt : 1u;
}
__device__ __forceinline__ void xcd_barrier(const XcdBarrier& b) {
    asm volatile("s_waitcnt vmcnt(0)" ::: "memory");
    __syncthreads();
    if (threadIdx.x == 0) {
        unsigned* bar = b.bar;
        __builtin_amdgcn_s_waitcnt(0);
        unsigned nloc = b.st[0], nx = b.st[1];
        if (nloc == 0u) { xcd_barrier_complete(bar, b.x, nloc, nx); b.st[0] = nloc; b.st[1] = nx; }
        const unsigned old = xb_add(&bar[XB_XSUB(b.x)], 1u);
        const unsigned gen = old / nloc;
        if (old + 1u == (gen + 1u) * nloc) {
            __builtin_amdgcn_fence(__ATOMIC_RELEASE, "agent");
            asm volatile("s_waitcnt vmcnt(0)" ::: "memory");
            const unsigned og = xb_add(&bar[XB_TOP], 1u);
            const unsigned tg = og / nx;
            if (og + 1u == (tg + 1u) * nx) xb_add(&bar[XB_TOPGEN], 1u);
            else XB_SPIN(xb_ld(&bar[XB_TOPGEN]) == tg, bar);
            __builtin_amdgcn_fence(__ATOMIC_ACQUIRE, "agent");
            xb_add(&bar[XB_XGEN(b.x)], 1u);
            asm volatile("s_waitcnt vmcnt(0)" ::: "memory");
        } else {
            XB_SPIN(xb_ld(&bar[XB_XGEN(b.x)]) == gen, bar);
            __builtin_amdgcn_fence(__ATOMIC_ACQUIRE, "agent");
            asm volatile("s_waitcnt vmcnt(0)" ::: "memory");
        }
    }
    __syncthreads();
}

__device__ __forceinline__ void flat_barrier(unsigned* cnt) {
    asm volatile("s_waitcnt vmcnt(0)" ::: "memory");
    __syncthreads();
    if (threadIdx.x == 0) {
        const unsigned G = gridDim.x;
        __builtin_amdgcn_fence(__ATOMIC_RELEASE, "agent");
        asm volatile("s_waitcnt vmcnt(0)" ::: "memory");
        const unsigned old = xb_add(cnt, 1u);
        const unsigned target = (old / G + 1u) * G;
        unsigned sp = 0;
        while (xb_ld(cnt) < target) { __builtin_amdgcn_s_sleep(1); if (++sp > (1u << 22)) break; }
        __builtin_amdgcn_fence(__ATOMIC_ACQUIRE, "agent");
        asm volatile("s_waitcnt vmcnt(0)" ::: "memory");
    }
    __syncthreads();
}

__device__ __forceinline__ void xcd_barrier2(const XcdBarrier& b) {
    asm volatile("s_waitcnt vmcnt(0)" ::: "memory");
    __syncthreads();
    if (threadIdx.x == 0) {
        unsigned* bar = b.bar;
        __builtin_amdgcn_s_waitcnt(0);
        unsigned nloc = b.st[0], nx = b.st[1];
        if (nloc == 0u) { xcd_barrier_complete(bar, b.x, nloc, nx); b.st[0] = nloc; b.st[1] = nx; }
        const unsigned old = xb_add(&bar[XB_XSUB(b.x)], 1u);
        const unsigned gen = old / nloc;
        if (old + 1u == (gen + 1u) * nloc) {
            __builtin_amdgcn_fence(__ATOMIC_RELEASE, "agent");
            asm volatile("s_waitcnt vmcnt(0)" ::: "memory");
            (void)xb_add(&bar[XB_TOP], 1u);
        }
        const unsigned target = (gen + 1u) * nx;
        XB_SPIN(xb_ld(&bar[XB_TOP]) < target, bar);
        __builtin_amdgcn_fence(__ATOMIC_ACQUIRE, "agent");
        asm volatile("s_waitcnt vmcnt(0)" ::: "memory");
    }
    __syncthreads();
}
namespace pg8 {
#define PG8_LAS __attribute__((address_space(3)))
typedef unsigned short bf16_t;
typedef short bf16x8 __attribute__((ext_vector_type(8)));
typedef float f32x4 __attribute__((ext_vector_type(4)));
typedef unsigned u32x4 __attribute__((ext_vector_type(4)));
constexpr int BM = 256, BK = 64, HALF = 128, HTB = HALF * BK * 2  , STAGE_BYTES = 8 * HTB, NXCD = 8, WGM = 8;

__host__ __device__ __forceinline__ int lds_byte(int r, int c) { const int st = (r >> 4) * 2 + (c >> 5), rr = r & 15, cc = c & 31, ob = rr * 64 + cc * 2; return st * 1024 + (ob ^ (((ob >> 9) & 1) << 5)); }
__host__ __device__ __forceinline__ void stage_rc(int b, int& R, int& C) { const int st = b / 1024, sb = b % 1024, swz = sb ^ (((sb >> 9) & 1) << 5); R = (st >> 1) * 16 + swz / 64; C = (st & 1) * 32 + (swz % 64) / 2; }
__host__ __device__ __forceinline__ int perm32(int rho) { const int n = rho >> 4, i = rho & 15; return 8 * (i >> 2) + 4 * n + (i & 3); }

struct Unit { int pm, pn; };
struct Gemm { const bf16_t* A; const bf16_t* Bt; int M, N, K; };

struct StaticOrder {
    int nM, nN, nwg, G, c;
    __host__ __device__ void init(int M, int N, int G_, int c_) { nM = M / BM; nN = N / BM; nwg = nM * nN; G = G_; c = c_; }
    __host__ __device__ bool next(int i, Unit& u) const {
        const long L = (long)i * G + c; if (L >= nwg) return false;
        int wgid = (int)L; { const int q = nwg / NXCD, r = nwg % NXCD, xcd = wgid % NXCD, off = wgid / NXCD; wgid = (xcd < r ? xcd * (q + 1) : r * (q + 1) + (xcd - r) * q) + off; }
        const int nig = WGM * nN, gid = wgid / nig, fm = gid * WGM, gsz = (nM - fm) < WGM ? (nM - fm) : WGM;
        u.pm = fm + ((wgid % nig) % gsz); u.pn = (wgid % nig) / gsz; return true;
    }
    __device__ __forceinline__ void a_ready(const Unit&) const {}
    __device__ __forceinline__ void done(const Unit&) const {}
};
__device__ __forceinline__ unsigned cvt_pk_bf16(float lo, float hi) { unsigned r; asm volatile("v_cvt_pk_bf16_f32 %0, %1, %2" : "=v"(r) : "v"(lo), "v"(hi)); return r; }
typedef float f32x2 __attribute__((ext_vector_type(2)));
template <class Epi, class Sched, bool ALIGN_EPI = false, bool SP2 = false>
__device__ __forceinline__ void gemm_phase(PG8_LAS unsigned char* lds, const Gemm g, const Sched& S, const Epi& E) {
    const int tid = threadIdx.x, wid = __builtin_amdgcn_readfirstlane(tid >> 6), lane = tid & 63, wr = wid >> 2, wc = wid & 3, fr = lane & 15, fq = lane >> 4;
    const int K = g.K, nt = K / BK;
    unsigned voffA[2], voffB[2];
#pragma unroll
    for (int i = 0; i < 2; ++i) { int R, C; stage_rc(tid * 16 + i * 8192, R, C); const int Rb = Epi::PERM ? ((R & ~31) + perm32(R & 31)) : R;
        voffA[i] = (unsigned)(R * K + C) * 2u; voffB[i] = (unsigned)(Rb * K + C) * 2u; }
    const size_t kstep = (size_t)(BK * 2);
    const size_t hstep = (size_t)HALF * K * 2;
    const size_t tstep = 2 * hstep;
    const unsigned ldsw = (unsigned)wid * 1024u;
    const int aoff = lds_byte(wr * 64 + fr, fq * 8), boff = lds_byte(wc * 32 + fr, fq * 8);
#define PG8_SA(b, h) (((b) * 2 + (h)) * HTB)
#define PG8_SB(b, h) ((4 + (b) * 2 + (h)) * HTB)
#define PG8_STAGE(bufoff, gbase, voff) do { _Pragma("unroll") for (int _i = 0; _i < 2; ++_i) \
        __builtin_amdgcn_global_load_lds((const unsigned*)((const char*)(gbase) + (voff)[_i]), (PG8_LAS unsigned*)(lds + (bufoff) + ldsw + _i * 8192), 16, 0, 0); } while (0)
#define PG8_LDA(dst, b, h) do { _Pragma("unroll") for (int m = 0; m < 4; ++m) _Pragma("unroll") for (int k = 0; k < 2; ++k) dst[m][k] = *(const PG8_LAS bf16x8*)(lds + PG8_SA(b, h) + aoff + m * 2048 + k * 1024); } while (0)
#define PG8_LDB(dst, b, h) do { _Pragma("unroll") for (int n = 0; n < 2; ++n) _Pragma("unroll") for (int k = 0; k < 2; ++k) dst[n][k] = *(const PG8_LAS bf16x8*)(lds + PG8_SB(b, h) + boff + n * 2048 + k * 1024); } while (0)
#define PG8_MMA(ai, bj, At, Bt) do { __builtin_amdgcn_s_setprio(1); _Pragma("unroll") for (int m = 0; m < 4; ++m) _Pragma("unroll") for (int n = 0; n < 2; ++n) _Pragma("unroll") for (int k = 0; k < 2; ++k) \
        acc[ai][bj][m][n] = __builtin_amdgcn_mfma_f32_16x16x32_bf16(Bt[n][k], At[m][k], acc[ai][bj][m][n], 0, 0, 0); __builtin_amdgcn_s_setprio(0); } while (0)
#define PG8_WAIT_V(n) asm volatile("s_waitcnt vmcnt(" #n ")" ::: "memory")
#define PG8_WAIT_L(n) asm volatile("s_waitcnt lgkmcnt(" #n ")" ::: "memory")
#define PG8_BAR __builtin_amdgcn_s_barrier()
#define PG8_SCHED __builtin_amdgcn_sched_barrier(0)
    Unit cur, nxt; int ui = 0;
    if (!S.next(0, cur)) return;
    f32x4 acc[2][2][4][2];
#pragma unroll
    for (int a = 0; a < 2; ++a)
#pragma unroll
        for (int b = 0; b < 2; ++b)
#pragma unroll
            for (int m = 0; m < 4; ++m)
#pragma unroll
                for (int n = 0; n < 2; ++n) acc[a][b][m][n] = (f32x4){0.f, 0.f, 0.f, 0.f};
    bf16x8 At[4][2], B0[2][2], B1[2][2];
    const char* cA = (const char*)g.A + (size_t)cur.pm * tstep; const char* cB = (const char*)g.Bt + (size_t)cur.pn * tstep;
    S.a_ready(cur);
    if constexpr (SP2) {
        PG8_STAGE(PG8_SB(0, 0), cB, voffB); PG8_STAGE(PG8_SB(0, 1), cB + hstep, voffB); PG8_STAGE(PG8_SA(0, 0), cA, voffA); PG8_STAGE(PG8_SA(0, 1), cA + hstep, voffA);
        if (wr == 1) PG8_BAR;
        PG8_WAIT_V(2); PG8_BAR;
        PG8_STAGE(PG8_SB(1, 0), cB + kstep, voffB); PG8_STAGE(PG8_SA(1, 0), cA + kstep, voffA); PG8_STAGE(PG8_SB(1, 1), cB + hstep + kstep, voffB);
        PG8_WAIT_V(6); PG8_BAR;
    } else {
        PG8_STAGE(PG8_SB(0, 0), cB, voffB); PG8_STAGE(PG8_SA(0, 0), cA, voffA); PG8_STAGE(PG8_SB(0, 1), cB + hstep, voffB); PG8_STAGE(PG8_SA(0, 1), cA + hstep, voffA);
        if (wr == 1) PG8_BAR;
        PG8_WAIT_V(4); PG8_BAR;
        PG8_STAGE(PG8_SB(1, 0), cB + kstep, voffB); PG8_STAGE(PG8_SA(1, 0), cA + kstep, voffA); PG8_STAGE(PG8_SB(1, 1), cB + hstep + kstep, voffB);
        PG8_WAIT_V(6); PG8_BAR;
    }
    for (;;) {
        const bool has_next = S.next(ui + 1, nxt);
        const char* nA = has_next ? (const char*)g.A + (size_t)nxt.pm * tstep : cA; const char* nB = has_next ? (const char*)g.Bt + (size_t)nxt.pn * tstep : cB;
        for (int t = 0; t < nt; t += 2) {
            const bool last = (t == nt - 2);
            const char* a1 = cA + (size_t)(t + 1) * kstep;
            const char* a2 = last ? nA : cA + (size_t)(t + 2) * kstep; const char* b2 = last ? nB : cB + (size_t)(t + 2) * kstep;
            const char* a3 = a2 + kstep; const char* b3 = b2 + kstep;
            if (last && has_next) S.a_ready(nxt);
            if constexpr (SP2) {
            PG8_LDB(B0, 0, 0); PG8_LDB(B1, 0, 1); PG8_SCHED; PG8_LDA(At, 0, 0); PG8_STAGE(PG8_SA(1, 1), a1 + hstep, voffA);
            PG8_WAIT_V(8); PG8_WAIT_L(0); PG8_BAR; PG8_MMA(0, 0, At, B0); PG8_MMA(0, 1, At, B1); PG8_BAR; PG8_SCHED;
            PG8_LDA(At, 0, 1); PG8_STAGE(PG8_SB(0, 0), b2, voffB); PG8_STAGE(PG8_SB(0, 1), b2 + hstep, voffB); PG8_STAGE(PG8_SA(0, 0), a2, voffA);
            PG8_WAIT_V(8); PG8_WAIT_L(0); PG8_BAR; PG8_MMA(1, 0, At, B0); PG8_MMA(1, 1, At, B1); PG8_BAR; PG8_SCHED;
            PG8_LDB(B0, 1, 0); PG8_LDB(B1, 1, 1); PG8_SCHED; PG8_LDA(At, 1, 0); PG8_STAGE(PG8_SA(0, 1), a2 + hstep, voffA);
            PG8_WAIT_V(8); PG8_WAIT_L(0); PG8_BAR; PG8_MMA(0, 0, At, B0); PG8_MMA(0, 1, At, B1); PG8_BAR; PG8_SCHED;
            PG8_LDA(At, 1, 1); PG8_STAGE(PG8_SB(1, 0), b3, voffB); PG8_STAGE(PG8_SB(1, 1), b3 + hstep, voffB); PG8_STAGE(PG8_SA(1, 0), a3, voffA);
            PG8_WAIT_V(8); PG8_WAIT_L(0); PG8_BAR; PG8_MMA(1, 0, At, B0); PG8_MMA(1, 1, At, B1); PG8_BAR; PG8_SCHED;
            } else {
            PG8_LDB(B0, 0, 0); PG8_SCHED; PG8_LDA(At, 0, 0); PG8_STAGE(PG8_SA(1, 1), a1 + hstep, voffA);
            PG8_WAIT_L(8); PG8_BAR; PG8_WAIT_L(0); PG8_MMA(0, 0, At, B0); PG8_BAR; PG8_SCHED;
            PG8_LDB(B1, 0, 1); PG8_STAGE(PG8_SB(0, 0), b2, voffB);
            PG8_BAR; PG8_WAIT_L(0); PG8_MMA(0, 1, At, B1); PG8_BAR;
            PG8_LDA(At, 0, 1); PG8_STAGE(PG8_SA(0, 0), a2, voffA);
            PG8_BAR; PG8_WAIT_L(0); PG8_MMA(1, 0, At, B0); PG8_BAR; PG8_SCHED;
            PG8_STAGE(PG8_SB(0, 1), b2 + hstep, voffB);
            PG8_WAIT_V(6); PG8_BAR; PG8_MMA(1, 1, At, B1); PG8_BAR;
            PG8_LDB(B0, 1, 0); PG8_SCHED; PG8_LDA(At, 1, 0); PG8_STAGE(PG8_SA(0, 1), a2 + hstep, voffA);
            PG8_WAIT_L(8); PG8_BAR; PG8_WAIT_L(0); PG8_MMA(0, 0, At, B0); PG8_BAR; PG8_SCHED;
            PG8_LDB(B1, 1, 1); PG8_STAGE(PG8_SB(1, 0), b3, voffB);
            PG8_BAR; PG8_WAIT_L(0); PG8_MMA(0, 1, At, B1); PG8_BAR;
            PG8_LDA(At, 1, 1); PG8_STAGE(PG8_SA(1, 0), a3, voffA);
            PG8_BAR; PG8_WAIT_L(0); PG8_MMA(1, 0, At, B0); PG8_BAR; PG8_SCHED;
            PG8_STAGE(PG8_SB(1, 1), b3 + hstep, voffB);
            PG8_WAIT_V(6); PG8_BAR; PG8_MMA(1, 1, At, B1); PG8_BAR;
            }
        }
        if constexpr (ALIGN_EPI) { if (wr == 0) PG8_BAR; }
        if constexpr (!Epi::AFTER_DRAIN) { E(acc, cur, wr, wc, fr, fq); S.done(cur); }
        if (!has_next) break;
#pragma unroll
        for (int a = 0; a < 2; ++a)
#pragma unroll
            for (int b = 0; b < 2; ++b)
#pragma unroll
                for (int m = 0; m < 4; ++m)
#pragma unroll
                    for (int n = 0; n < 2; ++n) acc[a][b][m][n] = (f32x4){0.f, 0.f, 0.f, 0.f};
        cur = nxt; cA = nA; cB = nB; ++ui;
        if constexpr (ALIGN_EPI) { if (wr == 1) PG8_BAR; }
    }
    PG8_WAIT_V(0);
    if constexpr (!ALIGN_EPI) { if (wr == 0) PG8_BAR; }
    PG8_BAR;
    if constexpr (Epi::AFTER_DRAIN) { E.fused(acc, cur, wr, wc, fr, fq, lds, wid, lane); S.done(cur); }
#undef PG8_SA
#undef PG8_SB
#undef PG8_STAGE
#undef PG8_LDA
#undef PG8_LDB
#undef PG8_MMA
#undef PG8_WAIT_V
#undef PG8_WAIT_L
#undef PG8_BAR
#undef PG8_SCHED
}
}

__device__ __forceinline__ u32x4 pack8(const f32x4 a, const f32x4 b) {
    u32x4 w; w.x = pk2(a[0], a[1]); w.y = pk2(a[2], a[3]); w.z = pk2(b[0], b[1]); w.w = pk2(b[2], b[3]); return w;
}
__device__ __forceinline__ float tanh_fast(float x) { const float e = __expf(2.f * x); return 1.f - 2.f * __builtin_amdgcn_rcpf(1.f + e); }
__device__ __forceinline__ float decay_of(float v) { const float ew = 0.6065306597126334f * __builtin_amdgcn_rcpf(1.f + __expf(-v)); return __expf(-ew); }
struct EpiInproj {
    static constexpr bool PERM = true, AFTER_DRAIN = false;
    bf16* QKV; float* R32; bf16* Z;
    __device__ __forceinline__ void operator()(const f32x4 (&acc)[2][2][4][2], const pg8::Unit& u, int wr, int wc, int fr, int fq) const {
        const int pn = u.pn;
#pragma unroll
        for (int ai = 0; ai < 2; ++ai)
#pragma unroll
            for (int m = 0; m < 4; ++m) {
                const unsigned row = (unsigned)u.pm * 256u + ai * 128 + wr * 64 + m * 16 + fr;
#pragma unroll
                for (int bj = 0; bj < 2; ++bj) {
                    f32x4 v0 = acc[ai][bj][m][0], v1 = acc[ai][bj][m][1];
                    const int cb = bj * 128 + wc * 32 + 8 * fq;
                    if (pn < 6) {
                        if (pn == 3) { v0 = v0 * C2; v1 = v1 * C2; }
                        *(u32x4*)(QKV + row * 1536 + pn * 256 + cb) = pack8(v0, v1);
                    } else if (pn < 9) {
                        float* p = R32 + row * 768 + (pn - 6) * 256 + cb;
                        *(f32x4*)p = v0; *(f32x4*)(p + 4) = v1;
                    } else if (pn == 9) {
                        if (bj == 0) {
#pragma unroll
                            for (int e = 0; e < 4; ++e) { v0[e] = tanh_fast(v0[e]); v1[e] = tanh_fast(v1[e]); }
                        }
                        *(u32x4*)(Z + row * 384 + cb) = pack8(v0, v1);
                    } else {
                        if (bj == 0) {
#pragma unroll
                            for (int e = 0; e < 4; ++e) { v0[e] = sigmoidf_(v0[e]); v1[e] = sigmoidf_(v1[e]); }
                            *(u32x4*)(Z + row * 384 + 256 + cb) = pack8(v0, v1);
                        }
                    }
                }
            }
    }
};
struct EpiLora {
    static constexpr bool PERM = true, AFTER_DRAIN = false;
    float* DEC; float* ASIG; float* G; const float* w0; const float* a0;
    template <int KIND> __device__ __forceinline__ void body(const f32x4 (&acc)[2][2][4][2], float* dst, const float* bias, unsigned row0, int cb0) const {
#pragma unroll
        for (int bj = 0; bj < 2; ++bj) {
            const int cb = bj * 128 + cb0;
            f32x4 b0 = (f32x4){0.f, 0.f, 0.f, 0.f}, b1 = b0;
            if (KIND != 2) { b0 = *(const f32x4*)(bias + cb); b1 = *(const f32x4*)(bias + cb + 4); }
#pragma unroll
            for (int ai = 0; ai < 2; ++ai)
#pragma unroll
                for (int m = 0; m < 4; ++m) {
                    f32x4 v0 = acc[ai][bj][m][0] + b0, v1 = acc[ai][bj][m][1] + b1;
#pragma unroll
                    for (int e = 0; e < 4; ++e) {
                        if (KIND == 0) { v0[e] = decay_of(v0[e]); v1[e] = decay_of(v1[e]); }
                        if (KIND == 1) { v0[e] = sigmoidf_(v0[e]); v1[e] = sigmoidf_(v1[e]); }
                    }
                    float* p = dst + (row0 + ai * 128 + m * 16) * 256u + cb;
                    *(f32x4*)p = v0; *(f32x4*)(p + 4) = v1;
                    asm volatile("" ::: "memory");
                }
        }
    }
    __device__ __forceinline__ void operator()(const f32x4 (&acc)[2][2][4][2], const pg8::Unit& u, int wr, int wc, int fr, int fq) const {
        const int pn = u.pn; const unsigned row0 = (unsigned)u.pm * 256u + wr * 64 + fr; const int cb0 = wc * 32 + 8 * fq;
        if (pn < 2) body<0>(acc, DEC + (size_t)pn * M * 256, w0 + pn * 256, row0, cb0);
        else if (pn < 4) body<1>(acc, ASIG + (size_t)(pn - 2) * M * 256, a0 + (pn - 2) * 256, row0, cb0);
        else body<2>(acc, G, w0, row0, cb0);
    }
};
struct EpiOut {
    static constexpr bool PERM = true, AFTER_DRAIN = false;
    float* Y;
    __device__ __forceinline__ void operator()(const f32x4 (&acc)[2][2][4][2], const pg8::Unit& u, int wr, int wc, int fr, int fq) const {
#pragma unroll
        for (int ai = 0; ai < 2; ++ai)
#pragma unroll
            for (int m = 0; m < 4; ++m) {
                const unsigned row = (unsigned)u.pm * 256u + ai * 128 + wr * 64 + m * 16 + fr;
#pragma unroll
                for (int bj = 0; bj < 2; ++bj) {
                    float* p = Y + row * 1024 + u.pn * 256 + bj * 128 + wc * 32 + 8 * fq;
                    *(f32x4*)p = acc[ai][bj][m][0]; *(f32x4*)(p + 4) = acc[ai][bj][m][1];
                }
            }
    }
};
struct EpiMoe1 {
    static constexpr bool PERM = true, AFTER_DRAIN = false;
    bf16* HID;
    __device__ __forceinline__ void operator()(const f32x4 (&acc)[2][2][4][2], const pg8::Unit& u, int wr, int wc, int fr, int fq) const {
        const int pnl = u.pn & 7;
#pragma unroll
        for (int ai = 0; ai < 2; ++ai)
#pragma unroll
            for (int m = 0; m < 4; ++m) {
                const unsigned row = (unsigned)u.pm * 256u + ai * 128 + wr * 64 + m * 16 + fr;
                f32x4 h0, h1;
#pragma unroll
                for (int e = 0; e < 4; ++e) {
                    const float g0 = acc[ai][0][m][0][e], g1 = acc[ai][0][m][1][e];
                    h0[e] = g0 * sigmoidf_(g0) * acc[ai][1][m][0][e];
                    h1[e] = g1 * sigmoidf_(g1) * acc[ai][1][m][1][e];
                }
                *(u32x4*)(HID + row * 1024 + pnl * 128 + wc * 32 + 8 * fq) = pack8(h0, h1);
            }
    }
};
struct EpiMoe2 {
    static constexpr bool PERM = true, AFTER_DRAIN = false;
    bf16* OUTE; const float* selg;
    __device__ __forceinline__ void operator()(const f32x4 (&acc)[2][2][4][2], const pg8::Unit& u, int wr, int wc, int fr, int fq) const {
        const int pnl = u.pn & 3;
#pragma unroll
        for (int ai = 0; ai < 2; ++ai)
#pragma unroll
            for (int m = 0; m < 4; ++m) {
                const unsigned row = (unsigned)u.pm * 256u + ai * 128 + wr * 64 + m * 16 + fr;
                const float gt = selg[row];
#pragma unroll
                for (int bj = 0; bj < 2; ++bj)
                    *(u32x4*)(OUTE + row * 1024 + pnl * 256 + bj * 128 + wc * 32 + 8 * fq) = pack8(acc[ai][bj][m][0] * gt, acc[ai][bj][m][1] * gt);
            }
    }
};

struct TileSched {
    int nM, nN, G, c; bool latent_only;
    __device__ __forceinline__ bool next(int i, pg8::Unit& u) const {
        const long L = (long)i * G + c; if (L >= (long)nM * nN) return false;
        const int pmi = (int)(L / nN); u.pn = (int)(L % nN); u.pm = latent_only ? (pmi >> 3) * 9 + 1 + (pmi & 7) : pmi; return true;
    }
    __device__ __forceinline__ void a_ready(const pg8::Unit&) const {}
    __device__ __forceinline__ void done(const pg8::Unit&) const {}
};
struct InprojLastSched {
    int G, c;
    __device__ __forceinline__ bool next(int i, pg8::Unit& u) const {
        const int L = i * G + c; if (L >= 768) return false;
        if (L < 704) { const int pmi = L / 11; u.pn = L % 11; u.pm = (pmi >> 3) * 9 + 1 + (pmi & 7); }
        else { const int r = L - 704; u.pm = (r >> 3) * 9; const int k = r & 7; u.pn = k == 0 ? 2 : k + 3; }
        return true;
    }
    __device__ __forceinline__ void a_ready(const pg8::Unit&) const {}
    __device__ __forceinline__ void done(const pg8::Unit&) const {}
};
struct MoeSched {
    int nMe, nNe, G, c;
    __device__ __forceinline__ bool next(int i, pg8::Unit& u) const {
        const long L = (long)i * G + c; if (L >= (long)NE * nMe * nNe) return false;
        const int pnl = (int)(L % nNe), t = (int)(L / nNe), pml = t % nMe, e = t / nMe;
        u.pm = e * 9 + pml; u.pn = e * nNe + pnl; return true;
    }
    __device__ __forceinline__ void a_ready(const pg8::Unit&) const {}
    __device__ __forceinline__ void done(const pg8::Unit&) const {}
};

template <class Epi, class Sched>
__device__ __forceinline__ void gemm_ref(const pg8::Gemm g, const Sched& S, const Epi& E) {
    const int tid = threadIdx.x, wid = tid >> 6, lane = tid & 63, wr = wid >> 2, wc = wid & 3, fr = lane & 15, fq = lane >> 4;
    int K = g.K; asm volatile("" : "+s"(K));
    pg8::Unit u;
    for (int ui = 0; S.next(ui, u); ++ui) {
        f32x4 acc[2][2][4][2];
#pragma unroll
        for (int a = 0; a < 2; ++a)
#pragma unroll
            for (int b = 0; b < 2; ++b)
#pragma unroll
                for (int m = 0; m < 4; ++m)
#pragma unroll
                    for (int n = 0; n < 2; ++n) acc[a][b][m][n] = (f32x4){0.f, 0.f, 0.f, 0.f};
        const bf16* Ab = g.A + ((size_t)u.pm * 256 + wr * 64 + fr) * K;
        const bf16* Bb = g.Bt + ((size_t)u.pn * 256 + wc * 32 + 8 * fq) * K;
#pragma unroll
        for (int ai = 0; ai < 2; ++ai)
#pragma unroll
            for (int bj = 0; bj < 2; ++bj)
#pragma unroll
                for (int m = 0; m < 4; ++m)
#pragma unroll
                    for (int n = 0; n < 2; ++n)
#pragma unroll
                        for (int e = 0; e < 4; ++e) {
                            const bf16* ar = Ab + (size_t)(ai * 128 + m * 16) * K; const bf16* br = Bb + (size_t)(bj * 128 + 4 * n + e) * K;
                            float s0 = 0.f, s1 = 0.f;
#pragma unroll 2
                            for (int k0 = 0; k0 < K; k0 += 8) {
                                const u32x4 wa = *(const u32x4*)(ar + k0), wb = *(const u32x4*)(br + k0);
                                s0 += bflo(wa.x) * bflo(wb.x) + bflo(wa.y) * bflo(wb.y) + bflo(wa.z) * bflo(wb.z) + bflo(wa.w) * bflo(wb.w);
                                s1 += bfhi(wa.x) * bfhi(wb.x) + bfhi(wa.y) * bfhi(wb.y) + bfhi(wa.z) * bfhi(wb.z) + bfhi(wa.w) * bfhi(wb.w);
                            }
                            acc[ai][bj][m][n][e] = s0 + s1;
                            asm volatile("" ::: "memory");
                        }
        E(acc, u, wr, wc, fr, fq);
    }
}
template <class Epi, class Sched>
__device__ __forceinline__ void run_gemm(LAS unsigned char* lds, const pg8::Gemm g, const Sched& S, const Epi& E) {
#if GOLD_GEMM
    gemm_ref<Epi, Sched>(g, S, E);
    __syncthreads();
#else
    pg8::Gemm g2 = g; { int kd = g.K; asm volatile("" : "+s"(kd)); g2.K = kd; }
    pg8::gemm_phase<Epi, Sched, true, true>(lds, g2, S, E);
#endif
}

struct Args { const float* in[29]; float* out; unsigned char* ws; int ph_lo, ph_hi; };
enum { I_X = 0, I_C, I_CTX, I_CCTX, I_WMOD, I_BMOD, I_GPREMIX, I_GPOSTMIX, I_GPREFFN, I_GPOSTFFN, I_WIN, I_WOUT, I_QGAIN, I_KGAIN, I_RPB,
       I_W0, I_WUP, I_A0, I_AUP, I_GUP, I_KK, I_KA, I_RK, I_LNXW, I_LNXB, I_WROUTER, I_WEGATE, I_WEUP, I_WEDOWN };

struct Frame {
    LAS unsigned char* lds; volatile LAS unsigned* MISC; unsigned* ctl;
    int wave, vcu, G;
    const float* const* in; float* out; unsigned char* ws;
};
#define TID_ ((int)threadIdx.x)
#define LANE_ ((int)(threadIdx.x & 63u))
#define WSP(T_, off) ((T_*)(F.ws + (off)))

__device__ __forceinline__ void cvt_item(const float* src, int ld_src, bf16* dst, int ld_dst, LAS float* scr, int lane) {
#pragma unroll 8
    for (int i = 0; i < 32; ++i) { const int kk = 2 * i + (lane >> 5); scr[kk * 33 + (lane & 31)] = src[(size_t)kk * ld_src + (lane & 31)]; }
    LDS_WAIT(); asm volatile("" ::: "memory");
    const int c = lane & 7;
#pragma unroll
    for (int j = 0; j < 4; ++j) { const int n = (lane >> 3) + 8 * j; const LAS float* s = scr + (8 * c) * 33 + n;
        u32x4 o; o.x = pk2(s[0 * 33], s[1 * 33]); o.y = pk2(s[2 * 33], s[3 * 33]); o.z = pk2(s[4 * 33], s[5 * 33]); o.w = pk2(s[6 * 33], s[7 * 33]);
        *(u32x4*)(dst + (size_t)n * ld_dst + 8 * c) = o; }
    LDS_WAIT(); asm volatile("" ::: "memory");
}
__device__ __forceinline__ void cvt_moe_item(Frame& F, int l, int it, LAS float* scr, int lane) {
    const int which = it >> 13, r = it & 8191, e = r >> 9, q = r & 511, kb = q >> 5, nb = q & 31, n0 = nb * 32;
    const float* W = F.in[which == 0 ? I_WEGATE : (which == 1 ? I_WEUP : I_WEDOWN)] + ((size_t)(l * NE + e) * 1024 + kb * 64) * 1024 + n0;
    bf16* dst;
    if (which < 2) dst = WSP(bf16, WS_WGU) + ((size_t)e * 2048 + (n0 >> 7) * 256 + which * 128 + (n0 & 127)) * 1024 + kb * 64;
    else dst = WSP(bf16, WS_WD) + ((size_t)e * 1024 + n0) * 1024 + kb * 64;
    cvt_item(W, 1024, dst, 1024, scr, lane);
}
constexpr int CVT_BLK = 32, CVT_NBLK = 3 * 8192 / CVT_BLK;
__device__ __forceinline__ void cvt_moe_block(Frame& F, int l, int bi) {
    int lane = LANE_; asm volatile("" : "+v"(lane));
    LAS float* scr = (LAS float*)(F.lds + F.wave * 16384);
#pragma unroll 1
    for (int k = 0; k < CVT_BLK / NWAVES; ++k) cvt_moe_item(F, l, bi * CVT_BLK + k * NWAVES + F.wave, scr, lane);
}

__device__ __forceinline__ void phase_init(Frame& F) {
    const int tid = TID_;
    {
        LAS float* sil = (LAS float*)F.lds;
        LAS float* red = (LAS float*)(F.lds + 40960);
        float* MOD = WSP(float, WS_MOD);
        bool have = false;
        for (int it = F.vcu; it < 2 * 96; it += F.G) {
            if (!have) {
                for (int i = tid; i < 9 * 1024; i += NTHREADS) { const int r = i >> 10, k = i & 1023; const float cv = (r < 8) ? F.in[I_C][r * 1024 + k] : F.in[I_CCTX][k]; sil[i] = cv / (1.f + expf(-cv)); }
                __syncthreads(); have = true;
            }
            const int l = it / 96, n0 = (it % 96) * 64, ks = tid >> 6, col = tid & 63;
            float acc[9];
#pragma unroll
            for (int r = 0; r < 9; ++r) acc[r] = 0.f;
            const float* w = F.in[I_WMOD] + ((size_t)l * 1024 + ks * 128) * 6144 + n0 + col;
            for (int k = 0; k < 128; ++k) { const float wv = w[(size_t)k * 6144];
#pragma unroll
                for (int r = 0; r < 9; ++r) acc[r] += sil[r * 1024 + ks * 128 + k] * wv; }
#pragma unroll
            for (int r = 0; r < 9; ++r) red[(ks * 9 + r) * 64 + col] = acc[r];
            __syncthreads();
            for (int o = tid; o < 576; o += NTHREADS) { const int r = o >> 6, cc = o & 63; float s = 0.f;
#pragma unroll
                for (int k2 = 0; k2 < 8; ++k2) s += red[(k2 * 9 + r) * 64 + cc];
                MOD[(size_t)(l * 9 + r) * 6144 + n0 + cc] = s + F.in[I_BMOD][l * 6144 + n0 + cc]; }
            __syncthreads();
        }
        __syncthreads();
    }
    {
        LAS float* scr = (LAS float*)(F.lds + F.wave * 16384);
        const int gw = F.vcu * NWAVES + F.wave, NGW = F.G * NWAVES;
        bf16* WIN = WSP(bf16, WS_WIN); bf16* WOUT = WSP(bf16, WS_WOUT);
        for (int it = gw; it < 2 * (1344 + 512); it += NGW) {
            const int l = it / 1856, r = it % 1856;
            if (r < 1344) { const int kb = r / 84, n0 = (r % 84) * 32; const int dn = n0 < 768 ? n0 : (n0 < 1920 ? n0 + 768 : n0 - 1152);
                cvt_item(F.in[I_WIN] + ((size_t)l * 1024 + kb * 64) * 2688 + n0, 2688, WIN + ((size_t)l * NINP + dn) * 1024 + kb * 64, 1024, scr, LANE_); }
            else { const int q = r - 1344, kb = q >> 5, n0 = (q & 31) * 32;
                cvt_item(F.in[I_WOUT] + ((size_t)l * 1024 + kb * 64) * 1024 + n0, 1024, WOUT + ((size_t)l * 1024 + n0) * 1024 + kb * 64, 1024, scr, LANE_); }
        }
    }
    {
        const size_t gt = (size_t)F.vcu * NTHREADS + tid, NT = (size_t)F.G * NTHREADS;
        u32x4* WIN4 = WSP(u32x4, WS_WIN);
        for (size_t i = gt; i < (size_t)2 * 128 * 128; i += NT) { const int l = (int)(i >> 14), r = (int)(i & 16383); WIN4[((size_t)l * NINP + 2688) * 128 + r] = (u32x4){0u, 0u, 0u, 0u}; }
        bf16* LORA = WSP(bf16, WS_LORA);
        for (size_t i = gt; i < (size_t)2 * 1280 * 384; i += NT) { const int l = (int)(i / (1280 * 384)), r = (int)(i % (1280 * 384)), n = r / 384, k = r % 384, tile = n >> 8, nn = n & 255;
            float v = 0.f;
            if (tile < 2) { const int d = tile, kk = k - 64 * d; if (kk >= 0 && kk < 64) v = F.in[I_WUP][(((size_t)l * 2 + d) * 64 + kk) * 256 + nn]; }
            else if (tile < 4) { const int d = tile - 2, kk = k - 128 - 64 * d; if (kk >= 0 && kk < 64) v = F.in[I_AUP][(((size_t)l * 2 + d) * 64 + kk) * 256 + nn]; }
            else { const int kk = k - 256; if (kk >= 0) v = F.in[I_GUP][((size_t)l * 128 + kk) * 256 + nn]; }
            LORA[i] = (bf16)f2bf(v); }
    }
}

__device__ __forceinline__ const float* in_row(Frame& F, int b, int t) { return t < CTXL ? F.in[I_CTX] + ((size_t)b * CTXL + t) * 1024 : F.in[I_X] + ((size_t)b * SEQ + (t - CTXL)) * 1024; }
__device__ __forceinline__ float row_ss(const f32x4 (&v)[4]) {
    float s = 0.f;
#pragma unroll
    for (int j = 0; j < 4; ++j) s += (v[j][0] * v[j][0] + v[j][1] * v[j][1]) + (v[j][2] * v[j][2] + v[j][3] * v[j][3]);
    return wave_sum(s);
}
__device__ __forceinline__ void mod_store(const f32x4 (&x)[4], float rinv, const float* g, const float* shift, const float* scale, bf16* dst, int lane, f32x4 (&h)[4]) {
#pragma unroll
    for (int j = 0; j < 4; ++j) { const int e = 256 * j + 4 * lane;
        const f32x4 gg = *(const f32x4*)(g + e), sh = *(const f32x4*)(shift + e), sc = *(const f32x4*)(scale + e);
        h[j] = x[j] * rinv * gg * (sc + 1.f) + sh;
        u32x2 w; w.x = pk2(h[j][0], h[j][1]); w.y = pk2(h[j][2], h[j][3]); *(u32x2*)(dst + e) = w; }
}
__device__ __forceinline__ void phase_row0(Frame& F) {
    const int gw = F.vcu * NWAVES + F.wave, NGW = F.G * NWAVES, lane = LANE_;
    bf16* H = WSP(bf16, WS_H); const float* MOD = WSP(float, WS_MOD);
    for (int m = gw; m < M; m += NGW) { const int b = m / T, t = m % T, r = t < CTXL ? 8 : b;
        const float* xin = in_row(F, b, t);
        f32x4 x[4], h[4];
#pragma unroll
        for (int j = 0; j < 4; ++j) x[j] = *(const f32x4*)(xin + 256 * j + 4 * lane);
        const float rinv = rsqrtf(row_ss(x) * (1.f / 1024.f) + 1e-6f);
        const float* md = MOD + (size_t)(0 * 9 + r) * 6144;
        mod_store(x, rinv, F.in[I_GPREMIX], md, md + 1024, H + (size_t)m * 1024, lane, h);
    }
}
__device__ __forceinline__ void phase_row1(Frame& F, int l, bool dry = false) {
    const int gw = F.vcu * NWAVES + F.wave, NGW = F.G * NWAVES, lane = LANE_;
    const float* X = WSP(float, WS_X); const float* Y = WSP(float, WS_Y); const float* MOD = WSP(float, WS_MOD);
    float* Xs = dry ? WSP(float, WS_XE) : WSP(float, WS_X); bf16* H2 = dry ? WSP(bf16, WS_XE) : WSP(bf16, WS_H2);
    float* AFF = dry ? WSP(float, WS_XE) : WSP(float, WS_AFF); int* INV = dry ? WSP(int, WS_XE) : WSP(int, WS_INV);
    {
        const f32x4* src = (const f32x4*)(F.in[I_WROUTER] + (size_t)l * 1024 * 16); LAS f32x4* dstl = (LAS f32x4*)F.lds;
        for (int i = TID_; i < 4096; i += NTHREADS) dstl[i] = src[i];
        __syncthreads();
    }
    const LAS float* wbase = (const LAS float*)F.lds + lane * 64;
    for (int m = gw; m < M; m += NGW) { const int b = m / T, t = m % T, r = t < CTXL ? 8 : b;
        if (l == NL - 1 && t < CTXL) continue;
        const float* md = MOD + (size_t)(l * 9 + r) * 6144;
        f32x4 x[4], y[4], h[4];
        const float* xin = (l == 0) ? in_row(F, b, t) : X + (size_t)m * 1024;
#pragma unroll
        for (int j = 0; j < 4; ++j) { y[j] = *(const f32x4*)(Y + (size_t)m * 1024 + 256 * j + 4 * lane); x[j] = *(const f32x4*)(xin + 256 * j + 4 * lane); }
        const float rinv = rsqrtf(row_ss(y) * (1.f / 1024.f) + 1e-6f);
#pragma unroll
        for (int j = 0; j < 4; ++j) { const int e = 256 * j + 4 * lane;
            const f32x4 gg = *(const f32x4*)(F.in[I_GPOSTMIX] + l * 1024 + e), gt = *(const f32x4*)(md + 2 * 1024 + e);
            x[j] = x[j] + gt * (y[j] * rinv * gg); *(f32x4*)(Xs + (size_t)m * 1024 + e) = x[j]; }
        const float rinv2 = rsqrtf(row_ss(x) * (1.f / 1024.f) + 1e-6f);
        mod_store(x, rinv2, F.in[I_GPREFFN] + l * 1024, md + 3 * 1024, md + 4 * 1024, H2 + (size_t)m * 1024, lane, h);
        float lg[16];
#pragma unroll
        for (int k = 0; k < 16; ++k) lg[k] = 0.f;
#pragma unroll
        for (int j = 0; j < 4; ++j)
#pragma unroll
            for (int c = 0; c < 4; ++c) { const LAS float* w = wbase + j * 4096 + c * 16; const float hv = h[j][c];
#pragma unroll
                for (int q = 0; q < 4; ++q) { const f32x4 wv = *(const LAS f32x4*)(w + 4 * q); lg[4 * q + 0] += hv * wv[0]; lg[4 * q + 1] += hv * wv[1]; lg[4 * q + 2] += hv * wv[2]; lg[4 * q + 3] += hv * wv[3]; }
                asm volatile("" ::: "memory"); }
        float mx = -1e30f;
#pragma unroll
        for (int k = 0; k < 16; ++k) { lg[k] = wave_sum(lg[k]); mx = fmaxf(mx, lg[k]); }
        float den = 0.f, mine = 0.f;
#pragma unroll
        for (int k = 0; k < 16; ++k) { const float ex = expf(lg[k] - mx); den += ex; if ((lane & 15) == k) mine = ex; }
        if (lane < 16) { AFF[(size_t)m * 16 + lane] = mine / den; INV[(size_t)m * 16 + lane] = -1; }
    }
}
__device__ __forceinline__ void phase_row2(Frame& F, int l, bool dry = false) {
    const int gw = F.vcu * NWAVES + F.wave, NGW = F.G * NWAVES, lane = LANE_;
    const float* X = WSP(float, WS_X); const bf16* OUTE = WSP(bf16, WS_OUTE); const float* MOD = WSP(float, WS_MOD);
    float* Xs = dry ? WSP(float, WS_XE) : WSP(float, WS_X); bf16* H = dry ? WSP(bf16, WS_XE) : WSP(bf16, WS_H); float* outp = dry ? WSP(float, WS_XE) : F.out;
    const int* INV = WSP(int, WS_INV);
    const bool last = (l == NL - 1);
    for (int m = gw; m < M; m += NGW) { const int b = m / T, t = m % T, r = t < CTXL ? 8 : b;
        if (last && t < CTXL) continue;
        const float* md = MOD + (size_t)(l * 9 + r) * 6144;
        f32x4 x[4], f[4], h[4];
#pragma unroll
        for (int j = 0; j < 4; ++j) { x[j] = *(const f32x4*)(X + (size_t)m * 1024 + 256 * j + 4 * lane); f[j] = (f32x4){0.f, 0.f, 0.f, 0.f}; }
        const int invl = INV[(size_t)m * 16 + (lane & 15)];
        for (int e = 0; e < 16; ++e) { const int rr = __shfl(invl, e);
            if (rr >= 0) {
#pragma unroll
                for (int j = 0; j < 4; ++j) { const u32x2 w = *(const u32x2*)(OUTE + (size_t)rr * 1024 + 256 * j + 4 * lane);
                    f[j][0] += bflo(w.x); f[j][1] += bfhi(w.x); f[j][2] += bflo(w.y); f[j][3] += bfhi(w.y); } } }
        const float rinv = rsqrtf(row_ss(f) * (1.f / 1024.f) + 1e-6f);
#pragma unroll
        for (int j = 0; j < 4; ++j) { const int e = 256 * j + 4 * lane;
            const f32x4 gg = *(const f32x4*)(F.in[I_GPOSTFFN] + l * 1024 + e), gt = *(const f32x4*)(md + 5 * 1024 + e);
            x[j] = x[j] + gt * (f[j] * rinv * gg);
            if (last) *(f32x4*)(outp + ((size_t)b * SEQ + (t - CTXL)) * 1024 + e) = x[j];
            else *(f32x4*)(Xs + (size_t)m * 1024 + e) = x[j]; }
        if (!last) {
            const float rinv2 = rsqrtf(row_ss(x) * (1.f / 1024.f) + 1e-6f);
            const float* md2 = MOD + (size_t)((l + 1) * 9 + r) * 6144;
            mod_store(x, rinv2, F.in[I_GPREMIX] + (l + 1) * 1024, md2, md2 + 1024, H + (size_t)m * 1024, lane, h);
        }
    }
}

__device__ __forceinline__ void phase_qkprep(Frame& F, int l, bool dry = false) {
    const int gw = F.vcu * NWAVES + F.wave, NGW = F.G * NWAVES, lane = LANE_;
    bf16* QKV = WSP(bf16, WS_QKV); bf16* QO = dry ? WSP(bf16, WS_YD) : QKV;
    const float qg = F.in[I_QGAIN][l * 64 + lane] * C2, kg = F.in[I_KGAIN][l * 64 + lane];
    const int i16 = lane & 15; const bool second = (lane & 16) != 0, colseg = (lane & 32) != 0;
    const float inv = exp2f(-(float)i16 * (13.287712379549449f / 16.f));
    for (int m = gw; m < M; m += NGW) { const int t = m % T; const bool ctx = t < CTXL;
        const int s0 = (l == NL - 1 && ctx) ? 8 : 0;
        const bf16* p = QKV + (size_t)m * 1536 + lane; bf16* po = QO + (size_t)m * 1536 + lane;
        float x[10];
#pragma unroll
        for (int s = 0; s < 10; ++s) x[s] = (s >= s0) ? bf2f(p[s * 64]) : 0.f;
        float cs = 1.f, sn = 0.f;
        if (!ctx) { const int pos = t - CTXL; const float ang = (float)(colseg ? (pos & 63) : (pos >> 6)) * inv; cs = cosf(ang); sn = sinf(ang); if (!second) sn = -sn; }
#pragma unroll
        for (int s = 0; s < 10; ++s) {
            if (s < s0) continue;
            const float ss = wave_sum(x[s] * x[s]);
            float y = x[s] * __builtin_amdgcn_rsqf(ss * (1.f / 64.f) + 1e-6f) * (s < 8 ? qg : kg);
            const float other = __shfl_xor(y, 16);
            y = y * cs + other * sn;
            po[s * 64] = (bf16)f2bf(y);
        }
    }
}
#include <hip/hip_bf16.h>
#include <cmath>
namespace attn_body {
using bf16=__hip_bfloat16;
using bf16x8=__attribute__((ext_vector_type(8)))short;
using s16x4=__attribute__((ext_vector_type(4)))short;
using f32x16=__attribute__((ext_vector_type(16)))float;
using u32x4=__attribute__((ext_vector_type(4)))unsigned;
constexpr int D=64,QP=1536,OP=1024;
constexpr int NW=8,QBLK=32,QB=QBLK*NW,KVBLK=64;
__device__ __forceinline__ int crow(int r,int hi){return (r&3)+8*(r>>2)+4*hi;}
#define SBAR() __builtin_amdgcn_sched_barrier(0)
constexpr int NSLOT=3, SLOTB=8192;
constexpr int LDS_K=0, LDS_V=NSLOT*SLOTB, LDS_WS=2*NSLOT*SLOTB, LDS_OST=LDS_WS+NW*64*4, LDS_RPB=LDS_OST+NW*4096, LDS_BYTES=LDS_RPB+3072;
constexpr float C2=0.125f*1.4426950408889634f;
__device__ __forceinline__ void glds16(const void*gsrc,unsigned lds_dst){unsigned keep;
  asm volatile("s_mov_b32 %0, m0\n\ts_mov_b32 m0, %2\n\ts_nop 0\n\tglobal_load_lds_dwordx4 %1, off\n\ts_mov_b32 m0, %0":"=&s"(keep):"v"(gsrc),"s"(lds_dst):"memory");}
__device__ __forceinline__ float max3f(float a,float b,float c){float r;asm("v_max3_f32 %0, %1, %2, %3":"=v"(r):"v"(a),"v"(b),"v"(c));return r;}
__device__ __forceinline__ float max2f(float a,float b){float r;asm("v_max_f32_e32 %0, %1, %2":"=v"(r):"v"(a),"v"(b));return r;}
__device__ __forceinline__ float fadd_s(float a,float b){float r;asm("v_add_f32_e32 %0, %1, %2":"=v"(r):"v"(a),"v"(b));return r;}
__device__ __forceinline__ float fsub_s(float a,float b){float r;asm("v_sub_f32_e32 %0, %1, %2":"=v"(r):"v"(a),"v"(b));return r;}
typedef float f32x2_t __attribute__((ext_vector_type(2))); typedef __bf16 bf16x2_t __attribute__((ext_vector_type(2)));
__device__ __forceinline__ unsigned cvtpk_s(float lo,float hi){f32x2_t v={lo,hi};bf16x2_t b=__builtin_convertvector(v,bf16x2_t);return __builtin_bit_cast(unsigned,b);}
#define WAIT_BAR(N) asm volatile("s_waitcnt vmcnt(" #N ") lgkmcnt(0)\n\ts_barrier":::"memory")

__device__ __forceinline__ void qkt(f32x16&p0,f32x16&p1,const char*Kslot,const bf16x8*qr,const f32x16&negm,int r32,int hi){
  const char*kb=Kslot+hi*1024+r32*16;
  #pragma unroll
  for(int d0=0;d0<4;++d0){
    const bf16x8 b0=*reinterpret_cast<const bf16x8*>(kb+d0*2048);
    const bf16x8 b1=*reinterpret_cast<const bf16x8*>(kb+d0*2048+512);
    if(d0==0){p0=__builtin_amdgcn_mfma_f32_32x32x16_bf16(b0,qr[0],negm,0,0,0);p1=__builtin_amdgcn_mfma_f32_32x32x16_bf16(b1,qr[0],negm,0,0,0);}
    else{p0=__builtin_amdgcn_mfma_f32_32x32x16_bf16(b0,qr[d0],p0,0,0,0);p1=__builtin_amdgcn_mfma_f32_32x32x16_bf16(b1,qr[d0],p1,0,0,0);}}
}
typedef __attribute__((address_space(3))) const char* lds_cptr;
typedef short v4i16_t __attribute__((ext_vector_type(4)));
__device__ __forceinline__ void kload8(bf16x8*kf,lds_cptr kp){
  kf[0]=*(const __attribute__((address_space(3))) bf16x8*)(kp);      kf[1]=*(const __attribute__((address_space(3))) bf16x8*)(kp+512);
  kf[2]=*(const __attribute__((address_space(3))) bf16x8*)(kp+2048); kf[3]=*(const __attribute__((address_space(3))) bf16x8*)(kp+2560);
  kf[4]=*(const __attribute__((address_space(3))) bf16x8*)(kp+4096); kf[5]=*(const __attribute__((address_space(3))) bf16x8*)(kp+4608);
  kf[6]=*(const __attribute__((address_space(3))) bf16x8*)(kp+6144); kf[7]=*(const __attribute__((address_space(3))) bf16x8*)(kp+6656);
}
__device__ __forceinline__ void kload2(bf16x8*kf,lds_cptr kp,int j){ kf[2*j]=*(const __attribute__((address_space(3))) bf16x8*)(kp+j*2048); kf[2*j+1]=*(const __attribute__((address_space(3))) bf16x8*)(kp+j*2048+512); }
__device__ __forceinline__ s16x4 vtr(lds_cptr p){ return __builtin_bit_cast(s16x4,__builtin_amdgcn_ds_read_tr16_b64_v4i16((__attribute__((address_space(3))) v4i16_t*)p)); }
__device__ __forceinline__ float rowmax(const f32x16&p0,const f32x16&p1){
  float a=max3f(p0[0],p0[1],p1[0]),b=max3f(p0[2],p0[3],p1[1]);a=max3f(a,p1[2],p1[3]);
  #pragma unroll
  for(int r=4;r<16;r+=4){a=max3f(a,p0[r],p0[r+1]);b=max3f(b,p0[r+2],p0[r+3]);a=max3f(a,p1[r],p1[r+1]);b=max3f(b,p1[r+2],p1[r+3]);}
  const float m=max2f(a,b);
  auto rr=__builtin_amdgcn_permlane32_swap(__float_as_uint(m),__float_as_uint(m),false,false);
  return max2f(__uint_as_float(rr[0]),__uint_as_float(rr[1]));
}
__device__ __forceinline__ void pv(f32x16*o,int vb,bf16x8 pa0,bf16x8 pa1,bf16x8 pa2,bf16x8 pa3){
  #pragma unroll
  for(int d0=0;d0<2;++d0){s16x4 lo[4],hi[4];
    #pragma unroll
    for(int ks=0;ks<4;++ks){
      asm volatile("ds_read_b64_tr_b16 %0,%1 offset:%c2":"=&v"(lo[ks]):"v"(vb),"i"(d0*4096+ks*1024):"memory");
      asm volatile("ds_read_b64_tr_b16 %0,%1 offset:%c2":"=&v"(hi[ks]):"v"(vb),"i"(d0*4096+ks*1024+512):"memory");}
    asm volatile("s_waitcnt lgkmcnt(0)":::"memory");SBAR();
    #define PK(k) (bf16x8){lo[k][0],lo[k][1],lo[k][2],lo[k][3],hi[k][0],hi[k][1],hi[k][2],hi[k][3]}
    o[d0]=__builtin_amdgcn_mfma_f32_32x32x16_bf16(pa0,PK(0),o[d0],0,0,0);
    o[d0]=__builtin_amdgcn_mfma_f32_32x32x16_bf16(pa1,PK(1),o[d0],0,0,0);
    o[d0]=__builtin_amdgcn_mfma_f32_32x32x16_bf16(pa2,PK(2),o[d0],0,0,0);
    o[d0]=__builtin_amdgcn_mfma_f32_32x32x16_bf16(pa3,PK(3),o[d0],0,0,0);
    #undef PK
  }
}

#ifndef ATTN_STORE16
#define ATTN_STORE16(p,v) (*(u32x4*)(p)=(v))
#endif
template<int THRL,bool WIN> __device__ __forceinline__ void attn_unit(const bf16*Qw0,const bf16*__restrict__ Kh,const bf16*__restrict__ Vh,bf16*Ow0,const int NT,const int toff,const int rb,const int rs0,const float*rpbh,char*shm){
  int tid_=threadIdx.x; asm volatile("":"+v"(tid_));
  const int tid=tid_,lane=tid&63,r32=lane&31,hi=lane>>5; const int wid=__builtin_amdgcn_readfirstlane(tid>>6);
  const bf16*Qw=Qw0+(long)(wid*QBLK)*QP;
  const unsigned lds0=(unsigned)(uintptr_t)shm;
  float*wsf=(float*)(shm+LDS_WS)+wid*64;
  const bf16*ksrc=Kh+(long)lane*QP+wid*8;
  const bf16*vsrc=Vh+(long)(16*(wid&3)+(lane>>2))*QP+(wid>>2)*32+(lane&3)*8;
  const unsigned kdst=lds0+LDS_K+wid*1024, vdst=lds0+LDS_V+wid*1024;
  #define TROW(t) ((long)(((t)+(((t)>=4)?toff:0))*KVBLK)*QP)
  #define DMA_K(t,slot) glds16(ksrc+TROW(t),(unsigned)__builtin_amdgcn_readfirstlane(kdst+(slot)))
  #define DMA_V(t,slot) glds16(vsrc+TROW(t),(unsigned)__builtin_amdgcn_readfirstlane(vdst+(slot)))
  const int vb0=(int)(lds0+LDS_V)+((lane>>4)&1)*32+(lane&3)*8+(4*hi+((lane&15)>>2))*64;
  const char*Kbase=shm+LDS_K; bf16x8 kf[8];
  const lds_cptr shm3=(lds_cptr)shm; const lds_cptr kp0=shm3+LDS_K+hi*1024+r32*16; const lds_cptr vp0=shm3+LDS_V+((lane>>4)&1)*32+(lane&3)*8+(4*hi+((lane&15)>>2))*64;
  DMA_K(0,0);DMA_V(0,0);DMA_K(1,SLOTB);
  bf16x8 qr[4];
  #pragma unroll
  for(int d0=0;d0<4;++d0)qr[d0]=*reinterpret_cast<const bf16x8*>(&Qw[(long)r32*QP+d0*16+hi*8]);
  float mhat=0.f,l_reg=0.f;f32x16 o[2];o[0]=f32x16{};o[1]=f32x16{};f32x16 negm=f32x16{};asm volatile("":"+v"(negm));
  const int gr=4*rb+(wid>>1), gc=(wid&1)*32+r32, rsq=min(max(gr-4,0),24), csq=min(max(gc-8,0),48);
  const float*rpbl=(const float*)(shm+LDS_RPB+256)+(15-gc+4*hi);
  const int kcb=4*hi-csq;
  if(WIN){ for(int i_=tid;i_<15*31;i_+=512)((float*)(shm+LDS_RPB+256))[i_]=rpbh[i_]*1.4426950408889634f; }
  #define CMASK(P0,P1,t) do{ if(WIN && (t)>=4){ const int kr_=rs0+(t)-4; const bool rowok_=(kr_>=rsq)&&(kr_<rsq+8); \
      if(!rowok_){ _Pragma("unroll") for(int r=0;r<16;++r){P0[r]=-INFINITY;P1[r]=-INFINITY;} } \
      else { const float*bp_=rpbl+(kr_-gr+7)*31; \
        _Pragma("unroll") for(int r=0;r<16;++r){ const int o_=(r&3)+8*(r>>2); \
          const float b0_=bp_[o_], b1_=bp_[o_+32]; \
          P0[r]=((unsigned)(kcb+o_)<16u)?P0[r]+b0_:-INFINITY; P1[r]=((unsigned)(kcb+o_+32)<16u)?P1[r]+b1_:-INFINITY; } } } }while(0)
  bool resc=false;
  #define START(P0,P1) do{ const float rm=rowmax(P0,P1); resc=false; \
    { const float dl=rm; mhat=fadd_s(mhat,dl); \
      _Pragma("unroll") for(int r=0;r<16;++r){P0[r]=fsub_s(P0[r],dl);P1[r]=fsub_s(P1[r],dl);} \
      _Pragma("unroll") for(int r=0;r<16;++r)negm[r]=-mhat; asm volatile("":"+v"(negm)); } \
    _Pragma("unroll") for(int r=0;r<16;++r)P0[r]=__builtin_amdgcn_exp2f(P0[r]); }while(0)
  #define RESC() do{ if(resc){ asm volatile("s_waitcnt lgkmcnt(0)":::"memory"); \
      _Pragma("unroll") for(int d_=0;d_<2;++d_) _Pragma("unroll") for(int r=0;r<16;++r)o[d_][r]*=wsf[crow(r,hi)]; } }while(0)
  f32x16 pA0,pA1,pB0,pB1;
  int sl_prev=0,sl_cur=0,sl_next=SLOTB;
  #define ROT() do{sl_prev=sl_cur;sl_cur=sl_next;sl_next=(sl_next==(NSLOT-1)*SLOTB)?0:sl_next+SLOTB;}while(0)
  DMA_K(2,2*SLOTB);
  WAIT_BAR(3);
  qkt(pA0,pA1,Kbase,qr,negm,r32,hi);asm volatile("s_nop 15\n\ts_nop 7":"+v"(pA0),"+v"(pA1));CMASK(pA0,pA1,0);
  START(pA0,pA1);
  _Pragma("unroll") for(int r=0;r<16;++r)pA1[r]=__builtin_amdgcn_exp2f(pA1[r]);
  WAIT_BAR(0);
  DMA_K(3,0);DMA_V(1,SLOTB);
  ROT();
  kload8(kf,kp0+sl_cur);
  WAIT_BAR(2);
  s16x4 vlo[8],vhi[8]; u32x4 pw0,pw1,pw2,pw3;
  #define PKW(P,B) cvtpk_s(P[B],P[B+1])
  #define PAF(k) __builtin_bit_cast(bf16x8,pw##k)
  #define VFR(i) (bf16x8){vlo[i][0],vlo[i][1],vlo[i][2],vlo[i][3],vhi[i][0],vhi[i][1],vhi[i][2],vhi[i][3]}
  #define PIN(x) asm volatile("":"+v"(x))
  #define MX3(a,b,c) __builtin_fmaxf(__builtin_fmaxf((a),(b)),(c))
  #define GAPA(MF,A0,A1,A2,A3,W0,W1,PW) do{ MF; sacc+=A0; sacc+=A1; sacc+=A2; sacc+=A3; PIN(sacc); W0; W1; PIN(PW); SBAR(); }while(0)
  #define EX(v) __builtin_amdgcn_exp2f(v)
  #define GAPB(MF,X,B) do{ MF; X[B]=EX(X[B]); X[B+1]=EX(X[B+1]); X[B+2]=EX(X[B+2]); X[B+3]=EX(X[B+3]); PIN(X); SBAR(); }while(0)
  #define VRD(i) do{ vlo[i]=vtr(vp_+(((i)>>2)*4096+((i)&3)*1024)); vhi[i]=vtr(vp_+(((i)>>2)*4096+((i)&3)*1024+512)); }while(0)
  #define KRD(G,j) do{ if(G){ kload2(kf,kp0+sl_next,j); SBAR(); } }while(0)
  #define STEP(C0,C1,P0,P1,t,GK,GV,GL) do{ SBAR(); \
    const lds_cptr vp_=vp0+sl_prev; \
    VRD(0); SBAR(); float sacc=(P0[0]+P0[1]); \
    GAPA(C0=__builtin_amdgcn_mfma_f32_32x32x16_bf16(kf[0],qr[0],negm,0,0,0), P0[2],P0[3],P0[4],P0[5],     pw0[0]=PKW(P0,0), pw0[1]=PKW(P0,2), pw0); \
    VRD(4); SBAR(); GAPA(C1=__builtin_amdgcn_mfma_f32_32x32x16_bf16(kf[1],qr[0],negm,0,0,0), P0[6],P0[7],P0[8],P0[9],     pw0[2]=PKW(P0,4), pw0[3]=PKW(P0,6), pw0); \
    VRD(1); SBAR(); GAPA(C0=__builtin_amdgcn_mfma_f32_32x32x16_bf16(kf[2],qr[1],C0,0,0,0),   P0[10],P0[11],P0[12],P0[13], pw1[0]=PKW(P0,8), pw1[1]=PKW(P0,10), pw1); \
    VRD(5); SBAR(); GAPA(C1=__builtin_amdgcn_mfma_f32_32x32x16_bf16(kf[3],qr[1],C1,0,0,0),   P0[14],P0[15],P1[0],P1[1],   pw1[2]=PKW(P0,12),pw1[3]=PKW(P0,14), pw1); \
    VRD(2); SBAR(); GAPA(C0=__builtin_amdgcn_mfma_f32_32x32x16_bf16(kf[4],qr[2],C0,0,0,0),   P1[2],P1[3],P1[4],P1[5],     pw2[0]=PKW(P1,0), pw2[1]=PKW(P1,2), pw2); \
    VRD(6); SBAR(); GAPA(C1=__builtin_amdgcn_mfma_f32_32x32x16_bf16(kf[5],qr[2],C1,0,0,0),   P1[6],P1[7],P1[8],P1[9],     pw2[2]=PKW(P1,4), pw2[3]=PKW(P1,6), pw2); \
    VRD(3); SBAR(); GAPA(C0=__builtin_amdgcn_mfma_f32_32x32x16_bf16(kf[6],qr[3],C0,0,0,0),   P1[10],P1[11],P1[12],P1[13], pw3[0]=PKW(P1,8), pw3[1]=PKW(P1,10), pw3); \
    VRD(7); SBAR(); GAPA(C1=__builtin_amdgcn_mfma_f32_32x32x16_bf16(kf[7],qr[3],C1,0,0,0),   P1[14],P1[15],0.f,0.f,       pw3[2]=PKW(P1,12),pw3[3]=PKW(P1,14), pw3); \
    l_reg+=sacc; \
    if(GK){DMA_K((t)+3,sl_cur);} if(GV){DMA_V((t)+1,sl_next);} \
    CMASK(C0,C1,t); \
    { float a=MX3(C0[0],C0[1],C1[0]),b=MX3(C0[2],C0[3],C1[1]); a=MX3(a,C1[2],C1[3]); \
      _Pragma("unroll") for(int r=4;r<16;r+=4){a=MX3(a,C0[r],C0[r+1]);b=MX3(b,C0[r+2],C0[r+3]);a=MX3(a,C1[r],C1[r+1]);b=MX3(b,C1[r+2],C1[r+3]);} \
      float rm=__builtin_fmaxf(a,b); { auto rr=__builtin_amdgcn_permlane32_swap(__float_as_uint(rm),__float_as_uint(rm),false,false); rm=__builtin_fmaxf(__uint_as_float(rr[0]),__uint_as_float(rr[1])); } \
      resc=false; \
      if(__builtin_expect(__any(rm>(float)THRL),0)){ const float dl=__builtin_fmaxf(rm,0.f); mhat+=dl; \
        _Pragma("unroll") for(int r=0;r<16;++r){C0[r]-=dl;C1[r]-=dl;} \
        _Pragma("unroll") for(int r=0;r<16;++r)negm[r]=-mhat; asm volatile("":"+v"(negm)); \
        const float f=__builtin_amdgcn_exp2f(-dl); l_reg*=f; if(hi==0)wsf[r32]=f; resc=true; } } \
    SBAR(); \
    GAPB(o[0]=__builtin_amdgcn_mfma_f32_32x32x16_bf16(PAF(0),VFR(0),o[0],0,0,0), C0,0); \
    GAPB(o[1]=__builtin_amdgcn_mfma_f32_32x32x16_bf16(PAF(0),VFR(4),o[1],0,0,0), C0,4); \
    KRD(GL,0); GAPB(o[0]=__builtin_amdgcn_mfma_f32_32x32x16_bf16(PAF(1),VFR(1),o[0],0,0,0), C0,8); \
    KRD(GL,1); GAPB(o[1]=__builtin_amdgcn_mfma_f32_32x32x16_bf16(PAF(1),VFR(5),o[1],0,0,0), C0,12); \
    KRD(GL,2); GAPB(o[0]=__builtin_amdgcn_mfma_f32_32x32x16_bf16(PAF(2),VFR(2),o[0],0,0,0), C1,0); \
    KRD(GL,3); GAPB(o[1]=__builtin_amdgcn_mfma_f32_32x32x16_bf16(PAF(2),VFR(6),o[1],0,0,0), C1,4); \
    GAPB(o[0]=__builtin_amdgcn_mfma_f32_32x32x16_bf16(PAF(3),VFR(3),o[0],0,0,0), C1,8); \
    GAPB(o[1]=__builtin_amdgcn_mfma_f32_32x32x16_bf16(PAF(3),VFR(7),o[1],0,0,0), C1,12); \
    }while(0)
  int t=1;
  for(;t+5<NT;t+=2){
    STEP(pB0,pB1,pA0,pA1,t,true,true,true);     WAIT_BAR(2); RESC(); ROT();
    STEP(pA0,pA1,pB0,pB1,t+1,true,true,true);   WAIT_BAR(2); RESC(); ROT();
  }
  #define ENDW(tt) do{ if((tt)+3<NT){WAIT_BAR(2);} else if((tt)+2<NT){WAIT_BAR(1);} else {WAIT_BAR(0);} }while(0)
  for(;t+1<NT;t+=2){
    STEP(pB0,pB1,pA0,pA1,t,(t+3<NT),(t+1<NT),(t+1<NT));       ENDW(t);   RESC(); ROT();
    STEP(pA0,pA1,pB0,pB1,t+1,(t+4<NT),(t+2<NT),(t+2<NT));     ENDW(t+1); RESC(); ROT();
  }
  STEP(pB0,pB1,pA0,pA1,NT-1,false,false,false); RESC();
  { float sacc=pB0[0]+pB0[1]; _Pragma("unroll") for(int r=2;r<16;++r)sacc+=pB0[r]; _Pragma("unroll") for(int r=0;r<16;++r)sacc+=pB1[r]; l_reg+=sacc;
    pw0=(u32x4){PKW(pB0,0),PKW(pB0,2),PKW(pB0,4),PKW(pB0,6)};pw1=(u32x4){PKW(pB0,8),PKW(pB0,10),PKW(pB0,12),PKW(pB0,14)};pw2=(u32x4){PKW(pB1,0),PKW(pB1,2),PKW(pB1,4),PKW(pB1,6)};pw3=(u32x4){PKW(pB1,8),PKW(pB1,10),PKW(pB1,12),PKW(pB1,14)};
    SBAR(); pv(o,vb0+sl_cur,PAF(0),PAF(1),PAF(2),PAF(3)); }
  #undef PKW
  #undef PAF
  #undef VFR
  #undef PIN
  #undef MX3
  #undef GAPA
  #undef GAPB
  #undef EX
  #undef VRD
  #undef KRD
  #undef STEP
  #undef ENDW
  {auto rr=__builtin_amdgcn_permlane32_swap(__float_as_uint(l_reg),__float_as_uint(l_reg),false,false);l_reg=__uint_as_float(rr[0])+__uint_as_float(rr[1]);}
  if(hi==0)wsf[32+r32]=l_reg;asm volatile("s_waitcnt lgkmcnt(0)":::"memory");
  float rli[16];
  #pragma unroll
  for(int r=0;r<16;++r)rli[r]=__builtin_amdgcn_rcpf(wsf[32+crow(r,hi)]);
  bf16*Ow=Ow0+(long)(wid*QBLK)*OP;
  { bf16*stg=(bf16*)(shm+LDS_OST)+wid*2048;
    #pragma unroll
    for(int r=0;r<16;++r){const int orow=crow(r,hi);
      #pragma unroll
      for(int d0=0;d0<2;++d0)stg[orow*64+d0*32+r32]=__float2bfloat16(o[d0][r]*rli[r]);}
    asm volatile("s_waitcnt lgkmcnt(0)":::"memory");
    #pragma unroll
    for(int i=0;i<4;++i){const int row=i*8+(lane>>3),ch=lane&7; const u32x4 v=*(const u32x4*)(stg+row*64+ch*8); ATTN_STORE16(Ow+(long)row*OP+ch*8,v);} }
  asm volatile("s_waitcnt lgkmcnt(0)\n\ts_barrier":::"memory");
  #undef DMA_K
  #undef TROW
  #undef DMA_V
  #undef CMASK
  #undef START
  #undef RESC
  #undef ROT
}
constexpr int ATTN_LDS_BYTES=LDS_BYTES;
#undef SBAR
#undef WAIT_BAR
}
typedef float f32x2 __attribute__((ext_vector_type(2)));
__device__ __forceinline__ int scan_tok(int p, int dir) { return p < CTXL ? (dir ? CTXL - 1 - p : p) : (dir ? (T + CTXL - 1) - p : p); }

constexpr int CS_NCH = T / 16;
constexpr size_t WS_W1F = WS_H;
typedef float f32x16 __attribute__((ext_vector_type(16)));
typedef __bf16 bf16x2_t __attribute__((ext_vector_type(2)));
__device__ __forceinline__ unsigned cvtpk(float lo, float hi) { f32x2 v = {lo, hi}; bf16x2_t b = __builtin_convertvector(v, bf16x2_t); return __builtin_bit_cast(unsigned, b); }
__device__ __forceinline__ bf16x8 pack8f(float a0, float a1, float a2, float a3, float a4, float a5, float a6, float a7) {
    u32x4 w; w.x = cvtpk(a0, a1); w.y = cvtpk(a2, a3); w.z = cvtpk(a4, a5); w.w = cvtpk(a6, a7); return __builtin_bit_cast(bf16x8, w);
}
#define MF4(a, b, c) __builtin_amdgcn_mfma_f32_16x16x4f32((a), (b), (c), 0, 0, 0)

constexpr int PS = 68, PQ = 17, PP_NW = 5;
constexpr int PP_AT = 0, PP_RT = 16 * PS, PP_BH = 32 * PS, PP_KH = 48 * PS, PP_CM = 64 * PS, PP_EM = PP_CM + 16 * PQ, PP_AP = PP_EM + 16 * PQ, PP_TI = PP_AP + 16 * PQ,
              PP_ET = PP_TI + 16 * PQ, PP_M1 = PP_ET + 16 * PQ, PP_M2 = PP_M1 + 16 * PQ, PP_P15 = PP_M2 + 16 * PQ, PP_FLOATS = PP_P15 + 64,
              PP_N1 = 0, PP_N2 = 1024;
static_assert(PP_NW * PP_FLOATS * 4 <= RING_BYTES && 2048 <= 32 * PS, "pre-pass LDS");
struct PPIn { float rr[16], kb[16], ww[16], as[16]; };
__device__ __forceinline__ void prepass_load(Frame& F, PPIn& I, int rec, int lane) {
    const int ch = rec / CS_NCH, c = rec % CS_NCH, b = ch >> 3, h = (ch >> 1) & 3, dir = ch & 1;
    const float* R32 = WSP(float, WS_R32); const float* DEC = WSP(float, WS_DEC) + (size_t)dir * M * 256; const float* ASIG = WSP(float, WS_ASIG) + (size_t)dir * M * 256;
    const int t0 = scan_tok(c * 16, dir); const int stp = dir ? -1 : 1;
#pragma unroll
    for (int t = 0; t < 16; ++t) { const size_t m = (size_t)b * T + (t0 + stp * t);
        I.rr[t] = R32[m * 768 + h * 64 + lane]; I.kb[t] = R32[m * 768 + 256 + h * 64 + lane]; I.ww[t] = DEC[m * 256 + h * 64 + lane]; I.as[t] = ASIG[m * 256 + h * 64 + lane]; }
}
__device__ __forceinline__ void prepass_record(Frame& F, int l, int rec, LAS float* L, int lane, const PPIn& I) {
    const int ch = rec / CS_NCH, h = (ch >> 1) & 3;
    const int n = lane & 31, hh = lane >> 5;
    bf16* W1F = WSP(bf16, WS_W1F) + (size_t)rec * 2048; bf16* W2F = (bf16*)F.out + (size_t)rec * 3200; float* P15F = F.out + (size_t)rec * 1600 + 1536;
    {
        const float kkw = F.in[I_KK][l * 256 + h * 64 + lane], kaw = F.in[I_KA][l * 256 + h * 64 + lane];
        float P = 1.f;
#pragma unroll
        for (int t = 0; t < 16; ++t) {
            const float r_ = I.rr[t], kb_ = I.kb[t], w_ = I.ww[t], as_ = I.as[t];
            float kk_ = kb_ * kkw; kk_ = kk_ * __builtin_amdgcn_rsqf(fmaxf(wave_sum(kk_ * kk_), 1e-24f));
            const float kd_ = kb_ * (1.f + (as_ - 1.f) * kaw);
            const float Pm = P; P *= w_; const float iP = __builtin_amdgcn_rcpf(P);
            L[PP_AT + t * PS + lane] = -kk_ * Pm; L[PP_RT + t * PS + lane] = r_ * P; L[PP_BH + t * PS + lane] = kk_ * as_ * iP; L[PP_KH + t * PS + lane] = kd_ * iP;
        }
        L[PP_P15 + lane] = P;
    }
    LDS_WAIT(); asm volatile("" ::: "memory");
#pragma unroll
    for (int ks = 0; ks < 4; ++ks) {
        const LAS float* src = L + (n < 16 ? PP_AT + n * PS : PP_RT + (n - 16) * PS) + 16 * ks + 4 * hh;
        const f32x4 lo = *(const LAS f32x4*)src, hi = *(const LAS f32x4*)(src + 8);
        *(bf16x8*)(W1F + (ks * 64 + lane) * 8) = pack8f(lo[0], lo[1], lo[2], lo[3], hi[0], hi[1], hi[2], hi[3]);
    }
    const int fr = lane & 15, fq = lane >> 4;
    f32x4 Cc = (f32x4){0.f, 0.f, 0.f, 0.f}, Ec = Cc, Apc = Cc, Bpc = Cc;
#pragma unroll 4
    for (int kk = 0; kk < 16; ++kk) {
        const float aB = L[PP_BH + fr * PS + 4 * kk + fq], aK = L[PP_KH + fr * PS + 4 * kk + fq], bA = L[PP_AT + fr * PS + 4 * kk + fq], bR = L[PP_RT + fr * PS + 4 * kk + fq];
        Cc = MF4(aB, bA, Cc); Ec = MF4(aK, bA, Ec); Apc = MF4(aB, bR, Apc); Bpc = MF4(aK, bR, Bpc);
    }
#pragma unroll
    for (int r = 0; r < 4; ++r) { const int s = 4 * fq + r, t = fr;
        if (!(s < t)) { Cc[r] = 0.f; Ec[r] = 0.f; } if (!(s <= t)) { Apc[r] = 0.f; Bpc[r] = 0.f; }
        L[PP_CM + s * PQ + t] = Cc[r]; L[PP_EM + s * PQ + t] = Ec[r]; L[PP_AP + s * PQ + t] = Apc[r]; }
    LDS_WAIT(); asm volatile("" ::: "memory");
    {
        float x[16];
#pragma unroll
        for (int t = 0; t < 16; ++t) { float acc = (fr == t) ? 1.f : 0.f;
#pragma unroll
            for (int s = 0; s < t; ++s) acc += x[s] * L[PP_CM + s * PQ + t];
            x[t] = acc; }
        if (fq == 0) {
#pragma unroll
            for (int t = 0; t < 16; ++t) L[PP_TI + fr * PQ + t] = x[t]; }
    }
    LDS_WAIT(); asm volatile("" ::: "memory");
    f32x4 ETc = (f32x4){0.f, 0.f, 0.f, 0.f}, M1c = ETc;
#pragma unroll
    for (int kk = 0; kk < 4; ++kk) {
        const float aE = L[PP_EM + fr * PQ + 4 * kk + fq], aT = L[PP_TI + fr * PQ + 4 * kk + fq], bT = L[PP_TI + (4 * kk + fq) * PQ + fr], bAp = L[PP_AP + (4 * kk + fq) * PQ + fr];
        ETc = MF4(aE, bT, ETc); M1c = MF4(aT, bAp, M1c);
    }
#pragma unroll
    for (int r = 0; r < 4; ++r) { L[PP_ET + (4 * fq + r) * PQ + fr] = ETc[r]; L[PP_M1 + (4 * fq + r) * PQ + fr] = M1c[r]; }
    LDS_WAIT(); asm volatile("" ::: "memory");
    f32x4 M2c = Bpc;
#pragma unroll
    for (int kk = 0; kk < 4; ++kk) { const float aET = L[PP_ET + fr * PQ + 4 * kk + fq], bAp = L[PP_AP + (4 * kk + fq) * PQ + fr]; M2c = MF4(aET, bAp, M2c); }
#pragma unroll
    for (int r = 0; r < 4; ++r) L[PP_M2 + (4 * fq + r) * PQ + fr] = M2c[r];
    f32x4 n1[4], n2[4];
#pragma unroll
    for (int nt = 0; nt < 4; ++nt) {
        n1[nt] = (f32x4){0.f, 0.f, 0.f, 0.f};
#pragma unroll
        for (int r = 0; r < 4; ++r) n2[nt][r] = L[PP_KH + (4 * fq + r) * PS + 16 * nt + fr];
#pragma unroll
        for (int kk = 0; kk < 4; ++kk) { const float aT = L[PP_TI + fr * PQ + 4 * kk + fq], aET = L[PP_ET + fr * PQ + 4 * kk + fq], bB = L[PP_BH + (4 * kk + fq) * PS + 16 * nt + fr];
            n1[nt] = MF4(aT, bB, n1[nt]); n2[nt] = MF4(aET, bB, n2[nt]); }
    }
    LDS_WAIT(); asm volatile("" ::: "memory");
#pragma unroll
    for (int nt = 0; nt < 4; ++nt) { const float p15 = L[PP_P15 + 16 * nt + fr];
#pragma unroll
        for (int r = 0; r < 4; ++r) { L[PP_N1 + (4 * fq + r) * 64 + 16 * nt + fr] = n1[nt][r] * p15; L[PP_N2 + (4 * fq + r) * 64 + 16 * nt + fr] = n2[nt][r] * p15; } }
    LDS_WAIT(); asm volatile("" ::: "memory");
#pragma unroll
    for (int mt = 0; mt < 3; ++mt)
#pragma unroll
        for (int ks = 0; ks < 2; ++ks) {
            float e[8];
#pragma unroll
            for (int jj = 0; jj < 8; ++jj) { const int kap = 8 * (jj >> 2) + 4 * hh + (jj & 3);
                if (mt == 0) e[jj] = (n < 16) ? 0.f : L[(ks == 0 ? PP_M1 : PP_M2) + kap * PQ + (n & 15)];
                else e[jj] = L[(ks == 0 ? PP_N1 : PP_N2) + kap * 64 + 32 * (mt - 1) + n]; }
            *(bf16x8*)(W2F + ((mt * 2 + ks) * 64 + lane) * 8) = pack8f(e[0], e[1], e[2], e[3], e[4], e[5], e[6], e[7]);
        }
    { const int idx = lane & 31, blk = idx >> 4, reg = idx & 15; P15F[lane] = L[PP_P15 + 32 * blk + (reg & 3) + 8 * (reg >> 2) + 4 * hh]; }
    LDS_WAIT(); asm volatile("" ::: "memory");
}
__device__ __forceinline__ void phase_prepass(Frame& F, int l) {
    if (F.wave < PP_NW) {
        int lane = LANE_; asm volatile("" : "+v"(lane));
        LAS float* L = (LAS float*)F.lds + F.wave * PP_FLOATS;
        int rec = F.vcu * PP_NW + F.wave; const int stride = F.G * PP_NW;
        PPIn I; if (rec < 64 * CS_NCH) prepass_load(F, I, rec, lane);
        for (; rec < 64 * CS_NCH; rec += stride) {
            PPIn Nx = I; if (rec + stride < 64 * CS_NCH) prepass_load(F, Nx, rec + stride, lane);
            prepass_record(F, l, rec, L, lane, I);
            I = Nx;
        }
    }
}

constexpr int CS_REC = 4096 + 6144 + 256 + 4096, CS_SLOTS = 8, CS_LEAD = 6;
__device__ __forceinline__ void scan_chunked(Frame& F, int ch, int l) {
    int lane = LANE_; asm volatile("" : "+v"(lane));
    const int wave = F.wave, b = ch >> 3, h = (ch >> 1) & 3, dir = ch & 1, hh = lane >> 5, icol = 32 * (wave & 1) + (lane & 31);
    float* YD = WSP(float, WS_YD) + (size_t)dir * M * 256;
    const float* R32 = WSP(float, WS_R32);
    LAS unsigned char* ring = F.lds;
    u32x4 st[15];
    const int hw = wave - 2;
#define CS_SRC(cc, q) ({ const int rec_ = ch * CS_NCH + (cc); const u32x4* r_; \
        if ((q) < 4) r_ = (const u32x4*)(WSP(bf16, WS_W1F) + (size_t)rec_ * 2048) + lane + (q) * 64; \
        else if ((q) < 10) r_ = (const u32x4*)((const unsigned char*)F.out + (size_t)rec_ * 6400) + lane + ((q) - 4) * 64; \
        else { const int p = (q) * 64 + lane; const int pv = min(max(p - 656, 0), 255); \
            const u32x4* sv_ = (const u32x4*)(R32 + ((size_t)b * T + scan_tok((cc) * 16 + (pv >> 4), dir)) * 768 + 512 + h * 64) + (pv & 15); \
            r_ = ((q) == 10 && lane < 16) ? (const u32x4*)((const unsigned char*)F.out + (size_t)rec_ * 6400) + lane + 384 : sv_; } \
        r_; })
#define CS_ISSUE1(cc, q) do { st[q] = *CS_SRC(cc, q); } while (0)
#define CS_WRITE1(cc, q) do { const int p = (q) * 64 + lane; if ((q) < 14 || p < 912) ((LAS u32x4*)(ring + ((cc) % CS_SLOTS) * CS_REC))[p] = st[q]; } while (0)
#define CS_ISSUE(cc) do { _Pragma("unroll") for (int q = 0; q < 15; ++q) CS_ISSUE1(cc, q); } while (0)
#define CS_WRITE(cc) do { _Pragma("unroll") for (int q = 0; q < 15; ++q) CS_WRITE1(cc, q); } while (0)
#define CS_STEP(wc, q) do { CS_WRITE1(wc, q); if ((wc) + 6 < CS_NCH) CS_ISSUE1((wc) + 6, q); } while (0)
#define CS_BAR() do { asm volatile("s_waitcnt lgkmcnt(0)" ::: "memory"); __builtin_amdgcn_s_barrier(); asm volatile("" ::: "memory"); } while (0)
    if (wave >= 2) {
        CS_ISSUE(hw); CS_WRITE(hw); if (hw + CS_LEAD < CS_NCH) CS_ISSUE(hw + CS_LEAD);
        CS_BAR();
        int c = 0;
        for (; c < hw; ++c) CS_BAR();
        for (; c + 6 <= CS_NCH; c += 6) {
            const int wc = c + 6;
            if (wc < CS_NCH) {
                CS_STEP(wc, 0); CS_STEP(wc, 1); CS_STEP(wc, 2); CS_BAR();
                CS_STEP(wc, 3); CS_STEP(wc, 4); CS_STEP(wc, 5); CS_BAR();
                CS_STEP(wc, 6); CS_STEP(wc, 7); CS_STEP(wc, 8); CS_BAR();
                CS_STEP(wc, 9); CS_STEP(wc, 10); CS_BAR();
                CS_STEP(wc, 11); CS_STEP(wc, 12); CS_BAR();
                CS_STEP(wc, 13); CS_STEP(wc, 14); CS_BAR();
            } else { CS_BAR(); CS_BAR(); CS_BAR(); CS_BAR(); CS_BAR(); CS_BAR(); }
        }
        for (; c < CS_NCH; ++c) CS_BAR();
    } else {
        f32x16 X0, X1;
#pragma unroll
        for (int r = 0; r < 16; ++r) { X0[r] = 0.f; X1[r] = 0.f; }
        CS_BAR();
        for (int c = 0; c < CS_NCH; ++c) {
            const LAS unsigned char* rec = ring + (c % CS_SLOTS) * CS_REC;
            const LAS bf16x8* w1 = (const LAS bf16x8*)rec + lane; const LAS bf16x8* w2 = (const LAS bf16x8*)(rec + 4096) + lane;
            const LAS f32x4* p15 = (const LAS f32x4*)(rec + 10240 + hh * 128); const LAS float* vr = (const LAS float*)(rec + 10496) + icol;
            f32x16 G;
#pragma unroll
            for (int r = 0; r < 16; ++r) G[r] = 0.f;
            G = __builtin_amdgcn_mfma_f32_32x32x16_bf16(w1[0], pack8f(X0[0], X0[1], X0[2], X0[3], X0[4], X0[5], X0[6], X0[7]), G, 0, 0, 0);
            G = __builtin_amdgcn_mfma_f32_32x32x16_bf16(w1[64], pack8f(X0[8], X0[9], X0[10], X0[11], X0[12], X0[13], X0[14], X0[15]), G, 0, 0, 0);
            G = __builtin_amdgcn_mfma_f32_32x32x16_bf16(w1[128], pack8f(X1[0], X1[1], X1[2], X1[3], X1[4], X1[5], X1[6], X1[7]), G, 0, 0, 0);
            G = __builtin_amdgcn_mfma_f32_32x32x16_bf16(w1[192], pack8f(X1[8], X1[9], X1[10], X1[11], X1[12], X1[13], X1[14], X1[15]), G, 0, 0, 0);
            const bf16x8 g1 = pack8f(G[0], G[1], G[2], G[3], G[4], G[5], G[6], G[7]);
            float vv[8];
#pragma unroll
            for (int jj = 0; jj < 8; ++jj) vv[jj] = vr[(8 * (jj >> 2) + 4 * hh + (jj & 3)) * 64];
            const bf16x8 vf = pack8f(vv[0], vv[1], vv[2], vv[3], vv[4], vv[5], vv[6], vv[7]);
            f32x16 Y = __builtin_amdgcn_mfma_f32_32x32x16_bf16(w2[0], g1, G, 0, 0, 0);
            Y = __builtin_amdgcn_mfma_f32_32x32x16_bf16(w2[64], vf, Y, 0, 0, 0);
#pragma unroll
            for (int k = 0; k < 4; ++k) { const f32x4 pa = p15[k], pb = p15[4 + k];
#pragma unroll
                for (int e = 0; e < 4; ++e) { X0[4 * k + e] *= pa[e]; X1[4 * k + e] *= pb[e]; } }
            X0 = __builtin_amdgcn_mfma_f32_32x32x16_bf16(w2[128], g1, X0, 0, 0, 0);
            X0 = __builtin_amdgcn_mfma_f32_32x32x16_bf16(w2[192], vf, X0, 0, 0, 0);
            X1 = __builtin_amdgcn_mfma_f32_32x32x16_bf16(w2[256], g1, X1, 0, 0, 0);
            X1 = __builtin_amdgcn_mfma_f32_32x32x16_bf16(w2[320], vf, X1, 0, 0, 0);
#pragma unroll
            for (int r = 8; r < 16; ++r) { const int t = (r & 3) + 4 * hh + 8 * ((r >> 2) - 2);
                YD[((size_t)b * T + scan_tok(c * 16 + t, dir)) * 256 + h * 64 + icol] = Y[r]; }
            CS_BAR();
        }
    }
#undef CS_BAR
#undef CS_ISSUE
#undef CS_ISSUE1
#undef CS_WRITE1
#undef CS_STEP
#undef CS_SRC
#undef CS_WRITE
    __syncthreads();
}

constexpr int SC_TC = 16, SC_STEP = 6 * 64, SC_BUF = SC_TC * SC_STEP;
constexpr int SC_YOFF = 2 * SC_BUF, SC_DUMMY = SC_YOFF + 2 * SC_TC * 64;
struct ScanVec { f32x4 r0, r1, w0, w1, k0, k1, a0, a1, b0, b1; float vi; };
__device__ __forceinline__ void scan_ld(ScanVec& V, const LAS float* vec, int jc, int i) {
    V.r0 = *(const LAS f32x4*)(vec + 8 * jc); V.r1 = *(const LAS f32x4*)(vec + 8 * jc + 4);
    V.w0 = *(const LAS f32x4*)(vec + 64 + 8 * jc); V.w1 = *(const LAS f32x4*)(vec + 64 + 8 * jc + 4);
    V.k0 = *(const LAS f32x4*)(vec + 128 + 8 * jc); V.k1 = *(const LAS f32x4*)(vec + 128 + 8 * jc + 4);
    V.vi = vec[192 + i];
    V.a0 = *(const LAS f32x4*)(vec + 256 + 8 * jc); V.a1 = *(const LAS f32x4*)(vec + 256 + 8 * jc + 4);
    V.b0 = *(const LAS f32x4*)(vec + 320 + 8 * jc); V.b1 = *(const LAS f32x4*)(vec + 320 + 8 * jc + 4);
}
__device__ __forceinline__ float dot8(const f32x4 s0, const f32x4 s1, const f32x4 x0, const f32x4 x1) {
    const f32x4 p = s0 * x0 + s1 * x1;
    return (p[0] + p[1]) + (p[2] + p[3]);
}
__device__ __forceinline__ void scan_chain(Frame& F, int chain, int half, int l) {
    const int b = chain >> 3, h = (chain >> 1) & 3, dir = chain & 1;
    int tid_ = threadIdx.x; asm volatile("" : "+v"(tid_));
    const int tid = tid_, lane = tid & 63, wave = F.wave, jc = lane & 7, il = 8 * (wave & 3) + (lane >> 3), i = 32 * half + il;
    const bool comp = wave < 4; const int hw = wave & 3, ht = tid & 255;
    LAS float* buf = (LAS float*)F.lds;
    const float* R32 = WSP(float, WS_R32); const float* DEC = WSP(float, WS_DEC) + (size_t)dir * M * 256; const float* ASIG = WSP(float, WS_ASIG) + (size_t)dir * M * 256;
    float* YD = WSP(float, WS_YD) + (size_t)dir * M * 256;
    const float kkw = F.in[I_KK][l * 256 + h * 64 + lane], kaw = F.in[I_KA][l * 256 + h * 64 + lane];
    f32x4 S0 = (f32x4){0.f, 0.f, 0.f, 0.f}, S1 = S0;
    float pr[4][5];
    constexpr int NCH = T / SC_TC;
    const int ywr = (jc == 0) ? il : (SC_DUMMY - SC_YOFF) + ht;
#define SC_LOAD(c) do { _Pragma("unroll") for (int s4 = 0; s4 < 4; ++s4) { const int p = (c) * SC_TC + 4 * hw + s4; const size_t m = (size_t)b * T + scan_tok(p, dir); \
        pr[s4][0] = R32[m * 768 + h * 64 + lane]; pr[s4][1] = R32[m * 768 + 256 + h * 64 + lane]; pr[s4][2] = R32[m * 768 + 512 + h * 64 + lane]; \
        pr[s4][3] = DEC[m * 256 + h * 64 + lane]; pr[s4][4] = ASIG[m * 256 + h * 64 + lane]; } } while (0)
#define SC_PREP(bi) do { _Pragma("unroll") for (int s4 = 0; s4 < 4; ++s4) { const float r_ = pr[s4][0], kb_ = pr[s4][1], v_ = pr[s4][2], de_ = pr[s4][3], as_ = pr[s4][4]; \
        float kk_ = kb_ * kkw; kk_ = kk_ * __builtin_amdgcn_rsqf(fmaxf(wave_sum(kk_ * kk_), 1e-24f)); const float kd_ = kb_ * (1.f + (as_ - 1.f) * kaw); \
        LAS float* o_ = buf + (bi) * SC_BUF + (4 * hw + s4) * SC_STEP + lane; o_[0] = r_; o_[64] = de_; o_[128] = kd_; o_[192] = v_; o_[256] = -kk_; o_[320] = kk_ * as_; } } while (0)
#define SC_FLUSH(c) do { const int s_ = ht >> 4, i2_ = 2 * (ht & 15); \
        const f32x2 yv_ = *(const LAS f32x2*)(buf + SC_YOFF + ((c) & 1) * SC_TC * 32 + s_ * 32 + i2_); \
        *(f32x2*)(YD + ((size_t)b * T + scan_tok((c) * SC_TC + s_, dir)) * 256 + h * 64 + 32 * half + i2_) = yv_; } while (0)
    if (!comp) { SC_LOAD(0); SC_PREP(0); SC_LOAD(1); }
    for (int c = 0; c < NCH; ++c) {
        __syncthreads();
        if (!comp) {
            if (c > 0) SC_FLUSH(c - 1);
            if (c + 1 < NCH) SC_PREP((c + 1) & 1);
            if (c + 2 < NCH) SC_LOAD(c + 2);
        } else {
            const LAS float* bc = buf + (c & 1) * SC_BUF;
            LAS float* yst = buf + SC_YOFF + (c & 1) * SC_TC * 32 + ywr;
            ScanVec V; scan_ld(V, bc, jc, i);
#pragma unroll
            for (int s = 0; s < SC_TC; ++s) {
                ScanVec N = V;
                if (s + 1 < SC_TC) scan_ld(N, bc + (s + 1) * SC_STEP, jc, i);
                const float sa = red8(dot8(S0, S1, V.a0, V.a1));
                const f32x4 u0 = S0 * V.w0 + V.k0 * V.vi, u1 = S1 * V.w1 + V.k1 * V.vi;
                S0 = u0 + V.b0 * sa; S1 = u1 + V.b1 * sa;
                const float y = red8(dot8(S0, S1, V.r0, V.r1));
                yst[(jc == 0) ? s * 32 : 0] = y;
                V = N;
            }
        }
    }
    __syncthreads();
    if (!comp) SC_FLUSH(NCH - 1);
#undef SC_LOAD
#undef SC_PREP
#undef SC_FLUSH
    __syncthreads();
}

#if GOLD_ATTN
__device__ __forceinline__ void attn_ref_unit(Frame& F, int mode, int qrow0, int qcol, int krow0, int nkeys, int kcol, int vcol, int ocol,
                                              int rb, const float* rpbh) {
    const int tid = TID_, q = tid & 255, dh = tid >> 8;
    const bf16* QKV = WSP(bf16, WS_QKV); bf16* O = WSP(bf16, WS_O);
    const int gr = 4 * rb + (q >> 6), gc = q & 63;
    const size_t qrow = (size_t)qrow0 + q;
    float qv[64], o[32];
#pragma unroll
    for (int d8 = 0; d8 < 8; ++d8) { const u32x4 w = *(const u32x4*)(QKV + qrow * 1536 + qcol + 8 * d8);
        qv[8 * d8 + 0] = bflo(w.x); qv[8 * d8 + 1] = bfhi(w.x); qv[8 * d8 + 2] = bflo(w.y); qv[8 * d8 + 3] = bfhi(w.y);
        qv[8 * d8 + 4] = bflo(w.z); qv[8 * d8 + 5] = bfhi(w.z); qv[8 * d8 + 6] = bflo(w.w); qv[8 * d8 + 7] = bfhi(w.w); }
#pragma unroll
    for (int d = 0; d < 32; ++d) o[d] = 0.f;
    float mrun = -1e30f, lrun = 0.f;
    const int kend = mode == 0 ? nkeys : 128 + CTXL;
    const int rs = min(max(gr - 4, 0), 32 - 8), cs = min(max(gc - 8, 0), 64 - 16);
    for (int kk = 0; kk < kend; ++kk) {
        size_t krow; float bias = 0.f;
        if (mode == 0) krow = (size_t)krow0 + kk;
        else if (kk < 128) { const int kr = rs + (kk >> 4), kc = cs + (kk & 15); krow = (size_t)krow0 + CTXL + kr * 64 + kc; bias = rpbh[(kr - gr + 7) * 31 + (kc - gc + 15)] * LOG2E; }
        else krow = (size_t)krow0 + (kk - 128);
        float s = bias;
#pragma unroll
        for (int d8 = 0; d8 < 8; ++d8) { const u32x4 w = *(const u32x4*)(QKV + krow * 1536 + kcol + 8 * d8);
            s += qv[8 * d8 + 0] * bflo(w.x) + qv[8 * d8 + 1] * bfhi(w.x) + qv[8 * d8 + 2] * bflo(w.y) + qv[8 * d8 + 3] * bfhi(w.y)
               + qv[8 * d8 + 4] * bflo(w.z) + qv[8 * d8 + 5] * bfhi(w.z) + qv[8 * d8 + 6] * bflo(w.w) + qv[8 * d8 + 7] * bfhi(w.w); }
        const float mn = fmaxf(mrun, s), al = exp2f(mrun - mn), p = exp2f(s - mn);
        lrun = lrun * al + p; mrun = mn;
#pragma unroll
        for (int d8 = 0; d8 < 4; ++d8) { const u32x4 w = *(const u32x4*)(QKV + krow * 1536 + vcol + 32 * dh + 8 * d8);
            o[8 * d8 + 0] = o[8 * d8 + 0] * al + p * bflo(w.x); o[8 * d8 + 1] = o[8 * d8 + 1] * al + p * bfhi(w.x);
            o[8 * d8 + 2] = o[8 * d8 + 2] * al + p * bflo(w.y); o[8 * d8 + 3] = o[8 * d8 + 3] * al + p * bfhi(w.y);
            o[8 * d8 + 4] = o[8 * d8 + 4] * al + p * bflo(w.z); o[8 * d8 + 5] = o[8 * d8 + 5] * al + p * bfhi(w.z);
            o[8 * d8 + 6] = o[8 * d8 + 6] * al + p * bflo(w.w); o[8 * d8 + 7] = o[8 * d8 + 7] * al + p * bfhi(w.w); }
    }
    const float li = 1.f / lrun;
#pragma unroll
    for (int d8 = 0; d8 < 4; ++d8) { u32x4 w;
        w.x = pk2(o[8 * d8 + 0] * li, o[8 * d8 + 1] * li); w.y = pk2(o[8 * d8 + 2] * li, o[8 * d8 + 3] * li);
        w.z = pk2(o[8 * d8 + 4] * li, o[8 * d8 + 5] * li); w.w = pk2(o[8 * d8 + 6] * li, o[8 * d8 + 7] * li);
        *(u32x4*)(O + qrow * 1024 + ocol + 32 * dh + 8 * d8) = w; }
}
#endif
__device__ __forceinline__ void attn_item(Frame& F, int item, int l) {
    const float* rpb = F.in[I_RPB] + (size_t)l * 4 * 15 * 31;
    int mode = 0, qrow0, qcol, krow0, nkeys, kcol, vcol, ocol, rb = 0;
    if (item < 512) { const int b = item >> 6, h = (item >> 3) & 7, qb = item & 7;
        qrow0 = b * T + CTXL + qb * 256; qcol = h * 64; krow0 = b * T; nkeys = T; kcol = 512 + (h >> 2) * 64; vcol = 640 + (h >> 2) * 64; ocol = h * 64; }
    else if (item < 768) { const int it = item - 512, b = it >> 5, h = (it >> 3) & 3; rb = it & 7; mode = 1;
        qrow0 = b * T + CTXL + rb * 256; qcol = 768 + h * 64; krow0 = b * T; nkeys = 0; kcol = 1024 + h * 64; vcol = 1280 + h * 64; ocol = 768 + h * 64; rpb += h * 15 * 31; }
    else if (item < 832) { const int it = item - 768, b = it >> 3, h = it & 7;
        qrow0 = b * T; qcol = h * 64; krow0 = b * T; nkeys = CTXL; kcol = 512 + (h >> 2) * 64; vcol = 640 + (h >> 2) * 64; ocol = h * 64; }
    else { const int it = item - 832, b = it >> 2, h = it & 3;
        qrow0 = b * T; qcol = 768 + h * 64; krow0 = b * T; nkeys = CTXL; kcol = 1024 + h * 64; vcol = 1280 + h * 64; ocol = 768 + h * 64; }
#if GOLD_ATTN
    attn_ref_unit(F, mode, qrow0, qcol, krow0, nkeys, kcol, vcol, ocol, rb, rpb);
#else
    const attn_body::bf16* QKV = (const attn_body::bf16*)WSP(bf16, WS_QKV); attn_body::bf16* O = (attn_body::bf16*)WSP(bf16, WS_O);
    const attn_body::bf16* Qw0 = QKV + (size_t)qrow0 * 1536 + qcol; const attn_body::bf16* Kh = QKV + (size_t)krow0 * 1536 + kcol; const attn_body::bf16* Vh = QKV + (size_t)krow0 * 1536 + vcol;
    attn_body::bf16* Ow0 = O + (size_t)qrow0 * 1024 + ocol;
    if (mode == 0) attn_body::attn_unit<8, false>(Qw0, Kh, Vh, Ow0, nkeys >> 6, 0, 0, 0, rpb, (char*)F.lds);
    else { const int rs0 = min(max(4 * rb - 4, 0), 24); attn_body::attn_unit<8, true>(Qw0, Kh, Vh, Ow0, (rb == 0 || rb == 7) ? 12 : 16, rs0, rb, rs0, rpb, (char*)F.lds); }
#endif
}
__device__ __forceinline__ void phase_mixer(Frame& F, int l, int rep = 0) {
#if CHUNK_SCAN
    if (F.vcu < 64) scan_chunked(F, F.vcu, l);
#else
    if (F.vcu < 128) scan_chain(F, F.vcu >> 1, F.vcu & 1, l);
#endif
    if (rep == 2) return;
    const int nattn = (l == NL - 1) ? 768 : 864, nitems = nattn + CVT_NBLK;
    for (;;) {
        if (TID_ == 0) F.MISC[16] = atomicAdd(F.ctl + CW_QUEUE + 64 * (l + 2 * rep), 1u);
        __syncthreads();
        const int item = (int)F.MISC[16];
        __syncthreads();
        if (item >= nitems) break;
        if (item < nattn) attn_item(F, item, l);
        else { cvt_moe_block(F, l, item - nattn); __syncthreads(); }
    }
}

__device__ __forceinline__ void phase_post(Frame& F, int l) {
    const int gw = F.vcu * NWAVES + F.wave, NGW = F.G * NWAVES, lane = LANE_;
    const float* R32 = WSP(float, WS_R32); const float* ASIG = WSP(float, WS_ASIG); const float* YD = WSP(float, WS_YD); const float* Gb = WSP(float, WS_G);
    bf16* O = WSP(bf16, WS_O);
    for (int it = gw; it < M * 4; it += NGW) { const int m = it >> 2, h = it & 3, t = m % T, ch = h * 64 + lane;
        if (l == NL - 1 && t < CTXL) continue;
        const float y = YD[(size_t)m * 256 + ch] + YD[((size_t)M + m) * 256 + ch];
        const float mu = wave_sum(y) * (1.f / 64.f); const float dv = y - mu; const float var = wave_sum(dv * dv) * (1.f / 64.f);
        float yn = dv * rsqrtf(var + 64e-5f) * F.in[I_LNXW][l * 256 + ch] + F.in[I_LNXB][l * 256 + ch];
        const float r = R32[(size_t)m * 768 + ch], kb = R32[(size_t)m * 768 + 256 + ch], v = R32[(size_t)m * 768 + 512 + ch];
        const float ka = F.in[I_KA][l * 256 + ch], rk = F.in[I_RK][l * 256 + ch];
        const float as0 = ASIG[(size_t)m * 256 + ch], as1 = ASIG[((size_t)M + m) * 256 + ch];
        const float kd0 = kb * (1.f + (as0 - 1.f) * ka), kd1 = kb * (1.f + (as1 - 1.f) * ka);
        const float bon = (wave_sum(r * kd0 * rk) + wave_sum(r * kd1 * rk)) * v;
        O[(size_t)m * 1024 + 512 + ch] = (bf16)f2bf((yn + bon) * Gb[(size_t)m * 256 + ch]);
    }
}

__device__ __forceinline__ void phase_topk(Frame& F, int l) {
    const int tid = TID_;
    LAS unsigned long long* keys = (LAS unsigned long long*)F.lds;
    const float* AFF = WSP(float, WS_AFF); int* INV = WSP(int, WS_INV); float* SELG = WSP(float, WS_SELG); int* SELT = WSP(int, WS_SELT);
    const bf16* H2 = WSP(bf16, WS_H2); bf16* XE = WSP(bf16, WS_XE);
    const int nitems = (l == NL - 1) ? 128 : 256;
    for (int it = F.vcu; it < nitems; it += F.G) {
        const int seg = it >> 7, be = it & 127, b = be >> 4, e = be & 15;
        const int n = seg ? CTXL : SEQ, cap = n / 8, mbase = b * T + (seg ? 0 : CTXL);
        const int rowbase = e * MEXP + (seg ? 2048 + b * 32 : b * 256);
        for (int i = tid; i < n; i += NTHREADS) keys[i] = ((unsigned long long)__float_as_uint(AFF[(size_t)(mbase + i) * 16 + e]) << 32) | (unsigned)(0xFFFFFFFFu - (unsigned)i);
        __syncthreads();
        for (int k = 2; k <= n; k <<= 1)
            for (int j = k >> 1; j > 0; j >>= 1) {
                for (int t = tid; t < (n >> 1); t += NTHREADS) { const int i = 2 * t - (t & (j - 1)), p = i + j; const bool desc = ((i & k) == 0);
                    const unsigned long long a = keys[i], bb = keys[p];
                    if ((a < bb) == desc) { keys[i] = bb; keys[p] = a; } }
                __syncthreads();
            }
        for (int s = tid; s < cap; s += NTHREADS) { const unsigned long long kv = keys[s]; const int idx = (int)(0xFFFFFFFFu - (unsigned)kv); const int m = mbase + idx;
            SELG[rowbase + s] = __uint_as_float((unsigned)(kv >> 32)); SELT[rowbase + s] = m; INV[(size_t)m * 16 + e] = rowbase + s; }
        for (int s0 = F.wave * 4; s0 < cap; s0 += NWAVES * 4) {
            u32x4 v[4][2];
#pragma unroll
            for (int k = 0; k < 4; ++k) { const unsigned long long kv = keys[s0 + k]; const int m = mbase + (int)(0xFFFFFFFFu - (unsigned)kv);
                const u32x4* src = (const u32x4*)(H2 + (size_t)m * 1024); v[k][0] = src[LANE_]; v[k][1] = src[64 + LANE_]; }
#pragma unroll
            for (int k = 0; k < 4; ++k) { u32x4* dst = (u32x4*)(XE + (size_t)(rowbase + s0 + k) * 1024); dst[LANE_] = v[k][0]; dst[64 + LANE_] = v[k][1]; }
        }
        __syncthreads();
    }
}

constexpr int N_PHASES = 2 + 10 * NL;
#ifndef EN_MASK
#define EN_MASK 0xFFFFF
#endif
#define EN(k) ((EN_MASK >> (k)) & 1)
#ifndef REP_MASK
#define REP_MASK 0
#endif
#define REP(k) ((REP_MASK >> (k)) & 1)
#define RUNPH(k, body) do { if (EN(k)) { body; if (REP(k)) { GBAR(); body; } } } while (0)
__global__ void __launch_bounds__(NTHREADS, 2) fwd_kernel(Args args) {
    extern __shared__ __attribute__((aligned(16))) unsigned char lds_raw[];
    cg::grid_group grid = cg::this_grid();
    Frame F;
    F.lds = (LAS unsigned char*)lds_raw;
    F.MISC = (volatile LAS unsigned*)(F.lds + MISC_OFF);
    F.wave = __builtin_amdgcn_readfirstlane(TID_ >> 6);
    F.G = gridDim.x; { const int bx = blockIdx.x; F.vcu = (F.G % 8 == 0) ? (bx % 8) * (F.G / 8) + bx / 8 : bx; }
    F.in = args.in; F.out = args.out; F.ws = args.ws; F.ctl = (unsigned*)(args.ws + WS_CTL);
    { int u0 = TID_; asm volatile("" : "+v"(u0)); for (int u = u0; u < (LDS_BYTES - RING_BYTES) / 4; u += NTHREADS) ((LAS unsigned*)(F.lds + RING_BYTES))[u] = 0u; }
    __syncthreads();
    const int lo = args.ph_lo, hi = args.ph_hi;
    XcdBarrier bar; bar.bar = F.ctl + CW_BAR; bar.x = 0; bar.st = nullptr;
    if (hi - lo > 1) bar = xcd_barrier_post(F.ctl + CW_BAR, F.MISC + 8);
    LAS unsigned char* ring = F.lds;

#define IN(k) (lo <= (k) && (k) < hi)
#define GBAR() xcd_barrier2(bar)
#define SEAM(k) do { if (IN(k) && IN((k) + 1)) { GBAR(); } } while (0)
    if (hi < 0) grid.sync();
    if (IN(0)) { RUNPH(10, phase_init(F)); }
    SEAM(0);
    if (IN(1)) { RUNPH(11, phase_row0(F)); }
    if (REP(16)) { for (int k_ = 0; k_ < 20; ++k_) xcd_barrier(bar); }
    if (REP(17)) { for (int k_ = 0; k_ < 20; ++k_) xcd_barrier2(bar); }
    SEAM(1);
#define LAYER(l) do { constexpr int base = 2 + 10 * (l); constexpr bool last = ((l) == NL - 1); \
    if (IN(base + 0)) { if (EN(0)) { \
        pg8::Gemm g{WSP(bf16, WS_H), WSP(bf16, WS_WIN) + (size_t)(l) * NINP * 1024, M, NINP, D}; \
        EpiInproj E{WSP(bf16, WS_QKV), WSP(float, WS_R32), WSP(bf16, WS_Z)}; \
        if (last) { InprojLastSched S{F.G, F.vcu}; run_gemm<EpiInproj, InprojLastSched>(ring, g, S, E); } else { TileSched S{M / 256, NINP / 256, F.G, F.vcu, false}; run_gemm<EpiInproj, TileSched>(ring, g, S, E); } } } \
    SEAM(base + 0); \
    if (IN(base + 1)) { if (EN(1)) { \
        pg8::Gemm g{WSP(bf16, WS_Z), WSP(bf16, WS_LORA) + (size_t)(l) * 1280 * 384, M, 1280, 384}; \
        TileSched S{M / 256, 5, F.G, F.vcu, false}; \
        EpiLora E{WSP(float, WS_DEC), WSP(float, WS_ASIG), WSP(float, WS_G), F.in[I_W0] + (l) * 512, F.in[I_A0] + (l) * 512}; \
        for (int rep_ = 0; rep_ < (REP(1) ? 2 : 1); ++rep_) { if (rep_) GBAR(); run_gemm<EpiLora, TileSched>(ring, g, S, E); } } \
        if (EN(12)) { phase_qkprep(F, (l)); if (REP(12)) { GBAR(); phase_qkprep(F, (l), true); } } } \
    SEAM(base + 1); \
    if (IN(base + 2)) { if (EN(2)) { if (CHUNK_SCAN) { phase_prepass(F, (l)); GBAR(); if (REP(14)) { phase_prepass(F, (l)); GBAR(); } } phase_mixer(F, (l)); if (REP(2)) { GBAR(); phase_mixer(F, (l), 1); } if (REP(15)) { GBAR(); phase_mixer(F, (l), 2); } } } \
    SEAM(base + 2); \
    if (IN(base + 3)) { RUNPH(3, phase_post(F, (l))); } \
    SEAM(base + 3); \
    if (IN(base + 4)) { if (EN(4)) { \
        pg8::Gemm g{WSP(bf16, WS_O), WSP(bf16, WS_WOUT) + (size_t)(l) * 1024 * 1024, M, D, D}; \
        TileSched S{last ? 64 : 72, 4, F.G, F.vcu, last}; \
        EpiOut E{WSP(float, WS_Y)}; \
        for (int rep_ = 0; rep_ < (REP(4) ? 2 : 1); ++rep_) { if (rep_) GBAR(); run_gemm<EpiOut, TileSched>(ring, g, S, E); } } } \
    SEAM(base + 4); \
    if (IN(base + 5)) { if (EN(5)) { phase_row1(F, (l)); if (REP(5)) { GBAR(); phase_row1(F, (l), true); } } } \
    SEAM(base + 5); \
    if (IN(base + 6)) { RUNPH(6, phase_topk(F, (l))); } \
    SEAM(base + 6); \
    if (IN(base + 7)) { if (EN(7)) { \
        pg8::Gemm g{WSP(bf16, WS_XE), WSP(bf16, WS_WGU), NE * MEXP, NE * 2048, D}; \
        MoeSched S{last ? 8 : 9, 8, F.G, F.vcu}; \
        EpiMoe1 E{WSP(bf16, WS_HID)}; \
        for (int rep_ = 0; rep_ < (REP(7) ? 2 : 1); ++rep_) { if (rep_) GBAR(); run_gemm<EpiMoe1, MoeSched>(ring, g, S, E); } } } \
    SEAM(base + 7); \
    if (IN(base + 8)) { if (EN(8)) { \
        pg8::Gemm g{WSP(bf16, WS_HID), WSP(bf16, WS_WD), NE * MEXP, NE * 1024, D}; \
        MoeSched S{last ? 8 : 9, 4, F.G, F.vcu}; \
        EpiMoe2 E{WSP(bf16, WS_OUTE), WSP(float, WS_SELG)}; \
        for (int rep_ = 0; rep_ < (REP(8) ? 2 : 1); ++rep_) { if (rep_) GBAR(); run_gemm<EpiMoe2, MoeSched>(ring, g, S, E); } } } \
    SEAM(base + 8); \
    if (IN(base + 9)) { if (EN(9)) { phase_row2(F, (l)); if (REP(9)) { GBAR(); phase_row2(F, (l), true); } } } \
    SEAM(base + 9); \
  } while (0)
    LAYER(0);
    LAYER(1);
#undef LAYER
#undef SEAM
#undef IN
}

extern "C" void kernel_launch(void* const* d_in, const int* in_sizes, int n_in, void* d_out, int out_size, void* d_ws, size_t ws_size, hipStream_t stream) {
    static int grid = 0;
    if (grid == 0) {
        if (n_in != 29 || out_size != NB * SEQ * D || ws_size < WS_END) { fprintf(stderr, "kernel_launch: unexpected sizes n_in %d out %d ws %zu\n", n_in, out_size, ws_size); grid = -1; return; }
        int dev = 0, cus = 0, per_cu = 0;
        if (hipGetDevice(&dev) != hipSuccess || hipDeviceGetAttribute(&cus, hipDeviceAttributeMultiprocessorCount, dev) != hipSuccess) { grid = -1; return; }
        if (hipFuncSetAttribute((const void*)fwd_kernel, hipFuncAttributeMaxDynamicSharedMemorySize, LDS_BYTES) != hipSuccess) { fprintf(stderr, "kernel_launch: hipFuncSetAttribute failed\n"); grid = -1; return; }
        if (hipOccupancyMaxActiveBlocksPerMultiprocessor(&per_cu, (const void*)fwd_kernel, NTHREADS, LDS_BYTES) != hipSuccess || per_cu < 1) { fprintf(stderr, "kernel_launch: occupancy query says %d\n", per_cu); per_cu = 1; }
        (void)hipGetLastError();
        grid = cus;
        fprintf(stderr, "kernel_launch: grid %d, per_cu %d, ws %zu\n", grid, per_cu, ws_size);
    }
    if (grid < 0) return;
    if (hipMemsetAsync((char*)d_ws + WS_CTL, 0, CTL_ZERO_BYTES, stream) != hipSuccess) return;
    Args a{};
    for (int i = 0; i < 29; ++i) a.in[i] = (const float*)d_in[i];
    a.out = (float*)d_out; a.ws = (unsigned char*)d_ws;
#if N_LAUNCH_MODE
    a.ph_lo = 0; a.ph_hi = N_PHASES;
    { void* kargs[] = {&a};
      hipError_t e = hipLaunchCooperativeKernel((const void*)fwd_kernel, dim3(grid), dim3(NTHREADS), kargs, LDS_BYTES, stream);
      if (e != hipSuccess) fprintf(stderr, "kernel_launch: cooperative launch failed: %s\n", hipGetErrorString(e)); }
#else
    for (int ph = 0; ph < N_PHASES; ++ph) {
        a.ph_lo = ph; a.ph_hi = ph + 1;
        void* kargs[] = {&a};
        hipError_t e = hipLaunchCooperativeKernel((const void*)fwd_kernel, dim3(grid), dim3(NTHREADS), kargs, LDS_BYTES, stream);
        if (e != hipSuccess) { fprintf(stderr, "kernel_launch: launch %d failed: %s\n", ph, hipGetErrorString(e)); break; }
    }
#endif
}
```

```cpp
#define GOLD_GEMM 0
#define N_LAUNCH_MODE 1
#define GOLD_ATTN 0
#define REP_MASK 0
#define CHUNK_SCAN 1
#include <hip/hip_runtime.h>
#include <hip/hip_cooperative_groups.h>
#include <cstdio>
#include <cstdint>
namespace cg = cooperative_groups;

#ifndef GOLD_GEMM
#define GOLD_GEMM 0
#endif
#ifndef GOLD_ATTN
#define GOLD_ATTN 1
#endif
#ifndef N_LAUNCH_MODE
#define N_LAUNCH_MODE 1
#endif

#define LAS __attribute__((address_space(3)))
typedef unsigned short bf16;
typedef float f32x4 __attribute__((ext_vector_type(4)));
typedef unsigned u32x4 __attribute__((ext_vector_type(4)));
typedef unsigned u32x2 __attribute__((ext_vector_type(2)));
typedef short bf16x8 __attribute__((ext_vector_type(8)));

constexpr int D = 1024, NB = 8, SEQ = 2048, CTXL = 256, T = SEQ + CTXL, M = NB * T, NL = 2;
constexpr int NINP = 2816;
constexpr int NE = 16, MEXP = 2304;
constexpr float LOG2E = 1.4426950408889634f;
constexpr float C2 = 0.125f * LOG2E;
constexpr int NTHREADS = 512, NWAVES = 8;
constexpr int LDS_BYTES = 147456, RING_BYTES = 131072, MISC_OFF = RING_BYTES + 320;

constexpr size_t MiB = 1u << 20;
constexpr size_t WS_CTL = 0, CTL_ZERO_BYTES = 1 * MiB;
constexpr size_t WS_MOD = 1 * MiB;
constexpr size_t WS_WIN = 2 * MiB;
constexpr size_t WS_WOUT = 13 * MiB;
constexpr size_t WS_LORA = 17 * MiB;
constexpr size_t WS_WGU = 19 * MiB;
constexpr size_t WS_WD = 83 * MiB;
constexpr size_t WS_X = 115 * MiB;
constexpr size_t R0 = 187 * MiB;
constexpr size_t WS_YD = R0 + 0 * MiB;
constexpr size_t WS_H = R0 + 36 * MiB;
constexpr size_t WS_QKV = R0 + 72 * MiB;
constexpr size_t WS_R32 = R0 + 126 * MiB;
constexpr size_t WS_Z = R0 + 180 * MiB;
constexpr size_t WS_DEC = R0 + 194 * MiB;
constexpr size_t WS_ASIG = R0 + 230 * MiB;
constexpr size_t WS_G = R0 + 266 * MiB;
constexpr size_t WS_O = R0 + 284 * MiB;
constexpr size_t WS_END = R0 + 320 * MiB;
constexpr size_t WS_Y = WS_QKV;
constexpr size_t WS_OUTE = WS_QKV;
constexpr size_t WS_H2 = WS_DEC;
constexpr size_t WS_AFF = WS_Z;
constexpr size_t WS_INV = WS_Z + 2 * MiB;
constexpr size_t WS_SELG = WS_Z + 4 * MiB;
constexpr size_t WS_SELT = WS_Z + 5 * MiB;
constexpr size_t WS_XE = WS_ASIG;
constexpr size_t WS_HID = WS_YD;
static_assert(WS_END <= 512 * MiB, "ws map");
constexpr int CW_BAR = 4096;
constexpr int CW_QUEUE = 16384;

__device__ __forceinline__ unsigned f2bf(float f) { unsigned u = __builtin_bit_cast(unsigned, f); return (u + 0x7fffu + ((u >> 16) & 1u)) >> 16; }
__device__ __forceinline__ unsigned pk2(float lo, float hi) { return f2bf(lo) | (f2bf(hi) << 16); }
__device__ __forceinline__ float bf2f(unsigned h) { return __builtin_bit_cast(float, h << 16); }
__device__ __forceinline__ float bflo(unsigned w) { return __builtin_bit_cast(float, w << 16); }
__device__ __forceinline__ float bfhi(unsigned w) { return __builtin_bit_cast(float, w & 0xffff0000u); }
template <int CTRL> __device__ __forceinline__ float dppf(float x) { return __builtin_bit_cast(float, __builtin_amdgcn_update_dpp(0, __builtin_bit_cast(int, x), CTRL, 0xF, 0xF, true)); }
__device__ __forceinline__ float red8(float x) { x += dppf<0xB1>(x); x += dppf<0x4E>(x); x += dppf<0x141>(x); return x; }
__device__ __forceinline__ float wave_sum(float v) {
    v = red8(v); v += dppf<0x140>(v);
    const float a0 = __builtin_bit_cast(float, __builtin_amdgcn_readlane(__builtin_bit_cast(int, v), 0));
    const float a1 = __builtin_bit_cast(float, __builtin_amdgcn_readlane(__builtin_bit_cast(int, v), 16));
    const float a2 = __builtin_bit_cast(float, __builtin_amdgcn_readlane(__builtin_bit_cast(int, v), 32));
    const float a3 = __builtin_bit_cast(float, __builtin_amdgcn_readlane(__builtin_bit_cast(int, v), 48));
    return (a0 + a1) + (a2 + a3);
}
__device__ __forceinline__ float sigmoidf_(float x) { return __builtin_amdgcn_rcpf(1.f + __expf(-x)); }
#define LDS_WAIT() asm volatile("s_waitcnt lgkmcnt(0)" ::: "memory")

#define XB_TMO      128
#define XB_XCNT(j)  (256  + 64 * (j))
#define XB_XSUB(j)  (1280 + 64 * (j))
#define XB_XGEN(j)  (2304 + 64 * (j))
#define XB_TOP      3328
#define XB_TOPGEN   3392
#define XCD_BAR_WORDS 3456
#define XB_SPIN_CAP (1u << 22)
__device__ __forceinline__ unsigned xb_ld(unsigned* p)              { return __hip_atomic_load(p, __ATOMIC_RELAXED, __HIP_MEMORY_SCOPE_AGENT); }
__device__ __forceinline__ unsigned xb_add(unsigned* p, unsigned v) { return __hip_atomic_fetch_add(p, v, __ATOMIC_RELAXED, __HIP_MEMORY_SCOPE_AGENT); }
__device__ __forceinline__ unsigned xb_xcc_id() { return (unsigned)__builtin_amdgcn_s_getreg((3 << 11) | 20) & 0xFu; }
#define XB_SPIN(cond, bar) do { unsigned _sp = 0; while (cond) { \
    if ((++_sp & 255u) == 0u) { if (xb_ld(&(bar)[XB_TMO])) break; if (_sp > XB_SPIN_CAP) { atomicAdd(&(bar)[XB_TMO], 1u); break; } } } } while (0)
struct XcdBarrier { unsigned* bar; unsigned x; volatile LAS unsigned* st; };
__device__ __forceinline__ XcdBarrier xcd_barrier_post(unsigned* bar, volatile LAS unsigned* st) {
    XcdBarrier b; b.bar = bar; b.x = xb_xcc_id(); b.st = st;
    if (threadIdx.x == 0) (void)xb_add(&bar[XB_XCNT(b.x)], 1u);
    return b;
}
__device__ __forceinline__ void xcd_barrier_complete(unsigned* bar, unsigned x, unsigned& nloc, unsigned& nx) {
    const unsigned G = gridDim.x * gridDim.y * gridDim.z;
    unsigned sum, cnt, mine, sp = 0u;
    for (;;) {
        sum = 0u; cnt = 0u; mine = 0u;
#pragma unroll
        for (unsigned j = 0; j < 16; ++j) { const unsigned c = xb_ld(&bar[XB_XCNT(j)]); sum += c; cnt += (c > 0u) ? 1u : 0u; mine = (j == x) ? c : mine; }
        if (sum == G) break;
        __builtin_amdgcn_s_sleep(1);
        if ((++sp & 255u) == 0u) { if (xb_ld(&bar[XB_TMO])) break; if (sp > XB_SPIN_CAP) { atomicAdd(&bar[XB_TMO], 1u); break; } }
    }
    nloc = mine > 0u ? mine : 1u; nx = cnt > 0u ? cnt : 1u;
}
__device__ __forceinline__ void xcd_barrier(const XcdBarrier& b) {
    asm volatile("s_waitcnt vmcnt(0)" ::: "memory");
    __syncthreads();
    if (threadIdx.x == 0) {
        unsigned* bar = b.bar;
        __builtin_amdgcn_s_waitcnt(0);
        unsigned nloc = b.st[0], nx = b.st[1];
        if (nloc == 0u) { xcd_barrier_complete(bar, b.x, nloc, nx); b.st[0] = nloc; b.st[1] = nx; }
        const unsigned old = xb_add(&bar[XB_XSUB(b.x)], 1u);
        const unsigned gen = old / nloc;
        if (old + 1u == (gen + 1u) * nloc) {
            __builtin_amdgcn_fence(__ATOMIC_RELEASE, "agent");
            asm volatile("s_waitcnt vmcnt(0)" ::: "memory");
            const unsigned og = xb_add(&bar[XB_TOP], 1u);
            const unsigned tg = og / nx;
            if (og + 1u == (tg + 1u) * nx) xb_add(&bar[XB_TOPGEN], 1u);
            else XB_SPIN(xb_ld(&bar[XB_TOPGEN]) == tg, bar);
            __builtin_amdgcn_fence(__ATOMIC_ACQUIRE, "agent");
            xb_add(&bar[XB_XGEN(b.x)], 1u);
            asm volatile("s_waitcnt vmcnt(0)" ::: "memory");
        } else {
            XB_SPIN(xb_ld(&bar[XB_XGEN(b.x)]) == gen, bar);
            __builtin_amdgcn_fence(__ATOMIC_ACQUIRE, "agent");
            asm volatile("s_waitcnt vmcnt(0)" ::: "memory");
        }
    }
    __syncthreads();
}

__device__ __forceinline__ void flat_barrier(unsigned* cnt) {
    asm volatile("s_waitcnt vmcnt(0)" ::: "memory");
    __syncthreads();
    if (threadIdx.x == 0) {
        const unsigned G = gridDim.x;
        __builtin_amdgcn_fence(__ATOMIC_RELEASE, "agent");
        asm volatile("s_waitcnt vmcnt(0)" ::: "memory");
        const unsigned old = xb_add(cnt, 1u);
        const unsigned target = (old / G + 1u) * G;
        unsigned sp = 0;
        while (xb_ld(cnt) < target) { __builtin_amdgcn_s_sleep(1); if (++sp > (1u << 22)) break; }
        __builtin_amdgcn_fence(__ATOMIC_ACQUIRE, "agent");
        asm volatile("s_waitcnt vmcnt(0)" ::: "memory");
    }
    __syncthreads();
}

__device__ __forceinline__ void xcd_barrier2(const XcdBarrier& b) {
    asm volatile("s_waitcnt vmcnt(0)" ::: "memory");
    __syncthreads();
    if (threadIdx.x == 0) {
        unsigned* bar = b.bar;
        __builtin_amdgcn_s_waitcnt(0);
        unsigned nloc = b.st[0], nx = b.st[1];
        if (nloc == 0u) { xcd_barrier_complete(bar, b.x, nloc, nx); b.st[0] = nloc; b.st[1] = nx; }
        const unsigned old = xb_add(&bar[XB_XSUB(b.x)], 1u);
        const unsigned gen = old / nloc;
        if (old + 1u == (gen + 1u) * nloc) {
            __builtin_amdgcn_fence(__ATOMIC_RELEASE, "agent");
            asm volatile("s_waitcnt vmcnt(0)" ::: "memory");
            (void)xb_add(&bar[XB_TOP], 1u);
        }
        const unsigned target = (gen + 1u) * nx;
        XB_SPIN(xb_ld(&bar[XB_TOP]) < target, bar);
        __builtin_amdgcn_fence(__ATOMIC_ACQUIRE, "agent");
        asm volatile("s_waitcnt vmcnt(0)" ::: "memory");
    }
    __syncthreads();
}

template <int MODE> __device__ __forceinline__ void xcd_barrier2_probe(const XcdBarrier& b) {
    asm volatile("s_waitcnt vmcnt(0)" ::: "memory");
    __syncthreads();
    if (threadIdx.x == 0) {
        unsigned* bar = b.bar;
        unsigned nloc = b.st[0], nx = b.st[1];
        const unsigned old = xb_add(&bar[XB_XSUB(b.x)], 1u);
        const unsigned gen = old / nloc;
        if (old + 1u == (gen + 1u) * nloc) {
            if (!(MODE & 2)) { __builtin_amdgcn_fence(__ATOMIC_RELEASE, "agent"); asm volatile("s_waitcnt vmcnt(0)" ::: "memory"); }
            (void)xb_add(&bar[XB_TOP], 1u);
        }
        const unsigned target = (gen + 1u) * nx;
        XB_SPIN(xb_ld(&bar[XB_TOP]) < target, bar);
        if (!(MODE & 1) && (!(MODE & 4) || (old + 1u == (gen + 1u) * nloc))) { __builtin_amdgcn_fence(__ATOMIC_ACQUIRE, "agent"); asm volatile("s_waitcnt vmcnt(0)" ::: "memory"); }
    }
    __syncthreads();
}

__device__ __forceinline__ void xcd_barrier3(const XcdBarrier& b) {
    asm volatile("s_waitcnt vmcnt(0)" ::: "memory");
    __syncthreads();
    if (threadIdx.x == 0) {
        unsigned* bar = b.bar;
        __builtin_amdgcn_s_waitcnt(0);
        unsigned nloc = b.st[0], nx = b.st[1];
        if (nloc == 0u) { xcd_barrier_complete(bar, b.x, nloc, nx); b.st[0] = nloc; b.st[1] = nx; }
        const unsigned old = xb_add(&bar[XB_XSUB(b.x)], 1u);
        const unsigned gen = old / nloc;
        if (old + 1u == (gen + 1u) * nloc) {
            __builtin_amdgcn_fence(__ATOMIC_RELEASE, "agent");
            asm volatile("s_waitcnt vmcnt(0)" ::: "memory");
            (void)xb_add(&bar[XB_TOP], 1u);
            const unsigned target = (gen + 1u) * nx;
            XB_SPIN(xb_ld(&bar[XB_TOP]) < target, bar);
            __builtin_amdgcn_fence(__ATOMIC_ACQUIRE, "agent");
            asm volatile("s_waitcnt vmcnt(0)" ::: "memory");
            xb_add(&bar[XB_XGEN(b.x)], 1u);
        } else {
            __builtin_amdgcn_fence(__ATOMIC_ACQUIRE, "agent");
            asm volatile("s_waitcnt vmcnt(0)" ::: "memory");
            XB_SPIN(xb_ld(&bar[XB_XGEN(b.x)]) == gen, bar);
        }
    }
    __syncthreads();
}
namespace pg8 {
#define PG8_LAS __attribute__((address_space(3)))
typedef unsigned short bf16_t;
typedef short bf16x8 __attribute__((ext_vector_type(8)));
typedef float f32x4 __attribute__((ext_vector_type(4)));
typedef unsigned u32x4 __attribute__((ext_vector_type(4)));
constexpr int BM = 256, BK = 64, HALF = 128, HTB = HALF * BK * 2  , STAGE_BYTES = 8 * HTB, NXCD = 8, WGM = 8;

__host__ __device__ __forceinline__ int lds_byte(int r, int c) { const int st = (r >> 4) * 2 + (c >> 5), rr = r & 15, cc = c & 31, ob = rr * 64 + cc * 2; return st * 1024 + (ob ^ (((ob >> 9) & 1) << 5)); }
__host__ __device__ __forceinline__ void stage_rc(int b, int& R, int& C) { const int st = b / 1024, sb = b % 1024, swz = sb ^ (((sb >> 9) & 1) << 5); R = (st >> 1) * 16 + swz / 64; C = (st & 1) * 32 + (swz % 64) / 2; }
__host__ __device__ __forceinline__ int perm32(int rho) { const int n = rho >> 4, i = rho & 15; return 8 * (i >> 2) + 4 * n + (i & 3); }

struct Unit { int pm, pn; };
struct Gemm { const bf16_t* A; const bf16_t* Bt; int M, N, K; };

struct StaticOrder {
    int nM, nN, nwg, G, c;
    __host__ __device__ void init(int M, int N, int G_, int c_) { nM = M / BM; nN = N / BM; nwg = nM * nN; G = G_; c = c_; }
    __host__ __device__ bool next(int i, Unit& u) const {
        const long L = (long)i * G + c; if (L >= nwg) return false;
        int wgid = (int)L; { const int q = nwg / NXCD, r = nwg % NXCD, xcd = wgid % NXCD, off = wgid / NXCD; wgid = (xcd < r ? xcd * (q + 1) : r * (q + 1) + (xcd - r) * q) + off; }
        const int nig = WGM * nN, gid = wgid / nig, fm = gid * WGM, gsz = (nM - fm) < WGM ? (nM - fm) : WGM;
        u.pm = fm + ((wgid % nig) % gsz); u.pn = (wgid % nig) / gsz; return true;
    }
    __device__ __forceinline__ void a_ready(const Unit&) const {}
    __device__ __forceinline__ void done(const Unit&) const {}
};
__device__ __forceinline__ unsigned cvt_pk_bf16(float lo, float hi) { unsigned r; asm volatile("v_cvt_pk_bf16_f32 %0, %1, %2" : "=v"(r) : "v"(lo), "v"(hi)); return r; }
typedef float f32x2 __attribute__((ext_vector_type(2)));
template <class Epi, class Sched, bool ALIGN_EPI = false, bool SP2 = false>
__device__ __forceinline__ void gemm_phase(PG8_LAS unsigned char* lds, const Gemm g, const Sched& S, const Epi& E) {
    const int tid = threadIdx.x, wid = __builtin_amdgcn_readfirstlane(tid >> 6), lane = tid & 63, wr = wid >> 2, wc = wid & 3, fr = lane & 15, fq = lane >> 4;
    const int K = g.K, nt = K / BK;
    unsigned voffA[2], voffB[2];
#pragma unroll
    for (int i = 0; i < 2; ++i) { int R, C; stage_rc(tid * 16 + i * 8192, R, C); const int Rb = Epi::PERM ? ((R & ~31) + perm32(R & 31)) : R;
        voffA[i] = (unsigned)(R * K + C) * 2u; voffB[i] = (unsigned)(Rb * K + C) * 2u; }
    const size_t kstep = (size_t)(BK * 2);
    const size_t hstep = (size_t)HALF * K * 2;
    const size_t tstep = 2 * hstep;
    const unsigned ldsw = (unsigned)wid * 1024u;
    const int aoff = lds_byte(wr * 64 + fr, fq * 8), boff = lds_byte(wc * 32 + fr, fq * 8);
#define PG8_SA(b, h) (((b) * 2 + (h)) * HTB)
#define PG8_SB(b, h) ((4 + (b) * 2 + (h)) * HTB)
#define PG8_STAGE(bufoff, gbase, voff) do { _Pragma("unroll") for (int _i = 0; _i < 2; ++_i) \
        __builtin_amdgcn_global_load_lds((const unsigned*)((const char*)(gbase) + (voff)[_i]), (PG8_LAS unsigned*)(lds + (bufoff) + ldsw + _i * 8192), 16, 0, 0); } while (0)
#define PG8_LDA(dst, b, h) do { _Pragma("unroll") for (int m = 0; m < 4; ++m) _Pragma("unroll") for (int k = 0; k < 2; ++k) dst[m][k] = *(const PG8_LAS bf16x8*)(lds + PG8_SA(b, h) + aoff + m * 2048 + k * 1024); } while (0)
#define PG8_LDB(dst, b, h) do { _Pragma("unroll") for (int n = 0; n < 2; ++n) _Pragma("unroll") for (int k = 0; k < 2; ++k) dst[n][k] = *(const PG8_LAS bf16x8*)(lds + PG8_SB(b, h) + boff + n * 2048 + k * 1024); } while (0)
#define PG8_MMA(ai, bj, At, Bt) do { __builtin_amdgcn_s_setprio(1); _Pragma("unroll") for (int m = 0; m < 4; ++m) _Pragma("unroll") for (int n = 0; n < 2; ++n) _Pragma("unroll") for (int k = 0; k < 2; ++k) \
        acc[ai][bj][m][n] = __builtin_amdgcn_mfma_f32_16x16x32_bf16(Bt[n][k], At[m][k], acc[ai][bj][m][n], 0, 0, 0); __builtin_amdgcn_s_setprio(0); } while (0)
#define PG8_WAIT_V(n) asm volatile("s_waitcnt vmcnt(" #n ")" ::: "memory")
#define PG8_WAIT_L(n) asm volatile("s_waitcnt lgkmcnt(" #n ")" ::: "memory")
#define PG8_BAR __builtin_amdgcn_s_barrier()
#define PG8_SCHED __builtin_amdgcn_sched_barrier(0)
    Unit cur, nxt; int ui = 0;
    if (!S.next(0, cur)) return;
    f32x4 acc[2][2][4][2];
#pragma unroll
    for (int a = 0; a < 2; ++a)
#pragma unroll
        for (int b = 0; b < 2; ++b)
#pragma unroll
            for (int m = 0; m < 4; ++m)
#pragma unroll
                for (int n = 0; n < 2; ++n) acc[a][b][m][n] = (f32x4){0.f, 0.f, 0.f, 0.f};
    bf16x8 At[4][2], B0[2][2], B1[2][2];
    const char* cA = (const char*)g.A + (size_t)cur.pm * tstep; const char* cB = (const char*)g.Bt + (size_t)cur.pn * tstep;
    S.a_ready(cur);
    if constexpr (SP2) {
        PG8_STAGE(PG8_SB(0, 0), cB, voffB); PG8_STAGE(PG8_SB(0, 1), cB + hstep, voffB); PG8_STAGE(PG8_SA(0, 0), cA, voffA); PG8_STAGE(PG8_SA(0, 1), cA + hstep, voffA);
        if (wr == 1) PG8_BAR;
        PG8_WAIT_V(2); PG8_BAR;
        PG8_STAGE(PG8_SB(1, 0), cB + kstep, voffB); PG8_STAGE(PG8_SA(1, 0), cA + kstep, voffA); PG8_STAGE(PG8_SB(1, 1), cB + hstep + kstep, voffB);
        PG8_WAIT_V(6); PG8_BAR;
    } else {
        PG8_STAGE(PG8_SB(0, 0), cB, voffB); PG8_STAGE(PG8_SA(0, 0), cA, voffA); PG8_STAGE(PG8_SB(0, 1), cB + hstep, voffB); PG8_STAGE(PG8_SA(0, 1), cA + hstep, voffA);
        if (wr == 1) PG8_BAR;
        PG8_WAIT_V(4); PG8_BAR;
        PG8_STAGE(PG8_SB(1, 0), cB + kstep, voffB); PG8_STAGE(PG8_SA(1, 0), cA + kstep, voffA); PG8_STAGE(PG8_SB(1, 1), cB + hstep + kstep, voffB);
        PG8_WAIT_V(6); PG8_BAR;
    }
    for (;;) {
        const bool has_next = S.next(ui + 1, nxt);
        const char* nA = has_next ? (const char*)g.A + (size_t)nxt.pm * tstep : cA; const char* nB = has_next ? (const char*)g.Bt + (size_t)nxt.pn * tstep : cB;
        for (int t = 0; t < nt; t += 2) {
            const bool last = (t == nt - 2);
            const char* a1 = cA + (size_t)(t + 1) * kstep;
            const char* a2 = last ? nA : cA + (size_t)(t + 2) * kstep; const char* b2 = last ? nB : cB + (size_t)(t + 2) * kstep;
            const char* a3 = a2 + kstep; const char* b3 = b2 + kstep;
            if (last && has_next) S.a_ready(nxt);
            if constexpr (SP2) {
            PG8_LDB(B0, 0, 0); PG8_LDB(B1, 0, 1); PG8_SCHED; PG8_LDA(At, 0, 0); PG8_STAGE(PG8_SA(1, 1), a1 + hstep, voffA);
            PG8_WAIT_V(8); PG8_WAIT_L(0); PG8_BAR; PG8_MMA(0, 0, At, B0); PG8_MMA(0, 1, At, B1); PG8_BAR; PG8_SCHED;
            PG8_LDA(At, 0, 1); PG8_STAGE(PG8_SB(0, 0), b2, voffB); PG8_STAGE(PG8_SB(0, 1), b2 + hstep, voffB); PG8_STAGE(PG8_SA(0, 0), a2, voffA);
            PG8_WAIT_V(8); PG8_WAIT_L(0); PG8_BAR; PG8_MMA(1, 0, At, B0); PG8_MMA(1, 1, At, B1); PG8_BAR; PG8_SCHED;
            PG8_LDB(B0, 1, 0); PG8_LDB(B1, 1, 1); PG8_SCHED; PG8_LDA(At, 1, 0); PG8_STAGE(PG8_SA(0, 1), a2 + hstep, voffA);
            PG8_WAIT_V(8); PG8_WAIT_L(0); PG8_BAR; PG8_MMA(0, 0, At, B0); PG8_MMA(0, 1, At, B1); PG8_BAR; PG8_SCHED;
            PG8_LDA(At, 1, 1); PG8_STAGE(PG8_SB(1, 0), b3, voffB); PG8_STAGE(PG8_SB(1, 1), b3 + hstep, voffB); PG8_STAGE(PG8_SA(1, 0), a3, voffA);
            PG8_WAIT_V(8); PG8_WAIT_L(0); PG8_BAR; PG8_MMA(1, 0, At, B0); PG8_MMA(1, 1, At, B1); PG8_BAR; PG8_SCHED;
            } else {
            PG8_LDB(B0, 0, 0); PG8_SCHED; PG8_LDA(At, 0, 0); PG8_STAGE(PG8_SA(1, 1), a1 + hstep, voffA);
            PG8_WAIT_L(8); PG8_BAR; PG8_WAIT_L(0); PG8_MMA(0, 0, At, B0); PG8_BAR; PG8_SCHED;
            PG8_LDB(B1, 0, 1); PG8_STAGE(PG8_SB(0, 0), b2, voffB);
            PG8_BAR; PG8_WAIT_L(0); PG8_MMA(0, 1, At, B1); PG8_BAR;
            PG8_LDA(At, 0, 1); PG8_STAGE(PG8_SA(0, 0), a2, voffA);
            PG8_BAR; PG8_WAIT_L(0); PG8_MMA(1, 0, At, B0); PG8_BAR; PG8_SCHED;
            PG8_STAGE(PG8_SB(0, 1), b2 + hstep, voffB);
            PG8_WAIT_V(6); PG8_BAR; PG8_MMA(1, 1, At, B1); PG8_BAR;
            PG8_LDB(B0, 1, 0); PG8_SCHED; PG8_LDA(At, 1, 0); PG8_STAGE(PG8_SA(0, 1), a2 + hstep, voffA);
            PG8_WAIT_L(8); PG8_BAR; PG8_WAIT_L(0); PG8_MMA(0, 0, At, B0); PG8_BAR; PG8_SCHED;
            PG8_LDB(B1, 1, 1); PG8_STAGE(PG8_SB(1, 0), b3, voffB);
            PG8_BAR; PG8_WAIT_L(0); PG8_MMA(0, 1, At, B1); PG8_BAR;
            PG8_LDA(At, 1, 1); PG8_STAGE(PG8_SA(1, 0), a3, voffA);
            PG8_BAR; PG8_WAIT_L(0); PG8_MMA(1, 0, At, B0); PG8_BAR; PG8_SCHED;
            PG8_STAGE(PG8_SB(1, 1), b3 + hstep, voffB);
            PG8_WAIT_V(6); PG8_BAR; PG8_MMA(1, 1, At, B1); PG8_BAR;
            }
        }
        if constexpr (ALIGN_EPI) { if (wr == 0) PG8_BAR; }
        if constexpr (!Epi::AFTER_DRAIN) { E(acc, cur, wr, wc, fr, fq); S.done(cur); }
        if (!has_next) break;
#pragma unroll
        for (int a = 0; a < 2; ++a)
#pragma unroll
            for (int b = 0; b < 2; ++b)
#pragma unroll
                for (int m = 0; m < 4; ++m)
#pragma unroll
                    for (int n = 0; n < 2; ++n) acc[a][b][m][n] = (f32x4){0.f, 0.f, 0.f, 0.f};
        cur = nxt; cA = nA; cB = nB; ++ui;
        if constexpr (ALIGN_EPI) { if (wr == 1) PG8_BAR; }
    }
    PG8_WAIT_V(0);
    if constexpr (!ALIGN_EPI) { if (wr == 0) PG8_BAR; }
    PG8_BAR;
    if constexpr (Epi::AFTER_DRAIN) { E.fused(acc, cur, wr, wc, fr, fq, lds, wid, lane); S.done(cur); }
#undef PG8_SA
#undef PG8_SB
#undef PG8_STAGE
#undef PG8_LDA
#undef PG8_LDB
#undef PG8_MMA
#undef PG8_WAIT_V
#undef PG8_WAIT_L
#undef PG8_BAR
#undef PG8_SCHED
}
}

__device__ __forceinline__ u32x4 pack8(const f32x4 a, const f32x4 b) {
    u32x4 w; w.x = pk2(a[0], a[1]); w.y = pk2(a[2], a[3]); w.z = pk2(b[0], b[1]); w.w = pk2(b[2], b[3]); return w;
}
__device__ __forceinline__ float tanh_fast(float x) { const float e = __expf(2.f * x); return 1.f - 2.f * __builtin_amdgcn_rcpf(1.f + e); }
__device__ __forceinline__ float decay_of(float v) { const float ew = 0.6065306597126334f * __builtin_amdgcn_rcpf(1.f + __expf(-v)); return __expf(-ew); }
struct EpiInproj {
    static constexpr bool PERM = true, AFTER_DRAIN = false;
    bf16* QKV; float* R32; bf16* Z;
    __device__ __forceinline__ void operator()(const f32x4 (&acc)[2][2][4][2], const pg8::Unit& u, int wr, int wc, int fr, int fq) const {
        const int pn = u.pn;
#pragma unroll
        for (int ai = 0; ai < 2; ++ai)
#pragma unroll
            for (int m = 0; m < 4; ++m) {
                const unsigned row = (unsigned)u.pm * 256u + ai * 128 + wr * 64 + m * 16 + fr;
#pragma unroll
                for (int bj = 0; bj < 2; ++bj) {
                    f32x4 v0 = acc[ai][bj][m][0], v1 = acc[ai][bj][m][1];
                    const int cb = bj * 128 + wc * 32 + 8 * fq;
                    if (pn < 6) {
                        if (pn == 3) { v0 = v0 * C2; v1 = v1 * C2; }
                        *(u32x4*)(QKV + row * 1536 + pn * 256 + cb) = pack8(v0, v1);
                    } else if (pn < 9) {
                        float* p = R32 + row * 768 + (pn - 6) * 256 + cb;
                        *(f32x4*)p = v0; *(f32x4*)(p + 4) = v1;
                    } else if (pn == 9) {
                        if (bj == 0) {
#pragma unroll
                            for (int e = 0; e < 4; ++e) { v0[e] = tanh_fast(v0[e]); v1[e] = tanh_fast(v1[e]); }
                        }
                        *(u32x4*)(Z + row * 384 + cb) = pack8(v0, v1);
                    } else {
                        if (bj == 0) {
#pragma unroll
                            for (int e = 0; e < 4; ++e) { v0[e] = sigmoidf_(v0[e]); v1[e] = sigmoidf_(v1[e]); }
                            *(u32x4*)(Z + row * 384 + 256 + cb) = pack8(v0, v1);
                        }
                    }
                }
            }
    }
};
struct EpiLora {
    static constexpr bool PERM = true, AFTER_DRAIN = false;
    float* DEC; float* ASIG; float* G; const float* w0; const float* a0;
    template <int KIND> __device__ __forceinline__ void body(const f32x4 (&acc)[2][2][4][2], float* dst, const float* bias, unsigned row0, int cb0) const {
#pragma unroll
        for (int bj = 0; bj < 2; ++bj) {
            const int cb = bj * 128 + cb0;
            f32x4 b0 = (f32x4){0.f, 0.f, 0.f, 0.f}, b1 = b0;
            if (KIND != 2) { b0 = *(const f32x4*)(bias + cb); b1 = *(const f32x4*)(bias + cb + 4); }
#pragma unroll
            for (int ai = 0; ai < 2; ++ai)
#pragma unroll
                for (int m = 0; m < 4; ++m) {
                    f32x4 v0 = acc[ai][bj][m][0] + b0, v1 = acc[ai][bj][m][1] + b1;
#pragma unroll
                    for (int e = 0; e < 4; ++e) {
                        if (KIND == 0) { v0[e] = decay_of(v0[e]); v1[e] = decay_of(v1[e]); }
                        if (KIND == 1) { v0[e] = sigmoidf_(v0[e]); v1[e] = sigmoidf_(v1[e]); }
                    }
                    float* p = dst + (row0 + ai * 128 + m * 16) * 256u + cb;
                    *(f32x4*)p = v0; *(f32x4*)(p + 4) = v1;
                    asm volatile("" ::: "memory");
                }
        }
    }
    __device__ __forceinline__ void operator()(const f32x4 (&acc)[2][2][4][2], const pg8::Unit& u, int wr, int wc, int fr, int fq) const {
        const int pn = u.pn; const unsigned row0 = (unsigned)u.pm * 256u + wr * 64 + fr; const int cb0 = wc * 32 + 8 * fq;
        if (pn < 2) body<0>(acc, DEC + (size_t)pn * M * 256, w0 + pn * 256, row0, cb0);
        else if (pn < 4) body<1>(acc, ASIG + (size_t)(pn - 2) * M * 256, a0 + (pn - 2) * 256, row0, cb0);
        else body<2>(acc, G, w0, row0, cb0);
    }
};
struct EpiOut {
    static constexpr bool PERM = true, AFTER_DRAIN = false;
    float* Y;
    __device__ __forceinline__ void operator()(const f32x4 (&acc)[2][2][4][2], const pg8::Unit& u, int wr, int wc, int fr, int fq) const {
#pragma unroll
        for (int ai = 0; ai < 2; ++ai)
#pragma unroll
            for (int m = 0; m < 4; ++m) {
                const unsigned row = (unsigned)u.pm * 256u + ai * 128 + wr * 64 + m * 16 + fr;
#pragma unroll
                for (int bj = 0; bj < 2; ++bj) {
                    float* p = Y + row * 1024 + u.pn * 256 + bj * 128 + wc * 32 + 8 * fq;
                    *(f32x4*)p = acc[ai][bj][m][0]; *(f32x4*)(p + 4) = acc[ai][bj][m][1];
                }
            }
    }
};
struct EpiMoe1 {
    static constexpr bool PERM = true, AFTER_DRAIN = false;
    bf16* HID;
    __device__ __forceinline__ void operator()(const f32x4 (&acc)[2][2][4][2], const pg8::Unit& u, int wr, int wc, int fr, int fq) const {
        const int pnl = u.pn & 7;
#pragma unroll
        for (int ai = 0; ai < 2; ++ai)
#pragma unroll
            for (int m = 0; m < 4; ++m) {
                const unsigned row = (unsigned)u.pm * 256u + ai * 128 + wr * 64 + m * 16 + fr;
                f32x4 h0, h1;
#pragma unroll
                for (int e = 0; e < 4; ++e) {
                    const float g0 = acc[ai][0][m][0][e], g1 = acc[ai][0][m][1][e];
                    h0[e] = g0 * sigmoidf_(g0) * acc[ai][1][m][0][e];
                    h1[e] = g1 * sigmoidf_(g1) * acc[ai][1][m][1][e];
                }
                *(u32x4*)(HID + row * 1024 + pnl * 128 + wc * 32 + 8 * fq) = pack8(h0, h1);
            }
    }
};
struct EpiMoe2 {
    static constexpr bool PERM = true, AFTER_DRAIN = false;
    bf16* OUTE; const float* selg;
    __device__ __forceinline__ void operator()(const f32x4 (&acc)[2][2][4][2], const pg8::Unit& u, int wr, int wc, int fr, int fq) const {
        const int pnl = u.pn & 3;
#pragma unroll
        for (int ai = 0; ai < 2; ++ai)
#pragma unroll
            for (int m = 0; m < 4; ++m) {
                const unsigned row = (unsigned)u.pm * 256u + ai * 128 + wr * 64 + m * 16 + fr;
                const float gt = selg[row];
#pragma unroll
                for (int bj = 0; bj < 2; ++bj)
                    *(u32x4*)(OUTE + row * 1024 + pnl * 256 + bj * 128 + wc * 32 + 8 * fq) = pack8(acc[ai][bj][m][0] * gt, acc[ai][bj][m][1] * gt);
            }
    }
};

struct TileSched {
    int nM, nN, G, c; bool latent_only;
    __device__ __forceinline__ bool next(int i, pg8::Unit& u) const {
        const long L = (long)i * G + c; if (L >= (long)nM * nN) return false;
        const int pmi = (int)(L / nN); u.pn = (int)(L % nN); u.pm = latent_only ? (pmi >> 3) * 9 + 1 + (pmi & 7) : pmi; return true;
    }
    __device__ __forceinline__ void a_ready(const pg8::Unit&) const {}
    __device__ __forceinline__ void done(const pg8::Unit&) const {}
};
struct InprojLastSched {
    int G, c;
    __device__ __forceinline__ bool next(int i, pg8::Unit& u) const {
        const int L = i * G + c; if (L >= 768) return false;
        if (L < 704) { const int pmi = L / 11; u.pn = L % 11; u.pm = (pmi >> 3) * 9 + 1 + (pmi & 7); }
        else { const int r = L - 704; u.pm = (r >> 3) * 9; const int k = r & 7; u.pn = k == 0 ? 2 : k + 3; }
        return true;
    }
    __device__ __forceinline__ void a_ready(const pg8::Unit&) const {}
    __device__ __forceinline__ void done(const pg8::Unit&) const {}
};
struct MoeSched {
    int nMe, nNe, G, c;
    __device__ __forceinline__ bool next(int i, pg8::Unit& u) const {
        const long L = (long)i * G + c; if (L >= (long)NE * nMe * nNe) return false;
        const int pnl = (int)(L % nNe), t = (int)(L / nNe), pml = t % nMe, e = t / nMe;
        u.pm = e * 9 + pml; u.pn = e * nNe + pnl; return true;
    }
    __device__ __forceinline__ void a_ready(const pg8::Unit&) const {}
    __device__ __forceinline__ void done(const pg8::Unit&) const {}
};

template <class Epi, class Sched>
__device__ __forceinline__ void gemm_ref(const pg8::Gemm g, const Sched& S, const Epi& E) {
    const int tid = threadIdx.x, wid = tid >> 6, lane = tid & 63, wr = wid >> 2, wc = wid & 3, fr = lane & 15, fq = lane >> 4;
    int K = g.K; asm volatile("" : "+s"(K));
    pg8::Unit u;
    for (int ui = 0; S.next(ui, u); ++ui) {
        f32x4 acc[2][2][4][2];
#pragma unroll
        for (int a = 0; a < 2; ++a)
#pragma unroll
            for (int b = 0; b < 2; ++b)
#pragma unroll
                for (int m = 0; m < 4; ++m)
#pragma unroll
                    for (int n = 0; n < 2; ++n) acc[a][b][m][n] = (f32x4){0.f, 0.f, 0.f, 0.f};
        const bf16* Ab = g.A + ((size_t)u.pm * 256 + wr * 64 + fr) * K;
        const bf16* Bb = g.Bt + ((size_t)u.pn * 256 + wc * 32 + 8 * fq) * K;
#pragma unroll
        for (int ai = 0; ai < 2; ++ai)
#pragma unroll
            for (int bj = 0; bj < 2; ++bj)
#pragma unroll
                for (int m = 0; m < 4; ++m)
#pragma unroll
                    for (int n = 0; n < 2; ++n)
#pragma unroll
                        for (int e = 0; e < 4; ++e) {
                            const bf16* ar = Ab + (size_t)(ai * 128 + m * 16) * K; const bf16* br = Bb + (size_t)(bj * 128 + 4 * n + e) * K;
                            float s0 = 0.f, s1 = 0.f;
#pragma unroll 2
                            for (int k0 = 0; k0 < K; k0 += 8) {
                                const u32x4 wa = *(const u32x4*)(ar + k0), wb = *(const u32x4*)(br + k0);
                                s0 += bflo(wa.x) * bflo(wb.x) + bflo(wa.y) * bflo(wb.y) + bflo(wa.z) * bflo(wb.z) + bflo(wa.w) * bflo(wb.w);
                                s1 += bfhi(wa.x) * bfhi(wb.x) + bfhi(wa.y) * bfhi(wb.y) + bfhi(wa.z) * bfhi(wb.z) + bfhi(wa.w) * bfhi(wb.w);
                            }
                            acc[ai][bj][m][n][e] = s0 + s1;
                            asm volatile("" ::: "memory");
                        }
        E(acc, u, wr, wc, fr, fq);
    }
}
template <class Epi, class Sched>
__device__ __forceinline__ void run_gemm(LAS unsigned char* lds, const pg8::Gemm g, const Sched& S, const Epi& E) {
#if GOLD_GEMM
    gemm_ref<Epi, Sched>(g, S, E);
    __syncthreads();
#else
    pg8::Gemm g2 = g; { int kd = g.K; asm volatile("" : "+s"(kd)); g2.K = kd; }
    pg8::gemm_phase<Epi, Sched, true, true>(lds, g2, S, E);
#endif
}

struct Args { const float* in[29]; float* out; unsigned char* ws; int ph_lo, ph_hi; };
enum { I_X = 0, I_C, I_CTX, I_CCTX, I_WMOD, I_BMOD, I_GPREMIX, I_GPOSTMIX, I_GPREFFN, I_GPOSTFFN, I_WIN, I_WOUT, I_QGAIN, I_KGAIN, I_RPB,
       I_W0, I_WUP, I_A0, I_AUP, I_GUP, I_KK, I_KA, I_RK, I_LNXW, I_LNXB, I_WROUTER, I_WEGATE, I_WEUP, I_WEDOWN };

struct Frame {
    LAS unsigned char* lds; volatile LAS unsigned* MISC; unsigned* ctl;
    int wave, vcu, G;
    const float* const* in; float* out; unsigned char* ws;
};
#define TID_ ((int)threadIdx.x)
#define LANE_ ((int)(threadIdx.x & 63u))
#define WSP(T_, off) ((T_*)(F.ws + (off)))

__device__ __forceinline__ void cvt_item(const float* src, int ld_src, bf16* dst, int ld_dst, LAS float* scr, int lane) {
#pragma unroll 8
    for (int i = 0; i < 32; ++i) { const int kk = 2 * i + (lane >> 5); scr[kk * 33 + (lane & 31)] = src[(size_t)kk * ld_src + (lane & 31)]; }
    LDS_WAIT(); asm volatile("" ::: "memory");
    const int c = lane & 7;
#pragma unroll
    for (int j = 0; j < 4; ++j) { const int n = (lane >> 3) + 8 * j; const LAS float* s = scr + (8 * c) * 33 + n;
        u32x4 o; o.x = pk2(s[0 * 33], s[1 * 33]); o.y = pk2(s[2 * 33], s[3 * 33]); o.z = pk2(s[4 * 33], s[5 * 33]); o.w = pk2(s[6 * 33], s[7 * 33]);
        *(u32x4*)(dst + (size_t)n * ld_dst + 8 * c) = o; }
    LDS_WAIT(); asm volatile("" ::: "memory");
}
__device__ __forceinline__ void cvt_moe_item(Frame& F, int l, int it, LAS float* scr, int lane) {
    const int which = it >> 13, r = it & 8191, e = r >> 9, q = r & 511, kb = q >> 5, nb = q & 31, n0 = nb * 32;
    const float* W = F.in[which == 0 ? I_WEGATE : (which == 1 ? I_WEUP : I_WEDOWN)] + ((size_t)(l * NE + e) * 1024 + kb * 64) * 1024 + n0;
    bf16* dst;
    if (which < 2) dst = WSP(bf16, WS_WGU) + ((size_t)e * 2048 + (n0 >> 7) * 256 + which * 128 + (n0 & 127)) * 1024 + kb * 64;
    else dst = WSP(bf16, WS_WD) + ((size_t)e * 1024 + n0) * 1024 + kb * 64;
    cvt_item(W, 1024, dst, 1024, scr, lane);
}
constexpr int CVT_BLK = 32, CVT_NBLK = 3 * 8192 / CVT_BLK;
__device__ __forceinline__ void cvt_moe_block(Frame& F, int l, int bi) {
    int lane = LANE_; asm volatile("" : "+v"(lane));
    LAS float* scr = (LAS float*)(F.lds + F.wave * 16384);
#pragma unroll 1
    for (int k = 0; k < CVT_BLK / NWAVES; ++k) cvt_moe_item(F, l, bi * CVT_BLK + k * NWAVES + F.wave, scr, lane);
}

__device__ __forceinline__ void phase_init(Frame& F) {
    const int tid = TID_;
    {
        LAS float* sil = (LAS float*)F.lds;
        LAS float* red = (LAS float*)(F.lds + 40960);
        float* MOD = WSP(float, WS_MOD);
        bool have = false;
        for (int it = F.vcu; it < 2 * 96; it += F.G) {
            if (!have) {
                for (int i = tid; i < 9 * 1024; i += NTHREADS) { const int r = i >> 10, k = i & 1023; const float cv = (r < 8) ? F.in[I_C][r * 1024 + k] : F.in[I_CCTX][k]; sil[i] = cv / (1.f + expf(-cv)); }
                __syncthreads(); have = true;
            }
            const int l = it / 96, n0 = (it % 96) * 64, ks = tid >> 6, col = tid & 63;
            float acc[9];
#pragma unroll
            for (int r = 0; r < 9; ++r) acc[r] = 0.f;
            const float* w = F.in[I_WMOD] + ((size_t)l * 1024 + ks * 128) * 6144 + n0 + col;
            for (int k = 0; k < 128; ++k) { const float wv = w[(size_t)k * 6144];
#pragma unroll
                for (int r = 0; r < 9; ++r) acc[r] += sil[r * 1024 + ks * 128 + k] * wv; }
#pragma unroll
            for (int r = 0; r < 9; ++r) red[(ks * 9 + r) * 64 + col] = acc[r];
            __syncthreads();
            for (int o = tid; o < 576; o += NTHREADS) { const int r = o >> 6, cc = o & 63; float s = 0.f;
#pragma unroll
                for (int k2 = 0; k2 < 8; ++k2) s += red[(k2 * 9 + r) * 64 + cc];
                MOD[(size_t)(l * 9 + r) * 6144 + n0 + cc] = s + F.in[I_BMOD][l * 6144 + n0 + cc]; }
            __syncthreads();
        }
        __syncthreads();
    }
    {
        LAS float* scr = (LAS float*)(F.lds + F.wave * 16384);
        const int gw = F.vcu * NWAVES + F.wave, NGW = F.G * NWAVES;
        bf16* WIN = WSP(bf16, WS_WIN); bf16* WOUT = WSP(bf16, WS_WOUT);
        for (int it = gw; it < 2 * (1344 + 512); it += NGW) {
            const int l = it / 1856, r = it % 1856;
            if (r < 1344) { const int kb = r / 84, n0 = (r % 84) * 32; const int dn = n0 < 768 ? n0 : (n0 < 1920 ? n0 + 768 : n0 - 1152);
                cvt_item(F.in[I_WIN] + ((size_t)l * 1024 + kb * 64) * 2688 + n0, 2688, WIN + ((size_t)l * NINP + dn) * 1024 + kb * 64, 1024, scr, LANE_); }
            else { const int q = r - 1344, kb = q >> 5, n0 = (q & 31) * 32;
                cvt_item(F.in[I_WOUT] + ((size_t)l * 1024 + kb * 64) * 1024 + n0, 1024, WOUT + ((size_t)l * 1024 + n0) * 1024 + kb * 64, 1024, scr, LANE_); }
        }
    }
    {
        const size_t gt = (size_t)F.vcu * NTHREADS + tid, NT = (size_t)F.G * NTHREADS;
        u32x4* WIN4 = WSP(u32x4, WS_WIN);
        for (size_t i = gt; i < (size_t)2 * 128 * 128; i += NT) { const int l = (int)(i >> 14), r = (int)(i & 16383); WIN4[((size_t)l * NINP + 2688) * 128 + r] = (u32x4){0u, 0u, 0u, 0u}; }
        bf16* LORA = WSP(bf16, WS_LORA);
        for (size_t i = gt; i < (size_t)2 * 1280 * 384; i += NT) { const int l = (int)(i / (1280 * 384)), r = (int)(i % (1280 * 384)), n = r / 384, k = r % 384, tile = n >> 8, nn = n & 255;
            float v = 0.f;
            if (tile < 2) { const int d = tile, kk = k - 64 * d; if (kk >= 0 && kk < 64) v = F.in[I_WUP][(((size_t)l * 2 + d) * 64 + kk) * 256 + nn]; }
            else if (tile < 4) { const int d = tile - 2, kk = k - 128 - 64 * d; if (kk >= 0 && kk < 64) v = F.in[I_AUP][(((size_t)l * 2 + d) * 64 + kk) * 256 + nn]; }
            else { const int kk = k - 256; if (kk >= 0) v = F.in[I_GUP][((size_t)l * 128 + kk) * 256 + nn]; }
            LORA[i] = (bf16)f2bf(v); }
    }
}

__device__ __forceinline__ const float* in_row(Frame& F, int b, int t) { return t < CTXL ? F.in[I_CTX] + ((size_t)b * CTXL + t) * 1024 : F.in[I_X] + ((size_t)b * SEQ + (t - CTXL)) * 1024; }
__device__ __forceinline__ float row_ss(const f32x4 (&v)[4]) {
    float s = 0.f;
#pragma unroll
    for (int j = 0; j < 4; ++j) s += (v[j][0] * v[j][0] + v[j][1] * v[j][1]) + (v[j][2] * v[j][2] + v[j][3] * v[j][3]);
    return wave_sum(s);
}
__device__ __forceinline__ void mod_store(const f32x4 (&x)[4], float rinv, const float* g, const float* shift, const float* scale, bf16* dst, int lane, f32x4 (&h)[4]) {
#pragma unroll
    for (int j = 0; j < 4; ++j) { const int e = 256 * j + 4 * lane;
        const f32x4 gg = *(const f32x4*)(g + e), sh = *(const f32x4*)(shift + e), sc = *(const f32x4*)(scale + e);
        h[j] = x[j] * rinv * gg * (sc + 1.f) + sh;
        u32x2 w; w.x = pk2(h[j][0], h[j][1]); w.y = pk2(h[j][2], h[j][3]); *(u32x2*)(dst + e) = w; }
}
__device__ __forceinline__ void phase_row0(Frame& F) {
    const int gw = F.vcu * NWAVES + F.wave, NGW = F.G * NWAVES, lane = LANE_;
    bf16* H = WSP(bf16, WS_H); const float* MOD = WSP(float, WS_MOD);
    for (int m = gw; m < M; m += NGW) { const int b = m / T, t = m % T, r = t < CTXL ? 8 : b;
        const float* xin = in_row(F, b, t);
        f32x4 x[4], h[4];
#pragma unroll
        for (int j = 0; j < 4; ++j) x[j] = *(const f32x4*)(xin + 256 * j + 4 * lane);
        const float rinv = rsqrtf(row_ss(x) * (1.f / 1024.f) + 1e-6f);
        const float* md = MOD + (size_t)(0 * 9 + r) * 6144;
        mod_store(x, rinv, F.in[I_GPREMIX], md, md + 1024, H + (size_t)m * 1024, lane, h);
    }
}
__device__ __forceinline__ void phase_row1(Frame& F, int l, bool dry = false) {
    const int gw = F.vcu * NWAVES + F.wave, NGW = F.G * NWAVES, lane = LANE_;
    const float* X = WSP(float, WS_X); const float* Y = WSP(float, WS_Y); const float* MOD = WSP(float, WS_MOD);
    float* Xs = dry ? WSP(float, WS_XE) : WSP(float, WS_X); bf16* H2 = dry ? WSP(bf16, WS_XE) : WSP(bf16, WS_H2);
    float* AFF = dry ? WSP(float, WS_XE) : WSP(float, WS_AFF); int* INV = dry ? WSP(int, WS_XE) : WSP(int, WS_INV);
    {
        const f32x4* src = (const f32x4*)(F.in[I_WROUTER] + (size_t)l * 1024 * 16); LAS f32x4* dstl = (LAS f32x4*)F.lds;
        for (int i = TID_; i < 4096; i += NTHREADS) dstl[i] = src[i];
        __syncthreads();
    }
    const LAS float* wbase = (const LAS float*)F.lds + lane * 64;
    for (int m = gw; m < M; m += NGW) { const int b = m / T, t = m % T, r = t < CTXL ? 8 : b;
        if (l == NL - 1 && t < CTXL) continue;
        const float* md = MOD + (size_t)(l * 9 + r) * 6144;
        f32x4 x[4], y[4], h[4];
        const float* xin = (l == 0) ? in_row(F, b, t) : X + (size_t)m * 1024;
#pragma unroll
        for (int j = 0; j < 4; ++j) { y[j] = *(const f32x4*)(Y + (size_t)m * 1024 + 256 * j + 4 * lane); x[j] = *(const f32x4*)(xin + 256 * j + 4 * lane); }
        const float rinv = rsqrtf(row_ss(y) * (1.f / 1024.f) + 1e-6f);
#pragma unroll
        for (int j = 0; j < 4; ++j) { const int e = 256 * j + 4 * lane;
            const f32x4 gg = *(const f32x4*)(F.in[I_GPOSTMIX] + l * 1024 + e), gt = *(const f32x4*)(md + 2 * 1024 + e);
            x[j] = x[j] + gt * (y[j] * rinv * gg); *(f32x4*)(Xs + (size_t)m * 1024 + e) = x[j]; }
        const float rinv2 = rsqrtf(row_ss(x) * (1.f / 1024.f) + 1e-6f);
        mod_store(x, rinv2, F.in[I_GPREFFN] + l * 1024, md + 3 * 1024, md + 4 * 1024, H2 + (size_t)m * 1024, lane, h);
        float lg[16];
#pragma unroll
        for (int k = 0; k < 16; ++k) lg[k] = 0.f;
#pragma unroll
        for (int j = 0; j < 4; ++j)
#pragma unroll
            for (int c = 0; c < 4; ++c) { const LAS float* w = wbase + j * 4096 + c * 16; const float hv = h[j][c];
#pragma unroll
                for (int q = 0; q < 4; ++q) { const f32x4 wv = *(const LAS f32x4*)(w + 4 * q); lg[4 * q + 0] += hv * wv[0]; lg[4 * q + 1] += hv * wv[1]; lg[4 * q + 2] += hv * wv[2]; lg[4 * q + 3] += hv * wv[3]; }
                asm volatile("" ::: "memory"); }
        float mx = -1e30f;
#pragma unroll
        for (int k = 0; k < 16; ++k) { lg[k] = wave_sum(lg[k]); mx = fmaxf(mx, lg[k]); }
        float den = 0.f, mine = 0.f;
#pragma unroll
        for (int k = 0; k < 16; ++k) { const float ex = expf(lg[k] - mx); den += ex; if ((lane & 15) == k) mine = ex; }
        if (lane < 16) { AFF[(size_t)m * 16 + lane] = mine / den; INV[(size_t)m * 16 + lane] = -1; }
    }
}
__device__ __forceinline__ void phase_row2(Frame& F, int l, bool dry = false) {
    const int gw = F.vcu * NWAVES + F.wave, NGW = F.G * NWAVES, lane = LANE_;
    const float* X = WSP(float, WS_X); const bf16* OUTE = WSP(bf16, WS_OUTE); const float* MOD = WSP(float, WS_MOD);
    float* Xs = dry ? WSP(float, WS_XE) : WSP(float, WS_X); bf16* H = dry ? WSP(bf16, WS_XE) : WSP(bf16, WS_H); float* outp = dry ? WSP(float, WS_XE) : F.out;
    const int* INV = WSP(int, WS_INV);
    const bool last = (l == NL - 1);
    for (int m = gw; m < M; m += NGW) { const int b = m / T, t = m % T, r = t < CTXL ? 8 : b;
        if (last && t < CTXL) continue;
        const float* md = MOD + (size_t)(l * 9 + r) * 6144;
        f32x4 x[4], f[4], h[4];
#pragma unroll
        for (int j = 0; j < 4; ++j) { x[j] = *(const f32x4*)(X + (size_t)m * 1024 + 256 * j + 4 * lane); f[j] = (f32x4){0.f, 0.f, 0.f, 0.f}; }
        const int invl = INV[(size_t)m * 16 + (lane & 15)];
        for (int e = 0; e < 16; ++e) { const int rr = __shfl(invl, e);
            if (rr >= 0) {
#pragma unroll
                for (int j = 0; j < 4; ++j) { const u32x2 w = *(const u32x2*)(OUTE + (size_t)rr * 1024 + 256 * j + 4 * lane);
                    f[j][0] += bflo(w.x); f[j][1] += bfhi(w.x); f[j][2] += bflo(w.y); f[j][3] += bfhi(w.y); } } }
        const float rinv = rsqrtf(row_ss(f) * (1.f / 1024.f) + 1e-6f);
#pragma unroll
        for (int j = 0; j < 4; ++j) { const int e = 256 * j + 4 * lane;
            const f32x4 gg = *(const f32x4*)(F.in[I_GPOSTFFN] + l * 1024 + e), gt = *(const f32x4*)(md + 5 * 1024 + e);
            x[j] = x[j] + gt * (f[j] * rinv * gg);
            if (last) *(f32x4*)(outp + ((size_t)b * SEQ + (t - CTXL)) * 1024 + e) = x[j];
            else *(f32x4*)(Xs + (size_t)m * 1024 + e) = x[j]; }
        if (!last) {
            const float rinv2 = rsqrtf(row_ss(x) * (1.f / 1024.f) + 1e-6f);
            const float* md2 = MOD + (size_t)((l + 1) * 9 + r) * 6144;
            mod_store(x, rinv2, F.in[I_GPREMIX] + (l + 1) * 1024, md2, md2 + 1024, H + (size_t)m * 1024, lane, h);
        }
    }
}

__device__ __forceinline__ void phase_qkprep(Frame& F, int l, bool dry = false) {
    const int gw = F.vcu * NWAVES + F.wave, NGW = F.G * NWAVES, lane = LANE_;
    bf16* QKV = WSP(bf16, WS_QKV); bf16* QO = dry ? WSP(bf16, WS_YD) : QKV;
    const float qg = F.in[I_QGAIN][l * 64 + lane] * C2, kg = F.in[I_KGAIN][l * 64 + lane];
    const int i16 = lane & 15; const bool second = (lane & 16) != 0, colseg = (lane & 32) != 0;
    const float inv = exp2f(-(float)i16 * (13.287712379549449f / 16.f));
    for (int m = gw; m < M; m += NGW) { const int t = m % T; const bool ctx = t < CTXL;
        const int s0 = (l == NL - 1 && ctx) ? 8 : 0;
        const bf16* p = QKV + (size_t)m * 1536 + lane; bf16* po = QO + (size_t)m * 1536 + lane;
        float x[10];
#pragma unroll
        for (int s = 0; s < 10; ++s) x[s] = (s >= s0) ? bf2f(p[s * 64]) : 0.f;
        float cs = 1.f, sn = 0.f;
        if (!ctx) { const int pos = t - CTXL; const float ang = (float)(colseg ? (pos & 63) : (pos >> 6)) * inv; cs = cosf(ang); sn = sinf(ang); if (!second) sn = -sn; }
#pragma unroll
        for (int s = 0; s < 10; ++s) {
            if (s < s0) continue;
            const float ss = wave_sum(x[s] * x[s]);
            float y = x[s] * __builtin_amdgcn_rsqf(ss * (1.f / 64.f) + 1e-6f) * (s < 8 ? qg : kg);
            const float other = __shfl_xor(y, 16);
            y = y * cs + other * sn;
            po[s * 64] = (bf16)f2bf(y);
        }
    }
}
#include <hip/hip_bf16.h>
#include <cmath>
namespace attn_body {
using bf16=__hip_bfloat16;
using bf16x8=__attribute__((ext_vector_type(8)))short;
using s16x4=__attribute__((ext_vector_type(4)))short;
using f32x16=__attribute__((ext_vector_type(16)))float;
using u32x4=__attribute__((ext_vector_type(4)))unsigned;
constexpr int D=64,QP=1536,OP=1024;
constexpr int NW=8,QBLK=32,QB=QBLK*NW,KVBLK=64;
__device__ __forceinline__ int crow(int r,int hi){return (r&3)+8*(r>>2)+4*hi;}
#define SBAR() __builtin_amdgcn_sched_barrier(0)
constexpr int NSLOT=3, SLOTB=8192;
constexpr int LDS_K=0, LDS_V=NSLOT*SLOTB, LDS_WS=2*NSLOT*SLOTB, LDS_OST=LDS_WS+NW*64*4, LDS_RPB=LDS_OST+NW*4096, LDS_BYTES=LDS_RPB+3072;
constexpr float C2=0.125f*1.4426950408889634f;
__device__ __forceinline__ void glds16(const void*gsrc,unsigned lds_dst){unsigned keep;
  asm volatile("s_mov_b32 %0, m0\n\ts_mov_b32 m0, %2\n\ts_nop 0\n\tglobal_load_lds_dwordx4 %1, off\n\ts_mov_b32 m0, %0":"=&s"(keep):"v"(gsrc),"s"(lds_dst):"memory");}
__device__ __forceinline__ float max3f(float a,float b,float c){float r;asm("v_max3_f32 %0, %1, %2, %3":"=v"(r):"v"(a),"v"(b),"v"(c));return r;}
__device__ __forceinline__ float max2f(float a,float b){float r;asm("v_max_f32_e32 %0, %1, %2":"=v"(r):"v"(a),"v"(b));return r;}
__device__ __forceinline__ float fadd_s(float a,float b){float r;asm("v_add_f32_e32 %0, %1, %2":"=v"(r):"v"(a),"v"(b));return r;}
__device__ __forceinline__ float fsub_s(float a,float b){float r;asm("v_sub_f32_e32 %0, %1, %2":"=v"(r):"v"(a),"v"(b));return r;}
typedef float f32x2_t __attribute__((ext_vector_type(2))); typedef __bf16 bf16x2_t __attribute__((ext_vector_type(2)));
__device__ __forceinline__ unsigned cvtpk_s(float lo,float hi){f32x2_t v={lo,hi};bf16x2_t b=__builtin_convertvector(v,bf16x2_t);return __builtin_bit_cast(unsigned,b);}
#define WAIT_BAR(N) asm volatile("s_waitcnt vmcnt(" #N ") lgkmcnt(0)\n\ts_barrier":::"memory")

__device__ __forceinline__ void qkt(f32x16&p0,f32x16&p1,const char*Kslot,const bf16x8*qr,const f32x16&negm,int r32,int hi){
  const char*kb=Kslot+hi*1024+r32*16;
  #pragma unroll
  for(int d0=0;d0<4;++d0){
    const bf16x8 b0=*reinterpret_cast<const bf16x8*>(kb+d0*2048);
    const bf16x8 b1=*reinterpret_cast<const bf16x8*>(kb+d0*2048+512);
    if(d0==0){p0=__builtin_amdgcn_mfma_f32_32x32x16_bf16(b0,qr[0],negm,0,0,0);p1=__builtin_amdgcn_mfma_f32_32x32x16_bf16(b1,qr[0],negm,0,0,0);}
    else{p0=__builtin_amdgcn_mfma_f32_32x32x16_bf16(b0,qr[d0],p0,0,0,0);p1=__builtin_amdgcn_mfma_f32_32x32x16_bf16(b1,qr[d0],p1,0,0,0);}}
}
typedef __attribute__((address_space(3))) const char* lds_cptr;
typedef short v4i16_t __attribute__((ext_vector_type(4)));
__device__ __forceinline__ void kload8(bf16x8*kf,lds_cptr kp){
  kf[0]=*(const __attribute__((address_space(3))) bf16x8*)(kp);      kf[1]=*(const __attribute__((address_space(3))) bf16x8*)(kp+512);
  kf[2]=*(const __attribute__((address_space(3))) bf16x8*)(kp+2048); kf[3]=*(const __attribute__((address_space(3))) bf16x8*)(kp+2560);
  kf[4]=*(const __attribute__((address_space(3))) bf16x8*)(kp+4096); kf[5]=*(const __attribute__((address_space(3))) bf16x8*)(kp+4608);
  kf[6]=*(const __attribute__((address_space(3))) bf16x8*)(kp+6144); kf[7]=*(const __attribute__((address_space(3))) bf16x8*)(kp+6656);
}
__device__ __forceinline__ void kload2(bf16x8*kf,lds_cptr kp,int j){ kf[2*j]=*(const __attribute__((address_space(3))) bf16x8*)(kp+j*2048); kf[2*j+1]=*(const __attribute__((address_space(3))) bf16x8*)(kp+j*2048+512); }
__device__ __forceinline__ s16x4 vtr(lds_cptr p){ return __builtin_bit_cast(s16x4,__builtin_amdgcn_ds_read_tr16_b64_v4i16((__attribute__((address_space(3))) v4i16_t*)p)); }
__device__ __forceinline__ float rowmax(const f32x16&p0,const f32x16&p1){
  float a=max3f(p0[0],p0[1],p1[0]),b=max3f(p0[2],p0[3],p1[1]);a=max3f(a,p1[2],p1[3]);
  #pragma unroll
  for(int r=4;r<16;r+=4){a=max3f(a,p0[r],p0[r+1]);b=max3f(b,p0[r+2],p0[r+3]);a=max3f(a,p1[r],p1[r+1]);b=max3f(b,p1[r+2],p1[r+3]);}
  const float m=max2f(a,b);
  auto rr=__builtin_amdgcn_permlane32_swap(__float_as_uint(m),__float_as_uint(m),false,false);
  return max2f(__uint_as_float(rr[0]),__uint_as_float(rr[1]));
}
__device__ __forceinline__ void pv(f32x16*o,int vb,bf16x8 pa0,bf16x8 pa1,bf16x8 pa2,bf16x8 pa3){
  #pragma unroll
  for(int d0=0;d0<2;++d0){s16x4 lo[4],hi[4];
    #pragma unroll
    for(int ks=0;ks<4;++ks){
      asm volatile("ds_read_b64_tr_b16 %0,%1 offset:%c2":"=&v"(lo[ks]):"v"(vb),"i"(d0*4096+ks*1024):"memory");
      asm volatile("ds_read_b64_tr_b16 %0,%1 offset:%c2":"=&v"(hi[ks]):"v"(vb),"i"(d0*4096+ks*1024+512):"memory");}
    asm volatile("s_waitcnt lgkmcnt(0)":::"memory");SBAR();
    #define PK(k) (bf16x8){lo[k][0],lo[k][1],lo[k][2],lo[k][3],hi[k][0],hi[k][1],hi[k][2],hi[k][3]}
    o[d0]=__builtin_amdgcn_mfma_f32_32x32x16_bf16(pa0,PK(0),o[d0],0,0,0);
    o[d0]=__builtin_amdgcn_mfma_f32_32x32x16_bf16(pa1,PK(1),o[d0],0,0,0);
    o[d0]=__builtin_amdgcn_mfma_f32_32x32x16_bf16(pa2,PK(2),o[d0],0,0,0);
    o[d0]=__builtin_amdgcn_mfma_f32_32x32x16_bf16(pa3,PK(3),o[d0],0,0,0);
    #undef PK
  }
}

#ifndef ATTN_STORE16
#define ATTN_STORE16(p,v) (*(u32x4*)(p)=(v))
#endif
template<int THRL,bool WIN> __device__ __forceinline__ void attn_unit(const bf16*Qw0,const bf16*__restrict__ Kh,const bf16*__restrict__ Vh,bf16*Ow0,const int NT,const int toff,const int rb,const int rs0,const float*rpbh,char*shm){
  int tid_=threadIdx.x; asm volatile("":"+v"(tid_));
  const int tid=tid_,lane=tid&63,r32=lane&31,hi=lane>>5; const int wid=__builtin_amdgcn_readfirstlane(tid>>6);
  const bf16*Qw=Qw0+(long)(wid*QBLK)*QP;
  const unsigned lds0=(unsigned)(uintptr_t)shm;
  float*wsf=(float*)(shm+LDS_WS)+wid*64;
  const bf16*ksrc=Kh+(long)lane*QP+wid*8;
  const bf16*vsrc=Vh+(long)(16*(wid&3)+(lane>>2))*QP+(wid>>2)*32+(lane&3)*8;
  const unsigned kdst=lds0+LDS_K+wid*1024, vdst=lds0+LDS_V+wid*1024;
  #define TROW(t) ((long)(((t)+(((t)>=4)?toff:0))*KVBLK)*QP)
  #define DMA_K(t,slot) glds16(ksrc+TROW(t),(unsigned)__builtin_amdgcn_readfirstlane(kdst+(slot)))
  #define DMA_V(t,slot) glds16(vsrc+TROW(t),(unsigned)__builtin_amdgcn_readfirstlane(vdst+(slot)))
  const int vb0=(int)(lds0+LDS_V)+((lane>>4)&1)*32+(lane&3)*8+(4*hi+((lane&15)>>2))*64;
  const char*Kbase=shm+LDS_K; bf16x8 kf[8];
  const lds_cptr shm3=(lds_cptr)shm; const lds_cptr kp0=shm3+LDS_K+hi*1024+r32*16; const lds_cptr vp0=shm3+LDS_V+((lane>>4)&1)*32+(lane&3)*8+(4*hi+((lane&15)>>2))*64;
  DMA_K(0,0);DMA_V(0,0);DMA_K(1,SLOTB);
  bf16x8 qr[4];
  #pragma unroll
  for(int d0=0;d0<4;++d0)qr[d0]=*reinterpret_cast<const bf16x8*>(&Qw[(long)r32*QP+d0*16+hi*8]);
  float mhat=0.f,l_reg=0.f;f32x16 o[2];o[0]=f32x16{};o[1]=f32x16{};f32x16 negm=f32x16{};asm volatile("":"+v"(negm));
  const int gr=4*rb+(wid>>1), gc=(wid&1)*32+r32, rsq=min(max(gr-4,0),24), csq=min(max(gc-8,0),48);
  const float*rpbl=(const float*)(shm+LDS_RPB+256)+(15-gc+4*hi);
  const int kcb=4*hi-csq;
  if(WIN){ for(int i_=tid;i_<15*31;i_+=512)((float*)(shm+LDS_RPB+256))[i_]=rpbh[i_]*1.4426950408889634f; }
  #define CMASK(P0,P1,t) do{ if(WIN && (t)>=4){ const int kr_=rs0+(t)-4; const bool rowok_=(kr_>=rsq)&&(kr_<rsq+8); \
      if(!rowok_){ _Pragma("unroll") for(int r=0;r<16;++r){P0[r]=-INFINITY;P1[r]=-INFINITY;} } \
      else { const float*bp_=rpbl+(kr_-gr+7)*31; \
        _Pragma("unroll") for(int r=0;r<16;++r){ const int o_=(r&3)+8*(r>>2); \
          const float b0_=bp_[o_], b1_=bp_[o_+32]; \
          P0[r]=((unsigned)(kcb+o_)<16u)?P0[r]+b0_:-INFINITY; P1[r]=((unsigned)(kcb+o_+32)<16u)?P1[r]+b1_:-INFINITY; } } } }while(0)
  bool resc=false;
  #define START(P0,P1) do{ const float rm=rowmax(P0,P1); resc=false; \
    { const float dl=rm; mhat=fadd_s(mhat,dl); \
      _Pragma("unroll") for(int r=0;r<16;++r){P0[r]=fsub_s(P0[r],dl);P1[r]=fsub_s(P1[r],dl);} \
      _Pragma("unroll") for(int r=0;r<16;++r)negm[r]=-mhat; asm volatile("":"+v"(negm)); } \
    _Pragma("unroll") for(int r=0;r<16;++r)P0[r]=__builtin_amdgcn_exp2f(P0[r]); }while(0)
  #define RESC() do{ if(resc){ asm volatile("s_waitcnt lgkmcnt(0)":::"memory"); \
      _Pragma("unroll") for(int d_=0;d_<2;++d_) _Pragma("unroll") for(int r=0;r<16;++r)o[d_][r]*=wsf[crow(r,hi)]; } }while(0)
  f32x16 pA0,pA1,pB0,pB1;
  int sl_prev=0,sl_cur=0,sl_next=SLOTB;
  #define ROT() do{sl_prev=sl_cur;sl_cur=sl_next;sl_next=(sl_next==(NSLOT-1)*SLOTB)?0:sl_next+SLOTB;}while(0)
  DMA_K(2,2*SLOTB);
  WAIT_BAR(3);
  qkt(pA0,pA1,Kbase,qr,negm,r32,hi);asm volatile("s_nop 15\n\ts_nop 7":"+v"(pA0),"+v"(pA1));CMASK(pA0,pA1,0);
  START(pA0,pA1);
  _Pragma("unroll") for(int r=0;r<16;++r)pA1[r]=__builtin_amdgcn_exp2f(pA1[r]);
  WAIT_BAR(0);
  DMA_K(3,0);DMA_V(1,SLOTB);
  ROT();
  kload8(kf,kp0+sl_cur);
  WAIT_BAR(2);
  s16x4 vlo[8],vhi[8]; u32x4 pw0,pw1,pw2,pw3;
  #define PKW(P,B) cvtpk_s(P[B],P[B+1])
  #define PAF(k) __builtin_bit_cast(bf16x8,pw##k)
  #define VFR(i) (bf16x8){vlo[i][0],vlo[i][1],vlo[i][2],vlo[i][3],vhi[i][0],vhi[i][1],vhi[i][2],vhi[i][3]}
  #define PIN(x) asm volatile("":"+v"(x))
  #define MX3(a,b,c) __builtin_fmaxf(__builtin_fmaxf((a),(b)),(c))
  #define GAPA(MF,A0,A1,A2,A3,W0,W1,PW) do{ MF; sacc+=A0; sacc+=A1; sacc+=A2; sacc+=A3; PIN(sacc); W0; W1; PIN(PW); SBAR(); }while(0)
  #define EX(v) __builtin_amdgcn_exp2f(v)
  #define GAPB(MF,X,B) do{ MF; X[B]=EX(X[B]); X[B+1]=EX(X[B+1]); X[B+2]=EX(X[B+2]); X[B+3]=EX(X[B+3]); PIN(X); SBAR(); }while(0)
  #define VRD(i) do{ vlo[i]=vtr(vp_+(((i)>>2)*4096+((i)&3)*1024)); vhi[i]=vtr(vp_+(((i)>>2)*4096+((i)&3)*1024+512)); }while(0)
  #define KRD(G,j) do{ if(G){ kload2(kf,kp0+sl_next,j); SBAR(); } }while(0)
  #define STEP(C0,C1,P0,P1,t,GK,GV,GL) do{ SBAR(); \
    const lds_cptr vp_=vp0+sl_prev; \
    VRD(0); SBAR(); float sacc=(P0[0]+P0[1]); \
    GAPA(C0=__builtin_amdgcn_mfma_f32_32x32x16_bf16(kf[0],qr[0],negm,0,0,0), P0[2],P0[3],P0[4],P0[5],     pw0[0]=PKW(P0,0), pw0[1]=PKW(P0,2), pw0); \
    VRD(4); SBAR(); GAPA(C1=__builtin_amdgcn_mfma_f32_32x32x16_bf16(kf[1],qr[0],negm,0,0,0), P0[6],P0[7],P0[8],P0[9],     pw0[2]=PKW(P0,4), pw0[3]=PKW(P0,6), pw0); \
    VRD(1); SBAR(); GAPA(C0=__builtin_amdgcn_mfma_f32_32x32x16_bf16(kf[2],qr[1],C0,0,0,0),   P0[10],P0[11],P0[12],P0[13], pw1[0]=PKW(P0,8), pw1[1]=PKW(P0,10), pw1); \
    VRD(5); SBAR(); GAPA(C1=__builtin_amdgcn_mfma_f32_32x32x16_bf16(kf[3],qr[1],C1,0,0,0),   P0[14],P0[15],P1[0],P1[1],   pw1[2]=PKW(P0,12),pw1[3]=PKW(P0,14), pw1); \
    VRD(2); SBAR(); GAPA(C0=__builtin_amdgcn_mfma_f32_32x32x16_bf16(kf[4],qr[2],C0,0,0,0),   P1[2],P1[3],P1[4],P1[5],     pw2[0]=PKW(P1,0), pw2[1]=PKW(P1,2), pw2); \
    VRD(6); SBAR(); GAPA(C1=__builtin_amdgcn_mfma_f32_32x32x16_bf16(kf[5],qr[2],C1,0,0,0),   P1[6],P1[7],P1[8],P1[9],     pw2[2]=PKW(P1,4), pw2[3]=PKW(P1,6), pw2); \
    VRD(3); SBAR(); GAPA(C0=__builtin_amdgcn_mfma_f32_32x32x16_bf16(kf[6],qr[3],C0,0,0,0),   P1[10],P1[11],P1[12],P1[13], pw3[0]=PKW(P1,8), pw3[1]=PKW(P1,10), pw3); \
    VRD(7); SBAR(); GAPA(C1=__builtin_amdgcn_mfma_f32_32x32x16_bf16(kf[7],qr[3],C1,0,0,0),   P1[14],P1[15],0.f,0.f,       pw3[2]=PKW(P1,12),pw3[3]=PKW(P1,14), pw3); \
    l_reg+=sacc; \
    if(GK){DMA_K((t)+3,sl_cur);} if(GV){DMA_V((t)+1,sl_next);} \
    CMASK(C0,C1,t); \
    { float a=MX3(C0[0],C0[1],C1[0]),b=MX3(C0[2],C0[3],C1[1]); a=MX3(a,C1[2],C1[3]); \
      _Pragma("unroll") for(int r=4;r<16;r+=4){a=MX3(a,C0[r],C0[r+1]);b=MX3(b,C0[r+2],C0[r+3]);a=MX3(a,C1[r],C1[r+1]);b=MX3(b,C1[r+2],C1[r+3]);} \
      float rm=__builtin_fmaxf(a,b); { auto rr=__builtin_amdgcn_permlane32_swap(__float_as_uint(rm),__float_as_uint(rm),false,false); rm=__builtin_fmaxf(__uint_as_float(rr[0]),__uint_as_float(rr[1])); } \
      resc=false; \
      if(__builtin_expect(__any(rm>(float)THRL),0)){ const float dl=__builtin_fmaxf(rm,0.f); mhat+=dl; \
        _Pragma("unroll") for(int r=0;r<16;++r){C0[r]-=dl;C1[r]-=dl;} \
        _Pragma("unroll") for(int r=0;r<16;++r)negm[r]=-mhat; asm volatile("":"+v"(negm)); \
        const float f=__builtin_amdgcn_exp2f(-dl); l_reg*=f; if(hi==0)wsf[r32]=f; resc=true; } } \
    SBAR(); \
    GAPB(o[0]=__builtin_amdgcn_mfma_f32_32x32x16_bf16(PAF(0),VFR(0),o[0],0,0,0), C0,0); \
    GAPB(o[1]=__builtin_amdgcn_mfma_f32_32x32x16_bf16(PAF(0),VFR(4),o[1],0,0,0), C0,4); \
    KRD(GL,0); GAPB(o[0]=__builtin_amdgcn_mfma_f32_32x32x16_bf16(PAF(1),VFR(1),o[0],0,0,0), C0,8); \
    KRD(GL,1); GAPB(o[1]=__builtin_amdgcn_mfma_f32_32x32x16_bf16(PAF(1),VFR(5),o[1],0,0,0), C0,12); \
    KRD(GL,2); GAPB(o[0]=__builtin_amdgcn_mfma_f32_32x32x16_bf16(PAF(2),VFR(2),o[0],0,0,0), C1,0); \
    KRD(GL,3); GAPB(o[1]=__builtin_amdgcn_mfma_f32_32x32x16_bf16(PAF(2),VFR(6),o[1],0,0,0), C1,4); \
    GAPB(o[0]=__builtin_amdgcn_mfma_f32_32x32x16_bf16(PAF(3),VFR(3),o[0],0,0,0), C1,8); \
    GAPB(o[1]=__builtin_amdgcn_mfma_f32_32x32x16_bf16(PAF(3),VFR(7),o[1],0,0,0), C1,12); \
    }while(0)
  int t=1;
  for(;t+5<NT;t+=2){
    STEP(pB0,pB1,pA0,pA1,t,true,true,true);     WAIT_BAR(2); RESC(); ROT();
    STEP(pA0,pA1,pB0,pB1,t+1,true,true,true);   WAIT_BAR(2); RESC(); ROT();
  }
  #define ENDW(tt) do{ if((tt)+3<NT){WAIT_BAR(2);} else if((tt)+2<NT){WAIT_BAR(1);} else {WAIT_BAR(0);} }while(0)
  for(;t+1<NT;t+=2){
    STEP(pB0,pB1,pA0,pA1,t,(t+3<NT),(t+1<NT),(t+1<NT));       ENDW(t);   RESC(); ROT();
    STEP(pA0,pA1,pB0,pB1,t+1,(t+4<NT),(t+2<NT),(t+2<NT));     ENDW(t+1); RESC(); ROT();
  }
  STEP(pB0,pB1,pA0,pA1,NT-1,false,false,false); RESC();
  { float sacc=pB0[0]+pB0[1]; _Pragma("unroll") for(int r=2;r<16;++r)sacc+=pB0[r]; _Pragma("unroll") for(int r=0;r<16;++r)sacc+=pB1[r]; l_reg+=sacc;
    pw0=(u32x4){PKW(pB0,0),PKW(pB0,2),PKW(pB0,4),PKW(pB0,6)};pw1=(u32x4){PKW(pB0,8),PKW(pB0,10),PKW(pB0,12),PKW(pB0,14)};pw2=(u32x4){PKW(pB1,0),PKW(pB1,2),PKW(pB1,4),PKW(pB1,6)};pw3=(u32x4){PKW(pB1,8),PKW(pB1,10),PKW(pB1,12),PKW(pB1,14)};
    SBAR(); pv(o,vb0+sl_cur,PAF(0),PAF(1),PAF(2),PAF(3)); }
  #undef PKW
  #undef PAF
  #undef VFR
  #undef PIN
  #undef MX3
  #undef GAPA
  #undef GAPB
  #undef EX
  #undef VRD
  #undef KRD
  #undef STEP
  #undef ENDW
  {auto rr=__builtin_amdgcn_permlane32_swap(__float_as_uint(l_reg),__float_as_uint(l_reg),false,false);l_reg=__uint_as_float(rr[0])+__uint_as_float(rr[1]);}
  if(hi==0)wsf[32+r32]=l_reg;asm volatile("s_waitcnt lgkmcnt(0)":::"memory");
  float rli[16];
  #pragma unroll
  for(int r=0;r<16;++r)rli[r]=__builtin_amdgcn_rcpf(wsf[32+crow(r,hi)]);
  bf16*Ow=Ow0+(long)(wid*QBLK)*OP;
  { bf16*stg=(bf16*)(shm+LDS_OST)+wid*2048;
    #pragma unroll
    for(int r=0;r<16;++r){const int orow=crow(r,hi);
      #pragma unroll
      for(int d0=0;d0<2;++d0)stg[orow*64+d0*32+r32]=__float2bfloat16(o[d0][r]*rli[r]);}
    asm volatile("s_waitcnt lgkmcnt(0)":::"memory");
    #pragma unroll
    for(int i=0;i<4;++i){const int row=i*8+(lane>>3),ch=lane&7; const u32x4 v=*(const u32x4*)(stg+row*64+ch*8); ATTN_STORE16(Ow+(long)row*OP+ch*8,v);} }
  asm volatile("s_waitcnt lgkmcnt(0)\n\ts_barrier":::"memory");
  #undef DMA_K
  #undef TROW
  #undef DMA_V
  #undef CMASK
  #undef START
  #undef RESC
  #undef ROT
}
constexpr int ATTN_LDS_BYTES=LDS_BYTES;
#undef SBAR
#undef WAIT_BAR
}
typedef float f32x2 __attribute__((ext_vector_type(2)));
__device__ __forceinline__ int scan_tok(int p, int dir) { return p < CTXL ? (dir ? CTXL - 1 - p : p) : (dir ? (T + CTXL - 1) - p : p); }

constexpr int CS_NCH = T / 16;
constexpr size_t WS_W1F = WS_H;
typedef float f32x16 __attribute__((ext_vector_type(16)));
typedef __bf16 bf16x2_t __attribute__((ext_vector_type(2)));
__device__ __forceinline__ unsigned cvtpk(float lo, float hi) { f32x2 v = {lo, hi}; bf16x2_t b = __builtin_convertvector(v, bf16x2_t); return __builtin_bit_cast(unsigned, b); }
__device__ __forceinline__ bf16x8 pack8f(float a0, float a1, float a2, float a3, float a4, float a5, float a6, float a7) {
    u32x4 w; w.x = cvtpk(a0, a1); w.y = cvtpk(a2, a3); w.z = cvtpk(a4, a5); w.w = cvtpk(a6, a7); return __builtin_bit_cast(bf16x8, w);
}
#define MF4(a, b, c) __builtin_amdgcn_mfma_f32_16x16x4f32((a), (b), (c), 0, 0, 0)

constexpr int PB_BK = 0, PB_AR = 4608, PB_CM = 9216, PB_EM = PB_CM + 16 * 17 * 4, PB_TM = PB_EM + 16 * 20 * 4, PB_P15 = PB_TM + 16 * 20 * 4, PB_BYTES = PB_P15 + 256;
constexpr int PBS = 72;
static_assert(8 * PB_BYTES <= RING_BYTES, "pre-pass LDS");
struct PPIn { float rr[16], kb[16], ww[16], as[16]; };
__device__ __forceinline__ void prepass_load(Frame& F, PPIn& I, int rec, int lane) {
    const int ch = rec / CS_NCH, c = rec % CS_NCH, b = ch >> 3, h = (ch >> 1) & 3, dir = ch & 1;
    const float* R32 = WSP(float, WS_R32); const float* DEC = WSP(float, WS_DEC) + (size_t)dir * M * 256; const float* ASIG = WSP(float, WS_ASIG) + (size_t)dir * M * 256;
    const int t0 = scan_tok(c * 16, dir); const int stp = dir ? -1 : 1;
#pragma unroll
    for (int t = 0; t < 16; ++t) { const size_t m = (size_t)b * T + (t0 + stp * t);
        I.rr[t] = R32[m * 768 + h * 64 + lane]; I.kb[t] = R32[m * 768 + 256 + h * 64 + lane]; I.ww[t] = DEC[m * 256 + h * 64 + lane]; I.as[t] = ASIG[m * 256 + h * 64 + lane]; }
}
__device__ __forceinline__ float bfu(unsigned short v) { return __builtin_bit_cast(float, (unsigned)v << 16); }
__device__ __forceinline__ void prepass_record(Frame& F, int l, int rec, LAS unsigned char* L, int lane, const PPIn& I) {
    const int ch = rec / CS_NCH, h = (ch >> 1) & 3;
    const int c = lane & 31, hh = lane >> 5;
    bf16* W1F = WSP(bf16, WS_W1F) + (size_t)rec * 2048; bf16* W2F = (bf16*)F.out + (size_t)rec * 3200; float* P15F = F.out + (size_t)rec * 1600 + 1536;
    LAS bf16* BK = (LAS bf16*)(L + PB_BK); LAS bf16* AR = (LAS bf16*)(L + PB_AR);
    LAS float* Cm = (LAS float*)(L + PB_CM); LAS float* Em = (LAS float*)(L + PB_EM); LAS float* Tm = (LAS float*)(L + PB_TM); LAS float* P15 = (LAS float*)(L + PB_P15);
    {
        const float kkw = F.in[I_KK][l * 256 + h * 64 + lane], kaw = F.in[I_KA][l * 256 + h * 64 + lane];
        float P = 1.f;
#pragma unroll
        for (int t = 0; t < 16; ++t) {
            const float r_ = I.rr[t], kb_ = I.kb[t], w_ = I.ww[t], as_ = I.as[t];
            float kk_ = kb_ * kkw; kk_ = kk_ * __builtin_amdgcn_rsqf(fmaxf(wave_sum(kk_ * kk_), 1e-24f));
            const float kd_ = kb_ * (1.f + (as_ - 1.f) * kaw);
            const float Pm = P; P *= w_; const float iP = __builtin_amdgcn_rcpf(P);
            AR[t * PBS + lane] = (bf16)f2bf(-kk_ * Pm); AR[(16 + t) * PBS + lane] = (bf16)f2bf(r_ * P);
            BK[t * PBS + lane] = (bf16)f2bf(kk_ * as_ * iP); BK[(16 + t) * PBS + lane] = (bf16)f2bf(kd_ * iP);
        }
        P15[lane] = P;
    }
    LDS_WAIT(); asm volatile("" ::: "memory");
#pragma unroll
    for (int ks = 0; ks < 4; ++ks) {
        const LAS bf16* src = AR + c * PBS + 16 * ks + 4 * hh;
        const u32x2 lo = *(const LAS u32x2*)src, hi = *(const LAS u32x2*)(src + 8);
        *(u32x4*)(W1F + (ks * 64 + lane) * 8) = (u32x4){lo.x, lo.y, hi.x, hi.y};
    }
    f32x16 Gm;
#pragma unroll
    for (int r = 0; r < 16; ++r) Gm[r] = 0.f;
#pragma unroll
    for (int ks = 0; ks < 4; ++ks)
        Gm = __builtin_amdgcn_mfma_f32_32x32x16_bf16(*(const LAS bf16x8*)(BK + c * PBS + 16 * ks + 8 * hh), *(const LAS bf16x8*)(AR + c * PBS + 16 * ks + 8 * hh), Gm, 0, 0, 0);
    {
        const int t = c & 15;
#pragma unroll
        for (int r = 0; r < 16; ++r) { const int s = (r & 3) + 8 * ((r & 7) >> 2) + 4 * hh; const bool keep = (c < 16) ? (s < t) : (s <= t); if (!keep) Gm[r] = 0.f; }
        if (c < 16) {
#pragma unroll
            for (int r = 0; r < 8; ++r) { const int s = (r & 3) + 8 * (r >> 2) + 4 * hh; Cm[s * 17 + t] = Gm[r]; Em[s * 20 + t] = Gm[8 + r]; }
        }
    }
    LDS_WAIT(); asm volatile("" ::: "memory");
    {
        const int rho = lane & 15;
        float x[16];
#pragma unroll
        for (int t = 0; t < 16; ++t) { float acc = (rho == t) ? 1.f : 0.f;
#pragma unroll
            for (int s = 0; s < t; ++s) acc += x[s] * Cm[s * 17 + t];
            x[t] = acc; }
        if (lane < 16) {
#pragma unroll
            for (int q = 0; q < 4; ++q) *(LAS f32x4*)(Tm + rho * 20 + 4 * q) = (f32x4){x[4 * q], x[4 * q + 1], x[4 * q + 2], x[4 * q + 3]}; }
    }
    LDS_WAIT(); asm volatile("" ::: "memory");
    bf16x8 A2;
    {
        float ta[8];
#pragma unroll
        for (int jj = 0; jj < 8; ++jj) ta[jj] = (c < 16) ? Tm[((jj & 3) + 8 * (jj >> 2) + 4 * hh) * 20 + c] : 0.f;
        const bf16x8 Aet = pack8f(ta[0], ta[1], ta[2], ta[3], ta[4], ta[5], ta[6], ta[7]);
        f32x4 e0 = (f32x4){0.f, 0.f, 0.f, 0.f}, e1 = e0, t0 = e0, t1 = e0;
        if (c >= 16) { e0 = *(const LAS f32x4*)(Em + (c - 16) * 20 + 4 * hh); e1 = *(const LAS f32x4*)(Em + (c - 16) * 20 + 8 + 4 * hh); }
        else { t0 = *(const LAS f32x4*)(Tm + c * 20 + 4 * hh); t1 = *(const LAS f32x4*)(Tm + c * 20 + 8 + 4 * hh); }
        const bf16x8 Bet = pack8f(e0[0], e0[1], e0[2], e0[3], e1[0], e1[1], e1[2], e1[3]);
        f32x16 Z;
#pragma unroll
        for (int r = 0; r < 16; ++r) Z[r] = 0.f;
        const f32x16 Dt = __builtin_amdgcn_mfma_f32_32x32x16_bf16(Aet, Bet, Z, 0, 0, 0);
        A2 = (c >= 16) ? pack8f(Dt[0], Dt[1], Dt[2], Dt[3], Dt[4], Dt[5], Dt[6], Dt[7]) : pack8f(t0[0], t0[1], t0[2], t0[3], t1[0], t1[1], t1[2], t1[3]);
    }
    {
        const bf16x8 Bm = pack8f(Gm[0], Gm[1], Gm[2], Gm[3], Gm[4], Gm[5], Gm[6], Gm[7]);
        const bf16x8 Bz = pack8f(0.f, 0.f, 0.f, 0.f, 0.f, 0.f, 0.f, 0.f);
        f32x16 Ci;
#pragma unroll
        for (int r = 0; r < 16; ++r) Ci[r] = (r >= 8 && c >= 16) ? Gm[r] : 0.f;
        const f32x16 Dm = __builtin_amdgcn_mfma_f32_32x32x16_bf16(A2, (c >= 16) ? Bm : Bz, Ci, 0, 0, 0);
        *(bf16x8*)(W2F + (0 * 64 + lane) * 8) = pack8f(Dm[0], Dm[1], Dm[2], Dm[3], Dm[4], Dm[5], Dm[6], Dm[7]);
        *(bf16x8*)(W2F + (1 * 64 + lane) * 8) = pack8f(Dm[8], Dm[9], Dm[10], Dm[11], Dm[12], Dm[13], Dm[14], Dm[15]);
    }
#pragma unroll
    for (int nt = 0; nt < 2; ++nt) {
        float bb[8]; f32x16 Ci;
#pragma unroll
        for (int jj = 0; jj < 8; ++jj) { const int kap = (jj & 3) + 8 * (jj >> 2) + 4 * hh;
            bb[jj] = bfu(BK[kap * PBS + 32 * nt + c]); Ci[jj] = 0.f; Ci[8 + jj] = bfu(BK[(16 + kap) * PBS + 32 * nt + c]); }
        const f32x16 Dn = __builtin_amdgcn_mfma_f32_32x32x16_bf16(A2, pack8f(bb[0], bb[1], bb[2], bb[3], bb[4], bb[5], bb[6], bb[7]), Ci, 0, 0, 0);
        const float p = P15[32 * nt + c];
        *(bf16x8*)(W2F + ((2 + 2 * nt) * 64 + lane) * 8) = pack8f(Dn[0] * p, Dn[1] * p, Dn[2] * p, Dn[3] * p, Dn[4] * p, Dn[5] * p, Dn[6] * p, Dn[7] * p);
        *(bf16x8*)(W2F + ((3 + 2 * nt) * 64 + lane) * 8) = pack8f(Dn[8] * p, Dn[9] * p, Dn[10] * p, Dn[11] * p, Dn[12] * p, Dn[13] * p, Dn[14] * p, Dn[15] * p);
    }
    { const int blk = c >> 4, reg = c & 15; P15F[lane] = P15[32 * blk + (reg & 3) + 8 * (reg >> 2) + 4 * hh]; }
    LDS_WAIT(); asm volatile("" ::: "memory");
}
__device__ __forceinline__ void phase_prepass(Frame& F, int l) {
    int lane = LANE_; asm volatile("" : "+v"(lane));
    LAS unsigned char* L = F.lds + F.wave * PB_BYTES;
    int rec = F.vcu * NWAVES + F.wave; const int stride = F.G * NWAVES;
    PPIn I; if (rec < 64 * CS_NCH) prepass_load(F, I, rec, lane);
    for (; rec < 64 * CS_NCH; rec += stride) {
        PPIn Nx = I; if (rec + stride < 64 * CS_NCH) prepass_load(F, Nx, rec + stride, lane);
        prepass_record(F, l, rec, L, lane, I);
        I = Nx;
    }
}

constexpr int CS_REC = 4096 + 6144 + 256 + 4096, CS_SLOTS = 8, CS_LEAD = 6;
__device__ __forceinline__ void scan_chunked(Frame& F, int ch, int l) {
    int lane = LANE_; asm volatile("" : "+v"(lane));
    const int wave = F.wave, b = ch >> 3, h = (ch >> 1) & 3, dir = ch & 1, hh = lane >> 5, icol = 32 * (wave & 1) + (lane & 31);
    float* YD = WSP(float, WS_YD) + (size_t)dir * M * 256;
    const float* R32 = WSP(float, WS_R32);
    LAS unsigned char* ring = F.lds;
    u32x4 st[15];
    const int hw = wave - 2;
#define CS_SRC(cc, q) ({ const int rec_ = ch * CS_NCH + (cc); const u32x4* r_; \
        if ((q) < 4) r_ = (const u32x4*)(WSP(bf16, WS_W1F) + (size_t)rec_ * 2048) + lane + (q) * 64; \
        else if ((q) < 10) r_ = (const u32x4*)((const unsigned char*)F.out + (size_t)rec_ * 6400) + lane + ((q) - 4) * 64; \
        else { const int p = (q) * 64 + lane; const int pv = min(max(p - 656, 0), 255); \
            const u32x4* sv_ = (const u32x4*)(R32 + ((size_t)b * T + scan_tok((cc) * 16 + (pv >> 4), dir)) * 768 + 512 + h * 64) + (pv & 15); \
            r_ = ((q) == 10 && lane < 16) ? (const u32x4*)((const unsigned char*)F.out + (size_t)rec_ * 6400) + lane + 384 : sv_; } \
        r_; })
#define CS_ISSUE1(cc, q) do { st[q] = *CS_SRC(cc, q); } while (0)
#define CS_WRITE1(cc, q) do { const int p = (q) * 64 + lane; if ((q) < 14 || p < 912) ((LAS u32x4*)(ring + ((cc) % CS_SLOTS) * CS_REC))[p] = st[q]; } while (0)
#define CS_ISSUE(cc) do { _Pragma("unroll") for (int q = 0; q < 15; ++q) CS_ISSUE1(cc, q); } while (0)
#define CS_WRITE(cc) do { _Pragma("unroll") for (int q = 0; q < 15; ++q) CS_WRITE1(cc, q); } while (0)
#define CS_STEP(wc, q) do { CS_WRITE1(wc, q); if ((wc) + 6 < CS_NCH) CS_ISSUE1((wc) + 6, q); } while (0)
#define CS_BAR() do { asm volatile("s_waitcnt lgkmcnt(0)" ::: "memory"); __builtin_amdgcn_s_barrier(); asm volatile("" ::: "memory"); } while (0)
    if (wave >= 2) {
        CS_ISSUE(hw); CS_WRITE(hw); if (hw + CS_LEAD < CS_NCH) CS_ISSUE(hw + CS_LEAD);
        CS_BAR();
        int c = 0;
        for (; c < hw; ++c) CS_BAR();
        for (; c + 6 <= CS_NCH; c += 6) {
            const int wc = c + 6;
            if (wc < CS_NCH) {
                CS_STEP(wc, 0); CS_STEP(wc, 1); CS_STEP(wc, 2); CS_BAR();
                CS_STEP(wc, 3); CS_STEP(wc, 4); CS_STEP(wc, 5); CS_BAR();
                CS_STEP(wc, 6); CS_STEP(wc, 7); CS_STEP(wc, 8); CS_BAR();
                CS_STEP(wc, 9); CS_STEP(wc, 10); CS_BAR();
                CS_STEP(wc, 11); CS_STEP(wc, 12); CS_BAR();
                CS_STEP(wc, 13); CS_STEP(wc, 14); CS_BAR();
            } else { CS_BAR(); CS_BAR(); CS_BAR(); CS_BAR(); CS_BAR(); CS_BAR(); }
        }
        for (; c < CS_NCH; ++c) CS_BAR();
    } else {
        f32x16 X0, X1;
#pragma unroll
        for (int r = 0; r < 16; ++r) { X0[r] = 0.f; X1[r] = 0.f; }
        CS_BAR();
        for (int c = 0; c < CS_NCH; ++c) {
            const LAS unsigned char* rec = ring + (c % CS_SLOTS) * CS_REC;
            const LAS bf16x8* w1 = (const LAS bf16x8*)rec + lane; const LAS bf16x8* w2 = (const LAS bf16x8*)(rec + 4096) + lane;
            const LAS f32x4* p15 = (const LAS f32x4*)(rec + 10240 + hh * 128); const LAS float* vr = (const LAS float*)(rec + 10496) + icol;
            f32x16 G;
#pragma unroll
            for (int r = 0; r < 16; ++r) G[r] = 0.f;
            G = __builtin_amdgcn_mfma_f32_32x32x16_bf16(w1[0], pack8f(X0[0], X0[1], X0[2], X0[3], X0[4], X0[5], X0[6], X0[7]), G, 0, 0, 0);
            G = __builtin_amdgcn_mfma_f32_32x32x16_bf16(w1[64], pack8f(X0[8], X0[9], X0[10], X0[11], X0[12], X0[13], X0[14], X0[15]), G, 0, 0, 0);
            G = __builtin_amdgcn_mfma_f32_32x32x16_bf16(w1[128], pack8f(X1[0], X1[1], X1[2], X1[3], X1[4], X1[5], X1[6], X1[7]), G, 0, 0, 0);
            G = __builtin_amdgcn_mfma_f32_32x32x16_bf16(w1[192], pack8f(X1[8], X1[9], X1[10], X1[11], X1[12], X1[13], X1[14], X1[15]), G, 0, 0, 0);
            const bf16x8 g1 = pack8f(G[0], G[1], G[2], G[3], G[4], G[5], G[6], G[7]);
            float vv[8];
#pragma unroll
            for (int jj = 0; jj < 8; ++jj) vv[jj] = vr[(8 * (jj >> 2) + 4 * hh + (jj & 3)) * 64];
            const bf16x8 vf = pack8f(vv[0], vv[1], vv[2], vv[3], vv[4], vv[5], vv[6], vv[7]);
            f32x16 Y = __builtin_amdgcn_mfma_f32_32x32x16_bf16(w2[0], g1, G, 0, 0, 0);
            Y = __builtin_amdgcn_mfma_f32_32x32x16_bf16(w2[64], vf, Y, 0, 0, 0);
#pragma unroll
            for (int k = 0; k < 4; ++k) { const f32x4 pa = p15[k], pb = p15[4 + k];
#pragma unroll
                for (int e = 0; e < 4; ++e) { X0[4 * k + e] *= pa[e]; X1[4 * k + e] *= pb[e]; } }
            X0 = __builtin_amdgcn_mfma_f32_32x32x16_bf16(w2[128], g1, X0, 0, 0, 0);
            X0 = __builtin_amdgcn_mfma_f32_32x32x16_bf16(w2[192], vf, X0, 0, 0, 0);
            X1 = __builtin_amdgcn_mfma_f32_32x32x16_bf16(w2[256], g1, X1, 0, 0, 0);
            X1 = __builtin_amdgcn_mfma_f32_32x32x16_bf16(w2[320], vf, X1, 0, 0, 0);
#pragma unroll
            for (int r = 8; r < 16; ++r) { const int t = (r & 3) + 4 * hh + 8 * ((r >> 2) - 2);
                YD[((size_t)b * T + scan_tok(c * 16 + t, dir)) * 256 + h * 64 + icol] = Y[r]; }
            CS_BAR();
        }
    }
#undef CS_BAR
#undef CS_ISSUE
#undef CS_ISSUE1
#undef CS_WRITE1
#undef CS_STEP
#undef CS_SRC
#undef CS_WRITE
    __syncthreads();
}

constexpr int SC_TC = 16, SC_STEP = 6 * 64, SC_BUF = SC_TC * SC_STEP;
constexpr int SC_YOFF = 2 * SC_BUF, SC_DUMMY = SC_YOFF + 2 * SC_TC * 64;
struct ScanVec { f32x4 r0, r1, w0, w1, k0, k1, a0, a1, b0, b1; float vi; };
__device__ __forceinline__ void scan_ld(ScanVec& V, const LAS float* vec, int jc, int i) {
    V.r0 = *(const LAS f32x4*)(vec + 8 * jc); V.r1 = *(const LAS f32x4*)(vec + 8 * jc + 4);
    V.w0 = *(const LAS f32x4*)(vec + 64 + 8 * jc); V.w1 = *(const LAS f32x4*)(vec + 64 + 8 * jc + 4);
    V.k0 = *(const LAS f32x4*)(vec + 128 + 8 * jc); V.k1 = *(const LAS f32x4*)(vec + 128 + 8 * jc + 4);
    V.vi = vec[192 + i];
    V.a0 = *(const LAS f32x4*)(vec + 256 + 8 * jc); V.a1 = *(const LAS f32x4*)(vec + 256 + 8 * jc + 4);
    V.b0 = *(const LAS f32x4*)(vec + 320 + 8 * jc); V.b1 = *(const LAS f32x4*)(vec + 320 + 8 * jc + 4);
}
__device__ __forceinline__ float dot8(const f32x4 s0, const f32x4 s1, const f32x4 x0, const f32x4 x1) {
    const f32x4 p = s0 * x0 + s1 * x1;
    return (p[0] + p[1]) + (p[2] + p[3]);
}
__device__ __forceinline__ void scan_chain(Frame& F, int chain, int half, int l) {
    const int b = chain >> 3, h = (chain >> 1) & 3, dir = chain & 1;
    int tid_ = threadIdx.x; asm volatile("" : "+v"(tid_));
    const int tid = tid_, lane = tid & 63, wave = F.wave, jc = lane & 7, il = 8 * (wave & 3) + (lane >> 3), i = 32 * half + il;
    const bool comp = wave < 4; const int hw = wave & 3, ht = tid & 255;
    LAS float* buf = (LAS float*)F.lds;
    const float* R32 = WSP(float, WS_R32); const float* DEC = WSP(float, WS_DEC) + (size_t)dir * M * 256; const float* ASIG = WSP(float, WS_ASIG) + (size_t)dir * M * 256;
    float* YD = WSP(float, WS_YD) + (size_t)dir * M * 256;
    const float kkw = F.in[I_KK][l * 256 + h * 64 + lane], kaw = F.in[I_KA][l * 256 + h * 64 + lane];
    f32x4 S0 = (f32x4){0.f, 0.f, 0.f, 0.f}, S1 = S0;
    float pr[4][5];
    constexpr int NCH = T / SC_TC;
    const int ywr = (jc == 0) ? il : (SC_DUMMY - SC_YOFF) + ht;
#define SC_LOAD(c) do { _Pragma("unroll") for (int s4 = 0; s4 < 4; ++s4) { const int p = (c) * SC_TC + 4 * hw + s4; const size_t m = (size_t)b * T + scan_tok(p, dir); \
        pr[s4][0] = R32[m * 768 + h * 64 + lane]; pr[s4][1] = R32[m * 768 + 256 + h * 64 + lane]; pr[s4][2] = R32[m * 768 + 512 + h * 64 + lane]; \
        pr[s4][3] = DEC[m * 256 + h * 64 + lane]; pr[s4][4] = ASIG[m * 256 + h * 64 + lane]; } } while (0)
#define SC_PREP(bi) do { _Pragma("unroll") for (int s4 = 0; s4 < 4; ++s4) { const float r_ = pr[s4][0], kb_ = pr[s4][1], v_ = pr[s4][2], de_ = pr[s4][3], as_ = pr[s4][4]; \
        float kk_ = kb_ * kkw; kk_ = kk_ * __builtin_amdgcn_rsqf(fmaxf(wave_sum(kk_ * kk_), 1e-24f)); const float kd_ = kb_ * (1.f + (as_ - 1.f) * kaw); \
        LAS float* o_ = buf + (bi) * SC_BUF + (4 * hw + s4) * SC_STEP + lane; o_[0] = r_; o_[64] = de_; o_[128] = kd_; o_[192] = v_; o_[256] = -kk_; o_[320] = kk_ * as_; } } while (0)
#define SC_FLUSH(c) do { const int s_ = ht >> 4, i2_ = 2 * (ht & 15); \
        const f32x2 yv_ = *(const LAS f32x2*)(buf + SC_YOFF + ((c) & 1) * SC_TC * 32 + s_ * 32 + i2_); \
        *(f32x2*)(YD + ((size_t)b * T + scan_tok((c) * SC_TC + s_, dir)) * 256 + h * 64 + 32 * half + i2_) = yv_; } while (0)
    if (!comp) { SC_LOAD(0); SC_PREP(0); SC_LOAD(1); }
    for (int c = 0; c < NCH; ++c) {
        __syncthreads();
        if (!comp) {
            if (c > 0) SC_FLUSH(c - 1);
            if (c + 1 < NCH) SC_PREP((c + 1) & 1);
            if (c + 2 < NCH) SC_LOAD(c + 2);
        } else {
            const LAS float* bc = buf + (c & 1) * SC_BUF;
            LAS float* yst = buf + SC_YOFF + (c & 1) * SC_TC * 32 + ywr;
            ScanVec V; scan_ld(V, bc, jc, i);
#pragma unroll
            for (int s = 0; s < SC_TC; ++s) {
                ScanVec N = V;
                if (s + 1 < SC_TC) scan_ld(N, bc + (s + 1) * SC_STEP, jc, i);
                const float sa = red8(dot8(S0, S1, V.a0, V.a1));
                const f32x4 u0 = S0 * V.w0 + V.k0 * V.vi, u1 = S1 * V.w1 + V.k1 * V.vi;
                S0 = u0 + V.b0 * sa; S1 = u1 + V.b1 * sa;
                const float y = red8(dot8(S0, S1, V.r0, V.r1));
                yst[(jc == 0) ? s * 32 : 0] = y;
                V = N;
            }
        }
    }
    __syncthreads();
    if (!comp) SC_FLUSH(NCH - 1);
#undef SC_LOAD
#undef SC_PREP
#undef SC_FLUSH
    __syncthreads();
}

#if GOLD_ATTN
__device__ __forceinline__ void attn_ref_unit(Frame& F, int mode, int qrow0, int qcol, int krow0, int nkeys, int kcol, int vcol, int ocol,
                                              int rb, const float* rpbh) {
    const int tid = TID_, q = tid & 255, dh = tid >> 8;
    const bf16* QKV = WSP(bf16, WS_QKV); bf16* O = WSP(bf16, WS_O);
    const int gr = 4 * rb + (q >> 6), gc = q & 63;
    const size_t qrow = (size_t)qrow0 + q;
    float qv[64], o[32];
#pragma unroll
    for (int d8 = 0; d8 < 8; ++d8) { const u32x4 w = *(const u32x4*)(QKV + qrow * 1536 + qcol + 8 * d8);
        qv[8 * d8 + 0] = bflo(w.x); qv[8 * d8 + 1] = bfhi(w.x); qv[8 * d8 + 2] = bflo(w.y); qv[8 * d8 + 3] = bfhi(w.y);
        qv[8 * d8 + 4] = bflo(w.z); qv[8 * d8 + 5] = bfhi(w.z); qv[8 * d8 + 6] = bflo(w.w); qv[8 * d8 + 7] = bfhi(w.w); }
#pragma unroll
    for (int d = 0; d < 32; ++d) o[d] = 0.f;
    float mrun = -1e30f, lrun = 0.f;
    const int kend = mode == 0 ? nkeys : 128 + CTXL;
    const int rs = min(max(gr - 4, 0), 32 - 8), cs = min(max(gc - 8, 0), 64 - 16);
    for (int kk = 0; kk < kend; ++kk) {
        size_t krow; float bias = 0.f;
        if (mode == 0) krow = (size_t)krow0 + kk;
        else if (kk < 128) { const int kr = rs + (kk >> 4), kc = cs + (kk & 15); krow = (size_t)krow0 + CTXL + kr * 64 + kc; bias = rpbh[(kr - gr + 7) * 31 + (kc - gc + 15)] * LOG2E; }
        else krow = (size_t)krow0 + (kk - 128);
        float s = bias;
#pragma unroll
        for (int d8 = 0; d8 < 8; ++d8) { const u32x4 w = *(const u32x4*)(QKV + krow * 1536 + kcol + 8 * d8);
            s += qv[8 * d8 + 0] * bflo(w.x) + qv[8 * d8 + 1] * bfhi(w.x) + qv[8 * d8 + 2] * bflo(w.y) + qv[8 * d8 + 3] * bfhi(w.y)
               + qv[8 * d8 + 4] * bflo(w.z) + qv[8 * d8 + 5] * bfhi(w.z) + qv[8 * d8 + 6] * bflo(w.w) + qv[8 * d8 + 7] * bfhi(w.w); }
        const float mn = fmaxf(mrun, s), al = exp2f(mrun - mn), p = exp2f(s - mn);
        lrun = lrun * al + p; mrun = mn;
#pragma unroll
        for (int d8 = 0; d8 < 4; ++d8) { const u32x4 w = *(const u32x4*)(QKV + krow * 1536 + vcol + 32 * dh + 8 * d8);
            o[8 * d8 + 0] = o[8 * d8 + 0] * al + p * bflo(w.x); o[8 * d8 + 1] = o[8 * d8 + 1] * al + p * bfhi(w.x);
            o[8 * d8 + 2] = o[8 * d8 + 2] * al + p * bflo(w.y); o[8 * d8 + 3] = o[8 * d8 + 3] * al + p * bfhi(w.y);
            o[8 * d8 + 4] = o[8 * d8 + 4] * al + p * bflo(w.z); o[8 * d8 + 5] = o[8 * d8 + 5] * al + p * bfhi(w.z);
            o[8 * d8 + 6] = o[8 * d8 + 6] * al + p * bflo(w.w); o[8 * d8 + 7] = o[8 * d8 + 7] * al + p * bfhi(w.w); }
    }
    const float li = 1.f / lrun;
#pragma unroll
    for (int d8 = 0; d8 < 4; ++d8) { u32x4 w;
        w.x = pk2(o[8 * d8 + 0] * li, o[8 * d8 + 1] * li); w.y = pk2(o[8 * d8 + 2] * li, o[8 * d8 + 3] * li);
        w.z = pk2(o[8 * d8 + 4] * li, o[8 * d8 + 5] * li); w.w = pk2(o[8 * d8 + 6] * li, o[8 * d8 + 7] * li);
        *(u32x4*)(O + qrow * 1024 + ocol + 32 * dh + 8 * d8) = w; }
}
#endif
__device__ __forceinline__ void attn_item(Frame& F, int item, int l) {
    const float* rpb = F.in[I_RPB] + (size_t)l * 4 * 15 * 31;
    int mode = 0, qrow0, qcol, krow0, nkeys, kcol, vcol, ocol, rb = 0;
    if (item < 512) { const int b = item >> 6, h = (item >> 3) & 7, qb = item & 7;
        qrow0 = b * T + CTXL + qb * 256; qcol = h * 64; krow0 = b * T; nkeys = T; kcol = 512 + (h >> 2) * 64; vcol = 640 + (h >> 2) * 64; ocol = h * 64; }
    else if (item < 768) { const int it = item - 512, b = it >> 5, h = (it >> 3) & 3; rb = it & 7; mode = 1;
        qrow0 = b * T + CTXL + rb * 256; qcol = 768 + h * 64; krow0 = b * T; nkeys = 0; kcol = 1024 + h * 64; vcol = 1280 + h * 64; ocol = 768 + h * 64; rpb += h * 15 * 31; }
    else if (item < 832) { const int it = item - 768, b = it >> 3, h = it & 7;
        qrow0 = b * T; qcol = h * 64; krow0 = b * T; nkeys = CTXL; kcol = 512 + (h >> 2) * 64; vcol = 640 + (h >> 2) * 64; ocol = h * 64; }
    else { const int it = item - 832, b = it >> 2, h = it & 3;
        qrow0 = b * T; qcol = 768 + h * 64; krow0 = b * T; nkeys = CTXL; kcol = 1024 + h * 64; vcol = 1280 + h * 64; ocol = 768 + h * 64; }
#if GOLD_ATTN
    attn_ref_unit(F, mode, qrow0, qcol, krow0, nkeys, kcol, vcol, ocol, rb, rpb);
#else
    const attn_body::bf16* QKV = (const attn_body::bf16*)WSP(bf16, WS_QKV); attn_body::bf16* O = (attn_body::bf16*)WSP(bf16, WS_O);
    const attn_body::bf16* Qw0 = QKV + (size_t)qrow0 * 1536 + qcol; const attn_body::bf16* Kh = QKV + (size_t)krow0 * 1536 + kcol; const attn_body::bf16* Vh = QKV + (size_t)krow0 * 1536 + vcol;
    attn_body::bf16* Ow0 = O + (size_t)qrow0 * 1024 + ocol;
    if (mode == 0) attn_body::attn_unit<8, false>(Qw0, Kh, Vh, Ow0, nkeys >> 6, 0, 0, 0, rpb, (char*)F.lds);
    else { const int rs0 = min(max(4 * rb - 4, 0), 24); attn_body::attn_unit<8, true>(Qw0, Kh, Vh, Ow0, (rb == 0 || rb == 7) ? 12 : 16, rs0, rb, rs0, rpb, (char*)F.lds); }
#endif
}
template <int NI> __device__ __forceinline__ void post_items(Frame& F, int l, const int (&m)[NI], int h, int lane) {
    const float* R32 = WSP(float, WS_R32); const float* ASIG = WSP(float, WS_ASIG); const float* YD = WSP(float, WS_YD); const float* Gb = WSP(float, WS_G);
    bf16* O = WSP(bf16, WS_O);
    const int ch = h * 64 + lane;
    float y[NI], r[NI], kb[NI], v[NI], as0[NI], as1[NI], gg[NI];
#pragma unroll
    for (int k = 0; k < NI; ++k) { const size_t mm = (size_t)m[k];
        y[k] = YD[mm * 256 + ch] + YD[((size_t)M + mm) * 256 + ch];
        r[k] = R32[mm * 768 + ch]; kb[k] = R32[mm * 768 + 256 + ch]; v[k] = R32[mm * 768 + 512 + ch];
        as0[k] = ASIG[mm * 256 + ch]; as1[k] = ASIG[((size_t)M + mm) * 256 + ch]; gg[k] = Gb[mm * 256 + ch]; }
    const float lw = F.in[I_LNXW][l * 256 + ch], lb = F.in[I_LNXB][l * 256 + ch], ka = F.in[I_KA][l * 256 + ch], rk = F.in[I_RK][l * 256 + ch];
#pragma unroll
    for (int k = 0; k < NI; ++k) {
        const float mu = wave_sum(y[k]) * (1.f / 64.f); const float dv = y[k] - mu; const float var = wave_sum(dv * dv) * (1.f / 64.f);
        const float yn = dv * rsqrtf(var + 64e-5f) * lw + lb;
        const float kd0 = kb[k] * (1.f + (as0[k] - 1.f) * ka), kd1 = kb[k] * (1.f + (as1[k] - 1.f) * ka);
        const float bon = wave_sum(r[k] * (kd0 + kd1) * rk) * v[k];
        O[(size_t)m[k] * 1024 + 512 + ch] = (bf16)f2bf((yn + bon) * gg[k]);
    }
}
__device__ __forceinline__ void post_item(Frame& F, int l, int m, int h, int lane) { const int mm[1] = {m}; post_items<1>(F, l, mm, h, lane); }
__device__ __forceinline__ void phase_post(Frame& F, int l) {
    const int gw = F.vcu * NWAVES + F.wave, NGW = F.G * NWAVES, lane = LANE_;
    for (int it = gw; it < M * 4; it += NGW) { const int m = it >> 2, h = it & 3, t = m % T;
        if (l == NL - 1 && t < CTXL) continue;
        post_item(F, l, m, h, lane);
    }
}
constexpr int CW_PAIR = 32768;
__device__ __forceinline__ void post_pair(Frame& F, int l, int ch) {
    const int b = ch >> 3, h = (ch >> 1) & 3, dir = ch & 1;
    asm volatile("s_waitcnt vmcnt(0)" ::: "memory");
    __syncthreads();
    if (TID_ == 0) {
        unsigned* flag = F.ctl + CW_PAIR + 64 * (l * 32 + (ch >> 1));
        __builtin_amdgcn_fence(__ATOMIC_RELEASE, "agent");
        asm volatile("s_waitcnt vmcnt(0)" ::: "memory");
        (void)xb_add(flag, 1u);
        unsigned sp = 0; while (xb_ld(flag) < 2u) { __builtin_amdgcn_s_sleep(2); if (++sp > (1u << 24)) break; }
        __builtin_amdgcn_fence(__ATOMIC_ACQUIRE, "agent");
        asm volatile("s_waitcnt vmcnt(0)" ::: "memory");
    }
    __syncthreads();
    const int t0 = (l == NL - 1) ? CTXL : 0, nt = T - t0, half = nt >> 1, lane = LANE_;
    for (int t = t0 + dir * half + 8 * F.wave; t < t0 + (dir + 1) * half; t += 8 * NWAVES) { int mm[8];
#pragma unroll
        for (int k = 0; k < 8; ++k) mm[k] = b * T + t + k;
        post_items<8>(F, l, mm, h, lane); }
}

__device__ __forceinline__ void phase_mixer(Frame& F, int l, int rep = 0) {
#if CHUNK_SCAN
    if (F.vcu < 64) { scan_chunked(F, F.vcu, l); if (rep == 0) post_pair(F, l, F.vcu); }
#else
    if (F.vcu < 128) scan_chain(F, F.vcu >> 1, F.vcu & 1, l);
#endif
    if (rep == 2) return;
    const int nattn = (l == NL - 1) ? 768 : 864, nitems = nattn + CVT_NBLK;
    for (;;) {
        if (TID_ == 0) F.MISC[16] = atomicAdd(F.ctl + CW_QUEUE + 64 * (l + 2 * rep), 1u);
        __syncthreads();
        const int item = (int)F.MISC[16];
        __syncthreads();
        if (item >= nitems) break;
        if (item < nattn) attn_item(F, item, l);
        else { cvt_moe_block(F, l, item - nattn); __syncthreads(); }
    }
}

__device__ __forceinline__ unsigned wave_incl_scan(unsigned v, int lane) {
#pragma unroll
    for (int o = 1; o < 64; o <<= 1) { const unsigned u = __shfl_up(v, o); if (lane >= o) v += u; }
    return v;
}
__device__ __forceinline__ void phase_topk(Frame& F, int l) {
    const int tid = TID_, lane = LANE_, wave = F.wave;
    LAS unsigned* hist = (LAS unsigned*)F.lds;
    LAS unsigned* ctrl = hist + 256;
    LAS unsigned* wsum = hist + 272;
    LAS int* stok = (LAS int*)(hist + 288);
    const float* AFF = WSP(float, WS_AFF); int* INV = WSP(int, WS_INV); float* SELG = WSP(float, WS_SELG); int* SELT = WSP(int, WS_SELT);
    const bf16* H2 = WSP(bf16, WS_H2); bf16* XE = WSP(bf16, WS_XE);
    const int nitems = (l == NL - 1) ? 128 : 256;
    for (int it = F.vcu; it < nitems; it += F.G) {
        const int seg = it >> 7, be = it & 127, b = be >> 4, e = be & 15;
        const int n = seg ? CTXL : SEQ, cap = n / 8, mbase = b * T + (seg ? 0 : CTXL);
        const int rowbase = e * MEXP + (seg ? 2048 + b * 32 : b * 256);
        unsigned key[4];
#pragma unroll
        for (int k = 0; k < 4; ++k) { const int i = 4 * tid + k; key[k] = (i < n) ? __float_as_uint(AFF[(size_t)(mbase + i) * 16 + e]) : 0u; }
        if (tid == 0) { ctrl[0] = 0u; ctrl[1] = (unsigned)cap; }
        unsigned prefix = 0u, pmask = 0u;
#pragma unroll 1
        for (int pass = 0; pass < 4; ++pass) {
            const int shift = 24 - 8 * pass;
            if (tid < 256) hist[tid] = 0u;
            __syncthreads();
#pragma unroll
            for (int k = 0; k < 4; ++k) if ((key[k] & pmask) == prefix && key[k] != 0u) __hip_atomic_fetch_add(&hist[(key[k] >> shift) & 255u], 1u, __ATOMIC_RELAXED, __HIP_MEMORY_SCOPE_WORKGROUP);
            __syncthreads();
            if (wave == 0) {
                const unsigned need = ctrl[1];
                unsigned c4[4]; unsigned tot = 0u;
#pragma unroll
                for (int k = 0; k < 4; ++k) { c4[k] = hist[255 - (4 * lane + k)]; tot += c4[k]; }
                const unsigned incl = wave_incl_scan(tot, lane); unsigned run = incl - tot;
#pragma unroll
                for (int k = 0; k < 4; ++k) { if (run < need && run + c4[k] >= need) { ctrl[0] = prefix | ((unsigned)(255 - (4 * lane + k)) << shift); ctrl[1] = need - run; } run += c4[k]; }
            }
            __syncthreads();
            prefix = ctrl[0]; pmask |= 255u << shift;
        }
        const unsigned thr = prefix, need_eq = ctrl[1];
        unsigned ngt = 0u, neq = 0u;
#pragma unroll
        for (int k = 0; k < 4; ++k) { ngt += key[k] > thr; neq += key[k] == thr; }
        const unsigned packed = ngt | (neq << 16);
        const unsigned incl = wave_incl_scan(packed, lane);
        if (lane == 63) wsum[wave] = incl;
        __syncthreads();
        unsigned base = 0u, total = 0u;
#pragma unroll
        for (int w = 0; w < NWAVES; ++w) { const unsigned s = wsum[w]; if (w < wave) base += s; total += s; }
        const unsigned excl = base + incl - packed;
        unsigned pgt = excl & 0xffffu, peq = excl >> 16; const unsigned cnt_gt = total & 0xffffu;
#pragma unroll
        for (int k = 0; k < 4; ++k) {
            int slot = -1;
            if (key[k] > thr) slot = (int)pgt++;
            else if (key[k] == thr) { if (peq < need_eq) slot = (int)(cnt_gt + peq); ++peq; }
            if (slot >= 0) { const int m = mbase + 4 * tid + k; stok[slot] = m;
                SELG[rowbase + slot] = __uint_as_float(key[k]); SELT[rowbase + slot] = m; INV[(size_t)m * 16 + e] = rowbase + slot; }
        }
        __syncthreads();
        for (int s0 = wave * 4; s0 < cap; s0 += NWAVES * 4) {
            u32x4 v[4][2];
#pragma unroll
            for (int k = 0; k < 4; ++k) { const int m = stok[s0 + k];
                const u32x4* src = (const u32x4*)(H2 + (size_t)m * 1024); v[k][0] = src[lane]; v[k][1] = src[64 + lane]; }
#pragma unroll
            for (int k = 0; k < 4; ++k) { u32x4* dst = (u32x4*)(XE + (size_t)(rowbase + s0 + k) * 1024); dst[lane] = v[k][0]; dst[64 + lane] = v[k][1]; }
        }
        __syncthreads();
    }
}

constexpr int N_PHASES = 2 + 10 * NL;
#ifndef EN_MASK
#define EN_MASK 0xFFFFF
#endif
#define EN(k) ((EN_MASK >> (k)) & 1)
#ifndef REP_MASK
#define REP_MASK 0
#endif
#define REP(k) ((REP_MASK >> (k)) & 1)
#define RUNPH(k, body) do { if (EN(k)) { body; if (REP(k)) { GBAR(); body; } } } while (0)
__global__ void __launch_bounds__(NTHREADS, 2) fwd_kernel(Args args) {
    extern __shared__ __attribute__((aligned(16))) unsigned char lds_raw[];
    cg::grid_group grid = cg::this_grid();
    Frame F;
    F.lds = (LAS unsigned char*)lds_raw;
    F.MISC = (volatile LAS unsigned*)(F.lds + MISC_OFF);
    F.wave = __builtin_amdgcn_readfirstlane(TID_ >> 6);
    F.G = gridDim.x; { const int bx = blockIdx.x; F.vcu = (F.G % 8 == 0) ? (bx % 8) * (F.G / 8) + bx / 8 : bx; }
    F.in = args.in; F.out = args.out; F.ws = args.ws; F.ctl = (unsigned*)(args.ws + WS_CTL);
    { int u0 = TID_; asm volatile("" : "+v"(u0)); for (int u = u0; u < (LDS_BYTES - RING_BYTES) / 4; u += NTHREADS) ((LAS unsigned*)(F.lds + RING_BYTES))[u] = 0u; }
    __syncthreads();
    const int lo = args.ph_lo, hi = args.ph_hi;
    XcdBarrier bar; bar.bar = F.ctl + CW_BAR; bar.x = 0; bar.st = nullptr;
    if (hi - lo > 1) bar = xcd_barrier_post(F.ctl + CW_BAR, F.MISC + 8);
    LAS unsigned char* ring = F.lds;

#define IN(k) (lo <= (k) && (k) < hi)
#define GBAR() xcd_barrier3(bar)
#define SEAM(k) do { if (IN(k) && IN((k) + 1)) { GBAR(); } } while (0)
    if (hi < 0) grid.sync();
    if (IN(0)) { RUNPH(10, phase_init(F)); }
    SEAM(0);
    if (IN(1)) { RUNPH(11, phase_row0(F)); }
    if (REP(16)) { for (int k_ = 0; k_ < 20; ++k_) xcd_barrier(bar); }
    if (REP(17)) { for (int k_ = 0; k_ < 20; ++k_) xcd_barrier3(bar); }
    if (REP(18)) { for (int k_ = 0; k_ < 20; ++k_) xcd_barrier2_probe<3>(bar); }
    if (REP(19)) { for (int k_ = 0; k_ < 20; ++k_) xcd_barrier2_probe<4>(bar); }
    SEAM(1);
#define LAYER(l) do { constexpr int base = 2 + 10 * (l); constexpr bool last = ((l) == NL - 1); \
    if (IN(base + 0)) { if (EN(0)) { \
        pg8::Gemm g{WSP(bf16, WS_H), WSP(bf16, WS_WIN) + (size_t)(l) * NINP * 1024, M, NINP, D}; \
        EpiInproj E{WSP(bf16, WS_QKV), WSP(float, WS_R32), WSP(bf16, WS_Z)}; \
        if (last) { InprojLastSched S{F.G, F.vcu}; run_gemm<EpiInproj, InprojLastSched>(ring, g, S, E); } else { TileSched S{M / 256, NINP / 256, F.G, F.vcu, false}; run_gemm<EpiInproj, TileSched>(ring, g, S, E); } } } \
    SEAM(base + 0); \
    if (IN(base + 1)) { if (EN(1)) { \
        pg8::Gemm g{WSP(bf16, WS_Z), WSP(bf16, WS_LORA) + (size_t)(l) * 1280 * 384, M, 1280, 384}; \
        TileSched S{M / 256, 5, F.G, F.vcu, false}; \
        EpiLora E{WSP(float, WS_DEC), WSP(float, WS_ASIG), WSP(float, WS_G), F.in[I_W0] + (l) * 512, F.in[I_A0] + (l) * 512}; \
        for (int rep_ = 0; rep_ < (REP(1) ? 2 : 1); ++rep_) { if (rep_) GBAR(); run_gemm<EpiLora, TileSched>(ring, g, S, E); } } \
        if (EN(12)) { phase_qkprep(F, (l)); if (REP(12)) { GBAR(); phase_qkprep(F, (l), true); } } } \
    SEAM(base + 1); \
    if (IN(base + 2)) { if (EN(2)) { if (CHUNK_SCAN) { phase_prepass(F, (l)); GBAR(); if (REP(14)) { phase_prepass(F, (l)); GBAR(); } } phase_mixer(F, (l)); if (REP(2)) { GBAR(); phase_mixer(F, (l), 1); } if (REP(15)) { GBAR(); phase_mixer(F, (l), 2); } } } \
    SEAM(base + 2); \
    if (!CHUNK_SCAN) { if (IN(base + 3)) { RUNPH(3, phase_post(F, (l))); } SEAM(base + 3); } \
    if (IN(base + 4)) { if (EN(4)) { \
        pg8::Gemm g{WSP(bf16, WS_O), WSP(bf16, WS_WOUT) + (size_t)(l) * 1024 * 1024, M, D, D}; \
        TileSched S{last ? 64 : 72, 4, F.G, F.vcu, last}; \
        EpiOut E{WSP(float, WS_Y)}; \
        for (int rep_ = 0; rep_ < (REP(4) ? 2 : 1); ++rep_) { if (rep_) GBAR(); run_gemm<EpiOut, TileSched>(ring, g, S, E); } } } \
    SEAM(base + 4); \
    if (IN(base + 5)) { if (EN(5)) { phase_row1(F, (l)); if (REP(5)) { GBAR(); phase_row1(F, (l), true); } } } \
    SEAM(base + 5); \
    if (IN(base + 6)) { RUNPH(6, phase_topk(F, (l))); } \
    SEAM(base + 6); \
    if (IN(base + 7)) { if (EN(7)) { \
        pg8::Gemm g{WSP(bf16, WS_XE), WSP(bf16, WS_WGU), NE * MEXP, NE * 2048, D}; \
        MoeSched S{last ? 8 : 9, 8, F.G, F.vcu}; \
        EpiMoe1 E{WSP(bf16, WS_HID)}; \
        for (int rep_ = 0; rep_ < (REP(7) ? 2 : 1); ++rep_) { if (rep_) GBAR(); run_gemm<EpiMoe1, MoeSched>(ring, g, S, E); } } } \
    SEAM(base + 7); \
    if (IN(base + 8)) { if (EN(8)) { \
        pg8::Gemm g{WSP(bf16, WS_HID), WSP(bf16, WS_WD), NE * MEXP, NE * 1024, D}; \
        MoeSched S{last ? 8 : 9, 4, F.G, F.vcu}; \
        EpiMoe2 E{WSP(bf16, WS_OUTE), WSP(float, WS_SELG)}; \
        for (int rep_ = 0; rep_ < (REP(8) ? 2 : 1); ++rep_) { if (rep_) GBAR(); run_gemm<EpiMoe2, MoeSched>(ring, g, S, E); } } } \
    SEAM(base + 8); \
    if (IN(base + 9)) { if (EN(9)) { phase_row2(F, (l)); if (REP(9)) { GBAR(); phase_row2(F, (l), true); } } } \
    SEAM(base + 9); \
  } while (0)
    LAYER(0);
    LAYER(1);
#undef LAYER
#undef SEAM
#undef IN
}

extern "C" void kernel_launch(void* const* d_in, const int* in_sizes, int n_in, void* d_out, int out_size, void* d_ws, size_t ws_size, hipStream_t stream) {
    static int grid = 0;
    if (grid == 0) {
        if (n_in != 29 || out_size != NB * SEQ * D || ws_size < WS_END) { fprintf(stderr, "kernel_launch: unexpected sizes n_in %d out %d ws %zu\n", n_in, out_size, ws_size); grid = -1; return; }
        int dev = 0, cus = 0, per_cu = 0;
        if (hipGetDevice(&dev) != hipSuccess || hipDeviceGetAttribute(&cus, hipDeviceAttributeMultiprocessorCount, dev) != hipSuccess) { grid = -1; return; }
        if (hipFuncSetAttribute((const void*)fwd_kernel, hipFuncAttributeMaxDynamicSharedMemorySize, LDS_BYTES) != hipSuccess) { fprintf(stderr, "kernel_launch: hipFuncSetAttribute failed\n"); grid = -1; return; }
        if (hipOccupancyMaxActiveBlocksPerMultiprocessor(&per_cu, (const void*)fwd_kernel, NTHREADS, LDS_BYTES) != hipSuccess || per_cu < 1) { fprintf(stderr, "kernel_launch: occupancy query says %d\n", per_cu); per_cu = 1; }
        (void)hipGetLastError();
        grid = cus;
        fprintf(stderr, "kernel_launch: grid %d, per_cu %d, ws %zu\n", grid, per_cu, ws_size);
    }
    if (grid < 0) return;
    if (hipMemsetAsync((char*)d_ws + WS_CTL, 0, CTL_ZERO_BYTES, stream) != hipSuccess) return;
    Args a{};
    for (int i = 0; i < 29; ++i) a.in[i] = (const float*)d_in[i];
    a.out = (float*)d_out; a.ws = (unsigned char*)d_ws;
#if N_LAUNCH_MODE
    a.ph_lo = 0; a.ph_hi = N_PHASES;
    { void* kargs[] = {&a};
      hipError_t e = hipLaunchCooperativeKernel((const void*)fwd_kernel, dim3(grid), dim3(NTHREADS), kargs, LDS_BYTES, stream);
      if (e != hipSuccess) fprintf(stderr, "kernel_launch: cooperative launch failed: %s\n", hipGetErrorString(e)); }
#else
    for (int ph = 0; ph < N_PHASES; ++ph) {
        a.ph_lo = ph; a.ph_hi = ph + 1;
        void* kargs[] = {&a};
        hipError_t e = hipLaunchCooperativeKernel((const void*)fwd_kernel, dim3(grid), dim3(NTHREADS), kargs, LDS_BYTES, stream);
        if (e != hipSuccess) { fprintf(stderr, "kernel_launch: launch %d failed: %s\n", ph, hipGetErrorString(e)); break; }
    }
#endif
}
```

```cpp
#define GOLD_GEMM 0
#define N_LAUNCH_MODE 1
#define GOLD_ATTN 0
#define REP_MASK 0
#define CHUNK_SCAN 1
#include <hip/hip_runtime.h>
#include <hip/hip_cooperative_groups.h>
#include <cstdio>
#include <cstdint>
namespace cg = cooperative_groups;

#ifndef GOLD_GEMM
#define GOLD_GEMM 0
#endif
#ifndef GOLD_ATTN
#define GOLD_ATTN 1
#endif
#ifndef N_LAUNCH_MODE
#define N_LAUNCH_MODE 1
#endif

#define LAS __attribute__((address_space(3)))
typedef unsigned short bf16;
typedef float f32x4 __attribute__((ext_vector_type(4)));
typedef unsigned u32x4 __attribute__((ext_vector_type(4)));
typedef unsigned u32x2 __attribute__((ext_vector_type(2)));
typedef short bf16x8 __attribute__((ext_vector_type(8)));

constexpr int D = 1024, NB = 8, SEQ = 2048, CTXL = 256, T = SEQ + CTXL, M = NB * T, NL = 2;
constexpr int NINP = 2816;
constexpr int NE = 16, MEXP = 2304;
constexpr float LOG2E = 1.4426950408889634f;
constexpr float C2 = 0.125f * LOG2E;
constexpr int NTHREADS = 512, NWAVES = 8;
constexpr int LDS_BYTES = 147456, RING_BYTES = 131072, MISC_OFF = RING_BYTES + 320;

constexpr size_t MiB = 1u << 20;
constexpr size_t WS_CTL = 0, CTL_ZERO_BYTES = 1 * MiB;
constexpr size_t WS_MOD = 1 * MiB;
constexpr size_t WS_WIN = 2 * MiB;
constexpr size_t WS_WOUT = 13 * MiB;
constexpr size_t WS_LORA = 17 * MiB;
constexpr size_t WS_WGU = 19 * MiB;
constexpr size_t WS_WD = 83 * MiB;
constexpr size_t WS_X = 115 * MiB;
constexpr size_t R0 = 187 * MiB;
constexpr size_t WS_YD = R0 + 0 * MiB;
constexpr size_t WS_H = R0 + 36 * MiB;
constexpr size_t WS_QKV = R0 + 72 * MiB;
constexpr size_t WS_R32 = R0 + 126 * MiB;
constexpr size_t WS_Z = R0 + 180 * MiB;
constexpr size_t WS_DEC = R0 + 194 * MiB;
constexpr size_t WS_ASIG = R0 + 230 * MiB;
constexpr size_t WS_G = R0 + 266 * MiB;
constexpr size_t WS_O = R0 + 284 * MiB;
constexpr size_t WS_END = R0 + 320 * MiB;
constexpr size_t WS_Y = WS_QKV;
constexpr size_t WS_OUTE = WS_QKV;
constexpr size_t WS_H2 = WS_DEC;
constexpr size_t WS_AFF = WS_Z;
constexpr size_t WS_INV = WS_Z + 2 * MiB;
constexpr size_t WS_SELG = WS_Z + 4 * MiB;
constexpr size_t WS_SELT = WS_Z + 5 * MiB;
constexpr size_t WS_XE = WS_ASIG;
constexpr size_t WS_HID = WS_YD;
static_assert(WS_END <= 512 * MiB, "ws map");
constexpr int CW_BAR = 4096;
constexpr int CW_QUEUE = 16384;

__device__ __forceinline__ unsigned f2bf(float f) { unsigned u = __builtin_bit_cast(unsigned, f); return (u + 0x7fffu + ((u >> 16) & 1u)) >> 16; }
__device__ __forceinline__ unsigned pk2(float lo, float hi) { return f2bf(lo) | (f2bf(hi) << 16); }
__device__ __forceinline__ float bf2f(unsigned h) { return __builtin_bit_cast(float, h << 16); }
__device__ __forceinline__ float bflo(unsigned w) { return __builtin_bit_cast(float, w << 16); }
__device__ __forceinline__ float bfhi(unsigned w) { return __builtin_bit_cast(float, w & 0xffff0000u); }
template <int CTRL> __device__ __forceinline__ float dppf(float x) { return __builtin_bit_cast(float, __builtin_amdgcn_update_dpp(0, __builtin_bit_cast(int, x), CTRL, 0xF, 0xF, true)); }
__device__ __forceinline__ float red8(float x) { x += dppf<0xB1>(x); x += dppf<0x4E>(x); x += dppf<0x141>(x); return x; }
__device__ __forceinline__ float wave_sum(float v) {
    v = red8(v); v += dppf<0x140>(v);
    const float a0 = __builtin_bit_cast(float, __builtin_amdgcn_readlane(__builtin_bit_cast(int, v), 0));
    const float a1 = __builtin_bit_cast(float, __builtin_amdgcn_readlane(__builtin_bit_cast(int, v), 16));
    const float a2 = __builtin_bit_cast(float, __builtin_amdgcn_readlane(__builtin_bit_cast(int, v), 32));
    const float a3 = __builtin_bit_cast(float, __builtin_amdgcn_readlane(__builtin_bit_cast(int, v), 48));
    return (a0 + a1) + (a2 + a3);
}
__device__ __forceinline__ float sigmoidf_(float x) { return __builtin_amdgcn_rcpf(1.f + __expf(-x)); }
#define LDS_WAIT() asm volatile("s_waitcnt lgkmcnt(0)" ::: "memory")

#define XB_TMO      128
#define XB_XCNT(j)  (256  + 64 * (j))
#define XB_XSUB(j)  (1280 + 64 * (j))
#define XB_XGEN(j)  (2304 + 64 * (j))
#define XB_TOP      3328
#define XB_TOPGEN   3392
#define XCD_BAR_WORDS 3456
#define XB_SPIN_CAP (1u << 22)
__device__ __forceinline__ unsigned xb_ld(unsigned* p)              { return __hip_atomic_load(p, __ATOMIC_RELAXED, __HIP_MEMORY_SCOPE_AGENT); }
__device__ __forceinline__ unsigned xb_add(unsigned* p, unsigned v) { return __hip_atomic_fetch_add(p, v, __ATOMIC_RELAXED, __HIP_MEMORY_SCOPE_AGENT); }
__device__ __forceinline__ unsigned xb_xcc_id() { return (unsigned)__builtin_amdgcn_s_getreg((3 << 11) | 20) & 0xFu; }
#define XB_SPIN(cond, bar) do { unsigned _sp = 0; while (cond) { __builtin_amdgcn_s_sleep(1); \
    if ((++_sp & 255u) == 0u) { if (xb_ld(&(bar)[XB_TMO])) break; if (_sp > XB_SPIN_CAP) { atomicAdd(&(bar)[XB_TMO], 1u); break; } } } } while (0)
struct XcdBarrier { unsigned* bar; unsigned x; volatile LAS unsigned* st; };
__device__ __forceinline__ XcdBarrier xcd_barrier_post(unsigned* bar, volatile LAS unsigned* st) {
    XcdBarrier b; b.bar = bar; b.x = xb_xcc_id(); b.st = st;
    if (threadIdx.x == 0) (void)xb_add(&bar[XB_XCNT(b.x)], 1u);
    return b;
}
__device__ __forceinline__ void xcd_barrier_complete(unsigned* bar, unsigned x, unsigned& nloc, unsigned& nx) {
    const unsigned G = gridDim.x * gridDim.y * gridDim.z;
    unsigned sum, cnt, mine, sp = 0u;
    for (;;) {
        sum = 0u; cnt = 0u; mine = 0u;
#pragma unroll
        for (unsigned j = 0; j < 16; ++j) { const unsigned c = xb_ld(&bar[XB_XCNT(j)]); sum += c; cnt += (c > 0u) ? 1u : 0u; mine = (j == x) ? c : mine; }
        if (sum == G) break;
        __builtin_amdgcn_s_sleep(1);
        if ((++sp & 255u) == 0u) { if (xb_ld(&bar[XB_TMO])) break; if (sp > XB_SPIN_CAP) { atomicAdd(&bar[XB_TMO], 1u); break; } }
    }
    nloc = mine > 0u ? mine : 1u; nx = cnt > 0u ? cnt : 1u;
}
__device__ __forceinline__ void xcd_barrier(const XcdBarrier& b) {
    asm volatile("s_waitcnt vmcnt(0)" ::: "memory");
    __syncthreads();
    if (threadIdx.x == 0) {
        unsigned* bar = b.bar;
        __builtin_amdgcn_s_waitcnt(0);
        unsigned nloc = b.st[0], nx = b.st[1];
        if (nloc == 0u) { xcd_barrier_complete(bar, b.x, nloc, nx); b.st[0] = nloc; b.st[1] = nx; }
        const unsigned old = xb_add(&bar[XB_XSUB(b.x)], 1u);
        const unsigned gen = old / nloc;
        if (old + 1u == (gen + 1u) * nloc) {
            __builtin_amdgcn_fence(__ATOMIC_RELEASE, "agent");
            asm volatile("s_waitcnt vmcnt(0)" ::: "memory");
            const unsigned og = xb_add(&bar[XB_TOP], 1u);
            const unsigned tg = og / nx;
            if (og + 1u == (tg + 1u) * nx) xb_add(&bar[XB_TOPGEN], 1u);
            else XB_SPIN(xb_ld(&bar[XB_TOPGEN]) == tg, bar);
            __builtin_amdgcn_fence(__ATOMIC_ACQUIRE, "agent");
            xb_add(&bar[XB_XGEN(b.x)], 1u);
            asm volatile("s_waitcnt vmcnt(0)" ::: "memory");
        } else {
            XB_SPIN(xb_ld(&bar[XB_XGEN(b.x)]) == gen, bar);
            __builtin_amdgcn_fence(__ATOMIC_ACQUIRE, "agent");
            asm volatile("s_waitcnt vmcnt(0)" ::: "memory");
        }
    }
    __syncthreads();
}

__device__ __forceinline__ void flat_barrier(unsigned* cnt) {
    asm volatile("s_waitcnt vmcnt(0)" ::: "memory");
    __syncthreads();
    if (threadIdx.x == 0) {
        const unsigned G = gridDim.x;
        __builtin_amdgcn_fence(__ATOMIC_RELEASE, "agent");
        asm volatile("s_waitcnt vmcnt(0)" ::: "memory");
        const unsigned old = xb_add(cnt, 1u);
        const unsigned target = (old / G + 1u) * G;
        unsigned sp = 0;
        while (xb_ld(cnt) < target) { __builtin_amdgcn_s_sleep(1); if (++sp > (1u << 22)) break; }
        __builtin_amdgcn_fence(__ATOMIC_ACQUIRE, "agent");
        asm volatile("s_waitcnt vmcnt(0)" ::: "memory");
    }
    __syncthreads();
}

__device__ __forceinline__ void xcd_barrier2(const XcdBarrier& b) {
    asm volatile("s_waitcnt vmcnt(0)" ::: "memory");
    __syncthreads();
    if (threadIdx.x == 0) {
        unsigned* bar = b.bar;
        __builtin_amdgcn_s_waitcnt(0);
        unsigned nloc = b.st[0], nx = b.st[1];
        if (nloc == 0u) { xcd_barrier_complete(bar, b.x, nloc, nx); b.st[0] = nloc; b.st[1] = nx; }
        const unsigned old = xb_add(&bar[XB_XSUB(b.x)], 1u);
        const unsigned gen = old / nloc;
        if (old + 1u == (gen + 1u) * nloc) {
            __builtin_amdgcn_fence(__ATOMIC_RELEASE, "agent");
            asm volatile("s_waitcnt vmcnt(0)" ::: "memory");
            (void)xb_add(&bar[XB_TOP], 1u);
        }
        const unsigned target = (gen + 1u) * nx;
        XB_SPIN(xb_ld(&bar[XB_TOP]) < target, bar);
        __builtin_amdgcn_fence(__ATOMIC_ACQUIRE, "agent");
        asm volatile("s_waitcnt vmcnt(0)" ::: "memory");
    }
    __syncthreads();
}

template <int MODE> __device__ __forceinline__ void xcd_barrier2_probe(const XcdBarrier& b) {
    asm volatile("s_waitcnt vmcnt(0)" ::: "memory");
    __syncthreads();
    if (threadIdx.x == 0) {
        unsigned* bar = b.bar;
        unsigned nloc = b.st[0], nx = b.st[1];
        const unsigned old = xb_add(&bar[XB_XSUB(b.x)], 1u);
        const unsigned gen = old / nloc;
        if (old + 1u == (gen + 1u) * nloc) {
            if (!(MODE & 2)) { __builtin_amdgcn_fence(__ATOMIC_RELEASE, "agent"); asm volatile("s_waitcnt vmcnt(0)" ::: "memory"); }
            (void)xb_add(&bar[XB_TOP], 1u);
        }
        const unsigned target = (gen + 1u) * nx;
        XB_SPIN(xb_ld(&bar[XB_TOP]) < target, bar);
        if (!(MODE & 1) && (!(MODE & 4) || (old + 1u == (gen + 1u) * nloc))) { __builtin_amdgcn_fence(__ATOMIC_ACQUIRE, "agent"); asm volatile("s_waitcnt vmcnt(0)" ::: "memory"); }
    }
    __syncthreads();
}

__device__ __forceinline__ void xcd_barrier3(const XcdBarrier& b) {
    asm volatile("s_waitcnt vmcnt(0)" ::: "memory");
    __syncthreads();
    if (threadIdx.x == 0) {
        unsigned* bar = b.bar;
        __builtin_amdgcn_s_waitcnt(0);
        unsigned nloc = b.st[0], nx = b.st[1];
        if (nloc == 0u) { xcd_barrier_complete(bar, b.x, nloc, nx); b.st[0] = nloc; b.st[1] = nx; }
        const unsigned old = xb_add(&bar[XB_XSUB(b.x)], 1u);
        const unsigned gen = old / nloc;
        if (old + 1u == (gen + 1u) * nloc) {
            __builtin_amdgcn_fence(__ATOMIC_RELEASE, "agent");
            asm volatile("s_waitcnt vmcnt(0)" ::: "memory");
            (void)xb_add(&bar[XB_TOP], 1u);
            const unsigned target = (gen + 1u) * nx;
            XB_SPIN(xb_ld(&bar[XB_TOP]) < target, bar);
            __builtin_amdgcn_fence(__ATOMIC_ACQUIRE, "agent");
            asm volatile("s_waitcnt vmcnt(0)" ::: "memory");
            xb_add(&bar[XB_XGEN(b.x)], 1u);
        } else {
            __builtin_amdgcn_fence(__ATOMIC_ACQUIRE, "agent");
            asm volatile("s_waitcnt vmcnt(0)" ::: "memory");
            XB_SPIN(xb_ld(&bar[XB_XGEN(b.x)]) == gen, bar);
        }
    }
    __syncthreads();
}

#define XCD_BARRIER_FILL(b, MISCW, FILL_STMT) do { \
    asm volatile("s_waitcnt vmcnt(0)" ::: "memory"); \
    __syncthreads(); \
    if (threadIdx.x == 0) { \
        unsigned* bar_ = (b).bar; __builtin_amdgcn_s_waitcnt(0); \
        unsigned nloc_ = (b).st[0], nx_ = (b).st[1]; \
        if (nloc_ == 0u) { xcd_barrier_complete(bar_, (b).x, nloc_, nx_); (b).st[0] = nloc_; (b).st[1] = nx_; } \
        const unsigned old_ = xb_add(&bar_[XB_XSUB((b).x)], 1u); const unsigned gen_ = old_ / nloc_; \
        if (old_ + 1u == (gen_ + 1u) * nloc_) { \
            __builtin_amdgcn_fence(__ATOMIC_RELEASE, "agent"); asm volatile("s_waitcnt vmcnt(0)" ::: "memory"); \
            (void)xb_add(&bar_[XB_TOP], 1u); const unsigned target_ = (gen_ + 1u) * nx_; \
            XB_SPIN(xb_ld(&bar_[XB_TOP]) < target_, bar_); \
            __builtin_amdgcn_fence(__ATOMIC_ACQUIRE, "agent"); asm volatile("s_waitcnt vmcnt(0)" ::: "memory"); \
            xb_add(&bar_[XB_XGEN((b).x)], 1u); \
            (MISCW)[0] = 0xffffffffu; \
        } else { \
            __builtin_amdgcn_fence(__ATOMIC_ACQUIRE, "agent"); asm volatile("s_waitcnt vmcnt(0)" ::: "memory"); \
            (MISCW)[0] = gen_; \
        } \
    } \
    __syncthreads(); \
    { const unsigned g_ = (MISCW)[0]; \
      if (g_ != 0xffffffffu) { bool more_ = true; \
        for (;;) { \
            if (threadIdx.x == 0) (MISCW)[1] = (xb_ld(&(b).bar[XB_XGEN((b).x)]) != g_) ? 1u : 0u; \
            __syncthreads(); \
            const bool rel_ = (MISCW)[1] != 0u; \
            __syncthreads(); \
            if (rel_) break; \
            if (more_) { FILL_STMT; } else __builtin_amdgcn_s_sleep(4); \
        } } } \
    __syncthreads(); \
  } while (0)
namespace pg8 {
#define PG8_LAS __attribute__((address_space(3)))
typedef unsigned short bf16_t;
typedef short bf16x8 __attribute__((ext_vector_type(8)));
typedef float f32x4 __attribute__((ext_vector_type(4)));
typedef unsigned u32x4 __attribute__((ext_vector_type(4)));
constexpr int BM = 256, BK = 64, HALF = 128, HTB = HALF * BK * 2  , STAGE_BYTES = 8 * HTB, NXCD = 8, WGM = 8;

__host__ __device__ __forceinline__ int lds_byte(int r, int c) { const int st = (r >> 4) * 2 + (c >> 5), rr = r & 15, cc = c & 31, ob = rr * 64 + cc * 2; return st * 1024 + (ob ^ (((ob >> 9) & 1) << 5)); }
__host__ __device__ __forceinline__ void stage_rc(int b, int& R, int& C) { const int st = b / 1024, sb = b % 1024, swz = sb ^ (((sb >> 9) & 1) << 5); R = (st >> 1) * 16 + swz / 64; C = (st & 1) * 32 + (swz % 64) / 2; }
__host__ __device__ __forceinline__ int perm32(int rho) { const int n = rho >> 4, i = rho & 15; return 8 * (i >> 2) + 4 * n + (i & 3); }

struct Unit { int pm, pn; };
struct Gemm { const bf16_t* A; const bf16_t* Bt; int M, N, K; };

struct StaticOrder {
    int nM, nN, nwg, G, c;
    __host__ __device__ void init(int M, int N, int G_, int c_) { nM = M / BM; nN = N / BM; nwg = nM * nN; G = G_; c = c_; }
    __host__ __device__ bool next(int i, Unit& u) const {
        const long L = (long)i * G + c; if (L >= nwg) return false;
        int wgid = (int)L; { const int q = nwg / NXCD, r = nwg % NXCD, xcd = wgid % NXCD, off = wgid / NXCD; wgid = (xcd < r ? xcd * (q + 1) : r * (q + 1) + (xcd - r) * q) + off; }
        const int nig = WGM * nN, gid = wgid / nig, fm = gid * WGM, gsz = (nM - fm) < WGM ? (nM - fm) : WGM;
        u.pm = fm + ((wgid % nig) % gsz); u.pn = (wgid % nig) / gsz; return true;
    }
    __device__ __forceinline__ void a_ready(const Unit&) const {}
    __device__ __forceinline__ void done(const Unit&) const {}
};
__device__ __forceinline__ unsigned cvt_pk_bf16(float lo, float hi) { unsigned r; asm volatile("v_cvt_pk_bf16_f32 %0, %1, %2" : "=v"(r) : "v"(lo), "v"(hi)); return r; }
typedef float f32x2 __attribute__((ext_vector_type(2)));
template <class Epi, class Sched, bool ALIGN_EPI = false, bool SP2 = false>
__device__ __forceinline__ void gemm_phase(PG8_LAS unsigned char* lds, const Gemm g, const Sched& S, const Epi& E) {
    const int tid = threadIdx.x, wid = __builtin_amdgcn_readfirstlane(tid >> 6), lane = tid & 63, wr = wid >> 2, wc = wid & 3, fr = lane & 15, fq = lane >> 4;
    const int K = g.K, nt = K / BK;
    unsigned voffA[2], voffB[2];
#pragma unroll
    for (int i = 0; i < 2; ++i) { int R, C; stage_rc(tid * 16 + i * 8192, R, C); const int Rb = Epi::PERM ? ((R & ~31) + perm32(R & 31)) : R;
        voffA[i] = (unsigned)(R * K + C) * 2u; voffB[i] = (unsigned)(Rb * K + C) * 2u; }
    const size_t kstep = (size_t)(BK * 2);
    const size_t hstep = (size_t)HALF * K * 2;
    const size_t tstep = 2 * hstep;
    const unsigned ldsw = (unsigned)wid * 1024u;
    const int aoff = lds_byte(wr * 64 + fr, fq * 8), boff = lds_byte(wc * 32 + fr, fq * 8);
#define PG8_SA(b, h) (((b) * 2 + (h)) * HTB)
#define PG8_SB(b, h) ((4 + (b) * 2 + (h)) * HTB)
#define PG8_STAGE(bufoff, gbase, voff) do { _Pragma("unroll") for (int _i = 0; _i < 2; ++_i) \
        __builtin_amdgcn_global_load_lds((const unsigned*)((const char*)(gbase) + (voff)[_i]), (PG8_LAS unsigned*)(lds + (bufoff) + ldsw + _i * 8192), 16, 0, 0); } while (0)
#define PG8_LDA(dst, b, h) do { _Pragma("unroll") for (int m = 0; m < 4; ++m) _Pragma("unroll") for (int k = 0; k < 2; ++k) dst[m][k] = *(const PG8_LAS bf16x8*)(lds + PG8_SA(b, h) + aoff + m * 2048 + k * 1024); } while (0)
#define PG8_LDB(dst, b, h) do { _Pragma("unroll") for (int n = 0; n < 2; ++n) _Pragma("unroll") for (int k = 0; k < 2; ++k) dst[n][k] = *(const PG8_LAS bf16x8*)(lds + PG8_SB(b, h) + boff + n * 2048 + k * 1024); } while (0)
#define PG8_MMA(ai, bj, At, Bt) do { __builtin_amdgcn_s_setprio(1); _Pragma("unroll") for (int m = 0; m < 4; ++m) _Pragma("unroll") for (int n = 0; n < 2; ++n) _Pragma("unroll") for (int k = 0; k < 2; ++k) \
        acc[ai][bj][m][n] = __builtin_amdgcn_mfma_f32_16x16x32_bf16(Bt[n][k], At[m][k], acc[ai][bj][m][n], 0, 0, 0); __builtin_amdgcn_s_setprio(0); } while (0)
#define PG8_WAIT_V(n) asm volatile("s_waitcnt vmcnt(" #n ")" ::: "memory")
#define PG8_WAIT_L(n) asm volatile("s_waitcnt lgkmcnt(" #n ")" ::: "memory")
#define PG8_BAR __builtin_amdgcn_s_barrier()
#define PG8_SCHED __builtin_amdgcn_sched_barrier(0)
    Unit cur, nxt; int ui = 0;
    if (!S.next(0, cur)) return;
    f32x4 acc[2][2][4][2];
#pragma unroll
    for (int a = 0; a < 2; ++a)
#pragma unroll
        for (int b = 0; b < 2; ++b)
#pragma unroll
            for (int m = 0; m < 4; ++m)
#pragma unroll
                for (int n = 0; n < 2; ++n) acc[a][b][m][n] = (f32x4){0.f, 0.f, 0.f, 0.f};
    bf16x8 At[4][2], B0[2][2], B1[2][2];
    const char* cA = (const char*)g.A + (size_t)cur.pm * tstep; const char* cB = (const char*)g.Bt + (size_t)cur.pn * tstep;
    S.a_ready(cur);
    if constexpr (SP2) {
        PG8_STAGE(PG8_SB(0, 0), cB, voffB); PG8_STAGE(PG8_SB(0, 1), cB + hstep, voffB); PG8_STAGE(PG8_SA(0, 0), cA, voffA); PG8_STAGE(PG8_SA(0, 1), cA + hstep, voffA);
        if (wr == 1) PG8_BAR;
        PG8_WAIT_V(2); PG8_BAR;
        PG8_STAGE(PG8_SB(1, 0), cB + kstep, voffB); PG8_STAGE(PG8_SA(1, 0), cA + kstep, voffA); PG8_STAGE(PG8_SB(1, 1), cB + hstep + kstep, voffB);
        PG8_WAIT_V(6); PG8_BAR;
    } else {
        PG8_STAGE(PG8_SB(0, 0), cB, voffB); PG8_STAGE(PG8_SA(0, 0), cA, voffA); PG8_STAGE(PG8_SB(0, 1), cB + hstep, voffB); PG8_STAGE(PG8_SA(0, 1), cA + hstep, voffA);
        if (wr == 1) PG8_BAR;
        PG8_WAIT_V(4); PG8_BAR;
        PG8_STAGE(PG8_SB(1, 0), cB + kstep, voffB); PG8_STAGE(PG8_SA(1, 0), cA + kstep, voffA); PG8_STAGE(PG8_SB(1, 1), cB + hstep + kstep, voffB);
        PG8_WAIT_V(6); PG8_BAR;
    }
    for (;;) {
        const bool has_next = S.next(ui + 1, nxt);
        const char* nA = has_next ? (const char*)g.A + (size_t)nxt.pm * tstep : cA; const char* nB = has_next ? (const char*)g.Bt + (size_t)nxt.pn * tstep : cB;
        for (int t = 0; t < nt; t += 2) {
            const bool last = (t == nt - 2);
            const char* a1 = cA + (size_t)(t + 1) * kstep;
            const char* a2 = last ? nA : cA + (size_t)(t + 2) * kstep; const char* b2 = last ? nB : cB + (size_t)(t + 2) * kstep;
            const char* a3 = a2 + kstep; const char* b3 = b2 + kstep;
            if (last && has_next) S.a_ready(nxt);
            if constexpr (SP2) {
            PG8_LDB(B0, 0, 0); PG8_LDB(B1, 0, 1); PG8_SCHED; PG8_LDA(At, 0, 0); PG8_STAGE(PG8_SA(1, 1), a1 + hstep, voffA);
            PG8_WAIT_V(8); PG8_WAIT_L(0); PG8_BAR; PG8_MMA(0, 0, At, B0); PG8_MMA(0, 1, At, B1); PG8_BAR; PG8_SCHED;
            PG8_LDA(At, 0, 1); PG8_STAGE(PG8_SB(0, 0), b2, voffB); PG8_STAGE(PG8_SB(0, 1), b2 + hstep, voffB); PG8_STAGE(PG8_SA(0, 0), a2, voffA);
            PG8_WAIT_V(8); PG8_WAIT_L(0); PG8_BAR; PG8_MMA(1, 0, At, B0); PG8_MMA(1, 1, At, B1); PG8_BAR; PG8_SCHED;
            PG8_LDB(B0, 1, 0); PG8_LDB(B1, 1, 1); PG8_SCHED; PG8_LDA(At, 1, 0); PG8_STAGE(PG8_SA(0, 1), a2 + hstep, voffA);
            PG8_WAIT_V(8); PG8_WAIT_L(0); PG8_BAR; PG8_MMA(0, 0, At, B0); PG8_MMA(0, 1, At, B1); PG8_BAR; PG8_SCHED;
            PG8_LDA(At, 1, 1); PG8_STAGE(PG8_SB(1, 0), b3, voffB); PG8_STAGE(PG8_SB(1, 1), b3 + hstep, voffB); PG8_STAGE(PG8_SA(1, 0), a3, voffA);
            PG8_WAIT_V(8); PG8_WAIT_L(0); PG8_BAR; PG8_MMA(1, 0, At, B0); PG8_MMA(1, 1, At, B1); PG8_BAR; PG8_SCHED;
            } else {
            PG8_LDB(B0, 0, 0); PG8_SCHED; PG8_LDA(At, 0, 0); PG8_STAGE(PG8_SA(1, 1), a1 + hstep, voffA);
            PG8_WAIT_L(8); PG8_BAR; PG8_WAIT_L(0); PG8_MMA(0, 0, At, B0); PG8_BAR; PG8_SCHED;
            PG8_LDB(B1, 0, 1); PG8_STAGE(PG8_SB(0, 0), b2, voffB);
            PG8_BAR; PG8_WAIT_L(0); PG8_MMA(0, 1, At, B1); PG8_BAR;
            PG8_LDA(At, 0, 1); PG8_STAGE(PG8_SA(0, 0), a2, voffA);
            PG8_BAR; PG8_WAIT_L(0); PG8_MMA(1, 0, At, B0); PG8_BAR; PG8_SCHED;
            PG8_STAGE(PG8_SB(0, 1), b2 + hstep, voffB);
            PG8_WAIT_V(6); PG8_BAR; PG8_MMA(1, 1, At, B1); PG8_BAR;
            PG8_LDB(B0, 1, 0); PG8_SCHED; PG8_LDA(At, 1, 0); PG8_STAGE(PG8_SA(0, 1), a2 + hstep, voffA);
            PG8_WAIT_L(8); PG8_BAR; PG8_WAIT_L(0); PG8_MMA(0, 0, At, B0); PG8_BAR; PG8_SCHED;
            PG8_LDB(B1, 1, 1); PG8_STAGE(PG8_SB(1, 0), b3, voffB);
            PG8_BAR; PG8_WAIT_L(0); PG8_MMA(0, 1, At, B1); PG8_BAR;
            PG8_LDA(At, 1, 1); PG8_STAGE(PG8_SA(1, 0), a3, voffA);
            PG8_BAR; PG8_WAIT_L(0); PG8_MMA(1, 0, At, B0); PG8_BAR; PG8_SCHED;
            PG8_STAGE(PG8_SB(1, 1), b3 + hstep, voffB);
            PG8_WAIT_V(6); PG8_BAR; PG8_MMA(1, 1, At, B1); PG8_BAR;
            }
        }
        if constexpr (ALIGN_EPI) { if (wr == 0) PG8_BAR; }
        if constexpr (!Epi::AFTER_DRAIN) { E(acc, cur, wr, wc, fr, fq); S.done(cur); }
        if (!has_next) break;
#pragma unroll
        for (int a = 0; a < 2; ++a)
#pragma unroll
            for (int b = 0; b < 2; ++b)
#pragma unroll
                for (int m = 0; m < 4; ++m)
#pragma unroll
                    for (int n = 0; n < 2; ++n) acc[a][b][m][n] = (f32x4){0.f, 0.f, 0.f, 0.f};
        cur = nxt; cA = nA; cB = nB; ++ui;
        if constexpr (ALIGN_EPI) { if (wr == 1) PG8_BAR; }
    }
    PG8_WAIT_V(0);
    if constexpr (!ALIGN_EPI) { if (wr == 0) PG8_BAR; }
    PG8_BAR;
    if constexpr (Epi::AFTER_DRAIN) { E.fused(acc, cur, wr, wc, fr, fq, lds, wid, lane); S.done(cur); }
#undef PG8_SA
#undef PG8_SB
#undef PG8_STAGE
#undef PG8_LDA
#undef PG8_LDB
#undef PG8_MMA
#undef PG8_WAIT_V
#undef PG8_WAIT_L
#undef PG8_BAR
#undef PG8_SCHED
}
}

__device__ __forceinline__ u32x4 pack8(const f32x4 a, const f32x4 b) {
    u32x4 w; w.x = pk2(a[0], a[1]); w.y = pk2(a[2], a[3]); w.z = pk2(b[0], b[1]); w.w = pk2(b[2], b[3]); return w;
}
__device__ __forceinline__ float tanh_fast(float x) { const float e = __expf(2.f * x); return 1.f - 2.f * __builtin_amdgcn_rcpf(1.f + e); }
__device__ __forceinline__ float decay_of(float v) { const float ew = 0.6065306597126334f * __builtin_amdgcn_rcpf(1.f + __expf(-v)); return __expf(-ew); }
struct EpiInproj {
    static constexpr bool PERM = true, AFTER_DRAIN = false;
    bf16* QKV; float* R32; bf16* Z;
    __device__ __forceinline__ void operator()(const f32x4 (&acc)[2][2][4][2], const pg8::Unit& u, int wr, int wc, int fr, int fq) const {
        const int pn = u.pn;
#pragma unroll
        for (int ai = 0; ai < 2; ++ai)
#pragma unroll
            for (int m = 0; m < 4; ++m) {
                const unsigned row = (unsigned)u.pm * 256u + ai * 128 + wr * 64 + m * 16 + fr;
#pragma unroll
                for (int bj = 0; bj < 2; ++bj) {
                    f32x4 v0 = acc[ai][bj][m][0], v1 = acc[ai][bj][m][1];
                    const int cb = bj * 128 + wc * 32 + 8 * fq;
                    if (pn < 6) {
                        if (pn == 3) { v0 = v0 * C2; v1 = v1 * C2; }
                        *(u32x4*)(QKV + row * 1536 + pn * 256 + cb) = pack8(v0, v1);
                    } else if (pn < 9) {
                        float* p = R32 + row * 768 + (pn - 6) * 256 + cb;
                        *(f32x4*)p = v0; *(f32x4*)(p + 4) = v1;
                    } else if (pn == 9) {
                        if (bj == 0) {
#pragma unroll
                            for (int e = 0; e < 4; ++e) { v0[e] = tanh_fast(v0[e]); v1[e] = tanh_fast(v1[e]); }
                        }
                        *(u32x4*)(Z + row * 384 + cb) = pack8(v0, v1);
                    } else {
                        if (bj == 0) {
#pragma unroll
                            for (int e = 0; e < 4; ++e) { v0[e] = sigmoidf_(v0[e]); v1[e] = sigmoidf_(v1[e]); }
                            *(u32x4*)(Z + row * 384 + 256 + cb) = pack8(v0, v1);
                        }
                    }
                }
            }
    }
};
struct EpiLora {
    static constexpr bool PERM = true, AFTER_DRAIN = false;
    float* DEC; float* ASIG; float* G; const float* w0; const float* a0;
    template <int KIND> __device__ __forceinline__ void body(const f32x4 (&acc)[2][2][4][2], float* dst, const float* bias, unsigned row0, int cb0) const {
#pragma unroll
        for (int bj = 0; bj < 2; ++bj) {
            const int cb = bj * 128 + cb0;
            f32x4 b0 = (f32x4){0.f, 0.f, 0.f, 0.f}, b1 = b0;
            if (KIND != 2) { b0 = *(const f32x4*)(bias + cb); b1 = *(const f32x4*)(bias + cb + 4); }
#pragma unroll
            for (int ai = 0; ai < 2; ++ai)
#pragma unroll
                for (int m = 0; m < 4; ++m) {
                    f32x4 v0 = acc[ai][bj][m][0] + b0, v1 = acc[ai][bj][m][1] + b1;
#pragma unroll
                    for (int e = 0; e < 4; ++e) {
                        if (KIND == 0) { v0[e] = decay_of(v0[e]); v1[e] = decay_of(v1[e]); }
                        if (KIND == 1) { v0[e] = sigmoidf_(v0[e]); v1[e] = sigmoidf_(v1[e]); }
                    }
                    float* p = dst + (row0 + ai * 128 + m * 16) * 256u + cb;
                    *(f32x4*)p = v0; *(f32x4*)(p + 4) = v1;
                    asm volatile("" ::: "memory");
                }
        }
    }
    __device__ __forceinline__ void operator()(const f32x4 (&acc)[2][2][4][2], const pg8::Unit& u, int wr, int wc, int fr, int fq) const {
        const int pn = u.pn; const unsigned row0 = (unsigned)u.pm * 256u + wr * 64 + fr; const int cb0 = wc * 32 + 8 * fq;
        if (pn < 2) body<0>(acc, DEC + (size_t)pn * M * 256, w0 + pn * 256, row0, cb0);
        else if (pn < 4) body<1>(acc, ASIG + (size_t)(pn - 2) * M * 256, a0 + (pn - 2) * 256, row0, cb0);
        else body<2>(acc, G, w0, row0, cb0);
    }
};
struct EpiOut {
    static constexpr bool PERM = true, AFTER_DRAIN = false;
    float* Y;
    __device__ __forceinline__ void operator()(const f32x4 (&acc)[2][2][4][2], const pg8::Unit& u, int wr, int wc, int fr, int fq) const {
#pragma unroll
        for (int ai = 0; ai < 2; ++ai)
#pragma unroll
            for (int m = 0; m < 4; ++m) {
                const unsigned row = (unsigned)u.pm * 256u + ai * 128 + wr * 64 + m * 16 + fr;
#pragma unroll
                for (int bj = 0; bj < 2; ++bj) {
                    float* p = Y + row * 1024 + u.pn * 256 + bj * 128 + wc * 32 + 8 * fq;
                    *(f32x4*)p = acc[ai][bj][m][0]; *(f32x4*)(p + 4) = acc[ai][bj][m][1];
                }
            }
    }
};
struct EpiMoe1 {
    static constexpr bool PERM = true, AFTER_DRAIN = false;
    bf16* HID;
    __device__ __forceinline__ void operator()(const f32x4 (&acc)[2][2][4][2], const pg8::Unit& u, int wr, int wc, int fr, int fq) const {
        const int pnl = u.pn & 7;
#pragma unroll
        for (int ai = 0; ai < 2; ++ai)
#pragma unroll
            for (int m = 0; m < 4; ++m) {
                const unsigned row = (unsigned)u.pm * 256u + ai * 128 + wr * 64 + m * 16 + fr;
                f32x4 h0, h1;
#pragma unroll
                for (int e = 0; e < 4; ++e) {
                    const float g0 = acc[ai][0][m][0][e], g1 = acc[ai][0][m][1][e];
                    h0[e] = g0 * sigmoidf_(g0) * acc[ai][1][m][0][e];
                    h1[e] = g1 * sigmoidf_(g1) * acc[ai][1][m][1][e];
                }
                *(u32x4*)(HID + row * 1024 + pnl * 128 + wc * 32 + 8 * fq) = pack8(h0, h1);
            }
    }
};
struct EpiMoe2 {
    static constexpr bool PERM = true, AFTER_DRAIN = false;
    bf16* OUTE; const float* selg;
    __device__ __forceinline__ void operator()(const f32x4 (&acc)[2][2][4][2], const pg8::Unit& u, int wr, int wc, int fr, int fq) const {
        const int pnl = u.pn & 3;
#pragma unroll
        for (int ai = 0; ai < 2; ++ai)
#pragma unroll
            for (int m = 0; m < 4; ++m) {
                const unsigned row = (unsigned)u.pm * 256u + ai * 128 + wr * 64 + m * 16 + fr;
                const float gt = selg[row];
#pragma unroll
                for (int bj = 0; bj < 2; ++bj)
                    *(u32x4*)(OUTE + row * 1024 + pnl * 256 + bj * 128 + wc * 32 + 8 * fq) = pack8(acc[ai][bj][m][0] * gt, acc[ai][bj][m][1] * gt);
            }
    }
};

struct TileSched {
    int nM, nN, G, c; bool latent_only;
    __device__ __forceinline__ bool next(int i, pg8::Unit& u) const {
        const long L = (long)i * G + c; if (L >= (long)nM * nN) return false;
        const int pmi = (int)(L / nN); u.pn = (int)(L % nN); u.pm = latent_only ? (pmi >> 3) * 9 + 1 + (pmi & 7) : pmi; return true;
    }
    __device__ __forceinline__ void a_ready(const pg8::Unit&) const {}
    __device__ __forceinline__ void done(const pg8::Unit&) const {}
};
struct InprojLastSched {
    int G, c;
    __device__ __forceinline__ bool next(int i, pg8::Unit& u) const {
        const int L = i * G + c; if (L >= 768) return false;
        if (L < 704) { const int pmi = L / 11; u.pn = L % 11; u.pm = (pmi >> 3) * 9 + 1 + (pmi & 7); }
        else { const int r = L - 704; u.pm = (r >> 3) * 9; const int k = r & 7; u.pn = k == 0 ? 2 : k + 3; }
        return true;
    }
    __device__ __forceinline__ void a_ready(const pg8::Unit&) const {}
    __device__ __forceinline__ void done(const pg8::Unit&) const {}
};
struct MoeSched {
    int nMe, nNe, G, c;
    __device__ __forceinline__ bool next(int i, pg8::Unit& u) const {
        const long L = (long)i * G + c; if (L >= (long)NE * nMe * nNe) return false;
        const int pnl = (int)(L % nNe), t = (int)(L / nNe), pml = t % nMe, e = t / nMe;
        u.pm = e * 9 + pml; u.pn = e * nNe + pnl; return true;
    }
    __device__ __forceinline__ void a_ready(const pg8::Unit&) const {}
    __device__ __forceinline__ void done(const pg8::Unit&) const {}
};

template <class Epi, class Sched>
__device__ __forceinline__ void gemm_ref(const pg8::Gemm g, const Sched& S, const Epi& E) {
    const int tid = threadIdx.x, wid = tid >> 6, lane = tid & 63, wr = wid >> 2, wc = wid & 3, fr = lane & 15, fq = lane >> 4;
    int K = g.K; asm volatile("" : "+s"(K));
    pg8::Unit u;
    for (int ui = 0; S.next(ui, u); ++ui) {
        f32x4 acc[2][2][4][2];
#pragma unroll
        for (int a = 0; a < 2; ++a)
#pragma unroll
            for (int b = 0; b < 2; ++b)
#pragma unroll
                for (int m = 0; m < 4; ++m)
#pragma unroll
                    for (int n = 0; n < 2; ++n) acc[a][b][m][n] = (f32x4){0.f, 0.f, 0.f, 0.f};
        const bf16* Ab = g.A + ((size_t)u.pm * 256 + wr * 64 + fr) * K;
        const bf16* Bb = g.Bt + ((size_t)u.pn * 256 + wc * 32 + 8 * fq) * K;
#pragma unroll
        for (int ai = 0; ai < 2; ++ai)
#pragma unroll
            for (int bj = 0; bj < 2; ++bj)
#pragma unroll
                for (int m = 0; m < 4; ++m)
#pragma unroll
                    for (int n = 0; n < 2; ++n)
#pragma unroll
                        for (int e = 0; e < 4; ++e) {
                            const bf16* ar = Ab + (size_t)(ai * 128 + m * 16) * K; const bf16* br = Bb + (size_t)(bj * 128 + 4 * n + e) * K;
                            float s0 = 0.f, s1 = 0.f;
#pragma unroll 2
                            for (int k0 = 0; k0 < K; k0 += 8) {
                                const u32x4 wa = *(const u32x4*)(ar + k0), wb = *(const u32x4*)(br + k0);
                                s0 += bflo(wa.x) * bflo(wb.x) + bflo(wa.y) * bflo(wb.y) + bflo(wa.z) * bflo(wb.z) + bflo(wa.w) * bflo(wb.w);
                                s1 += bfhi(wa.x) * bfhi(wb.x) + bfhi(wa.y) * bfhi(wb.y) + bfhi(wa.z) * bfhi(wb.z) + bfhi(wa.w) * bfhi(wb.w);
                            }
                            acc[ai][bj][m][n][e] = s0 + s1;
                            asm volatile("" ::: "memory");
                        }
        E(acc, u, wr, wc, fr, fq);
    }
}
template <class Epi, class Sched>
__device__ __forceinline__ void run_gemm(LAS unsigned char* lds, const pg8::Gemm g, const Sched& S, const Epi& E) {
#if GOLD_GEMM
    gemm_ref<Epi, Sched>(g, S, E);
    __syncthreads();
#else
    pg8::Gemm g2 = g; { int kd = g.K; asm volatile("" : "+s"(kd)); g2.K = kd; }
    pg8::gemm_phase<Epi, Sched, true, true>(lds, g2, S, E);
#endif
}

struct Args { const float* in[29]; float* out; unsigned char* ws; int ph_lo, ph_hi; };
enum { I_X = 0, I_C, I_CTX, I_CCTX, I_WMOD, I_BMOD, I_GPREMIX, I_GPOSTMIX, I_GPREFFN, I_GPOSTFFN, I_WIN, I_WOUT, I_QGAIN, I_KGAIN, I_RPB,
       I_W0, I_WUP, I_A0, I_AUP, I_GUP, I_KK, I_KA, I_RK, I_LNXW, I_LNXB, I_WROUTER, I_WEGATE, I_WEUP, I_WEDOWN };

struct Frame {
    LAS unsigned char* lds; volatile LAS unsigned* MISC; unsigned* ctl;
    int wave, vcu, G;
    const float* const* in; float* out; unsigned char* ws;
};
#define TID_ ((int)threadIdx.x)
#define LANE_ ((int)(threadIdx.x & 63u))
#define WSP(T_, off) ((T_*)(F.ws + (off)))

__device__ __forceinline__ void cvt_item(const float* src, int ld_src, bf16* dst, int ld_dst, LAS float* scr, int lane) {
#pragma unroll 8
    for (int i = 0; i < 32; ++i) { const int kk = 2 * i + (lane >> 5); scr[kk * 33 + (lane & 31)] = src[(size_t)kk * ld_src + (lane & 31)]; }
    LDS_WAIT(); asm volatile("" ::: "memory");
    const int c = lane & 7;
#pragma unroll
    for (int j = 0; j < 4; ++j) { const int n = (lane >> 3) + 8 * j; const LAS float* s = scr + (8 * c) * 33 + n;
        u32x4 o; o.x = pk2(s[0 * 33], s[1 * 33]); o.y = pk2(s[2 * 33], s[3 * 33]); o.z = pk2(s[4 * 33], s[5 * 33]); o.w = pk2(s[6 * 33], s[7 * 33]);
        *(u32x4*)(dst + (size_t)n * ld_dst + 8 * c) = o; }
    LDS_WAIT(); asm volatile("" ::: "memory");
}
__device__ __forceinline__ void cvt_moe_item(Frame& F, int l, int it, LAS float* scr, int lane) {
    const int which = it >> 13, r = it & 8191, e = r >> 9, q = r & 511, kb = q >> 5, nb = q & 31, n0 = nb * 32;
    const float* W = F.in[which == 0 ? I_WEGATE : (which == 1 ? I_WEUP : I_WEDOWN)] + ((size_t)(l * NE + e) * 1024 + kb * 64) * 1024 + n0;
    bf16* dst;
    if (which < 2) dst = WSP(bf16, WS_WGU) + ((size_t)e * 2048 + (n0 >> 7) * 256 + which * 128 + (n0 & 127)) * 1024 + kb * 64;
    else dst = WSP(bf16, WS_WD) + ((size_t)e * 1024 + n0) * 1024 + kb * 64;
    cvt_item(W, 1024, dst, 1024, scr, lane);
}
constexpr int CVT_NMINI = 3 * 8192 / NWAVES, CW_CVTQ = 40960;
__device__ __forceinline__ void cvt_moe_mini(Frame& F, int l, int mb) {
    int lane = LANE_; asm volatile("" : "+v"(lane));
    cvt_moe_item(F, l, mb * NWAVES + F.wave, (LAS float*)(F.lds + F.wave * 16384), lane);
}
__device__ __forceinline__ void cvt_moe_drain(Frame& F, int l, int n) {
    for (;;) {
        if (TID_ == 0) F.MISC[17] = atomicAdd(F.ctl + CW_CVTQ + 64 * l, (unsigned)n);
        __syncthreads();
        const int base = (int)F.MISC[17];
        __syncthreads();
        if (base >= CVT_NMINI) break;
#pragma unroll 1
        for (int k = 0; k < n; ++k) if (base + k < CVT_NMINI) cvt_moe_mini(F, l, base + k);
        __syncthreads();
    }
}

__device__ __forceinline__ void phase_init(Frame& F) {
    const int tid = TID_;
    {
        LAS float* sil = (LAS float*)F.lds;
        LAS float* red = (LAS float*)(F.lds + 40960);
        float* MOD = WSP(float, WS_MOD);
        bool have = false;
        for (int it = F.vcu; it < 2 * 96; it += F.G) {
            if (!have) {
                for (int i = tid; i < 9 * 1024; i += NTHREADS) { const int r = i >> 10, k = i & 1023; const float cv = (r < 8) ? F.in[I_C][r * 1024 + k] : F.in[I_CCTX][k]; sil[i] = cv / (1.f + expf(-cv)); }
                __syncthreads(); have = true;
            }
            const int l = it / 96, n0 = (it % 96) * 64, ks = tid >> 6, col = tid & 63;
            float acc[9];
#pragma unroll
            for (int r = 0; r < 9; ++r) acc[r] = 0.f;
            const float* w = F.in[I_WMOD] + ((size_t)l * 1024 + ks * 128) * 6144 + n0 + col;
            for (int k = 0; k < 128; ++k) { const float wv = w[(size_t)k * 6144];
#pragma unroll
                for (int r = 0; r < 9; ++r) acc[r] += sil[r * 1024 + ks * 128 + k] * wv; }
#pragma unroll
            for (int r = 0; r < 9; ++r) red[(ks * 9 + r) * 64 + col] = acc[r];
            __syncthreads();
            for (int o = tid; o < 576; o += NTHREADS) { const int r = o >> 6, cc = o & 63; float s = 0.f;
#pragma unroll
                for (int k2 = 0; k2 < 8; ++k2) s += red[(k2 * 9 + r) * 64 + cc];
                MOD[(size_t)(l * 9 + r) * 6144 + n0 + cc] = s + F.in[I_BMOD][l * 6144 + n0 + cc]; }
            __syncthreads();
        }
        __syncthreads();
    }
    {
        LAS float* scr = (LAS float*)(F.lds + F.wave * 16384);
        const int gw = F.vcu * NWAVES + F.wave, NGW = F.G * NWAVES;
        bf16* WIN = WSP(bf16, WS_WIN); bf16* WOUT = WSP(bf16, WS_WOUT);
        for (int it = gw; it < 2 * (1344 + 512); it += NGW) {
            const int l = it / 1856, r = it % 1856;
            if (r < 1344) { const int kb = r / 84, n0 = (r % 84) * 32; const int dn = n0 < 768 ? n0 : (n0 < 1920 ? n0 + 768 : n0 - 1152);
                cvt_item(F.in[I_WIN] + ((size_t)l * 1024 + kb * 64) * 2688 + n0, 2688, WIN + ((size_t)l * NINP + dn) * 1024 + kb * 64, 1024, scr, LANE_); }
            else { const int q = r - 1344, kb = q >> 5, n0 = (q & 31) * 32;
                cvt_item(F.in[I_WOUT] + ((size_t)l * 1024 + kb * 64) * 1024 + n0, 1024, WOUT + ((size_t)l * 1024 + n0) * 1024 + kb * 64, 1024, scr, LANE_); }
        }
    }
    {
        const size_t gt = (size_t)F.vcu * NTHREADS + tid, NT = (size_t)F.G * NTHREADS;
        u32x4* WIN4 = WSP(u32x4, WS_WIN);
        for (size_t i = gt; i < (size_t)2 * 128 * 128; i += NT) { const int l = (int)(i >> 14), r = (int)(i & 16383); WIN4[((size_t)l * NINP + 2688) * 128 + r] = (u32x4){0u, 0u, 0u, 0u}; }
        bf16* LORA = WSP(bf16, WS_LORA);
        for (size_t i = gt; i < (size_t)2 * 1280 * 384; i += NT) { const int l = (int)(i / (1280 * 384)), r = (int)(i % (1280 * 384)), n = r / 384, k = r % 384, tile = n >> 8, nn = n & 255;
            float v = 0.f;
            if (tile < 2) { const int d = tile, kk = k - 64 * d; if (kk >= 0 && kk < 64) v = F.in[I_WUP][(((size_t)l * 2 + d) * 64 + kk) * 256 + nn]; }
            else if (tile < 4) { const int d = tile - 2, kk = k - 128 - 64 * d; if (kk >= 0 && kk < 64) v = F.in[I_AUP][(((size_t)l * 2 + d) * 64 + kk) * 256 + nn]; }
            else { const int kk = k - 256; if (kk >= 0) v = F.in[I_GUP][((size_t)l * 128 + kk) * 256 + nn]; }
            LORA[i] = (bf16)f2bf(v); }
    }
}

__device__ __forceinline__ const float* in_row(Frame& F, int b, int t) { return t < CTXL ? F.in[I_CTX] + ((size_t)b * CTXL + t) * 1024 : F.in[I_X] + ((size_t)b * SEQ + (t - CTXL)) * 1024; }
__device__ __forceinline__ float row_ss(const f32x4 (&v)[4]) {
    float s = 0.f;
#pragma unroll
    for (int j = 0; j < 4; ++j) s += (v[j][0] * v[j][0] + v[j][1] * v[j][1]) + (v[j][2] * v[j][2] + v[j][3] * v[j][3]);
    return wave_sum(s);
}
__device__ __forceinline__ void mod_store(const f32x4 (&x)[4], float rinv, const float* g, const float* shift, const float* scale, bf16* dst, int lane, f32x4 (&h)[4]) {
#pragma unroll
    for (int j = 0; j < 4; ++j) { const int e = 256 * j + 4 * lane;
        const f32x4 gg = *(const f32x4*)(g + e), sh = *(const f32x4*)(shift + e), sc = *(const f32x4*)(scale + e);
        h[j] = x[j] * rinv * gg * (sc + 1.f) + sh;
        u32x2 w; w.x = pk2(h[j][0], h[j][1]); w.y = pk2(h[j][2], h[j][3]); *(u32x2*)(dst + e) = w; }
}
__device__ __forceinline__ void phase_row0(Frame& F) {
    const int gw = F.vcu * NWAVES + F.wave, NGW = F.G * NWAVES, lane = LANE_;
    bf16* H = WSP(bf16, WS_H); const float* MOD = WSP(float, WS_MOD);
    for (int m = gw; m < M; m += NGW) { const int b = m / T, t = m % T, r = t < CTXL ? 8 : b;
        const float* xin = in_row(F, b, t);
        f32x4 x[4], h[4];
#pragma unroll
        for (int j = 0; j < 4; ++j) x[j] = *(const f32x4*)(xin + 256 * j + 4 * lane);
        const float rinv = rsqrtf(row_ss(x) * (1.f / 1024.f) + 1e-6f);
        const float* md = MOD + (size_t)(0 * 9 + r) * 6144;
        mod_store(x, rinv, F.in[I_GPREMIX], md, md + 1024, H + (size_t)m * 1024, lane, h);
    }
}
__device__ __forceinline__ void phase_row1(Frame& F, int l, bool dry = false) {
    const int gw = F.vcu * NWAVES + F.wave, NGW = F.G * NWAVES, lane = LANE_;
    const float* X = WSP(float, WS_X); const float* Y = WSP(float, WS_Y); const float* MOD = WSP(float, WS_MOD);
    float* Xs = dry ? WSP(float, WS_XE) : WSP(float, WS_X); bf16* H2 = dry ? WSP(bf16, WS_XE) : WSP(bf16, WS_H2);
    float* AFF = dry ? WSP(float, WS_XE) : WSP(float, WS_AFF); int* INV = dry ? WSP(int, WS_XE) : WSP(int, WS_INV);
    {
        const f32x4* src = (const f32x4*)(F.in[I_WROUTER] + (size_t)l * 1024 * 16); LAS f32x4* dstl = (LAS f32x4*)F.lds;
        for (int i = TID_; i < 4096; i += NTHREADS) dstl[i] = src[i];
        __syncthreads();
    }
    const LAS float* wbase = (const LAS float*)F.lds + lane * 64;
    auto row_ok = [&](int m) { return m < M && !(l == NL - 1 && (m % T) < CTXL); };
    auto next_row = [&](int m) { m += NGW; while (m < M && !row_ok(m)) m += NGW; return m; };
    int m = gw; if (!row_ok(m)) m = next_row(m);
    f32x4 xn[4], yn[4];
    if (m < M) { const float* xin = (l == 0) ? in_row(F, m / T, m % T) : X + (size_t)m * 1024;
#pragma unroll
        for (int j = 0; j < 4; ++j) { yn[j] = *(const f32x4*)(Y + (size_t)m * 1024 + 256 * j + 4 * lane); xn[j] = *(const f32x4*)(xin + 256 * j + 4 * lane); } }
    for (; m < M; ) { const int b = m / T, t = m % T, r = t < CTXL ? 8 : b;
        const float* md = MOD + (size_t)(l * 9 + r) * 6144;
        f32x4 x[4], y[4], h[4];
#pragma unroll
        for (int j = 0; j < 4; ++j) { x[j] = xn[j]; y[j] = yn[j]; }
        const int mnext = next_row(m);
        if (mnext < M) { const float* xin = (l == 0) ? in_row(F, mnext / T, mnext % T) : X + (size_t)mnext * 1024;
#pragma unroll
            for (int j = 0; j < 4; ++j) { yn[j] = *(const f32x4*)(Y + (size_t)mnext * 1024 + 256 * j + 4 * lane); xn[j] = *(const f32x4*)(xin + 256 * j + 4 * lane); } }
        const float rinv = rsqrtf(row_ss(y) * (1.f / 1024.f) + 1e-6f);
#pragma unroll
        for (int j = 0; j < 4; ++j) { const int e = 256 * j + 4 * lane;
            const f32x4 gg = *(const f32x4*)(F.in[I_GPOSTMIX] + l * 1024 + e), gt = *(const f32x4*)(md + 2 * 1024 + e);
            x[j] = x[j] + gt * (y[j] * rinv * gg); *(f32x4*)(Xs + (size_t)m * 1024 + e) = x[j]; }
        const float rinv2 = rsqrtf(row_ss(x) * (1.f / 1024.f) + 1e-6f);
        mod_store(x, rinv2, F.in[I_GPREFFN] + l * 1024, md + 3 * 1024, md + 4 * 1024, H2 + (size_t)m * 1024, lane, h);
        float lg[16];
#pragma unroll
        for (int k = 0; k < 16; ++k) lg[k] = 0.f;
#pragma unroll
        for (int j = 0; j < 4; ++j)
#pragma unroll
            for (int c = 0; c < 4; ++c) { const LAS float* w = wbase + j * 4096 + c * 16; const float hv = h[j][c];
#pragma unroll
                for (int q = 0; q < 4; ++q) { const f32x4 wv = *(const LAS f32x4*)(w + 4 * q); lg[4 * q + 0] += hv * wv[0]; lg[4 * q + 1] += hv * wv[1]; lg[4 * q + 2] += hv * wv[2]; lg[4 * q + 3] += hv * wv[3]; }
                asm volatile("" ::: "memory"); }
        float mx = -1e30f;
#pragma unroll
        for (int k = 0; k < 16; ++k) { lg[k] = wave_sum(lg[k]); mx = fmaxf(mx, lg[k]); }
        float den = 0.f, mine = 0.f;
#pragma unroll
        for (int k = 0; k < 16; ++k) { const float ex = expf(lg[k] - mx); den += ex; if ((lane & 15) == k) mine = ex; }
        if (lane < 16) { AFF[(size_t)m * 16 + lane] = mine / den; INV[(size_t)m * 16 + lane] = -1; }
        m = mnext;
    }
}
__device__ __forceinline__ void phase_row2(Frame& F, int l, bool dry = false) {
    const int gw = F.vcu * NWAVES + F.wave, NGW = F.G * NWAVES, lane = LANE_;
    const float* X = WSP(float, WS_X); const bf16* OUTE = WSP(bf16, WS_OUTE); const float* MOD = WSP(float, WS_MOD);
    float* Xs = dry ? WSP(float, WS_XE) : WSP(float, WS_X); bf16* H = dry ? WSP(bf16, WS_XE) : WSP(bf16, WS_H); float* outp = dry ? WSP(float, WS_XE) : F.out;
    const int* INV = WSP(int, WS_INV);
    const bool last = (l == NL - 1);
    const float tp_scale = 1.f;
    auto row_ok = [&](int m) { return m < M && !(last && (m % T) < CTXL); };
    auto next_row = [&](int m) { m += NGW; while (m < M && !row_ok(m)) m += NGW; return m; };
    int m = gw; if (!row_ok(m)) m = next_row(m);
    f32x4 xn[4]; int invn = -1;
    if (m < M) { invn = INV[(size_t)m * 16 + (lane & 15)];
#pragma unroll
        for (int j = 0; j < 4; ++j) xn[j] = *(const f32x4*)(X + (size_t)m * 1024 + 256 * j + 4 * lane); }
    for (; m < M; ) { const int b = m / T, t = m % T, r = t < CTXL ? 8 : b;
        const float* md = MOD + (size_t)(l * 9 + r) * 6144;
        f32x4 x[4], f[4], h[4];
#pragma unroll
        for (int j = 0; j < 4; ++j) { x[j] = xn[j]; f[j] = (f32x4){0.f, 0.f, 0.f, 0.f}; }
        const int invl = invn;
        const int mnext = next_row(m);
        if (mnext < M) { invn = INV[(size_t)mnext * 16 + (lane & 15)];
#pragma unroll
            for (int j = 0; j < 4; ++j) xn[j] = *(const f32x4*)(X + (size_t)mnext * 1024 + 256 * j + 4 * lane); }
        for (int e = 0; e < 16; ++e) { const int rr = __shfl(invl, e);
            if (rr >= 0) {
#pragma unroll
                for (int j = 0; j < 4; ++j) { const u32x2 w = *(const u32x2*)(OUTE + (size_t)rr * 1024 + 256 * j + 4 * lane);
                    f[j][0] += bflo(w.x); f[j][1] += bfhi(w.x); f[j][2] += bflo(w.y); f[j][3] += bfhi(w.y); } } }
        const float rinv = rsqrtf(row_ss(f) * (1.f / 1024.f) + 1e-6f);
#pragma unroll
        for (int j = 0; j < 4; ++j) { const int e = 256 * j + 4 * lane;
            const f32x4 gg = *(const f32x4*)(F.in[I_GPOSTFFN] + l * 1024 + e), gt = *(const f32x4*)(md + 5 * 1024 + e);
            x[j] = x[j] + gt * (f[j] * rinv * gg);
            if (last) *(f32x4*)(outp + ((size_t)b * SEQ + (t - CTXL)) * 1024 + e) = x[j] * tp_scale;
            else *(f32x4*)(Xs + (size_t)m * 1024 + e) = x[j]; }
        if (!last) {
            const float rinv2 = rsqrtf(row_ss(x) * (1.f / 1024.f) + 1e-6f);
            const float* md2 = MOD + (size_t)((l + 1) * 9 + r) * 6144;
            mod_store(x, rinv2, F.in[I_GPREMIX] + (l + 1) * 1024, md2, md2 + 1024, H + (size_t)m * 1024, lane, h);
        }
        m = mnext;
    }
}

__device__ __forceinline__ void phase_qkprep(Frame& F, int l, bool dry = false) {
    const int gw = F.vcu * NWAVES + F.wave, NGW = F.G * NWAVES, lane = LANE_;
    bf16* QKV = WSP(bf16, WS_QKV); bf16* QO = dry ? WSP(bf16, WS_YD) : QKV;
    const float qg = F.in[I_QGAIN][l * 64 + lane] * C2, kg = F.in[I_KGAIN][l * 64 + lane];
    const int i16 = lane & 15; const bool second = (lane & 16) != 0, colseg = (lane & 32) != 0;
    const float inv = exp2f(-(float)i16 * (13.287712379549449f / 16.f));
    for (int m = gw; m < M; m += NGW) { const int t = m % T; const bool ctx = t < CTXL;
        const int s0 = (l == NL - 1 && ctx) ? 8 : 0;
        const bf16* p = QKV + (size_t)m * 1536 + lane; bf16* po = QO + (size_t)m * 1536 + lane;
        float x[10];
#pragma unroll
        for (int s = 0; s < 10; ++s) x[s] = (s >= s0) ? bf2f(p[s * 64]) : 0.f;
        float cs = 1.f, sn = 0.f;
        if (!ctx) { const int pos = t - CTXL; const float ang = (float)(colseg ? (pos & 63) : (pos >> 6)) * inv; cs = cosf(ang); sn = sinf(ang); if (!second) sn = -sn; }
#pragma unroll
        for (int s = 0; s < 10; ++s) {
            if (s < s0) continue;
            const float ss = wave_sum(x[s] * x[s]);
            float y = x[s] * __builtin_amdgcn_rsqf(ss * (1.f / 64.f) + 1e-6f) * (s < 8 ? qg : kg);
            const float other = __shfl_xor(y, 16);
            y = y * cs + other * sn;
            po[s * 64] = (bf16)f2bf(y);
        }
    }
}
#include <hip/hip_bf16.h>
#include <cmath>
namespace attn_body {
using bf16=__hip_bfloat16;
using bf16x8=__attribute__((ext_vector_type(8)))short;
using s16x4=__attribute__((ext_vector_type(4)))short;
using f32x16=__attribute__((ext_vector_type(16)))float;
using u32x4=__attribute__((ext_vector_type(4)))unsigned;
constexpr int D=64,QP=1536,OP=1024;
constexpr int NW=8,QBLK=32,QB=QBLK*NW,KVBLK=64;
__device__ __forceinline__ int crow(int r,int hi){return (r&3)+8*(r>>2)+4*hi;}
#define SBAR() __builtin_amdgcn_sched_barrier(0)
constexpr int NSLOT=3, SLOTB=8192;
constexpr int LDS_K=0, LDS_V=NSLOT*SLOTB, LDS_WS=2*NSLOT*SLOTB, LDS_OST=LDS_WS+NW*64*4, LDS_RPB=LDS_OST+NW*4096, LDS_BYTES=LDS_RPB+3072;
constexpr float C2=0.125f*1.4426950408889634f;
__device__ __forceinline__ void glds16(const void*gsrc,unsigned lds_dst){unsigned keep;
  asm volatile("s_mov_b32 %0, m0\n\ts_mov_b32 m0, %2\n\ts_nop 0\n\tglobal_load_lds_dwordx4 %1, off\n\ts_mov_b32 m0, %0":"=&s"(keep):"v"(gsrc),"s"(lds_dst):"memory");}
__device__ __forceinline__ float max3f(float a,float b,float c){float r;asm("v_max3_f32 %0, %1, %2, %3":"=v"(r):"v"(a),"v"(b),"v"(c));return r;}
__device__ __forceinline__ float max2f(float a,float b){float r;asm("v_max_f32_e32 %0, %1, %2":"=v"(r):"v"(a),"v"(b));return r;}
__device__ __forceinline__ float fadd_s(float a,float b){float r;asm("v_add_f32_e32 %0, %1, %2":"=v"(r):"v"(a),"v"(b));return r;}
__device__ __forceinline__ float fsub_s(float a,float b){float r;asm("v_sub_f32_e32 %0, %1, %2":"=v"(r):"v"(a),"v"(b));return r;}
typedef float f32x2_t __attribute__((ext_vector_type(2))); typedef __bf16 bf16x2_t __attribute__((ext_vector_type(2)));
__device__ __forceinline__ unsigned cvtpk_s(float lo,float hi){f32x2_t v={lo,hi};bf16x2_t b=__builtin_convertvector(v,bf16x2_t);return __builtin_bit_cast(unsigned,b);}
#define WAIT_BAR(N) asm volatile("s_waitcnt vmcnt(" #N ") lgkmcnt(0)\n\ts_barrier":::"memory")

__device__ __forceinline__ void qkt(f32x16&p0,f32x16&p1,const char*Kslot,const bf16x8*qr,const f32x16&negm,int r32,int hi){
  const char*kb=Kslot+hi*1024+r32*16;
  #pragma unroll
  for(int d0=0;d0<4;++d0){
    const bf16x8 b0=*reinterpret_cast<const bf16x8*>(kb+d0*2048);
    const bf16x8 b1=*reinterpret_cast<const bf16x8*>(kb+d0*2048+512);
    if(d0==0){p0=__builtin_amdgcn_mfma_f32_32x32x16_bf16(b0,qr[0],negm,0,0,0);p1=__builtin_amdgcn_mfma_f32_32x32x16_bf16(b1,qr[0],negm,0,0,0);}
    else{p0=__builtin_amdgcn_mfma_f32_32x32x16_bf16(b0,qr[d0],p0,0,0,0);p1=__builtin_amdgcn_mfma_f32_32x32x16_bf16(b1,qr[d0],p1,0,0,0);}}
}
typedef __attribute__((address_space(3))) const char* lds_cptr;
typedef short v4i16_t __attribute__((ext_vector_type(4)));
__device__ __forceinline__ void kload8(bf16x8*kf,lds_cptr kp){
  kf[0]=*(const __attribute__((address_space(3))) bf16x8*)(kp);      kf[1]=*(const __attribute__((address_space(3))) bf16x8*)(kp+512);
  kf[2]=*(const __attribute__((address_space(3))) bf16x8*)(kp+2048); kf[3]=*(const __attribute__((address_space(3))) bf16x8*)(kp+2560);
  kf[4]=*(const __attribute__((address_space(3))) bf16x8*)(kp+4096); kf[5]=*(const __attribute__((address_space(3))) bf16x8*)(kp+4608);
  kf[6]=*(const __attribute__((address_space(3))) bf16x8*)(kp+6144); kf[7]=*(const __attribute__((address_space(3))) bf16x8*)(kp+6656);
}
__device__ __forceinline__ void kload2(bf16x8*kf,lds_cptr kp,int j){ kf[2*j]=*(const __attribute__((address_space(3))) bf16x8*)(kp+j*2048); kf[2*j+1]=*(const __attribute__((address_space(3))) bf16x8*)(kp+j*2048+512); }
__device__ __forceinline__ s16x4 vtr(lds_cptr p){ return __builtin_bit_cast(s16x4,__builtin_amdgcn_ds_read_tr16_b64_v4i16((__attribute__((address_space(3))) v4i16_t*)p)); }
__device__ __forceinline__ float rowmax(const f32x16&p0,const f32x16&p1){
  float a=max3f(p0[0],p0[1],p1[0]),b=max3f(p0[2],p0[3],p1[1]);a=max3f(a,p1[2],p1[3]);
  #pragma unroll
  for(int r=4;r<16;r+=4){a=max3f(a,p0[r],p0[r+1]);b=max3f(b,p0[r+2],p0[r+3]);a=max3f(a,p1[r],p1[r+1]);b=max3f(b,p1[r+2],p1[r+3]);}
  const float m=max2f(a,b);
  auto rr=__builtin_amdgcn_permlane32_swap(__float_as_uint(m),__float_as_uint(m),false,false);
  return max2f(__uint_as_float(rr[0]),__uint_as_float(rr[1]));
}
__device__ __forceinline__ void pv(f32x16*o,int vb,bf16x8 pa0,bf16x8 pa1,bf16x8 pa2,bf16x8 pa3){
  #pragma unroll
  for(int d0=0;d0<2;++d0){s16x4 lo[4],hi[4];
    #pragma unroll
    for(int ks=0;ks<4;++ks){
      asm volatile("ds_read_b64_tr_b16 %0,%1 offset:%c2":"=&v"(lo[ks]):"v"(vb),"i"(d0*4096+ks*1024):"memory");
      asm volatile("ds_read_b64_tr_b16 %0,%1 offset:%c2":"=&v"(hi[ks]):"v"(vb),"i"(d0*4096+ks*1024+512):"memory");}
    asm volatile("s_waitcnt lgkmcnt(0)":::"memory");SBAR();
    #define PK(k) (bf16x8){lo[k][0],lo[k][1],lo[k][2],lo[k][3],hi[k][0],hi[k][1],hi[k][2],hi[k][3]}
    o[d0]=__builtin_amdgcn_mfma_f32_32x32x16_bf16(pa0,PK(0),o[d0],0,0,0);
    o[d0]=__builtin_amdgcn_mfma_f32_32x32x16_bf16(pa1,PK(1),o[d0],0,0,0);
    o[d0]=__builtin_amdgcn_mfma_f32_32x32x16_bf16(pa2,PK(2),o[d0],0,0,0);
    o[d0]=__builtin_amdgcn_mfma_f32_32x32x16_bf16(pa3,PK(3),o[d0],0,0,0);
    #undef PK
  }
}

#ifndef ATTN_STORE16
#define ATTN_STORE16(p,v) (*(u32x4*)(p)=(v))
#endif
template<int THRL,bool WIN> __device__ __forceinline__ void attn_unit(const bf16*Qw0,const bf16*__restrict__ Kh,const bf16*__restrict__ Vh,bf16*Ow0,const int NT,const int toff,const int rb,const int rs0,const float*rpbh,char*shm){
  int tid_=threadIdx.x; asm volatile("":"+v"(tid_));
  const int tid=tid_,lane=tid&63,r32=lane&31,hi=lane>>5; const int wid=__builtin_amdgcn_readfirstlane(tid>>6);
  const bf16*Qw=Qw0+(long)(wid*QBLK)*QP;
  const unsigned lds0=(unsigned)(uintptr_t)shm;
  float*wsf=(float*)(shm+LDS_WS)+wid*64;
  const bf16*ksrc=Kh+(long)lane*QP+wid*8;
  const bf16*vsrc=Vh+(long)(16*(wid&3)+(lane>>2))*QP+(wid>>2)*32+(lane&3)*8;
  const unsigned kdst=lds0+LDS_K+wid*1024, vdst=lds0+LDS_V+wid*1024;
  #define TROW(t) ((long)(((t)+(((t)>=4)?toff:0))*KVBLK)*QP)
  #define DMA_K(t,slot) glds16(ksrc+TROW(t),(unsigned)__builtin_amdgcn_readfirstlane(kdst+(slot)))
  #define DMA_V(t,slot) glds16(vsrc+TROW(t),(unsigned)__builtin_amdgcn_readfirstlane(vdst+(slot)))
  const int vb0=(int)(lds0+LDS_V)+((lane>>4)&1)*32+(lane&3)*8+(4*hi+((lane&15)>>2))*64;
  const char*Kbase=shm+LDS_K; bf16x8 kf[8];
  const lds_cptr shm3=(lds_cptr)shm; const lds_cptr kp0=shm3+LDS_K+hi*1024+r32*16; const lds_cptr vp0=shm3+LDS_V+((lane>>4)&1)*32+(lane&3)*8+(4*hi+((lane&15)>>2))*64;
  DMA_K(0,0);DMA_V(0,0);DMA_K(1,SLOTB);
  bf16x8 qr[4];
  #pragma unroll
  for(int d0=0;d0<4;++d0)qr[d0]=*reinterpret_cast<const bf16x8*>(&Qw[(long)r32*QP+d0*16+hi*8]);
  float mhat=0.f,l_reg=0.f;f32x16 o[2];o[0]=f32x16{};o[1]=f32x16{};f32x16 negm=f32x16{};asm volatile("":"+v"(negm));
  const int gr=4*rb+(wid>>1), gc=(wid&1)*32+r32, rsq=min(max(gr-4,0),24), csq=min(max(gc-8,0),48);
  const float*rpbl=(const float*)(shm+LDS_RPB+256)+(15-gc+4*hi);
  const int kcb=4*hi-csq;
  if(WIN){ for(int i_=tid;i_<15*31;i_+=512)((float*)(shm+LDS_RPB+256))[i_]=rpbh[i_]*1.4426950408889634f; }
  #define CMASK(P0,P1,t) do{ if(WIN && (t)>=4){ const int kr_=rs0+(t)-4; const bool rowok_=(kr_>=rsq)&&(kr_<rsq+8); \
      if(!rowok_){ _Pragma("unroll") for(int r=0;r<16;++r){P0[r]=-INFINITY;P1[r]=-INFINITY;} } \
      else { const float*bp_=rpbl+(kr_-gr+7)*31; \
        _Pragma("unroll") for(int r=0;r<16;++r){ const int o_=(r&3)+8*(r>>2); \
          const float b0_=bp_[o_], b1_=bp_[o_+32]; \
          P0[r]=((unsigned)(kcb+o_)<16u)?P0[r]+b0_:-INFINITY; P1[r]=((unsigned)(kcb+o_+32)<16u)?P1[r]+b1_:-INFINITY; } } } }while(0)
  bool resc=false;
  #define START(P0,P1) do{ const float rm=rowmax(P0,P1); resc=false; \
    { const float dl=rm; mhat=fadd_s(mhat,dl); \
      _Pragma("unroll") for(int r=0;r<16;++r){P0[r]=fsub_s(P0[r],dl);P1[r]=fsub_s(P1[r],dl);} \
      _Pragma("unroll") for(int r=0;r<16;++r)negm[r]=-mhat; asm volatile("":"+v"(negm)); } \
    _Pragma("unroll") for(int r=0;r<16;++r)P0[r]=__builtin_amdgcn_exp2f(P0[r]); }while(0)
  #define RESC() do{ if(resc){ asm volatile("s_waitcnt lgkmcnt(0)":::"memory"); \
      _Pragma("unroll") for(int d_=0;d_<2;++d_) _Pragma("unroll") for(int r=0;r<16;++r)o[d_][r]*=wsf[crow(r,hi)]; } }while(0)
  f32x16 pA0,pA1,pB0,pB1;
  int sl_prev=0,sl_cur=0,sl_next=SLOTB;
  #define ROT() do{sl_prev=sl_cur;sl_cur=sl_next;sl_next=(sl_next==(NSLOT-1)*SLOTB)?0:sl_next+SLOTB;}while(0)
  DMA_K(2,2*SLOTB);
  WAIT_BAR(3);
  qkt(pA0,pA1,Kbase,qr,negm,r32,hi);asm volatile("s_nop 15\n\ts_nop 7":"+v"(pA0),"+v"(pA1));CMASK(pA0,pA1,0);
  START(pA0,pA1);
  _Pragma("unroll") for(int r=0;r<16;++r)pA1[r]=__builtin_amdgcn_exp2f(pA1[r]);
  WAIT_BAR(0);
  DMA_K(3,0);DMA_V(1,SLOTB);
  ROT();
  kload8(kf,kp0+sl_cur);
  WAIT_BAR(2);
  s16x4 vlo[8],vhi[8]; u32x4 pw0,pw1,pw2,pw3;
  #define PKW(P,B) cvtpk_s(P[B],P[B+1])
  #define PAF(k) __builtin_bit_cast(bf16x8,pw##k)
  #define VFR(i) (bf16x8){vlo[i][0],vlo[i][1],vlo[i][2],vlo[i][3],vhi[i][0],vhi[i][1],vhi[i][2],vhi[i][3]}
  #define PIN(x) asm volatile("":"+v"(x))
  #define MX3(a,b,c) __builtin_fmaxf(__builtin_fmaxf((a),(b)),(c))
  #define GAPA(MF,A0,A1,A2,A3,W0,W1,PW) do{ MF; sacc+=A0; sacc+=A1; sacc+=A2; sacc+=A3; PIN(sacc); W0; W1; PIN(PW); SBAR(); }while(0)
  #define EX(v) __builtin_amdgcn_exp2f(v)
  #define GAPB(MF,X,B) do{ MF; X[B]=EX(X[B]); X[B+1]=EX(X[B+1]); X[B+2]=EX(X[B+2]); X[B+3]=EX(X[B+3]); PIN(X); SBAR(); }while(0)
  #define VRD(i) do{ vlo[i]=vtr(vp_+(((i)>>2)*4096+((i)&3)*1024)); vhi[i]=vtr(vp_+(((i)>>2)*4096+((i)&3)*1024+512)); }while(0)
  #define KRD(G,j) do{ if(G){ kload2(kf,kp0+sl_next,j); SBAR(); } }while(0)
  #define STEP(C0,C1,P0,P1,t,GK,GV,GL) do{ SBAR(); \
    const lds_cptr vp_=vp0+sl_prev; \
    VRD(0); SBAR(); float sacc=(P0[0]+P0[1]); \
    GAPA(C0=__builtin_amdgcn_mfma_f32_32x32x16_bf16(kf[0],qr[0],negm,0,0,0), P0[2],P0[3],P0[4],P0[5],     pw0[0]=PKW(P0,0), pw0[1]=PKW(P0,2), pw0); \
    VRD(4); SBAR(); GAPA(C1=__builtin_amdgcn_mfma_f32_32x32x16_bf16(kf[1],qr[0],negm,0,0,0), P0[6],P0[7],P0[8],P0[9],     pw0[2]=PKW(P0,4), pw0[3]=PKW(P0,6), pw0); \
    VRD(1); SBAR(); GAPA(C0=__builtin_amdgcn_mfma_f32_32x32x16_bf16(kf[2],qr[1],C0,0,0,0),   P0[10],P0[11],P0[12],P0[13], pw1[0]=PKW(P0,8), pw1[1]=PKW(P0,10), pw1); \
    VRD(5); SBAR(); GAPA(C1=__builtin_amdgcn_mfma_f32_32x32x16_bf16(kf[3],qr[1],C1,0,0,0),   P0[14],P0[15],P1[0],P1[1],   pw1[2]=PKW(P0,12),pw1[3]=PKW(P0,14), pw1); \
    VRD(2); SBAR(); GAPA(C0=__builtin_amdgcn_mfma_f32_32x32x16_bf16(kf[4],qr[2],C0,0,0,0),   P1[2],P1[3],P1[4],P1[5],     pw2[0]=PKW(P1,0), pw2[1]=PKW(P1,2), pw2); \
    VRD(6); SBAR(); GAPA(C1=__builtin_amdgcn_mfma_f32_32x32x16_bf16(kf[5],qr[2],C1,0,0,0),   P1[6],P1[7],P1[8],P1[9],     pw2[2]=PKW(P1,4), pw2[3]=PKW(P1,6), pw2); \
    VRD(3); SBAR(); GAPA(C0=__builtin_amdgcn_mfma_f32_32x32x16_bf16(kf[6],qr[3],C0,0,0,0),   P1[10],P1[11],P1[12],P1[13], pw3[0]=PKW(P1,8), pw3[1]=PKW(P1,10), pw3); \
    VRD(7); SBAR(); GAPA(C1=__builtin_amdgcn_mfma_f32_32x32x16_bf16(kf[7],qr[3],C1,0,0,0),   P1[14],P1[15],0.f,0.f,       pw3[2]=PKW(P1,12),pw3[3]=PKW(P1,14), pw3); \
    l_reg+=sacc; \
    if(GK){DMA_K((t)+3,sl_cur);} if(GV){DMA_V((t)+1,sl_next);} \
    CMASK(C0,C1,t); \
    { float a=MX3(C0[0],C0[1],C1[0]),b=MX3(C0[2],C0[3],C1[1]); a=MX3(a,C1[2],C1[3]); \
      _Pragma("unroll") for(int r=4;r<16;r+=4){a=MX3(a,C0[r],C0[r+1]);b=MX3(b,C0[r+2],C0[r+3]);a=MX3(a,C1[r],C1[r+1]);b=MX3(b,C1[r+2],C1[r+3]);} \
      float rm=__builtin_fmaxf(a,b); { auto rr=__builtin_amdgcn_permlane32_swap(__float_as_uint(rm),__float_as_uint(rm),false,false); rm=__builtin_fmaxf(__uint_as_float(rr[0]),__uint_as_float(rr[1])); } \
      resc=false; \
      if(__builtin_expect(__any(rm>(float)THRL),0)){ const float dl=__builtin_fmaxf(rm,0.f); mhat+=dl; \
        _Pragma("unroll") for(int r=0;r<16;++r){C0[r]-=dl;C1[r]-=dl;} \
        _Pragma("unroll") for(int r=0;r<16;++r)negm[r]=-mhat; asm volatile("":"+v"(negm)); \
        const float f=__builtin_amdgcn_exp2f(-dl); l_reg*=f; if(hi==0)wsf[r32]=f; resc=true; } } \
    SBAR(); \
    GAPB(o[0]=__builtin_amdgcn_mfma_f32_32x32x16_bf16(PAF(0),VFR(0),o[0],0,0,0), C0,0); \
    GAPB(o[1]=__builtin_amdgcn_mfma_f32_32x32x16_bf16(PAF(0),VFR(4),o[1],0,0,0), C0,4); \
    KRD(GL,0); GAPB(o[0]=__builtin_amdgcn_mfma_f32_32x32x16_bf16(PAF(1),VFR(1),o[0],0,0,0), C0,8); \
    KRD(GL,1); GAPB(o[1]=__builtin_amdgcn_mfma_f32_32x32x16_bf16(PAF(1),VFR(5),o[1],0,0,0), C0,12); \
    KRD(GL,2); GAPB(o[0]=__builtin_amdgcn_mfma_f32_32x32x16_bf16(PAF(2),VFR(2),o[0],0,0,0), C1,0); \
    KRD(GL,3); GAPB(o[1]=__builtin_amdgcn_mfma_f32_32x32x16_bf16(PAF(2),VFR(6),o[1],0,0,0), C1,4); \
    GAPB(o[0]=__builtin_amdgcn_mfma_f32_32x32x16_bf16(PAF(3),VFR(3),o[0],0,0,0), C1,8); \
    GAPB(o[1]=__builtin_amdgcn_mfma_f32_32x32x16_bf16(PAF(3),VFR(7),o[1],0,0,0), C1,12); \
    }while(0)
  int t=1;
  for(;t+5<NT;t+=2){
    STEP(pB0,pB1,pA0,pA1,t,true,true,true);     WAIT_BAR(2); RESC(); ROT();
    STEP(pA0,pA1,pB0,pB1,t+1,true,true,true);   WAIT_BAR(2); RESC(); ROT();
  }
  #define ENDW(tt) do{ if((tt)+3<NT){WAIT_BAR(2);} else if((tt)+2<NT){WAIT_BAR(1);} else {WAIT_BAR(0);} }while(0)
  for(;t+1<NT;t+=2){
    STEP(pB0,pB1,pA0,pA1,t,(t+3<NT),(t+1<NT),(t+1<NT));       ENDW(t);   RESC(); ROT();
    STEP(pA0,pA1,pB0,pB1,t+1,(t+4<NT),(t+2<NT),(t+2<NT));     ENDW(t+1); RESC(); ROT();
  }
  STEP(pB0,pB1,pA0,pA1,NT-1,false,false,false); RESC();
  { float sacc=pB0[0]+pB0[1]; _Pragma("unroll") for(int r=2;r<16;++r)sacc+=pB0[r]; _Pragma("unroll") for(int r=0;r<16;++r)sacc+=pB1[r]; l_reg+=sacc;
    pw0=(u32x4){PKW(pB0,0),PKW(pB0,2),PKW(pB0,4),PKW(pB0,6)};pw1=(u32x4){PKW(pB0,8),PKW(pB0,10),PKW(pB0,12),PKW(pB0,14)};pw2=(u32x4){PKW(pB1,0),PKW(pB1,2),PKW(pB1,4),PKW(pB1,6)};pw3=(u32x4){PKW(pB1,8),PKW(pB1,10),PKW(pB1,12),PKW(pB1,14)};
    SBAR(); pv(o,vb0+sl_cur,PAF(0),PAF(1),PAF(2),PAF(3)); }
  #undef PKW
  #undef PAF
  #undef VFR
  #undef PIN
  #undef MX3
  #undef GAPA
  #undef GAPB
  #undef EX
  #undef VRD
  #undef KRD
  #undef STEP
  #undef ENDW
  {auto rr=__builtin_amdgcn_permlane32_swap(__float_as_uint(l_reg),__float_as_uint(l_reg),false,false);l_reg=__uint_as_float(rr[0])+__uint_as_float(rr[1]);}
  if(hi==0)wsf[32+r32]=l_reg;asm volatile("s_waitcnt lgkmcnt(0)":::"memory");
  float rli[16];
  #pragma unroll
  for(int r=0;r<16;++r)rli[r]=__builtin_amdgcn_rcpf(wsf[32+crow(r,hi)]);
  bf16*Ow=Ow0+(long)(wid*QBLK)*OP;
  { bf16*stg=(bf16*)(shm+LDS_OST)+wid*2048;
    #pragma unroll
    for(int r=0;r<16;++r){const int orow=crow(r,hi);
      #pragma unroll
      for(int d0=0;d0<2;++d0)stg[orow*64+d0*32+r32]=__float2bfloat16(o[d0][r]*rli[r]);}
    asm volatile("s_waitcnt lgkmcnt(0)":::"memory");
    #pragma unroll
    for(int i=0;i<4;++i){const int row=i*8+(lane>>3),ch=lane&7; const u32x4 v=*(const u32x4*)(stg+row*64+ch*8); ATTN_STORE16(Ow+(long)row*OP+ch*8,v);} }
  asm volatile("s_waitcnt lgkmcnt(0)\n\ts_barrier":::"memory");
  #undef DMA_K
  #undef TROW
  #undef DMA_V
  #undef CMASK
  #undef START
  #undef RESC
  #undef ROT
}
constexpr int ATTN_LDS_BYTES=LDS_BYTES;
#undef SBAR
#undef WAIT_BAR
}
typedef float f32x2 __attribute__((ext_vector_type(2)));
__device__ __forceinline__ int scan_tok(int p, int dir) { return p < CTXL ? (dir ? CTXL - 1 - p : p) : (dir ? (T + CTXL - 1) - p : p); }

constexpr int CS_NCH = T / 16;
constexpr size_t WS_W1F = WS_H;
typedef float f32x16 __attribute__((ext_vector_type(16)));
typedef __bf16 bf16x2_t __attribute__((ext_vector_type(2)));
__device__ __forceinline__ unsigned cvtpk(float lo, float hi) { f32x2 v = {lo, hi}; bf16x2_t b = __builtin_convertvector(v, bf16x2_t); return __builtin_bit_cast(unsigned, b); }
__device__ __forceinline__ bf16x8 pack8f(float a0, float a1, float a2, float a3, float a4, float a5, float a6, float a7) {
    u32x4 w; w.x = cvtpk(a0, a1); w.y = cvtpk(a2, a3); w.z = cvtpk(a4, a5); w.w = cvtpk(a6, a7); return __builtin_bit_cast(bf16x8, w);
}
#define MF4(a, b, c) __builtin_amdgcn_mfma_f32_16x16x4f32((a), (b), (c), 0, 0, 0)

constexpr int PB_BK = 0, PB_AR = 4608, PB_CM = 9216, PB_EM = PB_CM + 16 * 17 * 4, PB_TM = PB_EM + 16 * 20 * 4, PB_P15 = PB_TM + 16 * 20 * 4, PB_BYTES = PB_P15 + 256;
constexpr int PBS = 72;
static_assert(8 * PB_BYTES <= RING_BYTES, "pre-pass LDS");
struct PPIn { float rr[16], kb[16], ww[16], as[16]; };
__device__ __forceinline__ void prepass_load(Frame& F, PPIn& I, int rec, int lane) {
    const int ch = rec / CS_NCH, c = rec % CS_NCH, b = ch >> 3, h = (ch >> 1) & 3, dir = ch & 1;
    const float* R32 = WSP(float, WS_R32); const float* DEC = WSP(float, WS_DEC) + (size_t)dir * M * 256; const float* ASIG = WSP(float, WS_ASIG) + (size_t)dir * M * 256;
    const int t0 = scan_tok(c * 16, dir); const int stp = dir ? -1 : 1;
#pragma unroll
    for (int t = 0; t < 16; ++t) { const size_t m = (size_t)b * T + (t0 + stp * t);
        I.rr[t] = R32[m * 768 + h * 64 + lane]; I.kb[t] = R32[m * 768 + 256 + h * 64 + lane]; I.ww[t] = DEC[m * 256 + h * 64 + lane]; I.as[t] = ASIG[m * 256 + h * 64 + lane]; }
}
__device__ __forceinline__ float bfu(unsigned short v) { return __builtin_bit_cast(float, (unsigned)v << 16); }
__device__ __forceinline__ void prepass_record(Frame& F, int l, int rec, LAS unsigned char* L, int lane, const PPIn& I) {
    const int ch = rec / CS_NCH, h = (ch >> 1) & 3;
    const int c = lane & 31, hh = lane >> 5;
    bf16* W1F = WSP(bf16, WS_W1F) + (size_t)rec * 2048; bf16* W2F = (bf16*)F.out + (size_t)rec * 3200; float* P15F = F.out + (size_t)rec * 1600 + 1536;
    LAS bf16* BK = (LAS bf16*)(L + PB_BK); LAS bf16* AR = (LAS bf16*)(L + PB_AR);
    LAS float* Cm = (LAS float*)(L + PB_CM); LAS float* Em = (LAS float*)(L + PB_EM); LAS float* Tm = (LAS float*)(L + PB_TM); LAS float* P15 = (LAS float*)(L + PB_P15);
    {
        const float kkw = F.in[I_KK][l * 256 + h * 64 + lane], kaw = F.in[I_KA][l * 256 + h * 64 + lane];
        float P = 1.f;
#pragma unroll
        for (int t = 0; t < 16; ++t) {
            const float r_ = I.rr[t], kb_ = I.kb[t], w_ = I.ww[t], as_ = I.as[t];
            float kk_ = kb_ * kkw; kk_ = kk_ * __builtin_amdgcn_rsqf(fmaxf(wave_sum(kk_ * kk_), 1e-24f));
            const float kd_ = kb_ * (1.f + (as_ - 1.f) * kaw);
            const float Pm = P; P *= w_; const float iP = __builtin_amdgcn_rcpf(P);
            AR[t * PBS + lane] = (bf16)f2bf(-kk_ * Pm); AR[(16 + t) * PBS + lane] = (bf16)f2bf(r_ * P);
            BK[t * PBS + lane] = (bf16)f2bf(kk_ * as_ * iP); BK[(16 + t) * PBS + lane] = (bf16)f2bf(kd_ * iP);
        }
        P15[lane] = P;
    }
    LDS_WAIT(); asm volatile("" ::: "memory");
#pragma unroll
    for (int ks = 0; ks < 4; ++ks) {
        const LAS bf16* src = AR + c * PBS + 16 * ks + 4 * hh;
        const u32x2 lo = *(const LAS u32x2*)src, hi = *(const LAS u32x2*)(src + 8);
        *(u32x4*)(W1F + (ks * 64 + lane) * 8) = (u32x4){lo.x, lo.y, hi.x, hi.y};
    }
    f32x16 Gm;
#pragma unroll
    for (int r = 0; r < 16; ++r) Gm[r] = 0.f;
#pragma unroll
    for (int ks = 0; ks < 4; ++ks)
        Gm = __builtin_amdgcn_mfma_f32_32x32x16_bf16(*(const LAS bf16x8*)(BK + c * PBS + 16 * ks + 8 * hh), *(const LAS bf16x8*)(AR + c * PBS + 16 * ks + 8 * hh), Gm, 0, 0, 0);
    {
        const int t = c & 15;
#pragma unroll
        for (int r = 0; r < 16; ++r) { const int s = (r & 3) + 8 * ((r & 7) >> 2) + 4 * hh; const bool keep = (c < 16) ? (s < t) : (s <= t); if (!keep) Gm[r] = 0.f; }
        if (c < 16) {
#pragma unroll
            for (int r = 0; r < 8; ++r) { const int s = (r & 3) + 8 * (r >> 2) + 4 * hh; Cm[s * 17 + t] = Gm[r]; Em[s * 20 + t] = Gm[8 + r]; }
        }
    }
    LDS_WAIT(); asm volatile("" ::: "memory");
    {
        const int rho = lane & 15;
        float x[16];
#pragma unroll
        for (int t = 0; t < 16; ++t) { float acc = (rho == t) ? 1.f : 0.f;
#pragma unroll
            for (int s = 0; s < t; ++s) acc += x[s] * Cm[s * 17 + t];
            x[t] = acc; }
        if (lane < 16) {
#pragma unroll
            for (int q = 0; q < 4; ++q) *(LAS f32x4*)(Tm + rho * 20 + 4 * q) = (f32x4){x[4 * q], x[4 * q + 1], x[4 * q + 2], x[4 * q + 3]}; }
    }
    LDS_WAIT(); asm volatile("" ::: "memory");
    bf16x8 A2;
    {
        float ta[8];
#pragma unroll
        for (int jj = 0; jj < 8; ++jj) ta[jj] = (c < 16) ? Tm[((jj & 3) + 8 * (jj >> 2) + 4 * hh) * 20 + c] : 0.f;
        const bf16x8 Aet = pack8f(ta[0], ta[1], ta[2], ta[3], ta[4], ta[5], ta[6], ta[7]);
        f32x4 e0 = (f32x4){0.f, 0.f, 0.f, 0.f}, e1 = e0, t0 = e0, t1 = e0;
        if (c >= 16) { e0 = *(const LAS f32x4*)(Em + (c - 16) * 20 + 4 * hh); e1 = *(const LAS f32x4*)(Em + (c - 16) * 20 + 8 + 4 * hh); }
        else { t0 = *(const LAS f32x4*)(Tm + c * 20 + 4 * hh); t1 = *(const LAS f32x4*)(Tm + c * 20 + 8 + 4 * hh); }
        const bf16x8 Bet = pack8f(e0[0], e0[1], e0[2], e0[3], e1[0], e1[1], e1[2], e1[3]);
        f32x16 Z;
#pragma unroll
        for (int r = 0; r < 16; ++r) Z[r] = 0.f;
        const f32x16 Dt = __builtin_amdgcn_mfma_f32_32x32x16_bf16(Aet, Bet, Z, 0, 0, 0);
        A2 = (c >= 16) ? pack8f(Dt[0], Dt[1], Dt[2], Dt[3], Dt[4], Dt[5], Dt[6], Dt[7]) : pack8f(t0[0], t0[1], t0[2], t0[3], t1[0], t1[1], t1[2], t1[3]);
    }
    {
        const bf16x8 Bm = pack8f(Gm[0], Gm[1], Gm[2], Gm[3], Gm[4], Gm[5], Gm[6], Gm[7]);
        const bf16x8 Bz = pack8f(0.f, 0.f, 0.f, 0.f, 0.f, 0.f, 0.f, 0.f);
        f32x16 Ci;
#pragma unroll
        for (int r = 0; r < 16; ++r) Ci[r] = (r >= 8 && c >= 16) ? Gm[r] : 0.f;
        const f32x16 Dm = __builtin_amdgcn_mfma_f32_32x32x16_bf16(A2, (c >= 16) ? Bm : Bz, Ci, 0, 0, 0);
        *(bf16x8*)(W2F + (0 * 64 + lane) * 8) = pack8f(Dm[0], Dm[1], Dm[2], Dm[3], Dm[4], Dm[5], Dm[6], Dm[7]);
        *(bf16x8*)(W2F + (1 * 64 + lane) * 8) = pack8f(Dm[8], Dm[9], Dm[10], Dm[11], Dm[12], Dm[13], Dm[14], Dm[15]);
    }
#pragma unroll
    for (int nt = 0; nt < 2; ++nt) {
        float bb[8]; f32x16 Ci;
#pragma unroll
        for (int jj = 0; jj < 8; ++jj) { const int kap = (jj & 3) + 8 * (jj >> 2) + 4 * hh;
            bb[jj] = bfu(BK[kap * PBS + 32 * nt + c]); Ci[jj] = 0.f; Ci[8 + jj] = bfu(BK[(16 + kap) * PBS + 32 * nt + c]); }
        const f32x16 Dn = __builtin_amdgcn_mfma_f32_32x32x16_bf16(A2, pack8f(bb[0], bb[1], bb[2], bb[3], bb[4], bb[5], bb[6], bb[7]), Ci, 0, 0, 0);
        const float p = P15[32 * nt + c];
        *(bf16x8*)(W2F + ((2 + 2 * nt) * 64 + lane) * 8) = pack8f(Dn[0] * p, Dn[1] * p, Dn[2] * p, Dn[3] * p, Dn[4] * p, Dn[5] * p, Dn[6] * p, Dn[7] * p);
        *(bf16x8*)(W2F + ((3 + 2 * nt) * 64 + lane) * 8) = pack8f(Dn[8] * p, Dn[9] * p, Dn[10] * p, Dn[11] * p, Dn[12] * p, Dn[13] * p, Dn[14] * p, Dn[15] * p);
    }
    { const int blk = c >> 4, reg = c & 15; P15F[lane] = P15[32 * blk + (reg & 3) + 8 * (reg >> 2) + 4 * hh]; }
    LDS_WAIT(); asm volatile("" ::: "memory");
}
__device__ __forceinline__ void phase_prepass(Frame& F, int l) {
    int lane = LANE_; asm volatile("" : "+v"(lane));
    LAS unsigned char* L = F.lds + F.wave * PB_BYTES;
    int rec = F.vcu * NWAVES + F.wave; const int stride = F.G * NWAVES;
    PPIn I; if (rec < 64 * CS_NCH) prepass_load(F, I, rec, lane);
    for (; rec < 64 * CS_NCH; rec += stride) {
        PPIn Nx = I; if (rec + stride < 64 * CS_NCH) prepass_load(F, Nx, rec + stride, lane);
        prepass_record(F, l, rec, L, lane, I);
        I = Nx;
    }
}

constexpr int CS_REC = 4096 + 6144 + 256 + 4096, CS_SLOTS = 8, CS_LEAD = 6;
__device__ __forceinline__ void scan_chunked(Frame& F, int ch, int l) {
    int lane = LANE_; asm volatile("" : "+v"(lane));
    const int wave = F.wave, b = ch >> 3, h = (ch >> 1) & 3, dir = ch & 1, hh = lane >> 5, icol = 32 * (wave & 1) + (lane & 31);
    float* YD = WSP(float, WS_YD) + (size_t)dir * M * 256;
    const float* R32 = WSP(float, WS_R32);
    LAS unsigned char* ring = F.lds;
    u32x4 st[15];
    const int hw = wave - 2;
#define CS_SRC(cc, q) ({ const int rec_ = ch * CS_NCH + (cc); const u32x4* r_; \
        if ((q) < 4) r_ = (const u32x4*)(WSP(bf16, WS_W1F) + (size_t)rec_ * 2048) + lane + (q) * 64; \
        else if ((q) < 10) r_ = (const u32x4*)((const unsigned char*)F.out + (size_t)rec_ * 6400) + lane + ((q) - 4) * 64; \
        else { const int p = (q) * 64 + lane; const int pv = min(max(p - 656, 0), 255); \
            const u32x4* sv_ = (const u32x4*)(R32 + ((size_t)b * T + scan_tok((cc) * 16 + (pv >> 4), dir)) * 768 + 512 + h * 64) + (pv & 15); \
            r_ = ((q) == 10 && lane < 16) ? (const u32x4*)((const unsigned char*)F.out + (size_t)rec_ * 6400) + lane + 384 : sv_; } \
        r_; })
#define CS_ISSUE1(cc, q) do { st[q] = *CS_SRC(cc, q); } while (0)
#define CS_WRITE1(cc, q) do { const int p = (q) * 64 + lane; if ((q) < 14 || p < 912) ((LAS u32x4*)(ring + ((cc) % CS_SLOTS) * CS_REC))[p] = st[q]; } while (0)
#define CS_ISSUE(cc) do { _Pragma("unroll") for (int q = 0; q < 15; ++q) CS_ISSUE1(cc, q); } while (0)
#define CS_WRITE(cc) do { _Pragma("unroll") for (int q = 0; q < 15; ++q) CS_WRITE1(cc, q); } while (0)
#define CS_STEP(wc, q) do { CS_WRITE1(wc, q); if ((wc) + 6 < CS_NCH) CS_ISSUE1((wc) + 6, q); } while (0)
#define CS_BAR() do { asm volatile("s_waitcnt lgkmcnt(0)" ::: "memory"); __builtin_amdgcn_s_barrier(); asm volatile("" ::: "memory"); } while (0)
    if (wave >= 2) {
        CS_ISSUE(hw); CS_WRITE(hw); if (hw + CS_LEAD < CS_NCH) CS_ISSUE(hw + CS_LEAD);
        CS_BAR();
        int c = 0;
        for (; c < hw; ++c) CS_BAR();
        for (; c + 6 <= CS_NCH; c += 6) {
            const int wc = c + 6;
            if (wc < CS_NCH) {
                CS_STEP(wc, 0); CS_STEP(wc, 1); CS_STEP(wc, 2); CS_BAR();
                CS_STEP(wc, 3); CS_STEP(wc, 4); CS_STEP(wc, 5); CS_BAR();
                CS_STEP(wc, 6); CS_STEP(wc, 7); CS_STEP(wc, 8); CS_BAR();
                CS_STEP(wc, 9); CS_STEP(wc, 10); CS_BAR();
                CS_STEP(wc, 11); CS_STEP(wc, 12); CS_BAR();
                CS_STEP(wc, 13); CS_STEP(wc, 14); CS_BAR();
            } else { CS_BAR(); CS_BAR(); CS_BAR(); CS_BAR(); CS_BAR(); CS_BAR(); }
        }
        for (; c < CS_NCH; ++c) CS_BAR();
    } else {
        f32x16 X0, X1;
#pragma unroll
        for (int r = 0; r < 16; ++r) { X0[r] = 0.f; X1[r] = 0.f; }
        CS_BAR();
        for (int c = 0; c < CS_NCH; ++c) {
            const LAS unsigned char* rec = ring + (c % CS_SLOTS) * CS_REC;
            const LAS bf16x8* w1 = (const LAS bf16x8*)rec + lane; const LAS bf16x8* w2 = (const LAS bf16x8*)(rec + 4096) + lane;
            const LAS f32x4* p15 = (const LAS f32x4*)(rec + 10240 + hh * 128); const LAS float* vr = (const LAS float*)(rec + 10496) + icol;
            f32x16 G;
#pragma unroll
            for (int r = 0; r < 16; ++r) G[r] = 0.f;
            G = __builtin_amdgcn_mfma_f32_32x32x16_bf16(w1[0], pack8f(X0[0], X0[1], X0[2], X0[3], X0[4], X0[5], X0[6], X0[7]), G, 0, 0, 0);
            G = __builtin_amdgcn_mfma_f32_32x32x16_bf16(w1[64], pack8f(X0[8], X0[9], X0[10], X0[11], X0[12], X0[13], X0[14], X0[15]), G, 0, 0, 0);
            G = __builtin_amdgcn_mfma_f32_32x32x16_bf16(w1[128], pack8f(X1[0], X1[1], X1[2], X1[3], X1[4], X1[5], X1[6], X1[7]), G, 0, 0, 0);
            G = __builtin_amdgcn_mfma_f32_32x32x16_bf16(w1[192], pack8f(X1[8], X1[9], X1[10], X1[11], X1[12], X1[13], X1[14], X1[15]), G, 0, 0, 0);
            const bf16x8 g1 = pack8f(G[0], G[1], G[2], G[3], G[4], G[5], G[6], G[7]);
            float vv[8];
#pragma unroll
            for (int jj = 0; jj < 8; ++jj) vv[jj] = vr[(8 * (jj >> 2) + 4 * hh + (jj & 3)) * 64];
            const bf16x8 vf = pack8f(vv[0], vv[1], vv[2], vv[3], vv[4], vv[5], vv[6], vv[7]);
            f32x16 Y = __builtin_amdgcn_mfma_f32_32x32x16_bf16(w2[0], g1, G, 0, 0, 0);
            Y = __builtin_amdgcn_mfma_f32_32x32x16_bf16(w2[64], vf, Y, 0, 0, 0);
#pragma unroll
            for (int k = 0; k < 4; ++k) { const f32x4 pa = p15[k], pb = p15[4 + k];
#pragma unroll
                for (int e = 0; e < 4; ++e) { X0[4 * k + e] *= pa[e]; X1[4 * k + e] *= pb[e]; } }
            X0 = __builtin_amdgcn_mfma_f32_32x32x16_bf16(w2[128], g1, X0, 0, 0, 0);
            X0 = __builtin_amdgcn_mfma_f32_32x32x16_bf16(w2[192], vf, X0, 0, 0, 0);
            X1 = __builtin_amdgcn_mfma_f32_32x32x16_bf16(w2[256], g1, X1, 0, 0, 0);
            X1 = __builtin_amdgcn_mfma_f32_32x32x16_bf16(w2[320], vf, X1, 0, 0, 0);
#pragma unroll
            for (int r = 8; r < 16; ++r) { const int t = (r & 3) + 4 * hh + 8 * ((r >> 2) - 2);
                YD[((size_t)b * T + scan_tok(c * 16 + t, dir)) * 256 + h * 64 + icol] = Y[r]; }
            CS_BAR();
        }
    }
#undef CS_BAR
#undef CS_ISSUE
#undef CS_ISSUE1
#undef CS_WRITE1
#undef CS_STEP
#undef CS_SRC
#undef CS_WRITE
    __syncthreads();
}

constexpr int SC_TC = 16, SC_STEP = 6 * 64, SC_BUF = SC_TC * SC_STEP;
constexpr int SC_YOFF = 2 * SC_BUF, SC_DUMMY = SC_YOFF + 2 * SC_TC * 64;
struct ScanVec { f32x4 r0, r1, w0, w1, k0, k1, a0, a1, b0, b1; float vi; };
__device__ __forceinline__ void scan_ld(ScanVec& V, const LAS float* vec, int jc, int i) {
    V.r0 = *(const LAS f32x4*)(vec + 8 * jc); V.r1 = *(const LAS f32x4*)(vec + 8 * jc + 4);
    V.w0 = *(const LAS f32x4*)(vec + 64 + 8 * jc); V.w1 = *(const LAS f32x4*)(vec + 64 + 8 * jc + 4);
    V.k0 = *(const LAS f32x4*)(vec + 128 + 8 * jc); V.k1 = *(const LAS f32x4*)(vec + 128 + 8 * jc + 4);
    V.vi = vec[192 + i];
    V.a0 = *(const LAS f32x4*)(vec + 256 + 8 * jc); V.a1 = *(const LAS f32x4*)(vec + 256 + 8 * jc + 4);
    V.b0 = *(const LAS f32x4*)(vec + 320 + 8 * jc); V.b1 = *(const LAS f32x4*)(vec + 320 + 8 * jc + 4);
}
__device__ __forceinline__ float dot8(const f32x4 s0, const f32x4 s1, const f32x4 x0, const f32x4 x1) {
    const f32x4 p = s0 * x0 + s1 * x1;
    return (p[0] + p[1]) + (p[2] + p[3]);
}
__device__ __forceinline__ void scan_chain(Frame& F, int chain, int half, int l) {
    const int b = chain >> 3, h = (chain >> 1) & 3, dir = chain & 1;
    int tid_ = threadIdx.x; asm volatile("" : "+v"(tid_));
    const int tid = tid_, lane = tid & 63, wave = F.wave, jc = lane & 7, il = 8 * (wave & 3) + (lane >> 3), i = 32 * half + il;
    const bool comp = wave < 4; const int hw = wave & 3, ht = tid & 255;
    LAS float* buf = (LAS float*)F.lds;
    const float* R32 = WSP(float, WS_R32); const float* DEC = WSP(float, WS_DEC) + (size_t)dir * M * 256; const float* ASIG = WSP(float, WS_ASIG) + (size_t)dir * M * 256;
    float* YD = WSP(float, WS_YD) + (size_t)dir * M * 256;
    const float kkw = F.in[I_KK][l * 256 + h * 64 + lane], kaw = F.in[I_KA][l * 256 + h * 64 + lane];
    f32x4 S0 = (f32x4){0.f, 0.f, 0.f, 0.f}, S1 = S0;
    float pr[4][5];
    constexpr int NCH = T / SC_TC;
    const int ywr = (jc == 0) ? il : (SC_DUMMY - SC_YOFF) + ht;
#define SC_LOAD(c) do { _Pragma("unroll") for (int s4 = 0; s4 < 4; ++s4) { const int p = (c) * SC_TC + 4 * hw + s4; const size_t m = (size_t)b * T + scan_tok(p, dir); \
        pr[s4][0] = R32[m * 768 + h * 64 + lane]; pr[s4][1] = R32[m * 768 + 256 + h * 64 + lane]; pr[s4][2] = R32[m * 768 + 512 + h * 64 + lane]; \
        pr[s4][3] = DEC[m * 256 + h * 64 + lane]; pr[s4][4] = ASIG[m * 256 + h * 64 + lane]; } } while (0)
#define SC_PREP(bi) do { _Pragma("unroll") for (int s4 = 0; s4 < 4; ++s4) { const float r_ = pr[s4][0], kb_ = pr[s4][1], v_ = pr[s4][2], de_ = pr[s4][3], as_ = pr[s4][4]; \
        float kk_ = kb_ * kkw; kk_ = kk_ * __builtin_amdgcn_rsqf(fmaxf(wave_sum(kk_ * kk_), 1e-24f)); const float kd_ = kb_ * (1.f + (as_ - 1.f) * kaw); \
        LAS float* o_ = buf + (bi) * SC_BUF + (4 * hw + s4) * SC_STEP + lane; o_[0] = r_; o_[64] = de_; o_[128] = kd_; o_[192] = v_; o_[256] = -kk_; o_[320] = kk_ * as_; } } while (0)
#define SC_FLUSH(c) do { const int s_ = ht >> 4, i2_ = 2 * (ht & 15); \
        const f32x2 yv_ = *(const LAS f32x2*)(buf + SC_YOFF + ((c) & 1) * SC_TC * 32 + s_ * 32 + i2_); \
        *(f32x2*)(YD + ((size_t)b * T + scan_tok((c) * SC_TC + s_, dir)) * 256 + h * 64 + 32 * half + i2_) = yv_; } while (0)
    if (!comp) { SC_LOAD(0); SC_PREP(0); SC_LOAD(1); }
    for (int c = 0; c < NCH; ++c) {
        __syncthreads();
        if (!comp) {
            if (c > 0) SC_FLUSH(c - 1);
            if (c + 1 < NCH) SC_PREP((c + 1) & 1);
            if (c + 2 < NCH) SC_LOAD(c + 2);
        } else {
            const LAS float* bc = buf + (c & 1) * SC_BUF;
            LAS float* yst = buf + SC_YOFF + (c & 1) * SC_TC * 32 + ywr;
            ScanVec V; scan_ld(V, bc, jc, i);
#pragma unroll
            for (int s = 0; s < SC_TC; ++s) {
                ScanVec N = V;
                if (s + 1 < SC_TC) scan_ld(N, bc + (s + 1) * SC_STEP, jc, i);
                const float sa = red8(dot8(S0, S1, V.a0, V.a1));
                const f32x4 u0 = S0 * V.w0 + V.k0 * V.vi, u1 = S1 * V.w1 + V.k1 * V.vi;
                S0 = u0 + V.b0 * sa; S1 = u1 + V.b1 * sa;
                const float y = red8(dot8(S0, S1, V.r0, V.r1));
                yst[(jc == 0) ? s * 32 : 0] = y;
                V = N;
            }
        }
    }
    __syncthreads();
    if (!comp) SC_FLUSH(NCH - 1);
#undef SC_LOAD
#undef SC_PREP
#undef SC_FLUSH
    __syncthreads();
}

#if GOLD_ATTN
__device__ __forceinline__ void attn_ref_unit(Frame& F, int mode, int qrow0, int qcol, int krow0, int nkeys, int kcol, int vcol, int ocol,
                                              int rb, const float* rpbh) {
    const int tid = TID_, q = tid & 255, dh = tid >> 8;
    const bf16* QKV = WSP(bf16, WS_QKV); bf16* O = WSP(bf16, WS_O);
    const int gr = 4 * rb + (q >> 6), gc = q & 63;
    const size_t qrow = (size_t)qrow0 + q;
    float qv[64], o[32];
#pragma unroll
    for (int d8 = 0; d8 < 8; ++d8) { const u32x4 w = *(const u32x4*)(QKV + qrow * 1536 + qcol + 8 * d8);
        qv[8 * d8 + 0] = bflo(w.x); qv[8 * d8 + 1] = bfhi(w.x); qv[8 * d8 + 2] = bflo(w.y); qv[8 * d8 + 3] = bfhi(w.y);
        qv[8 * d8 + 4] = bflo(w.z); qv[8 * d8 + 5] = bfhi(w.z); qv[8 * d8 + 6] = bflo(w.w); qv[8 * d8 + 7] = bfhi(w.w); }
#pragma unroll
    for (int d = 0; d < 32; ++d) o[d] = 0.f;
    float mrun = -1e30f, lrun = 0.f;
    const int kend = mode == 0 ? nkeys : 128 + CTXL;
    const int rs = min(max(gr - 4, 0), 32 - 8), cs = min(max(gc - 8, 0), 64 - 16);
    for (int kk = 0; kk < kend; ++kk) {
        size_t krow; float bias = 0.f;
        if (mode == 0) krow = (size_t)krow0 + kk;
        else if (kk < 128) { const int kr = rs + (kk >> 4), kc = cs + (kk & 15); krow = (size_t)krow0 + CTXL + kr * 64 + kc; bias = rpbh[(kr - gr + 7) * 31 + (kc - gc + 15)] * LOG2E; }
        else krow = (size_t)krow0 + (kk - 128);
        float s = bias;
#pragma unroll
        for (int d8 = 0; d8 < 8; ++d8) { const u32x4 w = *(const u32x4*)(QKV + krow * 1536 + kcol + 8 * d8);
            s += qv[8 * d8 + 0] * bflo(w.x) + qv[8 * d8 + 1] * bfhi(w.x) + qv[8 * d8 + 2] * bflo(w.y) + qv[8 * d8 + 3] * bfhi(w.y)
               + qv[8 * d8 + 4] * bflo(w.z) + qv[8 * d8 + 5] * bfhi(w.z) + qv[8 * d8 + 6] * bflo(w.w) + qv[8 * d8 + 7] * bfhi(w.w); }
        const float mn = fmaxf(mrun, s), al = exp2f(mrun - mn), p = exp2f(s - mn);
        lrun = lrun * al + p; mrun = mn;
#pragma unroll
        for (int d8 = 0; d8 < 4; ++d8) { const u32x4 w = *(const u32x4*)(QKV + krow * 1536 + vcol + 32 * dh + 8 * d8);
            o[8 * d8 + 0] = o[8 * d8 + 0] * al + p * bflo(w.x); o[8 * d8 + 1] = o[8 * d8 + 1] * al + p * bfhi(w.x);
            o[8 * d8 + 2] = o[8 * d8 + 2] * al + p * bflo(w.y); o[8 * d8 + 3] = o[8 * d8 + 3] * al + p * bfhi(w.y);
            o[8 * d8 + 4] = o[8 * d8 + 4] * al + p * bflo(w.z); o[8 * d8 + 5] = o[8 * d8 + 5] * al + p * bfhi(w.z);
            o[8 * d8 + 6] = o[8 * d8 + 6] * al + p * bflo(w.w); o[8 * d8 + 7] = o[8 * d8 + 7] * al + p * bfhi(w.w); }
    }
    const float li = 1.f / lrun;
#pragma unroll
    for (int d8 = 0; d8 < 4; ++d8) { u32x4 w;
        w.x = pk2(o[8 * d8 + 0] * li, o[8 * d8 + 1] * li); w.y = pk2(o[8 * d8 + 2] * li, o[8 * d8 + 3] * li);
        w.z = pk2(o[8 * d8 + 4] * li, o[8 * d8 + 5] * li); w.w = pk2(o[8 * d8 + 6] * li, o[8 * d8 + 7] * li);
        *(u32x4*)(O + qrow * 1024 + ocol + 32 * dh + 8 * d8) = w; }
}
#endif
__device__ __forceinline__ void attn_item(Frame& F, int item, int l) {
    const float* rpb = F.in[I_RPB] + (size_t)l * 4 * 15 * 31;
    int mode = 0, qrow0, qcol, krow0, nkeys, kcol, vcol, ocol, rb = 0;
    if (item < 512) { const int b = item >> 6, h = (item >> 3) & 7, qb = item & 7;
        qrow0 = b * T + CTXL + qb * 256; qcol = h * 64; krow0 = b * T; nkeys = T; kcol = 512 + (h >> 2) * 64; vcol = 640 + (h >> 2) * 64; ocol = h * 64; }
    else if (item < 768) { const int it = item - 512, b = it >> 5, h = (it >> 3) & 3; rb = it & 7; mode = 1;
        qrow0 = b * T + CTXL + rb * 256; qcol = 768 + h * 64; krow0 = b * T; nkeys = 0; kcol = 1024 + h * 64; vcol = 1280 + h * 64; ocol = 768 + h * 64; rpb += h * 15 * 31; }
    else if (item < 832) { const int it = item - 768, b = it >> 3, h = it & 7;
        qrow0 = b * T; qcol = h * 64; krow0 = b * T; nkeys = CTXL; kcol = 512 + (h >> 2) * 64; vcol = 640 + (h >> 2) * 64; ocol = h * 64; }
    else { const int it = item - 832, b = it >> 2, h = it & 3;
        qrow0 = b * T; qcol = 768 + h * 64; krow0 = b * T; nkeys = CTXL; kcol = 1024 + h * 64; vcol = 1280 + h * 64; ocol = 768 + h * 64; }
#if GOLD_ATTN
    attn_ref_unit(F, mode, qrow0, qcol, krow0, nkeys, kcol, vcol, ocol, rb, rpb);
#else
    const attn_body::bf16* QKV = (const attn_body::bf16*)WSP(bf16, WS_QKV); attn_body::bf16* O = (attn_body::bf16*)WSP(bf16, WS_O);
    const attn_body::bf16* Qw0 = QKV + (size_t)qrow0 * 1536 + qcol; const attn_body::bf16* Kh = QKV + (size_t)krow0 * 1536 + kcol; const attn_body::bf16* Vh = QKV + (size_t)krow0 * 1536 + vcol;
    attn_body::bf16* Ow0 = O + (size_t)qrow0 * 1024 + ocol;
    if (mode == 0) attn_body::attn_unit<8, false>(Qw0, Kh, Vh, Ow0, nkeys >> 6, 0, 0, 0, rpb, (char*)F.lds);
    else { const int rs0 = min(max(4 * rb - 4, 0), 24); attn_body::attn_unit<8, true>(Qw0, Kh, Vh, Ow0, (rb == 0 || rb == 7) ? 12 : 16, rs0, rb, rs0, rpb, (char*)F.lds); }
#endif
}
template <int NI> struct PostIn { float y[NI], r[NI], kb[NI], v[NI], as0[NI], as1[NI], gg[NI]; };
template <int NI> __device__ __forceinline__ void post_load(Frame& F, PostIn<NI>& P, int m0, int h, int lane) {
    const float* R32 = WSP(float, WS_R32); const float* ASIG = WSP(float, WS_ASIG); const float* YD = WSP(float, WS_YD); const float* Gb = WSP(float, WS_G);
    const int ch = h * 64 + lane;
#pragma unroll
    for (int k = 0; k < NI; ++k) { const size_t mm = (size_t)(m0 + k);
        P.y[k] = YD[mm * 256 + ch] + YD[((size_t)M + mm) * 256 + ch];
        P.r[k] = R32[mm * 768 + ch]; P.kb[k] = R32[mm * 768 + 256 + ch]; P.v[k] = R32[mm * 768 + 512 + ch];
        P.as0[k] = ASIG[mm * 256 + ch]; P.as1[k] = ASIG[((size_t)M + mm) * 256 + ch]; P.gg[k] = Gb[mm * 256 + ch]; }
}
template <int NI> __device__ __forceinline__ void post_math(Frame& F, int l, const PostIn<NI>& P, int m0, int h, int lane) {
    bf16* O = WSP(bf16, WS_O);
    const int ch = h * 64 + lane;
    const float lw = F.in[I_LNXW][l * 256 + ch], lb = F.in[I_LNXB][l * 256 + ch], ka = F.in[I_KA][l * 256 + ch], rk = F.in[I_RK][l * 256 + ch];
#pragma unroll
    for (int k = 0; k < NI; ++k) {
        const float mu = wave_sum(P.y[k]) * (1.f / 64.f); const float dv = P.y[k] - mu; const float var = wave_sum(dv * dv) * (1.f / 64.f);
        const float yn = dv * rsqrtf(var + 64e-5f) * lw + lb;
        const float kd0 = P.kb[k] * (1.f + (P.as0[k] - 1.f) * ka), kd1 = P.kb[k] * (1.f + (P.as1[k] - 1.f) * ka);
        const float bon = wave_sum(P.r[k] * (kd0 + kd1) * rk) * P.v[k];
        O[(size_t)(m0 + k) * 1024 + 512 + ch] = (bf16)f2bf((yn + bon) * P.gg[k]);
    }
}
__device__ __forceinline__ void post_item(Frame& F, int l, int m, int h, int lane) { PostIn<1> P; post_load<1>(F, P, m, h, lane); post_math<1>(F, l, P, m, h, lane); }
__device__ __forceinline__ void phase_post(Frame& F, int l) {
    const int gw = F.vcu * NWAVES + F.wave, NGW = F.G * NWAVES, lane = LANE_;
    for (int it = gw; it < M * 4; it += NGW) { const int m = it >> 2, h = it & 3, t = m % T;
        if (l == NL - 1 && t < CTXL) continue;
        post_item(F, l, m, h, lane);
    }
}
constexpr int CW_PAIR = 32768;
__device__ __forceinline__ void post_pair(Frame& F, int l, int ch) {
    const int b = ch >> 3, h = (ch >> 1) & 3, dir = ch & 1;
    asm volatile("s_waitcnt vmcnt(0)" ::: "memory");
    __syncthreads();
    if (TID_ == 0) {
        unsigned* flag = F.ctl + CW_PAIR + 64 * (l * 32 + (ch >> 1));
        __builtin_amdgcn_fence(__ATOMIC_RELEASE, "agent");
        asm volatile("s_waitcnt vmcnt(0)" ::: "memory");
        (void)xb_add(flag, 1u);
        unsigned sp = 0; while (xb_ld(flag) < 2u) { __builtin_amdgcn_s_sleep(2); if (++sp > (1u << 24)) break; }
        __builtin_amdgcn_fence(__ATOMIC_ACQUIRE, "agent");
        asm volatile("s_waitcnt vmcnt(0)" ::: "memory");
    }
    __syncthreads();
    const int t0 = (l == NL - 1) ? CTXL : 0, nt = T - t0, half = nt >> 1, lane = LANE_;
    const int tend = t0 + (dir + 1) * half; int t = t0 + dir * half + 8 * F.wave;
    PostIn<8> P; if (t < tend) post_load<8>(F, P, b * T + t, h, lane);
    for (; t < tend; t += 8 * NWAVES) {
        PostIn<8> Nx = P; if (t + 8 * NWAVES < tend) post_load<8>(F, Nx, b * T + t + 8 * NWAVES, h, lane);
        post_math<8>(F, l, P, b * T + t, h, lane);
        P = Nx;
    }
}

__device__ __forceinline__ void phase_mixer(Frame& F, int l, int rep = 0) {
#if CHUNK_SCAN
    if (F.vcu < 64) { scan_chunked(F, F.vcu, l); if (rep == 0) post_pair(F, l, F.vcu); }
#else
    if (F.vcu < 128) scan_chain(F, F.vcu >> 1, F.vcu & 1, l);
#endif
    if (rep == 2) return;
    const int nattn = (l == NL - 1) ? 768 : 864;
    for (;;) {
        if (TID_ == 0) F.MISC[16] = atomicAdd(F.ctl + CW_QUEUE + 64 * (l + 2 * rep), 1u);
        __syncthreads();
        const int item = (int)F.MISC[16];
        __syncthreads();
        if (item >= nattn) break;
        attn_item(F, item, l);
    }
    cvt_moe_drain(F, l, 4);
}

__device__ __forceinline__ unsigned wave_incl_scan(unsigned v, int lane) {
#pragma unroll
    for (int o = 1; o < 64; o <<= 1) { const unsigned u = __shfl_up(v, o); if (lane >= o) v += u; }
    return v;
}
__device__ __forceinline__ void phase_topk(Frame& F, int l) {
    const int tid = TID_, lane = LANE_, wave = F.wave;
    LAS unsigned* hist = (LAS unsigned*)F.lds;
    LAS unsigned* ctrl = hist + 256;
    LAS unsigned* wsum = hist + 272;
    LAS int* stok = (LAS int*)(hist + 288);
    const float* AFF = WSP(float, WS_AFF); int* INV = WSP(int, WS_INV); float* SELG = WSP(float, WS_SELG); int* SELT = WSP(int, WS_SELT);
    const bf16* H2 = WSP(bf16, WS_H2); bf16* XE = WSP(bf16, WS_XE);
    const int nitems = (l == NL - 1) ? 128 : 256;
    for (int it = F.vcu; it < nitems; it += F.G) {
        const int seg = it >> 7, be = it & 127, b = be >> 4, e = be & 15;
        const int n = seg ? CTXL : SEQ, cap = n / 8, mbase = b * T + (seg ? 0 : CTXL);
        const int rowbase = e * MEXP + (seg ? 2048 + b * 32 : b * 256);
        unsigned key[4];
#pragma unroll
        for (int k = 0; k < 4; ++k) { const int i = 4 * tid + k; key[k] = (i < n) ? __float_as_uint(AFF[(size_t)(mbase + i) * 16 + e]) : 0u; }
        if (tid == 0) { ctrl[0] = 0u; ctrl[1] = (unsigned)cap; }
        unsigned prefix = 0u, pmask = 0u;
#pragma unroll 1
        for (int pass = 0; pass < 4; ++pass) {
            const int shift = 24 - 8 * pass;
            if (tid < 256) hist[tid] = 0u;
            __syncthreads();
#pragma unroll
            for (int k = 0; k < 4; ++k) if ((key[k] & pmask) == prefix && key[k] != 0u) __hip_atomic_fetch_add(&hist[(key[k] >> shift) & 255u], 1u, __ATOMIC_RELAXED, __HIP_MEMORY_SCOPE_WORKGROUP);
            __syncthreads();
            if (wave == 0) {
                const unsigned need = ctrl[1];
                unsigned c4[4]; unsigned tot = 0u;
#pragma unroll
                for (int k = 0; k < 4; ++k) { c4[k] = hist[255 - (4 * lane + k)]; tot += c4[k]; }
                const unsigned incl = wave_incl_scan(tot, lane); unsigned run = incl - tot;
#pragma unroll
                for (int k = 0; k < 4; ++k) { if (run < need && run + c4[k] >= need) { ctrl[0] = prefix | ((unsigned)(255 - (4 * lane + k)) << shift); ctrl[1] = need - run; } run += c4[k]; }
            }
            __syncthreads();
            prefix = ctrl[0]; pmask |= 255u << shift;
        }
        const unsigned thr = prefix, need_eq = ctrl[1];
        unsigned ngt = 0u, neq = 0u;
#pragma unroll
        for (int k = 0; k < 4; ++k) { ngt += key[k] > thr; neq += key[k] == thr; }
        const unsigned packed = ngt | (neq << 16);
        const unsigned incl = wave_incl_scan(packed, lane);
        if (lane == 63) wsum[wave] = incl;
        __syncthreads();
        unsigned base = 0u, total = 0u;
#pragma unroll
        for (int w = 0; w < NWAVES; ++w) { const unsigned s = wsum[w]; if (w < wave) base += s; total += s; }
        const unsigned excl = base + incl - packed;
        unsigned pgt = excl & 0xffffu, peq = excl >> 16; const unsigned cnt_gt = total & 0xffffu;
#pragma unroll
        for (int k = 0; k < 4; ++k) {
            int slot = -1;
            if (key[k] > thr) slot = (int)pgt++;
            else if (key[k] == thr) { if (peq < need_eq) slot = (int)(cnt_gt + peq); ++peq; }
            if (slot >= 0) { const int m = mbase + 4 * tid + k; stok[slot] = m;
                SELG[rowbase + slot] = __uint_as_float(key[k]); SELT[rowbase + slot] = m; INV[(size_t)m * 16 + e] = rowbase + slot; }
        }
        __syncthreads();
        for (int s0 = wave * 4; s0 < cap; s0 += NWAVES * 4) {
            u32x4 v[4][2];
#pragma unroll
            for (int k = 0; k < 4; ++k) { const int m = stok[s0 + k];
                const u32x4* src = (const u32x4*)(H2 + (size_t)m * 1024); v[k][0] = src[lane]; v[k][1] = src[64 + lane]; }
#pragma unroll
            for (int k = 0; k < 4; ++k) { u32x4* dst = (u32x4*)(XE + (size_t)(rowbase + s0 + k) * 1024); dst[lane] = v[k][0]; dst[64 + lane] = v[k][1]; }
        }
        __syncthreads();
    }
    cvt_moe_drain(F, l, 1);
}

constexpr int N_PHASES = 2 + 10 * NL;
#ifndef EN_MASK
#define EN_MASK 0xFFFFF
#endif
#define EN(k) ((EN_MASK >> (k)) & 1)
#ifndef REP_MASK
#define REP_MASK 0
#endif
#define REP(k) ((REP_MASK >> (k)) & 1)
#define RUNPH(k, body) do { if (EN(k)) { body; if (REP(k)) { GBAR(); body; } } } while (0)
__global__ void __launch_bounds__(NTHREADS, 2) fwd_kernel(Args args) {
    extern __shared__ __attribute__((aligned(16))) unsigned char lds_raw[];
    cg::grid_group grid = cg::this_grid();
    Frame F;
    F.lds = (LAS unsigned char*)lds_raw;
    F.MISC = (volatile LAS unsigned*)(F.lds + MISC_OFF);
    F.wave = __builtin_amdgcn_readfirstlane(TID_ >> 6);
    F.G = gridDim.x; { const int bx = blockIdx.x; F.vcu = (F.G % 8 == 0) ? (bx % 8) * (F.G / 8) + bx / 8 : bx; }
    F.in = args.in; F.out = args.out; F.ws = args.ws; F.ctl = (unsigned*)(args.ws + WS_CTL);
    { int u0 = TID_; asm volatile("" : "+v"(u0)); for (int u = u0; u < (LDS_BYTES - RING_BYTES) / 4; u += NTHREADS) ((LAS unsigned*)(F.lds + RING_BYTES))[u] = 0u; }
    __syncthreads();
    const int lo = args.ph_lo, hi = args.ph_hi;
    XcdBarrier bar; bar.bar = F.ctl + CW_BAR; bar.x = 0; bar.st = nullptr;
    if (hi - lo > 1) bar = xcd_barrier_post(F.ctl + CW_BAR, F.MISC + 8);
    LAS unsigned char* ring = F.lds;

#ifndef TPROBE
#define TPROBE -1
#endif
#ifndef TP_T0
#define TP_T0 3000.0f
#endif
    unsigned long long tp_start = 0; if (TPROBE >= 0 && blockIdx.x == 0 && TID_ == 0) tp_start = __builtin_amdgcn_s_memrealtime();
#define TPMARK(k) do { if (TPROBE == (k) && blockIdx.x == 0 && TID_ == 0) { const unsigned long long t1_ = __builtin_amdgcn_s_memrealtime(); __hip_atomic_store(F.ctl + 3000, (unsigned)(t1_ - tp_start), __ATOMIC_RELAXED, __HIP_MEMORY_SCOPE_AGENT); } } while (0)
#define IN(k) (lo <= (k) && (k) < hi)
#define GBAR() xcd_barrier3(bar)
#define SEAM(k) do { if (IN(k) && IN((k) + 1)) { GBAR(); TPMARK(k); } } while (0)
#define SEAMF(k, fl) do { if (IN(k) && IN((k) + 1)) { XCD_BARRIER_FILL(bar, F.MISC + 20, { \
        if (TID_ == 0) F.MISC[17] = atomicAdd(F.ctl + CW_CVTQ + 64 * (fl), 1u); __syncthreads(); const int mb_ = (int)F.MISC[17]; __syncthreads(); \
        if (mb_ < CVT_NMINI) { cvt_moe_mini(F, (fl), mb_); asm volatile("s_waitcnt vmcnt(0)" ::: "memory"); } else more_ = false; }); TPMARK(k); } } while (0)
    if (hi < 0) grid.sync();
    if (IN(0)) { RUNPH(10, phase_init(F)); }
    SEAMF(0, 0);
    if (IN(1)) { RUNPH(11, phase_row0(F)); }
    if (REP(16)) { for (int k_ = 0; k_ < 20; ++k_) xcd_barrier(bar); }
    if (REP(17)) { for (int k_ = 0; k_ < 20; ++k_) xcd_barrier3(bar); }
    if (REP(18)) { for (int k_ = 0; k_ < 20; ++k_) xcd_barrier2_probe<3>(bar); }
    if (REP(19)) { for (int k_ = 0; k_ < 20; ++k_) xcd_barrier2_probe<4>(bar); }
    SEAMF(1, 0);
#define LAYER(l) do { constexpr int base = 2 + 10 * (l); constexpr bool last = ((l) == NL - 1); \
    if (IN(base + 0)) { if (EN(0)) { \
        pg8::Gemm g{WSP(bf16, WS_H), WSP(bf16, WS_WIN) + (size_t)(l) * NINP * 1024, M, NINP, D}; \
        EpiInproj E{WSP(bf16, WS_QKV), WSP(float, WS_R32), WSP(bf16, WS_Z)}; \
        for (int rep_ = 0; rep_ < (REP(0) ? 2 : 1); ++rep_) { if (rep_) GBAR(); if (last) { InprojLastSched S{F.G, F.vcu}; run_gemm<EpiInproj, InprojLastSched>(ring, g, S, E); } else { TileSched S{M / 256, NINP / 256, F.G, F.vcu, false}; run_gemm<EpiInproj, TileSched>(ring, g, S, E); } } } } \
    SEAMF(base + 0, (l)); \
    if (IN(base + 1)) { if (EN(1)) { \
        pg8::Gemm g{WSP(bf16, WS_Z), WSP(bf16, WS_LORA) + (size_t)(l) * 1280 * 384, M, 1280, 384}; \
        TileSched S{M / 256, 5, F.G, F.vcu, false}; \
        EpiLora E{WSP(float, WS_DEC), WSP(float, WS_ASIG), WSP(float, WS_G), F.in[I_W0] + (l) * 512, F.in[I_A0] + (l) * 512}; \
        for (int rep_ = 0; rep_ < (REP(1) ? 2 : 1); ++rep_) { if (rep_) GBAR(); run_gemm<EpiLora, TileSched>(ring, g, S, E); } } \
        if (EN(12)) { phase_qkprep(F, (l)); if (REP(12)) { GBAR(); phase_qkprep(F, (l), true); } } } \
    SEAMF(base + 1, (l)); \
    if (IN(base + 2)) { if (EN(2)) { if (CHUNK_SCAN) { phase_prepass(F, (l)); if (IN(base + 2)) SEAMF(base + 2 - 1, (l)); if (REP(14)) { phase_prepass(F, (l)); GBAR(); } } phase_mixer(F, (l)); if (REP(2)) { GBAR(); phase_mixer(F, (l), 1); } if (REP(15)) { GBAR(); phase_mixer(F, (l), 2); } } } \
    SEAMF(base + 2, (l)); \
    if (!CHUNK_SCAN) { if (IN(base + 3)) { RUNPH(3, phase_post(F, (l))); } SEAM(base + 3); } \
    if (IN(base + 4)) { if (EN(4)) { \
        pg8::Gemm g{WSP(bf16, WS_O), WSP(bf16, WS_WOUT) + (size_t)(l) * 1024 * 1024, M, D, D}; \
        TileSched S{last ? 64 : 72, 4, F.G, F.vcu, last}; \
        EpiOut E{WSP(float, WS_Y)}; \
        for (int rep_ = 0; rep_ < (REP(4) ? 2 : 1); ++rep_) { if (rep_) GBAR(); run_gemm<EpiOut, TileSched>(ring, g, S, E); } } } \
    SEAMF(base + 4, (l)); \
    if (IN(base + 5)) { if (EN(5)) { phase_row1(F, (l)); if (REP(5)) { GBAR(); phase_row1(F, (l), true); } } } \
    SEAMF(base + 5, (l)); \
    if (IN(base + 6)) { RUNPH(6, phase_topk(F, (l))); } \
    SEAM(base + 6); \
    if (IN(base + 7)) { if (EN(7)) { \
        pg8::Gemm g{WSP(bf16, WS_XE), WSP(bf16, WS_WGU), NE * MEXP, NE * 2048, D}; \
        MoeSched S{last ? 8 : 9, 8, F.G, F.vcu}; \
        EpiMoe1 E{WSP(bf16, WS_HID)}; \
        for (int rep_ = 0; rep_ < (REP(7) ? 2 : 1); ++rep_) { if (rep_) GBAR(); run_gemm<EpiMoe1, MoeSched>(ring, g, S, E); } } } \
    SEAM(base + 7); \
    if (IN(base + 8)) { if (EN(8)) { \
        pg8::Gemm g{WSP(bf16, WS_HID), WSP(bf16, WS_WD), NE * MEXP, NE * 1024, D}; \
        MoeSched S{last ? 8 : 9, 4, F.G, F.vcu}; \
        EpiMoe2 E{WSP(bf16, WS_OUTE), WSP(float, WS_SELG)}; \
        for (int rep_ = 0; rep_ < (REP(8) ? 2 : 1); ++rep_) { if (rep_) GBAR(); run_gemm<EpiMoe2, MoeSched>(ring, g, S, E); } } } \
    SEAM(base + 8); \
    if (IN(base + 9)) { if (EN(9)) { phase_row2(F, (l)); if (REP(9)) { GBAR(); phase_row2(F, (l), true); } } } \
    if ((l) + 1 < NL) SEAMF(base + 9, (l) + 1); else SEAM(base + 9); \
  } while (0)
    LAYER(0);
    LAYER(1);
#undef LAYER
#undef SEAM
#undef IN
}

extern "C" void kernel_launch(void* const* d_in, const int* in_sizes, int n_in, void* d_out, int out_size, void* d_ws, size_t ws_size, hipStream_t stream) {
    static int grid = 0;
    if (grid == 0) {
        if (n_in != 29 || out_size != NB * SEQ * D || ws_size < WS_END) { fprintf(stderr, "kernel_launch: unexpected sizes n_in %d out %d ws %zu\n", n_in, out_size, ws_size); grid = -1; return; }
        int dev = 0, cus = 0, per_cu = 0;
        if (hipGetDevice(&dev) != hipSuccess || hipDeviceGetAttribute(&cus, hipDeviceAttributeMultiprocessorCount, dev) != hipSuccess) { grid = -1; return; }
        if (hipFuncSetAttribute((const void*)fwd_kernel, hipFuncAttributeMaxDynamicSharedMemorySize, LDS_BYTES) != hipSuccess) { fprintf(stderr, "kernel_launch: hipFuncSetAttribute failed\n"); grid = -1; return; }
        if (hipOccupancyMaxActiveBlocksPerMultiprocessor(&per_cu, (const void*)fwd_kernel, NTHREADS, LDS_BYTES) != hipSuccess || per_cu < 1) { fprintf(stderr, "kernel_launch: occupancy query says %d\n", per_cu); per_cu = 1; }
        (void)hipGetLastError();
        grid = cus;
        fprintf(stderr, "kernel_launch: grid %d, per_cu %d, ws %zu\n", grid, per_cu, ws_size);
    }
    if (grid < 0) return;
    if (hipMemsetAsync((char*)d_ws + WS_CTL, 0, CTL_ZERO_BYTES, stream) != hipSuccess) return;
    Args a{};
    for (int i = 0; i < 29; ++i) a.in[i] = (const float*)d_in[i];
    a.out = (float*)d_out; a.ws = (unsigned char*)d_ws;
#if N_LAUNCH_MODE
    a.ph_lo = 0; a.ph_hi = N_PHASES;
    { void* kargs[] = {&a};
      hipError_t e = hipLaunchCooperativeKernel((const void*)fwd_kernel, dim3(grid), dim3(NTHREADS), kargs, LDS_BYTES, stream);
      if (e != hipSuccess) fprintf(stderr, "kernel_launch: cooperative launch failed: %s\n", hipGetErrorString(e)); }
#else
    for (int ph = 0; ph < N_PHASES; ++ph) {
        a.ph_lo = ph; a.ph_hi = ph + 1;
        void* kargs[] = {&a};
        hipError_t e = hipLaunchCooperativeKernel((const void*)fwd_kernel, dim3(grid), dim3(NTHREADS), kargs, LDS_BYTES, stream);
        if (e != hipSuccess) { fprintf(stderr, "kernel_launch: launch %d failed: %s\n", ph, hipGetErrorString(e)); break; }
    }
#endif
}
```

```cpp
#define GOLD_GEMM 0
#define N_LAUNCH_MODE 1
#define GOLD_ATTN 0
#define REP_MASK 0
#define CHUNK_SCAN 1
#include <hip/hip_runtime.h>
#include <hip/hip_cooperative_groups.h>
#include <cstdio>
#include <cstdint>
namespace cg = cooperative_groups;

#ifndef GOLD_GEMM
#define GOLD_GEMM 0
#endif
#ifndef GOLD_ATTN
#define GOLD_ATTN 1
#endif
#ifndef N_LAUNCH_MODE
#define N_LAUNCH_MODE 1
#endif

#ifndef REP_MASK
#define REP_MASK 0
#endif
#define REP(k) ((REP_MASK >> (k)) & 1)
#define LAS __attribute__((address_space(3)))
typedef unsigned short bf16;
typedef float f32x4 __attribute__((ext_vector_type(4)));
typedef unsigned u32x4 __attribute__((ext_vector_type(4)));
typedef unsigned u32x2 __attribute__((ext_vector_type(2)));
typedef short bf16x8 __attribute__((ext_vector_type(8)));

constexpr int D = 1024, NB = 8, SEQ = 2048, CTXL = 256, T = SEQ + CTXL, M = NB * T, NL = 2;
constexpr int NINP = 2816;
constexpr int NE = 16, MEXP = 2304;
constexpr float LOG2E = 1.4426950408889634f;
constexpr float C2 = 0.125f * LOG2E;
constexpr int NTHREADS = 512, NWAVES = 8;
constexpr int LDS_BYTES = 147456, RING_BYTES = 131072, MISC_OFF = RING_BYTES + 320;

constexpr size_t MiB = 1u << 20;
constexpr size_t WS_CTL = 0, CTL_ZERO_BYTES = 1 * MiB;
constexpr size_t WS_MOD = 1 * MiB;
constexpr size_t WS_WIN = 2 * MiB;
constexpr size_t WS_WOUT = 13 * MiB;
constexpr size_t WS_LORA = 17 * MiB;
constexpr size_t WS_WGU = 19 * MiB;
constexpr size_t WS_WD = 83 * MiB;
constexpr size_t WS_X = 115 * MiB;
constexpr size_t R0 = 187 * MiB;
constexpr size_t WS_YD = R0 + 0 * MiB;
constexpr size_t WS_H = R0 + 36 * MiB;
constexpr size_t WS_QKV = R0 + 72 * MiB;
constexpr size_t WS_R32 = R0 + 126 * MiB;
constexpr size_t WS_Z = R0 + 180 * MiB;
constexpr size_t WS_DEC = R0 + 194 * MiB;
constexpr size_t WS_ASIG = R0 + 230 * MiB;
constexpr size_t WS_G = R0 + 266 * MiB;
constexpr size_t WS_O = R0 + 284 * MiB;
constexpr size_t WS_END = R0 + 320 * MiB;
constexpr size_t WS_Y = WS_QKV;
constexpr size_t WS_OUTE = WS_QKV;
constexpr size_t WS_H2 = WS_DEC;
constexpr size_t WS_AFF = WS_Z;
constexpr size_t WS_INV = WS_Z + 2 * MiB;
constexpr size_t WS_SELG = WS_Z + 4 * MiB;
constexpr size_t WS_SELT = WS_Z + 5 * MiB;
constexpr size_t WS_XE = WS_ASIG;
constexpr size_t WS_HID = WS_YD;
static_assert(WS_END <= 512 * MiB, "ws map");
constexpr int CW_BAR = 4096;
constexpr int CW_QUEUE = 16384;

__device__ __forceinline__ unsigned f2bf(float f) { unsigned u = __builtin_bit_cast(unsigned, f); return (u + 0x7fffu + ((u >> 16) & 1u)) >> 16; }
__device__ __forceinline__ unsigned pk2(float lo, float hi) { return f2bf(lo) | (f2bf(hi) << 16); }
__device__ __forceinline__ float bf2f(unsigned h) { return __builtin_bit_cast(float, h << 16); }
__device__ __forceinline__ float bflo(unsigned w) { return __builtin_bit_cast(float, w << 16); }
__device__ __forceinline__ float bfhi(unsigned w) { return __builtin_bit_cast(float, w & 0xffff0000u); }
template <int CTRL> __device__ __forceinline__ float dppf(float x) { return __builtin_bit_cast(float, __builtin_amdgcn_update_dpp(0, __builtin_bit_cast(int, x), CTRL, 0xF, 0xF, true)); }
__device__ __forceinline__ float red8(float x) { x += dppf<0xB1>(x); x += dppf<0x4E>(x); x += dppf<0x141>(x); return x; }
__device__ __forceinline__ float wave_sum(float v) {
    v = red8(v); v += dppf<0x140>(v);
    const float a0 = __builtin_bit_cast(float, __builtin_amdgcn_readlane(__builtin_bit_cast(int, v), 0));
    const float a1 = __builtin_bit_cast(float, __builtin_amdgcn_readlane(__builtin_bit_cast(int, v), 16));
    const float a2 = __builtin_bit_cast(float, __builtin_amdgcn_readlane(__builtin_bit_cast(int, v), 32));
    const float a3 = __builtin_bit_cast(float, __builtin_amdgcn_readlane(__builtin_bit_cast(int, v), 48));
    return (a0 + a1) + (a2 + a3);
}
__device__ __forceinline__ float sigmoidf_(float x) { return __builtin_amdgcn_rcpf(1.f + __expf(-x)); }
#define LDS_WAIT() asm volatile("s_waitcnt lgkmcnt(0)" ::: "memory")

#define XB_TMO      128
#define XB_XCNT(j)  (256  + 64 * (j))
#define XB_XSUB(j)  (1280 + 64 * (j))
#define XB_XGEN(j)  (2304 + 64 * (j))
#define XB_TOP      3328
#define XB_TOPGEN   3392
#define XCD_BAR_WORDS 3456
#define XB_SPIN_CAP (1u << 22)
__device__ __forceinline__ unsigned xb_ld(unsigned* p)              { return __hip_atomic_load(p, __ATOMIC_RELAXED, __HIP_MEMORY_SCOPE_AGENT); }
__device__ __forceinline__ unsigned xb_add(unsigned* p, unsigned v) { return __hip_atomic_fetch_add(p, v, __ATOMIC_RELAXED, __HIP_MEMORY_SCOPE_AGENT); }
__device__ __forceinline__ unsigned xb_xcc_id() { return (unsigned)__builtin_amdgcn_s_getreg((3 << 11) | 20) & 0xFu; }
#define XB_SPIN(cond, bar) do { unsigned _sp = 0; while (cond) { __builtin_amdgcn_s_sleep(1); \
    if ((++_sp & 255u) == 0u) { if (xb_ld(&(bar)[XB_TMO])) break; if (_sp > XB_SPIN_CAP) { atomicAdd(&(bar)[XB_TMO], 1u); break; } } } } while (0)
struct XcdBarrier { unsigned* bar; unsigned x; volatile LAS unsigned* st; };
__device__ __forceinline__ XcdBarrier xcd_barrier_post(unsigned* bar, volatile LAS unsigned* st) {
    XcdBarrier b; b.bar = bar; b.x = xb_xcc_id(); b.st = st;
    if (threadIdx.x == 0) (void)xb_add(&bar[XB_XCNT(b.x)], 1u);
    return b;
}
__device__ __forceinline__ void xcd_barrier_complete(unsigned* bar, unsigned x, unsigned& nloc, unsigned& nx) {
    const unsigned G = gridDim.x * gridDim.y * gridDim.z;
    unsigned sum, cnt, mine, sp = 0u;
    for (;;) {
        sum = 0u; cnt = 0u; mine = 0u;
#pragma unroll
        for (unsigned j = 0; j < 16; ++j) { const unsigned c = xb_ld(&bar[XB_XCNT(j)]); sum += c; cnt += (c > 0u) ? 1u : 0u; mine = (j == x) ? c : mine; }
        if (sum == G) break;
        __builtin_amdgcn_s_sleep(1);
        if ((++sp & 255u) == 0u) { if (xb_ld(&bar[XB_TMO])) break; if (sp > XB_SPIN_CAP) { atomicAdd(&bar[XB_TMO], 1u); break; } }
    }
    nloc = mine > 0u ? mine : 1u; nx = cnt > 0u ? cnt : 1u;
}
__device__ __forceinline__ void xcd_barrier(const XcdBarrier& b) {
    asm volatile("s_waitcnt vmcnt(0)" ::: "memory");
    __syncthreads();
    if (threadIdx.x == 0) {
        unsigned* bar = b.bar;
        __builtin_amdgcn_s_waitcnt(0);
        unsigned nloc = b.st[0], nx = b.st[1];
        if (nloc == 0u) { xcd_barrier_complete(bar, b.x, nloc, nx); b.st[0] = nloc; b.st[1] = nx; }
        const unsigned old = xb_add(&bar[XB_XSUB(b.x)], 1u);
        const unsigned gen = old / nloc;
        if (old + 1u == (gen + 1u) * nloc) {
            __builtin_amdgcn_fence(__ATOMIC_RELEASE, "agent");
            asm volatile("s_waitcnt vmcnt(0)" ::: "memory");
            const unsigned og = xb_add(&bar[XB_TOP], 1u);
            const unsigned tg = og / nx;
            if (og + 1u == (tg + 1u) * nx) xb_add(&bar[XB_TOPGEN], 1u);
            else XB_SPIN(xb_ld(&bar[XB_TOPGEN]) == tg, bar);
            __builtin_amdgcn_fence(__ATOMIC_ACQUIRE, "agent");
            xb_add(&bar[XB_XGEN(b.x)], 1u);
            asm volatile("s_waitcnt vmcnt(0)" ::: "memory");
        } else {
            XB_SPIN(xb_ld(&bar[XB_XGEN(b.x)]) == gen, bar);
            __builtin_amdgcn_fence(__ATOMIC_ACQUIRE, "agent");
            asm volatile("s_waitcnt vmcnt(0)" ::: "memory");
        }
    }
    __syncthreads();
}

__device__ __forceinline__ void flat_barrier(unsigned* cnt) {
    asm volatile("s_waitcnt vmcnt(0)" ::: "memory");
    __syncthreads();
    if (threadIdx.x == 0) {
        const unsigned G = gridDim.x;
        __builtin_amdgcn_fence(__ATOMIC_RELEASE, "agent");
        asm volatile("s_waitcnt vmcnt(0)" ::: "memory");
        const unsigned old = xb_add(cnt, 1u);
        const unsigned target = (old / G + 1u) * G;
        unsigned sp = 0;
        while (xb_ld(cnt) < target) { __builtin_amdgcn_s_sleep(1); if (++sp > (1u << 22)) break; }
        __builtin_amdgcn_fence(__ATOMIC_ACQUIRE, "agent");
        asm volatile("s_waitcnt vmcnt(0)" ::: "memory");
    }
    __syncthreads();
}

__device__ __forceinline__ void xcd_barrier2(const XcdBarrier& b) {
    asm volatile("s_waitcnt vmcnt(0)" ::: "memory");
    __syncthreads();
    if (threadIdx.x == 0) {
        unsigned* bar = b.bar;
        __builtin_amdgcn_s_waitcnt(0);
        unsigned nloc = b.st[0], nx = b.st[1];
        if (nloc == 0u) { xcd_barrier_complete(bar, b.x, nloc, nx); b.st[0] = nloc; b.st[1] = nx; }
        const unsigned old = xb_add(&bar[XB_XSUB(b.x)], 1u);
        const unsigned gen = old / nloc;
        if (old + 1u == (gen + 1u) * nloc) {
            __builtin_amdgcn_fence(__ATOMIC_RELEASE, "agent");
            asm volatile("s_waitcnt vmcnt(0)" ::: "memory");
            (void)xb_add(&bar[XB_TOP], 1u);
        }
        const unsigned target = (gen + 1u) * nx;
        XB_SPIN(xb_ld(&bar[XB_TOP]) < target, bar);
        __builtin_amdgcn_fence(__ATOMIC_ACQUIRE, "agent");
        asm volatile("s_waitcnt vmcnt(0)" ::: "memory");
    }
    __syncthreads();
}

template <int MODE> __device__ __forceinline__ void xcd_barrier2_probe(const XcdBarrier& b) {
    asm volatile("s_waitcnt vmcnt(0)" ::: "memory");
    __syncthreads();
    if (threadIdx.x == 0) {
        unsigned* bar = b.bar;
        unsigned nloc = b.st[0], nx = b.st[1];
        const unsigned old = xb_add(&bar[XB_XSUB(b.x)], 1u);
        const unsigned gen = old / nloc;
        if (old + 1u == (gen + 1u) * nloc) {
            if (!(MODE & 2)) { __builtin_amdgcn_fence(__ATOMIC_RELEASE, "agent"); asm volatile("s_waitcnt vmcnt(0)" ::: "memory"); }
            (void)xb_add(&bar[XB_TOP], 1u);
        }
        const unsigned target = (gen + 1u) * nx;
        XB_SPIN(xb_ld(&bar[XB_TOP]) < target, bar);
        if (!(MODE & 1) && (!(MODE & 4) || (old + 1u == (gen + 1u) * nloc))) { __builtin_amdgcn_fence(__ATOMIC_ACQUIRE, "agent"); asm volatile("s_waitcnt vmcnt(0)" ::: "memory"); }
    }
    __syncthreads();
}

__device__ __forceinline__ void xcd_barrier3(const XcdBarrier& b) {
    asm volatile("s_waitcnt vmcnt(0)" ::: "memory");
    __syncthreads();
    if (threadIdx.x == 0) {
        unsigned* bar = b.bar;
        __builtin_amdgcn_s_waitcnt(0);
        unsigned nloc = b.st[0], nx = b.st[1];
        if (nloc == 0u) { xcd_barrier_complete(bar, b.x, nloc, nx); b.st[0] = nloc; b.st[1] = nx; }
        const unsigned old = xb_add(&bar[XB_XSUB(b.x)], 1u);
        const unsigned gen = old / nloc;
        if (old + 1u == (gen + 1u) * nloc) {
            __builtin_amdgcn_fence(__ATOMIC_RELEASE, "agent");
            asm volatile("s_waitcnt vmcnt(0)" ::: "memory");
            (void)xb_add(&bar[XB_TOP], 1u);
            const unsigned target = (gen + 1u) * nx;
            XB_SPIN(xb_ld(&bar[XB_TOP]) < target, bar);
            __builtin_amdgcn_fence(__ATOMIC_ACQUIRE, "agent");
            asm volatile("s_waitcnt vmcnt(0)" ::: "memory");
            xb_add(&bar[XB_XGEN(b.x)], 1u);
        } else {
            __builtin_amdgcn_fence(__ATOMIC_ACQUIRE, "agent");
            asm volatile("s_waitcnt vmcnt(0)" ::: "memory");
            XB_SPIN(xb_ld(&bar[XB_XGEN(b.x)]) == gen, bar);
        }
    }
    __syncthreads();
}

#define XCD_BARRIER_FILL(b, MISCW, FILL_STMT) do { \
    asm volatile("s_waitcnt vmcnt(0)" ::: "memory"); \
    __syncthreads(); \
    if (threadIdx.x == 0) { \
        unsigned* bar_ = (b).bar; __builtin_amdgcn_s_waitcnt(0); \
        unsigned nloc_ = (b).st[0], nx_ = (b).st[1]; \
        if (nloc_ == 0u) { xcd_barrier_complete(bar_, (b).x, nloc_, nx_); (b).st[0] = nloc_; (b).st[1] = nx_; } \
        const unsigned old_ = xb_add(&bar_[XB_XSUB((b).x)], 1u); const unsigned gen_ = old_ / nloc_; \
        if (old_ + 1u == (gen_ + 1u) * nloc_) { \
            __builtin_amdgcn_fence(__ATOMIC_RELEASE, "agent"); asm volatile("s_waitcnt vmcnt(0)" ::: "memory"); \
            (void)xb_add(&bar_[XB_TOP], 1u); const unsigned target_ = (gen_ + 1u) * nx_; \
            XB_SPIN(xb_ld(&bar_[XB_TOP]) < target_, bar_); \
            __builtin_amdgcn_fence(__ATOMIC_ACQUIRE, "agent"); asm volatile("s_waitcnt vmcnt(0)" ::: "memory"); \
            xb_add(&bar_[XB_XGEN((b).x)], 1u); \
            (MISCW)[0] = 0xffffffffu; \
        } else { \
            __builtin_amdgcn_fence(__ATOMIC_ACQUIRE, "agent"); asm volatile("s_waitcnt vmcnt(0)" ::: "memory"); \
            (MISCW)[0] = gen_; \
        } \
    } \
    __syncthreads(); \
    { const unsigned g_ = (MISCW)[0]; \
      if (g_ != 0xffffffffu) { bool more_ = true; \
        for (;;) { \
            if (threadIdx.x == 0) (MISCW)[1] = (xb_ld(&(b).bar[XB_XGEN((b).x)]) != g_) ? 1u : 0u; \
            __syncthreads(); \
            const bool rel_ = (MISCW)[1] != 0u; \
            __syncthreads(); \
            if (rel_) break; \
            if (more_) { FILL_STMT; } else __builtin_amdgcn_s_sleep(4); \
        } } } \
    __syncthreads(); \
  } while (0)
namespace pg8 {
#define PG8_LAS __attribute__((address_space(3)))
typedef unsigned short bf16_t;
typedef short bf16x8 __attribute__((ext_vector_type(8)));
typedef float f32x4 __attribute__((ext_vector_type(4)));
typedef unsigned u32x4 __attribute__((ext_vector_type(4)));
constexpr int BM = 256, BK = 64, HALF = 128, HTB = HALF * BK * 2  , STAGE_BYTES = 8 * HTB, NXCD = 8, WGM = 8;

__host__ __device__ __forceinline__ int lds_byte(int r, int c) { const int st = (r >> 4) * 2 + (c >> 5), rr = r & 15, cc = c & 31, ob = rr * 64 + cc * 2; return st * 1024 + (ob ^ (((ob >> 9) & 1) << 5)); }
__host__ __device__ __forceinline__ void stage_rc(int b, int& R, int& C) { const int st = b / 1024, sb = b % 1024, swz = sb ^ (((sb >> 9) & 1) << 5); R = (st >> 1) * 16 + swz / 64; C = (st & 1) * 32 + (swz % 64) / 2; }
__host__ __device__ __forceinline__ int perm32(int rho) { const int n = rho >> 4, i = rho & 15; return 8 * (i >> 2) + 4 * n + (i & 3); }

struct Unit { int pm, pn; };
struct Gemm { const bf16_t* A; const bf16_t* Bt; int M, N, K; };

struct StaticOrder {
    int nM, nN, nwg, G, c;
    __host__ __device__ void init(int M, int N, int G_, int c_) { nM = M / BM; nN = N / BM; nwg = nM * nN; G = G_; c = c_; }
    __host__ __device__ bool next(int i, Unit& u) const {
        const long L = (long)i * G + c; if (L >= nwg) return false;
        int wgid = (int)L; { const int q = nwg / NXCD, r = nwg % NXCD, xcd = wgid % NXCD, off = wgid / NXCD; wgid = (xcd < r ? xcd * (q + 1) : r * (q + 1) + (xcd - r) * q) + off; }
        const int nig = WGM * nN, gid = wgid / nig, fm = gid * WGM, gsz = (nM - fm) < WGM ? (nM - fm) : WGM;
        u.pm = fm + ((wgid % nig) % gsz); u.pn = (wgid % nig) / gsz; return true;
    }
    __device__ __forceinline__ void a_ready(const Unit&) const {}
    __device__ __forceinline__ void done(const Unit&) const {}
};
__device__ __forceinline__ unsigned cvt_pk_bf16(float lo, float hi) { unsigned r; asm volatile("v_cvt_pk_bf16_f32 %0, %1, %2" : "=v"(r) : "v"(lo), "v"(hi)); return r; }
typedef float f32x2 __attribute__((ext_vector_type(2)));
template <class Epi, class Sched, bool ALIGN_EPI = false, bool SP2 = false>
__device__ __forceinline__ void gemm_phase(PG8_LAS unsigned char* lds, const Gemm g, const Sched& S, const Epi& E) {
    const int tid = threadIdx.x, wid = __builtin_amdgcn_readfirstlane(tid >> 6), lane = tid & 63, wr = wid >> 2, wc = wid & 3, fr = lane & 15, fq = lane >> 4;
    const int K = g.K, nt = K / BK;
    unsigned voffA[2], voffB[2];
#pragma unroll
    for (int i = 0; i < 2; ++i) { int R, C; stage_rc(tid * 16 + i * 8192, R, C); const int Rb = Epi::PERM ? ((R & ~31) + perm32(R & 31)) : R;
        voffA[i] = (unsigned)(R * K + C) * 2u; voffB[i] = (unsigned)(Rb * K + C) * 2u; }
    const size_t kstep = (size_t)(BK * 2);
    const size_t hstep = (size_t)HALF * K * 2;
    const size_t tstep = 2 * hstep;
    const unsigned ldsw = (unsigned)wid * 1024u;
    const int aoff = lds_byte(wr * 64 + fr, fq * 8), boff = lds_byte(wc * 32 + fr, fq * 8);
#define PG8_SA(b, h) (((b) * 2 + (h)) * HTB)
#define PG8_SB(b, h) ((4 + (b) * 2 + (h)) * HTB)
#define PG8_STAGE(bufoff, gbase, voff) do { _Pragma("unroll") for (int _i = 0; _i < 2; ++_i) \
        __builtin_amdgcn_global_load_lds((const unsigned*)((const char*)(gbase) + (voff)[_i]), (PG8_LAS unsigned*)(lds + (bufoff) + ldsw + _i * 8192), 16, 0, 0); } while (0)
#define PG8_LDA(dst, b, h) do { _Pragma("unroll") for (int m = 0; m < 4; ++m) _Pragma("unroll") for (int k = 0; k < 2; ++k) dst[m][k] = *(const PG8_LAS bf16x8*)(lds + PG8_SA(b, h) + aoff + m * 2048 + k * 1024); } while (0)
#define PG8_LDB(dst, b, h) do { _Pragma("unroll") for (int n = 0; n < 2; ++n) _Pragma("unroll") for (int k = 0; k < 2; ++k) dst[n][k] = *(const PG8_LAS bf16x8*)(lds + PG8_SB(b, h) + boff + n * 2048 + k * 1024); } while (0)
#define PG8_MMA(ai, bj, At, Bt) do { __builtin_amdgcn_s_setprio(1); _Pragma("unroll") for (int m = 0; m < 4; ++m) _Pragma("unroll") for (int n = 0; n < 2; ++n) _Pragma("unroll") for (int k = 0; k < 2; ++k) \
        acc[ai][bj][m][n] = __builtin_amdgcn_mfma_f32_16x16x32_bf16(Bt[n][k], At[m][k], acc[ai][bj][m][n], 0, 0, 0); __builtin_amdgcn_s_setprio(0); } while (0)
#define PG8_WAIT_V(n) asm volatile("s_waitcnt vmcnt(" #n ")" ::: "memory")
#define PG8_WAIT_L(n) asm volatile("s_waitcnt lgkmcnt(" #n ")" ::: "memory")
#define PG8_BAR __builtin_amdgcn_s_barrier()
#define PG8_SCHED __builtin_amdgcn_sched_barrier(0)
    Unit cur, nxt; int ui = 0;
    if (!S.next(0, cur)) return;
    f32x4 acc[2][2][4][2];
#pragma unroll
    for (int a = 0; a < 2; ++a)
#pragma unroll
        for (int b = 0; b < 2; ++b)
#pragma unroll
            for (int m = 0; m < 4; ++m)
#pragma unroll
                for (int n = 0; n < 2; ++n) acc[a][b][m][n] = (f32x4){0.f, 0.f, 0.f, 0.f};
    bf16x8 At[4][2], B0[2][2], B1[2][2];
    const char* cA = (const char*)g.A + (size_t)cur.pm * tstep; const char* cB = (const char*)g.Bt + (size_t)cur.pn * tstep;
    S.a_ready(cur);
    if constexpr (SP2) {
        PG8_STAGE(PG8_SB(0, 0), cB, voffB); PG8_STAGE(PG8_SB(0, 1), cB + hstep, voffB); PG8_STAGE(PG8_SA(0, 0), cA, voffA); PG8_STAGE(PG8_SA(0, 1), cA + hstep, voffA);
        if (wr == 1) PG8_BAR;
        PG8_WAIT_V(2); PG8_BAR;
        PG8_STAGE(PG8_SB(1, 0), cB + kstep, voffB); PG8_STAGE(PG8_SA(1, 0), cA + kstep, voffA); PG8_STAGE(PG8_SB(1, 1), cB + hstep + kstep, voffB);
        PG8_WAIT_V(6); PG8_BAR;
    } else {
        PG8_STAGE(PG8_SB(0, 0), cB, voffB); PG8_STAGE(PG8_SA(0, 0), cA, voffA); PG8_STAGE(PG8_SB(0, 1), cB + hstep, voffB); PG8_STAGE(PG8_SA(0, 1), cA + hstep, voffA);
        if (wr == 1) PG8_BAR;
        PG8_WAIT_V(4); PG8_BAR;
        PG8_STAGE(PG8_SB(1, 0), cB + kstep, voffB); PG8_STAGE(PG8_SA(1, 0), cA + kstep, voffA); PG8_STAGE(PG8_SB(1, 1), cB + hstep + kstep, voffB);
        PG8_WAIT_V(6); PG8_BAR;
    }
    for (;;) {
        const bool has_next = S.next(ui + 1, nxt);
        const char* nA = has_next ? (const char*)g.A + (size_t)nxt.pm * tstep : cA; const char* nB = has_next ? (const char*)g.Bt + (size_t)nxt.pn * tstep : cB;
        for (int t = 0; t < nt; t += 2) {
            const bool last = (t == nt - 2);
            const char* a1 = cA + (size_t)(t + 1) * kstep;
            const char* a2 = last ? nA : cA + (size_t)(t + 2) * kstep; const char* b2 = last ? nB : cB + (size_t)(t + 2) * kstep;
            const char* a3 = a2 + kstep; const char* b3 = b2 + kstep;
            if (last && has_next) S.a_ready(nxt);
            if constexpr (SP2) {
            PG8_LDB(B0, 0, 0); PG8_LDB(B1, 0, 1); PG8_SCHED; PG8_LDA(At, 0, 0); PG8_STAGE(PG8_SA(1, 1), a1 + hstep, voffA);
            PG8_WAIT_V(8); PG8_WAIT_L(0); PG8_BAR; PG8_MMA(0, 0, At, B0); PG8_MMA(0, 1, At, B1); PG8_BAR; PG8_SCHED;
            PG8_LDA(At, 0, 1); PG8_STAGE(PG8_SB(0, 0), b2, voffB); PG8_STAGE(PG8_SB(0, 1), b2 + hstep, voffB); PG8_STAGE(PG8_SA(0, 0), a2, voffA);
            PG8_WAIT_V(8); PG8_WAIT_L(0); PG8_BAR; PG8_MMA(1, 0, At, B0); PG8_MMA(1, 1, At, B1); PG8_BAR; PG8_SCHED;
            PG8_LDB(B0, 1, 0); PG8_LDB(B1, 1, 1); PG8_SCHED; PG8_LDA(At, 1, 0); PG8_STAGE(PG8_SA(0, 1), a2 + hstep, voffA);
            PG8_WAIT_V(8); PG8_WAIT_L(0); PG8_BAR; PG8_MMA(0, 0, At, B0); PG8_MMA(0, 1, At, B1); PG8_BAR; PG8_SCHED;
            PG8_LDA(At, 1, 1); PG8_STAGE(PG8_SB(1, 0), b3, voffB); PG8_STAGE(PG8_SB(1, 1), b3 + hstep, voffB); PG8_STAGE(PG8_SA(1, 0), a3, voffA);
            PG8_WAIT_V(8); PG8_WAIT_L(0); PG8_BAR; PG8_MMA(1, 0, At, B0); PG8_MMA(1, 1, At, B1); PG8_BAR; PG8_SCHED;
            } else {
            PG8_LDB(B0, 0, 0); PG8_SCHED; PG8_LDA(At, 0, 0); PG8_STAGE(PG8_SA(1, 1), a1 + hstep, voffA);
            PG8_WAIT_L(8); PG8_BAR; PG8_WAIT_L(0); PG8_MMA(0, 0, At, B0); PG8_BAR; PG8_SCHED;
            PG8_LDB(B1, 0, 1); PG8_STAGE(PG8_SB(0, 0), b2, voffB);
            PG8_BAR; PG8_WAIT_L(0); PG8_MMA(0, 1, At, B1); PG8_BAR;
            PG8_LDA(At, 0, 1); PG8_STAGE(PG8_SA(0, 0), a2, voffA);
            PG8_BAR; PG8_WAIT_L(0); PG8_MMA(1, 0, At, B0); PG8_BAR; PG8_SCHED;
            PG8_STAGE(PG8_SB(0, 1), b2 + hstep, voffB);
            PG8_WAIT_V(6); PG8_BAR; PG8_MMA(1, 1, At, B1); PG8_BAR;
            PG8_LDB(B0, 1, 0); PG8_SCHED; PG8_LDA(At, 1, 0); PG8_STAGE(PG8_SA(0, 1), a2 + hstep, voffA);
            PG8_WAIT_L(8); PG8_BAR; PG8_WAIT_L(0); PG8_MMA(0, 0, At, B0); PG8_BAR; PG8_SCHED;
            PG8_LDB(B1, 1, 1); PG8_STAGE(PG8_SB(1, 0), b3, voffB);
            PG8_BAR; PG8_WAIT_L(0); PG8_MMA(0, 1, At, B1); PG8_BAR;
            PG8_LDA(At, 1, 1); PG8_STAGE(PG8_SA(1, 0), a3, voffA);
            PG8_BAR; PG8_WAIT_L(0); PG8_MMA(1, 0, At, B0); PG8_BAR; PG8_SCHED;
            PG8_STAGE(PG8_SB(1, 1), b3 + hstep, voffB);
            PG8_WAIT_V(6); PG8_BAR; PG8_MMA(1, 1, At, B1); PG8_BAR;
            }
        }
        if constexpr (ALIGN_EPI) { if (wr == 0) PG8_BAR; }
        if constexpr (!Epi::AFTER_DRAIN) { E(acc, cur, wr, wc, fr, fq); S.done(cur); }
        if (!has_next) break;
#pragma unroll
        for (int a = 0; a < 2; ++a)
#pragma unroll
            for (int b = 0; b < 2; ++b)
#pragma unroll
                for (int m = 0; m < 4; ++m)
#pragma unroll
                    for (int n = 0; n < 2; ++n) acc[a][b][m][n] = (f32x4){0.f, 0.f, 0.f, 0.f};
        cur = nxt; cA = nA; cB = nB; ++ui;
        if constexpr (ALIGN_EPI) { if (wr == 1) PG8_BAR; }
    }
    PG8_WAIT_V(0);
    if constexpr (!ALIGN_EPI) { if (wr == 0) PG8_BAR; }
    PG8_BAR;
    if constexpr (Epi::AFTER_DRAIN) { E.fused(acc, cur, wr, wc, fr, fq, lds, wid, lane); S.done(cur); }
#undef PG8_SA
#undef PG8_SB
#undef PG8_STAGE
#undef PG8_LDA
#undef PG8_LDB
#undef PG8_MMA
#undef PG8_WAIT_V
#undef PG8_WAIT_L
#undef PG8_BAR
#undef PG8_SCHED
}
}

__device__ __forceinline__ u32x4 pack8(const f32x4 a, const f32x4 b) {
    u32x4 w; w.x = pk2(a[0], a[1]); w.y = pk2(a[2], a[3]); w.z = pk2(b[0], b[1]); w.w = pk2(b[2], b[3]); return w;
}
__device__ __forceinline__ float tanh_fast(float x) { const float e = __expf(2.f * x); return 1.f - 2.f * __builtin_amdgcn_rcpf(1.f + e); }
__device__ __forceinline__ float decay_of(float v) { const float ew = 0.6065306597126334f * __builtin_amdgcn_rcpf(1.f + __expf(-v)); return __expf(-ew); }
struct EpiInproj {
    static constexpr bool PERM = true, AFTER_DRAIN = false;
    bf16* QKV; float* R32; bf16* Z;
    __device__ __forceinline__ void operator()(const f32x4 (&acc)[2][2][4][2], const pg8::Unit& u, int wr, int wc, int fr, int fq) const {
        const int pn = u.pn;
#pragma unroll
        for (int ai = 0; ai < 2; ++ai)
#pragma unroll
            for (int m = 0; m < 4; ++m) {
                const unsigned row = (unsigned)u.pm * 256u + ai * 128 + wr * 64 + m * 16 + fr;
#pragma unroll
                for (int bj = 0; bj < 2; ++bj) {
                    f32x4 v0 = acc[ai][bj][m][0], v1 = acc[ai][bj][m][1];
                    const int cb = bj * 128 + wc * 32 + 8 * fq;
                    if (pn < 6) {
                        if (pn == 3) { v0 = v0 * C2; v1 = v1 * C2; }
                        *(u32x4*)(QKV + row * 1536 + pn * 256 + cb) = pack8(v0, v1);
                    } else if (pn < 9) {
                        float* p = R32 + row * 768 + (pn - 6) * 256 + cb;
                        *(f32x4*)p = v0; *(f32x4*)(p + 4) = v1;
                    } else if (pn == 9) {
                        if (bj == 0) {
#pragma unroll
                            for (int e = 0; e < 4; ++e) { v0[e] = tanh_fast(v0[e]); v1[e] = tanh_fast(v1[e]); }
                        }
                        *(u32x4*)(Z + row * 384 + cb) = pack8(v0, v1);
                    } else {
                        if (bj == 0) {
#pragma unroll
                            for (int e = 0; e < 4; ++e) { v0[e] = sigmoidf_(v0[e]); v1[e] = sigmoidf_(v1[e]); }
                            *(u32x4*)(Z + row * 384 + 256 + cb) = pack8(v0, v1);
                        }
                    }
                }
            }
    }
};
struct EpiLora {
    static constexpr bool PERM = true, AFTER_DRAIN = false;
    float* DEC; float* ASIG; float* G; const float* w0; const float* a0;
    template <int KIND> __device__ __forceinline__ void body(const f32x4 (&acc)[2][2][4][2], float* dst, const float* bias, unsigned row0, int cb0) const {
#pragma unroll
        for (int bj = 0; bj < 2; ++bj) {
            const int cb = bj * 128 + cb0;
            f32x4 b0 = (f32x4){0.f, 0.f, 0.f, 0.f}, b1 = b0;
            if (KIND != 2) { b0 = *(const f32x4*)(bias + cb); b1 = *(const f32x4*)(bias + cb + 4); }
#pragma unroll
            for (int ai = 0; ai < 2; ++ai)
#pragma unroll
                for (int m = 0; m < 4; ++m) {
                    f32x4 v0 = acc[ai][bj][m][0] + b0, v1 = acc[ai][bj][m][1] + b1;
#pragma unroll
                    for (int e = 0; e < 4; ++e) {
                        if (KIND == 0) { v0[e] = decay_of(v0[e]); v1[e] = decay_of(v1[e]); }
                        if (KIND == 1) { v0[e] = sigmoidf_(v0[e]); v1[e] = sigmoidf_(v1[e]); }
                    }
                    float* p = dst + (row0 + ai * 128 + m * 16) * 256u + cb;
                    *(f32x4*)p = v0; *(f32x4*)(p + 4) = v1;
                    asm volatile("" ::: "memory");
                }
        }
    }
    __device__ __forceinline__ void operator()(const f32x4 (&acc)[2][2][4][2], const pg8::Unit& u, int wr, int wc, int fr, int fq) const {
        const int pn = u.pn; const unsigned row0 = (unsigned)u.pm * 256u + wr * 64 + fr; const int cb0 = wc * 32 + 8 * fq;
        if (pn < 2) body<0>(acc, DEC + (size_t)pn * M * 256, w0 + pn * 256, row0, cb0);
        else if (pn < 4) body<1>(acc, ASIG + (size_t)(pn - 2) * M * 256, a0 + (pn - 2) * 256, row0, cb0);
        else body<2>(acc, G, w0, row0, cb0);
    }
};
struct EpiOut {
    static constexpr bool PERM = true, AFTER_DRAIN = false;
    float* Y;
    __device__ __forceinline__ void operator()(const f32x4 (&acc)[2][2][4][2], const pg8::Unit& u, int wr, int wc, int fr, int fq) const {
#pragma unroll
        for (int ai = 0; ai < 2; ++ai)
#pragma unroll
            for (int m = 0; m < 4; ++m) {
                const unsigned row = (unsigned)u.pm * 256u + ai * 128 + wr * 64 + m * 16 + fr;
#pragma unroll
                for (int bj = 0; bj < 2; ++bj) {
                    float* p = Y + row * 1024 + u.pn * 256 + bj * 128 + wc * 32 + 8 * fq;
                    *(f32x4*)p = acc[ai][bj][m][0]; *(f32x4*)(p + 4) = acc[ai][bj][m][1];
                }
            }
    }
};
struct EpiMoe1 {
    static constexpr bool PERM = true, AFTER_DRAIN = false;
    bf16* HID;
    __device__ __forceinline__ void operator()(const f32x4 (&acc)[2][2][4][2], const pg8::Unit& u, int wr, int wc, int fr, int fq) const {
        const int pnl = u.pn & 7;
#pragma unroll
        for (int ai = 0; ai < 2; ++ai)
#pragma unroll
            for (int m = 0; m < 4; ++m) {
                const unsigned row = (unsigned)u.pm * 256u + ai * 128 + wr * 64 + m * 16 + fr;
                f32x4 h0, h1;
#pragma unroll
                for (int e = 0; e < 4; ++e) {
                    const float g0 = acc[ai][0][m][0][e], g1 = acc[ai][0][m][1][e];
                    h0[e] = g0 * sigmoidf_(g0) * acc[ai][1][m][0][e];
                    h1[e] = g1 * sigmoidf_(g1) * acc[ai][1][m][1][e];
                }
                *(u32x4*)(HID + row * 1024 + pnl * 128 + wc * 32 + 8 * fq) = pack8(h0, h1);
            }
    }
};
struct EpiMoe2 {
    static constexpr bool PERM = true, AFTER_DRAIN = false;
    bf16* OUTE; const float* selg;
    __device__ __forceinline__ void operator()(const f32x4 (&acc)[2][2][4][2], const pg8::Unit& u, int wr, int wc, int fr, int fq) const {
        const int pnl = u.pn & 3;
#pragma unroll
        for (int ai = 0; ai < 2; ++ai)
#pragma unroll
            for (int m = 0; m < 4; ++m) {
                const unsigned row = (unsigned)u.pm * 256u + ai * 128 + wr * 64 + m * 16 + fr;
                const float gt = selg[row];
#pragma unroll
                for (int bj = 0; bj < 2; ++bj)
                    *(u32x4*)(OUTE + row * 1024 + pnl * 256 + bj * 128 + wc * 32 + 8 * fq) = pack8(acc[ai][bj][m][0] * gt, acc[ai][bj][m][1] * gt);
            }
    }
};

struct TileSched {
    int nM, nN, G, c; bool latent_only;
    __device__ __forceinline__ bool next(int i, pg8::Unit& u) const {
        const long L = (long)i * G + c; if (L >= (long)nM * nN) return false;
        const int pmi = (int)(L / nN); u.pn = (int)(L % nN); u.pm = latent_only ? (pmi >> 3) * 9 + 1 + (pmi & 7) : pmi; return true;
    }
    __device__ __forceinline__ void a_ready(const pg8::Unit&) const {}
    __device__ __forceinline__ void done(const pg8::Unit&) const {}
};
struct InprojLastSched {
    int G, c;
    __device__ __forceinline__ bool next(int i, pg8::Unit& u) const {
        const int L = i * G + c; if (L >= 768) return false;
        if (L < 704) { const int pmi = L / 11; u.pn = L % 11; u.pm = (pmi >> 3) * 9 + 1 + (pmi & 7); }
        else { const int r = L - 704; u.pm = (r >> 3) * 9; const int k = r & 7; u.pn = k == 0 ? 2 : k + 3; }
        return true;
    }
    __device__ __forceinline__ void a_ready(const pg8::Unit&) const {}
    __device__ __forceinline__ void done(const pg8::Unit&) const {}
};
struct MoeSched {
    int nMe, nNe, G, c;
    __device__ __forceinline__ bool next(int i, pg8::Unit& u) const {
        const long L = (long)i * G + c; if (L >= (long)NE * nMe * nNe) return false;
        const int pnl = (int)(L % nNe), t = (int)(L / nNe), pml = t % nMe, e = t / nMe;
        u.pm = e * 9 + pml; u.pn = e * nNe + pnl; return true;
    }
    __device__ __forceinline__ void a_ready(const pg8::Unit&) const {}
    __device__ __forceinline__ void done(const pg8::Unit&) const {}
};

template <class Epi, class Sched>
__device__ __forceinline__ void gemm_ref(const pg8::Gemm g, const Sched& S, const Epi& E) {
    const int tid = threadIdx.x, wid = tid >> 6, lane = tid & 63, wr = wid >> 2, wc = wid & 3, fr = lane & 15, fq = lane >> 4;
    int K = g.K; asm volatile("" : "+s"(K));
    pg8::Unit u;
    for (int ui = 0; S.next(ui, u); ++ui) {
        f32x4 acc[2][2][4][2];
#pragma unroll
        for (int a = 0; a < 2; ++a)
#pragma unroll
            for (int b = 0; b < 2; ++b)
#pragma unroll
                for (int m = 0; m < 4; ++m)
#pragma unroll
                    for (int n = 0; n < 2; ++n) acc[a][b][m][n] = (f32x4){0.f, 0.f, 0.f, 0.f};
        const bf16* Ab = g.A + ((size_t)u.pm * 256 + wr * 64 + fr) * K;
        const bf16* Bb = g.Bt + ((size_t)u.pn * 256 + wc * 32 + 8 * fq) * K;
#pragma unroll
        for (int ai = 0; ai < 2; ++ai)
#pragma unroll
            for (int bj = 0; bj < 2; ++bj)
#pragma unroll
                for (int m = 0; m < 4; ++m)
#pragma unroll
                    for (int n = 0; n < 2; ++n)
#pragma unroll
                        for (int e = 0; e < 4; ++e) {
                            const bf16* ar = Ab + (size_t)(ai * 128 + m * 16) * K; const bf16* br = Bb + (size_t)(bj * 128 + 4 * n + e) * K;
                            float s0 = 0.f, s1 = 0.f;
#pragma unroll 2
                            for (int k0 = 0; k0 < K; k0 += 8) {
                                const u32x4 wa = *(const u32x4*)(ar + k0), wb = *(const u32x4*)(br + k0);
                                s0 += bflo(wa.x) * bflo(wb.x) + bflo(wa.y) * bflo(wb.y) + bflo(wa.z) * bflo(wb.z) + bflo(wa.w) * bflo(wb.w);
                                s1 += bfhi(wa.x) * bfhi(wb.x) + bfhi(wa.y) * bfhi(wb.y) + bfhi(wa.z) * bfhi(wb.z) + bfhi(wa.w) * bfhi(wb.w);
                            }
                            acc[ai][bj][m][n][e] = s0 + s1;
                            asm volatile("" ::: "memory");
                        }
        E(acc, u, wr, wc, fr, fq);
    }
}
template <class Epi, class Sched>
__device__ __forceinline__ void run_gemm(LAS unsigned char* lds, const pg8::Gemm g, const Sched& S, const Epi& E) {
#if GOLD_GEMM
    gemm_ref<Epi, Sched>(g, S, E);
    __syncthreads();
#else
    pg8::Gemm g2 = g; { int kd = g.K; asm volatile("" : "+s"(kd)); g2.K = kd; }
    pg8::gemm_phase<Epi, Sched, true, true>(lds, g2, S, E);
#endif
}

struct Args { const float* in[29]; float* out; unsigned char* ws; int ph_lo, ph_hi; };
enum { I_X = 0, I_C, I_CTX, I_CCTX, I_WMOD, I_BMOD, I_GPREMIX, I_GPOSTMIX, I_GPREFFN, I_GPOSTFFN, I_WIN, I_WOUT, I_QGAIN, I_KGAIN, I_RPB,
       I_W0, I_WUP, I_A0, I_AUP, I_GUP, I_KK, I_KA, I_RK, I_LNXW, I_LNXB, I_WROUTER, I_WEGATE, I_WEUP, I_WEDOWN };

struct Frame {
    LAS unsigned char* lds; volatile LAS unsigned* MISC; unsigned* ctl;
    int wave, vcu, G;
    const float* const* in; float* out; unsigned char* ws;
};
#define TID_ ((int)threadIdx.x)
#define LANE_ ((int)(threadIdx.x & 63u))
#define WSP(T_, off) ((T_*)(F.ws + (off)))

__device__ __forceinline__ void cvt_item(const float* src, int ld_src, bf16* dst, int ld_dst, LAS float* scr, int lane) {
#pragma unroll 8
    for (int i = 0; i < 32; ++i) { const int kk = 2 * i + (lane >> 5); scr[kk * 33 + (lane & 31)] = src[(size_t)kk * ld_src + (lane & 31)]; }
    LDS_WAIT(); asm volatile("" ::: "memory");
    const int c = lane & 7;
#pragma unroll
    for (int j = 0; j < 4; ++j) { const int n = (lane >> 3) + 8 * j; const LAS float* s = scr + (8 * c) * 33 + n;
        u32x4 o; o.x = pk2(s[0 * 33], s[1 * 33]); o.y = pk2(s[2 * 33], s[3 * 33]); o.z = pk2(s[4 * 33], s[5 * 33]); o.w = pk2(s[6 * 33], s[7 * 33]);
        *(u32x4*)(dst + (size_t)n * ld_dst + 8 * c) = o; }
    LDS_WAIT(); asm volatile("" ::: "memory");
}
__device__ __forceinline__ void cvt_moe_item(Frame& F, int l, int it, LAS float* scr, int lane) {
    const int which = it >> 13, r = it & 8191, e = r >> 9, q = r & 511, kb = q >> 5, nb = q & 31, n0 = nb * 32;
    const float* W = F.in[which == 0 ? I_WEGATE : (which == 1 ? I_WEUP : I_WEDOWN)] + ((size_t)(l * NE + e) * 1024 + kb * 64) * 1024 + n0;
    bf16* dst;
    if (which < 2) dst = WSP(bf16, WS_WGU) + ((size_t)e * 2048 + (n0 >> 7) * 256 + which * 128 + (n0 & 127)) * 1024 + kb * 64;
    else dst = WSP(bf16, WS_WD) + ((size_t)e * 1024 + n0) * 1024 + kb * 64;
    cvt_item(W, 1024, dst, 1024, scr, lane);
}
constexpr int CVT_NMINI = 3 * 8192 / NWAVES, CW_CVTQ = 40960;
__device__ __forceinline__ void cvt_moe_mini(Frame& F, int l, int mb) {
    int lane = LANE_; asm volatile("" : "+v"(lane));
    cvt_moe_item(F, l, mb * NWAVES + F.wave, (LAS float*)(F.lds + F.wave * 16384), lane);
}
__device__ __forceinline__ void cvt_moe_drain(Frame& F, int l, int n) {
    for (;;) {
        if (TID_ == 0) F.MISC[17] = atomicAdd(F.ctl + CW_CVTQ + 64 * l, (unsigned)n);
        __syncthreads();
        const int base = (int)F.MISC[17];
        __syncthreads();
        if (base >= CVT_NMINI) break;
#pragma unroll 1
        for (int k = 0; k < n; ++k) if (base + k < CVT_NMINI) cvt_moe_mini(F, l, base + k);
        __syncthreads();
    }
}

__device__ __forceinline__ void phase_init(Frame& F) {
    const int tid = TID_;
    {
        LAS float* sil = (LAS float*)F.lds;
        LAS float* red = (LAS float*)(F.lds + 40960);
        float* MOD = WSP(float, WS_MOD);
        bool have = false;
        for (int it = F.vcu; it < 2 * 96; it += F.G) {
            if (!have) {
                for (int i = tid; i < 9 * 1024; i += NTHREADS) { const int r = i >> 10, k = i & 1023; const float cv = (r < 8) ? F.in[I_C][r * 1024 + k] : F.in[I_CCTX][k]; sil[i] = cv / (1.f + expf(-cv)); }
                __syncthreads(); have = true;
            }
            const int l = it / 96, n0 = (it % 96) * 64, ks = tid >> 6, col = tid & 63;
            float acc[9];
#pragma unroll
            for (int r = 0; r < 9; ++r) acc[r] = 0.f;
            const float* w = F.in[I_WMOD] + ((size_t)l * 1024 + ks * 128) * 6144 + n0 + col;
            for (int k = 0; k < 128; ++k) { const float wv = w[(size_t)k * 6144];
#pragma unroll
                for (int r = 0; r < 9; ++r) acc[r] += sil[r * 1024 + ks * 128 + k] * wv; }
#pragma unroll
            for (int r = 0; r < 9; ++r) red[(ks * 9 + r) * 64 + col] = acc[r];
            __syncthreads();
            for (int o = tid; o < 576; o += NTHREADS) { const int r = o >> 6, cc = o & 63; float s = 0.f;
#pragma unroll
                for (int k2 = 0; k2 < 8; ++k2) s += red[(k2 * 9 + r) * 64 + cc];
                MOD[(size_t)(l * 9 + r) * 6144 + n0 + cc] = s + F.in[I_BMOD][l * 6144 + n0 + cc]; }
            __syncthreads();
        }
        __syncthreads();
    }
    {
        LAS float* scr = (LAS float*)(F.lds + F.wave * 16384);
        const int gw = F.vcu * NWAVES + F.wave, NGW = F.G * NWAVES;
        bf16* WIN = WSP(bf16, WS_WIN); bf16* WOUT = WSP(bf16, WS_WOUT);
        for (int it = gw; it < 2 * (1344 + 512); it += NGW) {
            const int l = it / 1856, r = it % 1856;
            if (r < 1344) { const int kb = r / 84, n0 = (r % 84) * 32; const int dn = n0 < 768 ? n0 : (n0 < 1920 ? n0 + 768 : n0 - 1152);
                cvt_item(F.in[I_WIN] + ((size_t)l * 1024 + kb * 64) * 2688 + n0, 2688, WIN + ((size_t)l * NINP + dn) * 1024 + kb * 64, 1024, scr, LANE_); }
            else { const int q = r - 1344, kb = q >> 5, n0 = (q & 31) * 32;
                cvt_item(F.in[I_WOUT] + ((size_t)l * 1024 + kb * 64) * 1024 + n0, 1024, WOUT + ((size_t)l * 1024 + n0) * 1024 + kb * 64, 1024, scr, LANE_); }
        }
    }
    {
        const size_t gt = (size_t)F.vcu * NTHREADS + tid, NT = (size_t)F.G * NTHREADS;
        u32x4* WIN4 = WSP(u32x4, WS_WIN);
        for (size_t i = gt; i < (size_t)2 * 128 * 128; i += NT) { const int l = (int)(i >> 14), r = (int)(i & 16383); WIN4[((size_t)l * NINP + 2688) * 128 + r] = (u32x4){0u, 0u, 0u, 0u}; }
        bf16* LORA = WSP(bf16, WS_LORA);
        for (size_t i = gt; i < (size_t)2 * 1280 * 384; i += NT) { const int l = (int)(i / (1280 * 384)), r = (int)(i % (1280 * 384)), n = r / 384, k = r % 384, tile = n >> 8, nn = n & 255;
            float v = 0.f;
            if (tile < 2) { const int d = tile, kk = k - 64 * d; if (kk >= 0 && kk < 64) v = F.in[I_WUP][(((size_t)l * 2 + d) * 64 + kk) * 256 + nn]; }
            else if (tile < 4) { const int d = tile - 2, kk = k - 128 - 64 * d; if (kk >= 0 && kk < 64) v = F.in[I_AUP][(((size_t)l * 2 + d) * 64 + kk) * 256 + nn]; }
            else { const int kk = k - 256; if (kk >= 0) v = F.in[I_GUP][((size_t)l * 128 + kk) * 256 + nn]; }
            LORA[i] = (bf16)f2bf(v); }
    }
}

__device__ __forceinline__ const float* in_row(Frame& F, int b, int t) { return t < CTXL ? F.in[I_CTX] + ((size_t)b * CTXL + t) * 1024 : F.in[I_X] + ((size_t)b * SEQ + (t - CTXL)) * 1024; }
__device__ __forceinline__ float row_ss(const f32x4 (&v)[4]) {
    float s = 0.f;
#pragma unroll
    for (int j = 0; j < 4; ++j) s += (v[j][0] * v[j][0] + v[j][1] * v[j][1]) + (v[j][2] * v[j][2] + v[j][3] * v[j][3]);
    return wave_sum(s);
}
__device__ __forceinline__ void mod_store(const f32x4 (&x)[4], float rinv, const float* g, const float* shift, const float* scale, bf16* dst, int lane, f32x4 (&h)[4]) {
#pragma unroll
    for (int j = 0; j < 4; ++j) { const int e = 256 * j + 4 * lane;
        const f32x4 gg = *(const f32x4*)(g + e), sh = *(const f32x4*)(shift + e), sc = *(const f32x4*)(scale + e);
        h[j] = x[j] * rinv * gg * (sc + 1.f) + sh;
        u32x2 w; w.x = pk2(h[j][0], h[j][1]); w.y = pk2(h[j][2], h[j][3]); *(u32x2*)(dst + e) = w; }
}
__device__ __forceinline__ void phase_row0(Frame& F) {
    const int gw = F.vcu * NWAVES + F.wave, NGW = F.G * NWAVES, lane = LANE_;
    bf16* H = WSP(bf16, WS_H); const float* MOD = WSP(float, WS_MOD);
    for (int m = gw; m < M; m += NGW) { const int b = m / T, t = m % T, r = t < CTXL ? 8 : b;
        const float* xin = in_row(F, b, t);
        f32x4 x[4], h[4];
#pragma unroll
        for (int j = 0; j < 4; ++j) x[j] = *(const f32x4*)(xin + 256 * j + 4 * lane);
        const float rinv = rsqrtf(row_ss(x) * (1.f / 1024.f) + 1e-6f);
        const float* md = MOD + (size_t)(0 * 9 + r) * 6144;
        mod_store(x, rinv, F.in[I_GPREMIX], md, md + 1024, H + (size_t)m * 1024, lane, h);
    }
}
__device__ __forceinline__ void phase_row1(Frame& F, int l, bool dry = false) {
    const int gw = F.vcu * NWAVES + F.wave, NGW = F.G * NWAVES, lane = LANE_;
    const float* X = WSP(float, WS_X); const float* Y = WSP(float, WS_Y); const float* MOD = WSP(float, WS_MOD);
    float* Xs = dry ? WSP(float, WS_XE) : WSP(float, WS_X); bf16* H2 = dry ? WSP(bf16, WS_XE) : WSP(bf16, WS_H2);
    float* AFF = dry ? WSP(float, WS_XE) : WSP(float, WS_AFF); int* INV = dry ? WSP(int, WS_XE) : WSP(int, WS_INV);
    {
        const f32x4* src = (const f32x4*)(F.in[I_WROUTER] + (size_t)l * 1024 * 16); LAS f32x4* dstl = (LAS f32x4*)F.lds;
        for (int i = TID_; i < 4096; i += NTHREADS) dstl[i] = src[i];
        __syncthreads();
    }
    const LAS float* wbase = (const LAS float*)F.lds + lane * 64;
    auto row_ok = [&](int m) { return m < M && !(l == NL - 1 && (m % T) < CTXL); };
    auto next_row = [&](int m) { m += NGW; while (m < M && !row_ok(m)) m += NGW; return m; };
    int m = gw; if (!row_ok(m)) m = next_row(m);
    f32x4 xn[4], yn[4];
    if (m < M) { const float* xin = (l == 0) ? in_row(F, m / T, m % T) : X + (size_t)m * 1024;
#pragma unroll
        for (int j = 0; j < 4; ++j) { yn[j] = *(const f32x4*)(Y + (size_t)m * 1024 + 256 * j + 4 * lane); xn[j] = *(const f32x4*)(xin + 256 * j + 4 * lane); } }
    for (; m < M; ) { const int b = m / T, t = m % T, r = t < CTXL ? 8 : b;
        const float* md = MOD + (size_t)(l * 9 + r) * 6144;
        f32x4 x[4], y[4], h[4];
#pragma unroll
        for (int j = 0; j < 4; ++j) { x[j] = xn[j]; y[j] = yn[j]; }
        const int mnext = next_row(m);
        if (mnext < M) { const float* xin = (l == 0) ? in_row(F, mnext / T, mnext % T) : X + (size_t)mnext * 1024;
#pragma unroll
            for (int j = 0; j < 4; ++j) { yn[j] = *(const f32x4*)(Y + (size_t)mnext * 1024 + 256 * j + 4 * lane); xn[j] = *(const f32x4*)(xin + 256 * j + 4 * lane); } }
        const float rinv = rsqrtf(row_ss(y) * (1.f / 1024.f) + 1e-6f);
#pragma unroll
        for (int j = 0; j < 4; ++j) { const int e = 256 * j + 4 * lane;
            const f32x4 gg = *(const f32x4*)(F.in[I_GPOSTMIX] + l * 1024 + e), gt = *(const f32x4*)(md + 2 * 1024 + e);
            x[j] = x[j] + gt * (y[j] * rinv * gg); *(f32x4*)(Xs + (size_t)m * 1024 + e) = x[j]; }
        const float rinv2 = rsqrtf(row_ss(x) * (1.f / 1024.f) + 1e-6f);
        mod_store(x, rinv2, F.in[I_GPREFFN] + l * 1024, md + 3 * 1024, md + 4 * 1024, H2 + (size_t)m * 1024, lane, h);
        float lg[16];
#pragma unroll
        for (int k = 0; k < 16; ++k) lg[k] = 0.f;
#pragma unroll
        for (int j = 0; j < 4; ++j)
#pragma unroll
            for (int c = 0; c < 4; ++c) { const LAS float* w = wbase + j * 4096 + c * 16; const float hv = h[j][c];
#pragma unroll
                for (int q = 0; q < 4; ++q) { const f32x4 wv = *(const LAS f32x4*)(w + 4 * q); lg[4 * q + 0] += hv * wv[0]; lg[4 * q + 1] += hv * wv[1]; lg[4 * q + 2] += hv * wv[2]; lg[4 * q + 3] += hv * wv[3]; }
                asm volatile("" ::: "memory"); }
        float mx = -1e30f;
#pragma unroll
        for (int k = 0; k < 16; ++k) { lg[k] = wave_sum(lg[k]); mx = fmaxf(mx, lg[k]); }
        float den = 0.f, mine = 0.f;
#pragma unroll
        for (int k = 0; k < 16; ++k) { const float ex = expf(lg[k] - mx); den += ex; if ((lane & 15) == k) mine = ex; }
        if (lane < 16) { AFF[(size_t)m * 16 + lane] = mine / den; INV[(size_t)m * 16 + lane] = -1; }
        m = mnext;
    }
}
__device__ __forceinline__ void phase_row2(Frame& F, int l, bool dry = false) {
    const int gw = F.vcu * NWAVES + F.wave, NGW = F.G * NWAVES, lane = LANE_;
    const float* X = WSP(float, WS_X); const bf16* OUTE = WSP(bf16, WS_OUTE); const float* MOD = WSP(float, WS_MOD);
    float* Xs = dry ? WSP(float, WS_XE) : WSP(float, WS_X); bf16* H = dry ? WSP(bf16, WS_XE) : WSP(bf16, WS_H); float* outp = dry ? WSP(float, WS_XE) : F.out;
    const int* INV = WSP(int, WS_INV);
    const bool last = (l == NL - 1);
    const float tp_scale = 1.f;
    auto row_ok = [&](int m) { return m < M && !(last && (m % T) < CTXL); };
    auto next_row = [&](int m) { m += NGW; while (m < M && !row_ok(m)) m += NGW; return m; };
    int m = gw; if (!row_ok(m)) m = next_row(m);
    f32x4 xn[4]; int invn = -1;
    if (m < M) { invn = INV[(size_t)m * 16 + (lane & 15)];
#pragma unroll
        for (int j = 0; j < 4; ++j) xn[j] = *(const f32x4*)(X + (size_t)m * 1024 + 256 * j + 4 * lane); }
    for (; m < M; ) { const int b = m / T, t = m % T, r = t < CTXL ? 8 : b;
        const float* md = MOD + (size_t)(l * 9 + r) * 6144;
        f32x4 x[4], f[4], h[4];
#pragma unroll
        for (int j = 0; j < 4; ++j) { x[j] = xn[j]; f[j] = (f32x4){0.f, 0.f, 0.f, 0.f}; }
        const int invl = invn;
        const int mnext = next_row(m);
        if (mnext < M) { invn = INV[(size_t)mnext * 16 + (lane & 15)];
#pragma unroll
            for (int j = 0; j < 4; ++j) xn[j] = *(const f32x4*)(X + (size_t)mnext * 1024 + 256 * j + 4 * lane); }
        for (int e = 0; e < 16; ++e) { const int rr = __shfl(invl, e);
            if (rr >= 0) {
#pragma unroll
                for (int j = 0; j < 4; ++j) { const u32x2 w = *(const u32x2*)(OUTE + (size_t)rr * 1024 + 256 * j + 4 * lane);
                    f[j][0] += bflo(w.x); f[j][1] += bfhi(w.x); f[j][2] += bflo(w.y); f[j][3] += bfhi(w.y); } } }
        const float rinv = rsqrtf(row_ss(f) * (1.f / 1024.f) + 1e-6f);
#pragma unroll
        for (int j = 0; j < 4; ++j) { const int e = 256 * j + 4 * lane;
            const f32x4 gg = *(const f32x4*)(F.in[I_GPOSTFFN] + l * 1024 + e), gt = *(const f32x4*)(md + 5 * 1024 + e);
            x[j] = x[j] + gt * (f[j] * rinv * gg);
            if (last) *(f32x4*)(outp + ((size_t)b * SEQ + (t - CTXL)) * 1024 + e) = x[j] * tp_scale;
            else *(f32x4*)(Xs + (size_t)m * 1024 + e) = x[j]; }
        if (!last) {
            const float rinv2 = rsqrtf(row_ss(x) * (1.f / 1024.f) + 1e-6f);
            const float* md2 = MOD + (size_t)((l + 1) * 9 + r) * 6144;
            mod_store(x, rinv2, F.in[I_GPREMIX] + (l + 1) * 1024, md2, md2 + 1024, H + (size_t)m * 1024, lane, h);
        }
        m = mnext;
    }
}

__device__ __forceinline__ void phase_qkprep(Frame& F, int l, bool dry = false) {
    const int gw = F.vcu * NWAVES + F.wave, NGW = F.G * NWAVES, lane = LANE_;
    bf16* QKV = WSP(bf16, WS_QKV); bf16* QO = dry ? WSP(bf16, WS_YD) : QKV;
    const float qg = F.in[I_QGAIN][l * 64 + lane] * C2, kg = F.in[I_KGAIN][l * 64 + lane];
    const int i16 = lane & 15; const bool second = (lane & 16) != 0, colseg = (lane & 32) != 0;
    const float inv = exp2f(-(float)i16 * (13.287712379549449f / 16.f));
    for (int m = gw; m < M; m += NGW) { const int t = m % T; const bool ctx = t < CTXL;
        const int s0 = (l == NL - 1 && ctx) ? 8 : 0;
        const bf16* p = QKV + (size_t)m * 1536 + lane; bf16* po = QO + (size_t)m * 1536 + lane;
        float x[10];
#pragma unroll
        for (int s = 0; s < 10; ++s) x[s] = (s >= s0) ? bf2f(p[s * 64]) : 0.f;
        float cs = 1.f, sn = 0.f;
        if (!ctx) { const int pos = t - CTXL; const float ang = (float)(colseg ? (pos & 63) : (pos >> 6)) * inv; cs = cosf(ang); sn = sinf(ang); if (!second) sn = -sn; }
#pragma unroll
        for (int s = 0; s < 10; ++s) {
            if (s < s0) continue;
            const float ss = wave_sum(x[s] * x[s]);
            float y = x[s] * __builtin_amdgcn_rsqf(ss * (1.f / 64.f) + 1e-6f) * (s < 8 ? qg : kg);
            const float other = __shfl_xor(y, 16);
            y = y * cs + other * sn;
            po[s * 64] = (bf16)f2bf(y);
        }
    }
}
#include <hip/hip_bf16.h>
#include <cmath>
namespace attn_body {
using bf16=__hip_bfloat16;
using bf16x8=__attribute__((ext_vector_type(8)))short;
using s16x4=__attribute__((ext_vector_type(4)))short;
using f32x16=__attribute__((ext_vector_type(16)))float;
using u32x4=__attribute__((ext_vector_type(4)))unsigned;
constexpr int D=64,QP=1536,OP=1024;
constexpr int NW=8,QBLK=32,QB=QBLK*NW,KVBLK=64;
__device__ __forceinline__ int crow(int r,int hi){return (r&3)+8*(r>>2)+4*hi;}
#define SBAR() __builtin_amdgcn_sched_barrier(0)
constexpr int NSLOT=3, SLOTB=8192;
constexpr int LDS_K=0, LDS_V=NSLOT*SLOTB, LDS_WS=2*NSLOT*SLOTB, LDS_OST=LDS_WS+NW*64*4, LDS_RPB=LDS_OST+NW*4096, LDS_BYTES=LDS_RPB+3072;
constexpr float C2=0.125f*1.4426950408889634f;
__device__ __forceinline__ void glds16(const void*gsrc,unsigned lds_dst){unsigned keep;
  asm volatile("s_mov_b32 %0, m0\n\ts_mov_b32 m0, %2\n\ts_nop 0\n\tglobal_load_lds_dwordx4 %1, off\n\ts_mov_b32 m0, %0":"=&s"(keep):"v"(gsrc),"s"(lds_dst):"memory");}
__device__ __forceinline__ float max3f(float a,float b,float c){float r;asm("v_max3_f32 %0, %1, %2, %3":"=v"(r):"v"(a),"v"(b),"v"(c));return r;}
__device__ __forceinline__ float max2f(float a,float b){float r;asm("v_max_f32_e32 %0, %1, %2":"=v"(r):"v"(a),"v"(b));return r;}
__device__ __forceinline__ float fadd_s(float a,float b){float r;asm("v_add_f32_e32 %0, %1, %2":"=v"(r):"v"(a),"v"(b));return r;}
__device__ __forceinline__ float fsub_s(float a,float b){float r;asm("v_sub_f32_e32 %0, %1, %2":"=v"(r):"v"(a),"v"(b));return r;}
typedef float f32x2_t __attribute__((ext_vector_type(2))); typedef __bf16 bf16x2_t __attribute__((ext_vector_type(2)));
__device__ __forceinline__ unsigned cvtpk_s(float lo,float hi){f32x2_t v={lo,hi};bf16x2_t b=__builtin_convertvector(v,bf16x2_t);return __builtin_bit_cast(unsigned,b);}
#define WAIT_BAR(N) asm volatile("s_waitcnt vmcnt(" #N ") lgkmcnt(0)\n\ts_barrier":::"memory")

__device__ __forceinline__ void qkt(f32x16&p0,f32x16&p1,const char*Kslot,const bf16x8*qr,const f32x16&negm,int r32,int hi){
  const char*kb=Kslot+hi*1024+r32*16;
  #pragma unroll
  for(int d0=0;d0<4;++d0){
    const bf16x8 b0=*reinterpret_cast<const bf16x8*>(kb+d0*2048);
    const bf16x8 b1=*reinterpret_cast<const bf16x8*>(kb+d0*2048+512);
    if(d0==0){p0=__builtin_amdgcn_mfma_f32_32x32x16_bf16(b0,qr[0],negm,0,0,0);p1=__builtin_amdgcn_mfma_f32_32x32x16_bf16(b1,qr[0],negm,0,0,0);}
    else{p0=__builtin_amdgcn_mfma_f32_32x32x16_bf16(b0,qr[d0],p0,0,0,0);p1=__builtin_amdgcn_mfma_f32_32x32x16_bf16(b1,qr[d0],p1,0,0,0);}}
}
typedef __attribute__((address_space(3))) const char* lds_cptr;
typedef short v4i16_t __attribute__((ext_vector_type(4)));
__device__ __forceinline__ void kload8(bf16x8*kf,lds_cptr kp){
  kf[0]=*(const __attribute__((address_space(3))) bf16x8*)(kp);      kf[1]=*(const __attribute__((address_space(3))) bf16x8*)(kp+512);
  kf[2]=*(const __attribute__((address_space(3))) bf16x8*)(kp+2048); kf[3]=*(const __attribute__((address_space(3))) bf16x8*)(kp+2560);
  kf[4]=*(const __attribute__((address_space(3))) bf16x8*)(kp+4096); kf[5]=*(const __attribute__((address_space(3))) bf16x8*)(kp+4608);
  kf[6]=*(const __attribute__((address_space(3))) bf16x8*)(kp+6144); kf[7]=*(const __attribute__((address_space(3))) bf16x8*)(kp+6656);
}
__device__ __forceinline__ void kload2(bf16x8*kf,lds_cptr kp,int j){ kf[2*j]=*(const __attribute__((address_space(3))) bf16x8*)(kp+j*2048); kf[2*j+1]=*(const __attribute__((address_space(3))) bf16x8*)(kp+j*2048+512); }
__device__ __forceinline__ s16x4 vtr(lds_cptr p){ return __builtin_bit_cast(s16x4,__builtin_amdgcn_ds_read_tr16_b64_v4i16((__attribute__((address_space(3))) v4i16_t*)p)); }
__device__ __forceinline__ float rowmax(const f32x16&p0,const f32x16&p1){
  float a=max3f(p0[0],p0[1],p1[0]),b=max3f(p0[2],p0[3],p1[1]);a=max3f(a,p1[2],p1[3]);
  #pragma unroll
  for(int r=4;r<16;r+=4){a=max3f(a,p0[r],p0[r+1]);b=max3f(b,p0[r+2],p0[r+3]);a=max3f(a,p1[r],p1[r+1]);b=max3f(b,p1[r+2],p1[r+3]);}
  const float m=max2f(a,b);
  auto rr=__builtin_amdgcn_permlane32_swap(__float_as_uint(m),__float_as_uint(m),false,false);
  return max2f(__uint_as_float(rr[0]),__uint_as_float(rr[1]));
}
__device__ __forceinline__ void pv(f32x16*o,int vb,bf16x8 pa0,bf16x8 pa1,bf16x8 pa2,bf16x8 pa3){
  #pragma unroll
  for(int d0=0;d0<2;++d0){s16x4 lo[4],hi[4];
    #pragma unroll
    for(int ks=0;ks<4;++ks){
      asm volatile("ds_read_b64_tr_b16 %0,%1 offset:%c2":"=&v"(lo[ks]):"v"(vb),"i"(d0*4096+ks*1024):"memory");
      asm volatile("ds_read_b64_tr_b16 %0,%1 offset:%c2":"=&v"(hi[ks]):"v"(vb),"i"(d0*4096+ks*1024+512):"memory");}
    asm volatile("s_waitcnt lgkmcnt(0)":::"memory");SBAR();
    #define PK(k) (bf16x8){lo[k][0],lo[k][1],lo[k][2],lo[k][3],hi[k][0],hi[k][1],hi[k][2],hi[k][3]}
    o[d0]=__builtin_amdgcn_mfma_f32_32x32x16_bf16(pa0,PK(0),o[d0],0,0,0);
    o[d0]=__builtin_amdgcn_mfma_f32_32x32x16_bf16(pa1,PK(1),o[d0],0,0,0);
    o[d0]=__builtin_amdgcn_mfma_f32_32x32x16_bf16(pa2,PK(2),o[d0],0,0,0);
    o[d0]=__builtin_amdgcn_mfma_f32_32x32x16_bf16(pa3,PK(3),o[d0],0,0,0);
    #undef PK
  }
}

#ifndef ATTN_STORE16
#define ATTN_STORE16(p,v) (*(u32x4*)(p)=(v))
#endif
template<int THRL,bool WIN> __device__ __forceinline__ void attn_unit(const bf16*Qw0,const bf16*__restrict__ Kh,const bf16*__restrict__ Vh,bf16*Ow0,const int NT,const int toff,const int rb,const int rs0,const float*rpbh,char*shm){
  int tid_=threadIdx.x; asm volatile("":"+v"(tid_));
  const int tid=tid_,lane=tid&63,r32=lane&31,hi=lane>>5; const int wid=__builtin_amdgcn_readfirstlane(tid>>6);
  const bf16*Qw=Qw0+(long)(wid*QBLK)*QP;
  const unsigned lds0=(unsigned)(uintptr_t)shm;
  float*wsf=(float*)(shm+LDS_WS)+wid*64;
  const bf16*ksrc=Kh+(long)lane*QP+wid*8;
  const bf16*vsrc=Vh+(long)(16*(wid&3)+(lane>>2))*QP+(wid>>2)*32+(lane&3)*8;
  const unsigned kdst=lds0+LDS_K+wid*1024, vdst=lds0+LDS_V+wid*1024;
  #define TROW(t) ((long)(((t)+(((t)>=4)?toff:0))*KVBLK)*QP)
  #define DMA_K(t,slot) glds16(ksrc+TROW(t),(unsigned)__builtin_amdgcn_readfirstlane(kdst+(slot)))
  #define DMA_V(t,slot) glds16(vsrc+TROW(t),(unsigned)__builtin_amdgcn_readfirstlane(vdst+(slot)))
  const int vb0=(int)(lds0+LDS_V)+((lane>>4)&1)*32+(lane&3)*8+(4*hi+((lane&15)>>2))*64;
  const char*Kbase=shm+LDS_K; bf16x8 kf[8];
  const lds_cptr shm3=(lds_cptr)shm; const lds_cptr kp0=shm3+LDS_K+hi*1024+r32*16; const lds_cptr vp0=shm3+LDS_V+((lane>>4)&1)*32+(lane&3)*8+(4*hi+((lane&15)>>2))*64;
  DMA_K(0,0);DMA_V(0,0);DMA_K(1,SLOTB);
  bf16x8 qr[4];
  #pragma unroll
  for(int d0=0;d0<4;++d0)qr[d0]=*reinterpret_cast<const bf16x8*>(&Qw[(long)r32*QP+d0*16+hi*8]);
  float mhat=0.f,l_reg=0.f;f32x16 o[2];o[0]=f32x16{};o[1]=f32x16{};f32x16 negm=f32x16{};asm volatile("":"+v"(negm));
  const int gr=4*rb+(wid>>1), gc=(wid&1)*32+r32, rsq=min(max(gr-4,0),24), csq=min(max(gc-8,0),48);
  const float*rpbl=(const float*)(shm+LDS_RPB+256)+(15-gc+4*hi);
  const int kcb=4*hi-csq;
  if(WIN){ for(int i_=tid;i_<15*31;i_+=512)((float*)(shm+LDS_RPB+256))[i_]=rpbh[i_]*1.4426950408889634f; }
  #define CMASK(P0,P1,t) do{ if(WIN && (t)>=4){ const int kr_=rs0+(t)-4; const bool rowok_=(kr_>=rsq)&&(kr_<rsq+8); \
      if(!rowok_){ _Pragma("unroll") for(int r=0;r<16;++r){P0[r]=-INFINITY;P1[r]=-INFINITY;} } \
      else { const float*bp_=rpbl+(kr_-gr+7)*31; \
        _Pragma("unroll") for(int r=0;r<16;++r){ const int o_=(r&3)+8*(r>>2); \
          const float b0_=bp_[o_], b1_=bp_[o_+32]; \
          P0[r]=((unsigned)(kcb+o_)<16u)?P0[r]+b0_:-INFINITY; P1[r]=((unsigned)(kcb+o_+32)<16u)?P1[r]+b1_:-INFINITY; } } } }while(0)
  bool resc=false;
  #define START(P0,P1) do{ const float rm=rowmax(P0,P1); resc=false; \
    { const float dl=rm; mhat=fadd_s(mhat,dl); \
      _Pragma("unroll") for(int r=0;r<16;++r){P0[r]=fsub_s(P0[r],dl);P1[r]=fsub_s(P1[r],dl);} \
      _Pragma("unroll") for(int r=0;r<16;++r)negm[r]=-mhat; asm volatile("":"+v"(negm)); } \
    _Pragma("unroll") for(int r=0;r<16;++r)P0[r]=__builtin_amdgcn_exp2f(P0[r]); }while(0)
  #define RESC() do{ if(resc){ asm volatile("s_waitcnt lgkmcnt(0)":::"memory"); \
      _Pragma("unroll") for(int d_=0;d_<2;++d_) _Pragma("unroll") for(int r=0;r<16;++r)o[d_][r]*=wsf[crow(r,hi)]; } }while(0)
  f32x16 pA0,pA1,pB0,pB1;
  int sl_prev=0,sl_cur=0,sl_next=SLOTB;
  #define ROT() do{sl_prev=sl_cur;sl_cur=sl_next;sl_next=(sl_next==(NSLOT-1)*SLOTB)?0:sl_next+SLOTB;}while(0)
  DMA_K(2,2*SLOTB);
  WAIT_BAR(3);
  qkt(pA0,pA1,Kbase,qr,negm,r32,hi);asm volatile("s_nop 15\n\ts_nop 7":"+v"(pA0),"+v"(pA1));CMASK(pA0,pA1,0);
  START(pA0,pA1);
  _Pragma("unroll") for(int r=0;r<16;++r)pA1[r]=__builtin_amdgcn_exp2f(pA1[r]);
  WAIT_BAR(0);
  DMA_K(3,0);DMA_V(1,SLOTB);
  ROT();
  kload8(kf,kp0+sl_cur);
  WAIT_BAR(2);
  s16x4 vlo[8],vhi[8]; u32x4 pw0,pw1,pw2,pw3;
  #define PKW(P,B) cvtpk_s(P[B],P[B+1])
  #define PAF(k) __builtin_bit_cast(bf16x8,pw##k)
  #define VFR(i) (bf16x8){vlo[i][0],vlo[i][1],vlo[i][2],vlo[i][3],vhi[i][0],vhi[i][1],vhi[i][2],vhi[i][3]}
  #define PIN(x) asm volatile("":"+v"(x))
  #define MX3(a,b,c) __builtin_fmaxf(__builtin_fmaxf((a),(b)),(c))
  #define GAPA(MF,A0,A1,A2,A3,W0,W1,PW) do{ MF; sacc+=A0; sacc+=A1; sacc+=A2; sacc+=A3; PIN(sacc); W0; W1; PIN(PW); SBAR(); }while(0)
  #define EX(v) __builtin_amdgcn_exp2f(v)
  #define GAPB(MF,X,B) do{ MF; X[B]=EX(X[B]); X[B+1]=EX(X[B+1]); X[B+2]=EX(X[B+2]); X[B+3]=EX(X[B+3]); PIN(X); SBAR(); }while(0)
  #define VRD(i) do{ vlo[i]=vtr(vp_+(((i)>>2)*4096+((i)&3)*1024)); vhi[i]=vtr(vp_+(((i)>>2)*4096+((i)&3)*1024+512)); }while(0)
  #define KRD(G,j) do{ if(G){ kload2(kf,kp0+sl_next,j); SBAR(); } }while(0)
  #define STEP(C0,C1,P0,P1,t,GK,GV,GL) do{ SBAR(); \
    const lds_cptr vp_=vp0+sl_prev; \
    VRD(0); SBAR(); float sacc=(P0[0]+P0[1]); \
    GAPA(C0=__builtin_amdgcn_mfma_f32_32x32x16_bf16(kf[0],qr[0],negm,0,0,0), P0[2],P0[3],P0[4],P0[5],     pw0[0]=PKW(P0,0), pw0[1]=PKW(P0,2), pw0); \
    VRD(4); SBAR(); GAPA(C1=__builtin_amdgcn_mfma_f32_32x32x16_bf16(kf[1],qr[0],negm,0,0,0), P0[6],P0[7],P0[8],P0[9],     pw0[2]=PKW(P0,4), pw0[3]=PKW(P0,6), pw0); \
    VRD(1); SBAR(); GAPA(C0=__builtin_amdgcn_mfma_f32_32x32x16_bf16(kf[2],qr[1],C0,0,0,0),   P0[10],P0[11],P0[12],P0[13], pw1[0]=PKW(P0,8), pw1[1]=PKW(P0,10), pw1); \
    VRD(5); SBAR(); GAPA(C1=__builtin_amdgcn_mfma_f32_32x32x16_bf16(kf[3],qr[1],C1,0,0,0),   P0[14],P0[15],P1[0],P1[1],   pw1[2]=PKW(P0,12),pw1[3]=PKW(P0,14), pw1); \
    VRD(2); SBAR(); GAPA(C0=__builtin_amdgcn_mfma_f32_32x32x16_bf16(kf[4],qr[2],C0,0,0,0),   P1[2],P1[3],P1[4],P1[5],     pw2[0]=PKW(P1,0), pw2[1]=PKW(P1,2), pw2); \
    VRD(6); SBAR(); GAPA(C1=__builtin_amdgcn_mfma_f32_32x32x16_bf16(kf[5],qr[2],C1,0,0,0),   P1[6],P1[7],P1[8],P1[9],     pw2[2]=PKW(P1,4), pw2[3]=PKW(P1,6), pw2); \
    VRD(3); SBAR(); GAPA(C0=__builtin_amdgcn_mfma_f32_32x32x16_bf16(kf[6],qr[3],C0,0,0,0),   P1[10],P1[11],P1[12],P1[13], pw3[0]=PKW(P1,8), pw3[1]=PKW(P1,10), pw3); \
    VRD(7); SBAR(); GAPA(C1=__builtin_amdgcn_mfma_f32_32x32x16_bf16(kf[7],qr[3],C1,0,0,0),   P1[14],P1[15],0.f,0.f,       pw3[2]=PKW(P1,12),pw3[3]=PKW(P1,14), pw3); \
    l_reg+=sacc; \
    if(GK){DMA_K((t)+3,sl_cur);} if(GV){DMA_V((t)+1,sl_next);} \
    CMASK(C0,C1,t); \
    { float a=MX3(C0[0],C0[1],C1[0]),b=MX3(C0[2],C0[3],C1[1]); a=MX3(a,C1[2],C1[3]); \
      _Pragma("unroll") for(int r=4;r<16;r+=4){a=MX3(a,C0[r],C0[r+1]);b=MX3(b,C0[r+2],C0[r+3]);a=MX3(a,C1[r],C1[r+1]);b=MX3(b,C1[r+2],C1[r+3]);} \
      float rm=__builtin_fmaxf(a,b); { auto rr=__builtin_amdgcn_permlane32_swap(__float_as_uint(rm),__float_as_uint(rm),false,false); rm=__builtin_fmaxf(__uint_as_float(rr[0]),__uint_as_float(rr[1])); } \
      resc=false; \
      if(__builtin_expect(__any(rm>(float)THRL),0)){ const float dl=__builtin_fmaxf(rm,0.f); mhat+=dl; \
        _Pragma("unroll") for(int r=0;r<16;++r){C0[r]-=dl;C1[r]-=dl;} \
        _Pragma("unroll") for(int r=0;r<16;++r)negm[r]=-mhat; asm volatile("":"+v"(negm)); \
        const float f=__builtin_amdgcn_exp2f(-dl); l_reg*=f; if(hi==0)wsf[r32]=f; resc=true; } } \
    SBAR(); \
    GAPB(o[0]=__builtin_amdgcn_mfma_f32_32x32x16_bf16(PAF(0),VFR(0),o[0],0,0,0), C0,0); \
    GAPB(o[1]=__builtin_amdgcn_mfma_f32_32x32x16_bf16(PAF(0),VFR(4),o[1],0,0,0), C0,4); \
    KRD(GL,0); GAPB(o[0]=__builtin_amdgcn_mfma_f32_32x32x16_bf16(PAF(1),VFR(1),o[0],0,0,0), C0,8); \
    KRD(GL,1); GAPB(o[1]=__builtin_amdgcn_mfma_f32_32x32x16_bf16(PAF(1),VFR(5),o[1],0,0,0), C0,12); \
    KRD(GL,2); GAPB(o[0]=__builtin_amdgcn_mfma_f32_32x32x16_bf16(PAF(2),VFR(2),o[0],0,0,0), C1,0); \
    KRD(GL,3); GAPB(o[1]=__builtin_amdgcn_mfma_f32_32x32x16_bf16(PAF(2),VFR(6),o[1],0,0,0), C1,4); \
    GAPB(o[0]=__builtin_amdgcn_mfma_f32_32x32x16_bf16(PAF(3),VFR(3),o[0],0,0,0), C1,8); \
    GAPB(o[1]=__builtin_amdgcn_mfma_f32_32x32x16_bf16(PAF(3),VFR(7),o[1],0,0,0), C1,12); \
    }while(0)
  int t=1;
  for(;t+5<NT;t+=2){
    STEP(pB0,pB1,pA0,pA1,t,true,true,true);     WAIT_BAR(2); RESC(); ROT();
    STEP(pA0,pA1,pB0,pB1,t+1,true,true,true);   WAIT_BAR(2); RESC(); ROT();
  }
  #define ENDW(tt) do{ if((tt)+3<NT){WAIT_BAR(2);} else if((tt)+2<NT){WAIT_BAR(1);} else {WAIT_BAR(0);} }while(0)
  for(;t+1<NT;t+=2){
    STEP(pB0,pB1,pA0,pA1,t,(t+3<NT),(t+1<NT),(t+1<NT));       ENDW(t);   RESC(); ROT();
    STEP(pA0,pA1,pB0,pB1,t+1,(t+4<NT),(t+2<NT),(t+2<NT));     ENDW(t+1); RESC(); ROT();
  }
  STEP(pB0,pB1,pA0,pA1,NT-1,false,false,false); RESC();
  { float sacc=pB0[0]+pB0[1]; _Pragma("unroll") for(int r=2;r<16;++r)sacc+=pB0[r]; _Pragma("unroll") for(int r=0;r<16;++r)sacc+=pB1[r]; l_reg+=sacc;
    pw0=(u32x4){PKW(pB0,0),PKW(pB0,2),PKW(pB0,4),PKW(pB0,6)};pw1=(u32x4){PKW(pB0,8),PKW(pB0,10),PKW(pB0,12),PKW(pB0,14)};pw2=(u32x4){PKW(pB1,0),PKW(pB1,2),PKW(pB1,4),PKW(pB1,6)};pw3=(u32x4){PKW(pB1,8),PKW(pB1,10),PKW(pB1,12),PKW(pB1,14)};
    SBAR(); pv(o,vb0+sl_cur,PAF(0),PAF(1),PAF(2),PAF(3)); }
  #undef PKW
  #undef PAF
  #undef VFR
  #undef PIN
  #undef MX3
  #undef GAPA
  #undef GAPB
  #undef EX
  #undef VRD
  #undef KRD
  #undef STEP
  #undef ENDW
  {auto rr=__builtin_amdgcn_permlane32_swap(__float_as_uint(l_reg),__float_as_uint(l_reg),false,false);l_reg=__uint_as_float(rr[0])+__uint_as_float(rr[1]);}
  if(hi==0)wsf[32+r32]=l_reg;asm volatile("s_waitcnt lgkmcnt(0)":::"memory");
  float rli[16];
  #pragma unroll
  for(int r=0;r<16;++r)rli[r]=__builtin_amdgcn_rcpf(wsf[32+crow(r,hi)]);
  bf16*Ow=Ow0+(long)(wid*QBLK)*OP;
  { bf16*stg=(bf16*)(shm+LDS_OST)+wid*2048;
    #pragma unroll
    for(int r=0;r<16;++r){const int orow=crow(r,hi);
      #pragma unroll
      for(int d0=0;d0<2;++d0)stg[orow*64+d0*32+r32]=__float2bfloat16(o[d0][r]*rli[r]);}
    asm volatile("s_waitcnt lgkmcnt(0)":::"memory");
    #pragma unroll
    for(int i=0;i<4;++i){const int row=i*8+(lane>>3),ch=lane&7; const u32x4 v=*(const u32x4*)(stg+row*64+ch*8); ATTN_STORE16(Ow+(long)row*OP+ch*8,v);} }
  asm volatile("s_waitcnt lgkmcnt(0)\n\ts_barrier":::"memory");
  #undef DMA_K
  #undef TROW
  #undef DMA_V
  #undef CMASK
  #undef START
  #undef RESC
  #undef ROT
}
constexpr int ATTN_LDS_BYTES=LDS_BYTES;
#undef SBAR
#undef WAIT_BAR
}
typedef float f32x2 __attribute__((ext_vector_type(2)));
__device__ __forceinline__ int scan_tok(int p, int dir) { return p < CTXL ? (dir ? CTXL - 1 - p : p) : (dir ? (T + CTXL - 1) - p : p); }

constexpr int CS_NCH = T / 16;
constexpr size_t WS_W1F = WS_H;
typedef float f32x16 __attribute__((ext_vector_type(16)));
typedef __bf16 bf16x2_t __attribute__((ext_vector_type(2)));
__device__ __forceinline__ unsigned cvtpk(float lo, float hi) { f32x2 v = {lo, hi}; bf16x2_t b = __builtin_convertvector(v, bf16x2_t); return __builtin_bit_cast(unsigned, b); }
__device__ __forceinline__ bf16x8 pack8f(float a0, float a1, float a2, float a3, float a4, float a5, float a6, float a7) {
    u32x4 w; w.x = cvtpk(a0, a1); w.y = cvtpk(a2, a3); w.z = cvtpk(a4, a5); w.w = cvtpk(a6, a7); return __builtin_bit_cast(bf16x8, w);
}
#define MF4(a, b, c) __builtin_amdgcn_mfma_f32_16x16x4f32((a), (b), (c), 0, 0, 0)

constexpr int PB_BK = 0, PB_AR = 4608, PB_CM = 9216, PB_EM = PB_CM + 16 * 17 * 4, PB_TM = PB_EM + 16 * 20 * 4, PB_P15 = PB_TM + 16 * 20 * 4, PB_BYTES = PB_P15 + 256;
constexpr int PBS = 72;
static_assert(8 * PB_BYTES <= RING_BYTES, "pre-pass LDS");
struct PPIn { float rr[16], kb[16], ww[16], as[16]; };
__device__ __forceinline__ void prepass_load(Frame& F, PPIn& I, int rec, int lane) {
    const int ch = rec / CS_NCH, c = rec % CS_NCH, b = ch >> 3, h = (ch >> 1) & 3, dir = ch & 1;
    const float* R32 = WSP(float, WS_R32); const float* DEC = WSP(float, WS_DEC) + (size_t)dir * M * 256; const float* ASIG = WSP(float, WS_ASIG) + (size_t)dir * M * 256;
    const int t0 = scan_tok(c * 16, dir); const int stp = dir ? -1 : 1;
#pragma unroll
    for (int t = 0; t < 16; ++t) { const size_t m = (size_t)b * T + (t0 + stp * t);
        I.rr[t] = R32[m * 768 + h * 64 + lane]; I.kb[t] = R32[m * 768 + 256 + h * 64 + lane]; I.ww[t] = DEC[m * 256 + h * 64 + lane]; I.as[t] = ASIG[m * 256 + h * 64 + lane]; }
}
__device__ __forceinline__ float bfu(unsigned short v) { return __builtin_bit_cast(float, (unsigned)v << 16); }
__device__ __forceinline__ void prepass_record(Frame& F, int l, int rec, LAS unsigned char* L, int lane, const PPIn& I) {
    const int ch = rec / CS_NCH, h = (ch >> 1) & 3;
    const int c = lane & 31, hh = lane >> 5;
    bf16* W1F = WSP(bf16, WS_W1F) + (size_t)rec * 2048; bf16* W2F = (bf16*)F.out + (size_t)rec * 3200; float* P15F = F.out + (size_t)rec * 1600 + 1536;
    LAS bf16* BK = (LAS bf16*)(L + PB_BK); LAS bf16* AR = (LAS bf16*)(L + PB_AR);
    LAS float* Cm = (LAS float*)(L + PB_CM); LAS float* Em = (LAS float*)(L + PB_EM); LAS float* Tm = (LAS float*)(L + PB_TM); LAS float* P15 = (LAS float*)(L + PB_P15);
    {
        const float kkw = F.in[I_KK][l * 256 + h * 64 + lane], kaw = F.in[I_KA][l * 256 + h * 64 + lane];
        float P = 1.f;
#pragma unroll
        for (int t = 0; t < 16; ++t) {
            const float r_ = I.rr[t], kb_ = I.kb[t], w_ = I.ww[t], as_ = I.as[t];
            float kk_ = kb_ * kkw; kk_ = kk_ * __builtin_amdgcn_rsqf(fmaxf(wave_sum(kk_ * kk_), 1e-24f));
            const float kd_ = kb_ * (1.f + (as_ - 1.f) * kaw);
            const float Pm = P; P *= w_; const float iP = __builtin_amdgcn_rcpf(P);
            AR[t * PBS + lane] = (bf16)f2bf(-kk_ * Pm); AR[(16 + t) * PBS + lane] = (bf16)f2bf(r_ * P);
            BK[t * PBS + lane] = (bf16)f2bf(kk_ * as_ * iP); BK[(16 + t) * PBS + lane] = (bf16)f2bf(kd_ * iP);
        }
        P15[lane] = P;
    }
    LDS_WAIT(); asm volatile("" ::: "memory");
#pragma unroll
    for (int ks = 0; ks < 4; ++ks) {
        const LAS bf16* src = AR + c * PBS + 16 * ks + 4 * hh;
        const u32x2 lo = *(const LAS u32x2*)src, hi = *(const LAS u32x2*)(src + 8);
        *(u32x4*)(W1F + (ks * 64 + lane) * 8) = (u32x4){lo.x, lo.y, hi.x, hi.y};
    }
    f32x16 Gm;
#pragma unroll
    for (int r = 0; r < 16; ++r) Gm[r] = 0.f;
#pragma unroll
    for (int ks = 0; ks < 4; ++ks)
        Gm = __builtin_amdgcn_mfma_f32_32x32x16_bf16(*(const LAS bf16x8*)(BK + c * PBS + 16 * ks + 8 * hh), *(const LAS bf16x8*)(AR + c * PBS + 16 * ks + 8 * hh), Gm, 0, 0, 0);
    {
        const int t = c & 15;
#pragma unroll
        for (int r = 0; r < 16; ++r) { const int s = (r & 3) + 8 * ((r & 7) >> 2) + 4 * hh; const bool keep = (c < 16) ? (s < t) : (s <= t); if (!keep) Gm[r] = 0.f; }
        if (c < 16) {
#pragma unroll
            for (int r = 0; r < 8; ++r) { const int s = (r & 3) + 8 * (r >> 2) + 4 * hh; Cm[s * 17 + t] = Gm[r]; Em[s * 20 + t] = Gm[8 + r]; }
        }
    }
    LDS_WAIT(); asm volatile("" ::: "memory");
    {
        const int rho = lane & 15;
        float x[16];
#pragma unroll
        for (int t = 0; t < 16; ++t) { float acc = (rho == t) ? 1.f : 0.f;
#pragma unroll
            for (int s = 0; s < t; ++s) acc += x[s] * Cm[s * 17 + t];
            x[t] = acc; }
        if (lane < 16) {
#pragma unroll
            for (int q = 0; q < 4; ++q) *(LAS f32x4*)(Tm + rho * 20 + 4 * q) = (f32x4){x[4 * q], x[4 * q + 1], x[4 * q + 2], x[4 * q + 3]}; }
    }
    LDS_WAIT(); asm volatile("" ::: "memory");
    bf16x8 A2;
    {
        float ta[8];
#pragma unroll
        for (int jj = 0; jj < 8; ++jj) ta[jj] = (c < 16) ? Tm[((jj & 3) + 8 * (jj >> 2) + 4 * hh) * 20 + c] : 0.f;
        const bf16x8 Aet = pack8f(ta[0], ta[1], ta[2], ta[3], ta[4], ta[5], ta[6], ta[7]);
        f32x4 e0 = (f32x4){0.f, 0.f, 0.f, 0.f}, e1 = e0, t0 = e0, t1 = e0;
        if (c >= 16) { e0 = *(const LAS f32x4*)(Em + (c - 16) * 20 + 4 * hh); e1 = *(const LAS f32x4*)(Em + (c - 16) * 20 + 8 + 4 * hh); }
        else { t0 = *(const LAS f32x4*)(Tm + c * 20 + 4 * hh); t1 = *(const LAS f32x4*)(Tm + c * 20 + 8 + 4 * hh); }
        const bf16x8 Bet = pack8f(e0[0], e0[1], e0[2], e0[3], e1[0], e1[1], e1[2], e1[3]);
        f32x16 Z;
#pragma unroll
        for (int r = 0; r < 16; ++r) Z[r] = 0.f;
        const f32x16 Dt = __builtin_amdgcn_mfma_f32_32x32x16_bf16(Aet, Bet, Z, 0, 0, 0);
        A2 = (c >= 16) ? pack8f(Dt[0], Dt[1], Dt[2], Dt[3], Dt[4], Dt[5], Dt[6], Dt[7]) : pack8f(t0[0], t0[1], t0[2], t0[3], t1[0], t1[1], t1[2], t1[3]);
    }
    {
        const bf16x8 Bm = pack8f(Gm[0], Gm[1], Gm[2], Gm[3], Gm[4], Gm[5], Gm[6], Gm[7]);
        const bf16x8 Bz = pack8f(0.f, 0.f, 0.f, 0.f, 0.f, 0.f, 0.f, 0.f);
        f32x16 Ci;
#pragma unroll
        for (int r = 0; r < 16; ++r) Ci[r] = (r >= 8 && c >= 16) ? Gm[r] : 0.f;
        const f32x16 Dm = __builtin_amdgcn_mfma_f32_32x32x16_bf16(A2, (c >= 16) ? Bm : Bz, Ci, 0, 0, 0);
        *(bf16x8*)(W2F + (0 * 64 + lane) * 8) = pack8f(Dm[0], Dm[1], Dm[2], Dm[3], Dm[4], Dm[5], Dm[6], Dm[7]);
        *(bf16x8*)(W2F + (1 * 64 + lane) * 8) = pack8f(Dm[8], Dm[9], Dm[10], Dm[11], Dm[12], Dm[13], Dm[14], Dm[15]);
    }
#pragma unroll
    for (int nt = 0; nt < 2; ++nt) {
        float bb[8]; f32x16 Ci;
#pragma unroll
        for (int jj = 0; jj < 8; ++jj) { const int kap = (jj & 3) + 8 * (jj >> 2) + 4 * hh;
            bb[jj] = bfu(BK[kap * PBS + 32 * nt + c]); Ci[jj] = 0.f; Ci[8 + jj] = bfu(BK[(16 + kap) * PBS + 32 * nt + c]); }
        const f32x16 Dn = __builtin_amdgcn_mfma_f32_32x32x16_bf16(A2, pack8f(bb[0], bb[1], bb[2], bb[3], bb[4], bb[5], bb[6], bb[7]), Ci, 0, 0, 0);
        const float p = P15[32 * nt + c];
        *(bf16x8*)(W2F + ((2 + 2 * nt) * 64 + lane) * 8) = pack8f(Dn[0] * p, Dn[1] * p, Dn[2] * p, Dn[3] * p, Dn[4] * p, Dn[5] * p, Dn[6] * p, Dn[7] * p);
        *(bf16x8*)(W2F + ((3 + 2 * nt) * 64 + lane) * 8) = pack8f(Dn[8] * p, Dn[9] * p, Dn[10] * p, Dn[11] * p, Dn[12] * p, Dn[13] * p, Dn[14] * p, Dn[15] * p);
    }
    { const int blk = c >> 4, reg = c & 15; P15F[lane] = P15[32 * blk + (reg & 3) + 8 * (reg >> 2) + 4 * hh]; }
    LDS_WAIT(); asm volatile("" ::: "memory");
}
__device__ __forceinline__ void phase_prepass(Frame& F, int l) {
    int lane = LANE_; asm volatile("" : "+v"(lane));
    LAS unsigned char* L = F.lds + F.wave * PB_BYTES;
    int rec = F.vcu * NWAVES + F.wave; const int stride = F.G * NWAVES;
    PPIn I; if (rec < 64 * CS_NCH) prepass_load(F, I, rec, lane);
    for (; rec < 64 * CS_NCH; rec += stride) {
        PPIn Nx = I; if (rec + stride < 64 * CS_NCH) prepass_load(F, Nx, rec + stride, lane);
        prepass_record(F, l, rec, L, lane, I);
        I = Nx;
    }
}

constexpr int CS_REC = 4096 + 6144 + 256 + 4096, CS_SLOTS = 8, CS_LEAD = 6;
__device__ __forceinline__ void scan_chunked(Frame& F, int ch, int l) {
    int lane = LANE_; asm volatile("" : "+v"(lane));
    const int wave = F.wave, b = ch >> 3, h = (ch >> 1) & 3, dir = ch & 1, hh = lane >> 5, icol = 32 * (wave & 1) + (lane & 31);
    float* YD = WSP(float, WS_YD) + (size_t)dir * M * 256;
    const float* R32 = WSP(float, WS_R32);
    LAS unsigned char* ring = F.lds;
    u32x4 st[15];
    const int hw = wave - 2;
#define CS_SRC(cc, q) ({ const int rec_ = ch * CS_NCH + (cc); const u32x4* r_; \
        if ((q) < 4) r_ = (const u32x4*)(WSP(bf16, WS_W1F) + (size_t)rec_ * 2048) + lane + (q) * 64; \
        else if ((q) < 10) r_ = (const u32x4*)((const unsigned char*)F.out + (size_t)rec_ * 6400) + lane + ((q) - 4) * 64; \
        else { const int p = (q) * 64 + lane; const int pv = min(max(p - 656, 0), 255); \
            const u32x4* sv_ = (const u32x4*)(R32 + ((size_t)b * T + scan_tok((cc) * 16 + (pv >> 4), dir)) * 768 + 512 + h * 64) + (pv & 15); \
            r_ = ((q) == 10 && lane < 16) ? (const u32x4*)((const unsigned char*)F.out + (size_t)rec_ * 6400) + lane + 384 : sv_; } \
        r_; })
#define CS_ISSUE1(cc, q) do { st[q] = *CS_SRC(cc, q); } while (0)
#define CS_WRITE1(cc, q) do { const int p = (q) * 64 + lane; if ((q) < 14 || p < 912) ((LAS u32x4*)(ring + ((cc) % CS_SLOTS) * CS_REC))[p] = st[q]; } while (0)
#define CS_ISSUE(cc) do { _Pragma("unroll") for (int q = 0; q < 15; ++q) CS_ISSUE1(cc, q); } while (0)
#define CS_WRITE(cc) do { _Pragma("unroll") for (int q = 0; q < 15; ++q) CS_WRITE1(cc, q); } while (0)
#define CS_STEP(wc, q) do { CS_WRITE1(wc, q); if ((wc) + 6 < CS_NCH) CS_ISSUE1((wc) + 6, q); } while (0)
#define CS_BAR() do { asm volatile("s_waitcnt lgkmcnt(0)" ::: "memory"); __builtin_amdgcn_s_barrier(); asm volatile("" ::: "memory"); } while (0)
    if (wave >= 2) {
        CS_ISSUE(hw); CS_WRITE(hw);
        if (hw == 0) { CS_ISSUE(6); CS_WRITE(6); }
        { const int wc1 = (hw == 0) ? 12 : hw + 6; CS_ISSUE(wc1); }
        CS_BAR();
        int c = 0; const int c0 = (hw + 5) % 6;
        for (; c < c0; ++c) CS_BAR();
        for (; c + 6 <= CS_NCH; c += 6) {
            const int wc = c + 7;
            if (wc < CS_NCH) {
                CS_STEP(wc, 0); CS_STEP(wc, 1); CS_STEP(wc, 2); CS_BAR();
                CS_STEP(wc, 3); CS_STEP(wc, 4); CS_STEP(wc, 5); CS_BAR();
                CS_STEP(wc, 6); CS_STEP(wc, 7); CS_STEP(wc, 8); CS_BAR();
                CS_STEP(wc, 9); CS_STEP(wc, 10); CS_BAR();
                CS_STEP(wc, 11); CS_STEP(wc, 12); CS_BAR();
                CS_STEP(wc, 13); CS_STEP(wc, 14); CS_BAR();
            } else { CS_BAR(); CS_BAR(); CS_BAR(); CS_BAR(); CS_BAR(); CS_BAR(); }
        }
        for (; c < CS_NCH; ++c) CS_BAR();
    } else {
        f32x16 X0, X1;
#pragma unroll
        for (int r = 0; r < 16; ++r) { X0[r] = 0.f; X1[r] = 0.f; }
        CS_BAR();
        bf16x8 w1[4], w2[6]; f32x4 p15[8]; float vv[8];
#define CS_RD(cc) do { const LAS unsigned char* rec_ = ring + ((cc) % CS_SLOTS) * CS_REC; \
            _Pragma("unroll") for (int k = 0; k < 4; ++k) w1[k] = ((const LAS bf16x8*)rec_)[k * 64 + lane]; \
            _Pragma("unroll") for (int k = 0; k < 6; ++k) w2[k] = ((const LAS bf16x8*)(rec_ + 4096))[k * 64 + lane]; \
            _Pragma("unroll") for (int k = 0; k < 8; ++k) p15[k] = ((const LAS f32x4*)(rec_ + 10240 + hh * 128))[k]; \
            _Pragma("unroll") for (int jj = 0; jj < 8; ++jj) vv[jj] = ((const LAS float*)(rec_ + 10496))[(8 * (jj >> 2) + 4 * hh + (jj & 3)) * 64 + icol]; } while (0)
        CS_RD(0);
        for (int c = 0; c < CS_NCH; ++c) {
            f32x16 G;
#pragma unroll
            for (int r = 0; r < 16; ++r) G[r] = 0.f;
            G = __builtin_amdgcn_mfma_f32_32x32x16_bf16(w1[0], pack8f(X0[0], X0[1], X0[2], X0[3], X0[4], X0[5], X0[6], X0[7]), G, 0, 0, 0);
            G = __builtin_amdgcn_mfma_f32_32x32x16_bf16(w1[1], pack8f(X0[8], X0[9], X0[10], X0[11], X0[12], X0[13], X0[14], X0[15]), G, 0, 0, 0);
            G = __builtin_amdgcn_mfma_f32_32x32x16_bf16(w1[2], pack8f(X1[0], X1[1], X1[2], X1[3], X1[4], X1[5], X1[6], X1[7]), G, 0, 0, 0);
            G = __builtin_amdgcn_mfma_f32_32x32x16_bf16(w1[3], pack8f(X1[8], X1[9], X1[10], X1[11], X1[12], X1[13], X1[14], X1[15]), G, 0, 0, 0);
            const bf16x8 g1 = pack8f(G[0], G[1], G[2], G[3], G[4], G[5], G[6], G[7]);
            const bf16x8 vf = pack8f(vv[0], vv[1], vv[2], vv[3], vv[4], vv[5], vv[6], vv[7]);
            f32x16 Y = __builtin_amdgcn_mfma_f32_32x32x16_bf16(w2[0], g1, G, 0, 0, 0);
            Y = __builtin_amdgcn_mfma_f32_32x32x16_bf16(w2[1], vf, Y, 0, 0, 0);
#pragma unroll
            for (int k = 0; k < 4; ++k) {
#pragma unroll
                for (int e = 0; e < 4; ++e) { X0[4 * k + e] *= p15[k][e]; X1[4 * k + e] *= p15[4 + k][e]; } }
            X0 = __builtin_amdgcn_mfma_f32_32x32x16_bf16(w2[2], g1, X0, 0, 0, 0);
            X0 = __builtin_amdgcn_mfma_f32_32x32x16_bf16(w2[3], vf, X0, 0, 0, 0);
            X1 = __builtin_amdgcn_mfma_f32_32x32x16_bf16(w2[4], g1, X1, 0, 0, 0);
            X1 = __builtin_amdgcn_mfma_f32_32x32x16_bf16(w2[5], vf, X1, 0, 0, 0);
            if (c + 1 < CS_NCH) CS_RD(c + 1);
            {
                float* yp = YD + ((size_t)b * T + scan_tok(c * 16, dir)) * 256 + h * 64 + icol + (dir ? -4 * hh * 256 : 4 * hh * 256);
                const int st = dir ? -256 : 256;
#pragma unroll
                for (int r = 8; r < 16; ++r) yp[((r & 3) + 8 * ((r >> 2) - 2)) * st] = Y[r];
            }
            asm volatile("" ::: "memory"); __builtin_amdgcn_s_barrier(); asm volatile("" ::: "memory");
        }
#undef CS_RD
    }
#undef CS_BAR
#undef CS_ISSUE
#undef CS_ISSUE1
#undef CS_WRITE1
#undef CS_STEP
#undef CS_SRC
#undef CS_WRITE
    __syncthreads();
}

constexpr int SC_TC = 16, SC_STEP = 6 * 64, SC_BUF = SC_TC * SC_STEP;
constexpr int SC_YOFF = 2 * SC_BUF, SC_DUMMY = SC_YOFF + 2 * SC_TC * 64;
struct ScanVec { f32x4 r0, r1, w0, w1, k0, k1, a0, a1, b0, b1; float vi; };
__device__ __forceinline__ void scan_ld(ScanVec& V, const LAS float* vec, int jc, int i) {
    V.r0 = *(const LAS f32x4*)(vec + 8 * jc); V.r1 = *(const LAS f32x4*)(vec + 8 * jc + 4);
    V.w0 = *(const LAS f32x4*)(vec + 64 + 8 * jc); V.w1 = *(const LAS f32x4*)(vec + 64 + 8 * jc + 4);
    V.k0 = *(const LAS f32x4*)(vec + 128 + 8 * jc); V.k1 = *(const LAS f32x4*)(vec + 128 + 8 * jc + 4);
    V.vi = vec[192 + i];
    V.a0 = *(const LAS f32x4*)(vec + 256 + 8 * jc); V.a1 = *(const LAS f32x4*)(vec + 256 + 8 * jc + 4);
    V.b0 = *(const LAS f32x4*)(vec + 320 + 8 * jc); V.b1 = *(const LAS f32x4*)(vec + 320 + 8 * jc + 4);
}
__device__ __forceinline__ float dot8(const f32x4 s0, const f32x4 s1, const f32x4 x0, const f32x4 x1) {
    const f32x4 p = s0 * x0 + s1 * x1;
    return (p[0] + p[1]) + (p[2] + p[3]);
}
__device__ __forceinline__ void scan_chain(Frame& F, int chain, int half, int l) {
    const int b = chain >> 3, h = (chain >> 1) & 3, dir = chain & 1;
    int tid_ = threadIdx.x; asm volatile("" : "+v"(tid_));
    const int tid = tid_, lane = tid & 63, wave = F.wave, jc = lane & 7, il = 8 * (wave & 3) + (lane >> 3), i = 32 * half + il;
    const bool comp = wave < 4; const int hw = wave & 3, ht = tid & 255;
    LAS float* buf = (LAS float*)F.lds;
    const float* R32 = WSP(float, WS_R32); const float* DEC = WSP(float, WS_DEC) + (size_t)dir * M * 256; const float* ASIG = WSP(float, WS_ASIG) + (size_t)dir * M * 256;
    float* YD = WSP(float, WS_YD) + (size_t)dir * M * 256;
    const float kkw = F.in[I_KK][l * 256 + h * 64 + lane], kaw = F.in[I_KA][l * 256 + h * 64 + lane];
    f32x4 S0 = (f32x4){0.f, 0.f, 0.f, 0.f}, S1 = S0;
    float pr[4][5];
    constexpr int NCH = T / SC_TC;
    const int ywr = (jc == 0) ? il : (SC_DUMMY - SC_YOFF) + ht;
#define SC_LOAD(c) do { _Pragma("unroll") for (int s4 = 0; s4 < 4; ++s4) { const int p = (c) * SC_TC + 4 * hw + s4; const size_t m = (size_t)b * T + scan_tok(p, dir); \
        pr[s4][0] = R32[m * 768 + h * 64 + lane]; pr[s4][1] = R32[m * 768 + 256 + h * 64 + lane]; pr[s4][2] = R32[m * 768 + 512 + h * 64 + lane]; \
        pr[s4][3] = DEC[m * 256 + h * 64 + lane]; pr[s4][4] = ASIG[m * 256 + h * 64 + lane]; } } while (0)
#define SC_PREP(bi) do { _Pragma("unroll") for (int s4 = 0; s4 < 4; ++s4) { const float r_ = pr[s4][0], kb_ = pr[s4][1], v_ = pr[s4][2], de_ = pr[s4][3], as_ = pr[s4][4]; \
        float kk_ = kb_ * kkw; kk_ = kk_ * __builtin_amdgcn_rsqf(fmaxf(wave_sum(kk_ * kk_), 1e-24f)); const float kd_ = kb_ * (1.f + (as_ - 1.f) * kaw); \
        LAS float* o_ = buf + (bi) * SC_BUF + (4 * hw + s4) * SC_STEP + lane; o_[0] = r_; o_[64] = de_; o_[128] = kd_; o_[192] = v_; o_[256] = -kk_; o_[320] = kk_ * as_; } } while (0)
#define SC_FLUSH(c) do { const int s_ = ht >> 4, i2_ = 2 * (ht & 15); \
        const f32x2 yv_ = *(const LAS f32x2*)(buf + SC_YOFF + ((c) & 1) * SC_TC * 32 + s_ * 32 + i2_); \
        *(f32x2*)(YD + ((size_t)b * T + scan_tok((c) * SC_TC + s_, dir)) * 256 + h * 64 + 32 * half + i2_) = yv_; } while (0)
    if (!comp) { SC_LOAD(0); SC_PREP(0); SC_LOAD(1); }
    for (int c = 0; c < NCH; ++c) {
        __syncthreads();
        if (!comp) {
            if (c > 0) SC_FLUSH(c - 1);
            if (c + 1 < NCH) SC_PREP((c + 1) & 1);
            if (c + 2 < NCH) SC_LOAD(c + 2);
        } else {
            const LAS float* bc = buf + (c & 1) * SC_BUF;
            LAS float* yst = buf + SC_YOFF + (c & 1) * SC_TC * 32 + ywr;
            ScanVec V; scan_ld(V, bc, jc, i);
#pragma unroll
            for (int s = 0; s < SC_TC; ++s) {
                ScanVec N = V;
                if (s + 1 < SC_TC) scan_ld(N, bc + (s + 1) * SC_STEP, jc, i);
                const float sa = red8(dot8(S0, S1, V.a0, V.a1));
                const f32x4 u0 = S0 * V.w0 + V.k0 * V.vi, u1 = S1 * V.w1 + V.k1 * V.vi;
                S0 = u0 + V.b0 * sa; S1 = u1 + V.b1 * sa;
                const float y = red8(dot8(S0, S1, V.r0, V.r1));
                yst[(jc == 0) ? s * 32 : 0] = y;
                V = N;
            }
        }
    }
    __syncthreads();
    if (!comp) SC_FLUSH(NCH - 1);
#undef SC_LOAD
#undef SC_PREP
#undef SC_FLUSH
    __syncthreads();
}

#if GOLD_ATTN
__device__ __forceinline__ void attn_ref_unit(Frame& F, int mode, int qrow0, int qcol, int krow0, int nkeys, int kcol, int vcol, int ocol,
                                              int rb, const float* rpbh) {
    const int tid = TID_, q = tid & 255, dh = tid >> 8;
    const bf16* QKV = WSP(bf16, WS_QKV); bf16* O = WSP(bf16, WS_O);
    const int gr = 4 * rb + (q >> 6), gc = q & 63;
    const size_t qrow = (size_t)qrow0 + q;
    float qv[64], o[32];
#pragma unroll
    for (int d8 = 0; d8 < 8; ++d8) { const u32x4 w = *(const u32x4*)(QKV + qrow * 1536 + qcol + 8 * d8);
        qv[8 * d8 + 0] = bflo(w.x); qv[8 * d8 + 1] = bfhi(w.x); qv[8 * d8 + 2] = bflo(w.y); qv[8 * d8 + 3] = bfhi(w.y);
        qv[8 * d8 + 4] = bflo(w.z); qv[8 * d8 + 5] = bfhi(w.z); qv[8 * d8 + 6] = bflo(w.w); qv[8 * d8 + 7] = bfhi(w.w); }
#pragma unroll
    for (int d = 0; d < 32; ++d) o[d] = 0.f;
    float mrun = -1e30f, lrun = 0.f;
    const int kend = mode == 0 ? nkeys : 128 + CTXL;
    const int rs = min(max(gr - 4, 0), 32 - 8), cs = min(max(gc - 8, 0), 64 - 16);
    for (int kk = 0; kk < kend; ++kk) {
        size_t krow; float bias = 0.f;
        if (mode == 0) krow = (size_t)krow0 + kk;
        else if (kk < 128) { const int kr = rs + (kk >> 4), kc = cs + (kk & 15); krow = (size_t)krow0 + CTXL + kr * 64 + kc; bias = rpbh[(kr - gr + 7) * 31 + (kc - gc + 15)] * LOG2E; }
        else krow = (size_t)krow0 + (kk - 128);
        float s = bias;
#pragma unroll
        for (int d8 = 0; d8 < 8; ++d8) { const u32x4 w = *(const u32x4*)(QKV + krow * 1536 + kcol + 8 * d8);
            s += qv[8 * d8 + 0] * bflo(w.x) + qv[8 * d8 + 1] * bfhi(w.x) + qv[8 * d8 + 2] * bflo(w.y) + qv[8 * d8 + 3] * bfhi(w.y)
               + qv[8 * d8 + 4] * bflo(w.z) + qv[8 * d8 + 5] * bfhi(w.z) + qv[8 * d8 + 6] * bflo(w.w) + qv[8 * d8 + 7] * bfhi(w.w); }
        const float mn = fmaxf(mrun, s), al = exp2f(mrun - mn), p = exp2f(s - mn);
        lrun = lrun * al + p; mrun = mn;
#pragma unroll
        for (int d8 = 0; d8 < 4; ++d8) { const u32x4 w = *(const u32x4*)(QKV + krow * 1536 + vcol + 32 * dh + 8 * d8);
            o[8 * d8 + 0] = o[8 * d8 + 0] * al + p * bflo(w.x); o[8 * d8 + 1] = o[8 * d8 + 1] * al + p * bfhi(w.x);
            o[8 * d8 + 2] = o[8 * d8 + 2] * al + p * bflo(w.y); o[8 * d8 + 3] = o[8 * d8 + 3] * al + p * bfhi(w.y);
            o[8 * d8 + 4] = o[8 * d8 + 4] * al + p * bflo(w.z); o[8 * d8 + 5] = o[8 * d8 + 5] * al + p * bfhi(w.z);
            o[8 * d8 + 6] = o[8 * d8 + 6] * al + p * bflo(w.w); o[8 * d8 + 7] = o[8 * d8 + 7] * al + p * bfhi(w.w); }
    }
    const float li = 1.f / lrun;
#pragma unroll
    for (int d8 = 0; d8 < 4; ++d8) { u32x4 w;
        w.x = pk2(o[8 * d8 + 0] * li, o[8 * d8 + 1] * li); w.y = pk2(o[8 * d8 + 2] * li, o[8 * d8 + 3] * li);
        w.z = pk2(o[8 * d8 + 4] * li, o[8 * d8 + 5] * li); w.w = pk2(o[8 * d8 + 6] * li, o[8 * d8 + 7] * li);
        *(u32x4*)(O + qrow * 1024 + ocol + 32 * dh + 8 * d8) = w; }
}
#endif
__device__ __forceinline__ void attn_item(Frame& F, int item, int l) {
    const float* rpb = F.in[I_RPB] + (size_t)l * 4 * 15 * 31;
    int mode = 0, qrow0, qcol, krow0, nkeys, kcol, vcol, ocol, rb = 0;
    if (item < 512) { const int b = item >> 6, h = (item >> 3) & 7, qb = item & 7;
        qrow0 = b * T + CTXL + qb * 256; qcol = h * 64; krow0 = b * T; nkeys = T; kcol = 512 + (h >> 2) * 64; vcol = 640 + (h >> 2) * 64; ocol = h * 64; }
    else if (item < 768) { const int it = item - 512, b = it >> 5, h = (it >> 3) & 3; rb = it & 7; mode = 1;
        qrow0 = b * T + CTXL + rb * 256; qcol = 768 + h * 64; krow0 = b * T; nkeys = 0; kcol = 1024 + h * 64; vcol = 1280 + h * 64; ocol = 768 + h * 64; rpb += h * 15 * 31; }
    else if (item < 832) { const int it = item - 768, b = it >> 3, h = it & 7;
        qrow0 = b * T; qcol = h * 64; krow0 = b * T; nkeys = CTXL; kcol = 512 + (h >> 2) * 64; vcol = 640 + (h >> 2) * 64; ocol = h * 64; }
    else { const int it = item - 832, b = it >> 2, h = it & 3;
        qrow0 = b * T; qcol = 768 + h * 64; krow0 = b * T; nkeys = CTXL; kcol = 1024 + h * 64; vcol = 1280 + h * 64; ocol = 768 + h * 64; }
#if GOLD_ATTN
    attn_ref_unit(F, mode, qrow0, qcol, krow0, nkeys, kcol, vcol, ocol, rb, rpb);
#else
    const attn_body::bf16* QKV = (const attn_body::bf16*)WSP(bf16, WS_QKV); attn_body::bf16* O = (attn_body::bf16*)WSP(bf16, WS_O);
    const attn_body::bf16* Qw0 = QKV + (size_t)qrow0 * 1536 + qcol; const attn_body::bf16* Kh = QKV + (size_t)krow0 * 1536 + kcol; const attn_body::bf16* Vh = QKV + (size_t)krow0 * 1536 + vcol;
    attn_body::bf16* Ow0 = O + (size_t)qrow0 * 1024 + ocol;
    if (mode == 0) attn_body::attn_unit<8, false>(Qw0, Kh, Vh, Ow0, nkeys >> 6, 0, 0, 0, rpb, (char*)F.lds);
    else { const int rs0 = min(max(4 * rb - 4, 0), 24); attn_body::attn_unit<8, true>(Qw0, Kh, Vh, Ow0, (rb == 0 || rb == 7) ? 12 : 16, rs0, rb, rs0, rpb, (char*)F.lds); }
#endif
}
template <int NI> struct PostIn { float y[NI], r[NI], kb[NI], v[NI], as0[NI], as1[NI], gg[NI]; };
template <int NI> __device__ __forceinline__ void post_load(Frame& F, PostIn<NI>& P, int m0, int h, int lane) {
    const float* R32 = WSP(float, WS_R32); const float* ASIG = WSP(float, WS_ASIG); const float* YD = WSP(float, WS_YD); const float* Gb = WSP(float, WS_G);
    const int ch = h * 64 + lane;
#pragma unroll
    for (int k = 0; k < NI; ++k) { const size_t mm = (size_t)(m0 + k);
        P.y[k] = YD[mm * 256 + ch] + YD[((size_t)M + mm) * 256 + ch];
        P.r[k] = R32[mm * 768 + ch]; P.kb[k] = R32[mm * 768 + 256 + ch]; P.v[k] = R32[mm * 768 + 512 + ch];
        P.as0[k] = ASIG[mm * 256 + ch]; P.as1[k] = ASIG[((size_t)M + mm) * 256 + ch]; P.gg[k] = Gb[mm * 256 + ch]; }
}
template <int NI> __device__ __forceinline__ void post_math(Frame& F, int l, const PostIn<NI>& P, int m0, int h, int lane) {
    bf16* O = WSP(bf16, WS_O);
    const int ch = h * 64 + lane;
    const float lw = F.in[I_LNXW][l * 256 + ch], lb = F.in[I_LNXB][l * 256 + ch], ka = F.in[I_KA][l * 256 + ch], rk = F.in[I_RK][l * 256 + ch];
#pragma unroll
    for (int k = 0; k < NI; ++k) {
        const float mu = wave_sum(P.y[k]) * (1.f / 64.f); const float dv = P.y[k] - mu; const float var = wave_sum(dv * dv) * (1.f / 64.f);
        const float yn = dv * rsqrtf(var + 64e-5f) * lw + lb;
        const float kd0 = P.kb[k] * (1.f + (P.as0[k] - 1.f) * ka), kd1 = P.kb[k] * (1.f + (P.as1[k] - 1.f) * ka);
        const float bon = wave_sum(P.r[k] * (kd0 + kd1) * rk) * P.v[k];
        O[(size_t)(m0 + k) * 1024 + 512 + ch] = (bf16)f2bf((yn + bon) * P.gg[k]);
    }
}
__device__ __forceinline__ void post_item(Frame& F, int l, int m, int h, int lane) { PostIn<1> P; post_load<1>(F, P, m, h, lane); post_math<1>(F, l, P, m, h, lane); }
__device__ __forceinline__ void phase_post(Frame& F, int l) {
    const int gw = F.vcu * NWAVES + F.wave, NGW = F.G * NWAVES, lane = LANE_;
    for (int it = gw; it < M * 4; it += NGW) { const int m = it >> 2, h = it & 3, t = m % T;
        if (l == NL - 1 && t < CTXL) continue;
        post_item(F, l, m, h, lane);
    }
}
constexpr int CW_PAIR = 32768, CW_SCDONE = 36864, CW_POSTQ = 37888;
__device__ __forceinline__ void post_pair(Frame& F, int l, int ch) {
    const int b = ch >> 3, h = (ch >> 1) & 3, dir = ch & 1;
    asm volatile("s_waitcnt vmcnt(0)" ::: "memory");
    __syncthreads();
    if (TID_ == 0) {
        unsigned* flag = F.ctl + CW_PAIR + 64 * (l * 32 + (ch >> 1));
        __builtin_amdgcn_fence(__ATOMIC_RELEASE, "agent");
        asm volatile("s_waitcnt vmcnt(0)" ::: "memory");
        (void)xb_add(flag, 1u);
        unsigned sp = 0; while (xb_ld(flag) < 2u) { __builtin_amdgcn_s_sleep(2); if (++sp > (1u << 24)) break; }
        __builtin_amdgcn_fence(__ATOMIC_ACQUIRE, "agent");
        asm volatile("s_waitcnt vmcnt(0)" ::: "memory");
    }
    __syncthreads();
    const int t0 = (l == NL - 1) ? CTXL : 0, nt = T - t0, half = nt >> 1, lane = LANE_;
    const int tend = t0 + (dir + 1) * half; int t = t0 + dir * half + 8 * F.wave;
    PostIn<8> P; if (t < tend) post_load<8>(F, P, b * T + t, h, lane);
    for (; t < tend; t += 8 * NWAVES) {
        PostIn<8> Nx = P; if (t + 8 * NWAVES < tend) post_load<8>(F, Nx, b * T + t + 8 * NWAVES, h, lane);
        post_math<8>(F, l, P, b * T + t, h, lane);
        P = Nx;
    }
}

__device__ __forceinline__ void phase_mixer(Frame& F, int l, int rep = 0) {
#if CHUNK_SCAN
    if (F.vcu < 64) { scan_chunked(F, F.vcu, l);
        if (rep == 0) {
            asm volatile("s_waitcnt vmcnt(0)" ::: "memory"); __syncthreads();
            if (TID_ == 0) { __builtin_amdgcn_fence(__ATOMIC_RELEASE, "agent"); asm volatile("s_waitcnt vmcnt(0)" ::: "memory"); (void)xb_add(F.ctl + CW_SCDONE + 64 * l, 1u); }
        } }
#else
    if (F.vcu < 128) scan_chain(F, F.vcu >> 1, F.vcu & 1, l);
#endif
    if (rep == 2) return;
    const int nattn = (l == NL - 1) ? 768 : 864;
    for (;;) {
        if (TID_ == 0) F.MISC[16] = atomicAdd(F.ctl + CW_QUEUE + 64 * (l + 2 * rep), 1u);
        __syncthreads();
        const int item = (int)F.MISC[16];
        __syncthreads();
        if (item >= nattn) break;
        attn_item(F, item, l);
    }
    if (rep == 0) {
        if (TID_ == 0) { unsigned sp = 0; while (xb_ld(F.ctl + CW_SCDONE + 64 * l) < 64u) { __builtin_amdgcn_s_sleep(2); if (++sp > (1u << 24)) break; }
            __builtin_amdgcn_fence(__ATOMIC_ACQUIRE, "agent"); asm volatile("s_waitcnt vmcnt(0)" ::: "memory"); }
        __syncthreads();
        const int t0 = (l == NL - 1) ? CTXL : 0, nchunk = (T - t0) / 64, nitem = 32 * nchunk, lane = LANE_;
        for (;;) {
            if (TID_ == 0) F.MISC[16] = atomicAdd(F.ctl + CW_POSTQ + 64 * l, 1u);
            __syncthreads();
            const int item = (int)F.MISC[16];
            __syncthreads();
            if (item >= nitem) break;
            const int bh = item / nchunk, ck = item % nchunk, m0 = (bh >> 2) * T + t0 + ck * 64 + 8 * F.wave;
            PostIn<8> P; post_load<8>(F, P, m0, bh & 3, lane); post_math<8>(F, l, P, m0, bh & 3, lane);
        }
    }
    cvt_moe_drain(F, l, 4);
}

__device__ __forceinline__ unsigned wave_incl_scan(unsigned v, int lane) {
#pragma unroll
    for (int o = 1; o < 64; o <<= 1) { const unsigned u = __shfl_up(v, o); if (lane >= o) v += u; }
    return v;
}
__device__ __forceinline__ void phase_topk(Frame& F, int l) {
    const int tid = TID_, lane = LANE_, wave = F.wave;
    LAS unsigned* hist = (LAS unsigned*)F.lds;
    LAS unsigned* ctrl = hist + 256;
    LAS unsigned* wsum = hist + 272;
    LAS int* stok = (LAS int*)(hist + 288);
    const float* AFF = WSP(float, WS_AFF); int* INV = WSP(int, WS_INV); float* SELG = WSP(float, WS_SELG); int* SELT = WSP(int, WS_SELT);
    const bf16* H2 = WSP(bf16, WS_H2); bf16* XE = WSP(bf16, WS_XE);
    const int nitems = (l == NL - 1) ? 128 : 256;
    for (int it = F.vcu; it < nitems; it += F.G) {
        const int seg = it >> 7, be = it & 127, b = be >> 4, e = be & 15;
        const int n = seg ? CTXL : SEQ, cap = n / 8, mbase = b * T + (seg ? 0 : CTXL);
        const int rowbase = e * MEXP + (seg ? 2048 + b * 32 : b * 256);
        unsigned key[4];
#pragma unroll
        for (int k = 0; k < 4; ++k) { const int i = 4 * tid + k; key[k] = (i < n) ? __float_as_uint(AFF[(size_t)(mbase + i) * 16 + e]) : 0u; }
        if (tid == 0) { ctrl[0] = 0u; ctrl[1] = (unsigned)cap; }
        unsigned prefix = 0u, pmask = 0u;
#pragma unroll 1
        for (int pass = 0; pass < 4; ++pass) {
            const int shift = 24 - 8 * pass;
            if (tid < 256) hist[tid] = 0u;
            __syncthreads();
#pragma unroll
            for (int k = 0; k < 4; ++k) if ((key[k] & pmask) == prefix && key[k] != 0u) __hip_atomic_fetch_add(&hist[(key[k] >> shift) & 255u], 1u, __ATOMIC_RELAXED, __HIP_MEMORY_SCOPE_WORKGROUP);
            __syncthreads();
            if (wave == 0) {
                const unsigned need = ctrl[1];
                unsigned c4[4]; unsigned tot = 0u;
#pragma unroll
                for (int k = 0; k < 4; ++k) { c4[k] = hist[255 - (4 * lane + k)]; tot += c4[k]; }
                const unsigned incl = wave_incl_scan(tot, lane); unsigned run = incl - tot;
#pragma unroll
                for (int k = 0; k < 4; ++k) { if (run < need && run + c4[k] >= need) { ctrl[0] = prefix | ((unsigned)(255 - (4 * lane + k)) << shift); ctrl[1] = need - run; } run += c4[k]; }
            }
            __syncthreads();
            prefix = ctrl[0]; pmask |= 255u << shift;
        }
        const unsigned thr = prefix, need_eq = ctrl[1];
        unsigned ngt = 0u, neq = 0u;
#pragma unroll
        for (int k = 0; k < 4; ++k) { ngt += key[k] > thr; neq += key[k] == thr; }
        const unsigned packed = ngt | (neq << 16);
        const unsigned incl = wave_incl_scan(packed, lane);
        if (lane == 63) wsum[wave] = incl;
        __syncthreads();
        unsigned base = 0u, total = 0u;
#pragma unroll
        for (int w = 0; w < NWAVES; ++w) { const unsigned s = wsum[w]; if (w < wave) base += s; total += s; }
        const unsigned excl = base + incl - packed;
        unsigned pgt = excl & 0xffffu, peq = excl >> 16; const unsigned cnt_gt = total & 0xffffu;
#pragma unroll
        for (int k = 0; k < 4; ++k) {
            int slot = -1;
            if (key[k] > thr) slot = (int)pgt++;
            else if (key[k] == thr) { if (peq < need_eq) slot = (int)(cnt_gt + peq); ++peq; }
            if (slot >= 0) { const int m = mbase + 4 * tid + k; stok[slot] = m;
                SELG[rowbase + slot] = __uint_as_float(key[k]); SELT[rowbase + slot] = m; INV[(size_t)m * 16 + e] = rowbase + slot; }
        }
        __syncthreads();
        for (int s0 = wave * 4; s0 < cap; s0 += NWAVES * 4) {
            u32x4 v[4][2];
#pragma unroll
            for (int k = 0; k < 4; ++k) { const int m = stok[s0 + k];
                const u32x4* src = (const u32x4*)(H2 + (size_t)m * 1024); v[k][0] = src[lane]; v[k][1] = src[64 + lane]; }
#pragma unroll
            for (int k = 0; k < 4; ++k) { u32x4* dst = (u32x4*)(XE + (size_t)(rowbase + s0 + k) * 1024); dst[lane] = v[k][0]; dst[64 + lane] = v[k][1]; }
        }
        __syncthreads();
    }
    cvt_moe_drain(F, l, 1);
}

constexpr int N_PHASES = 2 + 10 * NL;
#ifndef EN_MASK
#define EN_MASK 0xFFFFF
#endif
#define EN(k) ((EN_MASK >> (k)) & 1)
#define RUNPH(k, body) do { if (EN(k)) { body; if (REP(k)) { GBAR(); body; } } } while (0)
__global__ void __launch_bounds__(NTHREADS, 2) fwd_kernel(Args args) {
    extern __shared__ __attribute__((aligned(16))) unsigned char lds_raw[];
    cg::grid_group grid = cg::this_grid();
    Frame F;
    F.lds = (LAS unsigned char*)lds_raw;
    F.MISC = (volatile LAS unsigned*)(F.lds + MISC_OFF);
    F.wave = __builtin_amdgcn_readfirstlane(TID_ >> 6);
    F.G = gridDim.x; { const int bx = blockIdx.x; F.vcu = (F.G % 8 == 0) ? (bx % 8) * (F.G / 8) + bx / 8 : bx; }
    F.in = args.in; F.out = args.out; F.ws = args.ws; F.ctl = (unsigned*)(args.ws + WS_CTL);
    { int u0 = TID_; asm volatile("" : "+v"(u0)); for (int u = u0; u < (LDS_BYTES - RING_BYTES) / 4; u += NTHREADS) ((LAS unsigned*)(F.lds + RING_BYTES))[u] = 0u; }
    __syncthreads();
    const int lo = args.ph_lo, hi = args.ph_hi;
    XcdBarrier bar; bar.bar = F.ctl + CW_BAR; bar.x = 0; bar.st = nullptr;
    if (hi - lo > 1) bar = xcd_barrier_post(F.ctl + CW_BAR, F.MISC + 8);
    LAS unsigned char* ring = F.lds;

#ifndef TPROBE
#define TPROBE -1
#endif
#ifndef TP_T0
#define TP_T0 3000.0f
#endif
    unsigned long long tp_start = 0; if (TPROBE >= 0 && blockIdx.x == 0 && TID_ == 0) tp_start = __builtin_amdgcn_s_memrealtime();
#define TPMARK(k) do { if (TPROBE == (k) && blockIdx.x == 0 && TID_ == 0) { const unsigned long long t1_ = __builtin_amdgcn_s_memrealtime(); __hip_atomic_store(F.ctl + 3000, (unsigned)(t1_ - tp_start), __ATOMIC_RELAXED, __HIP_MEMORY_SCOPE_AGENT); } } while (0)
#define IN(k) (lo <= (k) && (k) < hi)
#define GBAR() xcd_barrier3(bar)
#define SEAM(k) do { if (IN(k) && IN((k) + 1)) { GBAR(); if (REP(21)) GBAR(); TPMARK(k); } } while (0)
#define SEAMF(k, fl) do { if (IN(k) && IN((k) + 1)) { XCD_BARRIER_FILL(bar, F.MISC + 20, { \
        if (TID_ == 0) F.MISC[17] = atomicAdd(F.ctl + CW_CVTQ + 64 * (fl), 1u); __syncthreads(); const int mb_ = (int)F.MISC[17]; __syncthreads(); \
        if (mb_ < CVT_NMINI) { cvt_moe_mini(F, (fl), mb_); asm volatile("s_waitcnt vmcnt(0)" ::: "memory"); } else more_ = false; }); if (REP(21)) GBAR(); TPMARK(k); } } while (0)
    if (hi < 0) grid.sync();
    if (IN(0)) { RUNPH(10, phase_init(F)); }
    SEAMF(0, 0);
    if (IN(1)) { RUNPH(11, phase_row0(F)); }
    if (REP(16)) { for (int k_ = 0; k_ < 20; ++k_) xcd_barrier(bar); }
    if (REP(17)) { for (int k_ = 0; k_ < 20; ++k_) xcd_barrier3(bar); }
    if (REP(18)) { for (int k_ = 0; k_ < 20; ++k_) xcd_barrier2_probe<3>(bar); }
    if (REP(19)) { for (int k_ = 0; k_ < 20; ++k_) xcd_barrier2_probe<4>(bar); }
    SEAMF(1, 0);
#define LAYER(l) do { constexpr int base = 2 + 10 * (l); constexpr bool last = ((l) == NL - 1); \
    if (IN(base + 0)) { if (EN(0)) { \
        pg8::Gemm g{WSP(bf16, WS_H), WSP(bf16, WS_WIN) + (size_t)(l) * NINP * 1024, M, NINP, D}; \
        EpiInproj E{WSP(bf16, WS_QKV), WSP(float, WS_R32), WSP(bf16, WS_Z)}; \
        for (int rep_ = 0; rep_ < (REP(0) ? 2 : 1); ++rep_) { if (rep_) GBAR(); if (last) { InprojLastSched S{F.G, F.vcu}; run_gemm<EpiInproj, InprojLastSched>(ring, g, S, E); } else { TileSched S{M / 256, NINP / 256, F.G, F.vcu, false}; run_gemm<EpiInproj, TileSched>(ring, g, S, E); } } } } \
    SEAMF(base + 0, (l)); \
    if (IN(base + 1)) { if (EN(1)) { \
        pg8::Gemm g{WSP(bf16, WS_Z), WSP(bf16, WS_LORA) + (size_t)(l) * 1280 * 384, M, 1280, 384}; \
        TileSched S{M / 256, 5, F.G, F.vcu, false}; \
        EpiLora E{WSP(float, WS_DEC), WSP(float, WS_ASIG), WSP(float, WS_G), F.in[I_W0] + (l) * 512, F.in[I_A0] + (l) * 512}; \
        for (int rep_ = 0; rep_ < (REP(1) ? 2 : 1); ++rep_) { if (rep_) GBAR(); run_gemm<EpiLora, TileSched>(ring, g, S, E); } } \
        if (EN(12)) { phase_qkprep(F, (l)); if (REP(12)) { GBAR(); phase_qkprep(F, (l), true); } } } \
    SEAMF(base + 1, (l)); \
    if (IN(base + 2)) { if (EN(2)) { if (CHUNK_SCAN) { phase_prepass(F, (l)); if (IN(base + 2)) SEAMF(base + 2 - 1, (l)); if (REP(14)) { phase_prepass(F, (l)); GBAR(); } } phase_mixer(F, (l)); if (REP(2)) { GBAR(); phase_mixer(F, (l), 1); } if (REP(15)) { GBAR(); phase_mixer(F, (l), 2); } } } \
    SEAMF(base + 2, (l)); \
    if (!CHUNK_SCAN) { if (IN(base + 3)) { RUNPH(3, phase_post(F, (l))); } SEAM(base + 3); } \
    if (IN(base + 4)) { if (EN(4)) { \
        pg8::Gemm g{WSP(bf16, WS_O), WSP(bf16, WS_WOUT) + (size_t)(l) * 1024 * 1024, M, D, D}; \
        TileSched S{last ? 64 : 72, 4, F.G, F.vcu, last}; \
        EpiOut E{WSP(float, WS_Y)}; \
        for (int rep_ = 0; rep_ < (REP(4) ? 2 : 1); ++rep_) { if (rep_) GBAR(); run_gemm<EpiOut, TileSched>(ring, g, S, E); } } } \
    SEAMF(base + 4, (l)); \
    if (IN(base + 5)) { if (EN(5)) { phase_row1(F, (l)); if (REP(5)) { GBAR(); phase_row1(F, (l), true); } } } \
    SEAMF(base + 5, (l)); \
    if (IN(base + 6)) { RUNPH(6, phase_topk(F, (l))); } \
    SEAM(base + 6); \
    if (IN(base + 7)) { if (EN(7)) { \
        pg8::Gemm g{WSP(bf16, WS_XE), WSP(bf16, WS_WGU), NE * MEXP, NE * 2048, D}; \
        MoeSched S{last ? 8 : 9, 8, F.G, F.vcu}; \
        EpiMoe1 E{WSP(bf16, WS_HID)}; \
        for (int rep_ = 0; rep_ < (REP(7) ? 2 : 1); ++rep_) { if (rep_) GBAR(); run_gemm<EpiMoe1, MoeSched>(ring, g, S, E); } } } \
    SEAM(base + 7); \
    if (IN(base + 8)) { if (EN(8)) { \
        pg8::Gemm g{WSP(bf16, WS_HID), WSP(bf16, WS_WD), NE * MEXP, NE * 1024, D}; \
        MoeSched S{last ? 8 : 9, 4, F.G, F.vcu}; \
        EpiMoe2 E{WSP(bf16, WS_OUTE), WSP(float, WS_SELG)}; \
        for (int rep_ = 0; rep_ < (REP(8) ? 2 : 1); ++rep_) { if (rep_) GBAR(); run_gemm<EpiMoe2, MoeSched>(ring, g, S, E); } } } \
    SEAM(base + 8); \
    if (IN(base + 9)) { if (EN(9)) { phase_row2(F, (l)); if (REP(9)) { GBAR(); phase_row2(F, (l), true); } } } \
    if ((l) + 1 < NL) SEAMF(base + 9, (l) + 1); else SEAM(base + 9); \
  } while (0)
    LAYER(0);
    LAYER(1);
#undef LAYER
#undef SEAM
#undef IN
}

extern "C" void kernel_launch(void* const* d_in, const int* in_sizes, int n_in, void* d_out, int out_size, void* d_ws, size_t ws_size, hipStream_t stream) {
    static int grid = 0;
    if (grid == 0) {
        if (n_in != 29 || out_size != NB * SEQ * D || ws_size < WS_END) { fprintf(stderr, "kernel_launch: unexpected sizes n_in %d out %d ws %zu\n", n_in, out_size, ws_size); grid = -1; return; }
        int dev = 0, cus = 0, per_cu = 0;
        if (hipGetDevice(&dev) != hipSuccess || hipDeviceGetAttribute(&cus, hipDeviceAttributeMultiprocessorCount, dev) != hipSuccess) { grid = -1; return; }
        if (hipFuncSetAttribute((const void*)fwd_kernel, hipFuncAttributeMaxDynamicSharedMemorySize, LDS_BYTES) != hipSuccess) { fprintf(stderr, "kernel_launch: hipFuncSetAttribute failed\n"); grid = -1; return; }
        if (hipOccupancyMaxActiveBlocksPerMultiprocessor(&per_cu, (const void*)fwd_kernel, NTHREADS, LDS_BYTES) != hipSuccess || per_cu < 1) { fprintf(stderr, "kernel_launch: occupancy query says %d\n", per_cu); per_cu = 1; }
        (void)hipGetLastError();
        grid = cus;
        fprintf(stderr, "kernel_launch: grid %d, per_cu %d, ws %zu\n", grid, per_cu, ws_size);
    }
    if (grid < 0) return;
    if (hipMemsetAsync((char*)d_ws + WS_CTL, 0, CTL_ZERO_BYTES, stream) != hipSuccess) return;
    Args a{};
    for (int i = 0; i < 29; ++i) a.in[i] = (const float*)d_in[i];
    a.out = (float*)d_out; a.ws = (unsigned char*)d_ws;
#if N_LAUNCH_MODE
    a.ph_lo = 0; a.ph_hi = N_PHASES;
    { void* kargs[] = {&a};
      hipError_t e = hipLaunchCooperativeKernel((const void*)fwd_kernel, dim3(grid), dim3(NTHREADS), kargs, LDS_BYTES, stream);
      if (e != hipSuccess) fprintf(stderr, "kernel_launch: cooperative launch failed: %s\n", hipGetErrorString(e)); }
#else
    for (int ph = 0; ph < N_PHASES; ++ph) {
        a.ph_lo = ph; a.ph_hi = ph + 1;
        void* kargs[] = {&a};
        hipError_t e = hipLaunchCooperativeKernel((const void*)fwd_kernel, dim3(grid), dim3(NTHREADS), kargs, LDS_BYTES, stream);
        if (e != hipSuccess) { fprintf(stderr, "kernel_launch: launch %d failed: %s\n", ph, hipGetErrorString(e)); break; }
    }
#endif
}
```

```cpp
#define GOLD_GEMM 0
#define N_LAUNCH_MODE 1
#define GOLD_ATTN 0
#define REP_MASK 0
#define CHUNK_SCAN 1
#define NOFILL 0
#include <hip/hip_runtime.h>
#include <hip/hip_cooperative_groups.h>
#include <cstdio>
#include <cstdint>
namespace cg = cooperative_groups;

#ifndef GOLD_GEMM
#define GOLD_GEMM 0
#endif
#ifndef GOLD_ATTN
#define GOLD_ATTN 1
#endif
#ifndef N_LAUNCH_MODE
#define N_LAUNCH_MODE 1
#endif

#ifndef REP_MASK
#define REP_MASK 0
#endif
#define REP(k) ((REP_MASK >> (k)) & 1)
#define LAS __attribute__((address_space(3)))
typedef unsigned short bf16;
typedef float f32x4 __attribute__((ext_vector_type(4)));
typedef unsigned u32x4 __attribute__((ext_vector_type(4)));
typedef unsigned u32x2 __attribute__((ext_vector_type(2)));
typedef short bf16x8 __attribute__((ext_vector_type(8)));

constexpr int D = 1024, NB = 8, SEQ = 2048, CTXL = 256, T = SEQ + CTXL, M = NB * T, NL = 2;
constexpr int NINP = 2816;
constexpr int NE = 16, MEXP = 2304;
constexpr float LOG2E = 1.4426950408889634f;
constexpr float C2 = 0.125f * LOG2E;
constexpr int NTHREADS = 512, NWAVES = 8;
constexpr int LDS_BYTES = 147456, RING_BYTES = 131072, MISC_OFF = RING_BYTES + 320;

constexpr size_t MiB = 1u << 20;
constexpr size_t WS_CTL = 0, CTL_ZERO_BYTES = 1 * MiB;
constexpr size_t WS_MOD = 1 * MiB;
constexpr size_t WS_WIN = 2 * MiB;
constexpr size_t WS_WOUT = 13 * MiB;
constexpr size_t WS_LORA = 17 * MiB;
constexpr size_t WS_WGU = 19 * MiB;
constexpr size_t WS_WD = 83 * MiB;
constexpr size_t WS_X = 115 * MiB;
constexpr size_t R0 = 187 * MiB;
constexpr size_t WS_YD = R0 + 0 * MiB;
constexpr size_t WS_H = R0 + 36 * MiB;
constexpr size_t WS_QKV = R0 + 72 * MiB;
constexpr size_t WS_R32 = R0 + 126 * MiB;
constexpr size_t WS_Z = R0 + 180 * MiB;
constexpr size_t WS_DEC = R0 + 194 * MiB;
constexpr size_t WS_ASIG = R0 + 230 * MiB;
constexpr size_t WS_G = R0 + 266 * MiB;
constexpr size_t WS_O = R0 + 284 * MiB;
constexpr size_t WS_END = R0 + 320 * MiB;
constexpr size_t WS_Y = WS_QKV;
constexpr size_t WS_OUTE = WS_QKV;
constexpr size_t WS_H2 = WS_DEC;
constexpr size_t WS_AFF = WS_Z;
constexpr size_t WS_INV = WS_Z + 2 * MiB;
constexpr size_t WS_SELG = WS_Z + 4 * MiB;
constexpr size_t WS_SELT = WS_Z + 5 * MiB;
constexpr size_t WS_XE = WS_ASIG;
constexpr size_t WS_HID = WS_YD;
static_assert(WS_END <= 512 * MiB, "ws map");
constexpr int CW_BAR = 4096;
constexpr int CW_QUEUE = 16384;

__device__ __forceinline__ unsigned f2bf(float f) { unsigned u = __builtin_bit_cast(unsigned, f); return (u + 0x7fffu + ((u >> 16) & 1u)) >> 16; }
__device__ __forceinline__ unsigned pk2(float lo, float hi) { return f2bf(lo) | (f2bf(hi) << 16); }
__device__ __forceinline__ float bf2f(unsigned h) { return __builtin_bit_cast(float, h << 16); }
__device__ __forceinline__ float bflo(unsigned w) { return __builtin_bit_cast(float, w << 16); }
__device__ __forceinline__ float bfhi(unsigned w) { return __builtin_bit_cast(float, w & 0xffff0000u); }
template <int CTRL> __device__ __forceinline__ float dppf(float x) { return __builtin_bit_cast(float, __builtin_amdgcn_update_dpp(0, __builtin_bit_cast(int, x), CTRL, 0xF, 0xF, true)); }
__device__ __forceinline__ float red8(float x) { x += dppf<0xB1>(x); x += dppf<0x4E>(x); x += dppf<0x141>(x); return x; }
__device__ __forceinline__ float wave_sum(float v) {
    v = red8(v); v += dppf<0x140>(v);
    const float a0 = __builtin_bit_cast(float, __builtin_amdgcn_readlane(__builtin_bit_cast(int, v), 0));
    const float a1 = __builtin_bit_cast(float, __builtin_amdgcn_readlane(__builtin_bit_cast(int, v), 16));
    const float a2 = __builtin_bit_cast(float, __builtin_amdgcn_readlane(__builtin_bit_cast(int, v), 32));
    const float a3 = __builtin_bit_cast(float, __builtin_amdgcn_readlane(__builtin_bit_cast(int, v), 48));
    return (a0 + a1) + (a2 + a3);
}
__device__ __forceinline__ float sigmoidf_(float x) { return __builtin_amdgcn_rcpf(1.f + __expf(-x)); }
#define LDS_WAIT() asm volatile("s_waitcnt lgkmcnt(0)" ::: "memory")

#define XB_TMO      128
#define XB_XCNT(j)  (256  + 64 * (j))
#define XB_XSUB(j)  (1280 + 64 * (j))
#define XB_XGEN(j)  (2304 + 64 * (j))
#define XB_TOP      3328
#define XB_TOPGEN   3392
#define XCD_BAR_WORDS 3456
#define XB_SPIN_CAP (1u << 22)
__device__ __forceinline__ unsigned xb_ld(unsigned* p)              { return __hip_atomic_load(p, __ATOMIC_RELAXED, __HIP_MEMORY_SCOPE_AGENT); }
__device__ __forceinline__ unsigned xb_add(unsigned* p, unsigned v) { return __hip_atomic_fetch_add(p, v, __ATOMIC_RELAXED, __HIP_MEMORY_SCOPE_AGENT); }
__device__ __forceinline__ unsigned xb_xcc_id() { return (unsigned)__builtin_amdgcn_s_getreg((3 << 11) | 20) & 0xFu; }
#define XB_SPIN(cond, bar) do { unsigned _sp = 0; while (cond) { __builtin_amdgcn_s_sleep(1); \
    if ((++_sp & 255u) == 0u) { if (xb_ld(&(bar)[XB_TMO])) break; if (_sp > XB_SPIN_CAP) { atomicAdd(&(bar)[XB_TMO], 1u); break; } } } } while (0)
struct XcdBarrier { unsigned* bar; unsigned x; volatile LAS unsigned* st; };
__device__ __forceinline__ XcdBarrier xcd_barrier_post(unsigned* bar, volatile LAS unsigned* st) {
    XcdBarrier b; b.bar = bar; b.x = xb_xcc_id(); b.st = st;
    if (threadIdx.x == 0) (void)xb_add(&bar[XB_XCNT(b.x)], 1u);
    return b;
}
__device__ __forceinline__ void xcd_barrier_complete(unsigned* bar, unsigned x, unsigned& nloc, unsigned& nx) {
    const unsigned G = gridDim.x * gridDim.y * gridDim.z;
    unsigned sum, cnt, mine, sp = 0u;
    for (;;) {
        sum = 0u; cnt = 0u; mine = 0u;
#pragma unroll
        for (unsigned j = 0; j < 16; ++j) { const unsigned c = xb_ld(&bar[XB_XCNT(j)]); sum += c; cnt += (c > 0u) ? 1u : 0u; mine = (j == x) ? c : mine; }
        if (sum == G) break;
        __builtin_amdgcn_s_sleep(1);
        if ((++sp & 255u) == 0u) { if (xb_ld(&bar[XB_TMO])) break; if (sp > XB_SPIN_CAP) { atomicAdd(&bar[XB_TMO], 1u); break; } }
    }
    nloc = mine > 0u ? mine : 1u; nx = cnt > 0u ? cnt : 1u;
}
__device__ __forceinline__ void xcd_barrier(const XcdBarrier& b) {
    asm volatile("s_waitcnt vmcnt(0)" ::: "memory");
    __syncthreads();
    if (threadIdx.x == 0) {
        unsigned* bar = b.bar;
        __builtin_amdgcn_s_waitcnt(0);
        unsigned nloc = b.st[0], nx = b.st[1];
        if (nloc == 0u) { xcd_barrier_complete(bar, b.x, nloc, nx); b.st[0] = nloc; b.st[1] = nx; }
        const unsigned old = xb_add(&bar[XB_XSUB(b.x)], 1u);
        const unsigned gen = old / nloc;
        if (old + 1u == (gen + 1u) * nloc) {
            __builtin_amdgcn_fence(__ATOMIC_RELEASE, "agent");
            asm volatile("s_waitcnt vmcnt(0)" ::: "memory");
            const unsigned og = xb_add(&bar[XB_TOP], 1u);
            const unsigned tg = og / nx;
            if (og + 1u == (tg + 1u) * nx) xb_add(&bar[XB_TOPGEN], 1u);
            else XB_SPIN(xb_ld(&bar[XB_TOPGEN]) == tg, bar);
            __builtin_amdgcn_fence(__ATOMIC_ACQUIRE, "agent");
            xb_add(&bar[XB_XGEN(b.x)], 1u);
            asm volatile("s_waitcnt vmcnt(0)" ::: "memory");
        } else {
            XB_SPIN(xb_ld(&bar[XB_XGEN(b.x)]) == gen, bar);
            __builtin_amdgcn_fence(__ATOMIC_ACQUIRE, "agent");
            asm volatile("s_waitcnt vmcnt(0)" ::: "memory");
        }
    }
    __syncthreads();
}

__device__ __forceinline__ void flat_barrier(unsigned* cnt) {
    asm volatile("s_waitcnt vmcnt(0)" ::: "memory");
    __syncthreads();
    if (threadIdx.x == 0) {
        const unsigned G = gridDim.x;
        __builtin_amdgcn_fence(__ATOMIC_RELEASE, "agent");
        asm volatile("s_waitcnt vmcnt(0)" ::: "memory");
        const unsigned old = xb_add(cnt, 1u);
        const unsigned target = (old / G + 1u) * G;
        unsigned sp = 0;
        while (xb_ld(cnt) < target) { __builtin_amdgcn_s_sleep(1); if (++sp > (1u << 22)) break; }
        __builtin_amdgcn_fence(__ATOMIC_ACQUIRE, "agent");
        asm volatile("s_waitcnt vmcnt(0)" ::: "memory");
    }
    __syncthreads();
}

__device__ __forceinline__ void xcd_barrier2(const XcdBarrier& b) {
    asm volatile("s_waitcnt vmcnt(0)" ::: "memory");
    __syncthreads();
    if (threadIdx.x == 0) {
        unsigned* bar = b.bar;
        __builtin_amdgcn_s_waitcnt(0);
        unsigned nloc = b.st[0], nx = b.st[1];
        if (nloc == 0u) { xcd_barrier_complete(bar, b.x, nloc, nx); b.st[0] = nloc; b.st[1] = nx; }
        const unsigned old = xb_add(&bar[XB_XSUB(b.x)], 1u);
        const unsigned gen = old / nloc;
        if (old + 1u == (gen + 1u) * nloc) {
            __builtin_amdgcn_fence(__ATOMIC_RELEASE, "agent");
            asm volatile("s_waitcnt vmcnt(0)" ::: "memory");
            (void)xb_add(&bar[XB_TOP], 1u);
        }
        const unsigned target = (gen + 1u) * nx;
        XB_SPIN(xb_ld(&bar[XB_TOP]) < target, bar);
        __builtin_amdgcn_fence(__ATOMIC_ACQUIRE, "agent");
        asm volatile("s_waitcnt vmcnt(0)" ::: "memory");
    }
    __syncthreads();
}

template <int MODE> __device__ __forceinline__ void xcd_barrier2_probe(const XcdBarrier& b) {
    asm volatile("s_waitcnt vmcnt(0)" ::: "memory");
    __syncthreads();
    if (threadIdx.x == 0) {
        unsigned* bar = b.bar;
        unsigned nloc = b.st[0], nx = b.st[1];
        const unsigned old = xb_add(&bar[XB_XSUB(b.x)], 1u);
        const unsigned gen = old / nloc;
        if (old + 1u == (gen + 1u) * nloc) {
            if (!(MODE & 2)) { __builtin_amdgcn_fence(__ATOMIC_RELEASE, "agent"); asm volatile("s_waitcnt vmcnt(0)" ::: "memory"); }
            (void)xb_add(&bar[XB_TOP], 1u);
        }
        const unsigned target = (gen + 1u) * nx;
        XB_SPIN(xb_ld(&bar[XB_TOP]) < target, bar);
        if (!(MODE & 1) && (!(MODE & 4) || (old + 1u == (gen + 1u) * nloc))) { __builtin_amdgcn_fence(__ATOMIC_ACQUIRE, "agent"); asm volatile("s_waitcnt vmcnt(0)" ::: "memory"); }
    }
    __syncthreads();
}

__device__ __forceinline__ void xcd_barrier3(const XcdBarrier& b) {
    asm volatile("s_waitcnt vmcnt(0)" ::: "memory");
    __syncthreads();
    if (threadIdx.x == 0) {
        unsigned* bar = b.bar;
        __builtin_amdgcn_s_waitcnt(0);
        unsigned nloc = b.st[0], nx = b.st[1];
        if (nloc == 0u) { xcd_barrier_complete(bar, b.x, nloc, nx); b.st[0] = nloc; b.st[1] = nx; }
        const unsigned old = xb_add(&bar[XB_XSUB(b.x)], 1u);
        const unsigned gen = old / nloc;
        if (old + 1u == (gen + 1u) * nloc) {
            __builtin_amdgcn_fence(__ATOMIC_RELEASE, "agent");
            asm volatile("s_waitcnt vmcnt(0)" ::: "memory");
            (void)xb_add(&bar[XB_TOP], 1u);
            const unsigned target = (gen + 1u) * nx;
            XB_SPIN(xb_ld(&bar[XB_TOP]) < target, bar);
            __builtin_amdgcn_fence(__ATOMIC_ACQUIRE, "agent");
            asm volatile("s_waitcnt vmcnt(0)" ::: "memory");
            xb_add(&bar[XB_XGEN(b.x)], 1u);
        } else {
            __builtin_amdgcn_fence(__ATOMIC_ACQUIRE, "agent");
            asm volatile("s_waitcnt vmcnt(0)" ::: "memory");
            XB_SPIN(xb_ld(&bar[XB_XGEN(b.x)]) == gen, bar);
        }
    }
    __syncthreads();
}

#define XCD_BARRIER_FILL(b, MISCW, FILL_STMT) do { \
    asm volatile("s_waitcnt vmcnt(0)" ::: "memory"); \
    __syncthreads(); \
    if (threadIdx.x == 0) { \
        unsigned* bar_ = (b).bar; __builtin_amdgcn_s_waitcnt(0); \
        unsigned nloc_ = (b).st[0], nx_ = (b).st[1]; \
        if (nloc_ == 0u) { xcd_barrier_complete(bar_, (b).x, nloc_, nx_); (b).st[0] = nloc_; (b).st[1] = nx_; } \
        const unsigned old_ = xb_add(&bar_[XB_XSUB((b).x)], 1u); const unsigned gen_ = old_ / nloc_; \
        if (old_ + 1u == (gen_ + 1u) * nloc_) { \
            __builtin_amdgcn_fence(__ATOMIC_RELEASE, "agent"); asm volatile("s_waitcnt vmcnt(0)" ::: "memory"); \
            (void)xb_add(&bar_[XB_TOP], 1u); const unsigned target_ = (gen_ + 1u) * nx_; \
            XB_SPIN(xb_ld(&bar_[XB_TOP]) < target_, bar_); \
            __builtin_amdgcn_fence(__ATOMIC_ACQUIRE, "agent"); asm volatile("s_waitcnt vmcnt(0)" ::: "memory"); \
            xb_add(&bar_[XB_XGEN((b).x)], 1u); \
            (MISCW)[0] = 0xffffffffu; \
        } else { \
            __builtin_amdgcn_fence(__ATOMIC_ACQUIRE, "agent"); asm volatile("s_waitcnt vmcnt(0)" ::: "memory"); \
            (MISCW)[0] = gen_; \
        } \
    } \
    __syncthreads(); \
    { const unsigned g_ = (MISCW)[0]; \
      if (g_ != 0xffffffffu) { bool more_ = true; \
        for (;;) { \
            if (threadIdx.x == 0) (MISCW)[1] = (xb_ld(&(b).bar[XB_XGEN((b).x)]) != g_) ? 1u : 0u; \
            __syncthreads(); \
            const bool rel_ = (MISCW)[1] != 0u; \
            __syncthreads(); \
            if (rel_) break; \
            if (more_) { FILL_STMT; } else __builtin_amdgcn_s_sleep(4); \
        } } } \
    __syncthreads(); \
  } while (0)
namespace pg8 {
#define PG8_LAS __attribute__((address_space(3)))
typedef unsigned short bf16_t;
typedef short bf16x8 __attribute__((ext_vector_type(8)));
typedef float f32x4 __attribute__((ext_vector_type(4)));
typedef unsigned u32x4 __attribute__((ext_vector_type(4)));
constexpr int BM = 256, BK = 64, HALF = 128, HTB = HALF * BK * 2  , STAGE_BYTES = 8 * HTB, NXCD = 8, WGM = 8;

__host__ __device__ __forceinline__ int lds_byte(int r, int c) { const int st = (r >> 4) * 2 + (c >> 5), rr = r & 15, cc = c & 31, ob = rr * 64 + cc * 2; return st * 1024 + (ob ^ (((ob >> 9) & 1) << 5)); }
__host__ __device__ __forceinline__ void stage_rc(int b, int& R, int& C) { const int st = b / 1024, sb = b % 1024, swz = sb ^ (((sb >> 9) & 1) << 5); R = (st >> 1) * 16 + swz / 64; C = (st & 1) * 32 + (swz % 64) / 2; }
__host__ __device__ __forceinline__ int perm32(int rho) { const int n = rho >> 4, i = rho & 15; return 8 * (i >> 2) + 4 * n + (i & 3); }

struct Unit { int pm, pn; };
struct Gemm { const bf16_t* A; const bf16_t* Bt; int M, N, K; };

struct StaticOrder {
    int nM, nN, nwg, G, c;
    __host__ __device__ void init(int M, int N, int G_, int c_) { nM = M / BM; nN = N / BM; nwg = nM * nN; G = G_; c = c_; }
    __host__ __device__ bool next(int i, Unit& u) const {
        const long L = (long)i * G + c; if (L >= nwg) return false;
        int wgid = (int)L; { const int q = nwg / NXCD, r = nwg % NXCD, xcd = wgid % NXCD, off = wgid / NXCD; wgid = (xcd < r ? xcd * (q + 1) : r * (q + 1) + (xcd - r) * q) + off; }
        const int nig = WGM * nN, gid = wgid / nig, fm = gid * WGM, gsz = (nM - fm) < WGM ? (nM - fm) : WGM;
        u.pm = fm + ((wgid % nig) % gsz); u.pn = (wgid % nig) / gsz; return true;
    }
    __device__ __forceinline__ void a_ready(const Unit&) const {}
    __device__ __forceinline__ void done(const Unit&) const {}
};
__device__ __forceinline__ unsigned cvt_pk_bf16(float lo, float hi) { unsigned r; asm volatile("v_cvt_pk_bf16_f32 %0, %1, %2" : "=v"(r) : "v"(lo), "v"(hi)); return r; }
typedef float f32x2 __attribute__((ext_vector_type(2)));
template <class Epi, class Sched, bool ALIGN_EPI = false, bool SP2 = false>
__device__ __forceinline__ void gemm_phase(PG8_LAS unsigned char* lds, const Gemm g, const Sched& S, const Epi& E) {
    const int tid = threadIdx.x, wid = __builtin_amdgcn_readfirstlane(tid >> 6), lane = tid & 63, wr = wid >> 2, wc = wid & 3, fr = lane & 15, fq = lane >> 4;
    const int K = g.K, nt = K / BK;
    unsigned voffA[2], voffB[2];
#pragma unroll
    for (int i = 0; i < 2; ++i) { int R, C; stage_rc(tid * 16 + i * 8192, R, C); const int Rb = Epi::PERM ? ((R & ~31) + perm32(R & 31)) : R;
        voffA[i] = (unsigned)(R * K + C) * 2u; voffB[i] = (unsigned)(Rb * K + C) * 2u; }
    const size_t kstep = (size_t)(BK * 2);
    const size_t hstep = (size_t)HALF * K * 2;
    const size_t tstep = 2 * hstep;
    const unsigned ldsw = (unsigned)wid * 1024u;
    const int aoff = lds_byte(wr * 64 + fr, fq * 8), boff = lds_byte(wc * 32 + fr, fq * 8);
#define PG8_SA(b, h) (((b) * 2 + (h)) * HTB)
#define PG8_SB(b, h) ((4 + (b) * 2 + (h)) * HTB)
#define PG8_STAGE(bufoff, gbase, voff) do { _Pragma("unroll") for (int _i = 0; _i < 2; ++_i) \
        __builtin_amdgcn_global_load_lds((const unsigned*)((const char*)(gbase) + (voff)[_i]), (PG8_LAS unsigned*)(lds + (bufoff) + ldsw + _i * 8192), 16, 0, 0); } while (0)
#define PG8_LDA(dst, b, h) do { _Pragma("unroll") for (int m = 0; m < 4; ++m) _Pragma("unroll") for (int k = 0; k < 2; ++k) dst[m][k] = *(const PG8_LAS bf16x8*)(lds + PG8_SA(b, h) + aoff + m * 2048 + k * 1024); } while (0)
#define PG8_LDB(dst, b, h) do { _Pragma("unroll") for (int n = 0; n < 2; ++n) _Pragma("unroll") for (int k = 0; k < 2; ++k) dst[n][k] = *(const PG8_LAS bf16x8*)(lds + PG8_SB(b, h) + boff + n * 2048 + k * 1024); } while (0)
#define PG8_MMA(ai, bj, At, Bt) do { __builtin_amdgcn_s_setprio(1); _Pragma("unroll") for (int m = 0; m < 4; ++m) _Pragma("unroll") for (int n = 0; n < 2; ++n) _Pragma("unroll") for (int k = 0; k < 2; ++k) \
        acc[ai][bj][m][n] = __builtin_amdgcn_mfma_f32_16x16x32_bf16(Bt[n][k], At[m][k], acc[ai][bj][m][n], 0, 0, 0); __builtin_amdgcn_s_setprio(0); } while (0)
#define PG8_WAIT_V(n) asm volatile("s_waitcnt vmcnt(" #n ")" ::: "memory")
#define PG8_WAIT_L(n) asm volatile("s_waitcnt lgkmcnt(" #n ")" ::: "memory")
#define PG8_BAR __builtin_amdgcn_s_barrier()
#define PG8_SCHED __builtin_amdgcn_sched_barrier(0)
    Unit cur, nxt; int ui = 0;
    if (!S.next(0, cur)) return;
    f32x4 acc[2][2][4][2];
#pragma unroll
    for (int a = 0; a < 2; ++a)
#pragma unroll
        for (int b = 0; b < 2; ++b)
#pragma unroll
            for (int m = 0; m < 4; ++m)
#pragma unroll
                for (int n = 0; n < 2; ++n) acc[a][b][m][n] = (f32x4){0.f, 0.f, 0.f, 0.f};
    bf16x8 At[4][2], B0[2][2], B1[2][2];
    const char* cA = (const char*)g.A + (size_t)cur.pm * tstep; const char* cB = (const char*)g.Bt + (size_t)cur.pn * tstep;
    S.a_ready(cur);
    if constexpr (SP2) {
        PG8_STAGE(PG8_SB(0, 0), cB, voffB); PG8_STAGE(PG8_SB(0, 1), cB + hstep, voffB); PG8_STAGE(PG8_SA(0, 0), cA, voffA); PG8_STAGE(PG8_SA(0, 1), cA + hstep, voffA);
        if (wr == 1) PG8_BAR;
        PG8_WAIT_V(2); PG8_BAR;
        PG8_STAGE(PG8_SB(1, 0), cB + kstep, voffB); PG8_STAGE(PG8_SA(1, 0), cA + kstep, voffA); PG8_STAGE(PG8_SB(1, 1), cB + hstep + kstep, voffB);
        PG8_WAIT_V(6); PG8_BAR;
    } else {
        PG8_STAGE(PG8_SB(0, 0), cB, voffB); PG8_STAGE(PG8_SA(0, 0), cA, voffA); PG8_STAGE(PG8_SB(0, 1), cB + hstep, voffB); PG8_STAGE(PG8_SA(0, 1), cA + hstep, voffA);
        if (wr == 1) PG8_BAR;
        PG8_WAIT_V(4); PG8_BAR;
        PG8_STAGE(PG8_SB(1, 0), cB + kstep, voffB); PG8_STAGE(PG8_SA(1, 0), cA + kstep, voffA); PG8_STAGE(PG8_SB(1, 1), cB + hstep + kstep, voffB);
        PG8_WAIT_V(6); PG8_BAR;
    }
    for (;;) {
        const bool has_next = S.next(ui + 1, nxt);
        const char* nA = has_next ? (const char*)g.A + (size_t)nxt.pm * tstep : cA; const char* nB = has_next ? (const char*)g.Bt + (size_t)nxt.pn * tstep : cB;
        for (int t = 0; t < nt; t += 2) {
            const bool last = (t == nt - 2);
            const char* a1 = cA + (size_t)(t + 1) * kstep;
            const char* a2 = last ? nA : cA + (size_t)(t + 2) * kstep; const char* b2 = last ? nB : cB + (size_t)(t + 2) * kstep;
            const char* a3 = a2 + kstep; const char* b3 = b2 + kstep;
            if (last && has_next) S.a_ready(nxt);
            if constexpr (SP2) {
            PG8_LDB(B0, 0, 0); PG8_LDB(B1, 0, 1); PG8_SCHED; PG8_LDA(At, 0, 0); PG8_STAGE(PG8_SA(1, 1), a1 + hstep, voffA);
            PG8_WAIT_V(8); PG8_WAIT_L(0); PG8_BAR; PG8_MMA(0, 0, At, B0); PG8_MMA(0, 1, At, B1); PG8_BAR; PG8_SCHED;
            PG8_LDA(At, 0, 1); PG8_STAGE(PG8_SB(0, 0), b2, voffB); PG8_STAGE(PG8_SB(0, 1), b2 + hstep, voffB); PG8_STAGE(PG8_SA(0, 0), a2, voffA);
            PG8_WAIT_V(8); PG8_WAIT_L(0); PG8_BAR; PG8_MMA(1, 0, At, B0); PG8_MMA(1, 1, At, B1); PG8_BAR; PG8_SCHED;
            PG8_LDB(B0, 1, 0); PG8_LDB(B1, 1, 1); PG8_SCHED; PG8_LDA(At, 1, 0); PG8_STAGE(PG8_SA(0, 1), a2 + hstep, voffA);
            PG8_WAIT_V(8); PG8_WAIT_L(0); PG8_BAR; PG8_MMA(0, 0, At, B0); PG8_MMA(0, 1, At, B1); PG8_BAR; PG8_SCHED;
            PG8_LDA(At, 1, 1); PG8_STAGE(PG8_SB(1, 0), b3, voffB); PG8_STAGE(PG8_SB(1, 1), b3 + hstep, voffB); PG8_STAGE(PG8_SA(1, 0), a3, voffA);
            PG8_WAIT_V(8); PG8_WAIT_L(0); PG8_BAR; PG8_MMA(1, 0, At, B0); PG8_MMA(1, 1, At, B1); PG8_BAR; PG8_SCHED;
            } else {
            PG8_LDB(B0, 0, 0); PG8_SCHED; PG8_LDA(At, 0, 0); PG8_STAGE(PG8_SA(1, 1), a1 + hstep, voffA);
            PG8_WAIT_L(8); PG8_BAR; PG8_WAIT_L(0); PG8_MMA(0, 0, At, B0); PG8_BAR; PG8_SCHED;
            PG8_LDB(B1, 0, 1); PG8_STAGE(PG8_SB(0, 0), b2, voffB);
            PG8_BAR; PG8_WAIT_L(0); PG8_MMA(0, 1, At, B1); PG8_BAR;
            PG8_LDA(At, 0, 1); PG8_STAGE(PG8_SA(0, 0), a2, voffA);
            PG8_BAR; PG8_WAIT_L(0); PG8_MMA(1, 0, At, B0); PG8_BAR; PG8_SCHED;
            PG8_STAGE(PG8_SB(0, 1), b2 + hstep, voffB);
            PG8_WAIT_V(6); PG8_BAR; PG8_MMA(1, 1, At, B1); PG8_BAR;
            PG8_LDB(B0, 1, 0); PG8_SCHED; PG8_LDA(At, 1, 0); PG8_STAGE(PG8_SA(0, 1), a2 + hstep, voffA);
            PG8_WAIT_L(8); PG8_BAR; PG8_WAIT_L(0); PG8_MMA(0, 0, At, B0); PG8_BAR; PG8_SCHED;
            PG8_LDB(B1, 1, 1); PG8_STAGE(PG8_SB(1, 0), b3, voffB);
            PG8_BAR; PG8_WAIT_L(0); PG8_MMA(0, 1, At, B1); PG8_BAR;
            PG8_LDA(At, 1, 1); PG8_STAGE(PG8_SA(1, 0), a3, voffA);
            PG8_BAR; PG8_WAIT_L(0); PG8_MMA(1, 0, At, B0); PG8_BAR; PG8_SCHED;
            PG8_STAGE(PG8_SB(1, 1), b3 + hstep, voffB);
            PG8_WAIT_V(6); PG8_BAR; PG8_MMA(1, 1, At, B1); PG8_BAR;
            }
        }
        if constexpr (ALIGN_EPI) { if (wr == 0) PG8_BAR; }
        if constexpr (!Epi::AFTER_DRAIN) { E(acc, cur, wr, wc, fr, fq); S.done(cur); }
        if (!has_next) break;
#pragma unroll
        for (int a = 0; a < 2; ++a)
#pragma unroll
            for (int b = 0; b < 2; ++b)
#pragma unroll
                for (int m = 0; m < 4; ++m)
#pragma unroll
                    for (int n = 0; n < 2; ++n) acc[a][b][m][n] = (f32x4){0.f, 0.f, 0.f, 0.f};
        cur = nxt; cA = nA; cB = nB; ++ui;
        if constexpr (ALIGN_EPI) { if (wr == 1) PG8_BAR; }
    }
    PG8_WAIT_V(0);
    if constexpr (!ALIGN_EPI) { if (wr == 0) PG8_BAR; }
    PG8_BAR;
    if constexpr (Epi::AFTER_DRAIN) { E.fused(acc, cur, wr, wc, fr, fq, lds, wid, lane); S.done(cur); }
#undef PG8_SA
#undef PG8_SB
#undef PG8_STAGE
#undef PG8_LDA
#undef PG8_LDB
#undef PG8_MMA
#undef PG8_WAIT_V
#undef PG8_WAIT_L
#undef PG8_BAR
#undef PG8_SCHED
}
}

__device__ __forceinline__ u32x4 pack8(const f32x4 a, const f32x4 b) {
    u32x4 w; w.x = pk2(a[0], a[1]); w.y = pk2(a[2], a[3]); w.z = pk2(b[0], b[1]); w.w = pk2(b[2], b[3]); return w;
}
__device__ __forceinline__ float tanh_fast(float x) { const float e = __expf(2.f * x); return 1.f - 2.f * __builtin_amdgcn_rcpf(1.f + e); }
__device__ __forceinline__ float decay_of(float v) { const float ew = 0.6065306597126334f * __builtin_amdgcn_rcpf(1.f + __expf(-v)); return __expf(-ew); }
struct EpiInproj {
    static constexpr bool PERM = true, AFTER_DRAIN = false;
    bf16* QKV; bf16* R32; bf16* Z;
    __device__ __forceinline__ void operator()(const f32x4 (&acc)[2][2][4][2], const pg8::Unit& u, int wr, int wc, int fr, int fq) const {
        const int pn = u.pn;
#pragma unroll
        for (int ai = 0; ai < 2; ++ai)
#pragma unroll
            for (int m = 0; m < 4; ++m) {
                const unsigned row = (unsigned)u.pm * 256u + ai * 128 + wr * 64 + m * 16 + fr;
#pragma unroll
                for (int bj = 0; bj < 2; ++bj) {
                    f32x4 v0 = acc[ai][bj][m][0], v1 = acc[ai][bj][m][1];
                    const int cb = bj * 128 + wc * 32 + 8 * fq;
                    if (pn < 6) {
                        if (pn == 3) { v0 = v0 * C2; v1 = v1 * C2; }
                        *(u32x4*)(QKV + row * 1536 + pn * 256 + cb) = pack8(v0, v1);
                    } else if (pn < 9) {
                        *(u32x4*)(R32 + row * 768 + (pn - 6) * 256 + cb) = pack8(v0, v1);
                    } else if (pn == 9) {
                        if (bj == 0) {
#pragma unroll
                            for (int e = 0; e < 4; ++e) { v0[e] = tanh_fast(v0[e]); v1[e] = tanh_fast(v1[e]); }
                        }
                        *(u32x4*)(Z + row * 384 + cb) = pack8(v0, v1);
                    } else {
                        if (bj == 0) {
#pragma unroll
                            for (int e = 0; e < 4; ++e) { v0[e] = sigmoidf_(v0[e]); v1[e] = sigmoidf_(v1[e]); }
                            *(u32x4*)(Z + row * 384 + 256 + cb) = pack8(v0, v1);
                        }
                    }
                }
            }
    }
};
struct EpiLora {
    static constexpr bool PERM = true, AFTER_DRAIN = false;
    bf16* DEC; bf16* ASIG; bf16* G; const float* w0; const float* a0;
    template <int KIND> __device__ __forceinline__ void body(const f32x4 (&acc)[2][2][4][2], bf16* dst, const float* bias, unsigned row0, int cb0) const {
#pragma unroll
        for (int bj = 0; bj < 2; ++bj) {
            const int cb = bj * 128 + cb0;
            f32x4 b0 = (f32x4){0.f, 0.f, 0.f, 0.f}, b1 = b0;
            if (KIND != 2) { b0 = *(const f32x4*)(bias + cb); b1 = *(const f32x4*)(bias + cb + 4); }
#pragma unroll
            for (int ai = 0; ai < 2; ++ai)
#pragma unroll
                for (int m = 0; m < 4; ++m) {
                    f32x4 v0 = acc[ai][bj][m][0] + b0, v1 = acc[ai][bj][m][1] + b1;
#pragma unroll
                    for (int e = 0; e < 4; ++e) {
                        if (KIND == 0) { v0[e] = 0.6065306597126334f * sigmoidf_(v0[e]); v1[e] = 0.6065306597126334f * sigmoidf_(v1[e]); }
                        if (KIND == 1) { v0[e] = sigmoidf_(v0[e]); v1[e] = sigmoidf_(v1[e]); }
                    }
                    *(u32x4*)(dst + (row0 + ai * 128 + m * 16) * 256u + cb) = pack8(v0, v1);
                    asm volatile("" ::: "memory");
                }
        }
    }
    __device__ __forceinline__ void operator()(const f32x4 (&acc)[2][2][4][2], const pg8::Unit& u, int wr, int wc, int fr, int fq) const {
        const int pn = u.pn; const unsigned row0 = (unsigned)u.pm * 256u + wr * 64 + fr; const int cb0 = wc * 32 + 8 * fq;
        if (pn < 2) body<0>(acc, DEC + (size_t)pn * M * 256, w0 + pn * 256, row0, cb0);
        else if (pn < 4) body<1>(acc, ASIG + (size_t)(pn - 2) * M * 256, a0 + (pn - 2) * 256, row0, cb0);
        else body<2>(acc, G, w0, row0, cb0);
    }
};
struct EpiOut {
    static constexpr bool PERM = true, AFTER_DRAIN = false;
    bf16* Y;
    __device__ __forceinline__ void operator()(const f32x4 (&acc)[2][2][4][2], const pg8::Unit& u, int wr, int wc, int fr, int fq) const {
#pragma unroll
        for (int ai = 0; ai < 2; ++ai)
#pragma unroll
            for (int m = 0; m < 4; ++m) {
                const unsigned row = (unsigned)u.pm * 256u + ai * 128 + wr * 64 + m * 16 + fr;
#pragma unroll
                for (int bj = 0; bj < 2; ++bj)
                    *(u32x4*)(Y + row * 1024 + u.pn * 256 + bj * 128 + wc * 32 + 8 * fq) = pack8(acc[ai][bj][m][0], acc[ai][bj][m][1]);
            }
    }
};
struct EpiMoe1 {
    static constexpr bool PERM = true, AFTER_DRAIN = false;
    bf16* HID;
    __device__ __forceinline__ void operator()(const f32x4 (&acc)[2][2][4][2], const pg8::Unit& u, int wr, int wc, int fr, int fq) const {
        const int pnl = u.pn & 7;
#pragma unroll
        for (int ai = 0; ai < 2; ++ai)
#pragma unroll
            for (int m = 0; m < 4; ++m) {
                const unsigned row = (unsigned)u.pm * 256u + ai * 128 + wr * 64 + m * 16 + fr;
                f32x4 h0, h1;
#pragma unroll
                for (int e = 0; e < 4; ++e) {
                    const float g0 = acc[ai][0][m][0][e], g1 = acc[ai][0][m][1][e];
                    h0[e] = g0 * sigmoidf_(g0) * acc[ai][1][m][0][e];
                    h1[e] = g1 * sigmoidf_(g1) * acc[ai][1][m][1][e];
                }
                *(u32x4*)(HID + row * 1024 + pnl * 128 + wc * 32 + 8 * fq) = pack8(h0, h1);
            }
    }
};
struct EpiMoe2 {
    static constexpr bool PERM = true, AFTER_DRAIN = false;
    bf16* OUTE; const float* selg;
    __device__ __forceinline__ void operator()(const f32x4 (&acc)[2][2][4][2], const pg8::Unit& u, int wr, int wc, int fr, int fq) const {
        const int pnl = u.pn & 3;
#pragma unroll
        for (int ai = 0; ai < 2; ++ai)
#pragma unroll
            for (int m = 0; m < 4; ++m) {
                const unsigned row = (unsigned)u.pm * 256u + ai * 128 + wr * 64 + m * 16 + fr;
                const float gt = selg[row];
#pragma unroll
                for (int bj = 0; bj < 2; ++bj)
                    *(u32x4*)(OUTE + row * 1024 + pnl * 256 + bj * 128 + wc * 32 + 8 * fq) = pack8(acc[ai][bj][m][0] * gt, acc[ai][bj][m][1] * gt);
            }
    }
};

struct TileSched {
    int nM, nN, G, c; bool latent_only;
    __device__ __forceinline__ bool next(int i, pg8::Unit& u) const {
        const long L = (long)i * G + c; if (L >= (long)nM * nN) return false;
        const int pmi = (int)(L / nN); u.pn = (int)(L % nN); u.pm = latent_only ? (pmi >> 3) * 9 + 1 + (pmi & 7) : pmi; return true;
    }
    __device__ __forceinline__ void a_ready(const pg8::Unit&) const {}
    __device__ __forceinline__ void done(const pg8::Unit&) const {}
};
struct InprojLastSched {
    int G, c;
    __device__ __forceinline__ bool next(int i, pg8::Unit& u) const {
        const int L = i * G + c; if (L >= 768) return false;
        if (L < 704) { const int pmi = L / 11; u.pn = L % 11; u.pm = (pmi >> 3) * 9 + 1 + (pmi & 7); }
        else { const int r = L - 704; u.pm = (r >> 3) * 9; const int k = r & 7; u.pn = k == 0 ? 2 : k + 3; }
        return true;
    }
    __device__ __forceinline__ void a_ready(const pg8::Unit&) const {}
    __device__ __forceinline__ void done(const pg8::Unit&) const {}
};
struct MoeSched {
    int nMe, nNe, G, c;
    __device__ __forceinline__ bool next(int i, pg8::Unit& u) const {
        const long L = (long)i * G + c; if (L >= (long)NE * nMe * nNe) return false;
        const int pnl = (int)(L % nNe), t = (int)(L / nNe), pml = t % nMe, e = t / nMe;
        u.pm = e * 9 + pml; u.pn = e * nNe + pnl; return true;
    }
    __device__ __forceinline__ void a_ready(const pg8::Unit&) const {}
    __device__ __forceinline__ void done(const pg8::Unit&) const {}
};

template <class Epi, class Sched>
__device__ __forceinline__ void gemm_ref(const pg8::Gemm g, const Sched& S, const Epi& E) {
    const int tid = threadIdx.x, wid = tid >> 6, lane = tid & 63, wr = wid >> 2, wc = wid & 3, fr = lane & 15, fq = lane >> 4;
    int K = g.K; asm volatile("" : "+s"(K));
    pg8::Unit u;
    for (int ui = 0; S.next(ui, u); ++ui) {
        f32x4 acc[2][2][4][2];
#pragma unroll
        for (int a = 0; a < 2; ++a)
#pragma unroll
            for (int b = 0; b < 2; ++b)
#pragma unroll
                for (int m = 0; m < 4; ++m)
#pragma unroll
                    for (int n = 0; n < 2; ++n) acc[a][b][m][n] = (f32x4){0.f, 0.f, 0.f, 0.f};
        const bf16* Ab = g.A + ((size_t)u.pm * 256 + wr * 64 + fr) * K;
        const bf16* Bb = g.Bt + ((size_t)u.pn * 256 + wc * 32 + 8 * fq) * K;
#pragma unroll
        for (int ai = 0; ai < 2; ++ai)
#pragma unroll
            for (int bj = 0; bj < 2; ++bj)
#pragma unroll
                for (int m = 0; m < 4; ++m)
#pragma unroll
                    for (int n = 0; n < 2; ++n)
#pragma unroll
                        for (int e = 0; e < 4; ++e) {
                            const bf16* ar = Ab + (size_t)(ai * 128 + m * 16) * K; const bf16* br = Bb + (size_t)(bj * 128 + 4 * n + e) * K;
                            float s0 = 0.f, s1 = 0.f;
#pragma unroll 2
                            for (int k0 = 0; k0 < K; k0 += 8) {
                                const u32x4 wa = *(const u32x4*)(ar + k0), wb = *(const u32x4*)(br + k0);
                                s0 += bflo(wa.x) * bflo(wb.x) + bflo(wa.y) * bflo(wb.y) + bflo(wa.z) * bflo(wb.z) + bflo(wa.w) * bflo(wb.w);
                                s1 += bfhi(wa.x) * bfhi(wb.x) + bfhi(wa.y) * bfhi(wb.y) + bfhi(wa.z) * bfhi(wb.z) + bfhi(wa.w) * bfhi(wb.w);
                            }
                            acc[ai][bj][m][n][e] = s0 + s1;
                            asm volatile("" ::: "memory");
                        }
        E(acc, u, wr, wc, fr, fq);
    }
}
template <class Epi, class Sched>
__device__ __forceinline__ void run_gemm(LAS unsigned char* lds, const pg8::Gemm g, const Sched& S, const Epi& E) {
#if GOLD_GEMM
    gemm_ref<Epi, Sched>(g, S, E);
    __syncthreads();
#else
    pg8::Gemm g2 = g; { int kd = g.K; asm volatile("" : "+s"(kd)); g2.K = kd; }
    pg8::gemm_phase<Epi, Sched, true, true>(lds, g2, S, E);
#endif
}

struct Args { const float* in[29]; float* out; unsigned char* ws; int ph_lo, ph_hi; };
enum { I_X = 0, I_C, I_CTX, I_CCTX, I_WMOD, I_BMOD, I_GPREMIX, I_GPOSTMIX, I_GPREFFN, I_GPOSTFFN, I_WIN, I_WOUT, I_QGAIN, I_KGAIN, I_RPB,
       I_W0, I_WUP, I_A0, I_AUP, I_GUP, I_KK, I_KA, I_RK, I_LNXW, I_LNXB, I_WROUTER, I_WEGATE, I_WEUP, I_WEDOWN };

struct Frame {
    LAS unsigned char* lds; volatile LAS unsigned* MISC; unsigned* ctl;
    int wave, vcu, G;
    const float* const* in; float* out; unsigned char* ws;
};
#define TID_ ((int)threadIdx.x)
#define LANE_ ((int)(threadIdx.x & 63u))
#define WSP(T_, off) ((T_*)(F.ws + (off)))

__device__ __forceinline__ void cvt_item(const float* src, int ld_src, bf16* dst, int ld_dst, LAS float* scr, int lane) {
#pragma unroll 8
    for (int i = 0; i < 32; ++i) { const int kk = 2 * i + (lane >> 5); scr[kk * 33 + (lane & 31)] = src[(size_t)kk * ld_src + (lane & 31)]; }
    LDS_WAIT(); asm volatile("" ::: "memory");
    const int c = lane & 7;
#pragma unroll
    for (int j = 0; j < 4; ++j) { const int n = (lane >> 3) + 8 * j; const LAS float* s = scr + (8 * c) * 33 + n;
        u32x4 o; o.x = pk2(s[0 * 33], s[1 * 33]); o.y = pk2(s[2 * 33], s[3 * 33]); o.z = pk2(s[4 * 33], s[5 * 33]); o.w = pk2(s[6 * 33], s[7 * 33]);
        *(u32x4*)(dst + (size_t)n * ld_dst + 8 * c) = o; }
    LDS_WAIT(); asm volatile("" ::: "memory");
}
__device__ __forceinline__ void cvt_moe_item(Frame& F, int l, int it, LAS float* scr, int lane) {
    const int which = it >> 13, r = it & 8191, e = r >> 9, q = r & 511, kb = q >> 5, nb = q & 31, n0 = nb * 32;
    const float* W = F.in[which == 0 ? I_WEGATE : (which == 1 ? I_WEUP : I_WEDOWN)] + ((size_t)(l * NE + e) * 1024 + kb * 64) * 1024 + n0;
    bf16* dst;
    if (which < 2) dst = WSP(bf16, WS_WGU) + ((size_t)e * 2048 + (n0 >> 7) * 256 + which * 128 + (n0 & 127)) * 1024 + kb * 64;
    else dst = WSP(bf16, WS_WD) + ((size_t)e * 1024 + n0) * 1024 + kb * 64;
    cvt_item(W, 1024, dst, 1024, scr, lane);
}
constexpr int CVT_NMINI = 3 * 8192 / NWAVES, CW_CVTQ = 40960;
__device__ __forceinline__ void cvt_moe_mini(Frame& F, int l, int mb) {
    int lane = LANE_; asm volatile("" : "+v"(lane));
    cvt_moe_item(F, l, mb * NWAVES + F.wave, (LAS float*)(F.lds + F.wave * 16384), lane);
}
__device__ __forceinline__ void cvt_moe_drain(Frame& F, int l, int n) {
    for (;;) {
        if (TID_ == 0) F.MISC[17] = atomicAdd(F.ctl + CW_CVTQ + 64 * l, (unsigned)n);
        __syncthreads();
        const int base = (int)F.MISC[17];
        __syncthreads();
        if (base >= CVT_NMINI) break;
#pragma unroll 1
        for (int k = 0; k < n; ++k) if (base + k < CVT_NMINI) cvt_moe_mini(F, l, base + k);
        __syncthreads();
    }
}

__device__ __forceinline__ void phase_init(Frame& F) {
    const int tid = TID_;
    {
        LAS float* sil = (LAS float*)F.lds;
        LAS float* red = (LAS float*)(F.lds + 40960);
        float* MOD = WSP(float, WS_MOD);
        bool have = false;
        for (int it = F.vcu; it < 2 * 96; it += F.G) {
            if (!have) {
                for (int i = tid; i < 9 * 1024; i += NTHREADS) { const int r = i >> 10, k = i & 1023; const float cv = (r < 8) ? F.in[I_C][r * 1024 + k] : F.in[I_CCTX][k]; sil[i] = cv / (1.f + expf(-cv)); }
                __syncthreads(); have = true;
            }
            const int l = it / 96, n0 = (it % 96) * 64, ks = tid >> 6, col = tid & 63;
            float acc[9];
#pragma unroll
            for (int r = 0; r < 9; ++r) acc[r] = 0.f;
            const float* w = F.in[I_WMOD] + ((size_t)l * 1024 + ks * 128) * 6144 + n0 + col;
            for (int k = 0; k < 128; ++k) { const float wv = w[(size_t)k * 6144];
#pragma unroll
                for (int r = 0; r < 9; ++r) acc[r] += sil[r * 1024 + ks * 128 + k] * wv; }
#pragma unroll
            for (int r = 0; r < 9; ++r) red[(ks * 9 + r) * 64 + col] = acc[r];
            __syncthreads();
            for (int o = tid; o < 576; o += NTHREADS) { const int r = o >> 6, cc = o & 63; float s = 0.f;
#pragma unroll
                for (int k2 = 0; k2 < 8; ++k2) s += red[(k2 * 9 + r) * 64 + cc];
                MOD[(size_t)(l * 9 + r) * 6144 + n0 + cc] = s + F.in[I_BMOD][l * 6144 + n0 + cc]; }
            __syncthreads();
        }
        __syncthreads();
    }
    {
        LAS float* scr = (LAS float*)(F.lds + F.wave * 16384);
        const int gw = F.vcu * NWAVES + F.wave, NGW = F.G * NWAVES;
        bf16* WIN = WSP(bf16, WS_WIN); bf16* WOUT = WSP(bf16, WS_WOUT);
        for (int it = gw; it < 2 * (1344 + 512); it += NGW) {
            const int l = it / 1856, r = it % 1856;
            if (r < 1344) { const int kb = r / 84, n0 = (r % 84) * 32; const int dn = n0 < 768 ? n0 : (n0 < 1920 ? n0 + 768 : n0 - 1152);
                cvt_item(F.in[I_WIN] + ((size_t)l * 1024 + kb * 64) * 2688 + n0, 2688, WIN + ((size_t)l * NINP + dn) * 1024 + kb * 64, 1024, scr, LANE_); }
            else { const int q = r - 1344, kb = q >> 5, n0 = (q & 31) * 32;
                cvt_item(F.in[I_WOUT] + ((size_t)l * 1024 + kb * 64) * 1024 + n0, 1024, WOUT + ((size_t)l * 1024 + n0) * 1024 + kb * 64, 1024, scr, LANE_); }
        }
    }
    {
        const size_t gt = (size_t)F.vcu * NTHREADS + tid, NT = (size_t)F.G * NTHREADS;
        u32x4* WIN4 = WSP(u32x4, WS_WIN);
        for (size_t i = gt; i < (size_t)2 * 128 * 128; i += NT) { const int l = (int)(i >> 14), r = (int)(i & 16383); WIN4[((size_t)l * NINP + 2688) * 128 + r] = (u32x4){0u, 0u, 0u, 0u}; }
        bf16* LORA = WSP(bf16, WS_LORA);
        for (size_t i = gt; i < (size_t)2 * 1280 * 384; i += NT) { const int l = (int)(i / (1280 * 384)), r = (int)(i % (1280 * 384)), n = r / 384, k = r % 384, tile = n >> 8, nn = n & 255;
            float v = 0.f;
            if (tile < 2) { const int d = tile, kk = k - 64 * d; if (kk >= 0 && kk < 64) v = F.in[I_WUP][(((size_t)l * 2 + d) * 64 + kk) * 256 + nn]; }
            else if (tile < 4) { const int d = tile - 2, kk = k - 128 - 64 * d; if (kk >= 0 && kk < 64) v = F.in[I_AUP][(((size_t)l * 2 + d) * 64 + kk) * 256 + nn]; }
            else { const int kk = k - 256; if (kk >= 0) v = F.in[I_GUP][((size_t)l * 128 + kk) * 256 + nn]; }
            LORA[i] = (bf16)f2bf(v); }
    }
}

__device__ __forceinline__ const float* in_row(Frame& F, int b, int t) { return t < CTXL ? F.in[I_CTX] + ((size_t)b * CTXL + t) * 1024 : F.in[I_X] + ((size_t)b * SEQ + (t - CTXL)) * 1024; }
__device__ __forceinline__ float row_ss(const f32x4 (&v)[4]) {
    float s = 0.f;
#pragma unroll
    for (int j = 0; j < 4; ++j) s += (v[j][0] * v[j][0] + v[j][1] * v[j][1]) + (v[j][2] * v[j][2] + v[j][3] * v[j][3]);
    return wave_sum(s);
}
__device__ __forceinline__ void mod_store(const f32x4 (&x)[4], float rinv, const float* g, const float* shift, const float* scale, bf16* dst, int lane, f32x4 (&h)[4]) {
#pragma unroll
    for (int j = 0; j < 4; ++j) { const int e = 256 * j + 4 * lane;
        const f32x4 gg = *(const f32x4*)(g + e), sh = *(const f32x4*)(shift + e), sc = *(const f32x4*)(scale + e);
        h[j] = x[j] * rinv * gg * (sc + 1.f) + sh;
        u32x2 w; w.x = pk2(h[j][0], h[j][1]); w.y = pk2(h[j][2], h[j][3]); *(u32x2*)(dst + e) = w; }
}
__device__ __forceinline__ void phase_row0(Frame& F) {
    const int gw = F.vcu * NWAVES + F.wave, NGW = F.G * NWAVES, lane = LANE_;
    bf16* H = WSP(bf16, WS_H); const float* MOD = WSP(float, WS_MOD);
    for (int m = gw; m < M; m += NGW) { const int b = m / T, t = m % T, r = t < CTXL ? 8 : b;
        const float* xin = in_row(F, b, t);
        f32x4 x[4], h[4];
#pragma unroll
        for (int j = 0; j < 4; ++j) x[j] = *(const f32x4*)(xin + 256 * j + 4 * lane);
        const float rinv = rsqrtf(row_ss(x) * (1.f / 1024.f) + 1e-6f);
        const float* md = MOD + (size_t)(0 * 9 + r) * 6144;
        mod_store(x, rinv, F.in[I_GPREMIX], md, md + 1024, H + (size_t)m * 1024, lane, h);
    }
}
__device__ __forceinline__ void phase_row1(Frame& F, int l, int dry = 0) {
    const int gw = F.vcu * NWAVES + F.wave, NGW = F.G * NWAVES, lane = LANE_;
    const float* X = WSP(float, WS_X); const bf16* Y = WSP(bf16, WS_Y); const float* MOD = WSP(float, WS_MOD);
    float* Xs = dry ? WSP(float, WS_XE) : WSP(float, WS_X); bf16* H2 = dry ? WSP(bf16, WS_YD) : WSP(bf16, WS_H2);
    float* AFF = dry ? WSP(float, WS_O) + 4 * MiB : WSP(float, WS_AFF); int* INV = dry ? WSP(int, WS_O) + 2 * MiB : WSP(int, WS_INV);
    {
        const float* src = F.in[I_WROUTER] + (size_t)l * 1024 * 16; LAS float* dstl = (LAS float*)F.lds;
        for (int i = TID_; i < 16384; i += NTHREADS) dstl[(i & 15) * 1024 + (i >> 4)] = src[i];
        __syncthreads();
    }
    const LAS float* wbase = (const LAS float*)F.lds + 4 * lane;
    auto row_ok = [&](int m) { return m < M && !(l == NL - 1 && (m % T) < CTXL); };
    auto next_row = [&](int m) { m += NGW; while (m < M && !row_ok(m)) m += NGW; return m; };
    int m = gw; if (!row_ok(m)) m = next_row(m);
    f32x4 xn[4], yn[4];
    if (m < M) { const float* xin = (l == 0) ? in_row(F, m / T, m % T) : X + (size_t)m * 1024;
#pragma unroll
        for (int j = 0; j < 4; ++j) { const u32x2 w = *(const u32x2*)(Y + (size_t)m * 1024 + 256 * j + 4 * lane); yn[j] = (f32x4){bflo(w.x), bfhi(w.x), bflo(w.y), bfhi(w.y)}; xn[j] = *(const f32x4*)(xin + 256 * j + 4 * lane); } }
    for (; m < M; ) { const int b = m / T, t = m % T, r = t < CTXL ? 8 : b;
        const float* md = MOD + (size_t)(l * 9 + r) * 6144;
        f32x4 x[4], y[4], h[4];
#pragma unroll
        for (int j = 0; j < 4; ++j) { x[j] = xn[j]; y[j] = yn[j]; }
        const int mnext = next_row(m);
        if (mnext < M) { const float* xin = (l == 0) ? in_row(F, mnext / T, mnext % T) : X + (size_t)mnext * 1024;
#pragma unroll
            for (int j = 0; j < 4; ++j) { const u32x2 w = *(const u32x2*)(Y + (size_t)mnext * 1024 + 256 * j + 4 * lane); yn[j] = (f32x4){bflo(w.x), bfhi(w.x), bflo(w.y), bfhi(w.y)}; xn[j] = *(const f32x4*)(xin + 256 * j + 4 * lane); } }
        const float rinv = rsqrtf(row_ss(y) * (1.f / 1024.f) + 1e-6f);
#pragma unroll
        for (int j = 0; j < 4; ++j) { const int e = 256 * j + 4 * lane;
            const f32x4 gg = *(const f32x4*)(F.in[I_GPOSTMIX] + l * 1024 + e), gt = *(const f32x4*)(md + 2 * 1024 + e);
            x[j] = x[j] + gt * (y[j] * rinv * gg); if (dry != 3) *(f32x4*)(Xs + (size_t)m * 1024 + e) = x[j]; }
        const float rinv2 = rsqrtf(row_ss(x) * (1.f / 1024.f) + 1e-6f);
        mod_store(x, rinv2, F.in[I_GPREFFN] + l * 1024, md + 3 * 1024, md + 4 * 1024, H2 + (size_t)m * 1024, lane, h);
        if (dry == 2) { m = mnext; continue; }
        float lg[16];
#pragma unroll
        for (int k = 0; k < 16; ++k) lg[k] = 0.f;
#pragma unroll
        for (int k = 0; k < 16; ++k) {
#pragma unroll
            for (int j = 0; j < 4; ++j) { const f32x4 wv = *(const LAS f32x4*)(wbase + k * 1024 + 256 * j); lg[k] += (h[j][0] * wv[0] + h[j][1] * wv[1]) + (h[j][2] * wv[2] + h[j][3] * wv[3]); }
            if ((k & 3) == 3) asm volatile("" ::: "memory");
        }
        float mx = -1e30f;
#pragma unroll
        for (int k = 0; k < 16; ++k) { lg[k] = wave_sum(lg[k]); mx = fmaxf(mx, lg[k]); }
        float den = 0.f, mine = 0.f;
#pragma unroll
        for (int k = 0; k < 16; ++k) { const float ex = expf(lg[k] - mx); den += ex; if ((lane & 15) == k) mine = ex; }
        if (lane < 16) { AFF[(size_t)m * 16 + lane] = mine / den; INV[(size_t)m * 16 + lane] = -1; }
        m = mnext;
    }
}
__device__ __forceinline__ void phase_row2(Frame& F, int l, bool dry = false) {
    const int gw = F.vcu * NWAVES + F.wave, NGW = F.G * NWAVES, lane = LANE_;
    const float* X = WSP(float, WS_X); const bf16* OUTE = WSP(bf16, WS_OUTE); const float* MOD = WSP(float, WS_MOD);
    float* Xs = dry ? WSP(float, WS_XE) : WSP(float, WS_X); bf16* H = dry ? WSP(bf16, WS_YD) : WSP(bf16, WS_H); float* outp = dry ? WSP(float, WS_XE) : F.out;
    const int* INV = WSP(int, WS_INV);
    const bool last = (l == NL - 1);
#if defined(TPROBE_ON)
    const float tp_scale = F.ctl[3000] ? 3.f : 1.f;
#else
    const float tp_scale = 1.f;
#endif
    auto row_ok = [&](int m) { return m < M && !(last && (m % T) < CTXL); };
    auto next_row = [&](int m) { m += NGW; while (m < M && !row_ok(m)) m += NGW; return m; };
    int m = gw; if (!row_ok(m)) m = next_row(m);
    f32x4 xn[4]; int invn = -1;
    if (m < M) { invn = INV[(size_t)m * 16 + (lane & 15)];
#pragma unroll
        for (int j = 0; j < 4; ++j) xn[j] = *(const f32x4*)(X + (size_t)m * 1024 + 256 * j + 4 * lane); }
    for (; m < M; ) { const int b = m / T, t = m % T, r = t < CTXL ? 8 : b;
        const float* md = MOD + (size_t)(l * 9 + r) * 6144;
        f32x4 x[4], f[4], h[4];
#pragma unroll
        for (int j = 0; j < 4; ++j) { x[j] = xn[j]; f[j] = (f32x4){0.f, 0.f, 0.f, 0.f}; }
        const int invl = invn;
        const int mnext = next_row(m);
        if (mnext < M) { invn = INV[(size_t)mnext * 16 + (lane & 15)];
#pragma unroll
            for (int j = 0; j < 4; ++j) xn[j] = *(const f32x4*)(X + (size_t)mnext * 1024 + 256 * j + 4 * lane); }
        for (int e = 0; e < 16; ++e) { const int rr = __shfl(invl, e);
            if (rr >= 0) {
#pragma unroll
                for (int j = 0; j < 4; ++j) { const u32x2 w = *(const u32x2*)(OUTE + (size_t)rr * 1024 + 256 * j + 4 * lane);
                    f[j][0] += bflo(w.x); f[j][1] += bfhi(w.x); f[j][2] += bflo(w.y); f[j][3] += bfhi(w.y); } } }
        const float rinv = rsqrtf(row_ss(f) * (1.f / 1024.f) + 1e-6f);
#pragma unroll
        for (int j = 0; j < 4; ++j) { const int e = 256 * j + 4 * lane;
            const f32x4 gg = *(const f32x4*)(F.in[I_GPOSTFFN] + l * 1024 + e), gt = *(const f32x4*)(md + 5 * 1024 + e);
            x[j] = x[j] + gt * (f[j] * rinv * gg);
            if (last) *(f32x4*)(outp + ((size_t)b * SEQ + (t - CTXL)) * 1024 + e) = x[j] * tp_scale;
            else *(f32x4*)(Xs + (size_t)m * 1024 + e) = x[j]; }
        if (!last) {
            const float rinv2 = rsqrtf(row_ss(x) * (1.f / 1024.f) + 1e-6f);
            const float* md2 = MOD + (size_t)((l + 1) * 9 + r) * 6144;
            mod_store(x, rinv2, F.in[I_GPREMIX] + (l + 1) * 1024, md2, md2 + 1024, H + (size_t)m * 1024, lane, h);
        }
        m = mnext;
    }
}

__device__ __forceinline__ void phase_qkprep(Frame& F, int l, bool dry = false) {
    const int gw = F.vcu * NWAVES + F.wave, NGW = F.G * NWAVES, lane = LANE_;
    bf16* QKV = WSP(bf16, WS_QKV); bf16* QO = dry ? WSP(bf16, WS_YD) : QKV;
    const float qg = F.in[I_QGAIN][l * 64 + lane] * C2, kg = F.in[I_KGAIN][l * 64 + lane];
    const int i16 = lane & 15; const bool second = (lane & 16) != 0, colseg = (lane & 32) != 0;
    const float inv = exp2f(-(float)i16 * (13.287712379549449f / 16.f));
    for (int m = gw; m < M; m += NGW) { const int t = m % T; const bool ctx = t < CTXL;
        const int s0 = (l == NL - 1 && ctx) ? 8 : 0;
        const bf16* p = QKV + (size_t)m * 1536 + lane; bf16* po = QO + (size_t)m * 1536 + lane;
        float x[10];
#pragma unroll
        for (int s = 0; s < 10; ++s) x[s] = (s >= s0) ? bf2f(p[s * 64]) : 0.f;
        float cs = 1.f, sn = 0.f;
        if (!ctx) { const int pos = t - CTXL; const float ang = (float)(colseg ? (pos & 63) : (pos >> 6)) * inv; cs = cosf(ang); sn = sinf(ang); if (!second) sn = -sn; }
#pragma unroll
        for (int s = 0; s < 10; ++s) {
            if (s < s0) continue;
            const float ss = wave_sum(x[s] * x[s]);
            float y = x[s] * __builtin_amdgcn_rsqf(ss * (1.f / 64.f) + 1e-6f) * (s < 8 ? qg : kg);
            const float other = __shfl_xor(y, 16);
            y = y * cs + other * sn;
            po[s * 64] = (bf16)f2bf(y);
        }
    }
}
#include <hip/hip_bf16.h>
#include <cmath>
namespace attn_body {
using bf16=__hip_bfloat16;
using bf16x8=__attribute__((ext_vector_type(8)))short;
using s16x4=__attribute__((ext_vector_type(4)))short;
using f32x16=__attribute__((ext_vector_type(16)))float;
using u32x4=__attribute__((ext_vector_type(4)))unsigned;
constexpr int D=64,QP=1536,OP=1024;
constexpr int NW=8,QBLK=32,QB=QBLK*NW,KVBLK=64;
__device__ __forceinline__ int crow(int r,int hi){return (r&3)+8*(r>>2)+4*hi;}
#define SBAR() __builtin_amdgcn_sched_barrier(0)
constexpr int NSLOT=3, SLOTB=8192;
constexpr int LDS_K=0, LDS_V=NSLOT*SLOTB, LDS_WS=2*NSLOT*SLOTB, LDS_OST=LDS_WS+NW*64*4, LDS_RPB=LDS_OST+NW*4096, LDS_BYTES=LDS_RPB+3072;
constexpr float C2=0.125f*1.4426950408889634f;
__device__ __forceinline__ void glds16(const void*gsrc,unsigned lds_dst){unsigned keep;
  asm volatile("s_mov_b32 %0, m0\n\ts_mov_b32 m0, %2\n\ts_nop 0\n\tglobal_load_lds_dwordx4 %1, off\n\ts_mov_b32 m0, %0":"=&s"(keep):"v"(gsrc),"s"(lds_dst):"memory");}
__device__ __forceinline__ float max3f(float a,float b,float c){float r;asm("v_max3_f32 %0, %1, %2, %3":"=v"(r):"v"(a),"v"(b),"v"(c));return r;}
__device__ __forceinline__ float max2f(float a,float b){float r;asm("v_max_f32_e32 %0, %1, %2":"=v"(r):"v"(a),"v"(b));return r;}
__device__ __forceinline__ float fadd_s(float a,float b){float r;asm("v_add_f32_e32 %0, %1, %2":"=v"(r):"v"(a),"v"(b));return r;}
__device__ __forceinline__ float fsub_s(float a,float b){float r;asm("v_sub_f32_e32 %0, %1, %2":"=v"(r):"v"(a),"v"(b));return r;}
typedef float f32x2_t __attribute__((ext_vector_type(2))); typedef __bf16 bf16x2_t __attribute__((ext_vector_type(2)));
__device__ __forceinline__ unsigned cvtpk_s(float lo,float hi){f32x2_t v={lo,hi};bf16x2_t b=__builtin_convertvector(v,bf16x2_t);return __builtin_bit_cast(unsigned,b);}
#define WAIT_BAR(N) asm volatile("s_waitcnt vmcnt(" #N ") lgkmcnt(0)\n\ts_barrier":::"memory")

__device__ __forceinline__ void qkt(f32x16&p0,f32x16&p1,const char*Kslot,const bf16x8*qr,const f32x16&negm,int r32,int hi){
  const char*kb=Kslot+hi*1024+r32*16;
  #pragma unroll
  for(int d0=0;d0<4;++d0){
    const bf16x8 b0=*reinterpret_cast<const bf16x8*>(kb+d0*2048);
    const bf16x8 b1=*reinterpret_cast<const bf16x8*>(kb+d0*2048+512);
    if(d0==0){p0=__builtin_amdgcn_mfma_f32_32x32x16_bf16(b0,qr[0],negm,0,0,0);p1=__builtin_amdgcn_mfma_f32_32x32x16_bf16(b1,qr[0],negm,0,0,0);}
    else{p0=__builtin_amdgcn_mfma_f32_32x32x16_bf16(b0,qr[d0],p0,0,0,0);p1=__builtin_amdgcn_mfma_f32_32x32x16_bf16(b1,qr[d0],p1,0,0,0);}}
}
typedef __attribute__((address_space(3))) const char* lds_cptr;
typedef short v4i16_t __attribute__((ext_vector_type(4)));
__device__ __forceinline__ void kload8(bf16x8*kf,lds_cptr kp){
  kf[0]=*(const __attribute__((address_space(3))) bf16x8*)(kp);      kf[1]=*(const __attribute__((address_space(3))) bf16x8*)(kp+512);
  kf[2]=*(const __attribute__((address_space(3))) bf16x8*)(kp+2048); kf[3]=*(const __attribute__((address_space(3))) bf16x8*)(kp+2560);
  kf[4]=*(const __attribute__((address_space(3))) bf16x8*)(kp+4096); kf[5]=*(const __attribute__((address_space(3))) bf16x8*)(kp+4608);
  kf[6]=*(const __attribute__((address_space(3))) bf16x8*)(kp+6144); kf[7]=*(const __attribute__((address_space(3))) bf16x8*)(kp+6656);
}
__device__ __forceinline__ void kload2(bf16x8*kf,lds_cptr kp,int j){ kf[2*j]=*(const __attribute__((address_space(3))) bf16x8*)(kp+j*2048); kf[2*j+1]=*(const __attribute__((address_space(3))) bf16x8*)(kp+j*2048+512); }
__device__ __forceinline__ s16x4 vtr(lds_cptr p){ return __builtin_bit_cast(s16x4,__builtin_amdgcn_ds_read_tr16_b64_v4i16((__attribute__((address_space(3))) v4i16_t*)p)); }
__device__ __forceinline__ float rowmax(const f32x16&p0,const f32x16&p1){
  float a=max3f(p0[0],p0[1],p1[0]),b=max3f(p0[2],p0[3],p1[1]);a=max3f(a,p1[2],p1[3]);
  #pragma unroll
  for(int r=4;r<16;r+=4){a=max3f(a,p0[r],p0[r+1]);b=max3f(b,p0[r+2],p0[r+3]);a=max3f(a,p1[r],p1[r+1]);b=max3f(b,p1[r+2],p1[r+3]);}
  const float m=max2f(a,b);
  auto rr=__builtin_amdgcn_permlane32_swap(__float_as_uint(m),__float_as_uint(m),false,false);
  return max2f(__uint_as_float(rr[0]),__uint_as_float(rr[1]));
}
__device__ __forceinline__ void pv(f32x16*o,int vb,bf16x8 pa0,bf16x8 pa1,bf16x8 pa2,bf16x8 pa3){
  #pragma unroll
  for(int d0=0;d0<2;++d0){s16x4 lo[4],hi[4];
    #pragma unroll
    for(int ks=0;ks<4;++ks){
      asm volatile("ds_read_b64_tr_b16 %0,%1 offset:%c2":"=&v"(lo[ks]):"v"(vb),"i"(d0*4096+ks*1024):"memory");
      asm volatile("ds_read_b64_tr_b16 %0,%1 offset:%c2":"=&v"(hi[ks]):"v"(vb),"i"(d0*4096+ks*1024+512):"memory");}
    asm volatile("s_waitcnt lgkmcnt(0)":::"memory");SBAR();
    #define PK(k) (bf16x8){lo[k][0],lo[k][1],lo[k][2],lo[k][3],hi[k][0],hi[k][1],hi[k][2],hi[k][3]}
    o[d0]=__builtin_amdgcn_mfma_f32_32x32x16_bf16(pa0,PK(0),o[d0],0,0,0);
    o[d0]=__builtin_amdgcn_mfma_f32_32x32x16_bf16(pa1,PK(1),o[d0],0,0,0);
    o[d0]=__builtin_amdgcn_mfma_f32_32x32x16_bf16(pa2,PK(2),o[d0],0,0,0);
    o[d0]=__builtin_amdgcn_mfma_f32_32x32x16_bf16(pa3,PK(3),o[d0],0,0,0);
    #undef PK
  }
}

#ifndef ATTN_STORE16
#define ATTN_STORE16(p,v) (*(u32x4*)(p)=(v))
#endif
template<int THRL,bool WIN> __device__ __forceinline__ void attn_unit(const bf16*Qw0,const bf16*__restrict__ Kh,const bf16*__restrict__ Vh,bf16*Ow0,const int NT,const int toff,const int rb,const int rs0,const float*rpbh,char*shm){
  int tid_=threadIdx.x; asm volatile("":"+v"(tid_));
  const int tid=tid_,lane=tid&63,r32=lane&31,hi=lane>>5; const int wid=__builtin_amdgcn_readfirstlane(tid>>6);
  const bf16*Qw=Qw0+(long)(wid*QBLK)*QP;
  const unsigned lds0=(unsigned)(uintptr_t)shm;
  float*wsf=(float*)(shm+LDS_WS)+wid*64;
  const bf16*ksrc=Kh+(long)lane*QP+wid*8;
  const bf16*vsrc=Vh+(long)(16*(wid&3)+(lane>>2))*QP+(wid>>2)*32+(lane&3)*8;
  const unsigned kdst=lds0+LDS_K+wid*1024, vdst=lds0+LDS_V+wid*1024;
  #define TROW(t) ((long)(((t)+(((t)>=4)?toff:0))*KVBLK)*QP)
  #define DMA_K(t,slot) glds16(ksrc+TROW(t),(unsigned)__builtin_amdgcn_readfirstlane(kdst+(slot)))
  #define DMA_V(t,slot) glds16(vsrc+TROW(t),(unsigned)__builtin_amdgcn_readfirstlane(vdst+(slot)))
  const int vb0=(int)(lds0+LDS_V)+((lane>>4)&1)*32+(lane&3)*8+(4*hi+((lane&15)>>2))*64;
  const char*Kbase=shm+LDS_K; bf16x8 kf[8];
  const lds_cptr shm3=(lds_cptr)shm; const lds_cptr kp0=shm3+LDS_K+hi*1024+r32*16; const lds_cptr vp0=shm3+LDS_V+((lane>>4)&1)*32+(lane&3)*8+(4*hi+((lane&15)>>2))*64;
  DMA_K(0,0);DMA_V(0,0);DMA_K(1,SLOTB);
  bf16x8 qr[4];
  #pragma unroll
  for(int d0=0;d0<4;++d0)qr[d0]=*reinterpret_cast<const bf16x8*>(&Qw[(long)r32*QP+d0*16+hi*8]);
  float mhat=0.f,l_reg=0.f;f32x16 o[2];o[0]=f32x16{};o[1]=f32x16{};f32x16 negm=f32x16{};asm volatile("":"+v"(negm));
  const int gr=4*rb+(wid>>1), gc=(wid&1)*32+r32, rsq=min(max(gr-4,0),24), csq=min(max(gc-8,0),48);
  const float*rpbl=(const float*)(shm+LDS_RPB+256)+(15-gc+4*hi);
  const int kcb=4*hi-csq;
  if(WIN){ for(int i_=tid;i_<15*31;i_+=512)((float*)(shm+LDS_RPB+256))[i_]=rpbh[i_]*1.4426950408889634f; }
  #define CMASK(P0,P1,t) do{ if(WIN && (t)>=4){ const int kr_=rs0+(t)-4; const bool rowok_=(kr_>=rsq)&&(kr_<rsq+8); \
      if(!rowok_){ _Pragma("unroll") for(int r=0;r<16;++r){P0[r]=-INFINITY;P1[r]=-INFINITY;} } \
      else { const float*bp_=rpbl+(kr_-gr+7)*31; \
        _Pragma("unroll") for(int r=0;r<16;++r){ const int o_=(r&3)+8*(r>>2); \
          const float b0_=bp_[o_], b1_=bp_[o_+32]; \
          P0[r]=((unsigned)(kcb+o_)<16u)?P0[r]+b0_:-INFINITY; P1[r]=((unsigned)(kcb+o_+32)<16u)?P1[r]+b1_:-INFINITY; } } } }while(0)
  bool resc=false;
  #define START(P0,P1) do{ const float rm=rowmax(P0,P1); resc=false; \
    { const float dl=rm; mhat=fadd_s(mhat,dl); \
      _Pragma("unroll") for(int r=0;r<16;++r){P0[r]=fsub_s(P0[r],dl);P1[r]=fsub_s(P1[r],dl);} \
      _Pragma("unroll") for(int r=0;r<16;++r)negm[r]=-mhat; asm volatile("":"+v"(negm)); } \
    _Pragma("unroll") for(int r=0;r<16;++r)P0[r]=__builtin_amdgcn_exp2f(P0[r]); }while(0)
  #define RESC() do{ if(resc){ asm volatile("s_waitcnt lgkmcnt(0)":::"memory"); \
      _Pragma("unroll") for(int d_=0;d_<2;++d_) _Pragma("unroll") for(int r=0;r<16;++r)o[d_][r]*=wsf[crow(r,hi)]; } }while(0)
  f32x16 pA0,pA1,pB0,pB1;
  int sl_prev=0,sl_cur=0,sl_next=SLOTB;
  #define ROT() do{sl_prev=sl_cur;sl_cur=sl_next;sl_next=(sl_next==(NSLOT-1)*SLOTB)?0:sl_next+SLOTB;}while(0)
  DMA_K(2,2*SLOTB);
  WAIT_BAR(3);
  qkt(pA0,pA1,Kbase,qr,negm,r32,hi);asm volatile("s_nop 15\n\ts_nop 7":"+v"(pA0),"+v"(pA1));CMASK(pA0,pA1,0);
  START(pA0,pA1);
  _Pragma("unroll") for(int r=0;r<16;++r)pA1[r]=__builtin_amdgcn_exp2f(pA1[r]);
  WAIT_BAR(0);
  DMA_K(3,0);DMA_V(1,SLOTB);
  ROT();
  kload8(kf,kp0+sl_cur);
  WAIT_BAR(2);
  s16x4 vlo[8],vhi[8]; u32x4 pw0,pw1,pw2,pw3;
  #define PKW(P,B) cvtpk_s(P[B],P[B+1])
  #define PAF(k) __builtin_bit_cast(bf16x8,pw##k)
  #define VFR(i) (bf16x8){vlo[i][0],vlo[i][1],vlo[i][2],vlo[i][3],vhi[i][0],vhi[i][1],vhi[i][2],vhi[i][3]}
  #define PIN(x) asm volatile("":"+v"(x))
  #define MX3(a,b,c) __builtin_fmaxf(__builtin_fmaxf((a),(b)),(c))
  #define GAPA(MF,A0,A1,A2,A3,W0,W1,PW) do{ MF; sacc+=A0; sacc+=A1; sacc+=A2; sacc+=A3; PIN(sacc); W0; W1; PIN(PW); SBAR(); }while(0)
  #define EX(v) __builtin_amdgcn_exp2f(v)
  #define GAPB(MF,X,B) do{ MF; X[B]=EX(X[B]); X[B+1]=EX(X[B+1]); X[B+2]=EX(X[B+2]); X[B+3]=EX(X[B+3]); PIN(X); SBAR(); }while(0)
  #define VRD(i) do{ vlo[i]=vtr(vp_+(((i)>>2)*4096+((i)&3)*1024)); vhi[i]=vtr(vp_+(((i)>>2)*4096+((i)&3)*1024+512)); }while(0)
  #define KRD(G,j) do{ if(G){ kload2(kf,kp0+sl_next,j); SBAR(); } }while(0)
  #define STEP(C0,C1,P0,P1,t,GK,GV,GL) do{ SBAR(); \
    const lds_cptr vp_=vp0+sl_prev; \
    VRD(0); SBAR(); float sacc=(P0[0]+P0[1]); \
    GAPA(C0=__builtin_amdgcn_mfma_f32_32x32x16_bf16(kf[0],qr[0],negm,0,0,0), P0[2],P0[3],P0[4],P0[5],     pw0[0]=PKW(P0,0), pw0[1]=PKW(P0,2), pw0); \
    VRD(4); SBAR(); GAPA(C1=__builtin_amdgcn_mfma_f32_32x32x16_bf16(kf[1],qr[0],negm,0,0,0), P0[6],P0[7],P0[8],P0[9],     pw0[2]=PKW(P0,4), pw0[3]=PKW(P0,6), pw0); \
    VRD(1); SBAR(); GAPA(C0=__builtin_amdgcn_mfma_f32_32x32x16_bf16(kf[2],qr[1],C0,0,0,0),   P0[10],P0[11],P0[12],P0[13], pw1[0]=PKW(P0,8), pw1[1]=PKW(P0,10), pw1); \
    VRD(5); SBAR(); GAPA(C1=__builtin_amdgcn_mfma_f32_32x32x16_bf16(kf[3],qr[1],C1,0,0,0),   P0[14],P0[15],P1[0],P1[1],   pw1[2]=PKW(P0,12),pw1[3]=PKW(P0,14), pw1); \
    VRD(2); SBAR(); GAPA(C0=__builtin_amdgcn_mfma_f32_32x32x16_bf16(kf[4],qr[2],C0,0,0,0),   P1[2],P1[3],P1[4],P1[5],     pw2[0]=PKW(P1,0), pw2[1]=PKW(P1,2), pw2); \
    VRD(6); SBAR(); GAPA(C1=__builtin_amdgcn_mfma_f32_32x32x16_bf16(kf[5],qr[2],C1,0,0,0),   P1[6],P1[7],P1[8],P1[9],     pw2[2]=PKW(P1,4), pw2[3]=PKW(P1,6), pw2); \
    VRD(3); SBAR(); GAPA(C0=__builtin_amdgcn_mfma_f32_32x32x16_bf16(kf[6],qr[3],C0,0,0,0),   P1[10],P1[11],P1[12],P1[13], pw3[0]=PKW(P1,8), pw3[1]=PKW(P1,10), pw3); \
    VRD(7); SBAR(); GAPA(C1=__builtin_amdgcn_mfma_f32_32x32x16_bf16(kf[7],qr[3],C1,0,0,0),   P1[14],P1[15],0.f,0.f,       pw3[2]=PKW(P1,12),pw3[3]=PKW(P1,14), pw3); \
    l_reg+=sacc; \
    if(GK){DMA_K((t)+3,sl_cur);} if(GV){DMA_V((t)+1,sl_next);} \
    CMASK(C0,C1,t); \
    { float a=MX3(C0[0],C0[1],C1[0]),b=MX3(C0[2],C0[3],C1[1]); a=MX3(a,C1[2],C1[3]); \
      _Pragma("unroll") for(int r=4;r<16;r+=4){a=MX3(a,C0[r],C0[r+1]);b=MX3(b,C0[r+2],C0[r+3]);a=MX3(a,C1[r],C1[r+1]);b=MX3(b,C1[r+2],C1[r+3]);} \
      float rm=__builtin_fmaxf(a,b); { auto rr=__builtin_amdgcn_permlane32_swap(__float_as_uint(rm),__float_as_uint(rm),false,false); rm=__builtin_fmaxf(__uint_as_float(rr[0]),__uint_as_float(rr[1])); } \
      resc=false; \
      if(__builtin_expect(__any(rm>(float)THRL),0)){ const float dl=__builtin_fmaxf(rm,0.f); mhat+=dl; \
        _Pragma("unroll") for(int r=0;r<16;++r){C0[r]-=dl;C1[r]-=dl;} \
        _Pragma("unroll") for(int r=0;r<16;++r)negm[r]=-mhat; asm volatile("":"+v"(negm)); \
        const float f=__builtin_amdgcn_exp2f(-dl); l_reg*=f; if(hi==0)wsf[r32]=f; resc=true; } } \
    SBAR(); \
    GAPB(o[0]=__builtin_amdgcn_mfma_f32_32x32x16_bf16(PAF(0),VFR(0),o[0],0,0,0), C0,0); \
    GAPB(o[1]=__builtin_amdgcn_mfma_f32_32x32x16_bf16(PAF(0),VFR(4),o[1],0,0,0), C0,4); \
    KRD(GL,0); GAPB(o[0]=__builtin_amdgcn_mfma_f32_32x32x16_bf16(PAF(1),VFR(1),o[0],0,0,0), C0,8); \
    KRD(GL,1); GAPB(o[1]=__builtin_amdgcn_mfma_f32_32x32x16_bf16(PAF(1),VFR(5),o[1],0,0,0), C0,12); \
    KRD(GL,2); GAPB(o[0]=__builtin_amdgcn_mfma_f32_32x32x16_bf16(PAF(2),VFR(2),o[0],0,0,0), C1,0); \
    KRD(GL,3); GAPB(o[1]=__builtin_amdgcn_mfma_f32_32x32x16_bf16(PAF(2),VFR(6),o[1],0,0,0), C1,4); \
    GAPB(o[0]=__builtin_amdgcn_mfma_f32_32x32x16_bf16(PAF(3),VFR(3),o[0],0,0,0), C1,8); \
    GAPB(o[1]=__builtin_amdgcn_mfma_f32_32x32x16_bf16(PAF(3),VFR(7),o[1],0,0,0), C1,12); \
    }while(0)
  int t=1;
  for(;t+5<NT;t+=2){
    STEP(pB0,pB1,pA0,pA1,t,true,true,true);     WAIT_BAR(2); RESC(); ROT();
    STEP(pA0,pA1,pB0,pB1,t+1,true,true,true);   WAIT_BAR(2); RESC(); ROT();
  }
  #define ENDW(tt) do{ if((tt)+3<NT){WAIT_BAR(2);} else if((tt)+2<NT){WAIT_BAR(1);} else {WAIT_BAR(0);} }while(0)
  for(;t+1<NT;t+=2){
    STEP(pB0,pB1,pA0,pA1,t,(t+3<NT),(t+1<NT),(t+1<NT));       ENDW(t);   RESC(); ROT();
    STEP(pA0,pA1,pB0,pB1,t+1,(t+4<NT),(t+2<NT),(t+2<NT));     ENDW(t+1); RESC(); ROT();
  }
  STEP(pB0,pB1,pA0,pA1,NT-1,false,false,false); RESC();
  { float sacc=pB0[0]+pB0[1]; _Pragma("unroll") for(int r=2;r<16;++r)sacc+=pB0[r]; _Pragma("unroll") for(int r=0;r<16;++r)sacc+=pB1[r]; l_reg+=sacc;
    pw0=(u32x4){PKW(pB0,0),PKW(pB0,2),PKW(pB0,4),PKW(pB0,6)};pw1=(u32x4){PKW(pB0,8),PKW(pB0,10),PKW(pB0,12),PKW(pB0,14)};pw2=(u32x4){PKW(pB1,0),PKW(pB1,2),PKW(pB1,4),PKW(pB1,6)};pw3=(u32x4){PKW(pB1,8),PKW(pB1,10),PKW(pB1,12),PKW(pB1,14)};
    SBAR(); pv(o,vb0+sl_cur,PAF(0),PAF(1),PAF(2),PAF(3)); }
  #undef PKW
  #undef PAF
  #undef VFR
  #undef PIN
  #undef MX3
  #undef GAPA
  #undef GAPB
  #undef EX
  #undef VRD
  #undef KRD
  #undef STEP
  #undef ENDW
  {auto rr=__builtin_amdgcn_permlane32_swap(__float_as_uint(l_reg),__float_as_uint(l_reg),false,false);l_reg=__uint_as_float(rr[0])+__uint_as_float(rr[1]);}
  if(hi==0)wsf[32+r32]=l_reg;asm volatile("s_waitcnt lgkmcnt(0)":::"memory");
  float rli[16];
  #pragma unroll
  for(int r=0;r<16;++r)rli[r]=__builtin_amdgcn_rcpf(wsf[32+crow(r,hi)]);
  bf16*Ow=Ow0+(long)(wid*QBLK)*OP;
  { bf16*stg=(bf16*)(shm+LDS_OST)+wid*2048;
    #pragma unroll
    for(int r=0;r<16;++r){const int orow=crow(r,hi);
      #pragma unroll
      for(int d0=0;d0<2;++d0)stg[orow*64+d0*32+r32]=__float2bfloat16(o[d0][r]*rli[r]);}
    asm volatile("s_waitcnt lgkmcnt(0)":::"memory");
    #pragma unroll
    for(int i=0;i<4;++i){const int row=i*8+(lane>>3),ch=lane&7; const u32x4 v=*(const u32x4*)(stg+row*64+ch*8); ATTN_STORE16(Ow+(long)row*OP+ch*8,v);} }
  asm volatile("s_waitcnt lgkmcnt(0)\n\ts_barrier":::"memory");
  #undef DMA_K
  #undef TROW
  #undef DMA_V
  #undef CMASK
  #undef START
  #undef RESC
  #undef ROT
}
constexpr int ATTN_LDS_BYTES=LDS_BYTES;
#undef SBAR
#undef WAIT_BAR
}
typedef float f32x2 __attribute__((ext_vector_type(2)));
__device__ __forceinline__ int scan_tok(int p, int dir) { return p < CTXL ? (dir ? CTXL - 1 - p : p) : (dir ? (T + CTXL - 1) - p : p); }

constexpr int CS_NCH = T / 16;
constexpr size_t WS_W1F = WS_H;
typedef float f32x16 __attribute__((ext_vector_type(16)));
typedef __bf16 bf16x2_t __attribute__((ext_vector_type(2)));
__device__ __forceinline__ unsigned cvtpk(float lo, float hi) { f32x2 v = {lo, hi}; bf16x2_t b = __builtin_convertvector(v, bf16x2_t); return __builtin_bit_cast(unsigned, b); }
__device__ __forceinline__ bf16x8 pack8f(float a0, float a1, float a2, float a3, float a4, float a5, float a6, float a7) {
    u32x4 w; w.x = cvtpk(a0, a1); w.y = cvtpk(a2, a3); w.z = cvtpk(a4, a5); w.w = cvtpk(a6, a7); return __builtin_bit_cast(bf16x8, w);
}
#define MF4(a, b, c) __builtin_amdgcn_mfma_f32_16x16x4f32((a), (b), (c), 0, 0, 0)

constexpr int PB_BK = 0, PB_AR = 4608, PB_CM = 9216, PB_EM = PB_CM + 16 * 17 * 4, PB_TM = PB_EM + 16 * 20 * 4, PB_P15 = PB_TM + 16 * 20 * 4, PB_BYTES = PB_P15 + 256;
constexpr int PBS = 72;
static_assert(8 * PB_BYTES <= RING_BYTES, "pre-pass LDS");
struct PPIn { float rr[16], kb[16], ww[16], as[16]; };
__device__ __forceinline__ void prepass_load(Frame& F, PPIn& I, int rec, int lane) {
    const int ch = rec / CS_NCH, c = rec % CS_NCH, b = ch >> 3, h = (ch >> 1) & 3, dir = ch & 1;
    const bf16* R32 = WSP(bf16, WS_R32); const bf16* DEC = WSP(bf16, WS_DEC) + (size_t)dir * M * 256; const bf16* ASIG = WSP(bf16, WS_ASIG) + (size_t)dir * M * 256;
    const int t0 = scan_tok(c * 16, dir); const int stp = dir ? -1 : 1;
#pragma unroll
    for (int t = 0; t < 16; ++t) { const size_t m = (size_t)b * T + (t0 + stp * t);
        I.rr[t] = bf2f(R32[m * 768 + h * 64 + lane]); I.kb[t] = bf2f(R32[m * 768 + 256 + h * 64 + lane]); I.ww[t] = bf2f(DEC[m * 256 + h * 64 + lane]); I.as[t] = bf2f(ASIG[m * 256 + h * 64 + lane]); }
}
__device__ __forceinline__ float bfu(unsigned short v) { return __builtin_bit_cast(float, (unsigned)v << 16); }
__device__ __forceinline__ void prepass_record(Frame& F, int l, int rec, LAS unsigned char* L, int lane, const PPIn& I) {
    const int ch = rec / CS_NCH, h = (ch >> 1) & 3;
    const int c = lane & 31, hh = lane >> 5;
    bf16* W1F = WSP(bf16, WS_W1F) + (size_t)rec * 2048; bf16* W2F = (bf16*)F.out + (size_t)rec * 3200; float* P15F = F.out + (size_t)rec * 1600 + 1536;
    LAS bf16* BK = (LAS bf16*)(L + PB_BK); LAS bf16* AR = (LAS bf16*)(L + PB_AR);
    LAS float* Cm = (LAS float*)(L + PB_CM); LAS float* Em = (LAS float*)(L + PB_EM); LAS float* Tm = (LAS float*)(L + PB_TM); LAS float* P15 = (LAS float*)(L + PB_P15);
    {
        const float kkw = F.in[I_KK][l * 256 + h * 64 + lane], kaw = F.in[I_KA][l * 256 + h * 64 + lane];
        float P = 1.f;
#pragma unroll
        for (int t = 0; t < 16; ++t) {
            const float r_ = I.rr[t], kb_ = I.kb[t], w_ = __expf(-I.ww[t]), as_ = I.as[t];
            float kk_ = kb_ * kkw; kk_ = kk_ * __builtin_amdgcn_rsqf(fmaxf(wave_sum(kk_ * kk_), 1e-24f));
            const float kd_ = kb_ * (1.f + (as_ - 1.f) * kaw);
            const float Pm = P; P *= w_; const float iP = __builtin_amdgcn_rcpf(P);
            AR[t * PBS + lane] = (bf16)f2bf(-kk_ * Pm); AR[(16 + t) * PBS + lane] = (bf16)f2bf(r_ * P);
            BK[t * PBS + lane] = (bf16)f2bf(kk_ * as_ * iP); BK[(16 + t) * PBS + lane] = (bf16)f2bf(kd_ * iP);
        }
        P15[lane] = P;
    }
    LDS_WAIT(); asm volatile("" ::: "memory");
#pragma unroll
    for (int ks = 0; ks < 4; ++ks) {
        const LAS bf16* src = AR + c * PBS + 16 * ks + 4 * hh;
        const u32x2 lo = *(const LAS u32x2*)src, hi = *(const LAS u32x2*)(src + 8);
        *(u32x4*)(W1F + (ks * 64 + lane) * 8) = (u32x4){lo.x, lo.y, hi.x, hi.y};
    }
    f32x16 Gm;
#pragma unroll
    for (int r = 0; r < 16; ++r) Gm[r] = 0.f;
#pragma unroll
    for (int ks = 0; ks < 4; ++ks)
        Gm = __builtin_amdgcn_mfma_f32_32x32x16_bf16(*(const LAS bf16x8*)(BK + c * PBS + 16 * ks + 8 * hh), *(const LAS bf16x8*)(AR + c * PBS + 16 * ks + 8 * hh), Gm, 0, 0, 0);
    {
        const int t = c & 15;
#pragma unroll
        for (int r = 0; r < 16; ++r) { const int s = (r & 3) + 8 * ((r & 7) >> 2) + 4 * hh; const bool keep = (c < 16) ? (s < t) : (s <= t); if (!keep) Gm[r] = 0.f; }
        if (c < 16) {
#pragma unroll
            for (int r = 0; r < 8; ++r) { const int s = (r & 3) + 8 * (r >> 2) + 4 * hh; Cm[s * 17 + t] = Gm[r]; Em[s * 20 + t] = Gm[8 + r]; }
        }
    }
    LDS_WAIT(); asm volatile("" ::: "memory");
    {
        const int rho = lane & 15;
        float x[16];
#pragma unroll
        for (int t = 0; t < 16; ++t) { float acc = (rho == t) ? 1.f : 0.f;
#pragma unroll
            for (int s = 0; s < t; ++s) acc += x[s] * Cm[s * 17 + t];
            x[t] = acc; }
        if (lane < 16) {
#pragma unroll
            for (int q = 0; q < 4; ++q) *(LAS f32x4*)(Tm + rho * 20 + 4 * q) = (f32x4){x[4 * q], x[4 * q + 1], x[4 * q + 2], x[4 * q + 3]}; }
    }
    LDS_WAIT(); asm volatile("" ::: "memory");
    bf16x8 A2;
    {
        float ta[8];
#pragma unroll
        for (int jj = 0; jj < 8; ++jj) ta[jj] = (c < 16) ? Tm[((jj & 3) + 8 * (jj >> 2) + 4 * hh) * 20 + c] : 0.f;
        const bf16x8 Aet = pack8f(ta[0], ta[1], ta[2], ta[3], ta[4], ta[5], ta[6], ta[7]);
        f32x4 e0 = (f32x4){0.f, 0.f, 0.f, 0.f}, e1 = e0, t0 = e0, t1 = e0;
        if (c >= 16) { e0 = *(const LAS f32x4*)(Em + (c - 16) * 20 + 4 * hh); e1 = *(const LAS f32x4*)(Em + (c - 16) * 20 + 8 + 4 * hh); }
        else { t0 = *(const LAS f32x4*)(Tm + c * 20 + 4 * hh); t1 = *(const LAS f32x4*)(Tm + c * 20 + 8 + 4 * hh); }
        const bf16x8 Bet = pack8f(e0[0], e0[1], e0[2], e0[3], e1[0], e1[1], e1[2], e1[3]);
        f32x16 Z;
#pragma unroll
        for (int r = 0; r < 16; ++r) Z[r] = 0.f;
        const f32x16 Dt = __builtin_amdgcn_mfma_f32_32x32x16_bf16(Aet, Bet, Z, 0, 0, 0);
        A2 = (c >= 16) ? pack8f(Dt[0], Dt[1], Dt[2], Dt[3], Dt[4], Dt[5], Dt[6], Dt[7]) : pack8f(t0[0], t0[1], t0[2], t0[3], t1[0], t1[1], t1[2], t1[3]);
    }
    {
        const bf16x8 Bm = pack8f(Gm[0], Gm[1], Gm[2], Gm[3], Gm[4], Gm[5], Gm[6], Gm[7]);
        const bf16x8 Bz = pack8f(0.f, 0.f, 0.f, 0.f, 0.f, 0.f, 0.f, 0.f);
        f32x16 Ci;
#pragma unroll
        for (int r = 0; r < 16; ++r) Ci[r] = (r >= 8 && c >= 16) ? Gm[r] : 0.f;
        const f32x16 Dm = __builtin_amdgcn_mfma_f32_32x32x16_bf16(A2, (c >= 16) ? Bm : Bz, Ci, 0, 0, 0);
        *(bf16x8*)(W2F + (0 * 64 + lane) * 8) = pack8f(Dm[0], Dm[1], Dm[2], Dm[3], Dm[4], Dm[5], Dm[6], Dm[7]);
        *(bf16x8*)(W2F + (1 * 64 + lane) * 8) = pack8f(Dm[8], Dm[9], Dm[10], Dm[11], Dm[12], Dm[13], Dm[14], Dm[15]);
    }
#pragma unroll
    for (int nt = 0; nt < 2; ++nt) {
        float bb[8]; f32x16 Ci;
#pragma unroll
        for (int jj = 0; jj < 8; ++jj) { const int kap = (jj & 3) + 8 * (jj >> 2) + 4 * hh;
            bb[jj] = bfu(BK[kap * PBS + 32 * nt + c]); Ci[jj] = 0.f; Ci[8 + jj] = bfu(BK[(16 + kap) * PBS + 32 * nt + c]); }
        const f32x16 Dn = __builtin_amdgcn_mfma_f32_32x32x16_bf16(A2, pack8f(bb[0], bb[1], bb[2], bb[3], bb[4], bb[5], bb[6], bb[7]), Ci, 0, 0, 0);
        const float p = P15[32 * nt + c];
        *(bf16x8*)(W2F + ((2 + 2 * nt) * 64 + lane) * 8) = pack8f(Dn[0] * p, Dn[1] * p, Dn[2] * p, Dn[3] * p, Dn[4] * p, Dn[5] * p, Dn[6] * p, Dn[7] * p);
        *(bf16x8*)(W2F + ((3 + 2 * nt) * 64 + lane) * 8) = pack8f(Dn[8] * p, Dn[9] * p, Dn[10] * p, Dn[11] * p, Dn[12] * p, Dn[13] * p, Dn[14] * p, Dn[15] * p);
    }
    { const int blk = c >> 4, reg = c & 15; P15F[lane] = P15[32 * blk + (reg & 3) + 8 * (reg >> 2) + 4 * hh]; }
    LDS_WAIT(); asm volatile("" ::: "memory");
}
__device__ __forceinline__ void phase_prepass(Frame& F, int l) {
    int lane = LANE_; asm volatile("" : "+v"(lane));
    LAS unsigned char* L = F.lds + F.wave * PB_BYTES;
    int rec = F.vcu * NWAVES + F.wave; const int stride = F.G * NWAVES;
    PPIn I; if (rec < 64 * CS_NCH) prepass_load(F, I, rec, lane);
    for (; rec < 64 * CS_NCH; rec += stride) {
        PPIn Nx = I; if (rec + stride < 64 * CS_NCH) prepass_load(F, Nx, rec + stride, lane);
        prepass_record(F, l, rec, L, lane, I);
        I = Nx;
    }
}

constexpr int CS_REC = 4096 + 6144 + 256 + 2048, CS_SLOTS = 8, CS_LEAD = 6, CS_NP = 13;
__device__ __forceinline__ void scan_chunked(Frame& F, int ch, int l) {
    int lane = LANE_; asm volatile("" : "+v"(lane));
    const int wave = F.wave, b = ch >> 3, h = (ch >> 1) & 3, dir = ch & 1, hh = lane >> 5, icol = 32 * (wave & 1) + (lane & 31);
    float* YD = WSP(float, WS_YD) + (size_t)dir * M * 256;
    const bf16* R32 = WSP(bf16, WS_R32);
    LAS unsigned char* ring = F.lds;
    u32x4 st[CS_NP];
    const int hw = wave - 2;
#define CS_SRC(cc, q) ({ const int rec_ = ch * CS_NCH + (cc); const u32x4* r_; \
        if ((q) < 4) r_ = (const u32x4*)(WSP(bf16, WS_W1F) + (size_t)rec_ * 2048) + lane + (q) * 64; \
        else if ((q) < 10) r_ = (const u32x4*)((const unsigned char*)F.out + (size_t)rec_ * 6400) + lane + ((q) - 4) * 64; \
        else { const int p = (q) * 64 + lane; const int pv = min(max(p - 656, 0), 127); \
            const u32x4* sv_ = (const u32x4*)(R32 + ((size_t)b * T + scan_tok((cc) * 16 + (pv >> 3), dir)) * 768 + 512 + h * 64) + (pv & 7); \
            r_ = ((q) == 10 && lane < 16) ? (const u32x4*)((const unsigned char*)F.out + (size_t)rec_ * 6400) + lane + 384 : sv_; } \
        r_; })
#define CS_ISSUE1(cc, q) do { st[q] = *CS_SRC(cc, q); } while (0)
#define CS_WRITE1(cc, q) do { const int p = (q) * 64 + lane; if ((q) < 12 || p < 784) ((LAS u32x4*)(ring + ((cc) % CS_SLOTS) * CS_REC))[p] = st[q]; } while (0)
#define CS_ISSUE(cc) do { _Pragma("unroll") for (int q = 0; q < CS_NP; ++q) CS_ISSUE1(cc, q); } while (0)
#define CS_WRITE(cc) do { _Pragma("unroll") for (int q = 0; q < CS_NP; ++q) CS_WRITE1(cc, q); } while (0)
#define CS_STEP(wc, q) do { CS_WRITE1(wc, q); if ((wc) + 6 < CS_NCH) CS_ISSUE1((wc) + 6, q); } while (0)
#define CS_BAR() do { asm volatile("s_waitcnt lgkmcnt(0)" ::: "memory"); __builtin_amdgcn_s_barrier(); asm volatile("" ::: "memory"); } while (0)
    if (wave >= 2) {
        CS_ISSUE(hw); CS_WRITE(hw);
        if (hw == 0) { CS_ISSUE(6); CS_WRITE(6); }
        { const int wc1 = (hw == 0) ? 12 : hw + 6; CS_ISSUE(wc1); }
        CS_BAR();
        int c = 0; const int c0 = (hw + 5) % 6;
        for (; c < c0; ++c) CS_BAR();
        for (; c + 6 <= CS_NCH; c += 6) {
            const int wc = c + 7;
            if (wc < CS_NCH) {
                CS_STEP(wc, 0); CS_STEP(wc, 1); CS_STEP(wc, 2); CS_BAR();
                CS_STEP(wc, 3); CS_STEP(wc, 4); CS_BAR();
                CS_STEP(wc, 5); CS_STEP(wc, 6); CS_BAR();
                CS_STEP(wc, 7); CS_STEP(wc, 8); CS_BAR();
                CS_STEP(wc, 9); CS_STEP(wc, 10); CS_BAR();
                CS_STEP(wc, 11); CS_STEP(wc, 12); CS_BAR();
            } else { CS_BAR(); CS_BAR(); CS_BAR(); CS_BAR(); CS_BAR(); CS_BAR(); }
        }
        for (; c < CS_NCH; ++c) CS_BAR();
    } else {
        f32x16 X0, X1;
#pragma unroll
        for (int r = 0; r < 16; ++r) { X0[r] = 0.f; X1[r] = 0.f; }
        CS_BAR();
        bf16x8 w1[4], w2[6]; f32x4 p15[8]; unsigned vv[8];
#define CS_RD(cc) do { const LAS unsigned char* rec_ = ring + ((cc) % CS_SLOTS) * CS_REC; \
            _Pragma("unroll") for (int k = 0; k < 4; ++k) w1[k] = ((const LAS bf16x8*)rec_)[k * 64 + lane]; \
            _Pragma("unroll") for (int k = 0; k < 6; ++k) w2[k] = ((const LAS bf16x8*)(rec_ + 4096))[k * 64 + lane]; \
            _Pragma("unroll") for (int k = 0; k < 8; ++k) p15[k] = ((const LAS f32x4*)(rec_ + 10240 + hh * 128))[k]; \
            _Pragma("unroll") for (int jj = 0; jj < 8; ++jj) vv[jj] = ((const LAS bf16*)(rec_ + 10496))[(8 * (jj >> 2) + 4 * hh + (jj & 3)) * 64 + icol]; } while (0)
        CS_RD(0);
        for (int c = 0; c < CS_NCH; ++c) {
            f32x16 G;
#pragma unroll
            for (int r = 0; r < 16; ++r) G[r] = 0.f;
            G = __builtin_amdgcn_mfma_f32_32x32x16_bf16(w1[0], pack8f(X0[0], X0[1], X0[2], X0[3], X0[4], X0[5], X0[6], X0[7]), G, 0, 0, 0);
            G = __builtin_amdgcn_mfma_f32_32x32x16_bf16(w1[1], pack8f(X0[8], X0[9], X0[10], X0[11], X0[12], X0[13], X0[14], X0[15]), G, 0, 0, 0);
            G = __builtin_amdgcn_mfma_f32_32x32x16_bf16(w1[2], pack8f(X1[0], X1[1], X1[2], X1[3], X1[4], X1[5], X1[6], X1[7]), G, 0, 0, 0);
            G = __builtin_amdgcn_mfma_f32_32x32x16_bf16(w1[3], pack8f(X1[8], X1[9], X1[10], X1[11], X1[12], X1[13], X1[14], X1[15]), G, 0, 0, 0);
            const bf16x8 g1 = pack8f(G[0], G[1], G[2], G[3], G[4], G[5], G[6], G[7]);
            const bf16x8 vf = __builtin_bit_cast(bf16x8, (u32x4){vv[0] | (vv[1] << 16), vv[2] | (vv[3] << 16), vv[4] | (vv[5] << 16), vv[6] | (vv[7] << 16)});
            f32x16 Y = __builtin_amdgcn_mfma_f32_32x32x16_bf16(w2[0], g1, G, 0, 0, 0);
            Y = __builtin_amdgcn_mfma_f32_32x32x16_bf16(w2[1], vf, Y, 0, 0, 0);
#pragma unroll
            for (int k = 0; k < 4; ++k) {
#pragma unroll
                for (int e = 0; e < 4; ++e) { X0[4 * k + e] *= p15[k][e]; X1[4 * k + e] *= p15[4 + k][e]; } }
            X0 = __builtin_amdgcn_mfma_f32_32x32x16_bf16(w2[2], g1, X0, 0, 0, 0);
            X0 = __builtin_amdgcn_mfma_f32_32x32x16_bf16(w2[3], vf, X0, 0, 0, 0);
            X1 = __builtin_amdgcn_mfma_f32_32x32x16_bf16(w2[4], g1, X1, 0, 0, 0);
            X1 = __builtin_amdgcn_mfma_f32_32x32x16_bf16(w2[5], vf, X1, 0, 0, 0);
            if (c + 1 < CS_NCH) CS_RD(c + 1);
            {
                float* yp = YD + ((size_t)b * T + scan_tok(c * 16, dir)) * 256 + h * 64 + icol + (dir ? -4 * hh * 256 : 4 * hh * 256);
                const int st = dir ? -256 : 256;
#pragma unroll
                for (int r = 8; r < 16; ++r) yp[((r & 3) + 8 * ((r >> 2) - 2)) * st] = Y[r];
            }
            asm volatile("" ::: "memory"); __builtin_amdgcn_s_barrier(); asm volatile("" ::: "memory");
        }
#undef CS_RD
    }
#undef CS_BAR
#undef CS_ISSUE
#undef CS_ISSUE1
#undef CS_WRITE1
#undef CS_STEP
#undef CS_SRC
#undef CS_WRITE
    __syncthreads();
}

constexpr int SC_TC = 16, SC_STEP = 6 * 64, SC_BUF = SC_TC * SC_STEP;
constexpr int SC_YOFF = 2 * SC_BUF, SC_DUMMY = SC_YOFF + 2 * SC_TC * 64;
#if GOLD_ATTN
__device__ __forceinline__ void attn_ref_unit(Frame& F, int mode, int qrow0, int qcol, int krow0, int nkeys, int kcol, int vcol, int ocol,
                                              int rb, const float* rpbh) {
    const int tid = TID_, q = tid & 255, dh = tid >> 8;
    const bf16* QKV = WSP(bf16, WS_QKV); bf16* O = WSP(bf16, WS_O);
    const int gr = 4 * rb + (q >> 6), gc = q & 63;
    const size_t qrow = (size_t)qrow0 + q;
    float qv[64], o[32];
#pragma unroll
    for (int d8 = 0; d8 < 8; ++d8) { const u32x4 w = *(const u32x4*)(QKV + qrow * 1536 + qcol + 8 * d8);
        qv[8 * d8 + 0] = bflo(w.x); qv[8 * d8 + 1] = bfhi(w.x); qv[8 * d8 + 2] = bflo(w.y); qv[8 * d8 + 3] = bfhi(w.y);
        qv[8 * d8 + 4] = bflo(w.z); qv[8 * d8 + 5] = bfhi(w.z); qv[8 * d8 + 6] = bflo(w.w); qv[8 * d8 + 7] = bfhi(w.w); }
#pragma unroll
    for (int d = 0; d < 32; ++d) o[d] = 0.f;
    float mrun = -1e30f, lrun = 0.f;
    const int kend = mode == 0 ? nkeys : 128 + CTXL;
    const int rs = min(max(gr - 4, 0), 32 - 8), cs = min(max(gc - 8, 0), 64 - 16);
    for (int kk = 0; kk < kend; ++kk) {
        size_t krow; float bias = 0.f;
        if (mode == 0) krow = (size_t)krow0 + kk;
        else if (kk < 128) { const int kr = rs + (kk >> 4), kc = cs + (kk & 15); krow = (size_t)krow0 + CTXL + kr * 64 + kc; bias = rpbh[(kr - gr + 7) * 31 + (kc - gc + 15)] * LOG2E; }
        else krow = (size_t)krow0 + (kk - 128);
        float s = bias;
#pragma unroll
        for (int d8 = 0; d8 < 8; ++d8) { const u32x4 w = *(const u32x4*)(QKV + krow * 1536 + kcol + 8 * d8);
            s += qv[8 * d8 + 0] * bflo(w.x) + qv[8 * d8 + 1] * bfhi(w.x) + qv[8 * d8 + 2] * bflo(w.y) + qv[8 * d8 + 3] * bfhi(w.y)
               + qv[8 * d8 + 4] * bflo(w.z) + qv[8 * d8 + 5] * bfhi(w.z) + qv[8 * d8 + 6] * bflo(w.w) + qv[8 * d8 + 7] * bfhi(w.w); }
        const float mn = fmaxf(mrun, s), al = exp2f(mrun - mn), p = exp2f(s - mn);
        lrun = lrun * al + p; mrun = mn;
#pragma unroll
        for (int d8 = 0; d8 < 4; ++d8) { const u32x4 w = *(const u32x4*)(QKV + krow * 1536 + vcol + 32 * dh + 8 * d8);
            o[8 * d8 + 0] = o[8 * d8 + 0] * al + p * bflo(w.x); o[8 * d8 + 1] = o[8 * d8 + 1] * al + p * bfhi(w.x);
            o[8 * d8 + 2] = o[8 * d8 + 2] * al + p * bflo(w.y); o[8 * d8 + 3] = o[8 * d8 + 3] * al + p * bfhi(w.y);
            o[8 * d8 + 4] = o[8 * d8 + 4] * al + p * bflo(w.z); o[8 * d8 + 5] = o[8 * d8 + 5] * al + p * bfhi(w.z);
            o[8 * d8 + 6] = o[8 * d8 + 6] * al + p * bflo(w.w); o[8 * d8 + 7] = o[8 * d8 + 7] * al + p * bfhi(w.w); }
    }
    const float li = 1.f / lrun;
#pragma unroll
    for (int d8 = 0; d8 < 4; ++d8) { u32x4 w;
        w.x = pk2(o[8 * d8 + 0] * li, o[8 * d8 + 1] * li); w.y = pk2(o[8 * d8 + 2] * li, o[8 * d8 + 3] * li);
        w.z = pk2(o[8 * d8 + 4] * li, o[8 * d8 + 5] * li); w.w = pk2(o[8 * d8 + 6] * li, o[8 * d8 + 7] * li);
        *(u32x4*)(O + qrow * 1024 + ocol + 32 * dh + 8 * d8) = w; }
}
#endif
__device__ __forceinline__ void attn_item(Frame& F, int item, int l) {
    const float* rpb = F.in[I_RPB] + (size_t)l * 4 * 15 * 31;
    int mode = 0, qrow0, qcol, krow0, nkeys, kcol, vcol, ocol, rb = 0;
    if (item < 512) { const int b = item >> 6, h = (item >> 3) & 7, qb = item & 7;
        qrow0 = b * T + CTXL + qb * 256; qcol = h * 64; krow0 = b * T; nkeys = T; kcol = 512 + (h >> 2) * 64; vcol = 640 + (h >> 2) * 64; ocol = h * 64; }
    else if (item < 768) { const int it = item - 512, b = it >> 5, h = (it >> 3) & 3; rb = it & 7; mode = 1;
        qrow0 = b * T + CTXL + rb * 256; qcol = 768 + h * 64; krow0 = b * T; nkeys = 0; kcol = 1024 + h * 64; vcol = 1280 + h * 64; ocol = 768 + h * 64; rpb += h * 15 * 31; }
    else if (item < 832) { const int it = item - 768, b = it >> 3, h = it & 7;
        qrow0 = b * T; qcol = h * 64; krow0 = b * T; nkeys = CTXL; kcol = 512 + (h >> 2) * 64; vcol = 640 + (h >> 2) * 64; ocol = h * 64; }
    else { const int it = item - 832, b = it >> 2, h = it & 3;
        qrow0 = b * T; qcol = 768 + h * 64; krow0 = b * T; nkeys = CTXL; kcol = 1024 + h * 64; vcol = 1280 + h * 64; ocol = 768 + h * 64; }
#if GOLD_ATTN
    attn_ref_unit(F, mode, qrow0, qcol, krow0, nkeys, kcol, vcol, ocol, rb, rpb);
#else
    const attn_body::bf16* QKV = (const attn_body::bf16*)WSP(bf16, WS_QKV); attn_body::bf16* O = (attn_body::bf16*)WSP(bf16, WS_O);
    const attn_body::bf16* Qw0 = QKV + (size_t)qrow0 * 1536 + qcol; const attn_body::bf16* Kh = QKV + (size_t)krow0 * 1536 + kcol; const attn_body::bf16* Vh = QKV + (size_t)krow0 * 1536 + vcol;
    attn_body::bf16* Ow0 = O + (size_t)qrow0 * 1024 + ocol;
    if (mode == 0) attn_body::attn_unit<8, false>(Qw0, Kh, Vh, Ow0, nkeys >> 6, 0, 0, 0, rpb, (char*)F.lds);
    else { const int rs0 = min(max(4 * rb - 4, 0), 24); attn_body::attn_unit<8, true>(Qw0, Kh, Vh, Ow0, (rb == 0 || rb == 7) ? 12 : 16, rs0, rb, rs0, rpb, (char*)F.lds); }
#endif
}
template <int NI> struct PostIn { float y[NI], r[NI], kb[NI], v[NI], as0[NI], as1[NI], gg[NI]; };
template <int NI> __device__ __forceinline__ void post_load(Frame& F, PostIn<NI>& P, int m0, int h, int lane) {
    const bf16* R32 = WSP(bf16, WS_R32); const bf16* ASIG = WSP(bf16, WS_ASIG); const float* YD = WSP(float, WS_YD); const bf16* Gb = WSP(bf16, WS_G);
    const int ch = h * 64 + lane;
#pragma unroll
    for (int k = 0; k < NI; ++k) { const size_t mm = (size_t)(m0 + k);
        P.y[k] = YD[mm * 256 + ch] + YD[((size_t)M + mm) * 256 + ch];
        P.r[k] = bf2f(R32[mm * 768 + ch]); P.kb[k] = bf2f(R32[mm * 768 + 256 + ch]); P.v[k] = bf2f(R32[mm * 768 + 512 + ch]);
        P.as0[k] = bf2f(ASIG[mm * 256 + ch]); P.as1[k] = bf2f(ASIG[((size_t)M + mm) * 256 + ch]); P.gg[k] = bf2f(Gb[mm * 256 + ch]); }
}
template <int NI> __device__ __forceinline__ void post_math(Frame& F, int l, const PostIn<NI>& P, int m0, int h, int lane) {
    bf16* O = WSP(bf16, WS_O);
    const int ch = h * 64 + lane;
    const float lw = F.in[I_LNXW][l * 256 + ch], lb = F.in[I_LNXB][l * 256 + ch], ka = F.in[I_KA][l * 256 + ch], rk = F.in[I_RK][l * 256 + ch];
#pragma unroll
    for (int k = 0; k < NI; ++k) {
        const float mu = wave_sum(P.y[k]) * (1.f / 64.f); const float dv = P.y[k] - mu; const float var = wave_sum(dv * dv) * (1.f / 64.f);
        const float yn = dv * rsqrtf(var + 64e-5f) * lw + lb;
        const float kd0 = P.kb[k] * (1.f + (P.as0[k] - 1.f) * ka), kd1 = P.kb[k] * (1.f + (P.as1[k] - 1.f) * ka);
        const float bon = wave_sum(P.r[k] * (kd0 + kd1) * rk) * P.v[k];
        O[(size_t)(m0 + k) * 1024 + 512 + ch] = (bf16)f2bf((yn + bon) * P.gg[k]);
    }
}
__device__ __forceinline__ void post_item(Frame& F, int l, int m, int h, int lane) { PostIn<1> P; post_load<1>(F, P, m, h, lane); post_math<1>(F, l, P, m, h, lane); }
constexpr int CW_SCDONE = 36864, CW_POSTQ = 37888;
__device__ __forceinline__ void phase_mixer(Frame& F, int l, int rep = 0) {
    if (F.vcu < 64) { scan_chunked(F, F.vcu, l);
        if (rep == 0) {
            asm volatile("s_waitcnt vmcnt(0)" ::: "memory"); __syncthreads();
            if (TID_ == 0) { __builtin_amdgcn_fence(__ATOMIC_RELEASE, "agent"); asm volatile("s_waitcnt vmcnt(0)" ::: "memory"); (void)xb_add(F.ctl + CW_SCDONE + 64 * l, 1u); }
        } }
    if (rep == 2) return;
    const int nattn = (l == NL - 1) ? 768 : 864;
    for (;;) {
        if (TID_ == 0) F.MISC[16] = atomicAdd(F.ctl + CW_QUEUE + 64 * (l + 2 * rep), 1u);
        __syncthreads();
        const int item = (int)F.MISC[16];
        __syncthreads();
        if (item >= nattn) break;
        attn_item(F, item, l);
    }
    if (rep == 0) {
        if (TID_ == 0) { unsigned sp = 0; while (xb_ld(F.ctl + CW_SCDONE + 64 * l) < 64u) { __builtin_amdgcn_s_sleep(2); if (++sp > (1u << 24)) break; }
            __builtin_amdgcn_fence(__ATOMIC_ACQUIRE, "agent"); asm volatile("s_waitcnt vmcnt(0)" ::: "memory"); }
        __syncthreads();
        const int t0 = (l == NL - 1) ? CTXL : 0, nchunk = (T - t0) / 64, nitem = 32 * nchunk, lane = LANE_;
        for (;;) {
            if (TID_ == 0) F.MISC[16] = atomicAdd(F.ctl + CW_POSTQ + 64 * l, 1u);
            __syncthreads();
            const int item = (int)F.MISC[16];
            __syncthreads();
            if (item >= nitem) break;
            const int bh = item / nchunk, ck = item % nchunk, m0 = (bh >> 2) * T + t0 + ck * 64 + 8 * F.wave;
            PostIn<8> P; post_load<8>(F, P, m0, bh & 3, lane); post_math<8>(F, l, P, m0, bh & 3, lane);
        }
    }
    cvt_moe_drain(F, l, 4);
}

__device__ __forceinline__ unsigned wave_incl_scan(unsigned v, int lane) {
#pragma unroll
    for (int o = 1; o < 64; o <<= 1) { const unsigned u = __shfl_up(v, o); if (lane >= o) v += u; }
    return v;
}
__device__ __forceinline__ void phase_topk(Frame& F, int l) {
    const int tid = TID_, lane = LANE_, wave = F.wave;
    LAS unsigned* hist = (LAS unsigned*)F.lds;
    LAS unsigned* ctrl = hist + 256;
    LAS unsigned* wsum = hist + 272;
    LAS int* stok = (LAS int*)(hist + 288);
    const float* AFF = WSP(float, WS_AFF); int* INV = WSP(int, WS_INV); float* SELG = WSP(float, WS_SELG); int* SELT = WSP(int, WS_SELT);
    const bf16* H2 = WSP(bf16, WS_H2); bf16* XE = WSP(bf16, WS_XE);
    const int nitems = (l == NL - 1) ? 128 : 256;
    for (int it = F.vcu; it < nitems; it += F.G) {
        const int seg = it >> 7, be = it & 127, b = be >> 4, e = be & 15;
        const int n = seg ? CTXL : SEQ, cap = n / 8, mbase = b * T + (seg ? 0 : CTXL);
        const int rowbase = e * MEXP + (seg ? 2048 + b * 32 : b * 256);
        unsigned key[4];
#pragma unroll
        for (int k = 0; k < 4; ++k) { const int i = 4 * tid + k; key[k] = (i < n) ? __float_as_uint(AFF[(size_t)(mbase + i) * 16 + e]) : 0u; }
        if (tid == 0) { ctrl[0] = 0u; ctrl[1] = (unsigned)cap; }
        unsigned prefix = 0u, pmask = 0u;
#pragma unroll 1
        for (int pass = 0; pass < 4; ++pass) {
            const int shift = 24 - 8 * pass;
            if (tid < 256) hist[tid] = 0u;
            __syncthreads();
#pragma unroll
            for (int k = 0; k < 4; ++k) if ((key[k] & pmask) == prefix && key[k] != 0u) __hip_atomic_fetch_add(&hist[(key[k] >> shift) & 255u], 1u, __ATOMIC_RELAXED, __HIP_MEMORY_SCOPE_WORKGROUP);
            __syncthreads();
            if (wave == 0) {
                const unsigned need = ctrl[1];
                unsigned c4[4]; unsigned tot = 0u;
#pragma unroll
                for (int k = 0; k < 4; ++k) { c4[k] = hist[255 - (4 * lane + k)]; tot += c4[k]; }
                const unsigned incl = wave_incl_scan(tot, lane); unsigned run = incl - tot;
#pragma unroll
                for (int k = 0; k < 4; ++k) { if (run < need && run + c4[k] >= need) { ctrl[0] = prefix | ((unsigned)(255 - (4 * lane + k)) << shift); ctrl[1] = need - run; } run += c4[k]; }
            }
            __syncthreads();
            prefix = ctrl[0]; pmask |= 255u << shift;
        }
        const unsigned thr = prefix, need_eq = ctrl[1];
        unsigned ngt = 0u, neq = 0u;
#pragma unroll
        for (int k = 0; k < 4; ++k) { ngt += key[k] > thr; neq += key[k] == thr; }
        const unsigned packed = ngt | (neq << 16);
        const unsigned incl = wave_incl_scan(packed, lane);
        if (lane == 63) wsum[wave] = incl;
        __syncthreads();
        unsigned base = 0u, total = 0u;
#pragma unroll
        for (int w = 0; w < NWAVES; ++w) { const unsigned s = wsum[w]; if (w < wave) base += s; total += s; }
        const unsigned excl = base + incl - packed;
        unsigned pgt = excl & 0xffffu, peq = excl >> 16; const unsigned cnt_gt = total & 0xffffu;
#pragma unroll
        for (int k = 0; k < 4; ++k) {
            int slot = -1;
            if (key[k] > thr) slot = (int)pgt++;
            else if (key[k] == thr) { if (peq < need_eq) slot = (int)(cnt_gt + peq); ++peq; }
            if (slot >= 0) { const int m = mbase + 4 * tid + k; stok[slot] = m;
                SELG[rowbase + slot] = __uint_as_float(key[k]); SELT[rowbase + slot] = m; INV[(size_t)m * 16 + e] = rowbase + slot; }
        }
        __syncthreads();
        for (int s0 = wave * 4; s0 < cap; s0 += NWAVES * 4) {
            u32x4 v[4][2];
#pragma unroll
            for (int k = 0; k < 4; ++k) { const int m = stok[s0 + k];
                const u32x4* src = (const u32x4*)(H2 + (size_t)m * 1024); v[k][0] = src[lane]; v[k][1] = src[64 + lane]; }
#pragma unroll
            for (int k = 0; k < 4; ++k) { u32x4* dst = (u32x4*)(XE + (size_t)(rowbase + s0 + k) * 1024); dst[lane] = v[k][0]; dst[64 + lane] = v[k][1]; }
        }
        __syncthreads();
    }
    cvt_moe_drain(F, l, 1);
}

constexpr int N_PHASES = 2 + 10 * NL;
#ifndef EN_MASK
#define EN_MASK 0xFFFFF
#endif
#define EN(k) ((EN_MASK >> (k)) & 1)
#define RUNPH(k, body) do { if (EN(k)) { body; if (REP(k)) { GBAR(); body; } } } while (0)
__global__ void __launch_bounds__(NTHREADS, 2) fwd_kernel(Args args) {
    extern __shared__ __attribute__((aligned(16))) unsigned char lds_raw[];
    cg::grid_group grid = cg::this_grid();
    Frame F;
    F.lds = (LAS unsigned char*)lds_raw;
    F.MISC = (volatile LAS unsigned*)(F.lds + MISC_OFF);
    F.wave = __builtin_amdgcn_readfirstlane(TID_ >> 6);
    F.G = gridDim.x; { const int bx = blockIdx.x; F.vcu = (F.G % 8 == 0) ? (bx % 8) * (F.G / 8) + bx / 8 : bx; }
    F.in = args.in; F.out = args.out; F.ws = args.ws; F.ctl = (unsigned*)(args.ws + WS_CTL);
    { int u0 = TID_; asm volatile("" : "+v"(u0)); for (int u = u0; u < (LDS_BYTES - RING_BYTES) / 4; u += NTHREADS) ((LAS unsigned*)(F.lds + RING_BYTES))[u] = 0u; }
    __syncthreads();
    const int lo = args.ph_lo, hi = args.ph_hi;
    XcdBarrier bar; bar.bar = F.ctl + CW_BAR; bar.x = 0; bar.st = nullptr;
    if (hi - lo > 1) bar = xcd_barrier_post(F.ctl + CW_BAR, F.MISC + 8);
    LAS unsigned char* ring = F.lds;

#ifndef TPROBE
#define TPROBE -1
#endif
#ifndef TP_X
#define TP_X 1000
#endif
    unsigned long long tp_start = 0; if (TPROBE >= 0 && blockIdx.x == 0 && TID_ == 0) tp_start = __builtin_amdgcn_s_memrealtime();
#define TPMARK(k) do { if (TPROBE == (k) && blockIdx.x == 0 && TID_ == 0) { const unsigned long long t1_ = __builtin_amdgcn_s_memrealtime(); __hip_atomic_store(F.ctl + 3000, ((float)(t1_ - tp_start) * 0.01f > (float)(TP_X)) ? 1u : 0u, __ATOMIC_RELAXED, __HIP_MEMORY_SCOPE_AGENT); } } while (0)
#define IN(k) (lo <= (k) && (k) < hi)
#define GBAR() xcd_barrier3(bar)
#define SEAM(k) do { if (IN(k) && IN((k) + 1)) { GBAR(); if (REP(21)) GBAR(); TPMARK(k); } } while (0)
#ifndef NOFILL
#define NOFILL 0
#endif
#define SEAMF(k, fl) do { if (NOFILL) { SEAM(k); } else if (IN(k) && IN((k) + 1)) { XCD_BARRIER_FILL(bar, F.MISC + 20, { \
        if (TID_ == 0) F.MISC[17] = atomicAdd(F.ctl + CW_CVTQ + 64 * (fl), 1u); __syncthreads(); const int mb_ = (int)F.MISC[17]; __syncthreads(); \
        if (mb_ < CVT_NMINI) { cvt_moe_mini(F, (fl), mb_); asm volatile("s_waitcnt vmcnt(0)" ::: "memory"); } else more_ = false; }); if (REP(21)) GBAR(); TPMARK(k); } } while (0)
    if (hi < 0) grid.sync();
    if (IN(0)) { RUNPH(10, phase_init(F)); }
    SEAMF(0, 0);
    if (IN(1)) { RUNPH(11, phase_row0(F)); }
    if (REP(16)) { for (int k_ = 0; k_ < 20; ++k_) xcd_barrier(bar); }
    if (REP(17)) { for (int k_ = 0; k_ < 20; ++k_) xcd_barrier3(bar); }
    if (REP(18)) { for (int k_ = 0; k_ < 20; ++k_) xcd_barrier2_probe<3>(bar); }
    if (REP(19)) { for (int k_ = 0; k_ < 20; ++k_) xcd_barrier2_probe<4>(bar); }
    SEAMF(1, 0);
#define LAYER(l) do { constexpr int base = 2 + 10 * (l); constexpr bool last = ((l) == NL - 1); \
    if (IN(base + 0)) { if (EN(0)) { \
        pg8::Gemm g{WSP(bf16, WS_H), WSP(bf16, WS_WIN) + (size_t)(l) * NINP * 1024, M, NINP, D}; \
        EpiInproj E{WSP(bf16, WS_QKV), WSP(bf16, WS_R32), WSP(bf16, WS_Z)}; \
        for (int rep_ = 0; rep_ < (REP(0) ? 2 : 1); ++rep_) { if (rep_) GBAR(); if (last) { InprojLastSched S{F.G, F.vcu}; run_gemm<EpiInproj, InprojLastSched>(ring, g, S, E); } else { TileSched S{M / 256, NINP / 256, F.G, F.vcu, false}; run_gemm<EpiInproj, TileSched>(ring, g, S, E); } } } } \
    SEAMF(base + 0, (l)); \
    if (IN(base + 1)) { if (EN(1)) { \
        pg8::Gemm g{WSP(bf16, WS_Z), WSP(bf16, WS_LORA) + (size_t)(l) * 1280 * 384, M, 1280, 384}; \
        TileSched S{M / 256, 5, F.G, F.vcu, false}; \
        EpiLora E{WSP(bf16, WS_DEC), WSP(bf16, WS_ASIG), WSP(bf16, WS_G), F.in[I_W0] + (l) * 512, F.in[I_A0] + (l) * 512}; \
        { int nrep_ = REP(1) ? 2 : 1; asm volatile("" : "+s"(nrep_)); _Pragma("unroll 1") for (int rep_ = 0; rep_ < nrep_; ++rep_) { if (rep_) GBAR(); run_gemm<EpiLora, TileSched>(ring, g, S, E); } } } \
        if (EN(12)) { phase_qkprep(F, (l)); if (REP(12)) { GBAR(); phase_qkprep(F, (l), true); } } } \
    SEAMF(base + 1, (l)); \
    if (IN(base + 2)) { if (EN(2)) { if (CHUNK_SCAN) { phase_prepass(F, (l)); if (IN(base + 2)) SEAMF(base + 2 - 1, (l)); if (REP(14)) { phase_prepass(F, (l)); GBAR(); } } phase_mixer(F, (l)); if (REP(2)) { GBAR(); phase_mixer(F, (l), 1); } if (REP(15)) { GBAR(); phase_mixer(F, (l), 2); } } } \
    SEAMF(base + 2, (l)); \
    if (IN(base + 4)) { if (EN(4)) { \
        pg8::Gemm g{WSP(bf16, WS_O), WSP(bf16, WS_WOUT) + (size_t)(l) * 1024 * 1024, M, D, D}; \
        TileSched S{last ? 64 : 72, 4, F.G, F.vcu, last}; \
        EpiOut E{WSP(bf16, WS_Y)}; \
        for (int rep_ = 0; rep_ < (REP(4) ? 2 : 1); ++rep_) { if (rep_) GBAR(); run_gemm<EpiOut, TileSched>(ring, g, S, E); } } } \
    SEAMF(base + 4, (l)); \
    if (IN(base + 5)) { if (EN(5)) { phase_row1(F, (l)); if (REP(5)) { GBAR(); phase_row1(F, (l), 1); } if (REP(22)) { GBAR(); phase_row1(F, (l), 2); } if (REP(23)) { GBAR(); phase_row1(F, (l), 3); } } } \
    SEAMF(base + 5, (l)); \
    if (IN(base + 6)) { RUNPH(6, phase_topk(F, (l))); } \
    SEAM(base + 6); \
    if (IN(base + 7)) { if (EN(7)) { \
        pg8::Gemm g{WSP(bf16, WS_XE), WSP(bf16, WS_WGU), NE * MEXP, NE * 2048, D}; \
        MoeSched S{last ? 8 : 9, 8, F.G, F.vcu}; \
        EpiMoe1 E{WSP(bf16, WS_HID)}; \
        for (int rep_ = 0; rep_ < (REP(7) ? 2 : 1); ++rep_) { if (rep_) GBAR(); run_gemm<EpiMoe1, MoeSched>(ring, g, S, E); } } } \
    SEAM(base + 7); \
    if (IN(base + 8)) { if (EN(8)) { \
        pg8::Gemm g{WSP(bf16, WS_HID), WSP(bf16, WS_WD), NE * MEXP, NE * 1024, D}; \
        MoeSched S{last ? 8 : 9, 4, F.G, F.vcu}; \
        EpiMoe2 E{WSP(bf16, WS_OUTE), WSP(float, WS_SELG)}; \
        for (int rep_ = 0; rep_ < (REP(8) ? 2 : 1); ++rep_) { if (rep_) GBAR(); run_gemm<EpiMoe2, MoeSched>(ring, g, S, E); } } } \
    SEAM(base + 8); \
    if (IN(base + 9)) { if (EN(9)) { phase_row2(F, (l)); if (REP(9)) { GBAR(); phase_row2(F, (l), true); } } } \
    if ((l) + 1 < NL) SEAMF(base + 9, (l) + 1); else SEAM(base + 9); \
  } while (0)
    LAYER(0);
    LAYER(1);
#undef LAYER
#undef SEAM
#undef IN
}

extern "C" void kernel_launch(void* const* d_in, const int* in_sizes, int n_in, void* d_out, int out_size, void* d_ws, size_t ws_size, hipStream_t stream) {
    static int grid = 0;
    if (grid == 0) {
        if (n_in != 29 || out_size != NB * SEQ * D || ws_size < WS_END) { fprintf(stderr, "kernel_launch: unexpected sizes n_in %d out %d ws %zu\n", n_in, out_size, ws_size); grid = -1; return; }
        int dev = 0, cus = 0, per_cu = 0;
        if (hipGetDevice(&dev) != hipSuccess || hipDeviceGetAttribute(&cus, hipDeviceAttributeMultiprocessorCount, dev) != hipSuccess) { grid = -1; return; }
        if (hipFuncSetAttribute((const void*)fwd_kernel, hipFuncAttributeMaxDynamicSharedMemorySize, LDS_BYTES) != hipSuccess) { fprintf(stderr, "kernel_launch: hipFuncSetAttribute failed\n"); grid = -1; return; }
        if (hipOccupancyMaxActiveBlocksPerMultiprocessor(&per_cu, (const void*)fwd_kernel, NTHREADS, LDS_BYTES) != hipSuccess || per_cu < 1) { fprintf(stderr, "kernel_launch: occupancy query says %d\n", per_cu); per_cu = 1; }
        (void)hipGetLastError();
        grid = cus;
        fprintf(stderr, "kernel_launch: grid %d, per_cu %d, ws %zu\n", grid, per_cu, ws_size);
    }
    if (grid < 0) return;
    if (hipMemsetAsync((char*)d_ws + WS_CTL, 0, CTL_ZERO_BYTES, stream) != hipSuccess) return;
    Args a{};
    for (int i = 0; i < 29; ++i) a.in[i] = (const float*)d_in[i];
    a.out = (float*)d_out; a.ws = (unsigned char*)d_ws;
#if N_LAUNCH_MODE
    a.ph_lo = 0; a.ph_hi = N_PHASES;
    { void* kargs[] = {&a};
      hipError_t e = hipLaunchCooperativeKernel((const void*)fwd_kernel, dim3(grid), dim3(NTHREADS), kargs, LDS_BYTES, stream);
      if (e != hipSuccess) fprintf(stderr, "kernel_launch: cooperative launch failed: %s\n", hipGetErrorString(e)); }
#else
    for (int ph = 0; ph < N_PHASES; ++ph) {
        a.ph_lo = ph; a.ph_hi = ph + 1;
        void* kargs[] = {&a};
        hipError_t e = hipLaunchCooperativeKernel((const void*)fwd_kernel, dim3(grid), dim3(NTHREADS), kargs, LDS_BYTES, stream);
        if (e != hipSuccess) { fprintf(stderr, "kernel_launch: launch %d failed: %s\n", ph, hipGetErrorString(e)); break; }
    }
#endif
}
```

```cpp
#define GOLD_GEMM 0
#define N_LAUNCH_MODE 1
#define GOLD_ATTN 0
#define REP_MASK 0
#define CHUNK_SCAN 1
#define NOFILL 0
#include <hip/hip_runtime.h>
#include <hip/hip_cooperative_groups.h>
#include <cstdio>
#include <cstdint>
namespace cg = cooperative_groups;

#ifndef GOLD_GEMM
#define GOLD_GEMM 0
#endif
#ifndef GOLD_ATTN
#define GOLD_ATTN 1
#endif
#ifndef N_LAUNCH_MODE
#define N_LAUNCH_MODE 1
#endif

#ifndef REP_MASK
#define REP_MASK 0
#endif
#define REP(k) ((REP_MASK >> (k)) & 1)
#define LAS __attribute__((address_space(3)))
typedef unsigned short bf16;
typedef float f32x4 __attribute__((ext_vector_type(4)));
typedef unsigned u32x4 __attribute__((ext_vector_type(4)));
typedef unsigned u32x2 __attribute__((ext_vector_type(2)));
typedef short bf16x8 __attribute__((ext_vector_type(8)));

constexpr int D = 1024, NB = 8, SEQ = 2048, CTXL = 256, T = SEQ + CTXL, M = NB * T, NL = 2;
constexpr int NINP = 2816;
constexpr int NE = 16, MEXP = 2304;
constexpr float LOG2E = 1.4426950408889634f;
constexpr float C2 = 0.125f * LOG2E;
constexpr int NTHREADS = 512, NWAVES = 8;
constexpr int LDS_BYTES = 147456, RING_BYTES = 131072, MISC_OFF = RING_BYTES + 320;

constexpr size_t MiB = 1u << 20;
constexpr size_t WS_CTL = 0, CTL_ZERO_BYTES = 1 * MiB;
constexpr size_t WS_MOD = 1 * MiB;
constexpr size_t WS_WIN = 2 * MiB;
constexpr size_t WS_WOUT = 13 * MiB;
constexpr size_t WS_LORA = 17 * MiB;
constexpr size_t WS_WGU = 19 * MiB;
constexpr size_t WS_WD = 83 * MiB;
constexpr size_t WS_X = 115 * MiB;
constexpr size_t R0 = 187 * MiB;
constexpr size_t WS_YD = R0 + 0 * MiB;
constexpr size_t WS_H = R0 + 36 * MiB;
constexpr size_t WS_QKV = R0 + 72 * MiB;
constexpr size_t WS_R32 = R0 + 126 * MiB;
constexpr size_t WS_Z = R0 + 180 * MiB;
constexpr size_t WS_DEC = R0 + 194 * MiB;
constexpr size_t WS_ASIG = R0 + 230 * MiB;
constexpr size_t WS_G = R0 + 266 * MiB;
constexpr size_t WS_O = R0 + 284 * MiB;
constexpr size_t WS_END = R0 + 320 * MiB;
constexpr size_t WS_Y = WS_QKV;
constexpr size_t WS_OUTE = WS_QKV;
constexpr size_t WS_H2 = WS_DEC;
constexpr size_t WS_AFF = WS_Z;
constexpr size_t WS_INV = WS_Z + 2 * MiB;
constexpr size_t WS_SELG = WS_Z + 4 * MiB;
constexpr size_t WS_SELT = WS_Z + 5 * MiB;
constexpr size_t WS_XE = WS_ASIG;
constexpr size_t WS_HID = WS_YD;
static_assert(WS_END <= 512 * MiB, "ws map");
constexpr int CW_BAR = 4096;
constexpr int CW_QUEUE = 16384;

__device__ __forceinline__ unsigned f2bf(float f) { unsigned u = __builtin_bit_cast(unsigned, f); return (u + 0x7fffu + ((u >> 16) & 1u)) >> 16; }
__device__ __forceinline__ unsigned pk2(float lo, float hi) { return f2bf(lo) | (f2bf(hi) << 16); }
__device__ __forceinline__ float bf2f(unsigned h) { return __builtin_bit_cast(float, h << 16); }
__device__ __forceinline__ float bflo(unsigned w) { return __builtin_bit_cast(float, w << 16); }
__device__ __forceinline__ float bfhi(unsigned w) { return __builtin_bit_cast(float, w & 0xffff0000u); }
template <int CTRL> __device__ __forceinline__ float dppf(float x) { return __builtin_bit_cast(float, __builtin_amdgcn_update_dpp(0, __builtin_bit_cast(int, x), CTRL, 0xF, 0xF, true)); }
__device__ __forceinline__ float red8(float x) { x += dppf<0xB1>(x); x += dppf<0x4E>(x); x += dppf<0x141>(x); return x; }
__device__ __forceinline__ float wave_sum(float v) {
    v = red8(v); v += dppf<0x140>(v);
    const float a0 = __builtin_bit_cast(float, __builtin_amdgcn_readlane(__builtin_bit_cast(int, v), 0));
    const float a1 = __builtin_bit_cast(float, __builtin_amdgcn_readlane(__builtin_bit_cast(int, v), 16));
    const float a2 = __builtin_bit_cast(float, __builtin_amdgcn_readlane(__builtin_bit_cast(int, v), 32));
    const float a3 = __builtin_bit_cast(float, __builtin_amdgcn_readlane(__builtin_bit_cast(int, v), 48));
    return (a0 + a1) + (a2 + a3);
}
__device__ __forceinline__ float wave_max(float v) {
    v = fmaxf(v, dppf<0xB1>(v)); v = fmaxf(v, dppf<0x4E>(v)); v = fmaxf(v, dppf<0x141>(v)); v = fmaxf(v, dppf<0x140>(v));
    const float a0 = __builtin_bit_cast(float, __builtin_amdgcn_readlane(__builtin_bit_cast(int, v), 0));
    const float a1 = __builtin_bit_cast(float, __builtin_amdgcn_readlane(__builtin_bit_cast(int, v), 16));
    const float a2 = __builtin_bit_cast(float, __builtin_amdgcn_readlane(__builtin_bit_cast(int, v), 32));
    const float a3 = __builtin_bit_cast(float, __builtin_amdgcn_readlane(__builtin_bit_cast(int, v), 48));
    return fmaxf(fmaxf(a0, a1), fmaxf(a2, a3));
}
__device__ __forceinline__ float sigmoidf_(float x) { return __builtin_amdgcn_rcpf(1.f + __expf(-x)); }
#define LDS_WAIT() asm volatile("s_waitcnt lgkmcnt(0)" ::: "memory")

#define XB_TMO      128
#define XB_XCNT(j)  (256  + 64 * (j))
#define XB_XSUB(j)  (1280 + 64 * (j))
#define XB_XGEN(j)  (2304 + 64 * (j))
#define XB_TOP      3328
#define XB_TOPGEN   3392
#define XCD_BAR_WORDS 3456
#define XB_SPIN_CAP (1u << 22)
__device__ __forceinline__ unsigned xb_ld(unsigned* p)              { return __hip_atomic_load(p, __ATOMIC_RELAXED, __HIP_MEMORY_SCOPE_AGENT); }
__device__ __forceinline__ unsigned xb_add(unsigned* p, unsigned v) { return __hip_atomic_fetch_add(p, v, __ATOMIC_RELAXED, __HIP_MEMORY_SCOPE_AGENT); }
__device__ __forceinline__ unsigned xb_xcc_id() { return (unsigned)__builtin_amdgcn_s_getreg((3 << 11) | 20) & 0xFu; }
#define XB_SPIN(cond, bar) do { unsigned _sp = 0; while (cond) { __builtin_amdgcn_s_sleep(1); \
    if ((++_sp & 255u) == 0u) { if (xb_ld(&(bar)[XB_TMO])) break; if (_sp > XB_SPIN_CAP) { atomicAdd(&(bar)[XB_TMO], 1u); break; } } } } while (0)
struct XcdBarrier { unsigned* bar; unsigned x; volatile LAS unsigned* st; };
__device__ __forceinline__ XcdBarrier xcd_barrier_post(unsigned* bar, volatile LAS unsigned* st) {
    XcdBarrier b; b.bar = bar; b.x = xb_xcc_id(); b.st = st;
    if (threadIdx.x == 0) (void)xb_add(&bar[XB_XCNT(b.x)], 1u);
    return b;
}
__device__ __forceinline__ void xcd_barrier_complete(unsigned* bar, unsigned x, unsigned& nloc, unsigned& nx) {
    const unsigned G = gridDim.x * gridDim.y * gridDim.z;
    unsigned sum, cnt, mine, sp = 0u;
    for (;;) {
        sum = 0u; cnt = 0u; mine = 0u;
#pragma unroll
        for (unsigned j = 0; j < 16; ++j) { const unsigned c = xb_ld(&bar[XB_XCNT(j)]); sum += c; cnt += (c > 0u) ? 1u : 0u; mine = (j == x) ? c : mine; }
        if (sum == G) break;
        __builtin_amdgcn_s_sleep(1);
        if ((++sp & 255u) == 0u) { if (xb_ld(&bar[XB_TMO])) break; if (sp > XB_SPIN_CAP) { atomicAdd(&bar[XB_TMO], 1u); break; } }
    }
    nloc = mine > 0u ? mine : 1u; nx = cnt > 0u ? cnt : 1u;
}
__device__ __forceinline__ void xcd_barrier(const XcdBarrier& b) {
    asm volatile("s_waitcnt vmcnt(0)" ::: "memory");
    __syncthreads();
    if (threadIdx.x == 0) {
        unsigned* bar = b.bar;
        __builtin_amdgcn_s_waitcnt(0);
        unsigned nloc = b.st[0], nx = b.st[1];
        if (nloc == 0u) { xcd_barrier_complete(bar, b.x, nloc, nx); b.st[0] = nloc; b.st[1] = nx; }
        const unsigned old = xb_add(&bar[XB_XSUB(b.x)], 1u);
        const unsigned gen = old / nloc;
        if (old + 1u == (gen + 1u) * nloc) {
            __builtin_amdgcn_fence(__ATOMIC_RELEASE, "agent");
            asm volatile("s_waitcnt vmcnt(0)" ::: "memory");
            const unsigned og = xb_add(&bar[XB_TOP], 1u);
            const unsigned tg = og / nx;
            if (og + 1u == (tg + 1u) * nx) xb_add(&bar[XB_TOPGEN], 1u);
            else XB_SPIN(xb_ld(&bar[XB_TOPGEN]) == tg, bar);
            __builtin_amdgcn_fence(__ATOMIC_ACQUIRE, "agent");
            xb_add(&bar[XB_XGEN(b.x)], 1u);
            asm volatile("s_waitcnt vmcnt(0)" ::: "memory");
        } else {
            XB_SPIN(xb_ld(&bar[XB_XGEN(b.x)]) == gen, bar);
            __builtin_amdgcn_fence(__ATOMIC_ACQUIRE, "agent");
            asm volatile("s_waitcnt vmcnt(0)" ::: "memory");
        }
    }
    __syncthreads();
}

__device__ __forceinline__ void flat_barrier(unsigned* cnt) {
    asm volatile("s_waitcnt vmcnt(0)" ::: "memory");
    __syncthreads();
    if (threadIdx.x == 0) {
        const unsigned G = gridDim.x;
        __builtin_amdgcn_fence(__ATOMIC_RELEASE, "agent");
        asm volatile("s_waitcnt vmcnt(0)" ::: "memory");
        const unsigned old = xb_add(cnt, 1u);
        const unsigned target = (old / G + 1u) * G;
        unsigned sp = 0;
        while (xb_ld(cnt) < target) { __builtin_amdgcn_s_sleep(1); if (++sp > (1u << 22)) break; }
        __builtin_amdgcn_fence(__ATOMIC_ACQUIRE, "agent");
        asm volatile("s_waitcnt vmcnt(0)" ::: "memory");
    }
    __syncthreads();
}

__device__ __forceinline__ void xcd_barrier2(const XcdBarrier& b) {
    asm volatile("s_waitcnt vmcnt(0)" ::: "memory");
    __syncthreads();
    if (threadIdx.x == 0) {
        unsigned* bar = b.bar;
        __builtin_amdgcn_s_waitcnt(0);
        unsigned nloc = b.st[0], nx = b.st[1];
        if (nloc == 0u) { xcd_barrier_complete(bar, b.x, nloc, nx); b.st[0] = nloc; b.st[1] = nx; }
        const unsigned old = xb_add(&bar[XB_XSUB(b.x)], 1u);
        const unsigned gen = old / nloc;
        if (old + 1u == (gen + 1u) * nloc) {
            __builtin_amdgcn_fence(__ATOMIC_RELEASE, "agent");
            asm volatile("s_waitcnt vmcnt(0)" ::: "memory");
            (void)xb_add(&bar[XB_TOP], 1u);
        }
        const unsigned target = (gen + 1u) * nx;
        XB_SPIN(xb_ld(&bar[XB_TOP]) < target, bar);
        __builtin_amdgcn_fence(__ATOMIC_ACQUIRE, "agent");
        asm volatile("s_waitcnt vmcnt(0)" ::: "memory");
    }
    __syncthreads();
}

template <int MODE> __device__ __forceinline__ void xcd_barrier2_probe(const XcdBarrier& b) {
    asm volatile("s_waitcnt vmcnt(0)" ::: "memory");
    __syncthreads();
    if (threadIdx.x == 0) {
        unsigned* bar = b.bar;
        unsigned nloc = b.st[0], nx = b.st[1];
        const unsigned old = xb_add(&bar[XB_XSUB(b.x)], 1u);
        const unsigned gen = old / nloc;
        if (old + 1u == (gen + 1u) * nloc) {
            if (!(MODE & 2)) { __builtin_amdgcn_fence(__ATOMIC_RELEASE, "agent"); asm volatile("s_waitcnt vmcnt(0)" ::: "memory"); }
            (void)xb_add(&bar[XB_TOP], 1u);
        }
        const unsigned target = (gen + 1u) * nx;
        XB_SPIN(xb_ld(&bar[XB_TOP]) < target, bar);
        if (!(MODE & 1) && (!(MODE & 4) || (old + 1u == (gen + 1u) * nloc))) { __builtin_amdgcn_fence(__ATOMIC_ACQUIRE, "agent"); asm volatile("s_waitcnt vmcnt(0)" ::: "memory"); }
    }
    __syncthreads();
}

__device__ __forceinline__ void xcd_barrier3(const XcdBarrier& b) {
    asm volatile("s_waitcnt vmcnt(0)" ::: "memory");
    __syncthreads();
    if (threadIdx.x == 0) {
        unsigned* bar = b.bar;
        __builtin_amdgcn_s_waitcnt(0);
        unsigned nloc = b.st[0], nx = b.st[1];
        if (nloc == 0u) { xcd_barrier_complete(bar, b.x, nloc, nx); b.st[0] = nloc; b.st[1] = nx; }
        const unsigned old = xb_add(&bar[XB_XSUB(b.x)], 1u);
        const unsigned gen = old / nloc;
        if (old + 1u == (gen + 1u) * nloc) {
            __builtin_amdgcn_fence(__ATOMIC_RELEASE, "agent");
            asm volatile("s_waitcnt vmcnt(0)" ::: "memory");
            (void)xb_add(&bar[XB_TOP], 1u);
            const unsigned target = (gen + 1u) * nx;
            XB_SPIN(xb_ld(&bar[XB_TOP]) < target, bar);
            __builtin_amdgcn_fence(__ATOMIC_ACQUIRE, "agent");
            asm volatile("s_waitcnt vmcnt(0)" ::: "memory");
            xb_add(&bar[XB_XGEN(b.x)], 1u);
        } else {
            __builtin_amdgcn_fence(__ATOMIC_ACQUIRE, "agent");
            asm volatile("s_waitcnt vmcnt(0)" ::: "memory");
            XB_SPIN(xb_ld(&bar[XB_XGEN(b.x)]) == gen, bar);
        }
    }
    __syncthreads();
}

#define XCD_BARRIER_FILL(b, MISCW, FILL_STMT) do { \
    asm volatile("s_waitcnt vmcnt(0)" ::: "memory"); \
    __syncthreads(); \
    if (threadIdx.x == 0) { \
        unsigned* bar_ = (b).bar; __builtin_amdgcn_s_waitcnt(0); \
        unsigned nloc_ = (b).st[0], nx_ = (b).st[1]; \
        if (nloc_ == 0u) { xcd_barrier_complete(bar_, (b).x, nloc_, nx_); (b).st[0] = nloc_; (b).st[1] = nx_; } \
        const unsigned old_ = xb_add(&bar_[XB_XSUB((b).x)], 1u); const unsigned gen_ = old_ / nloc_; \
        if (old_ + 1u == (gen_ + 1u) * nloc_) { \
            __builtin_amdgcn_fence(__ATOMIC_RELEASE, "agent"); asm volatile("s_waitcnt vmcnt(0)" ::: "memory"); \
            (void)xb_add(&bar_[XB_TOP], 1u); const unsigned target_ = (gen_ + 1u) * nx_; \
            XB_SPIN(xb_ld(&bar_[XB_TOP]) < target_, bar_); \
            __builtin_amdgcn_fence(__ATOMIC_ACQUIRE, "agent"); asm volatile("s_waitcnt vmcnt(0)" ::: "memory"); \
            xb_add(&bar_[XB_XGEN((b).x)], 1u); \
            (MISCW)[0] = 0xffffffffu; \
        } else { \
            __builtin_amdgcn_fence(__ATOMIC_ACQUIRE, "agent"); asm volatile("s_waitcnt vmcnt(0)" ::: "memory"); \
            (MISCW)[0] = gen_; \
        } \
    } \
    __syncthreads(); \
    { const unsigned g_ = (MISCW)[0]; \
      if (g_ != 0xffffffffu) { bool more_ = true; \
        for (;;) { \
            if (threadIdx.x == 0) (MISCW)[1] = (xb_ld(&(b).bar[XB_XGEN((b).x)]) != g_) ? 1u : 0u; \
            __syncthreads(); \
            const bool rel_ = (MISCW)[1] != 0u; \
            __syncthreads(); \
            if (rel_) break; \
            if (more_) { FILL_STMT; } else __builtin_amdgcn_s_sleep(4); \
        } } } \
    __syncthreads(); \
  } while (0)
namespace pg8 {
#define PG8_LAS __attribute__((address_space(3)))
typedef unsigned short bf16_t;
typedef short bf16x8 __attribute__((ext_vector_type(8)));
typedef float f32x4 __attribute__((ext_vector_type(4)));
typedef unsigned u32x4 __attribute__((ext_vector_type(4)));
constexpr int BM = 256, BK = 64, HALF = 128, HTB = HALF * BK * 2  , STAGE_BYTES = 8 * HTB, NXCD = 8, WGM = 8;

__host__ __device__ __forceinline__ int lds_byte(int r, int c) { const int st = (r >> 4) * 2 + (c >> 5), rr = r & 15, cc = c & 31, ob = rr * 64 + cc * 2; return st * 1024 + (ob ^ (((ob >> 9) & 1) << 5)); }
__host__ __device__ __forceinline__ void stage_rc(int b, int& R, int& C) { const int st = b / 1024, sb = b % 1024, swz = sb ^ (((sb >> 9) & 1) << 5); R = (st >> 1) * 16 + swz / 64; C = (st & 1) * 32 + (swz % 64) / 2; }
__host__ __device__ __forceinline__ int perm32(int rho) { const int n = rho >> 4, i = rho & 15; return 8 * (i >> 2) + 4 * n + (i & 3); }

struct Unit { int pm, pn; };
struct Gemm { const bf16_t* A; const bf16_t* Bt; int M, N, K; };

struct StaticOrder {
    int nM, nN, nwg, G, c;
    __host__ __device__ void init(int M, int N, int G_, int c_) { nM = M / BM; nN = N / BM; nwg = nM * nN; G = G_; c = c_; }
    __host__ __device__ bool next(int i, Unit& u) const {
        const long L = (long)i * G + c; if (L >= nwg) return false;
        int wgid = (int)L; { const int q = nwg / NXCD, r = nwg % NXCD, xcd = wgid % NXCD, off = wgid / NXCD; wgid = (xcd < r ? xcd * (q + 1) : r * (q + 1) + (xcd - r) * q) + off; }
        const int nig = WGM * nN, gid = wgid / nig, fm = gid * WGM, gsz = (nM - fm) < WGM ? (nM - fm) : WGM;
        u.pm = fm + ((wgid % nig) % gsz); u.pn = (wgid % nig) / gsz; return true;
    }
    __device__ __forceinline__ void a_ready(const Unit&) const {}
    __device__ __forceinline__ void done(const Unit&) const {}
};
__device__ __forceinline__ unsigned cvt_pk_bf16(float lo, float hi) { unsigned r; asm volatile("v_cvt_pk_bf16_f32 %0, %1, %2" : "=v"(r) : "v"(lo), "v"(hi)); return r; }
typedef float f32x2 __attribute__((ext_vector_type(2)));
template <class Epi, class Sched, bool ALIGN_EPI = false, bool SP2 = false>
__device__ __forceinline__ void gemm_phase(PG8_LAS unsigned char* lds, const Gemm g, const Sched& S, const Epi& E) {
    const int tid = threadIdx.x, wid = __builtin_amdgcn_readfirstlane(tid >> 6), lane = tid & 63, wr = wid >> 2, wc = wid & 3, fr = lane & 15, fq = lane >> 4;
    const int K = g.K, nt = K / BK;
    unsigned voffA[2], voffB[2];
#pragma unroll
    for (int i = 0; i < 2; ++i) { int R, C; stage_rc(tid * 16 + i * 8192, R, C); const int Rb = Epi::PERM ? ((R & ~31) + perm32(R & 31)) : R;
        voffA[i] = (unsigned)(R * K + C) * 2u; voffB[i] = (unsigned)(Rb * K + C) * 2u; }
    const size_t kstep = (size_t)(BK * 2);
    const size_t hstep = (size_t)HALF * K * 2;
    const size_t tstep = 2 * hstep;
    const unsigned ldsw = (unsigned)wid * 1024u;
    const int aoff = lds_byte(wr * 64 + fr, fq * 8), boff = lds_byte(wc * 32 + fr, fq * 8);
#define PG8_SA(b, h) (((b) * 2 + (h)) * HTB)
#define PG8_SB(b, h) ((4 + (b) * 2 + (h)) * HTB)
#define PG8_STAGE(bufoff, gbase, voff) do { _Pragma("unroll") for (int _i = 0; _i < 2; ++_i) \
        __builtin_amdgcn_global_load_lds((const unsigned*)((const char*)(gbase) + (voff)[_i]), (PG8_LAS unsigned*)(lds + (bufoff) + ldsw + _i * 8192), 16, 0, 0); } while (0)
#define PG8_LDA(dst, b, h) do { _Pragma("unroll") for (int m = 0; m < 4; ++m) _Pragma("unroll") for (int k = 0; k < 2; ++k) dst[m][k] = *(const PG8_LAS bf16x8*)(lds + PG8_SA(b, h) + aoff + m * 2048 + k * 1024); } while (0)
#define PG8_LDB(dst, b, h) do { _Pragma("unroll") for (int n = 0; n < 2; ++n) _Pragma("unroll") for (int k = 0; k < 2; ++k) dst[n][k] = *(const PG8_LAS bf16x8*)(lds + PG8_SB(b, h) + boff + n * 2048 + k * 1024); } while (0)
#define PG8_MMA(ai, bj, At, Bt) do { __builtin_amdgcn_s_setprio(1); _Pragma("unroll") for (int m = 0; m < 4; ++m) _Pragma("unroll") for (int n = 0; n < 2; ++n) _Pragma("unroll") for (int k = 0; k < 2; ++k) \
        acc[ai][bj][m][n] = __builtin_amdgcn_mfma_f32_16x16x32_bf16(Bt[n][k], At[m][k], acc[ai][bj][m][n], 0, 0, 0); __builtin_amdgcn_s_setprio(0); } while (0)
#define PG8_WAIT_V(n) asm volatile("s_waitcnt vmcnt(" #n ")" ::: "memory")
#define PG8_WAIT_L(n) asm volatile("s_waitcnt lgkmcnt(" #n ")" ::: "memory")
#define PG8_BAR __builtin_amdgcn_s_barrier()
#define PG8_SCHED __builtin_amdgcn_sched_barrier(0)
    Unit cur, nxt; int ui = 0;
    if (!S.next(0, cur)) return;
    f32x4 acc[2][2][4][2];
#pragma unroll
    for (int a = 0; a < 2; ++a)
#pragma unroll
        for (int b = 0; b < 2; ++b)
#pragma unroll
            for (int m = 0; m < 4; ++m)
#pragma unroll
                for (int n = 0; n < 2; ++n) acc[a][b][m][n] = (f32x4){0.f, 0.f, 0.f, 0.f};
    bf16x8 At[4][2], B0[2][2], B1[2][2];
    const char* cA = (const char*)g.A + (size_t)cur.pm * tstep; const char* cB = (const char*)g.Bt + (size_t)cur.pn * tstep;
    S.a_ready(cur);
    if constexpr (SP2) {
        PG8_STAGE(PG8_SB(0, 0), cB, voffB); PG8_STAGE(PG8_SB(0, 1), cB + hstep, voffB); PG8_STAGE(PG8_SA(0, 0), cA, voffA); PG8_STAGE(PG8_SA(0, 1), cA + hstep, voffA);
        if (wr == 1) PG8_BAR;
        PG8_WAIT_V(2); PG8_BAR;
        PG8_STAGE(PG8_SB(1, 0), cB + kstep, voffB); PG8_STAGE(PG8_SA(1, 0), cA + kstep, voffA); PG8_STAGE(PG8_SB(1, 1), cB + hstep + kstep, voffB);
        PG8_WAIT_V(6); PG8_BAR;
    } else {
        PG8_STAGE(PG8_SB(0, 0), cB, voffB); PG8_STAGE(PG8_SA(0, 0), cA, voffA); PG8_STAGE(PG8_SB(0, 1), cB + hstep, voffB); PG8_STAGE(PG8_SA(0, 1), cA + hstep, voffA);
        if (wr == 1) PG8_BAR;
        PG8_WAIT_V(4); PG8_BAR;
        PG8_STAGE(PG8_SB(1, 0), cB + kstep, voffB); PG8_STAGE(PG8_SA(1, 0), cA + kstep, voffA); PG8_STAGE(PG8_SB(1, 1), cB + hstep + kstep, voffB);
        PG8_WAIT_V(6); PG8_BAR;
    }
    for (;;) {
        const bool has_next = S.next(ui + 1, nxt);
        const char* nA = has_next ? (const char*)g.A + (size_t)nxt.pm * tstep : cA; const char* nB = has_next ? (const char*)g.Bt + (size_t)nxt.pn * tstep : cB;
        for (int t = 0; t < nt; t += 2) {
            const bool last = (t == nt - 2);
            const char* a1 = cA + (size_t)(t + 1) * kstep;
            const char* a2 = last ? nA : cA + (size_t)(t + 2) * kstep; const char* b2 = last ? nB : cB + (size_t)(t + 2) * kstep;
            const char* a3 = a2 + kstep; const char* b3 = b2 + kstep;
            if (last && has_next) S.a_ready(nxt);
            if constexpr (SP2) {
            PG8_LDB(B0, 0, 0); PG8_LDB(B1, 0, 1); PG8_SCHED; PG8_LDA(At, 0, 0); PG8_STAGE(PG8_SA(1, 1), a1 + hstep, voffA);
            PG8_WAIT_V(8); PG8_WAIT_L(0); PG8_BAR; PG8_MMA(0, 0, At, B0); PG8_MMA(0, 1, At, B1); PG8_BAR; PG8_SCHED;
            PG8_LDA(At, 0, 1); PG8_STAGE(PG8_SB(0, 0), b2, voffB); PG8_STAGE(PG8_SB(0, 1), b2 + hstep, voffB); PG8_STAGE(PG8_SA(0, 0), a2, voffA);
            PG8_WAIT_V(8); PG8_WAIT_L(0); PG8_BAR; PG8_MMA(1, 0, At, B0); PG8_MMA(1, 1, At, B1); PG8_BAR; PG8_SCHED;
            PG8_LDB(B0, 1, 0); PG8_LDB(B1, 1, 1); PG8_SCHED; PG8_LDA(At, 1, 0); PG8_STAGE(PG8_SA(0, 1), a2 + hstep, voffA);
            PG8_WAIT_V(8); PG8_WAIT_L(0); PG8_BAR; PG8_MMA(0, 0, At, B0); PG8_MMA(0, 1, At, B1); PG8_BAR; PG8_SCHED;
            PG8_LDA(At, 1, 1); PG8_STAGE(PG8_SB(1, 0), b3, voffB); PG8_STAGE(PG8_SB(1, 1), b3 + hstep, voffB); PG8_STAGE(PG8_SA(1, 0), a3, voffA);
            PG8_WAIT_V(8); PG8_WAIT_L(0); PG8_BAR; PG8_MMA(1, 0, At, B0); PG8_MMA(1, 1, At, B1); PG8_BAR; PG8_SCHED;
            } else {
            PG8_LDB(B0, 0, 0); PG8_SCHED; PG8_LDA(At, 0, 0); PG8_STAGE(PG8_SA(1, 1), a1 + hstep, voffA);
            PG8_WAIT_L(8); PG8_BAR; PG8_WAIT_L(0); PG8_MMA(0, 0, At, B0); PG8_BAR; PG8_SCHED;
            PG8_LDB(B1, 0, 1); PG8_STAGE(PG8_SB(0, 0), b2, voffB);
            PG8_BAR; PG8_WAIT_L(0); PG8_MMA(0, 1, At, B1); PG8_BAR;
            PG8_LDA(At, 0, 1); PG8_STAGE(PG8_SA(0, 0), a2, voffA);
            PG8_BAR; PG8_WAIT_L(0); PG8_MMA(1, 0, At, B0); PG8_BAR; PG8_SCHED;
            PG8_STAGE(PG8_SB(0, 1), b2 + hstep, voffB);
            PG8_WAIT_V(6); PG8_BAR; PG8_MMA(1, 1, At, B1); PG8_BAR;
            PG8_LDB(B0, 1, 0); PG8_SCHED; PG8_LDA(At, 1, 0); PG8_STAGE(PG8_SA(0, 1), a2 + hstep, voffA);
            PG8_WAIT_L(8); PG8_BAR; PG8_WAIT_L(0); PG8_MMA(0, 0, At, B0); PG8_BAR; PG8_SCHED;
            PG8_LDB(B1, 1, 1); PG8_STAGE(PG8_SB(1, 0), b3, voffB);
            PG8_BAR; PG8_WAIT_L(0); PG8_MMA(0, 1, At, B1); PG8_BAR;
            PG8_LDA(At, 1, 1); PG8_STAGE(PG8_SA(1, 0), a3, voffA);
            PG8_BAR; PG8_WAIT_L(0); PG8_MMA(1, 0, At, B0); PG8_BAR; PG8_SCHED;
            PG8_STAGE(PG8_SB(1, 1), b3 + hstep, voffB);
            PG8_WAIT_V(6); PG8_BAR; PG8_MMA(1, 1, At, B1); PG8_BAR;
            }
        }
        if constexpr (ALIGN_EPI) { if (wr == 0) PG8_BAR; }
        if constexpr (!Epi::AFTER_DRAIN) { E(acc, cur, wr, wc, fr, fq); S.done(cur); }
        if (!has_next) break;
#pragma unroll
        for (int a = 0; a < 2; ++a)
#pragma unroll
            for (int b = 0; b < 2; ++b)
#pragma unroll
                for (int m = 0; m < 4; ++m)
#pragma unroll
                    for (int n = 0; n < 2; ++n) acc[a][b][m][n] = (f32x4){0.f, 0.f, 0.f, 0.f};
        cur = nxt; cA = nA; cB = nB; ++ui;
        if constexpr (ALIGN_EPI) { if (wr == 1) PG8_BAR; }
    }
    PG8_WAIT_V(0);
    if constexpr (!ALIGN_EPI) { if (wr == 0) PG8_BAR; }
    PG8_BAR;
    if constexpr (Epi::AFTER_DRAIN) { E.fused(acc, cur, wr, wc, fr, fq, lds, wid, lane); S.done(cur); }
#undef PG8_SA
#undef PG8_SB
#undef PG8_STAGE
#undef PG8_LDA
#undef PG8_LDB
#undef PG8_MMA
#undef PG8_WAIT_V
#undef PG8_WAIT_L
#undef PG8_BAR
#undef PG8_SCHED
}
}

__device__ __forceinline__ u32x4 pack8(const f32x4 a, const f32x4 b) {
    u32x4 w; w.x = pk2(a[0], a[1]); w.y = pk2(a[2], a[3]); w.z = pk2(b[0], b[1]); w.w = pk2(b[2], b[3]); return w;
}
__device__ __forceinline__ float tanh_fast(float x) { const float e = __expf(2.f * x); return 1.f - 2.f * __builtin_amdgcn_rcpf(1.f + e); }
__device__ __forceinline__ float decay_of(float v) { const float ew = 0.6065306597126334f * __builtin_amdgcn_rcpf(1.f + __expf(-v)); return __expf(-ew); }
struct EpiInproj {
    static constexpr bool PERM = true, AFTER_DRAIN = false;
    bf16* QKV; bf16* R32; bf16* Z;
    __device__ __forceinline__ void operator()(const f32x4 (&acc)[2][2][4][2], const pg8::Unit& u, int wr, int wc, int fr, int fq) const {
        const int pn = u.pn;
#pragma unroll
        for (int ai = 0; ai < 2; ++ai)
#pragma unroll
            for (int m = 0; m < 4; ++m) {
                const unsigned row = (unsigned)u.pm * 256u + ai * 128 + wr * 64 + m * 16 + fr;
#pragma unroll
                for (int bj = 0; bj < 2; ++bj) {
                    f32x4 v0 = acc[ai][bj][m][0], v1 = acc[ai][bj][m][1];
                    const int cb = bj * 128 + wc * 32 + 8 * fq;
                    if (pn < 6) {
                        if (pn == 3) { v0 = v0 * C2; v1 = v1 * C2; }
                        *(u32x4*)(QKV + row * 1536 + pn * 256 + cb) = pack8(v0, v1);
                    } else if (pn < 9) {
                        *(u32x4*)(R32 + row * 768 + (pn - 6) * 256 + cb) = pack8(v0, v1);
                    } else if (pn == 9) {
                        if (bj == 0) {
#pragma unroll
                            for (int e = 0; e < 4; ++e) { v0[e] = tanh_fast(v0[e]); v1[e] = tanh_fast(v1[e]); }
                        }
                        *(u32x4*)(Z + row * 384 + cb) = pack8(v0, v1);
                    } else {
                        if (bj == 0) {
#pragma unroll
                            for (int e = 0; e < 4; ++e) { v0[e] = sigmoidf_(v0[e]); v1[e] = sigmoidf_(v1[e]); }
                            *(u32x4*)(Z + row * 384 + 256 + cb) = pack8(v0, v1);
                        }
                    }
                }
            }
    }
};
struct EpiLora {
    static constexpr bool PERM = true, AFTER_DRAIN = false;
    bf16* DEC; bf16* ASIG; bf16* G; const float* w0; const float* a0;
    template <int KIND> __device__ __forceinline__ void body(const f32x4 (&acc)[2][2][4][2], bf16* dst, const float* bias, unsigned row0, int cb0) const {
#pragma unroll
        for (int bj = 0; bj < 2; ++bj) {
            const int cb = bj * 128 + cb0;
            f32x4 b0 = (f32x4){0.f, 0.f, 0.f, 0.f}, b1 = b0;
            if (KIND != 2) { b0 = *(const f32x4*)(bias + cb); b1 = *(const f32x4*)(bias + cb + 4); }
#pragma unroll
            for (int ai = 0; ai < 2; ++ai)
#pragma unroll
                for (int m = 0; m < 4; ++m) {
                    f32x4 v0 = acc[ai][bj][m][0] + b0, v1 = acc[ai][bj][m][1] + b1;
#pragma unroll
                    for (int e = 0; e < 4; ++e) {
                        if (KIND == 0) { v0[e] = 0.6065306597126334f * sigmoidf_(v0[e]); v1[e] = 0.6065306597126334f * sigmoidf_(v1[e]); }
                        if (KIND == 1) { v0[e] = sigmoidf_(v0[e]); v1[e] = sigmoidf_(v1[e]); }
                    }
                    *(u32x4*)(dst + (row0 + ai * 128 + m * 16) * 256u + cb) = pack8(v0, v1);
                    asm volatile("" ::: "memory");
                }
        }
    }
    __device__ __forceinline__ void operator()(const f32x4 (&acc)[2][2][4][2], const pg8::Unit& u, int wr, int wc, int fr, int fq) const {
        const int pn = u.pn; const unsigned row0 = (unsigned)u.pm * 256u + wr * 64 + fr; const int cb0 = wc * 32 + 8 * fq;
        if (pn < 2) body<0>(acc, DEC + (size_t)pn * M * 256, w0 + pn * 256, row0, cb0);
        else if (pn < 4) body<1>(acc, ASIG + (size_t)(pn - 2) * M * 256, a0 + (pn - 2) * 256, row0, cb0);
        else body<2>(acc, G, w0, row0, cb0);
    }
};
struct EpiOut {
    static constexpr bool PERM = true, AFTER_DRAIN = false;
    bf16* Y;
    __device__ __forceinline__ void operator()(const f32x4 (&acc)[2][2][4][2], const pg8::Unit& u, int wr, int wc, int fr, int fq) const {
#pragma unroll
        for (int ai = 0; ai < 2; ++ai)
#pragma unroll
            for (int m = 0; m < 4; ++m) {
                const unsigned row = (unsigned)u.pm * 256u + ai * 128 + wr * 64 + m * 16 + fr;
#pragma unroll
                for (int bj = 0; bj < 2; ++bj)
                    *(u32x4*)(Y + row * 1024 + u.pn * 256 + bj * 128 + wc * 32 + 8 * fq) = pack8(acc[ai][bj][m][0], acc[ai][bj][m][1]);
            }
    }
};
struct EpiMoe1 {
    static constexpr bool PERM = true, AFTER_DRAIN = false;
    bf16* HID;
    __device__ __forceinline__ void operator()(const f32x4 (&acc)[2][2][4][2], const pg8::Unit& u, int wr, int wc, int fr, int fq) const {
        const int pnl = u.pn & 7;
#pragma unroll
        for (int ai = 0; ai < 2; ++ai)
#pragma unroll
            for (int m = 0; m < 4; ++m) {
                const unsigned row = (unsigned)u.pm * 256u + ai * 128 + wr * 64 + m * 16 + fr;
                f32x4 h0, h1;
#pragma unroll
                for (int e = 0; e < 4; ++e) {
                    const float g0 = acc[ai][0][m][0][e], g1 = acc[ai][0][m][1][e];
                    h0[e] = g0 * sigmoidf_(g0) * acc[ai][1][m][0][e];
                    h1[e] = g1 * sigmoidf_(g1) * acc[ai][1][m][1][e];
                }
                *(u32x4*)(HID + row * 1024 + pnl * 128 + wc * 32 + 8 * fq) = pack8(h0, h1);
            }
    }
};
struct EpiMoe2 {
    static constexpr bool PERM = true, AFTER_DRAIN = false;
    bf16* OUTE; const float* selg;
    __device__ __forceinline__ void operator()(const f32x4 (&acc)[2][2][4][2], const pg8::Unit& u, int wr, int wc, int fr, int fq) const {
        const int pnl = u.pn & 3;
#pragma unroll
        for (int ai = 0; ai < 2; ++ai)
#pragma unroll
            for (int m = 0; m < 4; ++m) {
                const unsigned row = (unsigned)u.pm * 256u + ai * 128 + wr * 64 + m * 16 + fr;
                const float gt = selg[row];
#pragma unroll
                for (int bj = 0; bj < 2; ++bj)
                    *(u32x4*)(OUTE + row * 1024 + pnl * 256 + bj * 128 + wc * 32 + 8 * fq) = pack8(acc[ai][bj][m][0] * gt, acc[ai][bj][m][1] * gt);
            }
    }
};

struct TileSched {
    int nM, nN, G, c; bool latent_only;
    __device__ __forceinline__ bool next(int i, pg8::Unit& u) const {
        const long L = (long)i * G + c; if (L >= (long)nM * nN) return false;
        const int pmi = (int)(L / nN); u.pn = (int)(L % nN); u.pm = latent_only ? (pmi >> 3) * 9 + 1 + (pmi & 7) : pmi; return true;
    }
    __device__ __forceinline__ void a_ready(const pg8::Unit&) const {}
    __device__ __forceinline__ void done(const pg8::Unit&) const {}
};
struct InprojLastSched {
    int G, c;
    __device__ __forceinline__ bool next(int i, pg8::Unit& u) const {
        const int L = i * G + c; if (L >= 768) return false;
        if (L < 704) { const int pmi = L / 11; u.pn = L % 11; u.pm = (pmi >> 3) * 9 + 1 + (pmi & 7); }
        else { const int r = L - 704; u.pm = (r >> 3) * 9; const int k = r & 7; u.pn = k == 0 ? 2 : k + 3; }
        return true;
    }
    __device__ __forceinline__ void a_ready(const pg8::Unit&) const {}
    __device__ __forceinline__ void done(const pg8::Unit&) const {}
};
struct MoeSched {
    int nMe, nNe, G, c;
    __device__ __forceinline__ bool next(int i, pg8::Unit& u) const {
        const long L = (long)i * G + c; if (L >= (long)NE * nMe * nNe) return false;
        const int pnl = (int)(L % nNe), t = (int)(L / nNe), pml = t % nMe, e = t / nMe;
        u.pm = e * 9 + pml; u.pn = e * nNe + pnl; return true;
    }
    __device__ __forceinline__ void a_ready(const pg8::Unit&) const {}
    __device__ __forceinline__ void done(const pg8::Unit&) const {}
};

template <class Epi, class Sched>
__device__ __forceinline__ void gemm_ref(const pg8::Gemm g, const Sched& S, const Epi& E) {
    const int tid = threadIdx.x, wid = tid >> 6, lane = tid & 63, wr = wid >> 2, wc = wid & 3, fr = lane & 15, fq = lane >> 4;
    int K = g.K; asm volatile("" : "+s"(K));
    pg8::Unit u;
    for (int ui = 0; S.next(ui, u); ++ui) {
        f32x4 acc[2][2][4][2];
#pragma unroll
        for (int a = 0; a < 2; ++a)
#pragma unroll
            for (int b = 0; b < 2; ++b)
#pragma unroll
                for (int m = 0; m < 4; ++m)
#pragma unroll
                    for (int n = 0; n < 2; ++n) acc[a][b][m][n] = (f32x4){0.f, 0.f, 0.f, 0.f};
        const bf16* Ab = g.A + ((size_t)u.pm * 256 + wr * 64 + fr) * K;
        const bf16* Bb = g.Bt + ((size_t)u.pn * 256 + wc * 32 + 8 * fq) * K;
#pragma unroll
        for (int ai = 0; ai < 2; ++ai)
#pragma unroll
            for (int bj = 0; bj < 2; ++bj)
#pragma unroll
                for (int m = 0; m < 4; ++m)
#pragma unroll
                    for (int n = 0; n < 2; ++n)
#pragma unroll
                        for (int e = 0; e < 4; ++e) {
                            const bf16* ar = Ab + (size_t)(ai * 128 + m * 16) * K; const bf16* br = Bb + (size_t)(bj * 128 + 4 * n + e) * K;
                            float s0 = 0.f, s1 = 0.f;
#pragma unroll 2
                            for (int k0 = 0; k0 < K; k0 += 8) {
                                const u32x4 wa = *(const u32x4*)(ar + k0), wb = *(const u32x4*)(br + k0);
                                s0 += bflo(wa.x) * bflo(wb.x) + bflo(wa.y) * bflo(wb.y) + bflo(wa.z) * bflo(wb.z) + bflo(wa.w) * bflo(wb.w);
                                s1 += bfhi(wa.x) * bfhi(wb.x) + bfhi(wa.y) * bfhi(wb.y) + bfhi(wa.z) * bfhi(wb.z) + bfhi(wa.w) * bfhi(wb.w);
                            }
                            acc[ai][bj][m][n][e] = s0 + s1;
                            asm volatile("" ::: "memory");
                        }
        E(acc, u, wr, wc, fr, fq);
    }
}
template <class Epi, class Sched>
__device__ __forceinline__ void run_gemm(LAS unsigned char* lds, const pg8::Gemm g, const Sched& S, const Epi& E) {
#if GOLD_GEMM
    gemm_ref<Epi, Sched>(g, S, E);
    __syncthreads();
#else
    pg8::Gemm g2 = g; { int kd = g.K; asm volatile("" : "+s"(kd)); g2.K = kd; }
    pg8::gemm_phase<Epi, Sched, true, true>(lds, g2, S, E);
#endif
}

struct Args { const float* in[29]; float* out; unsigned char* ws; int ph_lo, ph_hi; };
enum { I_X = 0, I_C, I_CTX, I_CCTX, I_WMOD, I_BMOD, I_GPREMIX, I_GPOSTMIX, I_GPREFFN, I_GPOSTFFN, I_WIN, I_WOUT, I_QGAIN, I_KGAIN, I_RPB,
       I_W0, I_WUP, I_A0, I_AUP, I_GUP, I_KK, I_KA, I_RK, I_LNXW, I_LNXB, I_WROUTER, I_WEGATE, I_WEUP, I_WEDOWN };

struct Frame {
    LAS unsigned char* lds; volatile LAS unsigned* MISC; unsigned* ctl;
    int wave, vcu, G;
    const float* const* in; float* out; unsigned char* ws;
};
#define TID_ ((int)threadIdx.x)
#define LANE_ ((int)(threadIdx.x & 63u))
#define WSP(T_, off) ((T_*)(F.ws + (off)))

__device__ __forceinline__ void cvt_item(const float* src, int ld_src, bf16* dst, int ld_dst, LAS float* scr, int lane) {
#pragma unroll 8
    for (int i = 0; i < 32; ++i) { const int kk = 2 * i + (lane >> 5); scr[kk * 33 + (lane & 31)] = src[(size_t)kk * ld_src + (lane & 31)]; }
    LDS_WAIT(); asm volatile("" ::: "memory");
    const int c = lane & 7;
#pragma unroll
    for (int j = 0; j < 4; ++j) { const int n = (lane >> 3) + 8 * j; const LAS float* s = scr + (8 * c) * 33 + n;
        u32x4 o; o.x = pk2(s[0 * 33], s[1 * 33]); o.y = pk2(s[2 * 33], s[3 * 33]); o.z = pk2(s[4 * 33], s[5 * 33]); o.w = pk2(s[6 * 33], s[7 * 33]);
        *(u32x4*)(dst + (size_t)n * ld_dst + 8 * c) = o; }
    LDS_WAIT(); asm volatile("" ::: "memory");
}
__device__ __forceinline__ void cvt_moe_item(Frame& F, int l, int it, LAS float* scr, int lane) {
    const int which = it >> 13, r = it & 8191, e = r >> 9, q = r & 511, kb = q >> 5, nb = q & 31, n0 = nb * 32;
    const float* W = F.in[which == 0 ? I_WEGATE : (which == 1 ? I_WEUP : I_WEDOWN)] + ((size_t)(l * NE + e) * 1024 + kb * 64) * 1024 + n0;
    bf16* dst;
    if (which < 2) dst = WSP(bf16, WS_WGU) + ((size_t)e * 2048 + (n0 >> 7) * 256 + which * 128 + (n0 & 127)) * 1024 + kb * 64;
    else dst = WSP(bf16, WS_WD) + ((size_t)e * 1024 + n0) * 1024 + kb * 64;
    cvt_item(W, 1024, dst, 1024, scr, lane);
}
constexpr int CVT_NMINI = 3 * 8192 / NWAVES, CW_CVTQ = 40960;
__device__ __forceinline__ void cvt_moe_mini(Frame& F, int l, int mb) {
    int lane = LANE_; asm volatile("" : "+v"(lane));
    cvt_moe_item(F, l, mb * NWAVES + F.wave, (LAS float*)(F.lds + F.wave * 16384), lane);
}
__device__ __forceinline__ void cvt_moe_drain(Frame& F, int l, int n) {
    for (;;) {
        if (TID_ == 0) F.MISC[17] = atomicAdd(F.ctl + CW_CVTQ + 64 * l, (unsigned)n);
        __syncthreads();
        const int base = (int)F.MISC[17];
        __syncthreads();
        if (base >= CVT_NMINI) break;
#pragma unroll 1
        for (int k = 0; k < n; ++k) if (base + k < CVT_NMINI) cvt_moe_mini(F, l, base + k);
        __syncthreads();
    }
}

__device__ __forceinline__ void phase_init(Frame& F) {
    const int tid = TID_;
    {
        LAS float* sil = (LAS float*)F.lds;
        LAS float* red = (LAS float*)(F.lds + 40960);
        float* MOD = WSP(float, WS_MOD);
        bool have = false;
        for (int it = F.vcu; it < 2 * 96; it += F.G) {
            if (!have) {
                for (int i = tid; i < 9 * 1024; i += NTHREADS) { const int r = i >> 10, k = i & 1023; const float cv = (r < 8) ? F.in[I_C][r * 1024 + k] : F.in[I_CCTX][k]; sil[i] = cv / (1.f + expf(-cv)); }
                __syncthreads(); have = true;
            }
            const int l = it / 96, n0 = (it % 96) * 64, ks = tid >> 6, col = tid & 63;
            float acc[9];
#pragma unroll
            for (int r = 0; r < 9; ++r) acc[r] = 0.f;
            const float* w = F.in[I_WMOD] + ((size_t)l * 1024 + ks * 128) * 6144 + n0 + col;
            for (int k0 = 0; k0 < 128; k0 += 16) {
                float wv[16];
#pragma unroll
                for (int k = 0; k < 16; ++k) wv[k] = w[(size_t)(k0 + k) * 6144];
#pragma unroll
                for (int k = 0; k < 16; ++k)
#pragma unroll
                    for (int r = 0; r < 9; ++r) acc[r] += sil[r * 1024 + ks * 128 + k0 + k] * wv[k];
            }
#pragma unroll
            for (int r = 0; r < 9; ++r) red[(ks * 9 + r) * 64 + col] = acc[r];
            __syncthreads();
            for (int o = tid; o < 576; o += NTHREADS) { const int r = o >> 6, cc = o & 63; float s = 0.f;
#pragma unroll
                for (int k2 = 0; k2 < 8; ++k2) s += red[(k2 * 9 + r) * 64 + cc];
                MOD[(size_t)(l * 9 + r) * 6144 + n0 + cc] = s + F.in[I_BMOD][l * 6144 + n0 + cc]; }
            __syncthreads();
        }
        __syncthreads();
    }
    {
        LAS float* scr = (LAS float*)(F.lds + F.wave * 16384);
        const int gw = F.vcu * NWAVES + F.wave, NGW = F.G * NWAVES;
        bf16* WIN = WSP(bf16, WS_WIN); bf16* WOUT = WSP(bf16, WS_WOUT);
        for (int it = gw; it < 2 * (1344 + 512); it += NGW) {
            const int l = it / 1856, r = it % 1856;
            if (r < 1344) { const int kb = r / 84, n0 = (r % 84) * 32; const int dn = n0 < 768 ? n0 : (n0 < 1920 ? n0 + 768 : n0 - 1152);
                cvt_item(F.in[I_WIN] + ((size_t)l * 1024 + kb * 64) * 2688 + n0, 2688, WIN + ((size_t)l * NINP + dn) * 1024 + kb * 64, 1024, scr, LANE_); }
            else { const int q = r - 1344, kb = q >> 5, n0 = (q & 31) * 32;
                cvt_item(F.in[I_WOUT] + ((size_t)l * 1024 + kb * 64) * 1024 + n0, 1024, WOUT + ((size_t)l * 1024 + n0) * 1024 + kb * 64, 1024, scr, LANE_); }
        }
    }
    {
        const size_t gt = (size_t)F.vcu * NTHREADS + tid, NT = (size_t)F.G * NTHREADS;
        u32x4* WIN4 = WSP(u32x4, WS_WIN);
        for (size_t i = gt; i < (size_t)2 * 128 * 128; i += NT) { const int l = (int)(i >> 14), r = (int)(i & 16383); WIN4[((size_t)l * NINP + 2688) * 128 + r] = (u32x4){0u, 0u, 0u, 0u}; }
        bf16* LORA = WSP(bf16, WS_LORA);
        for (size_t i = gt; i < (size_t)2 * 1280 * 384; i += NT) { const int l = (int)(i / (1280 * 384)), r = (int)(i % (1280 * 384)), n = r / 384, k = r % 384, tile = n >> 8, nn = n & 255;
            float v = 0.f;
            if (tile < 2) { const int d = tile, kk = k - 64 * d; if (kk >= 0 && kk < 64) v = F.in[I_WUP][(((size_t)l * 2 + d) * 64 + kk) * 256 + nn]; }
            else if (tile < 4) { const int d = tile - 2, kk = k - 128 - 64 * d; if (kk >= 0 && kk < 64) v = F.in[I_AUP][(((size_t)l * 2 + d) * 64 + kk) * 256 + nn]; }
            else { const int kk = k - 256; if (kk >= 0) v = F.in[I_GUP][((size_t)l * 128 + kk) * 256 + nn]; }
            LORA[i] = (bf16)f2bf(v); }
    }
}

__device__ __forceinline__ const float* in_row(Frame& F, int b, int t) { return t < CTXL ? F.in[I_CTX] + ((size_t)b * CTXL + t) * 1024 : F.in[I_X] + ((size_t)b * SEQ + (t - CTXL)) * 1024; }
__device__ __forceinline__ f32x4 ldbf4(const bf16* p) { const u32x2 w = *(const u32x2*)p; return (f32x4){bflo(w.x), bfhi(w.x), bflo(w.y), bfhi(w.y)}; }
__device__ __forceinline__ void stbf4(bf16* p, const f32x4 v) { u32x2 w; w.x = pk2(v[0], v[1]); w.y = pk2(v[2], v[3]); *(u32x2*)p = w; }
__device__ __forceinline__ float row_ss(const f32x4 (&v)[4]) {
    float s = 0.f;
#pragma unroll
    for (int j = 0; j < 4; ++j) s += (v[j][0] * v[j][0] + v[j][1] * v[j][1]) + (v[j][2] * v[j][2] + v[j][3] * v[j][3]);
    return wave_sum(s);
}
__device__ __forceinline__ void mod_store(const f32x4 (&x)[4], float rinv, const float* g, const float* shift, const float* scale, bf16* dst, int lane, f32x4 (&h)[4]) {
#pragma unroll
    for (int j = 0; j < 4; ++j) { const int e = 256 * j + 4 * lane;
        const f32x4 gg = *(const f32x4*)(g + e), sh = *(const f32x4*)(shift + e), sc = *(const f32x4*)(scale + e);
        h[j] = x[j] * rinv * gg * (sc + 1.f) + sh;
        u32x2 w; w.x = pk2(h[j][0], h[j][1]); w.y = pk2(h[j][2], h[j][3]); *(u32x2*)(dst + e) = w; }
}
__device__ __forceinline__ void phase_row0(Frame& F) {
    const int gw = F.vcu * NWAVES + F.wave, NGW = F.G * NWAVES, lane = LANE_;
    bf16* H = WSP(bf16, WS_H); const float* MOD = WSP(float, WS_MOD);
    f32x4 xn[4];
    if (gw < M) { const float* xin = in_row(F, gw / T, gw % T);
#pragma unroll
        for (int j = 0; j < 4; ++j) xn[j] = *(const f32x4*)(xin + 256 * j + 4 * lane); }
    for (int m = gw; m < M; m += NGW) { const int b = m / T, t = m % T, r = t < CTXL ? 8 : b;
        f32x4 x[4], h[4];
#pragma unroll
        for (int j = 0; j < 4; ++j) x[j] = xn[j];
        if (m + NGW < M) { const float* xin = in_row(F, (m + NGW) / T, (m + NGW) % T);
#pragma unroll
            for (int j = 0; j < 4; ++j) xn[j] = *(const f32x4*)(xin + 256 * j + 4 * lane); }
        const float rinv = rsqrtf(row_ss(x) * (1.f / 1024.f) + 1e-6f);
        const float* md = MOD + (size_t)(0 * 9 + r) * 6144;
        mod_store(x, rinv, F.in[I_GPREMIX], md, md + 1024, H + (size_t)m * 1024, lane, h);
    }
}
__device__ __forceinline__ void phase_row1(Frame& F, int l, int dry = 0) {
    const int gw = F.vcu * NWAVES + F.wave, NGW = F.G * NWAVES, lane = LANE_;
    const bf16* X = WSP(bf16, WS_X); const bf16* Y = WSP(bf16, WS_Y); const float* MOD = WSP(float, WS_MOD);
    bf16* Xs = dry ? WSP(bf16, WS_XE) : WSP(bf16, WS_X); bf16* H2 = dry ? WSP(bf16, WS_YD) : WSP(bf16, WS_H2);
    float* AFF = dry ? WSP(float, WS_O) + 4 * MiB : WSP(float, WS_AFF); int* INV = dry ? WSP(int, WS_O) + 2 * MiB : WSP(int, WS_INV);
    {
        const float* src = F.in[I_WROUTER] + (size_t)l * 1024 * 16; LAS float* dstl = (LAS float*)F.lds;
        for (int i = TID_; i < 16384; i += NTHREADS) dstl[(i & 15) * 1024 + (i >> 4)] = src[i];
        __syncthreads();
    }
    const LAS float* wbase = (const LAS float*)F.lds + 4 * lane;
    auto row_ok = [&](int m) { return m < M && !(l == NL - 1 && (m % T) < CTXL); };
    auto next_row = [&](int m) { m += NGW; while (m < M && !row_ok(m)) m += NGW; return m; };
    int m = gw; if (!row_ok(m)) m = next_row(m);
    f32x4 xn[4], yn[4];
    if (m < M) { const float* xin = in_row(F, m / T, m % T);
#pragma unroll
        for (int j = 0; j < 4; ++j) { yn[j] = ldbf4(Y + (size_t)m * 1024 + 256 * j + 4 * lane); xn[j] = (l == 0) ? *(const f32x4*)(xin + 256 * j + 4 * lane) : ldbf4(X + (size_t)m * 1024 + 256 * j + 4 * lane); } }
    for (; m < M; ) { const int b = m / T, t = m % T, r = t < CTXL ? 8 : b;
        const float* md = MOD + (size_t)(l * 9 + r) * 6144;
        f32x4 x[4], y[4], h[4];
#pragma unroll
        for (int j = 0; j < 4; ++j) { x[j] = xn[j]; y[j] = yn[j]; }
        const int mnext = next_row(m);
        if (mnext < M) { const float* xin = in_row(F, mnext / T, mnext % T);
#pragma unroll
            for (int j = 0; j < 4; ++j) { yn[j] = ldbf4(Y + (size_t)mnext * 1024 + 256 * j + 4 * lane); xn[j] = (l == 0) ? *(const f32x4*)(xin + 256 * j + 4 * lane) : ldbf4(X + (size_t)mnext * 1024 + 256 * j + 4 * lane); } }
        const float rinv = rsqrtf(row_ss(y) * (1.f / 1024.f) + 1e-6f);
#pragma unroll
        for (int j = 0; j < 4; ++j) { const int e = 256 * j + 4 * lane;
            const f32x4 gg = *(const f32x4*)(F.in[I_GPOSTMIX] + l * 1024 + e), gt = *(const f32x4*)(md + 2 * 1024 + e);
            x[j] = x[j] + gt * (y[j] * rinv * gg); if (dry != 3) stbf4(Xs + (size_t)m * 1024 + e, x[j]); }
        const float rinv2 = rsqrtf(row_ss(x) * (1.f / 1024.f) + 1e-6f);
        mod_store(x, rinv2, F.in[I_GPREFFN] + l * 1024, md + 3 * 1024, md + 4 * 1024, H2 + (size_t)m * 1024, lane, h);
        if (dry == 2) { m = mnext; continue; }
        float lg[16];
#pragma unroll
        for (int k = 0; k < 16; ++k) lg[k] = 0.f;
#pragma unroll
        for (int k = 0; k < 16; ++k) {
#pragma unroll
            for (int j = 0; j < 4; ++j) { const f32x4 wv = *(const LAS f32x4*)(wbase + k * 1024 + 256 * j); lg[k] += (h[j][0] * wv[0] + h[j][1] * wv[1]) + (h[j][2] * wv[2] + h[j][3] * wv[3]); }
            if ((k & 3) == 3) asm volatile("" ::: "memory");
        }
        {
            LAS float* red = (LAS float*)F.lds + 16384 + F.wave * 1024;
#pragma unroll
            for (int k = 0; k < 16; ++k) red[k * 64 + lane] = lg[k];
            LDS_WAIT(); asm volatile("" ::: "memory");
            const LAS f32x4* rp = (const LAS f32x4*)(red + (lane >> 2) * 64 + (lane & 3) * 16);
            const f32x4 q0 = rp[0], q1 = rp[1], q2 = rp[2], q3 = rp[3];
            float s = ((q0[0] + q0[1]) + (q0[2] + q0[3])) + ((q1[0] + q1[1]) + (q1[2] + q1[3])) + ((q2[0] + q2[1]) + (q2[2] + q2[3])) + ((q3[0] + q3[1]) + (q3[2] + q3[3]));
            s += dppf<0xB1>(s); s += dppf<0x4E>(s);
            const float mx = wave_max(s);
            const float ex = expf(s - mx);
            const float den = wave_sum(ex) * 0.25f;
            if ((lane & 3) == 0) { AFF[(size_t)m * 16 + (lane >> 2)] = ex / den; INV[(size_t)m * 16 + (lane >> 2)] = -1; }
            LDS_WAIT(); asm volatile("" ::: "memory");
        }
        m = mnext;
    }
}
__device__ __forceinline__ void phase_row2(Frame& F, int l, bool dry = false) {
    const int gw = F.vcu * NWAVES + F.wave, NGW = F.G * NWAVES, lane = LANE_;
    const bf16* X = WSP(bf16, WS_X); const bf16* OUTE = WSP(bf16, WS_OUTE); const float* MOD = WSP(float, WS_MOD);
    bf16* Xs = dry ? WSP(bf16, WS_XE) : WSP(bf16, WS_X); bf16* H = dry ? WSP(bf16, WS_YD) : WSP(bf16, WS_H); float* outp = dry ? WSP(float, WS_XE) : F.out;
    const int* INV = WSP(int, WS_INV);
    const bool last = (l == NL - 1);
#if defined(TPROBE_ON)
    const float tp_scale = F.ctl[3000] ? 3.f : 1.f;
#else
    const float tp_scale = 1.f;
#endif
    auto row_ok = [&](int m) { return m < M && !(last && (m % T) < CTXL); };
    auto next_row = [&](int m) { m += NGW; while (m < M && !row_ok(m)) m += NGW; return m; };
    int m = gw; if (!row_ok(m)) m = next_row(m);
    f32x4 xn[4]; int invn = -1;
    if (m < M) { invn = INV[(size_t)m * 16 + (lane & 15)];
#pragma unroll
        for (int j = 0; j < 4; ++j) xn[j] = ldbf4(X + (size_t)m * 1024 + 256 * j + 4 * lane); }
    for (; m < M; ) { const int b = m / T, t = m % T, r = t < CTXL ? 8 : b;
        const float* md = MOD + (size_t)(l * 9 + r) * 6144;
        f32x4 x[4], f[4], h[4];
#pragma unroll
        for (int j = 0; j < 4; ++j) { x[j] = xn[j]; f[j] = (f32x4){0.f, 0.f, 0.f, 0.f}; }
        const int invl = invn;
        const int mnext = next_row(m);
        if (mnext < M) { invn = INV[(size_t)mnext * 16 + (lane & 15)];
#pragma unroll
            for (int j = 0; j < 4; ++j) xn[j] = ldbf4(X + (size_t)mnext * 1024 + 256 * j + 4 * lane); }
        for (int e = 0; e < 16; ++e) { const int rr = __shfl(invl, e);
            if (rr >= 0) {
#pragma unroll
                for (int j = 0; j < 4; ++j) { const u32x2 w = *(const u32x2*)(OUTE + (size_t)rr * 1024 + 256 * j + 4 * lane);
                    f[j][0] += bflo(w.x); f[j][1] += bfhi(w.x); f[j][2] += bflo(w.y); f[j][3] += bfhi(w.y); } } }
        const float rinv = rsqrtf(row_ss(f) * (1.f / 1024.f) + 1e-6f);
#pragma unroll
        for (int j = 0; j < 4; ++j) { const int e = 256 * j + 4 * lane;
            const f32x4 gg = *(const f32x4*)(F.in[I_GPOSTFFN] + l * 1024 + e), gt = *(const f32x4*)(md + 5 * 1024 + e);
            x[j] = x[j] + gt * (f[j] * rinv * gg);
            if (last) *(f32x4*)(outp + ((size_t)b * SEQ + (t - CTXL)) * 1024 + e) = x[j] * tp_scale;
            else stbf4(Xs + (size_t)m * 1024 + e, x[j]); }
        if (!last) {
            const float rinv2 = rsqrtf(row_ss(x) * (1.f / 1024.f) + 1e-6f);
            const float* md2 = MOD + (size_t)((l + 1) * 9 + r) * 6144;
            mod_store(x, rinv2, F.in[I_GPREMIX] + (l + 1) * 1024, md2, md2 + 1024, H + (size_t)m * 1024, lane, h);
        }
        m = mnext;
    }
}

__device__ __forceinline__ void phase_qkprep(Frame& F, int l, bool dry = false) {
    const int gw = F.vcu * NWAVES + F.wave, NGW = F.G * NWAVES, lane = LANE_;
    bf16* QKV = WSP(bf16, WS_QKV); bf16* QO = dry ? WSP(bf16, WS_YD) : QKV;
    const float qg = F.in[I_QGAIN][l * 64 + lane] * C2, kg = F.in[I_KGAIN][l * 64 + lane];
    const int i16 = lane & 15; const bool second = (lane & 16) != 0, colseg = (lane & 32) != 0;
    const float inv = exp2f(-(float)i16 * (13.287712379549449f / 16.f));
    for (int m = gw; m < M; m += NGW) { const int t = m % T; const bool ctx = t < CTXL;
        const int s0 = (l == NL - 1 && ctx) ? 8 : 0;
        const bf16* p = QKV + (size_t)m * 1536 + lane; bf16* po = QO + (size_t)m * 1536 + lane;
        float x[10];
#pragma unroll
        for (int s = 0; s < 10; ++s) x[s] = (s >= s0) ? bf2f(p[s * 64]) : 0.f;
        float cs = 1.f, sn = 0.f;
        if (!ctx) { const int pos = t - CTXL; const float ang = (float)(colseg ? (pos & 63) : (pos >> 6)) * inv; cs = cosf(ang); sn = sinf(ang); if (!second) sn = -sn; }
#pragma unroll
        for (int s = 0; s < 10; ++s) {
            if (s < s0) continue;
            const float ss = wave_sum(x[s] * x[s]);
            float y = x[s] * __builtin_amdgcn_rsqf(ss * (1.f / 64.f) + 1e-6f) * (s < 8 ? qg : kg);
            const float other = __shfl_xor(y, 16);
            y = y * cs + other * sn;
            po[s * 64] = (bf16)f2bf(y);
        }
    }
}
#include <hip/hip_bf16.h>
#include <cmath>
namespace attn_body {
using bf16=__hip_bfloat16;
using bf16x8=__attribute__((ext_vector_type(8)))short;
using s16x4=__attribute__((ext_vector_type(4)))short;
using f32x16=__attribute__((ext_vector_type(16)))float;
using u32x4=__attribute__((ext_vector_type(4)))unsigned;
constexpr int D=64,QP=1536,OP=1024;
constexpr int NW=8,QBLK=32,QB=QBLK*NW,KVBLK=64;
__device__ __forceinline__ int crow(int r,int hi){return (r&3)+8*(r>>2)+4*hi;}
#define SBAR() __builtin_amdgcn_sched_barrier(0)
constexpr int NSLOT=3, SLOTB=8192;
constexpr int LDS_K=0, LDS_V=NSLOT*SLOTB, LDS_WS=2*NSLOT*SLOTB, LDS_OST=LDS_WS+NW*64*4, LDS_RPB=LDS_OST+NW*4096, LDS_BYTES=LDS_RPB+3072;
constexpr float C2=0.125f*1.4426950408889634f;
__device__ __forceinline__ void glds16(const void*gsrc,unsigned lds_dst){unsigned keep;
  asm volatile("s_mov_b32 %0, m0\n\ts_mov_b32 m0, %2\n\ts_nop 0\n\tglobal_load_lds_dwordx4 %1, off\n\ts_mov_b32 m0, %0":"=&s"(keep):"v"(gsrc),"s"(lds_dst):"memory");}
__device__ __forceinline__ float max3f(float a,float b,float c){float r;asm("v_max3_f32 %0, %1, %2, %3":"=v"(r):"v"(a),"v"(b),"v"(c));return r;}
__device__ __forceinline__ float max2f(float a,float b){float r;asm("v_max_f32_e32 %0, %1, %2":"=v"(r):"v"(a),"v"(b));return r;}
__device__ __forceinline__ float fadd_s(float a,float b){float r;asm("v_add_f32_e32 %0, %1, %2":"=v"(r):"v"(a),"v"(b));return r;}
__device__ __forceinline__ float fsub_s(float a,float b){float r;asm("v_sub_f32_e32 %0, %1, %2":"=v"(r):"v"(a),"v"(b));return r;}
typedef float f32x2_t __attribute__((ext_vector_type(2))); typedef __bf16 bf16x2_t __attribute__((ext_vector_type(2)));
__device__ __forceinline__ unsigned cvtpk_s(float lo,float hi){f32x2_t v={lo,hi};bf16x2_t b=__builtin_convertvector(v,bf16x2_t);return __builtin_bit_cast(unsigned,b);}
#define WAIT_BAR(N) asm volatile("s_waitcnt vmcnt(" #N ") lgkmcnt(0)\n\ts_barrier":::"memory")

__device__ __forceinline__ void qkt(f32x16&p0,f32x16&p1,const char*Kslot,const bf16x8*qr,const f32x16&negm,int r32,int hi){
  const char*kb=Kslot+hi*1024+r32*16;
  #pragma unroll
  for(int d0=0;d0<4;++d0){
    const bf16x8 b0=*reinterpret_cast<const bf16x8*>(kb+d0*2048);
    const bf16x8 b1=*reinterpret_cast<const bf16x8*>(kb+d0*2048+512);
    if(d0==0){p0=__builtin_amdgcn_mfma_f32_32x32x16_bf16(b0,qr[0],negm,0,0,0);p1=__builtin_amdgcn_mfma_f32_32x32x16_bf16(b1,qr[0],negm,0,0,0);}
    else{p0=__builtin_amdgcn_mfma_f32_32x32x16_bf16(b0,qr[d0],p0,0,0,0);p1=__builtin_amdgcn_mfma_f32_32x32x16_bf16(b1,qr[d0],p1,0,0,0);}}
}
typedef __attribute__((address_space(3))) const char* lds_cptr;
typedef short v4i16_t __attribute__((ext_vector_type(4)));
__device__ __forceinline__ void kload8(bf16x8*kf,lds_cptr kp){
  kf[0]=*(const __attribute__((address_space(3))) bf16x8*)(kp);      kf[1]=*(const __attribute__((address_space(3))) bf16x8*)(kp+512);
  kf[2]=*(const __attribute__((address_space(3))) bf16x8*)(kp+2048); kf[3]=*(const __attribute__((address_space(3))) bf16x8*)(kp+2560);
  kf[4]=*(const __attribute__((address_space(3))) bf16x8*)(kp+4096); kf[5]=*(const __attribute__((address_space(3))) bf16x8*)(kp+4608);
  kf[6]=*(const __attribute__((address_space(3))) bf16x8*)(kp+6144); kf[7]=*(const __attribute__((address_space(3))) bf16x8*)(kp+6656);
}
__device__ __forceinline__ void kload2(bf16x8*kf,lds_cptr kp,int j){ kf[2*j]=*(const __attribute__((address_space(3))) bf16x8*)(kp+j*2048); kf[2*j+1]=*(const __attribute__((address_space(3))) bf16x8*)(kp+j*2048+512); }
__device__ __forceinline__ s16x4 vtr(lds_cptr p){ return __builtin_bit_cast(s16x4,__builtin_amdgcn_ds_read_tr16_b64_v4i16((__attribute__((address_space(3))) v4i16_t*)p)); }
__device__ __forceinline__ float rowmax(const f32x16&p0,const f32x16&p1){
  float a=max3f(p0[0],p0[1],p1[0]),b=max3f(p0[2],p0[3],p1[1]);a=max3f(a,p1[2],p1[3]);
  #pragma unroll
  for(int r=4;r<16;r+=4){a=max3f(a,p0[r],p0[r+1]);b=max3f(b,p0[r+2],p0[r+3]);a=max3f(a,p1[r],p1[r+1]);b=max3f(b,p1[r+2],p1[r+3]);}
  const float m=max2f(a,b);
  auto rr=__builtin_amdgcn_permlane32_swap(__float_as_uint(m),__float_as_uint(m),false,false);
  return max2f(__uint_as_float(rr[0]),__uint_as_float(rr[1]));
}
__device__ __forceinline__ void pv(f32x16*o,int vb,bf16x8 pa0,bf16x8 pa1,bf16x8 pa2,bf16x8 pa3){
  #pragma unroll
  for(int d0=0;d0<2;++d0){s16x4 lo[4],hi[4];
    #pragma unroll
    for(int ks=0;ks<4;++ks){
      asm volatile("ds_read_b64_tr_b16 %0,%1 offset:%c2":"=&v"(lo[ks]):"v"(vb),"i"(d0*4096+ks*1024):"memory");
      asm volatile("ds_read_b64_tr_b16 %0,%1 offset:%c2":"=&v"(hi[ks]):"v"(vb),"i"(d0*4096+ks*1024+512):"memory");}
    asm volatile("s_waitcnt lgkmcnt(0)":::"memory");SBAR();
    #define PK(k) (bf16x8){lo[k][0],lo[k][1],lo[k][2],lo[k][3],hi[k][0],hi[k][1],hi[k][2],hi[k][3]}
    o[d0]=__builtin_amdgcn_mfma_f32_32x32x16_bf16(pa0,PK(0),o[d0],0,0,0);
    o[d0]=__builtin_amdgcn_mfma_f32_32x32x16_bf16(pa1,PK(1),o[d0],0,0,0);
    o[d0]=__builtin_amdgcn_mfma_f32_32x32x16_bf16(pa2,PK(2),o[d0],0,0,0);
    o[d0]=__builtin_amdgcn_mfma_f32_32x32x16_bf16(pa3,PK(3),o[d0],0,0,0);
    #undef PK
  }
}

#ifndef ATTN_STORE16
#define ATTN_STORE16(p,v) (*(u32x4*)(p)=(v))
#endif
template<int THRL,bool WIN> __device__ __forceinline__ void attn_unit(const bf16*Qw0,const bf16*__restrict__ Kh,const bf16*__restrict__ Vh,bf16*Ow0,const int NT,const int toff,const int rb,const int rs0,const float*rpbh,char*shm){
  int tid_=threadIdx.x; asm volatile("":"+v"(tid_));
  const int tid=tid_,lane=tid&63,r32=lane&31,hi=lane>>5; const int wid=__builtin_amdgcn_readfirstlane(tid>>6);
  const bf16*Qw=Qw0+(long)(wid*QBLK)*QP;
  const unsigned lds0=(unsigned)(uintptr_t)shm;
  float*wsf=(float*)(shm+LDS_WS)+wid*64;
  const bf16*ksrc=Kh+(long)lane*QP+wid*8;
  const bf16*vsrc=Vh+(long)(16*(wid&3)+(lane>>2))*QP+(wid>>2)*32+(lane&3)*8;
  const unsigned kdst=lds0+LDS_K+wid*1024, vdst=lds0+LDS_V+wid*1024;
  #define TROW(t) ((long)(((t)+(((t)>=4)?toff:0))*KVBLK)*QP)
  #define DMA_K(t,slot) glds16(ksrc+TROW(t),(unsigned)__builtin_amdgcn_readfirstlane(kdst+(slot)))
  #define DMA_V(t,slot) glds16(vsrc+TROW(t),(unsigned)__builtin_amdgcn_readfirstlane(vdst+(slot)))
  const int vb0=(int)(lds0+LDS_V)+((lane>>4)&1)*32+(lane&3)*8+(4*hi+((lane&15)>>2))*64;
  const char*Kbase=shm+LDS_K; bf16x8 kf[8];
  const lds_cptr shm3=(lds_cptr)shm; const lds_cptr kp0=shm3+LDS_K+hi*1024+r32*16; const lds_cptr vp0=shm3+LDS_V+((lane>>4)&1)*32+(lane&3)*8+(4*hi+((lane&15)>>2))*64;
  DMA_K(0,0);DMA_V(0,0);DMA_K(1,SLOTB);
  bf16x8 qr[4];
  #pragma unroll
  for(int d0=0;d0<4;++d0)qr[d0]=*reinterpret_cast<const bf16x8*>(&Qw[(long)r32*QP+d0*16+hi*8]);
  float mhat=0.f,l_reg=0.f;f32x16 o[2];o[0]=f32x16{};o[1]=f32x16{};f32x16 negm=f32x16{};asm volatile("":"+v"(negm));
  const int gr=4*rb+(wid>>1), gc=(wid&1)*32+r32, rsq=min(max(gr-4,0),24), csq=min(max(gc-8,0),48);
  const float*rpbl=(const float*)(shm+LDS_RPB+256)+(15-gc+4*hi);
  const int kcb=4*hi-csq;
  if(WIN){ for(int i_=tid;i_<15*31;i_+=512)((float*)(shm+LDS_RPB+256))[i_]=rpbh[i_]*1.4426950408889634f; }
  #define CMASK(P0,P1,t) do{ if(WIN && (t)>=4){ const int kr_=rs0+(t)-4; const bool rowok_=(kr_>=rsq)&&(kr_<rsq+8); \
      if(!rowok_){ _Pragma("unroll") for(int r=0;r<16;++r){P0[r]=-INFINITY;P1[r]=-INFINITY;} } \
      else { const float*bp_=rpbl+(kr_-gr+7)*31; \
        _Pragma("unroll") for(int r=0;r<16;++r){ const int o_=(r&3)+8*(r>>2); \
          const float b0_=bp_[o_], b1_=bp_[o_+32]; \
          P0[r]=((unsigned)(kcb+o_)<16u)?P0[r]+b0_:-INFINITY; P1[r]=((unsigned)(kcb+o_+32)<16u)?P1[r]+b1_:-INFINITY; } } } }while(0)
  bool resc=false;
  #define START(P0,P1) do{ const float rm=rowmax(P0,P1); resc=false; \
    { const float dl=rm; mhat=fadd_s(mhat,dl); \
      _Pragma("unroll") for(int r=0;r<16;++r){P0[r]=fsub_s(P0[r],dl);P1[r]=fsub_s(P1[r],dl);} \
      _Pragma("unroll") for(int r=0;r<16;++r)negm[r]=-mhat; asm volatile("":"+v"(negm)); } \
    _Pragma("unroll") for(int r=0;r<16;++r)P0[r]=__builtin_amdgcn_exp2f(P0[r]); }while(0)
  #define RESC() do{ if(resc){ asm volatile("s_waitcnt lgkmcnt(0)":::"memory"); \
      _Pragma("unroll") for(int d_=0;d_<2;++d_) _Pragma("unroll") for(int r=0;r<16;++r)o[d_][r]*=wsf[crow(r,hi)]; } }while(0)
  f32x16 pA0,pA1,pB0,pB1;
  int sl_prev=0,sl_cur=0,sl_next=SLOTB;
  #define ROT() do{sl_prev=sl_cur;sl_cur=sl_next;sl_next=(sl_next==(NSLOT-1)*SLOTB)?0:sl_next+SLOTB;}while(0)
  DMA_K(2,2*SLOTB);
  WAIT_BAR(3);
  qkt(pA0,pA1,Kbase,qr,negm,r32,hi);asm volatile("s_nop 15\n\ts_nop 7":"+v"(pA0),"+v"(pA1));CMASK(pA0,pA1,0);
  START(pA0,pA1);
  _Pragma("unroll") for(int r=0;r<16;++r)pA1[r]=__builtin_amdgcn_exp2f(pA1[r]);
  WAIT_BAR(0);
  DMA_K(3,0);DMA_V(1,SLOTB);
  ROT();
  kload8(kf,kp0+sl_cur);
  WAIT_BAR(2);
  s16x4 vlo[8],vhi[8]; u32x4 pw0,pw1,pw2,pw3;
  #define PKW(P,B) cvtpk_s(P[B],P[B+1])
  #define PAF(k) __builtin_bit_cast(bf16x8,pw##k)
  #define VFR(i) (bf16x8){vlo[i][0],vlo[i][1],vlo[i][2],vlo[i][3],vhi[i][0],vhi[i][1],vhi[i][2],vhi[i][3]}
  #define PIN(x) asm volatile("":"+v"(x))
  #define MX3(a,b,c) __builtin_fmaxf(__builtin_fmaxf((a),(b)),(c))
  #define GAPA(MF,A0,A1,A2,A3,W0,W1,PW) do{ MF; sacc+=A0; sacc+=A1; sacc+=A2; sacc+=A3; PIN(sacc); W0; W1; PIN(PW); SBAR(); }while(0)
  #define EX(v) __builtin_amdgcn_exp2f(v)
  #define GAPB(MF,X,B) do{ MF; X[B]=EX(X[B]); X[B+1]=EX(X[B+1]); X[B+2]=EX(X[B+2]); X[B+3]=EX(X[B+3]); PIN(X); SBAR(); }while(0)
  #define VRD(i) do{ vlo[i]=vtr(vp_+(((i)>>2)*4096+((i)&3)*1024)); vhi[i]=vtr(vp_+(((i)>>2)*4096+((i)&3)*1024+512)); }while(0)
  #define KRD(G,j) do{ if(G){ kload2(kf,kp0+sl_next,j); SBAR(); } }while(0)
  #define STEP(C0,C1,P0,P1,t,GK,GV,GL) do{ SBAR(); \
    const lds_cptr vp_=vp0+sl_prev; \
    VRD(0); SBAR(); float sacc=(P0[0]+P0[1]); \
    GAPA(C0=__builtin_amdgcn_mfma_f32_32x32x16_bf16(kf[0],qr[0],negm,0,0,0), P0[2],P0[3],P0[4],P0[5],     pw0[0]=PKW(P0,0), pw0[1]=PKW(P0,2), pw0); \
    VRD(4); SBAR(); GAPA(C1=__builtin_amdgcn_mfma_f32_32x32x16_bf16(kf[1],qr[0],negm,0,0,0), P0[6],P0[7],P0[8],P0[9],     pw0[2]=PKW(P0,4), pw0[3]=PKW(P0,6), pw0); \
    VRD(1); SBAR(); GAPA(C0=__builtin_amdgcn_mfma_f32_32x32x16_bf16(kf[2],qr[1],C0,0,0,0),   P0[10],P0[11],P0[12],P0[13], pw1[0]=PKW(P0,8), pw1[1]=PKW(P0,10), pw1); \
    VRD(5); SBAR(); GAPA(C1=__builtin_amdgcn_mfma_f32_32x32x16_bf16(kf[3],qr[1],C1,0,0,0),   P0[14],P0[15],P1[0],P1[1],   pw1[2]=PKW(P0,12),pw1[3]=PKW(P0,14), pw1); \
    VRD(2); SBAR(); GAPA(C0=__builtin_amdgcn_mfma_f32_32x32x16_bf16(kf[4],qr[2],C0,0,0,0),   P1[2],P1[3],P1[4],P1[5],     pw2[0]=PKW(P1,0), pw2[1]=PKW(P1,2), pw2); \
    VRD(6); SBAR(); GAPA(C1=__builtin_amdgcn_mfma_f32_32x32x16_bf16(kf[5],qr[2],C1,0,0,0),   P1[6],P1[7],P1[8],P1[9],     pw2[2]=PKW(P1,4), pw2[3]=PKW(P1,6), pw2); \
    VRD(3); SBAR(); GAPA(C0=__builtin_amdgcn_mfma_f32_32x32x16_bf16(kf[6],qr[3],C0,0,0,0),   P1[10],P1[11],P1[12],P1[13], pw3[0]=PKW(P1,8), pw3[1]=PKW(P1,10), pw3); \
    VRD(7); SBAR(); GAPA(C1=__builtin_amdgcn_mfma_f32_32x32x16_bf16(kf[7],qr[3],C1,0,0,0),   P1[14],P1[15],0.f,0.f,       pw3[2]=PKW(P1,12),pw3[3]=PKW(P1,14), pw3); \
    l_reg+=sacc; \
    if(GK){DMA_K((t)+3,sl_cur);} if(GV){DMA_V((t)+1,sl_next);} \
    CMASK(C0,C1,t); \
    { float a=MX3(C0[0],C0[1],C1[0]),b=MX3(C0[2],C0[3],C1[1]); a=MX3(a,C1[2],C1[3]); \
      _Pragma("unroll") for(int r=4;r<16;r+=4){a=MX3(a,C0[r],C0[r+1]);b=MX3(b,C0[r+2],C0[r+3]);a=MX3(a,C1[r],C1[r+1]);b=MX3(b,C1[r+2],C1[r+3]);} \
      float rm=__builtin_fmaxf(a,b); { auto rr=__builtin_amdgcn_permlane32_swap(__float_as_uint(rm),__float_as_uint(rm),false,false); rm=__builtin_fmaxf(__uint_as_float(rr[0]),__uint_as_float(rr[1])); } \
      resc=false; \
      if(__builtin_expect(__any(rm>(float)THRL),0)){ const float dl=__builtin_fmaxf(rm,0.f); mhat+=dl; \
        _Pragma("unroll") for(int r=0;r<16;++r){C0[r]-=dl;C1[r]-=dl;} \
        _Pragma("unroll") for(int r=0;r<16;++r)negm[r]=-mhat; asm volatile("":"+v"(negm)); \
        const float f=__builtin_amdgcn_exp2f(-dl); l_reg*=f; if(hi==0)wsf[r32]=f; resc=true; } } \
    SBAR(); \
    GAPB(o[0]=__builtin_amdgcn_mfma_f32_32x32x16_bf16(PAF(0),VFR(0),o[0],0,0,0), C0,0); \
    GAPB(o[1]=__builtin_amdgcn_mfma_f32_32x32x16_bf16(PAF(0),VFR(4),o[1],0,0,0), C0,4); \
    KRD(GL,0); GAPB(o[0]=__builtin_amdgcn_mfma_f32_32x32x16_bf16(PAF(1),VFR(1),o[0],0,0,0), C0,8); \
    KRD(GL,1); GAPB(o[1]=__builtin_amdgcn_mfma_f32_32x32x16_bf16(PAF(1),VFR(5),o[1],0,0,0), C0,12); \
    KRD(GL,2); GAPB(o[0]=__builtin_amdgcn_mfma_f32_32x32x16_bf16(PAF(2),VFR(2),o[0],0,0,0), C1,0); \
    KRD(GL,3); GAPB(o[1]=__builtin_amdgcn_mfma_f32_32x32x16_bf16(PAF(2),VFR(6),o[1],0,0,0), C1,4); \
    GAPB(o[0]=__builtin_amdgcn_mfma_f32_32x32x16_bf16(PAF(3),VFR(3),o[0],0,0,0), C1,8); \
    GAPB(o[1]=__builtin_amdgcn_mfma_f32_32x32x16_bf16(PAF(3),VFR(7),o[1],0,0,0), C1,12); \
    }while(0)
  int t=1;
  for(;t+5<NT;t+=2){
    STEP(pB0,pB1,pA0,pA1,t,true,true,true);     WAIT_BAR(2); RESC(); ROT();
    STEP(pA0,pA1,pB0,pB1,t+1,true,true,true);   WAIT_BAR(2); RESC(); ROT();
  }
  #define ENDW(tt) do{ if((tt)+3<NT){WAIT_BAR(2);} else if((tt)+2<NT){WAIT_BAR(1);} else {WAIT_BAR(0);} }while(0)
  for(;t+1<NT;t+=2){
    STEP(pB0,pB1,pA0,pA1,t,(t+3<NT),(t+1<NT),(t+1<NT));       ENDW(t);   RESC(); ROT();
    STEP(pA0,pA1,pB0,pB1,t+1,(t+4<NT),(t+2<NT),(t+2<NT));     ENDW(t+1); RESC(); ROT();
  }
  STEP(pB0,pB1,pA0,pA1,NT-1,false,false,false); RESC();
  { float sacc=pB0[0]+pB0[1]; _Pragma("unroll") for(int r=2;r<16;++r)sacc+=pB0[r]; _Pragma("unroll") for(int r=0;r<16;++r)sacc+=pB1[r]; l_reg+=sacc;
    pw0=(u32x4){PKW(pB0,0),PKW(pB0,2),PKW(pB0,4),PKW(pB0,6)};pw1=(u32x4){PKW(pB0,8),PKW(pB0,10),PKW(pB0,12),PKW(pB0,14)};pw2=(u32x4){PKW(pB1,0),PKW(pB1,2),PKW(pB1,4),PKW(pB1,6)};pw3=(u32x4){PKW(pB1,8),PKW(pB1,10),PKW(pB1,12),PKW(pB1,14)};
    SBAR(); pv(o,vb0+sl_cur,PAF(0),PAF(1),PAF(2),PAF(3)); }
  #undef PKW
  #undef PAF
  #undef VFR
  #undef PIN
  #undef MX3
  #undef GAPA
  #undef GAPB
  #undef EX
  #undef VRD
  #undef KRD
  #undef STEP
  #undef ENDW
  {auto rr=__builtin_amdgcn_permlane32_swap(__float_as_uint(l_reg),__float_as_uint(l_reg),false,false);l_reg=__uint_as_float(rr[0])+__uint_as_float(rr[1]);}
  if(hi==0)wsf[32+r32]=l_reg;asm volatile("s_waitcnt lgkmcnt(0)":::"memory");
  float rli[16];
  #pragma unroll
  for(int r=0;r<16;++r)rli[r]=__builtin_amdgcn_rcpf(wsf[32+crow(r,hi)]);
  bf16*Ow=Ow0+(long)(wid*QBLK)*OP;
  { bf16*stg=(bf16*)(shm+LDS_OST)+wid*2048;
    #pragma unroll
    for(int r=0;r<16;++r){const int orow=crow(r,hi);
      #pragma unroll
      for(int d0=0;d0<2;++d0)stg[orow*64+d0*32+r32]=__float2bfloat16(o[d0][r]*rli[r]);}
    asm volatile("s_waitcnt lgkmcnt(0)":::"memory");
    #pragma unroll
    for(int i=0;i<4;++i){const int row=i*8+(lane>>3),ch=lane&7; const u32x4 v=*(const u32x4*)(stg+row*64+ch*8); ATTN_STORE16(Ow+(long)row*OP+ch*8,v);} }
  asm volatile("s_waitcnt lgkmcnt(0)\n\ts_barrier":::"memory");
  #undef DMA_K
  #undef TROW
  #undef DMA_V
  #undef CMASK
  #undef START
  #undef RESC
  #undef ROT
}
constexpr int ATTN_LDS_BYTES=LDS_BYTES;
#undef SBAR
#undef WAIT_BAR
}
typedef float f32x2 __attribute__((ext_vector_type(2)));
__device__ __forceinline__ int scan_tok(int p, int dir) { return p < CTXL ? (dir ? CTXL - 1 - p : p) : (dir ? (T + CTXL - 1) - p : p); }

constexpr int CS_NCH = T / 16;
constexpr size_t WS_W1F = WS_H;
typedef float f32x16 __attribute__((ext_vector_type(16)));
typedef __bf16 bf16x2_t __attribute__((ext_vector_type(2)));
__device__ __forceinline__ unsigned cvtpk(float lo, float hi) { f32x2 v = {lo, hi}; bf16x2_t b = __builtin_convertvector(v, bf16x2_t); return __builtin_bit_cast(unsigned, b); }
__device__ __forceinline__ bf16x8 pack8f(float a0, float a1, float a2, float a3, float a4, float a5, float a6, float a7) {
    u32x4 w; w.x = cvtpk(a0, a1); w.y = cvtpk(a2, a3); w.z = cvtpk(a4, a5); w.w = cvtpk(a6, a7); return __builtin_bit_cast(bf16x8, w);
}
#define MF4(a, b, c) __builtin_amdgcn_mfma_f32_16x16x4f32((a), (b), (c), 0, 0, 0)

constexpr int PB_BK = 0, PB_AR = 4608, PB_CM = 9216, PB_EM = PB_CM + 16 * 17 * 4, PB_TM = PB_EM + 16 * 20 * 4, PB_P15 = PB_TM + 16 * 20 * 4, PB_BYTES = PB_P15 + 256;
constexpr int PBS = 72;
static_assert(8 * PB_BYTES <= RING_BYTES, "pre-pass LDS");
struct PPIn { float rr[16], kb[16], ww[16], as[16]; };
__device__ __forceinline__ void prepass_load(Frame& F, PPIn& I, int rec, int lane) {
    const int ch = rec / CS_NCH, c = rec % CS_NCH, b = ch >> 3, h = (ch >> 1) & 3, dir = ch & 1;
    const bf16* R32 = WSP(bf16, WS_R32); const bf16* DEC = WSP(bf16, WS_DEC) + (size_t)dir * M * 256; const bf16* ASIG = WSP(bf16, WS_ASIG) + (size_t)dir * M * 256;
    const int t0 = scan_tok(c * 16, dir); const int stp = dir ? -1 : 1;
#pragma unroll
    for (int t = 0; t < 16; ++t) { const size_t m = (size_t)b * T + (t0 + stp * t);
        I.rr[t] = bf2f(R32[m * 768 + h * 64 + lane]); I.kb[t] = bf2f(R32[m * 768 + 256 + h * 64 + lane]); I.ww[t] = bf2f(DEC[m * 256 + h * 64 + lane]); I.as[t] = bf2f(ASIG[m * 256 + h * 64 + lane]); }
}
__device__ __forceinline__ float bfu(unsigned short v) { return __builtin_bit_cast(float, (unsigned)v << 16); }
__device__ __forceinline__ void prepass_record(Frame& F, int l, int rec, LAS unsigned char* L, int lane, const PPIn& I) {
    const int ch = rec / CS_NCH, h = (ch >> 1) & 3;
    const int c = lane & 31, hh = lane >> 5;
    bf16* W1F = WSP(bf16, WS_W1F) + (size_t)rec * 2048; bf16* W2F = (bf16*)F.out + (size_t)rec * 3200; float* P15F = F.out + (size_t)rec * 1600 + 1536;
    LAS bf16* BK = (LAS bf16*)(L + PB_BK); LAS bf16* AR = (LAS bf16*)(L + PB_AR);
    LAS float* Cm = (LAS float*)(L + PB_CM); LAS float* Em = (LAS float*)(L + PB_EM); LAS float* Tm = (LAS float*)(L + PB_TM); LAS float* P15 = (LAS float*)(L + PB_P15);
    {
        const float kkw = F.in[I_KK][l * 256 + h * 64 + lane], kaw = F.in[I_KA][l * 256 + h * 64 + lane];
        float P = 1.f;
#pragma unroll
        for (int t = 0; t < 16; ++t) {
            const float r_ = I.rr[t], kb_ = I.kb[t], w_ = __expf(-I.ww[t]), as_ = I.as[t];
            float kk_ = kb_ * kkw; kk_ = kk_ * __builtin_amdgcn_rsqf(fmaxf(wave_sum(kk_ * kk_), 1e-24f));
            const float kd_ = kb_ * (1.f + (as_ - 1.f) * kaw);
            const float Pm = P; P *= w_; const float iP = __builtin_amdgcn_rcpf(P);
            AR[t * PBS + lane] = (bf16)f2bf(-kk_ * Pm); AR[(16 + t) * PBS + lane] = (bf16)f2bf(r_ * P);
            BK[t * PBS + lane] = (bf16)f2bf(kk_ * as_ * iP); BK[(16 + t) * PBS + lane] = (bf16)f2bf(kd_ * iP);
        }
        P15[lane] = P;
    }
    LDS_WAIT(); asm volatile("" ::: "memory");
#pragma unroll
    for (int ks = 0; ks < 4; ++ks) {
        const LAS bf16* src = AR + c * PBS + 16 * ks + 4 * hh;
        const u32x2 lo = *(const LAS u32x2*)src, hi = *(const LAS u32x2*)(src + 8);
        *(u32x4*)(W1F + (ks * 64 + lane) * 8) = (u32x4){lo.x, lo.y, hi.x, hi.y};
    }
    f32x16 Gm;
#pragma unroll
    for (int r = 0; r < 16; ++r) Gm[r] = 0.f;
#pragma unroll
    for (int ks = 0; ks < 4; ++ks)
        Gm = __builtin_amdgcn_mfma_f32_32x32x16_bf16(*(const LAS bf16x8*)(BK + c * PBS + 16 * ks + 8 * hh), *(const LAS bf16x8*)(AR + c * PBS + 16 * ks + 8 * hh), Gm, 0, 0, 0);
    {
        const int t = c & 15;
#pragma unroll
        for (int r = 0; r < 16; ++r) { const int s = (r & 3) + 8 * ((r & 7) >> 2) + 4 * hh; const bool keep = (c < 16) ? (s < t) : (s <= t); if (!keep) Gm[r] = 0.f; }
        if (c < 16) {
#pragma unroll
            for (int r = 0; r < 8; ++r) { const int s = (r & 3) + 8 * (r >> 2) + 4 * hh; Cm[s * 17 + t] = Gm[r]; Em[s * 20 + t] = Gm[8 + r]; }
        }
    }
    LDS_WAIT(); asm volatile("" ::: "memory");
    {
        const int rho = lane & 15;
        float x[16];
#pragma unroll
        for (int t = 0; t < 16; ++t) { float acc = (rho == t) ? 1.f : 0.f;
#pragma unroll
            for (int s = 0; s < t; ++s) acc += x[s] * Cm[s * 17 + t];
            x[t] = acc; }
        if (lane < 16) {
#pragma unroll
            for (int q = 0; q < 4; ++q) *(LAS f32x4*)(Tm + rho * 20 + 4 * q) = (f32x4){x[4 * q], x[4 * q + 1], x[4 * q + 2], x[4 * q + 3]}; }
    }
    LDS_WAIT(); asm volatile("" ::: "memory");
    bf16x8 A2;
    {
        float ta[8];
#pragma unroll
        for (int jj = 0; jj < 8; ++jj) ta[jj] = (c < 16) ? Tm[((jj & 3) + 8 * (jj >> 2) + 4 * hh) * 20 + c] : 0.f;
        const bf16x8 Aet = pack8f(ta[0], ta[1], ta[2], ta[3], ta[4], ta[5], ta[6], ta[7]);
        f32x4 e0 = (f32x4){0.f, 0.f, 0.f, 0.f}, e1 = e0, t0 = e0, t1 = e0;
        if (c >= 16) { e0 = *(const LAS f32x4*)(Em + (c - 16) * 20 + 4 * hh); e1 = *(const LAS f32x4*)(Em + (c - 16) * 20 + 8 + 4 * hh); }
        else { t0 = *(const LAS f32x4*)(Tm + c * 20 + 4 * hh); t1 = *(const LAS f32x4*)(Tm + c * 20 + 8 + 4 * hh); }
        const bf16x8 Bet = pack8f(e0[0], e0[1], e0[2], e0[3], e1[0], e1[1], e1[2], e1[3]);
        f32x16 Z;
#pragma unroll
        for (int r = 0; r < 16; ++r) Z[r] = 0.f;
        const f32x16 Dt = __builtin_amdgcn_mfma_f32_32x32x16_bf16(Aet, Bet, Z, 0, 0, 0);
        A2 = (c >= 16) ? pack8f(Dt[0], Dt[1], Dt[2], Dt[3], Dt[4], Dt[5], Dt[6], Dt[7]) : pack8f(t0[0], t0[1], t0[2], t0[3], t1[0], t1[1], t1[2], t1[3]);
    }
    {
        const bf16x8 Bm = pack8f(Gm[0], Gm[1], Gm[2], Gm[3], Gm[4], Gm[5], Gm[6], Gm[7]);
        const bf16x8 Bz = pack8f(0.f, 0.f, 0.f, 0.f, 0.f, 0.f, 0.f, 0.f);
        f32x16 Ci;
#pragma unroll
        for (int r = 0; r < 16; ++r) Ci[r] = (r >= 8 && c >= 16) ? Gm[r] : 0.f;
        const f32x16 Dm = __builtin_amdgcn_mfma_f32_32x32x16_bf16(A2, (c >= 16) ? Bm : Bz, Ci, 0, 0, 0);
        *(bf16x8*)(W2F + (0 * 64 + lane) * 8) = pack8f(Dm[0], Dm[1], Dm[2], Dm[3], Dm[4], Dm[5], Dm[6], Dm[7]);
        *(bf16x8*)(W2F + (1 * 64 + lane) * 8) = pack8f(Dm[8], Dm[9], Dm[10], Dm[11], Dm[12], Dm[13], Dm[14], Dm[15]);
    }
#pragma unroll
    for (int nt = 0; nt < 2; ++nt) {
        float bb[8]; f32x16 Ci;
#pragma unroll
        for (int jj = 0; jj < 8; ++jj) { const int kap = (jj & 3) + 8 * (jj >> 2) + 4 * hh;
            bb[jj] = bfu(BK[kap * PBS + 32 * nt + c]); Ci[jj] = 0.f; Ci[8 + jj] = bfu(BK[(16 + kap) * PBS + 32 * nt + c]); }
        const f32x16 Dn = __builtin_amdgcn_mfma_f32_32x32x16_bf16(A2, pack8f(bb[0], bb[1], bb[2], bb[3], bb[4], bb[5], bb[6], bb[7]), Ci, 0, 0, 0);
        const float p = P15[32 * nt + c];
        *(bf16x8*)(W2F + ((2 + 2 * nt) * 64 + lane) * 8) = pack8f(Dn[0] * p, Dn[1] * p, Dn[2] * p, Dn[3] * p, Dn[4] * p, Dn[5] * p, Dn[6] * p, Dn[7] * p);
        *(bf16x8*)(W2F + ((3 + 2 * nt) * 64 + lane) * 8) = pack8f(Dn[8] * p, Dn[9] * p, Dn[10] * p, Dn[11] * p, Dn[12] * p, Dn[13] * p, Dn[14] * p, Dn[15] * p);
    }
    { const int blk = c >> 4, reg = c & 15; P15F[lane] = P15[32 * blk + (reg & 3) + 8 * (reg >> 2) + 4 * hh]; }
    LDS_WAIT(); asm volatile("" ::: "memory");
}
__device__ __forceinline__ void phase_prepass(Frame& F, int l) {
    int lane = LANE_; asm volatile("" : "+v"(lane));
    LAS unsigned char* L = F.lds + F.wave * PB_BYTES;
    int rec = F.vcu * NWAVES + F.wave; const int stride = F.G * NWAVES;
    PPIn I; if (rec < 64 * CS_NCH) prepass_load(F, I, rec, lane);
    for (; rec < 64 * CS_NCH; rec += stride) {
        PPIn Nx = I; if (rec + stride < 64 * CS_NCH) prepass_load(F, Nx, rec + stride, lane);
        prepass_record(F, l, rec, L, lane, I);
        I = Nx;
    }
}

constexpr int CS_REC = 4096 + 6144 + 256 + 2048, CS_SLOTS = 8, CS_LEAD = 6, CS_NP = 13;
__device__ __forceinline__ void scan_chunked(Frame& F, int ch, int l) {
    int lane = LANE_; asm volatile("" : "+v"(lane));
    const int wave = F.wave, b = ch >> 3, h = (ch >> 1) & 3, dir = ch & 1, hh = lane >> 5, icol = 32 * (wave & 1) + (lane & 31);
    float* YD = WSP(float, WS_YD) + (size_t)dir * M * 256;
    const bf16* R32 = WSP(bf16, WS_R32);
    LAS unsigned char* ring = F.lds;
    u32x4 st[CS_NP];
    const int hw = wave - 2;
#define CS_SRC(cc, q) ({ const int rec_ = ch * CS_NCH + (cc); const u32x4* r_; \
        if ((q) < 4) r_ = (const u32x4*)(WSP(bf16, WS_W1F) + (size_t)rec_ * 2048) + lane + (q) * 64; \
        else if ((q) < 10) r_ = (const u32x4*)((const unsigned char*)F.out + (size_t)rec_ * 6400) + lane + ((q) - 4) * 64; \
        else { const int p = (q) * 64 + lane; const int pv = min(max(p - 656, 0), 127); \
            const u32x4* sv_ = (const u32x4*)(R32 + ((size_t)b * T + scan_tok((cc) * 16 + (pv >> 3), dir)) * 768 + 512 + h * 64) + (pv & 7); \
            r_ = ((q) == 10 && lane < 16) ? (const u32x4*)((const unsigned char*)F.out + (size_t)rec_ * 6400) + lane + 384 : sv_; } \
        r_; })
#define CS_ISSUE1(cc, q) do { st[q] = *CS_SRC(cc, q); } while (0)
#define CS_WRITE1(cc, q) do { const int p = (q) * 64 + lane; if ((q) < 12 || p < 784) ((LAS u32x4*)(ring + ((cc) % CS_SLOTS) * CS_REC))[p] = st[q]; } while (0)
#define CS_ISSUE(cc) do { _Pragma("unroll") for (int q = 0; q < CS_NP; ++q) CS_ISSUE1(cc, q); } while (0)
#define CS_WRITE(cc) do { _Pragma("unroll") for (int q = 0; q < CS_NP; ++q) CS_WRITE1(cc, q); } while (0)
#define CS_STEP(wc, q) do { CS_WRITE1(wc, q); if ((wc) + 6 < CS_NCH) CS_ISSUE1((wc) + 6, q); } while (0)
#define CS_BAR() do { asm volatile("s_waitcnt lgkmcnt(0)" ::: "memory"); __builtin_amdgcn_s_barrier(); asm volatile("" ::: "memory"); } while (0)
    if (wave >= 2) {
        CS_ISSUE(hw); CS_WRITE(hw);
        if (hw == 0) { CS_ISSUE(6); CS_WRITE(6); }
        { const int wc1 = (hw == 0) ? 12 : hw + 6; CS_ISSUE(wc1); }
        CS_BAR();
        int c = 0; const int c0 = (hw + 5) % 6;
        for (; c < c0; ++c) CS_BAR();
        for (; c + 6 <= CS_NCH; c += 6) {
            const int wc = c + 7;
            if (wc < CS_NCH) {
                CS_STEP(wc, 0); CS_STEP(wc, 1); CS_STEP(wc, 2); CS_BAR();
                CS_STEP(wc, 3); CS_STEP(wc, 4); CS_BAR();
                CS_STEP(wc, 5); CS_STEP(wc, 6); CS_BAR();
                CS_STEP(wc, 7); CS_STEP(wc, 8); CS_BAR();
                CS_STEP(wc, 9); CS_STEP(wc, 10); CS_BAR();
                CS_STEP(wc, 11); CS_STEP(wc, 12); CS_BAR();
            } else { CS_BAR(); CS_BAR(); CS_BAR(); CS_BAR(); CS_BAR(); CS_BAR(); }
        }
        for (; c < CS_NCH; ++c) CS_BAR();
    } else {
        f32x16 X0, X1;
#pragma unroll
        for (int r = 0; r < 16; ++r) { X0[r] = 0.f; X1[r] = 0.f; }
        CS_BAR();
        bf16x8 w1[4], w2[6]; f32x4 p15[8]; unsigned vv[8];
#define CS_RD(cc) do { const LAS unsigned char* rec_ = ring + ((cc) % CS_SLOTS) * CS_REC; \
            _Pragma("unroll") for (int k = 0; k < 4; ++k) w1[k] = ((const LAS bf16x8*)rec_)[k * 64 + lane]; \
            _Pragma("unroll") for (int k = 0; k < 6; ++k) w2[k] = ((const LAS bf16x8*)(rec_ + 4096))[k * 64 + lane]; \
            _Pragma("unroll") for (int k = 0; k < 8; ++k) p15[k] = ((const LAS f32x4*)(rec_ + 10240 + hh * 128))[k]; \
            _Pragma("unroll") for (int jj = 0; jj < 8; ++jj) vv[jj] = ((const LAS bf16*)(rec_ + 10496))[(8 * (jj >> 2) + 4 * hh + (jj & 3)) * 64 + icol]; } while (0)
        CS_RD(0);
        for (int c = 0; c < CS_NCH; ++c) {
            f32x16 G;
#pragma unroll
            for (int r = 0; r < 16; ++r) G[r] = 0.f;
            G = __builtin_amdgcn_mfma_f32_32x32x16_bf16(w1[0], pack8f(X0[0], X0[1], X0[2], X0[3], X0[4], X0[5], X0[6], X0[7]), G, 0, 0, 0);
            G = __builtin_amdgcn_mfma_f32_32x32x16_bf16(w1[1], pack8f(X0[8], X0[9], X0[10], X0[11], X0[12], X0[13], X0[14], X0[15]), G, 0, 0, 0);
            G = __builtin_amdgcn_mfma_f32_32x32x16_bf16(w1[2], pack8f(X1[0], X1[1], X1[2], X1[3], X1[4], X1[5], X1[6], X1[7]), G, 0, 0, 0);
            G = __builtin_amdgcn_mfma_f32_32x32x16_bf16(w1[3], pack8f(X1[8], X1[9], X1[10], X1[11], X1[12], X1[13], X1[14], X1[15]), G, 0, 0, 0);
            const bf16x8 g1 = pack8f(G[0], G[1], G[2], G[3], G[4], G[5], G[6], G[7]);
            const bf16x8 vf = __builtin_bit_cast(bf16x8, (u32x4){vv[0] | (vv[1] << 16), vv[2] | (vv[3] << 16), vv[4] | (vv[5] << 16), vv[6] | (vv[7] << 16)});
            f32x16 Y = __builtin_amdgcn_mfma_f32_32x32x16_bf16(w2[0], g1, G, 0, 0, 0);
            Y = __builtin_amdgcn_mfma_f32_32x32x16_bf16(w2[1], vf, Y, 0, 0, 0);
#pragma unroll
            for (int k = 0; k < 4; ++k) {
#pragma unroll
                for (int e = 0; e < 4; ++e) { X0[4 * k + e] *= p15[k][e]; X1[4 * k + e] *= p15[4 + k][e]; } }
            X0 = __builtin_amdgcn_mfma_f32_32x32x16_bf16(w2[2], g1, X0, 0, 0, 0);
            X0 = __builtin_amdgcn_mfma_f32_32x32x16_bf16(w2[3], vf, X0, 0, 0, 0);
            X1 = __builtin_amdgcn_mfma_f32_32x32x16_bf16(w2[4], g1, X1, 0, 0, 0);
            X1 = __builtin_amdgcn_mfma_f32_32x32x16_bf16(w2[5], vf, X1, 0, 0, 0);
            if (c + 1 < CS_NCH) CS_RD(c + 1);
            {
                float* yp = YD + ((size_t)b * T + scan_tok(c * 16, dir)) * 256 + h * 64 + icol + (dir ? -4 * hh * 256 : 4 * hh * 256);
                const int st = dir ? -256 : 256;
#pragma unroll
                for (int r = 8; r < 16; ++r) yp[((r & 3) + 8 * ((r >> 2) - 2)) * st] = Y[r];
            }
            asm volatile("" ::: "memory"); __builtin_amdgcn_s_barrier(); asm volatile("" ::: "memory");
        }
#undef CS_RD
    }
#undef CS_BAR
#undef CS_ISSUE
#undef CS_ISSUE1
#undef CS_WRITE1
#undef CS_STEP
#undef CS_SRC
#undef CS_WRITE
    __syncthreads();
}

constexpr int SC_TC = 16, SC_STEP = 6 * 64, SC_BUF = SC_TC * SC_STEP;
constexpr int SC_YOFF = 2 * SC_BUF, SC_DUMMY = SC_YOFF + 2 * SC_TC * 64;
#if GOLD_ATTN
__device__ __forceinline__ void attn_ref_unit(Frame& F, int mode, int qrow0, int qcol, int krow0, int nkeys, int kcol, int vcol, int ocol,
                                              int rb, const float* rpbh) {
    const int tid = TID_, q = tid & 255, dh = tid >> 8;
    const bf16* QKV = WSP(bf16, WS_QKV); bf16* O = WSP(bf16, WS_O);
    const int gr = 4 * rb + (q >> 6), gc = q & 63;
    const size_t qrow = (size_t)qrow0 + q;
    float qv[64], o[32];
#pragma unroll
    for (int d8 = 0; d8 < 8; ++d8) { const u32x4 w = *(const u32x4*)(QKV + qrow * 1536 + qcol + 8 * d8);
        qv[8 * d8 + 0] = bflo(w.x); qv[8 * d8 + 1] = bfhi(w.x); qv[8 * d8 + 2] = bflo(w.y); qv[8 * d8 + 3] = bfhi(w.y);
        qv[8 * d8 + 4] = bflo(w.z); qv[8 * d8 + 5] = bfhi(w.z); qv[8 * d8 + 6] = bflo(w.w); qv[8 * d8 + 7] = bfhi(w.w); }
#pragma unroll
    for (int d = 0; d < 32; ++d) o[d] = 0.f;
    float mrun = -1e30f, lrun = 0.f;
    const int kend = mode == 0 ? nkeys : 128 + CTXL;
    const int rs = min(max(gr - 4, 0), 32 - 8), cs = min(max(gc - 8, 0), 64 - 16);
    for (int kk = 0; kk < kend; ++kk) {
        size_t krow; float bias = 0.f;
        if (mode == 0) krow = (size_t)krow0 + kk;
        else if (kk < 128) { const int kr = rs + (kk >> 4), kc = cs + (kk & 15); krow = (size_t)krow0 + CTXL + kr * 64 + kc; bias = rpbh[(kr - gr + 7) * 31 + (kc - gc + 15)] * LOG2E; }
        else krow = (size_t)krow0 + (kk - 128);
        float s = bias;
#pragma unroll
        for (int d8 = 0; d8 < 8; ++d8) { const u32x4 w = *(const u32x4*)(QKV + krow * 1536 + kcol + 8 * d8);
            s += qv[8 * d8 + 0] * bflo(w.x) + qv[8 * d8 + 1] * bfhi(w.x) + qv[8 * d8 + 2] * bflo(w.y) + qv[8 * d8 + 3] * bfhi(w.y)
               + qv[8 * d8 + 4] * bflo(w.z) + qv[8 * d8 + 5] * bfhi(w.z) + qv[8 * d8 + 6] * bflo(w.w) + qv[8 * d8 + 7] * bfhi(w.w); }
        const float mn = fmaxf(mrun, s), al = exp2f(mrun - mn), p = exp2f(s - mn);
        lrun = lrun * al + p; mrun = mn;
#pragma unroll
        for (int d8 = 0; d8 < 4; ++d8) { const u32x4 w = *(const u32x4*)(QKV + krow * 1536 + vcol + 32 * dh + 8 * d8);
            o[8 * d8 + 0] = o[8 * d8 + 0] * al + p * bflo(w.x); o[8 * d8 + 1] = o[8 * d8 + 1] * al + p * bfhi(w.x);
            o[8 * d8 + 2] = o[8 * d8 + 2] * al + p * bflo(w.y); o[8 * d8 + 3] = o[8 * d8 + 3] * al + p * bfhi(w.y);
            o[8 * d8 + 4] = o[8 * d8 + 4] * al + p * bflo(w.z); o[8 * d8 + 5] = o[8 * d8 + 5] * al + p * bfhi(w.z);
            o[8 * d8 + 6] = o[8 * d8 + 6] * al + p * bflo(w.w); o[8 * d8 + 7] = o[8 * d8 + 7] * al + p * bfhi(w.w); }
    }
    const float li = 1.f / lrun;
#pragma unroll
    for (int d8 = 0; d8 < 4; ++d8) { u32x4 w;
        w.x = pk2(o[8 * d8 + 0] * li, o[8 * d8 + 1] * li); w.y = pk2(o[8 * d8 + 2] * li, o[8 * d8 + 3] * li);
        w.z = pk2(o[8 * d8 + 4] * li, o[8 * d8 + 5] * li); w.w = pk2(o[8 * d8 + 6] * li, o[8 * d8 + 7] * li);
        *(u32x4*)(O + qrow * 1024 + ocol + 32 * dh + 8 * d8) = w; }
}
#endif
__device__ __forceinline__ void attn_item(Frame& F, int item, int l) {
    const float* rpb = F.in[I_RPB] + (size_t)l * 4 * 15 * 31;
    int mode = 0, qrow0, qcol, krow0, nkeys, kcol, vcol, ocol, rb = 0;
    if (item < 512) { const int b = item >> 6, h = (item >> 3) & 7, qb = item & 7;
        qrow0 = b * T + CTXL + qb * 256; qcol = h * 64; krow0 = b * T; nkeys = T; kcol = 512 + (h >> 2) * 64; vcol = 640 + (h >> 2) * 64; ocol = h * 64; }
    else if (item < 768) { const int it = item - 512, b = it >> 5, h = (it >> 3) & 3; rb = it & 7; mode = 1;
        qrow0 = b * T + CTXL + rb * 256; qcol = 768 + h * 64; krow0 = b * T; nkeys = 0; kcol = 1024 + h * 64; vcol = 1280 + h * 64; ocol = 768 + h * 64; rpb += h * 15 * 31; }
    else if (item < 832) { const int it = item - 768, b = it >> 3, h = it & 7;
        qrow0 = b * T; qcol = h * 64; krow0 = b * T; nkeys = CTXL; kcol = 512 + (h >> 2) * 64; vcol = 640 + (h >> 2) * 64; ocol = h * 64; }
    else { const int it = item - 832, b = it >> 2, h = it & 3;
        qrow0 = b * T; qcol = 768 + h * 64; krow0 = b * T; nkeys = CTXL; kcol = 1024 + h * 64; vcol = 1280 + h * 64; ocol = 768 + h * 64; }
#if GOLD_ATTN
    attn_ref_unit(F, mode, qrow0, qcol, krow0, nkeys, kcol, vcol, ocol, rb, rpb);
#else
    const attn_body::bf16* QKV = (const attn_body::bf16*)WSP(bf16, WS_QKV); attn_body::bf16* O = (attn_body::bf16*)WSP(bf16, WS_O);
    const attn_body::bf16* Qw0 = QKV + (size_t)qrow0 * 1536 + qcol; const attn_body::bf16* Kh = QKV + (size_t)krow0 * 1536 + kcol; const attn_body::bf16* Vh = QKV + (size_t)krow0 * 1536 + vcol;
    attn_body::bf16* Ow0 = O + (size_t)qrow0 * 1024 + ocol;
    if (mode == 0) attn_body::attn_unit<8, false>(Qw0, Kh, Vh, Ow0, nkeys >> 6, 0, 0, 0, rpb, (char*)F.lds);
    else { const int rs0 = min(max(4 * rb - 4, 0), 24); attn_body::attn_unit<8, true>(Qw0, Kh, Vh, Ow0, (rb == 0 || rb == 7) ? 12 : 16, rs0, rb, rs0, rpb, (char*)F.lds); }
#endif
}
template <int NI> struct PostIn { float y[NI], r[NI], kb[NI], v[NI], as0[NI], as1[NI], gg[NI]; };
template <int NI> __device__ __forceinline__ void post_load(Frame& F, PostIn<NI>& P, int m0, int h, int lane) {
    const bf16* R32 = WSP(bf16, WS_R32); const bf16* ASIG = WSP(bf16, WS_ASIG); const float* YD = WSP(float, WS_YD); const bf16* Gb = WSP(bf16, WS_G);
    const int ch = h * 64 + lane;
#pragma unroll
    for (int k = 0; k < NI; ++k) { const size_t mm = (size_t)(m0 + k);
        P.y[k] = YD[mm * 256 + ch] + YD[((size_t)M + mm) * 256 + ch];
        P.r[k] = bf2f(R32[mm * 768 + ch]); P.kb[k] = bf2f(R32[mm * 768 + 256 + ch]); P.v[k] = bf2f(R32[mm * 768 + 512 + ch]);
        P.as0[k] = bf2f(ASIG[mm * 256 + ch]); P.as1[k] = bf2f(ASIG[((size_t)M + mm) * 256 + ch]); P.gg[k] = bf2f(Gb[mm * 256 + ch]); }
}
template <int NI> __device__ __forceinline__ void post_math(Frame& F, int l, const PostIn<NI>& P, int m0, int h, int lane) {
    bf16* O = WSP(bf16, WS_O);
    const int ch = h * 64 + lane;
    const float lw = F.in[I_LNXW][l * 256 + ch], lb = F.in[I_LNXB][l * 256 + ch], ka = F.in[I_KA][l * 256 + ch], rk = F.in[I_RK][l * 256 + ch];
#pragma unroll
    for (int k = 0; k < NI; ++k) {
        const float mu = wave_sum(P.y[k]) * (1.f / 64.f); const float dv = P.y[k] - mu; const float var = wave_sum(dv * dv) * (1.f / 64.f);
        const float yn = dv * rsqrtf(var + 64e-5f) * lw + lb;
        const float kd0 = P.kb[k] * (1.f + (P.as0[k] - 1.f) * ka), kd1 = P.kb[k] * (1.f + (P.as1[k] - 1.f) * ka);
        const float bon = wave_sum(P.r[k] * (kd0 + kd1) * rk) * P.v[k];
        O[(size_t)(m0 + k) * 1024 + 512 + ch] = (bf16)f2bf((yn + bon) * P.gg[k]);
    }
}
__device__ __forceinline__ void post_item(Frame& F, int l, int m, int h, int lane) { PostIn<1> P; post_load<1>(F, P, m, h, lane); post_math<1>(F, l, P, m, h, lane); }
constexpr int CW_SCDONE = 36864, CW_POSTQ = 37888;
__device__ __forceinline__ void phase_mixer(Frame& F, int l, int rep = 0) {
    if (F.vcu < 64) { scan_chunked(F, F.vcu, l);
        if (rep == 0) {
            asm volatile("s_waitcnt vmcnt(0)" ::: "memory"); __syncthreads();
            if (TID_ == 0) { __builtin_amdgcn_fence(__ATOMIC_RELEASE, "agent"); asm volatile("s_waitcnt vmcnt(0)" ::: "memory"); (void)xb_add(F.ctl + CW_SCDONE + 64 * l, 1u); }
        } }
    if (rep == 2) return;
    const int nattn = (l == NL - 1) ? 768 : 864;
    for (;;) {
        if (TID_ == 0) F.MISC[16] = atomicAdd(F.ctl + CW_QUEUE + 64 * (l + 2 * rep), 1u);
        __syncthreads();
        const int item = (int)F.MISC[16];
        __syncthreads();
        if (item >= nattn) break;
        attn_item(F, item, l);
    }
    if (rep == 0) {
        if (TID_ == 0) { unsigned sp = 0; while (xb_ld(F.ctl + CW_SCDONE + 64 * l) < 64u) { __builtin_amdgcn_s_sleep(2); if (++sp > (1u << 24)) break; }
            __builtin_amdgcn_fence(__ATOMIC_ACQUIRE, "agent"); asm volatile("s_waitcnt vmcnt(0)" ::: "memory"); }
        __syncthreads();
        const int t0 = (l == NL - 1) ? CTXL : 0, nchunk = (T - t0) / 64, nitem = 32 * nchunk, lane = LANE_;
        for (;;) {
            if (TID_ == 0) F.MISC[16] = atomicAdd(F.ctl + CW_POSTQ + 64 * l, 1u);
            __syncthreads();
            const int item = (int)F.MISC[16];
            __syncthreads();
            if (item >= nitem) break;
            const int bh = item / nchunk, ck = item % nchunk, m0 = (bh >> 2) * T + t0 + ck * 64 + 8 * F.wave;
            PostIn<8> P; post_load<8>(F, P, m0, bh & 3, lane); post_math<8>(F, l, P, m0, bh & 3, lane);
        }
    }
    cvt_moe_drain(F, l, 4);
}

__device__ __forceinline__ unsigned wave_incl_scan(unsigned v, int lane) {
#pragma unroll
    for (int o = 1; o < 64; o <<= 1) { const unsigned u = __shfl_up(v, o); if (lane >= o) v += u; }
    return v;
}
__device__ __forceinline__ void phase_topk(Frame& F, int l) {
    const int tid = TID_, lane = LANE_, wave = F.wave;
    LAS unsigned* hist = (LAS unsigned*)F.lds;
    LAS unsigned* ctrl = hist + 256;
    LAS unsigned* wsum = hist + 272;
    LAS int* stok = (LAS int*)(hist + 288);
    const float* AFF = WSP(float, WS_AFF); int* INV = WSP(int, WS_INV); float* SELG = WSP(float, WS_SELG); int* SELT = WSP(int, WS_SELT);
    const bf16* H2 = WSP(bf16, WS_H2); bf16* XE = WSP(bf16, WS_XE);
    const int nitems = (l == NL - 1) ? 128 : 256;
    for (int it = F.vcu; it < nitems; it += F.G) {
        const int seg = it >> 7, be = it & 127, b = be >> 4, e = be & 15;
        const int n = seg ? CTXL : SEQ, cap = n / 8, mbase = b * T + (seg ? 0 : CTXL);
        const int rowbase = e * MEXP + (seg ? 2048 + b * 32 : b * 256);
        unsigned key[4];
#pragma unroll
        for (int k = 0; k < 4; ++k) { const int i = 4 * tid + k; key[k] = (i < n) ? __float_as_uint(AFF[(size_t)(mbase + i) * 16 + e]) : 0u; }
        if (tid == 0) { ctrl[0] = 0u; ctrl[1] = (unsigned)cap; }
        unsigned prefix = 0u, pmask = 0u;
#pragma unroll 1
        for (int pass = 0; pass < 4; ++pass) {
            const int shift = 24 - 8 * pass;
            if (tid < 256) hist[tid] = 0u;
            __syncthreads();
#pragma unroll
            for (int k = 0; k < 4; ++k) if ((key[k] & pmask) == prefix && key[k] != 0u) __hip_atomic_fetch_add(&hist[(key[k] >> shift) & 255u], 1u, __ATOMIC_RELAXED, __HIP_MEMORY_SCOPE_WORKGROUP);
            __syncthreads();
            if (wave == 0) {
                const unsigned need = ctrl[1];
                unsigned c4[4]; unsigned tot = 0u;
#pragma unroll
                for (int k = 0; k < 4; ++k) { c4[k] = hist[255 - (4 * lane + k)]; tot += c4[k]; }
                const unsigned incl = wave_incl_scan(tot, lane); unsigned run = incl - tot;
#pragma unroll
                for (int k = 0; k < 4; ++k) { if (run < need && run + c4[k] >= need) { ctrl[0] = prefix | ((unsigned)(255 - (4 * lane + k)) << shift); ctrl[1] = need - run; } run += c4[k]; }
            }
            __syncthreads();
            prefix = ctrl[0]; pmask |= 255u << shift;
        }
        const unsigned thr = prefix, need_eq = ctrl[1];
        unsigned ngt = 0u, neq = 0u;
#pragma unroll
        for (int k = 0; k < 4; ++k) { ngt += key[k] > thr; neq += key[k] == thr; }
        const unsigned packed = ngt | (neq << 16);
        const unsigned incl = wave_incl_scan(packed, lane);
        if (lane == 63) wsum[wave] = incl;
        __syncthreads();
        unsigned base = 0u, total = 0u;
#pragma unroll
        for (int w = 0; w < NWAVES; ++w) { const unsigned s = wsum[w]; if (w < wave) base += s; total += s; }
        const unsigned excl = base + incl - packed;
        unsigned pgt = excl & 0xffffu, peq = excl >> 16; const unsigned cnt_gt = total & 0xffffu;
#pragma unroll
        for (int k = 0; k < 4; ++k) {
            int slot = -1;
            if (key[k] > thr) slot = (int)pgt++;
            else if (key[k] == thr) { if (peq < need_eq) slot = (int)(cnt_gt + peq); ++peq; }
            if (slot >= 0) { const int m = mbase + 4 * tid + k; stok[slot] = m;
                SELG[rowbase + slot] = __uint_as_float(key[k]); SELT[rowbase + slot] = m; INV[(size_t)m * 16 + e] = rowbase + slot; }
        }
        __syncthreads();
        for (int s0 = wave * 4; s0 < cap; s0 += NWAVES * 4) {
            u32x4 v[4][2];
#pragma unroll
            for (int k = 0; k < 4; ++k) { const int m = stok[s0 + k];
                const u32x4* src = (const u32x4*)(H2 + (size_t)m * 1024); v[k][0] = src[lane]; v[k][1] = src[64 + lane]; }
#pragma unroll
            for (int k = 0; k < 4; ++k) { u32x4* dst = (u32x4*)(XE + (size_t)(rowbase + s0 + k) * 1024); dst[lane] = v[k][0]; dst[64 + lane] = v[k][1]; }
        }
        __syncthreads();
    }
    cvt_moe_drain(F, l, 1);
}

constexpr int N_PHASES = 2 + 10 * NL;
#ifndef EN_MASK
#define EN_MASK 0xFFFFF
#endif
#define EN(k) ((EN_MASK >> (k)) & 1)
#define RUNPH(k, body) do { if (EN(k)) { body; if (REP(k)) { GBAR(); body; } } } while (0)
__global__ void __launch_bounds__(NTHREADS, 2) fwd_kernel(Args args) {
    extern __shared__ __attribute__((aligned(16))) unsigned char lds_raw[];
    cg::grid_group grid = cg::this_grid();
    Frame F;
    F.lds = (LAS unsigned char*)lds_raw;
    F.MISC = (volatile LAS unsigned*)(F.lds + MISC_OFF);
    F.wave = __builtin_amdgcn_readfirstlane(TID_ >> 6);
    F.G = gridDim.x; { const int bx = blockIdx.x; F.vcu = (F.G % 8 == 0) ? (bx % 8) * (F.G / 8) + bx / 8 : bx; }
    F.in = args.in; F.out = args.out; F.ws = args.ws; F.ctl = (unsigned*)(args.ws + WS_CTL);
    { int u0 = TID_; asm volatile("" : "+v"(u0)); for (int u = u0; u < (LDS_BYTES - RING_BYTES) / 4; u += NTHREADS) ((LAS unsigned*)(F.lds + RING_BYTES))[u] = 0u; }
    __syncthreads();
    const int lo = args.ph_lo, hi = args.ph_hi;
    XcdBarrier bar; bar.bar = F.ctl + CW_BAR; bar.x = 0; bar.st = nullptr;
    if (hi - lo > 1) bar = xcd_barrier_post(F.ctl + CW_BAR, F.MISC + 8);
    LAS unsigned char* ring = F.lds;

#ifndef TPROBE
#define TPROBE -1
#endif
#ifndef TP_X
#define TP_X 1000
#endif
    unsigned long long tp_start = 0; if (TPROBE >= 0 && blockIdx.x == 0 && TID_ == 0) tp_start = __builtin_amdgcn_s_memrealtime();
#define TPMARK(k) do { if (TPROBE == (k) && blockIdx.x == 0 && TID_ == 0) { const unsigned long long t1_ = __builtin_amdgcn_s_memrealtime(); __hip_atomic_store(F.ctl + 3000, ((float)(t1_ - tp_start) * 0.01f > (float)(TP_X)) ? 1u : 0u, __ATOMIC_RELAXED, __HIP_MEMORY_SCOPE_AGENT); } } while (0)
#define IN(k) (lo <= (k) && (k) < hi)
#define GBAR() xcd_barrier3(bar)
#define SEAM(k) do { if (IN(k) && IN((k) + 1)) { GBAR(); if (REP(21)) GBAR(); TPMARK(k); } } while (0)
#ifndef NOFILL
#define NOFILL 0
#endif
#define SEAMF(k, fl) do { if (NOFILL) { SEAM(k); } else if (IN(k) && IN((k) + 1)) { XCD_BARRIER_FILL(bar, F.MISC + 20, { \
        if (TID_ == 0) F.MISC[17] = atomicAdd(F.ctl + CW_CVTQ + 64 * (fl), 1u); __syncthreads(); const int mb_ = (int)F.MISC[17]; __syncthreads(); \
        if (mb_ < CVT_NMINI) { cvt_moe_mini(F, (fl), mb_); asm volatile("s_waitcnt vmcnt(0)" ::: "memory"); } else more_ = false; }); if (REP(21)) GBAR(); TPMARK(k); } } while (0)
    if (hi < 0) grid.sync();
    if (IN(0)) { RUNPH(10, phase_init(F)); }
    SEAMF(0, 0);
    if (IN(1)) { RUNPH(11, phase_row0(F)); }
    if (REP(16)) { for (int k_ = 0; k_ < 20; ++k_) xcd_barrier(bar); }
    if (REP(17)) { for (int k_ = 0; k_ < 20; ++k_) xcd_barrier3(bar); }
    if (REP(18)) { for (int k_ = 0; k_ < 20; ++k_) xcd_barrier2_probe<3>(bar); }
    if (REP(19)) { for (int k_ = 0; k_ < 20; ++k_) xcd_barrier2_probe<4>(bar); }
    SEAMF(1, 0);
#define LAYER(l) do { constexpr int base = 2 + 10 * (l); constexpr bool last = ((l) == NL - 1); \
    if (IN(base + 0)) { if (EN(0)) { \
        pg8::Gemm g{WSP(bf16, WS_H), WSP(bf16, WS_WIN) + (size_t)(l) * NINP * 1024, M, NINP, D}; \
        EpiInproj E{WSP(bf16, WS_QKV), WSP(bf16, WS_R32), WSP(bf16, WS_Z)}; \
        for (int rep_ = 0; rep_ < (REP(0) ? 2 : 1); ++rep_) { if (rep_) GBAR(); if (last) { InprojLastSched S{F.G, F.vcu}; run_gemm<EpiInproj, InprojLastSched>(ring, g, S, E); } else { TileSched S{M / 256, NINP / 256, F.G, F.vcu, false}; run_gemm<EpiInproj, TileSched>(ring, g, S, E); } } } } \
    SEAMF(base + 0, (l)); \
    if (IN(base + 1)) { if (EN(1)) { \
        pg8::Gemm g{WSP(bf16, WS_Z), WSP(bf16, WS_LORA) + (size_t)(l) * 1280 * 384, M, 1280, 384}; \
        TileSched S{M / 256, 5, F.G, F.vcu, false}; \
        EpiLora E{WSP(bf16, WS_DEC), WSP(bf16, WS_ASIG), WSP(bf16, WS_G), F.in[I_W0] + (l) * 512, F.in[I_A0] + (l) * 512}; \
        { int nrep_ = REP(1) ? 2 : 1; asm volatile("" : "+s"(nrep_)); _Pragma("unroll 1") for (int rep_ = 0; rep_ < nrep_; ++rep_) { if (rep_) GBAR(); run_gemm<EpiLora, TileSched>(ring, g, S, E); } } } \
        if (EN(12)) { phase_qkprep(F, (l)); if (REP(12)) { GBAR(); phase_qkprep(F, (l), true); } } } \
    SEAMF(base + 1, (l)); \
    if (IN(base + 2)) { if (EN(2)) { if (CHUNK_SCAN) { phase_prepass(F, (l)); if (IN(base + 2)) SEAMF(base + 2 - 1, (l)); if (REP(14)) { phase_prepass(F, (l)); GBAR(); } } phase_mixer(F, (l)); if (REP(2)) { GBAR(); phase_mixer(F, (l), 1); } if (REP(15)) { GBAR(); phase_mixer(F, (l), 2); } } } \
    SEAMF(base + 2, (l)); \
    if (IN(base + 4)) { if (EN(4)) { \
        pg8::Gemm g{WSP(bf16, WS_O), WSP(bf16, WS_WOUT) + (size_t)(l) * 1024 * 1024, M, D, D}; \
        TileSched S{last ? 64 : 72, 4, F.G, F.vcu, last}; \
        EpiOut E{WSP(bf16, WS_Y)}; \
        for (int rep_ = 0; rep_ < (REP(4) ? 2 : 1); ++rep_) { if (rep_) GBAR(); run_gemm<EpiOut, TileSched>(ring, g, S, E); } } } \
    SEAMF(base + 4, (l)); \
    if (IN(base + 5)) { if (EN(5)) { phase_row1(F, (l)); if (REP(5)) { GBAR(); phase_row1(F, (l), 1); } if (REP(22)) { GBAR(); phase_row1(F, (l), 2); } if (REP(23)) { GBAR(); phase_row1(F, (l), 3); } } } \
    SEAMF(base + 5, (l)); \
    if (IN(base + 6)) { RUNPH(6, phase_topk(F, (l))); } \
    SEAM(base + 6); \
    if (IN(base + 7)) { if (EN(7)) { \
        pg8::Gemm g{WSP(bf16, WS_XE), WSP(bf16, WS_WGU), NE * MEXP, NE * 2048, D}; \
        MoeSched S{last ? 8 : 9, 8, F.G, F.vcu}; \
        EpiMoe1 E{WSP(bf16, WS_HID)}; \
        for (int rep_ = 0; rep_ < (REP(7) ? 2 : 1); ++rep_) { if (rep_) GBAR(); run_gemm<EpiMoe1, MoeSched>(ring, g, S, E); } } } \
    SEAM(base + 7); \
    if (IN(base + 8)) { if (EN(8)) { \
        pg8::Gemm g{WSP(bf16, WS_HID), WSP(bf16, WS_WD), NE * MEXP, NE * 1024, D}; \
        MoeSched S{last ? 8 : 9, 4, F.G, F.vcu}; \
        EpiMoe2 E{WSP(bf16, WS_OUTE), WSP(float, WS_SELG)}; \
        for (int rep_ = 0; rep_ < (REP(8) ? 2 : 1); ++rep_) { if (rep_) GBAR(); run_gemm<EpiMoe2, MoeSched>(ring, g, S, E); } } } \
    SEAM(base + 8); \
    if (IN(base + 9)) { if (EN(9)) { phase_row2(F, (l)); if (REP(9)) { GBAR(); phase_row2(F, (l), true); } } } \
    if ((l) + 1 < NL) SEAMF(base + 9, (l) + 1); else SEAM(base + 9); \
  } while (0)
    LAYER(0);
    LAYER(1);
#undef LAYER
#undef SEAM
#undef IN
}

extern "C" void kernel_launch(void* const* d_in, const int* in_sizes, int n_in, void* d_out, int out_size, void* d_ws, size_t ws_size, hipStream_t stream) {
    static int grid = 0;
    if (grid == 0) {
        if (n_in != 29 || out_size != NB * SEQ * D || ws_size < WS_END) { fprintf(stderr, "kernel_launch: unexpected sizes n_in %d out %d ws %zu\n", n_in, out_size, ws_size); grid = -1; return; }
        int dev = 0, cus = 0, per_cu = 0;
        if (hipGetDevice(&dev) != hipSuccess || hipDeviceGetAttribute(&cus, hipDeviceAttributeMultiprocessorCount, dev) != hipSuccess) { grid = -1; return; }
        if (hipFuncSetAttribute((const void*)fwd_kernel, hipFuncAttributeMaxDynamicSharedMemorySize, LDS_BYTES) != hipSuccess) { fprintf(stderr, "kernel_launch: hipFuncSetAttribute failed\n"); grid = -1; return; }
        if (hipOccupancyMaxActiveBlocksPerMultiprocessor(&per_cu, (const void*)fwd_kernel, NTHREADS, LDS_BYTES) != hipSuccess || per_cu < 1) { fprintf(stderr, "kernel_launch: occupancy query says %d\n", per_cu); per_cu = 1; }
        (void)hipGetLastError();
        grid = cus;
        fprintf(stderr, "kernel_launch: grid %d, per_cu %d, ws %zu\n", grid, per_cu, ws_size);
    }
    if (grid < 0) return;
    if (hipMemsetAsync((char*)d_ws + WS_CTL, 0, CTL_ZERO_BYTES, stream) != hipSuccess) return;
    Args a{};
    for (int i = 0; i < 29; ++i) a.in[i] = (const float*)d_in[i];
    a.out = (float*)d_out; a.ws = (unsigned char*)d_ws;
#if N_LAUNCH_MODE
    a.ph_lo = 0; a.ph_hi = N_PHASES;
    { void* kargs[] = {&a};
      hipError_t e = hipLaunchCooperativeKernel((const void*)fwd_kernel, dim3(grid), dim3(NTHREADS), kargs, LDS_BYTES, stream);
      if (e != hipSuccess) fprintf(stderr, "kernel_launch: cooperative launch failed: %s\n", hipGetErrorString(e)); }
#else
    for (int ph = 0; ph < N_PHASES; ++ph) {
        a.ph_lo = ph; a.ph_hi = ph + 1;
        void* kargs[] = {&a};
        hipError_t e = hipLaunchCooperativeKernel((const void*)fwd_kernel, dim3(grid), dim3(NTHREADS), kargs, LDS_BYTES, stream);
        if (e != hipSuccess) { fprintf(stderr, "kernel_launch: launch %d failed: %s\n", ph, hipGetErrorString(e)); break; }
    }
#endif
}
```

```cpp
#define GOLD_GEMM 0
#define N_LAUNCH_MODE 1
#define GOLD_ATTN 0
#define REP_MASK 0
#define CHUNK_SCAN 1
#define NOFILL 0
#include <hip/hip_runtime.h>
#include <hip/hip_cooperative_groups.h>
#include <cstdio>
#include <cstdint>
namespace cg = cooperative_groups;

#ifndef GOLD_GEMM
#define GOLD_GEMM 0
#endif
#ifndef GOLD_ATTN
#define GOLD_ATTN 1
#endif
#ifndef N_LAUNCH_MODE
#define N_LAUNCH_MODE 1
#endif

#ifndef REP_MASK
#define REP_MASK 0
#endif
#define REP(k) ((REP_MASK >> (k)) & 1)
#define LAS __attribute__((address_space(3)))
typedef unsigned short bf16;
typedef float f32x4 __attribute__((ext_vector_type(4)));
typedef unsigned u32x4 __attribute__((ext_vector_type(4)));
typedef unsigned u32x2 __attribute__((ext_vector_type(2)));
typedef short bf16x8 __attribute__((ext_vector_type(8)));

constexpr int D = 1024, NB = 8, SEQ = 2048, CTXL = 256, T = SEQ + CTXL, M = NB * T, NL = 2;
constexpr int NINP = 2816;
constexpr int NE = 16, MEXP = 2304;
constexpr float LOG2E = 1.4426950408889634f;
constexpr float C2 = 0.125f * LOG2E;
constexpr int NTHREADS = 512, NWAVES = 8;
constexpr int LDS_BYTES = 147456, RING_BYTES = 131072, MISC_OFF = RING_BYTES + 320;

constexpr size_t MiB = 1u << 20;
constexpr size_t WS_CTL = 0, CTL_ZERO_BYTES = 1 * MiB;
constexpr size_t WS_MOD = 1 * MiB;
constexpr size_t WS_WIN = 2 * MiB;
constexpr size_t WS_WOUT = 13 * MiB;
constexpr size_t WS_LORA = 17 * MiB;
constexpr size_t WS_WGU = 19 * MiB;
constexpr size_t WS_WD = 83 * MiB;
constexpr size_t WS_X = 115 * MiB;
constexpr size_t R0 = 187 * MiB;
constexpr size_t WS_YD = R0 + 0 * MiB;
constexpr size_t WS_H = R0 + 36 * MiB;
constexpr size_t WS_QKV = R0 + 72 * MiB;
constexpr size_t WS_R32 = R0 + 126 * MiB;
constexpr size_t WS_Z = R0 + 180 * MiB;
constexpr size_t WS_DEC = R0 + 194 * MiB;
constexpr size_t WS_ASIG = R0 + 230 * MiB;
constexpr size_t WS_G = R0 + 266 * MiB;
constexpr size_t WS_O = R0 + 284 * MiB;
constexpr size_t WS_END = R0 + 320 * MiB;
constexpr size_t WS_Y = WS_QKV;
constexpr size_t WS_OUTE = WS_QKV;
constexpr size_t WS_H2 = WS_DEC;
constexpr size_t WS_AFF = WS_Z;
constexpr size_t WS_INV = WS_Z + 2 * MiB;
constexpr size_t WS_SELG = WS_Z + 4 * MiB;
constexpr size_t WS_SELT = WS_Z + 5 * MiB;
constexpr size_t WS_XE = WS_ASIG;
constexpr size_t WS_HID = WS_YD;
static_assert(WS_END <= 512 * MiB, "ws map");
constexpr int CW_BAR = 4096;
constexpr int CW_QUEUE = 16384;

__device__ __forceinline__ unsigned f2bf(float f) { unsigned u = __builtin_bit_cast(unsigned, f); return (u + 0x7fffu + ((u >> 16) & 1u)) >> 16; }
__device__ __forceinline__ unsigned pk2(float lo, float hi) { return f2bf(lo) | (f2bf(hi) << 16); }
__device__ __forceinline__ float bf2f(unsigned h) { return __builtin_bit_cast(float, h << 16); }
__device__ __forceinline__ float bflo(unsigned w) { return __builtin_bit_cast(float, w << 16); }
__device__ __forceinline__ float bfhi(unsigned w) { return __builtin_bit_cast(float, w & 0xffff0000u); }
template <int CTRL> __device__ __forceinline__ float dppf(float x) { return __builtin_bit_cast(float, __builtin_amdgcn_update_dpp(0, __builtin_bit_cast(int, x), CTRL, 0xF, 0xF, true)); }
__device__ __forceinline__ float red8(float x) { x += dppf<0xB1>(x); x += dppf<0x4E>(x); x += dppf<0x141>(x); return x; }
__device__ __forceinline__ float wave_sum(float v) {
    v = red8(v); v += dppf<0x140>(v);
    const float a0 = __builtin_bit_cast(float, __builtin_amdgcn_readlane(__builtin_bit_cast(int, v), 0));
    const float a1 = __builtin_bit_cast(float, __builtin_amdgcn_readlane(__builtin_bit_cast(int, v), 16));
    const float a2 = __builtin_bit_cast(float, __builtin_amdgcn_readlane(__builtin_bit_cast(int, v), 32));
    const float a3 = __builtin_bit_cast(float, __builtin_amdgcn_readlane(__builtin_bit_cast(int, v), 48));
    return (a0 + a1) + (a2 + a3);
}
__device__ __forceinline__ float wave_max(float v) {
    v = fmaxf(v, dppf<0xB1>(v)); v = fmaxf(v, dppf<0x4E>(v)); v = fmaxf(v, dppf<0x141>(v)); v = fmaxf(v, dppf<0x140>(v));
    const float a0 = __builtin_bit_cast(float, __builtin_amdgcn_readlane(__builtin_bit_cast(int, v), 0));
    const float a1 = __builtin_bit_cast(float, __builtin_amdgcn_readlane(__builtin_bit_cast(int, v), 16));
    const float a2 = __builtin_bit_cast(float, __builtin_amdgcn_readlane(__builtin_bit_cast(int, v), 32));
    const float a3 = __builtin_bit_cast(float, __builtin_amdgcn_readlane(__builtin_bit_cast(int, v), 48));
    return fmaxf(fmaxf(a0, a1), fmaxf(a2, a3));
}
__device__ __forceinline__ float sigmoidf_(float x) { return __builtin_amdgcn_rcpf(1.f + __expf(-x)); }
#define LDS_WAIT() asm volatile("s_waitcnt lgkmcnt(0)" ::: "memory")

#define XB_TMO      128
#define XB_XCNT(j)  (256  + 64 * (j))
#define XB_XSUB(j)  (1280 + 64 * (j))
#define XB_XGEN(j)  (2304 + 64 * (j))
#define XB_TOP      3328
#define XB_TOPGEN   3392
#define XCD_BAR_WORDS 3456
#define XB_SPIN_CAP (1u << 22)
__device__ __forceinline__ unsigned xb_ld(unsigned* p)              { return __hip_atomic_load(p, __ATOMIC_RELAXED, __HIP_MEMORY_SCOPE_AGENT); }
__device__ __forceinline__ unsigned xb_add(unsigned* p, unsigned v) { return __hip_atomic_fetch_add(p, v, __ATOMIC_RELAXED, __HIP_MEMORY_SCOPE_AGENT); }
__device__ __forceinline__ unsigned xb_xcc_id() { return (unsigned)__builtin_amdgcn_s_getreg((3 << 11) | 20) & 0xFu; }
#define XB_SPIN(cond, bar) do { unsigned _sp = 0; while (cond) { __builtin_amdgcn_s_sleep(1); \
    if ((++_sp & 255u) == 0u) { if (xb_ld(&(bar)[XB_TMO])) break; if (_sp > XB_SPIN_CAP) { atomicAdd(&(bar)[XB_TMO], 1u); break; } } } } while (0)
struct XcdBarrier { unsigned* bar; unsigned x; volatile LAS unsigned* st; };
__device__ __forceinline__ XcdBarrier xcd_barrier_post(unsigned* bar, volatile LAS unsigned* st) {
    XcdBarrier b; b.bar = bar; b.x = xb_xcc_id(); b.st = st;
    if (threadIdx.x == 0) (void)xb_add(&bar[XB_XCNT(b.x)], 1u);
    return b;
}
__device__ __forceinline__ void xcd_barrier_complete(unsigned* bar, unsigned x, unsigned& nloc, unsigned& nx) {
    const unsigned G = gridDim.x * gridDim.y * gridDim.z;
    unsigned sum, cnt, mine, sp = 0u;
    for (;;) {
        sum = 0u; cnt = 0u; mine = 0u;
#pragma unroll
        for (unsigned j = 0; j < 16; ++j) { const unsigned c = xb_ld(&bar[XB_XCNT(j)]); sum += c; cnt += (c > 0u) ? 1u : 0u; mine = (j == x) ? c : mine; }
        if (sum == G) break;
        __builtin_amdgcn_s_sleep(1);
        if ((++sp & 255u) == 0u) { if (xb_ld(&bar[XB_TMO])) break; if (sp > XB_SPIN_CAP) { atomicAdd(&bar[XB_TMO], 1u); break; } }
    }
    nloc = mine > 0u ? mine : 1u; nx = cnt > 0u ? cnt : 1u;
}
__device__ __forceinline__ void xcd_barrier(const XcdBarrier& b) {
    asm volatile("s_waitcnt vmcnt(0)" ::: "memory");
    __syncthreads();
    if (threadIdx.x == 0) {
        unsigned* bar = b.bar;
        __builtin_amdgcn_s_waitcnt(0);
        unsigned nloc = b.st[0], nx = b.st[1];
        if (nloc == 0u) { xcd_barrier_complete(bar, b.x, nloc, nx); b.st[0] = nloc; b.st[1] = nx; }
        const unsigned old = xb_add(&bar[XB_XSUB(b.x)], 1u);
        const unsigned gen = old / nloc;
        if (old + 1u == (gen + 1u) * nloc) {
            __builtin_amdgcn_fence(__ATOMIC_RELEASE, "agent");
            asm volatile("s_waitcnt vmcnt(0)" ::: "memory");
            const unsigned og = xb_add(&bar[XB_TOP], 1u);
            const unsigned tg = og / nx;
            if (og + 1u == (tg + 1u) * nx) xb_add(&bar[XB_TOPGEN], 1u);
            else XB_SPIN(xb_ld(&bar[XB_TOPGEN]) == tg, bar);
            __builtin_amdgcn_fence(__ATOMIC_ACQUIRE, "agent");
            xb_add(&bar[XB_XGEN(b.x)], 1u);
            asm volatile("s_waitcnt vmcnt(0)" ::: "memory");
        } else {
            XB_SPIN(xb_ld(&bar[XB_XGEN(b.x)]) == gen, bar);
            __builtin_amdgcn_fence(__ATOMIC_ACQUIRE, "agent");
            asm volatile("s_waitcnt vmcnt(0)" ::: "memory");
        }
    }
    __syncthreads();
}

__device__ __forceinline__ void flat_barrier(unsigned* cnt) {
    asm volatile("s_waitcnt vmcnt(0)" ::: "memory");
    __syncthreads();
    if (threadIdx.x == 0) {
        const unsigned G = gridDim.x;
        __builtin_amdgcn_fence(__ATOMIC_RELEASE, "agent");
        asm volatile("s_waitcnt vmcnt(0)" ::: "memory");
        const unsigned old = xb_add(cnt, 1u);
        const unsigned target = (old / G + 1u) * G;
        unsigned sp = 0;
        while (xb_ld(cnt) < target) { __builtin_amdgcn_s_sleep(1); if (++sp > (1u << 22)) break; }
        __builtin_amdgcn_fence(__ATOMIC_ACQUIRE, "agent");
        asm volatile("s_waitcnt vmcnt(0)" ::: "memory");
    }
    __syncthreads();
}

__device__ __forceinline__ void xcd_barrier2(const XcdBarrier& b) {
    asm volatile("s_waitcnt vmcnt(0)" ::: "memory");
    __syncthreads();
    if (threadIdx.x == 0) {
        unsigned* bar = b.bar;
        __builtin_amdgcn_s_waitcnt(0);
        unsigned nloc = b.st[0], nx = b.st[1];
        if (nloc == 0u) { xcd_barrier_complete(bar, b.x, nloc, nx); b.st[0] = nloc; b.st[1] = nx; }
        const unsigned old = xb_add(&bar[XB_XSUB(b.x)], 1u);
        const unsigned gen = old / nloc;
        if (old + 1u == (gen + 1u) * nloc) {
            __builtin_amdgcn_fence(__ATOMIC_RELEASE, "agent");
            asm volatile("s_waitcnt vmcnt(0)" ::: "memory");
            (void)xb_add(&bar[XB_TOP], 1u);
        }
        const unsigned target = (gen + 1u) * nx;
        XB_SPIN(xb_ld(&bar[XB_TOP]) < target, bar);
        __builtin_amdgcn_fence(__ATOMIC_ACQUIRE, "agent");
        asm volatile("s_waitcnt vmcnt(0)" ::: "memory");
    }
    __syncthreads();
}

template <int MODE> __device__ __forceinline__ void xcd_barrier2_probe(const XcdBarrier& b) {
    asm volatile("s_waitcnt vmcnt(0)" ::: "memory");
    __syncthreads();
    if (threadIdx.x == 0) {
        unsigned* bar = b.bar;
        unsigned nloc = b.st[0], nx = b.st[1];
        const unsigned old = xb_add(&bar[XB_XSUB(b.x)], 1u);
        const unsigned gen = old / nloc;
        if (old + 1u == (gen + 1u) * nloc) {
            if (!(MODE & 2)) { __builtin_amdgcn_fence(__ATOMIC_RELEASE, "agent"); asm volatile("s_waitcnt vmcnt(0)" ::: "memory"); }
            (void)xb_add(&bar[XB_TOP], 1u);
        }
        const unsigned target = (gen + 1u) * nx;
        XB_SPIN(xb_ld(&bar[XB_TOP]) < target, bar);
        if (!(MODE & 1) && (!(MODE & 4) || (old + 1u == (gen + 1u) * nloc))) { __builtin_amdgcn_fence(__ATOMIC_ACQUIRE, "agent"); asm volatile("s_waitcnt vmcnt(0)" ::: "memory"); }
    }
    __syncthreads();
}

__device__ __forceinline__ void xcd_barrier3(const XcdBarrier& b) {
    asm volatile("s_waitcnt vmcnt(0)" ::: "memory");
    __syncthreads();
    if (threadIdx.x == 0) {
        unsigned* bar = b.bar;
        __builtin_amdgcn_s_waitcnt(0);
        unsigned nloc = b.st[0], nx = b.st[1];
        if (nloc == 0u) { xcd_barrier_complete(bar, b.x, nloc, nx); b.st[0] = nloc; b.st[1] = nx; }
        const unsigned old = xb_add(&bar[XB_XSUB(b.x)], 1u);
        const unsigned gen = old / nloc;
        if (old + 1u == (gen + 1u) * nloc) {
            __builtin_amdgcn_fence(__ATOMIC_RELEASE, "agent");
            asm volatile("s_waitcnt vmcnt(0)" ::: "memory");
            (void)xb_add(&bar[XB_TOP], 1u);
            const unsigned target = (gen + 1u) * nx;
            XB_SPIN(xb_ld(&bar[XB_TOP]) < target, bar);
            __builtin_amdgcn_fence(__ATOMIC_ACQUIRE, "agent");
            asm volatile("s_waitcnt vmcnt(0)" ::: "memory");
            xb_add(&bar[XB_XGEN(b.x)], 1u);
        } else {
            __builtin_amdgcn_fence(__ATOMIC_ACQUIRE, "agent");
            asm volatile("s_waitcnt vmcnt(0)" ::: "memory");
            XB_SPIN(xb_ld(&bar[XB_XGEN(b.x)]) == gen, bar);
        }
    }
    __syncthreads();
}

#define XCD_BARRIER_FILL(b, MISCW, FILL_STMT) do { \
    asm volatile("s_waitcnt vmcnt(0)" ::: "memory"); \
    __syncthreads(); \
    if (threadIdx.x == 0) { \
        unsigned* bar_ = (b).bar; __builtin_amdgcn_s_waitcnt(0); \
        unsigned nloc_ = (b).st[0], nx_ = (b).st[1]; \
        if (nloc_ == 0u) { xcd_barrier_complete(bar_, (b).x, nloc_, nx_); (b).st[0] = nloc_; (b).st[1] = nx_; } \
        const unsigned old_ = xb_add(&bar_[XB_XSUB((b).x)], 1u); const unsigned gen_ = old_ / nloc_; \
        if (old_ + 1u == (gen_ + 1u) * nloc_) { \
            __builtin_amdgcn_fence(__ATOMIC_RELEASE, "agent"); asm volatile("s_waitcnt vmcnt(0)" ::: "memory"); \
            (void)xb_add(&bar_[XB_TOP], 1u); const unsigned target_ = (gen_ + 1u) * nx_; \
            XB_SPIN(xb_ld(&bar_[XB_TOP]) < target_, bar_); \
            __builtin_amdgcn_fence(__ATOMIC_ACQUIRE, "agent"); asm volatile("s_waitcnt vmcnt(0)" ::: "memory"); \
            xb_add(&bar_[XB_XGEN((b).x)], 1u); \
            (MISCW)[0] = 0xffffffffu; \
        } else { \
            __builtin_amdgcn_fence(__ATOMIC_ACQUIRE, "agent"); asm volatile("s_waitcnt vmcnt(0)" ::: "memory"); \
            (MISCW)[0] = gen_; \
        } \
    } \
    __syncthreads(); \
    { const unsigned g_ = (MISCW)[0]; \
      if (g_ != 0xffffffffu) { bool more_ = true; \
        for (;;) { \
            if (threadIdx.x == 0) (MISCW)[1] = (xb_ld(&(b).bar[XB_XGEN((b).x)]) != g_) ? 1u : 0u; \
            __syncthreads(); \
            const bool rel_ = (MISCW)[1] != 0u; \
            __syncthreads(); \
            if (rel_) break; \
            if (more_) { FILL_STMT; } else __builtin_amdgcn_s_sleep(4); \
        } } } \
    __syncthreads(); \
  } while (0)
namespace pg8 {
#define PG8_LAS __attribute__((address_space(3)))
typedef unsigned short bf16_t;
typedef short bf16x8 __attribute__((ext_vector_type(8)));
typedef float f32x4 __attribute__((ext_vector_type(4)));
typedef unsigned u32x4 __attribute__((ext_vector_type(4)));
constexpr int BM = 256, BK = 64, HALF = 128, HTB = HALF * BK * 2  , STAGE_BYTES = 8 * HTB, NXCD = 8, WGM = 8;

__host__ __device__ __forceinline__ int lds_byte(int r, int c) { const int st = (r >> 4) * 2 + (c >> 5), rr = r & 15, cc = c & 31, ob = rr * 64 + cc * 2; return st * 1024 + (ob ^ (((ob >> 9) & 1) << 5)); }
__host__ __device__ __forceinline__ void stage_rc(int b, int& R, int& C) { const int st = b / 1024, sb = b % 1024, swz = sb ^ (((sb >> 9) & 1) << 5); R = (st >> 1) * 16 + swz / 64; C = (st & 1) * 32 + (swz % 64) / 2; }
__host__ __device__ __forceinline__ int perm32(int rho) { const int n = rho >> 4, i = rho & 15; return 8 * (i >> 2) + 4 * n + (i & 3); }

struct Unit { int pm, pn; };
struct Gemm { const bf16_t* A; const bf16_t* Bt; int M, N, K; };

struct StaticOrder {
    int nM, nN, nwg, G, c;
    __host__ __device__ void init(int M, int N, int G_, int c_) { nM = M / BM; nN = N / BM; nwg = nM * nN; G = G_; c = c_; }
    __host__ __device__ bool next(int i, Unit& u) const {
        const long L = (long)i * G + c; if (L >= nwg) return false;
        int wgid = (int)L; { const int q = nwg / NXCD, r = nwg % NXCD, xcd = wgid % NXCD, off = wgid / NXCD; wgid = (xcd < r ? xcd * (q + 1) : r * (q + 1) + (xcd - r) * q) + off; }
        const int nig = WGM * nN, gid = wgid / nig, fm = gid * WGM, gsz = (nM - fm) < WGM ? (nM - fm) : WGM;
        u.pm = fm + ((wgid % nig) % gsz); u.pn = (wgid % nig) / gsz; return true;
    }
    __device__ __forceinline__ void a_ready(const Unit&) const {}
    __device__ __forceinline__ void done(const Unit&) const {}
};
__device__ __forceinline__ unsigned cvt_pk_bf16(float lo, float hi) { unsigned r; asm volatile("v_cvt_pk_bf16_f32 %0, %1, %2" : "=v"(r) : "v"(lo), "v"(hi)); return r; }
typedef float f32x2 __attribute__((ext_vector_type(2)));
template <class Epi, class Sched, bool ALIGN_EPI = false, bool SP2 = false>
__device__ __forceinline__ void gemm_phase(PG8_LAS unsigned char* lds, const Gemm g, const Sched& S, const Epi& E) {
    const int tid = threadIdx.x, wid = __builtin_amdgcn_readfirstlane(tid >> 6), lane = tid & 63, wr = wid >> 2, wc = wid & 3, fr = lane & 15, fq = lane >> 4;
    const int K = g.K, nt = K / BK;
    unsigned voffA[2], voffB[2];
#pragma unroll
    for (int i = 0; i < 2; ++i) { int R, C; stage_rc(tid * 16 + i * 8192, R, C); const int Rb = Epi::PERM ? ((R & ~31) + perm32(R & 31)) : R;
        voffA[i] = (unsigned)(R * K + C) * 2u; voffB[i] = (unsigned)(Rb * K + C) * 2u; }
    const size_t kstep = (size_t)(BK * 2);
    const size_t hstep = (size_t)HALF * K * 2;
    const size_t tstep = 2 * hstep;
    const unsigned ldsw = (unsigned)wid * 1024u;
    const int aoff = lds_byte(wr * 64 + fr, fq * 8), boff = lds_byte(wc * 32 + fr, fq * 8);
#define PG8_SA(b, h) (((b) * 2 + (h)) * HTB)
#define PG8_SB(b, h) ((4 + (b) * 2 + (h)) * HTB)
#define PG8_STAGE(bufoff, gbase, voff) do { _Pragma("unroll") for (int _i = 0; _i < 2; ++_i) \
        __builtin_amdgcn_global_load_lds((const unsigned*)((const char*)(gbase) + (voff)[_i]), (PG8_LAS unsigned*)(lds + (bufoff) + ldsw + _i * 8192), 16, 0, 0); } while (0)
#define PG8_LDA(dst, b, h) do { _Pragma("unroll") for (int m = 0; m < 4; ++m) _Pragma("unroll") for (int k = 0; k < 2; ++k) dst[m][k] = *(const PG8_LAS bf16x8*)(lds + PG8_SA(b, h) + aoff + m * 2048 + k * 1024); } while (0)
#define PG8_LDB(dst, b, h) do { _Pragma("unroll") for (int n = 0; n < 2; ++n) _Pragma("unroll") for (int k = 0; k < 2; ++k) dst[n][k] = *(const PG8_LAS bf16x8*)(lds + PG8_SB(b, h) + boff + n * 2048 + k * 1024); } while (0)
#define PG8_MMA(ai, bj, At, Bt) do { __builtin_amdgcn_s_setprio(1); _Pragma("unroll") for (int m = 0; m < 4; ++m) _Pragma("unroll") for (int n = 0; n < 2; ++n) _Pragma("unroll") for (int k = 0; k < 2; ++k) \
        acc[ai][bj][m][n] = __builtin_amdgcn_mfma_f32_16x16x32_bf16(Bt[n][k], At[m][k], acc[ai][bj][m][n], 0, 0, 0); __builtin_amdgcn_s_setprio(0); } while (0)
#define PG8_WAIT_V(n) asm volatile("s_waitcnt vmcnt(" #n ")" ::: "memory")
#define PG8_WAIT_L(n) asm volatile("s_waitcnt lgkmcnt(" #n ")" ::: "memory")
#define PG8_BAR __builtin_amdgcn_s_barrier()
#define PG8_SCHED __builtin_amdgcn_sched_barrier(0)
    Unit cur, nxt; int ui = 0;
    if (!S.next(0, cur)) return;
    f32x4 acc[2][2][4][2];
#pragma unroll
    for (int a = 0; a < 2; ++a)
#pragma unroll
        for (int b = 0; b < 2; ++b)
#pragma unroll
            for (int m = 0; m < 4; ++m)
#pragma unroll
                for (int n = 0; n < 2; ++n) acc[a][b][m][n] = (f32x4){0.f, 0.f, 0.f, 0.f};
    bf16x8 At[4][2], B0[2][2], B1[2][2];
    const char* cA = (const char*)g.A + (size_t)cur.pm * tstep; const char* cB = (const char*)g.Bt + (size_t)cur.pn * tstep;
    S.a_ready(cur);
    if constexpr (SP2) {
        PG8_STAGE(PG8_SB(0, 0), cB, voffB); PG8_STAGE(PG8_SB(0, 1), cB + hstep, voffB); PG8_STAGE(PG8_SA(0, 0), cA, voffA); PG8_STAGE(PG8_SA(0, 1), cA + hstep, voffA);
        if (wr == 1) PG8_BAR;
        PG8_WAIT_V(2); PG8_BAR;
        PG8_STAGE(PG8_SB(1, 0), cB + kstep, voffB); PG8_STAGE(PG8_SA(1, 0), cA + kstep, voffA); PG8_STAGE(PG8_SB(1, 1), cB + hstep + kstep, voffB);
        PG8_WAIT_V(6); PG8_BAR;
    } else {
        PG8_STAGE(PG8_SB(0, 0), cB, voffB); PG8_STAGE(PG8_SA(0, 0), cA, voffA); PG8_STAGE(PG8_SB(0, 1), cB + hstep, voffB); PG8_STAGE(PG8_SA(0, 1), cA + hstep, voffA);
        if (wr == 1) PG8_BAR;
        PG8_WAIT_V(4); PG8_BAR;
        PG8_STAGE(PG8_SB(1, 0), cB + kstep, voffB); PG8_STAGE(PG8_SA(1, 0), cA + kstep, voffA); PG8_STAGE(PG8_SB(1, 1), cB + hstep + kstep, voffB);
        PG8_WAIT_V(6); PG8_BAR;
    }
    for (;;) {
        const bool has_next = S.next(ui + 1, nxt);
        const char* nA = has_next ? (const char*)g.A + (size_t)nxt.pm * tstep : cA; const char* nB = has_next ? (const char*)g.Bt + (size_t)nxt.pn * tstep : cB;
        for (int t = 0; t < nt; t += 2) {
            const bool last = (t == nt - 2);
            const char* a1 = cA + (size_t)(t + 1) * kstep;
            const char* a2 = last ? nA : cA + (size_t)(t + 2) * kstep; const char* b2 = last ? nB : cB + (size_t)(t + 2) * kstep;
            const char* a3 = a2 + kstep; const char* b3 = b2 + kstep;
            if (last && has_next) S.a_ready(nxt);
            if constexpr (SP2) {
            PG8_LDB(B0, 0, 0); PG8_LDB(B1, 0, 1); PG8_SCHED; PG8_LDA(At, 0, 0); PG8_STAGE(PG8_SA(1, 1), a1 + hstep, voffA);
            PG8_WAIT_V(8); PG8_WAIT_L(0); PG8_BAR; PG8_MMA(0, 0, At, B0); PG8_MMA(0, 1, At, B1); PG8_BAR; PG8_SCHED;
            PG8_LDA(At, 0, 1); PG8_STAGE(PG8_SB(0, 0), b2, voffB); PG8_STAGE(PG8_SB(0, 1), b2 + hstep, voffB); PG8_STAGE(PG8_SA(0, 0), a2, voffA);
            PG8_WAIT_V(8); PG8_WAIT_L(0); PG8_BAR; PG8_MMA(1, 0, At, B0); PG8_MMA(1, 1, At, B1); PG8_BAR; PG8_SCHED;
            PG8_LDB(B0, 1, 0); PG8_LDB(B1, 1, 1); PG8_SCHED; PG8_LDA(At, 1, 0); PG8_STAGE(PG8_SA(0, 1), a2 + hstep, voffA);
            PG8_WAIT_V(8); PG8_WAIT_L(0); PG8_BAR; PG8_MMA(0, 0, At, B0); PG8_MMA(0, 1, At, B1); PG8_BAR; PG8_SCHED;
            PG8_LDA(At, 1, 1); PG8_STAGE(PG8_SB(1, 0), b3, voffB); PG8_STAGE(PG8_SB(1, 1), b3 + hstep, voffB); PG8_STAGE(PG8_SA(1, 0), a3, voffA);
            PG8_WAIT_V(8); PG8_WAIT_L(0); PG8_BAR; PG8_MMA(1, 0, At, B0); PG8_MMA(1, 1, At, B1); PG8_BAR; PG8_SCHED;
            } else {
            PG8_LDB(B0, 0, 0); PG8_SCHED; PG8_LDA(At, 0, 0); PG8_STAGE(PG8_SA(1, 1), a1 + hstep, voffA);
            PG8_WAIT_L(8); PG8_BAR; PG8_WAIT_L(0); PG8_MMA(0, 0, At, B0); PG8_BAR; PG8_SCHED;
            PG8_LDB(B1, 0, 1); PG8_STAGE(PG8_SB(0, 0), b2, voffB);
            PG8_BAR; PG8_WAIT_L(0); PG8_MMA(0, 1, At, B1); PG8_BAR;
            PG8_LDA(At, 0, 1); PG8_STAGE(PG8_SA(0, 0), a2, voffA);
            PG8_BAR; PG8_WAIT_L(0); PG8_MMA(1, 0, At, B0); PG8_BAR; PG8_SCHED;
            PG8_STAGE(PG8_SB(0, 1), b2 + hstep, voffB);
            PG8_WAIT_V(6); PG8_BAR; PG8_MMA(1, 1, At, B1); PG8_BAR;
            PG8_LDB(B0, 1, 0); PG8_SCHED; PG8_LDA(At, 1, 0); PG8_STAGE(PG8_SA(0, 1), a2 + hstep, voffA);
            PG8_WAIT_L(8); PG8_BAR; PG8_WAIT_L(0); PG8_MMA(0, 0, At, B0); PG8_BAR; PG8_SCHED;
            PG8_LDB(B1, 1, 1); PG8_STAGE(PG8_SB(1, 0), b3, voffB);
            PG8_BAR; PG8_WAIT_L(0); PG8_MMA(0, 1, At, B1); PG8_BAR;
            PG8_LDA(At, 1, 1); PG8_STAGE(PG8_SA(1, 0), a3, voffA);
            PG8_BAR; PG8_WAIT_L(0); PG8_MMA(1, 0, At, B0); PG8_BAR; PG8_SCHED;
            PG8_STAGE(PG8_SB(1, 1), b3 + hstep, voffB);
            PG8_WAIT_V(6); PG8_BAR; PG8_MMA(1, 1, At, B1); PG8_BAR;
            }
        }
        if constexpr (ALIGN_EPI) { if (wr == 0) PG8_BAR; }
        if constexpr (!Epi::AFTER_DRAIN) { E(acc, cur, wr, wc, fr, fq); S.done(cur); }
        if (!has_next) break;
#pragma unroll
        for (int a = 0; a < 2; ++a)
#pragma unroll
            for (int b = 0; b < 2; ++b)
#pragma unroll
                for (int m = 0; m < 4; ++m)
#pragma unroll
                    for (int n = 0; n < 2; ++n) acc[a][b][m][n] = (f32x4){0.f, 0.f, 0.f, 0.f};
        cur = nxt; cA = nA; cB = nB; ++ui;
        if constexpr (ALIGN_EPI) { if (wr == 1) PG8_BAR; }
    }
    PG8_WAIT_V(0);
    if constexpr (!ALIGN_EPI) { if (wr == 0) PG8_BAR; }
    PG8_BAR;
    if constexpr (Epi::AFTER_DRAIN) { E.fused(acc, cur, wr, wc, fr, fq, lds, wid, lane); S.done(cur); }
#undef PG8_SA
#undef PG8_SB
#undef PG8_STAGE
#undef PG8_LDA
#undef PG8_LDB
#undef PG8_MMA
#undef PG8_WAIT_V
#undef PG8_WAIT_L
#undef PG8_BAR
#undef PG8_SCHED
}
}

__device__ __forceinline__ u32x4 pack8(const f32x4 a, const f32x4 b) {
    u32x4 w; w.x = pk2(a[0], a[1]); w.y = pk2(a[2], a[3]); w.z = pk2(b[0], b[1]); w.w = pk2(b[2], b[3]); return w;
}
__device__ __forceinline__ float tanh_fast(float x) { const float e = __expf(2.f * x); return 1.f - 2.f * __builtin_amdgcn_rcpf(1.f + e); }
__device__ __forceinline__ float decay_of(float v) { const float ew = 0.6065306597126334f * __builtin_amdgcn_rcpf(1.f + __expf(-v)); return __expf(-ew); }
struct EpiInproj {
    static constexpr bool PERM = true, AFTER_DRAIN = false;
    bf16* QKV; bf16* R32; bf16* Z;
    __device__ __forceinline__ void operator()(const f32x4 (&acc)[2][2][4][2], const pg8::Unit& u, int wr, int wc, int fr, int fq) const {
        const int pn = u.pn;
#pragma unroll
        for (int ai = 0; ai < 2; ++ai)
#pragma unroll
            for (int m = 0; m < 4; ++m) {
                const unsigned row = (unsigned)u.pm * 256u + ai * 128 + wr * 64 + m * 16 + fr;
#pragma unroll
                for (int bj = 0; bj < 2; ++bj) {
                    f32x4 v0 = acc[ai][bj][m][0], v1 = acc[ai][bj][m][1];
                    const int cb = bj * 128 + wc * 32 + 8 * fq;
                    if (pn < 6) {
                        if (pn == 3) { v0 = v0 * C2; v1 = v1 * C2; }
                        *(u32x4*)(QKV + row * 1536 + pn * 256 + cb) = pack8(v0, v1);
                    } else if (pn < 9) {
                        *(u32x4*)(R32 + row * 768 + (pn - 6) * 256 + cb) = pack8(v0, v1);
                    } else if (pn == 9) {
                        if (bj == 0) {
#pragma unroll
                            for (int e = 0; e < 4; ++e) { v0[e] = tanh_fast(v0[e]); v1[e] = tanh_fast(v1[e]); }
                        }
                        *(u32x4*)(Z + row * 384 + cb) = pack8(v0, v1);
                    } else {
                        if (bj == 0) {
#pragma unroll
                            for (int e = 0; e < 4; ++e) { v0[e] = sigmoidf_(v0[e]); v1[e] = sigmoidf_(v1[e]); }
                            *(u32x4*)(Z + row * 384 + 256 + cb) = pack8(v0, v1);
                        }
                    }
                }
            }
    }
};
struct EpiLora {
    static constexpr bool PERM = true, AFTER_DRAIN = false;
    bf16* DEC; bf16* ASIG; bf16* G; const float* w0; const float* a0;
    template <int KIND> __device__ __forceinline__ void body(const f32x4 (&acc)[2][2][4][2], bf16* dst, const float* bias, unsigned row0, int cb0) const {
#pragma unroll
        for (int bj = 0; bj < 2; ++bj) {
            const int cb = bj * 128 + cb0;
            f32x4 b0 = (f32x4){0.f, 0.f, 0.f, 0.f}, b1 = b0;
            if (KIND != 2) { b0 = *(const f32x4*)(bias + cb); b1 = *(const f32x4*)(bias + cb + 4); }
#pragma unroll
            for (int ai = 0; ai < 2; ++ai)
#pragma unroll
                for (int m = 0; m < 4; ++m) {
                    f32x4 v0 = acc[ai][bj][m][0] + b0, v1 = acc[ai][bj][m][1] + b1;
#pragma unroll
                    for (int e = 0; e < 4; ++e) {
                        if (KIND == 0) { v0[e] = 0.6065306597126334f * sigmoidf_(v0[e]); v1[e] = 0.6065306597126334f * sigmoidf_(v1[e]); }
                        if (KIND == 1) { v0[e] = sigmoidf_(v0[e]); v1[e] = sigmoidf_(v1[e]); }
                    }
                    *(u32x4*)(dst + (row0 + ai * 128 + m * 16) * 256u + cb) = pack8(v0, v1);
                    asm volatile("" ::: "memory");
                }
        }
    }
    __device__ __forceinline__ void operator()(const f32x4 (&acc)[2][2][4][2], const pg8::Unit& u, int wr, int wc, int fr, int fq) const {
        const int pn = u.pn; const unsigned row0 = (unsigned)u.pm * 256u + wr * 64 + fr; const int cb0 = wc * 32 + 8 * fq;
        if (pn < 2) body<0>(acc, DEC + (size_t)pn * M * 256, w0 + pn * 256, row0, cb0);
        else if (pn < 4) body<1>(acc, ASIG + (size_t)(pn - 2) * M * 256, a0 + (pn - 2) * 256, row0, cb0);
        else body<2>(acc, G, w0, row0, cb0);
    }
};
struct EpiOut {
    static constexpr bool PERM = true, AFTER_DRAIN = false;
    bf16* Y;
    __device__ __forceinline__ void operator()(const f32x4 (&acc)[2][2][4][2], const pg8::Unit& u, int wr, int wc, int fr, int fq) const {
#pragma unroll
        for (int ai = 0; ai < 2; ++ai)
#pragma unroll
            for (int m = 0; m < 4; ++m) {
                const unsigned row = (unsigned)u.pm * 256u + ai * 128 + wr * 64 + m * 16 + fr;
#pragma unroll
                for (int bj = 0; bj < 2; ++bj)
                    *(u32x4*)(Y + row * 1024 + u.pn * 256 + bj * 128 + wc * 32 + 8 * fq) = pack8(acc[ai][bj][m][0], acc[ai][bj][m][1]);
            }
    }
};
struct EpiMoe1 {
    static constexpr bool PERM = true, AFTER_DRAIN = false;
    bf16* HID;
    __device__ __forceinline__ void operator()(const f32x4 (&acc)[2][2][4][2], const pg8::Unit& u, int wr, int wc, int fr, int fq) const {
        const int pnl = u.pn & 7;
#pragma unroll
        for (int ai = 0; ai < 2; ++ai)
#pragma unroll
            for (int m = 0; m < 4; ++m) {
                const unsigned row = (unsigned)u.pm * 256u + ai * 128 + wr * 64 + m * 16 + fr;
                f32x4 h0, h1;
#pragma unroll
                for (int e = 0; e < 4; ++e) {
                    const float g0 = acc[ai][0][m][0][e], g1 = acc[ai][0][m][1][e];
                    h0[e] = g0 * sigmoidf_(g0) * acc[ai][1][m][0][e];
                    h1[e] = g1 * sigmoidf_(g1) * acc[ai][1][m][1][e];
                }
                *(u32x4*)(HID + row * 1024 + pnl * 128 + wc * 32 + 8 * fq) = pack8(h0, h1);
            }
    }
};
struct EpiMoe2 {
    static constexpr bool PERM = true, AFTER_DRAIN = false;
    bf16* OUTE; const float* selg;
    __device__ __forceinline__ void operator()(const f32x4 (&acc)[2][2][4][2], const pg8::Unit& u, int wr, int wc, int fr, int fq) const {
        const int pnl = u.pn & 3;
#pragma unroll
        for (int ai = 0; ai < 2; ++ai)
#pragma unroll
            for (int m = 0; m < 4; ++m) {
                const unsigned row = (unsigned)u.pm * 256u + ai * 128 + wr * 64 + m * 16 + fr;
                const float gt = selg[row];
#pragma unroll
                for (int bj = 0; bj < 2; ++bj)
                    *(u32x4*)(OUTE + row * 1024 + pnl * 256 + bj * 128 + wc * 32 + 8 * fq) = pack8(acc[ai][bj][m][0] * gt, acc[ai][bj][m][1] * gt);
            }
    }
};

struct TileSched {
    int nM, nN, G, c; bool latent_only;
    __device__ __forceinline__ bool next(int i, pg8::Unit& u) const {
        const long L = (long)i * G + c; if (L >= (long)nM * nN) return false;
        const int pmi = (int)(L / nN); u.pn = (int)(L % nN); u.pm = latent_only ? (pmi >> 3) * 9 + 1 + (pmi & 7) : pmi; return true;
    }
    __device__ __forceinline__ void a_ready(const pg8::Unit&) const {}
    __device__ __forceinline__ void done(const pg8::Unit&) const {}
};
struct InprojLastSched {
    int G, c;
    __device__ __forceinline__ bool next(int i, pg8::Unit& u) const {
        const int L = i * G + c; if (L >= 768) return false;
        if (L < 704) { const int pmi = L / 11; u.pn = L % 11; u.pm = (pmi >> 3) * 9 + 1 + (pmi & 7); }
        else { const int r = L - 704; u.pm = (r >> 3) * 9; const int k = r & 7; u.pn = k == 0 ? 2 : k + 3; }
        return true;
    }
    __device__ __forceinline__ void a_ready(const pg8::Unit&) const {}
    __device__ __forceinline__ void done(const pg8::Unit&) const {}
};
struct MoeSched {
    int nMe, nNe, G, c;
    __device__ __forceinline__ bool next(int i, pg8::Unit& u) const {
        const long L = (long)i * G + c; if (L >= (long)NE * nMe * nNe) return false;
        const int pnl = (int)(L % nNe), t = (int)(L / nNe), pml = t % nMe, e = t / nMe;
        u.pm = e * 9 + pml; u.pn = e * nNe + pnl; return true;
    }
    __device__ __forceinline__ void a_ready(const pg8::Unit&) const {}
    __device__ __forceinline__ void done(const pg8::Unit&) const {}
};

template <class Epi, class Sched>
__device__ __forceinline__ void gemm_ref(const pg8::Gemm g, const Sched& S, const Epi& E) {
    const int tid = threadIdx.x, wid = tid >> 6, lane = tid & 63, wr = wid >> 2, wc = wid & 3, fr = lane & 15, fq = lane >> 4;
    int K = g.K; asm volatile("" : "+s"(K));
    pg8::Unit u;
    for (int ui = 0; S.next(ui, u); ++ui) {
        f32x4 acc[2][2][4][2];
#pragma unroll
        for (int a = 0; a < 2; ++a)
#pragma unroll
            for (int b = 0; b < 2; ++b)
#pragma unroll
                for (int m = 0; m < 4; ++m)
#pragma unroll
                    for (int n = 0; n < 2; ++n) acc[a][b][m][n] = (f32x4){0.f, 0.f, 0.f, 0.f};
        const bf16* Ab = g.A + ((size_t)u.pm * 256 + wr * 64 + fr) * K;
        const bf16* Bb = g.Bt + ((size_t)u.pn * 256 + wc * 32 + 8 * fq) * K;
#pragma unroll
        for (int ai = 0; ai < 2; ++ai)
#pragma unroll
            for (int bj = 0; bj < 2; ++bj)
#pragma unroll
                for (int m = 0; m < 4; ++m)
#pragma unroll
                    for (int n = 0; n < 2; ++n)
#pragma unroll
                        for (int e = 0; e < 4; ++e) {
                            const bf16* ar = Ab + (size_t)(ai * 128 + m * 16) * K; const bf16* br = Bb + (size_t)(bj * 128 + 4 * n + e) * K;
                            float s0 = 0.f, s1 = 0.f;
#pragma unroll 2
                            for (int k0 = 0; k0 < K; k0 += 8) {
                                const u32x4 wa = *(const u32x4*)(ar + k0), wb = *(const u32x4*)(br + k0);
                                s0 += bflo(wa.x) * bflo(wb.x) + bflo(wa.y) * bflo(wb.y) + bflo(wa.z) * bflo(wb.z) + bflo(wa.w) * bflo(wb.w);
                                s1 += bfhi(wa.x) * bfhi(wb.x) + bfhi(wa.y) * bfhi(wb.y) + bfhi(wa.z) * bfhi(wb.z) + bfhi(wa.w) * bfhi(wb.w);
                            }
                            acc[ai][bj][m][n][e] = s0 + s1;
                            asm volatile("" ::: "memory");
                        }
        E(acc, u, wr, wc, fr, fq);
    }
}
template <class Epi, class Sched>
__device__ __forceinline__ void run_gemm(LAS unsigned char* lds, const pg8::Gemm g, const Sched& S, const Epi& E) {
#if GOLD_GEMM
    gemm_ref<Epi, Sched>(g, S, E);
    __syncthreads();
#else
    pg8::Gemm g2 = g; { int kd = g.K; asm volatile("" : "+s"(kd)); g2.K = kd; }
    pg8::gemm_phase<Epi, Sched, true, true>(lds, g2, S, E);
#endif
}

struct Args { const float* in[29]; float* out; unsigned char* ws; int ph_lo, ph_hi; };
enum { I_X = 0, I_C, I_CTX, I_CCTX, I_WMOD, I_BMOD, I_GPREMIX, I_GPOSTMIX, I_GPREFFN, I_GPOSTFFN, I_WIN, I_WOUT, I_QGAIN, I_KGAIN, I_RPB,
       I_W0, I_WUP, I_A0, I_AUP, I_GUP, I_KK, I_KA, I_RK, I_LNXW, I_LNXB, I_WROUTER, I_WEGATE, I_WEUP, I_WEDOWN };

struct Frame {
    LAS unsigned char* lds; volatile LAS unsigned* MISC; unsigned* ctl;
    int wave, vcu, G;
    const float* const* in; float* out; unsigned char* ws;
};
#define TID_ ((int)threadIdx.x)
#define LANE_ ((int)(threadIdx.x & 63u))
#define WSP(T_, off) ((T_*)(F.ws + (off)))

__device__ __forceinline__ void cvt_item(const float* src, int ld_src, bf16* dst, int ld_dst, LAS float* scr, int lane) {
#pragma unroll 8
    for (int i = 0; i < 32; ++i) { const int kk = 2 * i + (lane >> 5); scr[kk * 33 + (lane & 31)] = src[(size_t)kk * ld_src + (lane & 31)]; }
    LDS_WAIT(); asm volatile("" ::: "memory");
    const int c = lane & 7;
#pragma unroll
    for (int j = 0; j < 4; ++j) { const int n = (lane >> 3) + 8 * j; const LAS float* s = scr + (8 * c) * 33 + n;
        u32x4 o; o.x = pk2(s[0 * 33], s[1 * 33]); o.y = pk2(s[2 * 33], s[3 * 33]); o.z = pk2(s[4 * 33], s[5 * 33]); o.w = pk2(s[6 * 33], s[7 * 33]);
        *(u32x4*)(dst + (size_t)n * ld_dst + 8 * c) = o; }
    LDS_WAIT(); asm volatile("" ::: "memory");
}
__device__ __forceinline__ void cvt_moe_item(Frame& F, int l, int it, LAS float* scr, int lane) {
    const int which = it >> 13, r = it & 8191, e = r >> 9, q = r & 511, kb = q >> 5, nb = q & 31, n0 = nb * 32;
    const float* W = F.in[which == 0 ? I_WEGATE : (which == 1 ? I_WEUP : I_WEDOWN)] + ((size_t)(l * NE + e) * 1024 + kb * 64) * 1024 + n0;
    bf16* dst;
    if (which < 2) dst = WSP(bf16, WS_WGU) + ((size_t)e * 2048 + (n0 >> 7) * 256 + which * 128 + (n0 & 127)) * 1024 + kb * 64;
    else dst = WSP(bf16, WS_WD) + ((size_t)e * 1024 + n0) * 1024 + kb * 64;
    cvt_item(W, 1024, dst, 1024, scr, lane);
}
constexpr int CVT_NMINI = 3 * 8192 / NWAVES, CW_CVTQ = 40960;
__device__ __forceinline__ void cvt_moe_mini(Frame& F, int l, int mb) {
    int lane = LANE_; asm volatile("" : "+v"(lane));
    cvt_moe_item(F, l, mb * NWAVES + F.wave, (LAS float*)(F.lds + F.wave * 16384), lane);
}
__device__ __forceinline__ void cvt_moe_drain(Frame& F, int l, int n) {
    for (;;) {
        if (TID_ == 0) F.MISC[17] = atomicAdd(F.ctl + CW_CVTQ + 64 * l, (unsigned)n);
        __syncthreads();
        const int base = (int)F.MISC[17];
        __syncthreads();
        if (base >= CVT_NMINI) break;
#pragma unroll 1
        for (int k = 0; k < n; ++k) if (base + k < CVT_NMINI) cvt_moe_mini(F, l, base + k);
        __syncthreads();
    }
}

__device__ __forceinline__ void phase_init(Frame& F) {
    const int tid = TID_;
    {
        LAS float* sil = (LAS float*)F.lds;
        LAS float* red = (LAS float*)(F.lds + 40960);
        float* MOD = WSP(float, WS_MOD);
        bool have = false;
        for (int it = F.vcu; it < 2 * 96; it += F.G) {
            if (!have) {
                for (int i = tid; i < 9 * 1024; i += NTHREADS) { const int r = i >> 10, k = i & 1023; const float cv = (r < 8) ? F.in[I_C][r * 1024 + k] : F.in[I_CCTX][k]; sil[i] = cv / (1.f + expf(-cv)); }
                __syncthreads(); have = true;
            }
            const int l = it / 96, n0 = (it % 96) * 64, ks = tid >> 6, col = tid & 63;
            float acc[9];
#pragma unroll
            for (int r = 0; r < 9; ++r) acc[r] = 0.f;
            const float* w = F.in[I_WMOD] + ((size_t)l * 1024 + ks * 128) * 6144 + n0 + col;
            for (int k0 = 0; k0 < 128; k0 += 16) {
                float wv[16];
#pragma unroll
                for (int k = 0; k < 16; ++k) wv[k] = w[(size_t)(k0 + k) * 6144];
#pragma unroll
                for (int k = 0; k < 16; ++k)
#pragma unroll
                    for (int r = 0; r < 9; ++r) acc[r] += sil[r * 1024 + ks * 128 + k0 + k] * wv[k];
            }
#pragma unroll
            for (int r = 0; r < 9; ++r) red[(ks * 9 + r) * 64 + col] = acc[r];
            __syncthreads();
            for (int o = tid; o < 576; o += NTHREADS) { const int r = o >> 6, cc = o & 63; float s = 0.f;
#pragma unroll
                for (int k2 = 0; k2 < 8; ++k2) s += red[(k2 * 9 + r) * 64 + cc];
                MOD[(size_t)(l * 9 + r) * 6144 + n0 + cc] = s + F.in[I_BMOD][l * 6144 + n0 + cc]; }
            __syncthreads();
        }
        __syncthreads();
    }
    {
        LAS float* scr = (LAS float*)(F.lds + F.wave * 16384);
        const int gw = F.vcu * NWAVES + F.wave, NGW = F.G * NWAVES;
        bf16* WIN = WSP(bf16, WS_WIN); bf16* WOUT = WSP(bf16, WS_WOUT);
        for (int it = gw; it < 2 * (1344 + 512); it += NGW) {
            const int l = it / 1856, r = it % 1856;
            if (r < 1344) { const int kb = r / 84, n0 = (r % 84) * 32; const int dn = n0 < 768 ? n0 : (n0 < 1920 ? n0 + 768 : n0 - 1152);
                cvt_item(F.in[I_WIN] + ((size_t)l * 1024 + kb * 64) * 2688 + n0, 2688, WIN + ((size_t)l * NINP + dn) * 1024 + kb * 64, 1024, scr, LANE_); }
            else { const int q = r - 1344, kb = q >> 5, n0 = (q & 31) * 32;
                cvt_item(F.in[I_WOUT] + ((size_t)l * 1024 + kb * 64) * 1024 + n0, 1024, WOUT + ((size_t)l * 1024 + n0) * 1024 + kb * 64, 1024, scr, LANE_); }
        }
    }
    {
        const size_t gt = (size_t)F.vcu * NTHREADS + tid, NT = (size_t)F.G * NTHREADS;
        u32x4* WIN4 = WSP(u32x4, WS_WIN);
        for (size_t i = gt; i < (size_t)2 * 128 * 128; i += NT) { const int l = (int)(i >> 14), r = (int)(i & 16383); WIN4[((size_t)l * NINP + 2688) * 128 + r] = (u32x4){0u, 0u, 0u, 0u}; }
        bf16* LORA = WSP(bf16, WS_LORA);
        for (size_t i = gt; i < (size_t)2 * 1280 * 384; i += NT) { const int l = (int)(i / (1280 * 384)), r = (int)(i % (1280 * 384)), n = r / 384, k = r % 384, tile = n >> 8, nn = n & 255;
            float v = 0.f;
            if (tile < 2) { const int d = tile, kk = k - 64 * d; if (kk >= 0 && kk < 64) v = F.in[I_WUP][(((size_t)l * 2 + d) * 64 + kk) * 256 + nn]; }
            else if (tile < 4) { const int d = tile - 2, kk = k - 128 - 64 * d; if (kk >= 0 && kk < 64) v = F.in[I_AUP][(((size_t)l * 2 + d) * 64 + kk) * 256 + nn]; }
            else { const int kk = k - 256; if (kk >= 0) v = F.in[I_GUP][((size_t)l * 128 + kk) * 256 + nn]; }
            LORA[i] = (bf16)f2bf(v); }
    }
}

__device__ __forceinline__ const float* in_row(Frame& F, int b, int t) { return t < CTXL ? F.in[I_CTX] + ((size_t)b * CTXL + t) * 1024 : F.in[I_X] + ((size_t)b * SEQ + (t - CTXL)) * 1024; }
__device__ __forceinline__ f32x4 ldbf4(const bf16* p) { const u32x2 w = *(const u32x2*)p; return (f32x4){bflo(w.x), bfhi(w.x), bflo(w.y), bfhi(w.y)}; }
__device__ __forceinline__ void stbf4(bf16* p, const f32x4 v) { u32x2 w; w.x = pk2(v[0], v[1]); w.y = pk2(v[2], v[3]); *(u32x2*)p = w; }
__device__ __forceinline__ float row_ss(const f32x4 (&v)[4]) {
    float s = 0.f;
#pragma unroll
    for (int j = 0; j < 4; ++j) s += (v[j][0] * v[j][0] + v[j][1] * v[j][1]) + (v[j][2] * v[j][2] + v[j][3] * v[j][3]);
    return wave_sum(s);
}
__device__ __forceinline__ void mod_store(const f32x4 (&x)[4], float rinv, const float* g, const float* shift, const float* scale, bf16* dst, int lane, f32x4 (&h)[4]) {
#pragma unroll
    for (int j = 0; j < 4; ++j) { const int e = 256 * j + 4 * lane;
        const f32x4 gg = *(const f32x4*)(g + e), sh = *(const f32x4*)(shift + e), sc = *(const f32x4*)(scale + e);
        h[j] = x[j] * rinv * gg * (sc + 1.f) + sh;
        u32x2 w; w.x = pk2(h[j][0], h[j][1]); w.y = pk2(h[j][2], h[j][3]); *(u32x2*)(dst + e) = w; }
}
__device__ __forceinline__ void phase_row0(Frame& F) {
    const int gw = F.vcu * NWAVES + F.wave, NGW = F.G * NWAVES, lane = LANE_;
    bf16* H = WSP(bf16, WS_H); const float* MOD = WSP(float, WS_MOD);
    const int RB = M / F.G, m0 = F.vcu * RB + F.wave, mend = F.vcu * RB + RB;
    f32x4 xn[4];
    if (m0 < mend) { const float* xin = in_row(F, m0 / T, m0 % T);
#pragma unroll
        for (int j = 0; j < 4; ++j) xn[j] = *(const f32x4*)(xin + 256 * j + 4 * lane); }
    for (int m = m0; m < mend; m += NWAVES) { const int b = m / T, t = m % T, r = t < CTXL ? 8 : b;
        f32x4 x[4], h[4];
#pragma unroll
        for (int j = 0; j < 4; ++j) x[j] = xn[j];
        if (m + NWAVES < mend) { const float* xin = in_row(F, (m + NWAVES) / T, (m + NWAVES) % T);
#pragma unroll
            for (int j = 0; j < 4; ++j) xn[j] = *(const f32x4*)(xin + 256 * j + 4 * lane); }
        const float rinv = rsqrtf(row_ss(x) * (1.f / 1024.f) + 1e-6f);
        const float* md = MOD + (size_t)(0 * 9 + r) * 6144;
        mod_store(x, rinv, F.in[I_GPREMIX], md, md + 1024, H + (size_t)m * 1024, lane, h);
    }
}
__device__ __forceinline__ void phase_row1(Frame& F, int l, int dry = 0) {
    const int gw = F.vcu * NWAVES + F.wave, NGW = F.G * NWAVES, lane = LANE_;
    const bf16* X = WSP(bf16, WS_X); const bf16* Y = WSP(bf16, WS_Y); const float* MOD = WSP(float, WS_MOD);
    bf16* Xs = dry ? WSP(bf16, WS_XE) : WSP(bf16, WS_X); bf16* H2 = dry ? WSP(bf16, WS_YD) : WSP(bf16, WS_H2);
    float* AFF = dry ? WSP(float, WS_O) + 4 * MiB : WSP(float, WS_AFF); int* INV = dry ? WSP(int, WS_O) + 2 * MiB : WSP(int, WS_INV);
    {
        const float* src = F.in[I_WROUTER] + (size_t)l * 1024 * 16; LAS float* dstl = (LAS float*)F.lds;
        for (int i = TID_; i < 16384; i += NTHREADS) dstl[(i & 15) * 1024 + (i >> 4)] = src[i];
        __syncthreads();
    }
    const LAS float* wbase = (const LAS float*)F.lds + 4 * lane;
    const bool lat_only = (l == NL - 1); const int RB = (lat_only ? NB * SEQ : M) / F.G, jbase = F.vcu * RB + F.wave, jend = F.vcu * RB + RB;
    auto row_of = [&](int j) { return j >= jend ? M : (lat_only ? (j >> 11) * T + CTXL + (j & 2047) : j); };
    auto next_row = [&](int m) { const int j = lat_only ? ((m / T) << 11) + (m % T) - CTXL : m; return row_of(j + NWAVES); };
    int m = row_of(jbase);
    f32x4 xn[4], yn[4];
    if (m < M) { const float* xin = in_row(F, m / T, m % T);
#pragma unroll
        for (int j = 0; j < 4; ++j) { yn[j] = ldbf4(Y + (size_t)m * 1024 + 256 * j + 4 * lane); xn[j] = (l == 0) ? *(const f32x4*)(xin + 256 * j + 4 * lane) : ldbf4(X + (size_t)m * 1024 + 256 * j + 4 * lane); } }
    for (; m < M; ) { const int b = m / T, t = m % T, r = t < CTXL ? 8 : b;
        const float* md = MOD + (size_t)(l * 9 + r) * 6144;
        f32x4 x[4], y[4], h[4];
#pragma unroll
        for (int j = 0; j < 4; ++j) { x[j] = xn[j]; y[j] = yn[j]; }
        const int mnext = next_row(m);
        if (mnext < M) { const float* xin = in_row(F, mnext / T, mnext % T);
#pragma unroll
            for (int j = 0; j < 4; ++j) { yn[j] = ldbf4(Y + (size_t)mnext * 1024 + 256 * j + 4 * lane); xn[j] = (l == 0) ? *(const f32x4*)(xin + 256 * j + 4 * lane) : ldbf4(X + (size_t)mnext * 1024 + 256 * j + 4 * lane); } }
        const float rinv = rsqrtf(row_ss(y) * (1.f / 1024.f) + 1e-6f);
#pragma unroll
        for (int j = 0; j < 4; ++j) { const int e = 256 * j + 4 * lane;
            const f32x4 gg = *(const f32x4*)(F.in[I_GPOSTMIX] + l * 1024 + e), gt = *(const f32x4*)(md + 2 * 1024 + e);
            x[j] = x[j] + gt * (y[j] * rinv * gg); if (dry != 3) stbf4(Xs + (size_t)m * 1024 + e, x[j]); }
        const float rinv2 = rsqrtf(row_ss(x) * (1.f / 1024.f) + 1e-6f);
        mod_store(x, rinv2, F.in[I_GPREFFN] + l * 1024, md + 3 * 1024, md + 4 * 1024, H2 + (size_t)m * 1024, lane, h);
        if (dry == 2) { m = mnext; continue; }
        float lg[16];
#pragma unroll
        for (int k = 0; k < 16; ++k) lg[k] = 0.f;
#pragma unroll
        for (int k = 0; k < 16; ++k) {
#pragma unroll
            for (int j = 0; j < 4; ++j) { const f32x4 wv = *(const LAS f32x4*)(wbase + k * 1024 + 256 * j); lg[k] += (h[j][0] * wv[0] + h[j][1] * wv[1]) + (h[j][2] * wv[2] + h[j][3] * wv[3]); }
            if ((k & 3) == 3) asm volatile("" ::: "memory");
        }
        {
            LAS float* red = (LAS float*)F.lds + 16384 + F.wave * 1024;
#pragma unroll
            for (int k = 0; k < 16; ++k) red[k * 64 + lane] = lg[k];
            LDS_WAIT(); asm volatile("" ::: "memory");
            const LAS f32x4* rp = (const LAS f32x4*)(red + (lane >> 2) * 64 + (lane & 3) * 16);
            const f32x4 q0 = rp[0], q1 = rp[1], q2 = rp[2], q3 = rp[3];
            float s = ((q0[0] + q0[1]) + (q0[2] + q0[3])) + ((q1[0] + q1[1]) + (q1[2] + q1[3])) + ((q2[0] + q2[1]) + (q2[2] + q2[3])) + ((q3[0] + q3[1]) + (q3[2] + q3[3]));
            s += dppf<0xB1>(s); s += dppf<0x4E>(s);
            const float mx = wave_max(s);
            const float ex = expf(s - mx);
            const float den = wave_sum(ex) * 0.25f;
            if ((lane & 3) == 0) { AFF[(size_t)m * 16 + (lane >> 2)] = ex / den; INV[(size_t)m * 16 + (lane >> 2)] = -1; }
            LDS_WAIT(); asm volatile("" ::: "memory");
        }
        m = mnext;
    }
}
__device__ __forceinline__ void phase_row2(Frame& F, int l, bool dry = false) {
    const int gw = F.vcu * NWAVES + F.wave, NGW = F.G * NWAVES, lane = LANE_;
    const bf16* X = WSP(bf16, WS_X); const bf16* OUTE = WSP(bf16, WS_OUTE); const float* MOD = WSP(float, WS_MOD);
    bf16* Xs = dry ? WSP(bf16, WS_XE) : WSP(bf16, WS_X); bf16* H = dry ? WSP(bf16, WS_YD) : WSP(bf16, WS_H); float* outp = dry ? WSP(float, WS_XE) : F.out;
    const int* INV = WSP(int, WS_INV);
    const bool last = (l == NL - 1);
#if defined(TPROBE_ON)
    const float tp_scale = F.ctl[3000] ? 3.f : 1.f;
#else
    const float tp_scale = 1.f;
#endif
    const bool lat_only = last; const int RB = (lat_only ? NB * SEQ : M) / F.G, jbase = F.vcu * RB + F.wave, jend = F.vcu * RB + RB;
    auto row_of = [&](int j) { return j >= jend ? M : (lat_only ? (j >> 11) * T + CTXL + (j & 2047) : j); };
    auto next_row = [&](int m) { const int j = lat_only ? ((m / T) << 11) + (m % T) - CTXL : m; return row_of(j + NWAVES); };
    int m = row_of(jbase);
    f32x4 xn[4]; int invn = -1;
    if (m < M) { invn = INV[(size_t)m * 16 + (lane & 15)];
#pragma unroll
        for (int j = 0; j < 4; ++j) xn[j] = ldbf4(X + (size_t)m * 1024 + 256 * j + 4 * lane); }
    for (; m < M; ) { const int b = m / T, t = m % T, r = t < CTXL ? 8 : b;
        const float* md = MOD + (size_t)(l * 9 + r) * 6144;
        f32x4 x[4], f[4], h[4];
#pragma unroll
        for (int j = 0; j < 4; ++j) { x[j] = xn[j]; f[j] = (f32x4){0.f, 0.f, 0.f, 0.f}; }
        const int invl = invn;
        const int mnext = next_row(m);
        if (mnext < M) { invn = INV[(size_t)mnext * 16 + (lane & 15)];
#pragma unroll
            for (int j = 0; j < 4; ++j) xn[j] = ldbf4(X + (size_t)mnext * 1024 + 256 * j + 4 * lane); }
        for (int e = 0; e < 16; ++e) { const int rr = __shfl(invl, e);
            if (rr >= 0) {
#pragma unroll
                for (int j = 0; j < 4; ++j) { const u32x2 w = *(const u32x2*)(OUTE + (size_t)rr * 1024 + 256 * j + 4 * lane);
                    f[j][0] += bflo(w.x); f[j][1] += bfhi(w.x); f[j][2] += bflo(w.y); f[j][3] += bfhi(w.y); } } }
        const float rinv = rsqrtf(row_ss(f) * (1.f / 1024.f) + 1e-6f);
#pragma unroll
        for (int j = 0; j < 4; ++j) { const int e = 256 * j + 4 * lane;
            const f32x4 gg = *(const f32x4*)(F.in[I_GPOSTFFN] + l * 1024 + e), gt = *(const f32x4*)(md + 5 * 1024 + e);
            x[j] = x[j] + gt * (f[j] * rinv * gg);
            if (last) *(f32x4*)(outp + ((size_t)b * SEQ + (t - CTXL)) * 1024 + e) = x[j] * tp_scale;
            else stbf4(Xs + (size_t)m * 1024 + e, x[j]); }
        if (!last) {
            const float rinv2 = rsqrtf(row_ss(x) * (1.f / 1024.f) + 1e-6f);
            const float* md2 = MOD + (size_t)((l + 1) * 9 + r) * 6144;
            mod_store(x, rinv2, F.in[I_GPREMIX] + (l + 1) * 1024, md2, md2 + 1024, H + (size_t)m * 1024, lane, h);
        }
        m = mnext;
    }
}

__device__ __forceinline__ void phase_qkprep(Frame& F, int l, bool dry = false) {
    const int gw = F.vcu * NWAVES + F.wave, NGW = F.G * NWAVES, lane = LANE_;
    bf16* QKV = WSP(bf16, WS_QKV); bf16* QO = dry ? WSP(bf16, WS_YD) : QKV;
    const float qg = F.in[I_QGAIN][l * 64 + lane] * C2, kg = F.in[I_KGAIN][l * 64 + lane];
    const int i16 = lane & 15; const bool second = (lane & 16) != 0, colseg = (lane & 32) != 0;
    const float inv = exp2f(-(float)i16 * (13.287712379549449f / 16.f));
    const int RB = M / F.G;
    for (int m = F.vcu * RB + F.wave; m < F.vcu * RB + RB; m += NWAVES) { const int t = m % T; const bool ctx = t < CTXL;
        const int s0 = (l == NL - 1 && ctx) ? 8 : 0;
        const bf16* p = QKV + (size_t)m * 1536 + lane; bf16* po = QO + (size_t)m * 1536 + lane;
        float x[10];
#pragma unroll
        for (int s = 0; s < 10; ++s) x[s] = (s >= s0) ? bf2f(p[s * 64]) : 0.f;
        float cs = 1.f, sn = 0.f;
        if (!ctx) { const int pos = t - CTXL; const float ang = (float)(colseg ? (pos & 63) : (pos >> 6)) * inv; cs = cosf(ang); sn = sinf(ang); if (!second) sn = -sn; }
#pragma unroll
        for (int s = 0; s < 10; ++s) {
            if (s < s0) continue;
            const float ss = wave_sum(x[s] * x[s]);
            float y = x[s] * __builtin_amdgcn_rsqf(ss * (1.f / 64.f) + 1e-6f) * (s < 8 ? qg : kg);
            const float other = __shfl_xor(y, 16);
            y = y * cs + other * sn;
            po[s * 64] = (bf16)f2bf(y);
        }
    }
}
#include <hip/hip_bf16.h>
#include <cmath>
namespace attn_body {
using bf16=__hip_bfloat16;
using bf16x8=__attribute__((ext_vector_type(8)))short;
using s16x4=__attribute__((ext_vector_type(4)))short;
using f32x16=__attribute__((ext_vector_type(16)))float;
using u32x4=__attribute__((ext_vector_type(4)))unsigned;
constexpr int D=64,QP=1536,OP=1024;
constexpr int NW=8,QBLK=32,QB=QBLK*NW,KVBLK=64;
__device__ __forceinline__ int crow(int r,int hi){return (r&3)+8*(r>>2)+4*hi;}
#define SBAR() __builtin_amdgcn_sched_barrier(0)
constexpr int NSLOT=3, SLOTB=8192;
constexpr int LDS_K=0, LDS_V=NSLOT*SLOTB, LDS_WS=2*NSLOT*SLOTB, LDS_OST=LDS_WS+NW*64*4, LDS_RPB=LDS_OST+NW*4096, LDS_BYTES=LDS_RPB+3072;
constexpr float C2=0.125f*1.4426950408889634f;
__device__ __forceinline__ void glds16(const void*gsrc,unsigned lds_dst){unsigned keep;
  asm volatile("s_mov_b32 %0, m0\n\ts_mov_b32 m0, %2\n\ts_nop 0\n\tglobal_load_lds_dwordx4 %1, off\n\ts_mov_b32 m0, %0":"=&s"(keep):"v"(gsrc),"s"(lds_dst):"memory");}
__device__ __forceinline__ float max3f(float a,float b,float c){float r;asm("v_max3_f32 %0, %1, %2, %3":"=v"(r):"v"(a),"v"(b),"v"(c));return r;}
__device__ __forceinline__ float max2f(float a,float b){float r;asm("v_max_f32_e32 %0, %1, %2":"=v"(r):"v"(a),"v"(b));return r;}
__device__ __forceinline__ float fadd_s(float a,float b){float r;asm("v_add_f32_e32 %0, %1, %2":"=v"(r):"v"(a),"v"(b));return r;}
__device__ __forceinline__ float fsub_s(float a,float b){float r;asm("v_sub_f32_e32 %0, %1, %2":"=v"(r):"v"(a),"v"(b));return r;}
typedef float f32x2_t __attribute__((ext_vector_type(2))); typedef __bf16 bf16x2_t __attribute__((ext_vector_type(2)));
__device__ __forceinline__ unsigned cvtpk_s(float lo,float hi){f32x2_t v={lo,hi};bf16x2_t b=__builtin_convertvector(v,bf16x2_t);return __builtin_bit_cast(unsigned,b);}
#define WAIT_BAR(N) asm volatile("s_waitcnt vmcnt(" #N ") lgkmcnt(0)\n\ts_barrier":::"memory")

__device__ __forceinline__ void qkt(f32x16&p0,f32x16&p1,const char*Kslot,const bf16x8*qr,const f32x16&negm,int r32,int hi){
  const char*kb=Kslot+hi*1024+r32*16;
  #pragma unroll
  for(int d0=0;d0<4;++d0){
    const bf16x8 b0=*reinterpret_cast<const bf16x8*>(kb+d0*2048);
    const bf16x8 b1=*reinterpret_cast<const bf16x8*>(kb+d0*2048+512);
    if(d0==0){p0=__builtin_amdgcn_mfma_f32_32x32x16_bf16(b0,qr[0],negm,0,0,0);p1=__builtin_amdgcn_mfma_f32_32x32x16_bf16(b1,qr[0],negm,0,0,0);}
    else{p0=__builtin_amdgcn_mfma_f32_32x32x16_bf16(b0,qr[d0],p0,0,0,0);p1=__builtin_amdgcn_mfma_f32_32x32x16_bf16(b1,qr[d0],p1,0,0,0);}}
}
typedef __attribute__((address_space(3))) const char* lds_cptr;
typedef short v4i16_t __attribute__((ext_vector_type(4)));
__device__ __forceinline__ void kload8(bf16x8*kf,lds_cptr kp){
  kf[0]=*(const __attribute__((address_space(3))) bf16x8*)(kp);      kf[1]=*(const __attribute__((address_space(3))) bf16x8*)(kp+512);
  kf[2]=*(const __attribute__((address_space(3))) bf16x8*)(kp+2048); kf[3]=*(const __attribute__((address_space(3))) bf16x8*)(kp+2560);
  kf[4]=*(const __attribute__((address_space(3))) bf16x8*)(kp+4096); kf[5]=*(const __attribute__((address_space(3))) bf16x8*)(kp+4608);
  kf[6]=*(const __attribute__((address_space(3))) bf16x8*)(kp+6144); kf[7]=*(const __attribute__((address_space(3))) bf16x8*)(kp+6656);
}
__device__ __forceinline__ void kload2(bf16x8*kf,lds_cptr kp,int j){ kf[2*j]=*(const __attribute__((address_space(3))) bf16x8*)(kp+j*2048); kf[2*j+1]=*(const __attribute__((address_space(3))) bf16x8*)(kp+j*2048+512); }
__device__ __forceinline__ s16x4 vtr(lds_cptr p){ return __builtin_bit_cast(s16x4,__builtin_amdgcn_ds_read_tr16_b64_v4i16((__attribute__((address_space(3))) v4i16_t*)p)); }
__device__ __forceinline__ float rowmax(const f32x16&p0,const f32x16&p1){
  float a=max3f(p0[0],p0[1],p1[0]),b=max3f(p0[2],p0[3],p1[1]);a=max3f(a,p1[2],p1[3]);
  #pragma unroll
  for(int r=4;r<16;r+=4){a=max3f(a,p0[r],p0[r+1]);b=max3f(b,p0[r+2],p0[r+3]);a=max3f(a,p1[r],p1[r+1]);b=max3f(b,p1[r+2],p1[r+3]);}
  const float m=max2f(a,b);
  auto rr=__builtin_amdgcn_permlane32_swap(__float_as_uint(m),__float_as_uint(m),false,false);
  return max2f(__uint_as_float(rr[0]),__uint_as_float(rr[1]));
}
__device__ __forceinline__ void pv(f32x16*o,int vb,bf16x8 pa0,bf16x8 pa1,bf16x8 pa2,bf16x8 pa3){
  #pragma unroll
  for(int d0=0;d0<2;++d0){s16x4 lo[4],hi[4];
    #pragma unroll
    for(int ks=0;ks<4;++ks){
      asm volatile("ds_read_b64_tr_b16 %0,%1 offset:%c2":"=&v"(lo[ks]):"v"(vb),"i"(d0*4096+ks*1024):"memory");
      asm volatile("ds_read_b64_tr_b16 %0,%1 offset:%c2":"=&v"(hi[ks]):"v"(vb),"i"(d0*4096+ks*1024+512):"memory");}
    asm volatile("s_waitcnt lgkmcnt(0)":::"memory");SBAR();
    #define PK(k) (bf16x8){lo[k][0],lo[k][1],lo[k][2],lo[k][3],hi[k][0],hi[k][1],hi[k][2],hi[k][3]}
    o[d0]=__builtin_amdgcn_mfma_f32_32x32x16_bf16(pa0,PK(0),o[d0],0,0,0);
    o[d0]=__builtin_amdgcn_mfma_f32_32x32x16_bf16(pa1,PK(1),o[d0],0,0,0);
    o[d0]=__builtin_amdgcn_mfma_f32_32x32x16_bf16(pa2,PK(2),o[d0],0,0,0);
    o[d0]=__builtin_amdgcn_mfma_f32_32x32x16_bf16(pa3,PK(3),o[d0],0,0,0);
    #undef PK
  }
}

#ifndef ATTN_STORE16
#define ATTN_STORE16(p,v) (*(u32x4*)(p)=(v))
#endif
template<int THRL,bool WIN> __device__ __forceinline__ void attn_unit(const bf16*Qw0,const bf16*__restrict__ Kh,const bf16*__restrict__ Vh,bf16*Ow0,const int NT,const int toff,const int rb,const int rs0,const float*rpbh,char*shm){
  int tid_=threadIdx.x; asm volatile("":"+v"(tid_));
  const int tid=tid_,lane=tid&63,r32=lane&31,hi=lane>>5; const int wid=__builtin_amdgcn_readfirstlane(tid>>6);
  const bf16*Qw=Qw0+(long)(wid*QBLK)*QP;
  const unsigned lds0=(unsigned)(uintptr_t)shm;
  float*wsf=(float*)(shm+LDS_WS)+wid*64;
  const bf16*ksrc=Kh+(long)lane*QP+wid*8;
  const bf16*vsrc=Vh+(long)(16*(wid&3)+(lane>>2))*QP+(wid>>2)*32+(lane&3)*8;
  const unsigned kdst=lds0+LDS_K+wid*1024, vdst=lds0+LDS_V+wid*1024;
  #define TROW(t) ((long)(((t)+(((t)>=4)?toff:0))*KVBLK)*QP)
  #define DMA_K(t,slot) glds16(ksrc+TROW(t),(unsigned)__builtin_amdgcn_readfirstlane(kdst+(slot)))
  #define DMA_V(t,slot) glds16(vsrc+TROW(t),(unsigned)__builtin_amdgcn_readfirstlane(vdst+(slot)))
  const int vb0=(int)(lds0+LDS_V)+((lane>>4)&1)*32+(lane&3)*8+(4*hi+((lane&15)>>2))*64;
  const char*Kbase=shm+LDS_K; bf16x8 kf[8];
  const lds_cptr shm3=(lds_cptr)shm; const lds_cptr kp0=shm3+LDS_K+hi*1024+r32*16; const lds_cptr vp0=shm3+LDS_V+((lane>>4)&1)*32+(lane&3)*8+(4*hi+((lane&15)>>2))*64;
  DMA_K(0,0);DMA_V(0,0);DMA_K(1,SLOTB);
  bf16x8 qr[4];
  #pragma unroll
  for(int d0=0;d0<4;++d0)qr[d0]=*reinterpret_cast<const bf16x8*>(&Qw[(long)r32*QP+d0*16+hi*8]);
  float mhat=0.f,l_reg=0.f;f32x16 o[2];o[0]=f32x16{};o[1]=f32x16{};f32x16 negm=f32x16{};asm volatile("":"+v"(negm));
  const int gr=4*rb+(wid>>1), gc=(wid&1)*32+r32, rsq=min(max(gr-4,0),24), csq=min(max(gc-8,0),48);
  const float*rpbl=(const float*)(shm+LDS_RPB+256)+(15-gc+4*hi);
  const int kcb=4*hi-csq;
  if(WIN){ for(int i_=tid;i_<15*31;i_+=512)((float*)(shm+LDS_RPB+256))[i_]=rpbh[i_]*1.4426950408889634f; }
  #define CMASK(P0,P1,t) do{ if(WIN && (t)>=4){ const int kr_=rs0+(t)-4; const bool rowok_=(kr_>=rsq)&&(kr_<rsq+8); \
      if(!rowok_){ _Pragma("unroll") for(int r=0;r<16;++r){P0[r]=-INFINITY;P1[r]=-INFINITY;} } \
      else { const float*bp_=rpbl+(kr_-gr+7)*31; \
        _Pragma("unroll") for(int r=0;r<16;++r){ const int o_=(r&3)+8*(r>>2); \
          const float b0_=bp_[o_], b1_=bp_[o_+32]; \
          P0[r]=((unsigned)(kcb+o_)<16u)?P0[r]+b0_:-INFINITY; P1[r]=((unsigned)(kcb+o_+32)<16u)?P1[r]+b1_:-INFINITY; } } } }while(0)
  bool resc=false;
  #define START(P0,P1) do{ const float rm=rowmax(P0,P1); resc=false; \
    { const float dl=rm; mhat=fadd_s(mhat,dl); \
      _Pragma("unroll") for(int r=0;r<16;++r){P0[r]=fsub_s(P0[r],dl);P1[r]=fsub_s(P1[r],dl);} \
      _Pragma("unroll") for(int r=0;r<16;++r)negm[r]=-mhat; asm volatile("":"+v"(negm)); } \
    _Pragma("unroll") for(int r=0;r<16;++r)P0[r]=__builtin_amdgcn_exp2f(P0[r]); }while(0)
  #define RESC() do{ if(resc){ asm volatile("s_waitcnt lgkmcnt(0)":::"memory"); \
      _Pragma("unroll") for(int d_=0;d_<2;++d_) _Pragma("unroll") for(int r=0;r<16;++r)o[d_][r]*=wsf[crow(r,hi)]; } }while(0)
  f32x16 pA0,pA1,pB0,pB1;
  int sl_prev=0,sl_cur=0,sl_next=SLOTB;
  #define ROT() do{sl_prev=sl_cur;sl_cur=sl_next;sl_next=(sl_next==(NSLOT-1)*SLOTB)?0:sl_next+SLOTB;}while(0)
  DMA_K(2,2*SLOTB);
  WAIT_BAR(3);
  qkt(pA0,pA1,Kbase,qr,negm,r32,hi);asm volatile("s_nop 15\n\ts_nop 7":"+v"(pA0),"+v"(pA1));CMASK(pA0,pA1,0);
  START(pA0,pA1);
  _Pragma("unroll") for(int r=0;r<16;++r)pA1[r]=__builtin_amdgcn_exp2f(pA1[r]);
  WAIT_BAR(0);
  DMA_K(3,0);DMA_V(1,SLOTB);
  ROT();
  kload8(kf,kp0+sl_cur);
  WAIT_BAR(2);
  s16x4 vlo[8],vhi[8]; u32x4 pw0,pw1,pw2,pw3;
  #define PKW(P,B) cvtpk_s(P[B],P[B+1])
  #define PAF(k) __builtin_bit_cast(bf16x8,pw##k)
  #define VFR(i) (bf16x8){vlo[i][0],vlo[i][1],vlo[i][2],vlo[i][3],vhi[i][0],vhi[i][1],vhi[i][2],vhi[i][3]}
  #define PIN(x) asm volatile("":"+v"(x))
  #define MX3(a,b,c) __builtin_fmaxf(__builtin_fmaxf((a),(b)),(c))
  #define GAPA(MF,A0,A1,A2,A3,W0,W1,PW) do{ MF; sacc+=A0; sacc+=A1; sacc+=A2; sacc+=A3; PIN(sacc); W0; W1; PIN(PW); SBAR(); }while(0)
  #define EX(v) __builtin_amdgcn_exp2f(v)
  #define GAPB(MF,X,B) do{ MF; X[B]=EX(X[B]); X[B+1]=EX(X[B+1]); X[B+2]=EX(X[B+2]); X[B+3]=EX(X[B+3]); PIN(X); SBAR(); }while(0)
  #define VRD(i) do{ vlo[i]=vtr(vp_+(((i)>>2)*4096+((i)&3)*1024)); vhi[i]=vtr(vp_+(((i)>>2)*4096+((i)&3)*1024+512)); }while(0)
  #define KRD(G,j) do{ if(G){ kload2(kf,kp0+sl_next,j); SBAR(); } }while(0)
  #define STEP(C0,C1,P0,P1,t,GK,GV,GL) do{ SBAR(); \
    const lds_cptr vp_=vp0+sl_prev; \
    VRD(0); SBAR(); float sacc=(P0[0]+P0[1]); \
    GAPA(C0=__builtin_amdgcn_mfma_f32_32x32x16_bf16(kf[0],qr[0],negm,0,0,0), P0[2],P0[3],P0[4],P0[5],     pw0[0]=PKW(P0,0), pw0[1]=PKW(P0,2), pw0); \
    VRD(4); SBAR(); GAPA(C1=__builtin_amdgcn_mfma_f32_32x32x16_bf16(kf[1],qr[0],negm,0,0,0), P0[6],P0[7],P0[8],P0[9],     pw0[2]=PKW(P0,4), pw0[3]=PKW(P0,6), pw0); \
    VRD(1); SBAR(); GAPA(C0=__builtin_amdgcn_mfma_f32_32x32x16_bf16(kf[2],qr[1],C0,0,0,0),   P0[10],P0[11],P0[12],P0[13], pw1[0]=PKW(P0,8), pw1[1]=PKW(P0,10), pw1); \
    VRD(5); SBAR(); GAPA(C1=__builtin_amdgcn_mfma_f32_32x32x16_bf16(kf[3],qr[1],C1,0,0,0),   P0[14],P0[15],P1[0],P1[1],   pw1[2]=PKW(P0,12),pw1[3]=PKW(P0,14), pw1); \
    VRD(2); SBAR(); GAPA(C0=__builtin_amdgcn_mfma_f32_32x32x16_bf16(kf[4],qr[2],C0,0,0,0),   P1[2],P1[3],P1[4],P1[5],     pw2[0]=PKW(P1,0), pw2[1]=PKW(P1,2), pw2); \
    VRD(6); SBAR(); GAPA(C1=__builtin_amdgcn_mfma_f32_32x32x16_bf16(kf[5],qr[2],C1,0,0,0),   P1[6],P1[7],P1[8],P1[9],     pw2[2]=PKW(P1,4), pw2[3]=PKW(P1,6), pw2); \
    VRD(3); SBAR(); GAPA(C0=__builtin_amdgcn_mfma_f32_32x32x16_bf16(kf[6],qr[3],C0,0,0,0),   P1[10],P1[11],P1[12],P1[13], pw3[0]=PKW(P1,8), pw3[1]=PKW(P1,10), pw3); \
    VRD(7); SBAR(); GAPA(C1=__builtin_amdgcn_mfma_f32_32x32x16_bf16(kf[7],qr[3],C1,0,0,0),   P1[14],P1[15],0.f,0.f,       pw3[2]=PKW(P1,12),pw3[3]=PKW(P1,14), pw3); \
    l_reg+=sacc; \
    if(GK){DMA_K((t)+3,sl_cur);} if(GV){DMA_V((t)+1,sl_next);} \
    CMASK(C0,C1,t); \
    { float a=MX3(C0[0],C0[1],C1[0]),b=MX3(C0[2],C0[3],C1[1]); a=MX3(a,C1[2],C1[3]); \
      _Pragma("unroll") for(int r=4;r<16;r+=4){a=MX3(a,C0[r],C0[r+1]);b=MX3(b,C0[r+2],C0[r+3]);a=MX3(a,C1[r],C1[r+1]);b=MX3(b,C1[r+2],C1[r+3]);} \
      float rm=__builtin_fmaxf(a,b); { auto rr=__builtin_amdgcn_permlane32_swap(__float_as_uint(rm),__float_as_uint(rm),false,false); rm=__builtin_fmaxf(__uint_as_float(rr[0]),__uint_as_float(rr[1])); } \
      resc=false; \
      if(__builtin_expect(__any(rm>(float)THRL),0)){ const float dl=__builtin_fmaxf(rm,0.f); mhat+=dl; \
        _Pragma("unroll") for(int r=0;r<16;++r){C0[r]-=dl;C1[r]-=dl;} \
        _Pragma("unroll") for(int r=0;r<16;++r)negm[r]=-mhat; asm volatile("":"+v"(negm)); \
        const float f=__builtin_amdgcn_exp2f(-dl); l_reg*=f; if(hi==0)wsf[r32]=f; resc=true; } } \
    SBAR(); \
    GAPB(o[0]=__builtin_amdgcn_mfma_f32_32x32x16_bf16(PAF(0),VFR(0),o[0],0,0,0), C0,0); \
    GAPB(o[1]=__builtin_amdgcn_mfma_f32_32x32x16_bf16(PAF(0),VFR(4),o[1],0,0,0), C0,4); \
    KRD(GL,0); GAPB(o[0]=__builtin_amdgcn_mfma_f32_32x32x16_bf16(PAF(1),VFR(1),o[0],0,0,0), C0,8); \
    KRD(GL,1); GAPB(o[1]=__builtin_amdgcn_mfma_f32_32x32x16_bf16(PAF(1),VFR(5),o[1],0,0,0), C0,12); \
    KRD(GL,2); GAPB(o[0]=__builtin_amdgcn_mfma_f32_32x32x16_bf16(PAF(2),VFR(2),o[0],0,0,0), C1,0); \
    KRD(GL,3); GAPB(o[1]=__builtin_amdgcn_mfma_f32_32x32x16_bf16(PAF(2),VFR(6),o[1],0,0,0), C1,4); \
    GAPB(o[0]=__builtin_amdgcn_mfma_f32_32x32x16_bf16(PAF(3),VFR(3),o[0],0,0,0), C1,8); \
    GAPB(o[1]=__builtin_amdgcn_mfma_f32_32x32x16_bf16(PAF(3),VFR(7),o[1],0,0,0), C1,12); \
    }while(0)
  int t=1;
  for(;t+5<NT;t+=2){
    STEP(pB0,pB1,pA0,pA1,t,true,true,true);     WAIT_BAR(2); RESC(); ROT();
    STEP(pA0,pA1,pB0,pB1,t+1,true,true,true);   WAIT_BAR(2); RESC(); ROT();
  }
  #define ENDW(tt) do{ if((tt)+3<NT){WAIT_BAR(2);} else if((tt)+2<NT){WAIT_BAR(1);} else {WAIT_BAR(0);} }while(0)
  for(;t+1<NT;t+=2){
    STEP(pB0,pB1,pA0,pA1,t,(t+3<NT),(t+1<NT),(t+1<NT));       ENDW(t);   RESC(); ROT();
    STEP(pA0,pA1,pB0,pB1,t+1,(t+4<NT),(t+2<NT),(t+2<NT));     ENDW(t+1); RESC(); ROT();
  }
  STEP(pB0,pB1,pA0,pA1,NT-1,false,false,false); RESC();
  { float sacc=pB0[0]+pB0[1]; _Pragma("unroll") for(int r=2;r<16;++r)sacc+=pB0[r]; _Pragma("unroll") for(int r=0;r<16;++r)sacc+=pB1[r]; l_reg+=sacc;
    pw0=(u32x4){PKW(pB0,0),PKW(pB0,2),PKW(pB0,4),PKW(pB0,6)};pw1=(u32x4){PKW(pB0,8),PKW(pB0,10),PKW(pB0,12),PKW(pB0,14)};pw2=(u32x4){PKW(pB1,0),PKW(pB1,2),PKW(pB1,4),PKW(pB1,6)};pw3=(u32x4){PKW(pB1,8),PKW(pB1,10),PKW(pB1,12),PKW(pB1,14)};
    SBAR(); pv(o,vb0+sl_cur,PAF(0),PAF(1),PAF(2),PAF(3)); }
  #undef PKW
  #undef PAF
  #undef VFR
  #undef PIN
  #undef MX3
  #undef GAPA
  #undef GAPB
  #undef EX
  #undef VRD
  #undef KRD
  #undef STEP
  #undef ENDW
  {auto rr=__builtin_amdgcn_permlane32_swap(__float_as_uint(l_reg),__float_as_uint(l_reg),false,false);l_reg=__uint_as_float(rr[0])+__uint_as_float(rr[1]);}
  if(hi==0)wsf[32+r32]=l_reg;asm volatile("s_waitcnt lgkmcnt(0)":::"memory");
  float rli[16];
  #pragma unroll
  for(int r=0;r<16;++r)rli[r]=__builtin_amdgcn_rcpf(wsf[32+crow(r,hi)]);
  bf16*Ow=Ow0+(long)(wid*QBLK)*OP;
  { bf16*stg=(bf16*)(shm+LDS_OST)+wid*2048;
    #pragma unroll
    for(int r=0;r<16;++r){const int orow=crow(r,hi);
      #pragma unroll
      for(int d0=0;d0<2;++d0)stg[orow*64+d0*32+r32]=__float2bfloat16(o[d0][r]*rli[r]);}
    asm volatile("s_waitcnt lgkmcnt(0)":::"memory");
    #pragma unroll
    for(int i=0;i<4;++i){const int row=i*8+(lane>>3),ch=lane&7; const u32x4 v=*(const u32x4*)(stg+row*64+ch*8); ATTN_STORE16(Ow+(long)row*OP+ch*8,v);} }
  asm volatile("s_waitcnt lgkmcnt(0)\n\ts_barrier":::"memory");
  #undef DMA_K
  #undef TROW
  #undef DMA_V
  #undef CMASK
  #undef START
  #undef RESC
  #undef ROT
}
constexpr int ATTN_LDS_BYTES=LDS_BYTES;
#undef SBAR
#undef WAIT_BAR
}
typedef float f32x2 __attribute__((ext_vector_type(2)));
__device__ __forceinline__ int scan_tok(int p, int dir) { return p < CTXL ? (dir ? CTXL - 1 - p : p) : (dir ? (T + CTXL - 1) - p : p); }

constexpr int CS_NCH = T / 16;
constexpr size_t WS_W1F = WS_H;
typedef float f32x16 __attribute__((ext_vector_type(16)));
typedef __bf16 bf16x2_t __attribute__((ext_vector_type(2)));
__device__ __forceinline__ unsigned cvtpk(float lo, float hi) { f32x2 v = {lo, hi}; bf16x2_t b = __builtin_convertvector(v, bf16x2_t); return __builtin_bit_cast(unsigned, b); }
__device__ __forceinline__ bf16x8 pack8f(float a0, float a1, float a2, float a3, float a4, float a5, float a6, float a7) {
    u32x4 w; w.x = cvtpk(a0, a1); w.y = cvtpk(a2, a3); w.z = cvtpk(a4, a5); w.w = cvtpk(a6, a7); return __builtin_bit_cast(bf16x8, w);
}
#define MF4(a, b, c) __builtin_amdgcn_mfma_f32_16x16x4f32((a), (b), (c), 0, 0, 0)

constexpr int PB_BK = 0, PB_AR = 4608, PB_CM = 9216, PB_EM = PB_CM + 16 * 17 * 4, PB_TM = PB_EM + 16 * 20 * 4, PB_P15 = PB_TM + 16 * 20 * 4, PB_BYTES = PB_P15 + 256;
constexpr int PBS = 72;
static_assert(8 * PB_BYTES <= RING_BYTES, "pre-pass LDS");
struct PPIn { float rr[16], kb[16], ww[16], as[16]; };
__device__ __forceinline__ void prepass_load(Frame& F, PPIn& I, int rec, int lane) {
    const int ch = rec / CS_NCH, c = rec % CS_NCH, b = ch >> 3, h = (ch >> 1) & 3, dir = ch & 1;
    const bf16* R32 = WSP(bf16, WS_R32); const bf16* DEC = WSP(bf16, WS_DEC) + (size_t)dir * M * 256; const bf16* ASIG = WSP(bf16, WS_ASIG) + (size_t)dir * M * 256;
    const int t0 = scan_tok(c * 16, dir); const int stp = dir ? -1 : 1;
#pragma unroll
    for (int t = 0; t < 16; ++t) { const size_t m = (size_t)b * T + (t0 + stp * t);
        I.rr[t] = bf2f(R32[m * 768 + h * 64 + lane]); I.kb[t] = bf2f(R32[m * 768 + 256 + h * 64 + lane]); I.ww[t] = bf2f(DEC[m * 256 + h * 64 + lane]); I.as[t] = bf2f(ASIG[m * 256 + h * 64 + lane]); }
}
__device__ __forceinline__ float bfu(unsigned short v) { return __builtin_bit_cast(float, (unsigned)v << 16); }
__device__ __forceinline__ void prepass_record(Frame& F, int l, int rec, LAS unsigned char* L, int lane, const PPIn& I) {
    const int ch = rec / CS_NCH, h = (ch >> 1) & 3;
    const int c = lane & 31, hh = lane >> 5;
    bf16* W1F = WSP(bf16, WS_W1F) + (size_t)rec * 2048; bf16* W2F = (bf16*)F.out + (size_t)rec * 3200; float* P15F = F.out + (size_t)rec * 1600 + 1536;
    LAS bf16* BK = (LAS bf16*)(L + PB_BK); LAS bf16* AR = (LAS bf16*)(L + PB_AR);
    LAS float* Cm = (LAS float*)(L + PB_CM); LAS float* Em = (LAS float*)(L + PB_EM); LAS float* Tm = (LAS float*)(L + PB_TM); LAS float* P15 = (LAS float*)(L + PB_P15);
    {
        const float kkw = F.in[I_KK][l * 256 + h * 64 + lane], kaw = F.in[I_KA][l * 256 + h * 64 + lane];
        float P = 1.f;
#pragma unroll
        for (int t = 0; t < 16; ++t) {
            const float r_ = I.rr[t], kb_ = I.kb[t], w_ = __expf(-I.ww[t]), as_ = I.as[t];
            float kk_ = kb_ * kkw; kk_ = kk_ * __builtin_amdgcn_rsqf(fmaxf(wave_sum(kk_ * kk_), 1e-24f));
            const float kd_ = kb_ * (1.f + (as_ - 1.f) * kaw);
            const float Pm = P; P *= w_; const float iP = __builtin_amdgcn_rcpf(P);
            AR[t * PBS + lane] = (bf16)f2bf(-kk_ * Pm); AR[(16 + t) * PBS + lane] = (bf16)f2bf(r_ * P);
            BK[t * PBS + lane] = (bf16)f2bf(kk_ * as_ * iP); BK[(16 + t) * PBS + lane] = (bf16)f2bf(kd_ * iP);
        }
        P15[lane] = P;
    }
    LDS_WAIT(); asm volatile("" ::: "memory");
#pragma unroll
    for (int ks = 0; ks < 4; ++ks) {
        const LAS bf16* src = AR + c * PBS + 16 * ks + 4 * hh;
        const u32x2 lo = *(const LAS u32x2*)src, hi = *(const LAS u32x2*)(src + 8);
        *(u32x4*)(W1F + (ks * 64 + lane) * 8) = (u32x4){lo.x, lo.y, hi.x, hi.y};
    }
    f32x16 Gm;
#pragma unroll
    for (int r = 0; r < 16; ++r) Gm[r] = 0.f;
#pragma unroll
    for (int ks = 0; ks < 4; ++ks)
        Gm = __builtin_amdgcn_mfma_f32_32x32x16_bf16(*(const LAS bf16x8*)(BK + c * PBS + 16 * ks + 8 * hh), *(const LAS bf16x8*)(AR + c * PBS + 16 * ks + 8 * hh), Gm, 0, 0, 0);
    {
        const int t = c & 15;
#pragma unroll
        for (int r = 0; r < 16; ++r) { const int s = (r & 3) + 8 * ((r & 7) >> 2) + 4 * hh; const bool keep = (c < 16) ? (s < t) : (s <= t); if (!keep) Gm[r] = 0.f; }
        if (c < 16) {
#pragma unroll
            for (int r = 0; r < 8; ++r) { const int s = (r & 3) + 8 * (r >> 2) + 4 * hh; Cm[s * 17 + t] = Gm[r]; Em[s * 20 + t] = Gm[8 + r]; }
        }
    }
    LDS_WAIT(); asm volatile("" ::: "memory");
    {
        const int rho = lane & 15;
        float x[16];
#pragma unroll
        for (int t = 0; t < 16; ++t) { float acc = (rho == t) ? 1.f : 0.f;
#pragma unroll
            for (int s = 0; s < t; ++s) acc += x[s] * Cm[s * 17 + t];
            x[t] = acc; }
        if (lane < 16) {
#pragma unroll
            for (int q = 0; q < 4; ++q) *(LAS f32x4*)(Tm + rho * 20 + 4 * q) = (f32x4){x[4 * q], x[4 * q + 1], x[4 * q + 2], x[4 * q + 3]}; }
    }
    LDS_WAIT(); asm volatile("" ::: "memory");
    bf16x8 A2;
    {
        float ta[8];
#pragma unroll
        for (int jj = 0; jj < 8; ++jj) ta[jj] = (c < 16) ? Tm[((jj & 3) + 8 * (jj >> 2) + 4 * hh) * 20 + c] : 0.f;
        const bf16x8 Aet = pack8f(ta[0], ta[1], ta[2], ta[3], ta[4], ta[5], ta[6], ta[7]);
        f32x4 e0 = (f32x4){0.f, 0.f, 0.f, 0.f}, e1 = e0, t0 = e0, t1 = e0;
        if (c >= 16) { e0 = *(const LAS f32x4*)(Em + (c - 16) * 20 + 4 * hh); e1 = *(const LAS f32x4*)(Em + (c - 16) * 20 + 8 + 4 * hh); }
        else { t0 = *(const LAS f32x4*)(Tm + c * 20 + 4 * hh); t1 = *(const LAS f32x4*)(Tm + c * 20 + 8 + 4 * hh); }
        const bf16x8 Bet = pack8f(e0[0], e0[1], e0[2], e0[3], e1[0], e1[1], e1[2], e1[3]);
        f32x16 Z;
#pragma unroll
        for (int r = 0; r < 16; ++r) Z[r] = 0.f;
        const f32x16 Dt = __builtin_amdgcn_mfma_f32_32x32x16_bf16(Aet, Bet, Z, 0, 0, 0);
        A2 = (c >= 16) ? pack8f(Dt[0], Dt[1], Dt[2], Dt[3], Dt[4], Dt[5], Dt[6], Dt[7]) : pack8f(t0[0], t0[1], t0[2], t0[3], t1[0], t1[1], t1[2], t1[3]);
    }
    {
        const bf16x8 Bm = pack8f(Gm[0], Gm[1], Gm[2], Gm[3], Gm[4], Gm[5], Gm[6], Gm[7]);
        const bf16x8 Bz = pack8f(0.f, 0.f, 0.f, 0.f, 0.f, 0.f, 0.f, 0.f);
        f32x16 Ci;
#pragma unroll
        for (int r = 0; r < 16; ++r) Ci[r] = (r >= 8 && c >= 16) ? Gm[r] : 0.f;
        const f32x16 Dm = __builtin_amdgcn_mfma_f32_32x32x16_bf16(A2, (c >= 16) ? Bm : Bz, Ci, 0, 0, 0);
        *(bf16x8*)(W2F + (0 * 64 + lane) * 8) = pack8f(Dm[0], Dm[1], Dm[2], Dm[3], Dm[4], Dm[5], Dm[6], Dm[7]);
        *(bf16x8*)(W2F + (1 * 64 + lane) * 8) = pack8f(Dm[8], Dm[9], Dm[10], Dm[11], Dm[12], Dm[13], Dm[14], Dm[15]);
    }
#pragma unroll
    for (int nt = 0; nt < 2; ++nt) {
        float bb[8]; f32x16 Ci;
#pragma unroll
        for (int jj = 0; jj < 8; ++jj) { const int kap = (jj & 3) + 8 * (jj >> 2) + 4 * hh;
            bb[jj] = bfu(BK[kap * PBS + 32 * nt + c]); Ci[jj] = 0.f; Ci[8 + jj] = bfu(BK[(16 + kap) * PBS + 32 * nt + c]); }
        const f32x16 Dn = __builtin_amdgcn_mfma_f32_32x32x16_bf16(A2, pack8f(bb[0], bb[1], bb[2], bb[3], bb[4], bb[5], bb[6], bb[7]), Ci, 0, 0, 0);
        const float p = P15[32 * nt + c];
        *(bf16x8*)(W2F + ((2 + 2 * nt) * 64 + lane) * 8) = pack8f(Dn[0] * p, Dn[1] * p, Dn[2] * p, Dn[3] * p, Dn[4] * p, Dn[5] * p, Dn[6] * p, Dn[7] * p);
        *(bf16x8*)(W2F + ((3 + 2 * nt) * 64 + lane) * 8) = pack8f(Dn[8] * p, Dn[9] * p, Dn[10] * p, Dn[11] * p, Dn[12] * p, Dn[13] * p, Dn[14] * p, Dn[15] * p);
    }
    { const int blk = c >> 4, reg = c & 15; P15F[lane] = P15[32 * blk + (reg & 3) + 8 * (reg >> 2) + 4 * hh]; }
    LDS_WAIT(); asm volatile("" ::: "memory");
}
__device__ __forceinline__ void phase_prepass(Frame& F, int l) {
    int lane = LANE_; asm volatile("" : "+v"(lane));
    LAS unsigned char* L = F.lds + F.wave * PB_BYTES;
    int rec = F.vcu * NWAVES + F.wave; const int stride = F.G * NWAVES;
    PPIn I; if (rec < 64 * CS_NCH) prepass_load(F, I, rec, lane);
    for (; rec < 64 * CS_NCH; rec += stride) {
        PPIn Nx = I; if (rec + stride < 64 * CS_NCH) prepass_load(F, Nx, rec + stride, lane);
        prepass_record(F, l, rec, L, lane, I);
        I = Nx;
    }
}

constexpr int CS_REC = 4096 + 6144 + 256 + 2048, CS_SLOTS = 8, CS_LEAD = 6, CS_NP = 13;
__device__ __forceinline__ void scan_chunked(Frame& F, int ch, int l) {
    int lane = LANE_; asm volatile("" : "+v"(lane));
    const int wave = F.wave, b = ch >> 3, h = (ch >> 1) & 3, dir = ch & 1, hh = lane >> 5, icol = 32 * (wave & 1) + (lane & 31);
    float* YD = WSP(float, WS_YD) + (size_t)dir * M * 256;
    const bf16* R32 = WSP(bf16, WS_R32);
    LAS unsigned char* ring = F.lds;
    u32x4 st[CS_NP];
    const int hw = wave - 2;
#define CS_SRC(cc, q) ({ const int rec_ = ch * CS_NCH + (cc); const u32x4* r_; \
        if ((q) < 4) r_ = (const u32x4*)(WSP(bf16, WS_W1F) + (size_t)rec_ * 2048) + lane + (q) * 64; \
        else if ((q) < 10) r_ = (const u32x4*)((const unsigned char*)F.out + (size_t)rec_ * 6400) + lane + ((q) - 4) * 64; \
        else { const int p = (q) * 64 + lane; const int pv = min(max(p - 656, 0), 127); \
            const u32x4* sv_ = (const u32x4*)(R32 + ((size_t)b * T + scan_tok((cc) * 16 + (pv >> 3), dir)) * 768 + 512 + h * 64) + (pv & 7); \
            r_ = ((q) == 10 && lane < 16) ? (const u32x4*)((const unsigned char*)F.out + (size_t)rec_ * 6400) + lane + 384 : sv_; } \
        r_; })
#define CS_ISSUE1(cc, q) do { st[q] = *CS_SRC(cc, q); } while (0)
#define CS_WRITE1(cc, q) do { const int p = (q) * 64 + lane; if ((q) < 12 || p < 784) ((LAS u32x4*)(ring + ((cc) % CS_SLOTS) * CS_REC))[p] = st[q]; } while (0)
#define CS_ISSUE(cc) do { _Pragma("unroll") for (int q = 0; q < CS_NP; ++q) CS_ISSUE1(cc, q); } while (0)
#define CS_WRITE(cc) do { _Pragma("unroll") for (int q = 0; q < CS_NP; ++q) CS_WRITE1(cc, q); } while (0)
#define CS_STEP(wc, q) do { CS_WRITE1(wc, q); if ((wc) + 6 < CS_NCH) CS_ISSUE1((wc) + 6, q); } while (0)
#define CS_BAR() do { asm volatile("s_waitcnt lgkmcnt(0)" ::: "memory"); __builtin_amdgcn_s_barrier(); asm volatile("" ::: "memory"); } while (0)
    if (wave >= 2) {
        CS_ISSUE(hw); CS_WRITE(hw);
        if (hw == 0) { CS_ISSUE(6); CS_WRITE(6); }
        { const int wc1 = (hw == 0) ? 12 : hw + 6; CS_ISSUE(wc1); }
        CS_BAR();
        int c = 0; const int c0 = (hw + 5) % 6;
        for (; c < c0; ++c) CS_BAR();
        for (; c + 6 <= CS_NCH; c += 6) {
            const int wc = c + 7;
            if (wc < CS_NCH) {
                CS_STEP(wc, 0); CS_STEP(wc, 1); CS_STEP(wc, 2); CS_BAR();
                CS_STEP(wc, 3); CS_STEP(wc, 4); CS_BAR();
                CS_STEP(wc, 5); CS_STEP(wc, 6); CS_BAR();
                CS_STEP(wc, 7); CS_STEP(wc, 8); CS_BAR();
                CS_STEP(wc, 9); CS_STEP(wc, 10); CS_BAR();
                CS_STEP(wc, 11); CS_STEP(wc, 12); CS_BAR();
            } else { CS_BAR(); CS_BAR(); CS_BAR(); CS_BAR(); CS_BAR(); CS_BAR(); }
        }
        for (; c < CS_NCH; ++c) CS_BAR();
    } else {
        f32x16 X0, X1;
#pragma unroll
        for (int r = 0; r < 16; ++r) { X0[r] = 0.f; X1[r] = 0.f; }
        CS_BAR();
        bf16x8 w1[4], w2[6]; f32x4 p15[8]; unsigned vv[8];
#define CS_RD(cc) do { const LAS unsigned char* rec_ = ring + ((cc) % CS_SLOTS) * CS_REC; \
            _Pragma("unroll") for (int k = 0; k < 4; ++k) w1[k] = ((const LAS bf16x8*)rec_)[k * 64 + lane]; \
            _Pragma("unroll") for (int k = 0; k < 6; ++k) w2[k] = ((const LAS bf16x8*)(rec_ + 4096))[k * 64 + lane]; \
            _Pragma("unroll") for (int k = 0; k < 8; ++k) p15[k] = ((const LAS f32x4*)(rec_ + 10240 + hh * 128))[k]; \
            _Pragma("unroll") for (int jj = 0; jj < 8; ++jj) vv[jj] = ((const LAS bf16*)(rec_ + 10496))[(8 * (jj >> 2) + 4 * hh + (jj & 3)) * 64 + icol]; } while (0)
        CS_RD(0);
        for (int c = 0; c < CS_NCH; ++c) {
            f32x16 G;
#pragma unroll
            for (int r = 0; r < 16; ++r) G[r] = 0.f;
            G = __builtin_amdgcn_mfma_f32_32x32x16_bf16(w1[0], pack8f(X0[0], X0[1], X0[2], X0[3], X0[4], X0[5], X0[6], X0[7]), G, 0, 0, 0);
            G = __builtin_amdgcn_mfma_f32_32x32x16_bf16(w1[1], pack8f(X0[8], X0[9], X0[10], X0[11], X0[12], X0[13], X0[14], X0[15]), G, 0, 0, 0);
            G = __builtin_amdgcn_mfma_f32_32x32x16_bf16(w1[2], pack8f(X1[0], X1[1], X1[2], X1[3], X1[4], X1[5], X1[6], X1[7]), G, 0, 0, 0);
            G = __builtin_amdgcn_mfma_f32_32x32x16_bf16(w1[3], pack8f(X1[8], X1[9], X1[10], X1[11], X1[12], X1[13], X1[14], X1[15]), G, 0, 0, 0);
            const bf16x8 g1 = pack8f(G[0], G[1], G[2], G[3], G[4], G[5], G[6], G[7]);
            const bf16x8 vf = __builtin_bit_cast(bf16x8, (u32x4){vv[0] | (vv[1] << 16), vv[2] | (vv[3] << 16), vv[4] | (vv[5] << 16), vv[6] | (vv[7] << 16)});
            f32x16 Y = __builtin_amdgcn_mfma_f32_32x32x16_bf16(w2[0], g1, G, 0, 0, 0);
            Y = __builtin_amdgcn_mfma_f32_32x32x16_bf16(w2[1], vf, Y, 0, 0, 0);
#pragma unroll
            for (int k = 0; k < 4; ++k) {
#pragma unroll
                for (int e = 0; e < 4; ++e) { X0[4 * k + e] *= p15[k][e]; X1[4 * k + e] *= p15[4 + k][e]; } }
            X0 = __builtin_amdgcn_mfma_f32_32x32x16_bf16(w2[2], g1, X0, 0, 0, 0);
            X0 = __builtin_amdgcn_mfma_f32_32x32x16_bf16(w2[3], vf, X0, 0, 0, 0);
            X1 = __builtin_amdgcn_mfma_f32_32x32x16_bf16(w2[4], g1, X1, 0, 0, 0);
            X1 = __builtin_amdgcn_mfma_f32_32x32x16_bf16(w2[5], vf, X1, 0, 0, 0);
            if (c + 1 < CS_NCH) CS_RD(c + 1);
            {
                float* yp = YD + ((size_t)b * T + scan_tok(c * 16, dir)) * 256 + h * 64 + icol + (dir ? -4 * hh * 256 : 4 * hh * 256);
                const int st = dir ? -256 : 256;
#pragma unroll
                for (int r = 8; r < 16; ++r) yp[((r & 3) + 8 * ((r >> 2) - 2)) * st] = Y[r];
            }
            asm volatile("" ::: "memory"); __builtin_amdgcn_s_barrier(); asm volatile("" ::: "memory");
        }
#undef CS_RD
    }
#undef CS_BAR
#undef CS_ISSUE
#undef CS_ISSUE1
#undef CS_WRITE1
#undef CS_STEP
#undef CS_SRC
#undef CS_WRITE
    __syncthreads();
}

constexpr int SC_TC = 16, SC_STEP = 6 * 64, SC_BUF = SC_TC * SC_STEP;
constexpr int SC_YOFF = 2 * SC_BUF, SC_DUMMY = SC_YOFF + 2 * SC_TC * 64;
#if GOLD_ATTN
__device__ __forceinline__ void attn_ref_unit(Frame& F, int mode, int qrow0, int qcol, int krow0, int nkeys, int kcol, int vcol, int ocol,
                                              int rb, const float* rpbh) {
    const int tid = TID_, q = tid & 255, dh = tid >> 8;
    const bf16* QKV = WSP(bf16, WS_QKV); bf16* O = WSP(bf16, WS_O);
    const int gr = 4 * rb + (q >> 6), gc = q & 63;
    const size_t qrow = (size_t)qrow0 + q;
    float qv[64], o[32];
#pragma unroll
    for (int d8 = 0; d8 < 8; ++d8) { const u32x4 w = *(const u32x4*)(QKV + qrow * 1536 + qcol + 8 * d8);
        qv[8 * d8 + 0] = bflo(w.x); qv[8 * d8 + 1] = bfhi(w.x); qv[8 * d8 + 2] = bflo(w.y); qv[8 * d8 + 3] = bfhi(w.y);
        qv[8 * d8 + 4] = bflo(w.z); qv[8 * d8 + 5] = bfhi(w.z); qv[8 * d8 + 6] = bflo(w.w); qv[8 * d8 + 7] = bfhi(w.w); }
#pragma unroll
    for (int d = 0; d < 32; ++d) o[d] = 0.f;
    float mrun = -1e30f, lrun = 0.f;
    const int kend = mode == 0 ? nkeys : 128 + CTXL;
    const int rs = min(max(gr - 4, 0), 32 - 8), cs = min(max(gc - 8, 0), 64 - 16);
    for (int kk = 0; kk < kend; ++kk) {
        size_t krow; float bias = 0.f;
        if (mode == 0) krow = (size_t)krow0 + kk;
        else if (kk < 128) { const int kr = rs + (kk >> 4), kc = cs + (kk & 15); krow = (size_t)krow0 + CTXL + kr * 64 + kc; bias = rpbh[(kr - gr + 7) * 31 + (kc - gc + 15)] * LOG2E; }
        else krow = (size_t)krow0 + (kk - 128);
        float s = bias;
#pragma unroll
        for (int d8 = 0; d8 < 8; ++d8) { const u32x4 w = *(const u32x4*)(QKV + krow * 1536 + kcol + 8 * d8);
            s += qv[8 * d8 + 0] * bflo(w.x) + qv[8 * d8 + 1] * bfhi(w.x) + qv[8 * d8 + 2] * bflo(w.y) + qv[8 * d8 + 3] * bfhi(w.y)
               + qv[8 * d8 + 4] * bflo(w.z) + qv[8 * d8 + 5] * bfhi(w.z) + qv[8 * d8 + 6] * bflo(w.w) + qv[8 * d8 + 7] * bfhi(w.w); }
        const float mn = fmaxf(mrun, s), al = exp2f(mrun - mn), p = exp2f(s - mn);
        lrun = lrun * al + p; mrun = mn;
#pragma unroll
        for (int d8 = 0; d8 < 4; ++d8) { const u32x4 w = *(const u32x4*)(QKV + krow * 1536 + vcol + 32 * dh + 8 * d8);
            o[8 * d8 + 0] = o[8 * d8 + 0] * al + p * bflo(w.x); o[8 * d8 + 1] = o[8 * d8 + 1] * al + p * bfhi(w.x);
            o[8 * d8 + 2] = o[8 * d8 + 2] * al + p * bflo(w.y); o[8 * d8 + 3] = o[8 * d8 + 3] * al + p * bfhi(w.y);
            o[8 * d8 + 4] = o[8 * d8 + 4] * al + p * bflo(w.z); o[8 * d8 + 5] = o[8 * d8 + 5] * al + p * bfhi(w.z);
            o[8 * d8 + 6] = o[8 * d8 + 6] * al + p * bflo(w.w); o[8 * d8 + 7] = o[8 * d8 + 7] * al + p * bfhi(w.w); }
    }
    const float li = 1.f / lrun;
#pragma unroll
    for (int d8 = 0; d8 < 4; ++d8) { u32x4 w;
        w.x = pk2(o[8 * d8 + 0] * li, o[8 * d8 + 1] * li); w.y = pk2(o[8 * d8 + 2] * li, o[8 * d8 + 3] * li);
        w.z = pk2(o[8 * d8 + 4] * li, o[8 * d8 + 5] * li); w.w = pk2(o[8 * d8 + 6] * li, o[8 * d8 + 7] * li);
        *(u32x4*)(O + qrow * 1024 + ocol + 32 * dh + 8 * d8) = w; }
}
#endif
__device__ __forceinline__ void attn_item(Frame& F, int item, int l) {
    const float* rpb = F.in[I_RPB] + (size_t)l * 4 * 15 * 31;
    int mode = 0, qrow0, qcol, krow0, nkeys, kcol, vcol, ocol, rb = 0;
    if (item < 512) { const int b = item >> 6, h = (item >> 3) & 7, qb = item & 7;
        qrow0 = b * T + CTXL + qb * 256; qcol = h * 64; krow0 = b * T; nkeys = T; kcol = 512 + (h >> 2) * 64; vcol = 640 + (h >> 2) * 64; ocol = h * 64; }
    else if (item < 768) { const int it = item - 512, b = it >> 5, h = (it >> 3) & 3; rb = it & 7; mode = 1;
        qrow0 = b * T + CTXL + rb * 256; qcol = 768 + h * 64; krow0 = b * T; nkeys = 0; kcol = 1024 + h * 64; vcol = 1280 + h * 64; ocol = 768 + h * 64; rpb += h * 15 * 31; }
    else if (item < 832) { const int it = item - 768, b = it >> 3, h = it & 7;
        qrow0 = b * T; qcol = h * 64; krow0 = b * T; nkeys = CTXL; kcol = 512 + (h >> 2) * 64; vcol = 640 + (h >> 2) * 64; ocol = h * 64; }
    else { const int it = item - 832, b = it >> 2, h = it & 3;
        qrow0 = b * T; qcol = 768 + h * 64; krow0 = b * T; nkeys = CTXL; kcol = 1024 + h * 64; vcol = 1280 + h * 64; ocol = 768 + h * 64; }
#if GOLD_ATTN
    attn_ref_unit(F, mode, qrow0, qcol, krow0, nkeys, kcol, vcol, ocol, rb, rpb);
#else
    const attn_body::bf16* QKV = (const attn_body::bf16*)WSP(bf16, WS_QKV); attn_body::bf16* O = (attn_body::bf16*)WSP(bf16, WS_O);
    const attn_body::bf16* Qw0 = QKV + (size_t)qrow0 * 1536 + qcol; const attn_body::bf16* Kh = QKV + (size_t)krow0 * 1536 + kcol; const attn_body::bf16* Vh = QKV + (size_t)krow0 * 1536 + vcol;
    attn_body::bf16* Ow0 = O + (size_t)qrow0 * 1024 + ocol;
    if (mode == 0) attn_body::attn_unit<8, false>(Qw0, Kh, Vh, Ow0, nkeys >> 6, 0, 0, 0, rpb, (char*)F.lds);
    else { const int rs0 = min(max(4 * rb - 4, 0), 24); attn_body::attn_unit<8, true>(Qw0, Kh, Vh, Ow0, (rb == 0 || rb == 7) ? 12 : 16, rs0, rb, rs0, rpb, (char*)F.lds); }
#endif
}
template <int NI> struct PostIn { float y[NI], r[NI], kb[NI], v[NI], as0[NI], as1[NI], gg[NI]; };
template <int NI> __device__ __forceinline__ void post_load(Frame& F, PostIn<NI>& P, int m0, int h, int lane) {
    const bf16* R32 = WSP(bf16, WS_R32); const bf16* ASIG = WSP(bf16, WS_ASIG); const float* YD = WSP(float, WS_YD); const bf16* Gb = WSP(bf16, WS_G);
    const int ch = h * 64 + lane;
#pragma unroll
    for (int k = 0; k < NI; ++k) { const size_t mm = (size_t)(m0 + k);
        P.y[k] = YD[mm * 256 + ch] + YD[((size_t)M + mm) * 256 + ch];
        P.r[k] = bf2f(R32[mm * 768 + ch]); P.kb[k] = bf2f(R32[mm * 768 + 256 + ch]); P.v[k] = bf2f(R32[mm * 768 + 512 + ch]);
        P.as0[k] = bf2f(ASIG[mm * 256 + ch]); P.as1[k] = bf2f(ASIG[((size_t)M + mm) * 256 + ch]); P.gg[k] = bf2f(Gb[mm * 256 + ch]); }
}
template <int NI> __device__ __forceinline__ void post_math(Frame& F, int l, const PostIn<NI>& P, int m0, int h, int lane) {
    bf16* O = WSP(bf16, WS_O);
    const int ch = h * 64 + lane;
    const float lw = F.in[I_LNXW][l * 256 + ch], lb = F.in[I_LNXB][l * 256 + ch], ka = F.in[I_KA][l * 256 + ch], rk = F.in[I_RK][l * 256 + ch];
#pragma unroll
    for (int k = 0; k < NI; ++k) {
        const float mu = wave_sum(P.y[k]) * (1.f / 64.f); const float dv = P.y[k] - mu; const float var = wave_sum(dv * dv) * (1.f / 64.f);
        const float yn = dv * rsqrtf(var + 64e-5f) * lw + lb;
        const float kd0 = P.kb[k] * (1.f + (P.as0[k] - 1.f) * ka), kd1 = P.kb[k] * (1.f + (P.as1[k] - 1.f) * ka);
        const float bon = wave_sum(P.r[k] * (kd0 + kd1) * rk) * P.v[k];
        O[(size_t)(m0 + k) * 1024 + 512 + ch] = (bf16)f2bf((yn + bon) * P.gg[k]);
    }
}
__device__ __forceinline__ void post_item(Frame& F, int l, int m, int h, int lane) { PostIn<1> P; post_load<1>(F, P, m, h, lane); post_math<1>(F, l, P, m, h, lane); }
constexpr int CW_SCDONE = 36864, CW_POSTQ = 37888;
__device__ __forceinline__ void phase_mixer(Frame& F, int l, int rep = 0) {
    if (F.vcu < 64) { scan_chunked(F, F.vcu, l);
        if (rep == 0) {
            asm volatile("s_waitcnt vmcnt(0)" ::: "memory"); __syncthreads();
            if (TID_ == 0) { __builtin_amdgcn_fence(__ATOMIC_RELEASE, "agent"); asm volatile("s_waitcnt vmcnt(0)" ::: "memory"); (void)xb_add(F.ctl + CW_SCDONE + 64 * l, 1u); }
        } }
    if (rep == 2) return;
    const int nattn = (l == NL - 1) ? 768 : 864;
    for (;;) {
        if (TID_ == 0) F.MISC[16] = atomicAdd(F.ctl + CW_QUEUE + 64 * (l + 2 * rep), 1u);
        __syncthreads();
        const int item = (int)F.MISC[16];
        __syncthreads();
        if (item >= nattn) break;
        attn_item(F, item, l);
    }
    if (rep == 0) {
        if (TID_ == 0) { unsigned sp = 0; while (xb_ld(F.ctl + CW_SCDONE + 64 * l) < 64u) { __builtin_amdgcn_s_sleep(2); if (++sp > (1u << 24)) break; }
            __builtin_amdgcn_fence(__ATOMIC_ACQUIRE, "agent"); asm volatile("s_waitcnt vmcnt(0)" ::: "memory"); }
        __syncthreads();
        const int t0 = (l == NL - 1) ? CTXL : 0, nchunk = (T - t0) / 64, nitem = 32 * nchunk, lane = LANE_;
        for (;;) {
            if (TID_ == 0) F.MISC[16] = atomicAdd(F.ctl + CW_POSTQ + 64 * l, 1u);
            __syncthreads();
            const int item = (int)F.MISC[16];
            __syncthreads();
            if (item >= nitem) break;
            const int bh = item / nchunk, ck = item % nchunk, m0 = (bh >> 2) * T + t0 + ck * 64 + 8 * F.wave;
            PostIn<8> P; post_load<8>(F, P, m0, bh & 3, lane); post_math<8>(F, l, P, m0, bh & 3, lane);
        }
    }
    cvt_moe_drain(F, l, 4);
}

__device__ __forceinline__ unsigned wave_incl_scan(unsigned v, int lane) {
#pragma unroll
    for (int o = 1; o < 64; o <<= 1) { const unsigned u = __shfl_up(v, o); if (lane >= o) v += u; }
    return v;
}
__device__ __forceinline__ void phase_topk(Frame& F, int l) {
    const int tid = TID_, lane = LANE_, wave = F.wave;
    LAS unsigned* hist = (LAS unsigned*)F.lds;
    LAS unsigned* ctrl = hist + 256;
    LAS unsigned* wsum = hist + 272;
    LAS int* stok = (LAS int*)(hist + 288);
    const float* AFF = WSP(float, WS_AFF); int* INV = WSP(int, WS_INV); float* SELG = WSP(float, WS_SELG); int* SELT = WSP(int, WS_SELT);
    const bf16* H2 = WSP(bf16, WS_H2); bf16* XE = WSP(bf16, WS_XE);
    const int nitems = (l == NL - 1) ? 128 : 256;
    for (int it = F.vcu; it < nitems; it += F.G) {
        const int seg = it >> 7, be = it & 127, b = be >> 4, e = be & 15;
        const int n = seg ? CTXL : SEQ, cap = n / 8, mbase = b * T + (seg ? 0 : CTXL);
        const int rowbase = e * MEXP + (seg ? 2048 + b * 32 : b * 256);
        unsigned key[4];
#pragma unroll
        for (int k = 0; k < 4; ++k) { const int i = 4 * tid + k; key[k] = (i < n) ? __float_as_uint(AFF[(size_t)(mbase + i) * 16 + e]) : 0u; }
        if (tid == 0) { ctrl[0] = 0u; ctrl[1] = (unsigned)cap; }
        unsigned prefix = 0u, pmask = 0u;
#pragma unroll 1
        for (int pass = 0; pass < 4; ++pass) {
            const int shift = 24 - 8 * pass;
            if (tid < 256) hist[tid] = 0u;
            __syncthreads();
#pragma unroll
            for (int k = 0; k < 4; ++k) if ((key[k] & pmask) == prefix && key[k] != 0u) __hip_atomic_fetch_add(&hist[(key[k] >> shift) & 255u], 1u, __ATOMIC_RELAXED, __HIP_MEMORY_SCOPE_WORKGROUP);
            __syncthreads();
            if (wave == 0) {
                const unsigned need = ctrl[1];
                unsigned c4[4]; unsigned tot = 0u;
#pragma unroll
                for (int k = 0; k < 4; ++k) { c4[k] = hist[255 - (4 * lane + k)]; tot += c4[k]; }
                const unsigned incl = wave_incl_scan(tot, lane); unsigned run = incl - tot;
#pragma unroll
                for (int k = 0; k < 4; ++k) { if (run < need && run + c4[k] >= need) { ctrl[0] = prefix | ((unsigned)(255 - (4 * lane + k)) << shift); ctrl[1] = need - run; } run += c4[k]; }
            }
            __syncthreads();
            prefix = ctrl[0]; pmask |= 255u << shift;
        }
        const unsigned thr = prefix, need_eq = ctrl[1];
        unsigned ngt = 0u, neq = 0u;
#pragma unroll
        for (int k = 0; k < 4; ++k) { ngt += key[k] > thr; neq += key[k] == thr; }
        const unsigned packed = ngt | (neq << 16);
        const unsigned incl = wave_incl_scan(packed, lane);
        if (lane == 63) wsum[wave] = incl;
        __syncthreads();
        unsigned base = 0u, total = 0u;
#pragma unroll
        for (int w = 0; w < NWAVES; ++w) { const unsigned s = wsum[w]; if (w < wave) base += s; total += s; }
        const unsigned excl = base + incl - packed;
        unsigned pgt = excl & 0xffffu, peq = excl >> 16; const unsigned cnt_gt = total & 0xffffu;
#pragma unroll
        for (int k = 0; k < 4; ++k) {
            int slot = -1;
            if (key[k] > thr) slot = (int)pgt++;
            else if (key[k] == thr) { if (peq < need_eq) slot = (int)(cnt_gt + peq); ++peq; }
            if (slot >= 0) { const int m = mbase + 4 * tid + k; stok[slot] = m;
                SELG[rowbase + slot] = __uint_as_float(key[k]); SELT[rowbase + slot] = m; INV[(size_t)m * 16 + e] = rowbase + slot; }
        }
        __syncthreads();
        for (int s0 = wave * 4; s0 < cap; s0 += NWAVES * 4) {
            u32x4 v[4][2];
#pragma unroll
            for (int k = 0; k < 4; ++k) { const int m = stok[s0 + k];
                const u32x4* src = (const u32x4*)(H2 + (size_t)m * 1024); v[k][0] = src[lane]; v[k][1] = src[64 + lane]; }
#pragma unroll
            for (int k = 0; k < 4; ++k) { u32x4* dst = (u32x4*)(XE + (size_t)(rowbase + s0 + k) * 1024); dst[lane] = v[k][0]; dst[64 + lane] = v[k][1]; }
        }
        __syncthreads();
    }
    cvt_moe_drain(F, l, 1);
}

constexpr int N_PHASES = 2 + 10 * NL;
#ifndef EN_MASK
#define EN_MASK 0xFFFFF
#endif
#define EN(k) ((EN_MASK >> (k)) & 1)
#define RUNPH(k, body) do { if (EN(k)) { body; if (REP(k)) { GBAR(); body; } } } while (0)
__global__ void __launch_bounds__(NTHREADS, 2) fwd_kernel(Args args) {
    extern __shared__ __attribute__((aligned(16))) unsigned char lds_raw[];
    cg::grid_group grid = cg::this_grid();
    Frame F;
    F.lds = (LAS unsigned char*)lds_raw;
    F.MISC = (volatile LAS unsigned*)(F.lds + MISC_OFF);
    F.wave = __builtin_amdgcn_readfirstlane(TID_ >> 6);
    F.G = gridDim.x; { const int bx = blockIdx.x; F.vcu = (F.G % 8 == 0) ? (bx % 8) * (F.G / 8) + bx / 8 : bx; }
    F.in = args.in; F.out = args.out; F.ws = args.ws; F.ctl = (unsigned*)(args.ws + WS_CTL);
    { int u0 = TID_; asm volatile("" : "+v"(u0)); for (int u = u0; u < (LDS_BYTES - RING_BYTES) / 4; u += NTHREADS) ((LAS unsigned*)(F.lds + RING_BYTES))[u] = 0u; }
    __syncthreads();
    const int lo = args.ph_lo, hi = args.ph_hi;
    XcdBarrier bar; bar.bar = F.ctl + CW_BAR; bar.x = 0; bar.st = nullptr;
    if (hi - lo > 1) bar = xcd_barrier_post(F.ctl + CW_BAR, F.MISC + 8);
    LAS unsigned char* ring = F.lds;

#ifndef TPROBE
#define TPROBE -1
#endif
#ifndef TP_X
#define TP_X 1000
#endif
    unsigned long long tp_start = 0; if (TPROBE >= 0 && blockIdx.x == 0 && TID_ == 0) tp_start = __builtin_amdgcn_s_memrealtime();
#define TPMARK(k) do { if (TPROBE == (k) && blockIdx.x == 0 && TID_ == 0) { const unsigned long long t1_ = __builtin_amdgcn_s_memrealtime(); __hip_atomic_store(F.ctl + 3000, ((float)(t1_ - tp_start) * 0.01f > (float)(TP_X)) ? 1u : 0u, __ATOMIC_RELAXED, __HIP_MEMORY_SCOPE_AGENT); } } while (0)
#define IN(k) (lo <= (k) && (k) < hi)
#define GBAR() xcd_barrier3(bar)
#define SEAM(k) do { if (IN(k) && IN((k) + 1)) { GBAR(); if (REP(21)) GBAR(); TPMARK(k); } } while (0)
#ifndef NOFILL
#define NOFILL 0
#endif
#define SEAMF(k, fl) do { if (NOFILL) { SEAM(k); } else if (IN(k) && IN((k) + 1)) { XCD_BARRIER_FILL(bar, F.MISC + 20, { \
        if (TID_ == 0) F.MISC[17] = atomicAdd(F.ctl + CW_CVTQ + 64 * (fl), 1u); __syncthreads(); const int mb_ = (int)F.MISC[17]; __syncthreads(); \
        if (mb_ < CVT_NMINI) { cvt_moe_mini(F, (fl), mb_); asm volatile("s_waitcnt vmcnt(0)" ::: "memory"); } else more_ = false; }); if (REP(21)) GBAR(); TPMARK(k); } } while (0)
    if (hi < 0) grid.sync();
    if (IN(0)) { RUNPH(10, phase_init(F)); }
    SEAMF(0, 0);
    if (IN(1)) { RUNPH(11, phase_row0(F)); }
    if (REP(16)) { for (int k_ = 0; k_ < 20; ++k_) xcd_barrier(bar); }
    if (REP(17)) { for (int k_ = 0; k_ < 20; ++k_) xcd_barrier3(bar); }
    if (REP(18)) { for (int k_ = 0; k_ < 20; ++k_) xcd_barrier2_probe<3>(bar); }
    if (REP(19)) { for (int k_ = 0; k_ < 20; ++k_) xcd_barrier2_probe<4>(bar); }
    SEAMF(1, 0);
#define LAYER(l) do { constexpr int base = 2 + 10 * (l); constexpr bool last = ((l) == NL - 1); \
    if (IN(base + 0)) { if (EN(0)) { \
        pg8::Gemm g{WSP(bf16, WS_H), WSP(bf16, WS_WIN) + (size_t)(l) * NINP * 1024, M, NINP, D}; \
        EpiInproj E{WSP(bf16, WS_QKV), WSP(bf16, WS_R32), WSP(bf16, WS_Z)}; \
        for (int rep_ = 0; rep_ < (REP(0) ? 2 : 1); ++rep_) { if (rep_) GBAR(); if (last) { InprojLastSched S{F.G, F.vcu}; run_gemm<EpiInproj, InprojLastSched>(ring, g, S, E); } else { TileSched S{M / 256, NINP / 256, F.G, F.vcu, false}; run_gemm<EpiInproj, TileSched>(ring, g, S, E); } } } } \
    SEAMF(base + 0, (l)); \
    if (IN(base + 1)) { if (EN(1)) { \
        pg8::Gemm g{WSP(bf16, WS_Z), WSP(bf16, WS_LORA) + (size_t)(l) * 1280 * 384, M, 1280, 384}; \
        TileSched S{M / 256, 5, F.G, F.vcu, false}; \
        EpiLora E{WSP(bf16, WS_DEC), WSP(bf16, WS_ASIG), WSP(bf16, WS_G), F.in[I_W0] + (l) * 512, F.in[I_A0] + (l) * 512}; \
        { int nrep_ = REP(1) ? 2 : 1; asm volatile("" : "+s"(nrep_)); _Pragma("unroll 1") for (int rep_ = 0; rep_ < nrep_; ++rep_) { if (rep_) GBAR(); run_gemm<EpiLora, TileSched>(ring, g, S, E); } } } \
        if (EN(12)) { phase_qkprep(F, (l)); if (REP(12)) { GBAR(); phase_qkprep(F, (l), true); } } } \
    SEAMF(base + 1, (l)); \
    if (IN(base + 2)) { if (EN(2)) { if (CHUNK_SCAN) { phase_prepass(F, (l)); if (IN(base + 2)) SEAMF(base + 2 - 1, (l)); if (REP(14)) { phase_prepass(F, (l)); GBAR(); } } phase_mixer(F, (l)); if (REP(2)) { GBAR(); phase_mixer(F, (l), 1); } if (REP(15)) { GBAR(); phase_mixer(F, (l), 2); } } } \
    SEAMF(base + 2, (l)); \
    if (IN(base + 4)) { if (EN(4)) { \
        pg8::Gemm g{WSP(bf16, WS_O), WSP(bf16, WS_WOUT) + (size_t)(l) * 1024 * 1024, M, D, D}; \
        TileSched S{last ? 64 : 72, 4, F.G, F.vcu, last}; \
        EpiOut E{WSP(bf16, WS_Y)}; \
        for (int rep_ = 0; rep_ < (REP(4) ? 2 : 1); ++rep_) { if (rep_) GBAR(); run_gemm<EpiOut, TileSched>(ring, g, S, E); } } } \
    SEAMF(base + 4, (l)); \
    if (IN(base + 5)) { if (EN(5)) { phase_row1(F, (l)); if (REP(5)) { GBAR(); phase_row1(F, (l), 1); } if (REP(22)) { GBAR(); phase_row1(F, (l), 2); } if (REP(23)) { GBAR(); phase_row1(F, (l), 3); } } } \
    SEAMF(base + 5, (l)); \
    if (IN(base + 6)) { RUNPH(6, phase_topk(F, (l))); } \
    SEAM(base + 6); \
    if (IN(base + 7)) { if (EN(7)) { \
        pg8::Gemm g{WSP(bf16, WS_XE), WSP(bf16, WS_WGU), NE * MEXP, NE * 2048, D}; \
        MoeSched S{last ? 8 : 9, 8, F.G, F.vcu}; \
        EpiMoe1 E{WSP(bf16, WS_HID)}; \
        for (int rep_ = 0; rep_ < (REP(7) ? 2 : 1); ++rep_) { if (rep_) GBAR(); run_gemm<EpiMoe1, MoeSched>(ring, g, S, E); } } } \
    SEAM(base + 7); \
    if (IN(base + 8)) { if (EN(8)) { \
        pg8::Gemm g{WSP(bf16, WS_HID), WSP(bf16, WS_WD), NE * MEXP, NE * 1024, D}; \
        MoeSched S{last ? 8 : 9, 4, F.G, F.vcu}; \
        EpiMoe2 E{WSP(bf16, WS_OUTE), WSP(float, WS_SELG)}; \
        for (int rep_ = 0; rep_ < (REP(8) ? 2 : 1); ++rep_) { if (rep_) GBAR(); run_gemm<EpiMoe2, MoeSched>(ring, g, S, E); } } } \
    SEAM(base + 8); \
    if (IN(base + 9)) { if (EN(9)) { phase_row2(F, (l)); if (REP(9)) { GBAR(); phase_row2(F, (l), true); } } } \
    if ((l) + 1 < NL) SEAMF(base + 9, (l) + 1); else SEAM(base + 9); \
  } while (0)
    LAYER(0);
    LAYER(1);
#undef LAYER
#undef SEAM
#undef IN
}

extern "C" void kernel_launch(void* const* d_in, const int* in_sizes, int n_in, void* d_out, int out_size, void* d_ws, size_t ws_size, hipStream_t stream) {
    static int grid = 0;
    if (grid == 0) {
        if (n_in != 29 || out_size != NB * SEQ * D || ws_size < WS_END) { fprintf(stderr, "kernel_launch: unexpected sizes n_in %d out %d ws %zu\n", n_in, out_size, ws_size); grid = -1; return; }
        int dev = 0, cus = 0, per_cu = 0;
        if (hipGetDevice(&dev) != hipSuccess || hipDeviceGetAttribute(&cus, hipDeviceAttributeMultiprocessorCount, dev) != hipSuccess) { grid = -1; return; }
        if (hipFuncSetAttribute((const void*)fwd_kernel, hipFuncAttributeMaxDynamicSharedMemorySize, LDS_BYTES) != hipSuccess) { fprintf(stderr, "kernel_launch: hipFuncSetAttribute failed\n"); grid = -1; return; }
        if (hipOccupancyMaxActiveBlocksPerMultiprocessor(&per_cu, (const void*)fwd_kernel, NTHREADS, LDS_BYTES) != hipSuccess || per_cu < 1) { fprintf(stderr, "kernel_launch: occupancy query says %d\n", per_cu); per_cu = 1; }
        (void)hipGetLastError();
        grid = cus;
        fprintf(stderr, "kernel_launch: grid %d, per_cu %d, ws %zu\n", grid, per_cu, ws_size);
    }
    if (grid < 0) return;
    if (hipMemsetAsync((char*)d_ws + WS_CTL, 0, CTL_ZERO_BYTES, stream) != hipSuccess) return;
    Args a{};
    for (int i = 0; i < 29; ++i) a.in[i] = (const float*)d_in[i];
    a.out = (float*)d_out; a.ws = (unsigned char*)d_ws;
#if N_LAUNCH_MODE
    a.ph_lo = 0; a.ph_hi = N_PHASES;
    { void* kargs[] = {&a};
      hipError_t e = hipLaunchCooperativeKernel((const void*)fwd_kernel, dim3(grid), dim3(NTHREADS), kargs, LDS_BYTES, stream);
      if (e != hipSuccess) fprintf(stderr, "kernel_launch: cooperative launch failed: %s\n", hipGetErrorString(e)); }
#else
    for (int ph = 0; ph < N_PHASES; ++ph) {
        a.ph_lo = ph; a.ph_hi = ph + 1;
        void* kargs[] = {&a};
        hipError_t e = hipLaunchCooperativeKernel((const void*)fwd_kernel, dim3(grid), dim3(NTHREADS), kargs, LDS_BYTES, stream);
        if (e != hipSuccess) { fprintf(stderr, "kernel_launch: launch %d failed: %s\n", ph, hipGetErrorString(e)); break; }
    }
#endif
}
```
